# Optimizing an MI355X kernel written in HIP

```python
import jax, jax.numpy as jnp
from jax import lax
import numpy as np

D_MODEL = 4096
BATCH = 1
SEQ = 8192
DEPTH = 1

N_META = 16
ATT_HEADS = 16
ATT_KV_HEADS = 4
HEAD_DIM = 128
ATT_GROUP = ATT_HEADS // ATT_KV_HEADS
ATT_WIDTH = ATT_HEADS * HEAD_DIM
KV_WIDTH = ATT_KV_HEADS * HEAD_DIM
WINDOW = 128
BLOCK = 128
ROPE_DIMS = HEAD_DIM // 4
ROPE_THETA = 500000.0
RWKV_HEAD = 64
RWKV_WIDTH = D_MODEL // 2
RWKV_HEADS = RWKV_WIDTH // RWKV_HEAD
DECAY_LORA = 96
ICLR_LORA = 96
GATE_LORA = 256
SHIFT_WIDTH = 3 * RWKV_WIDTH + 2 * DECAY_LORA + 2 * ICLR_LORA + GATE_LORA
IN_WIDTH = 2 * D_MODEL + ATT_WIDTH + 2 * KV_WIDTH + SHIFT_WIDTH
D_FF = -(-8 * D_MODEL // (3 * 256)) * 256
RMS_EPS = 1e-6
GN_EPS = 64e-5

kernel_name = 'hybrid_bidir_swa_rwkv7_gated'


def rms_norm(x, w):
    xf = x.astype(jnp.float32)
    y = xf * lax.rsqrt(jnp.mean(xf * xf, axis=-1, keepdims=True) + RMS_EPS)
    return (y * w.astype(jnp.float32)).astype(x.dtype)


def rope_partial(t, pos):
    inv = ROPE_THETA ** (-jnp.arange(0, ROPE_DIMS, 2, dtype=jnp.float32) / ROPE_DIMS)
    ang = pos.astype(jnp.float32)[:, None] * inv[None, :]
    cos = jnp.cos(ang)[None, :, None, :]
    sin = jnp.sin(ang)[None, :, None, :]
    tf = t.astype(jnp.float32)
    x1 = tf[..., :ROPE_DIMS // 2]
    x2 = tf[..., ROPE_DIMS // 2:ROPE_DIMS]
    rot = jnp.concatenate([x1 * cos - x2 * sin, x2 * cos + x1 * sin, tf[..., ROPE_DIMS:]], axis=-1)
    return rot.astype(t.dtype)


def windowed_gqa(q, k, v, sink):
    B, L = q.shape[0], q.shape[1]
    S = L - N_META
    nb = S // BLOCK
    f32 = jnp.float32
    scale = HEAD_DIM ** -0.5
    neg = jnp.array(-jnp.inf, f32)
    pos = jnp.arange(L, dtype=jnp.int32)
    sink_f = sink.astype(f32).reshape(ATT_KV_HEADS, ATT_GROUP)
    qm, qr = q[:, :N_META], q[:, N_META:]
    km, kr = k[:, :N_META], k[:, N_META:]
    vm, vr = v[:, :N_META], v[:, N_META:]

    qb = qr.reshape(B, nb, BLOCK, ATT_KV_HEADS, ATT_GROUP, HEAD_DIM)
    padw = ((0, 0), (BLOCK, BLOCK), (0, 0), (0, 0))
    kp = jnp.pad(kr, padw).reshape(B, nb + 2, BLOCK, ATT_KV_HEADS, HEAD_DIM)
    vp = jnp.pad(vr, padw).reshape(B, nb + 2, BLOCK, ATT_KV_HEADS, HEAD_DIM)
    kband = jnp.concatenate([kp[:, :-2], kp[:, 1:-1], kp[:, 2:]], axis=2)
    vband = jnp.concatenate([vp[:, :-2], vp[:, 1:-1], vp[:, 2:]], axis=2)
    kpos = jnp.pad(pos[N_META:], (BLOCK, BLOCK), constant_values=-(2 ** 30)).reshape(nb + 2, BLOCK)
    kpos_band = jnp.concatenate([kpos[:-2], kpos[1:-1], kpos[2:]], axis=1)
    qpos = pos[N_META:].reshape(nb, BLOCK)
    band_ok = jnp.abs(qpos[:, :, None] - kpos_band[:, None, :]) <= WINDOW
    s_band = jnp.einsum('bnqhgd,bnkhd->bnhgqk', qb, kband).astype(f32) * scale
    s_band = jnp.where(band_ok[None, :, None, None], s_band, neg)
    s_meta = jnp.einsum('bnqhgd,bmhd->bnhgqm', qb, km).astype(f32) * scale
    s_sink = jnp.broadcast_to(sink_f[None, None, :, :, None, None], s_meta.shape[:-1] + (1,))
    p = jax.nn.softmax(jnp.concatenate([s_band, s_meta, s_sink], axis=-1), axis=-1).astype(v.dtype)
    o_real = (jnp.einsum('bnhgqk,bnkhd->bnqhgd', p[..., :3 * BLOCK], vband)
              + jnp.einsum('bnhgqm,bmhd->bnqhgd', p[..., 3 * BLOCK:3 * BLOCK + N_META], vm))
    o_real = o_real.reshape(B, S, ATT_WIDTH)

    qmb = qm.reshape(B, N_META, ATT_KV_HEADS, ATT_GROUP, HEAD_DIM)
    kmk = jnp.concatenate([km, kr[:, :BLOCK]], axis=1)
    vmk = jnp.concatenate([vm, vr[:, :BLOCK]], axis=1)
    ok_m = jnp.abs(pos[:N_META, None] - pos[None, :N_META + BLOCK]) <= WINDOW
    s_m = jnp.einsum('bqhgd,bkhd->bhgqk', qmb, kmk).astype(f32) * scale
    s_m = jnp.where(ok_m[None, None, None], s_m, neg)
    s_ms = jnp.broadcast_to(sink_f[None, :, :, None, None], s_m.shape[:-1] + (1,))
    pm = jax.nn.softmax(jnp.concatenate([s_m, s_ms], axis=-1), axis=-1).astype(v.dtype)
    o_meta = jnp.einsum('bhgqk,bkhd->bqhgd', pm[..., :N_META + BLOCK], vmk).reshape(B, N_META, ATT_WIDTH)
    return jnp.concatenate([o_meta, o_real], axis=1)


def token_shift_centred(u, mu_prev, mu_next):
    prev = jnp.pad(u, ((0, 0), (1, 0), (0, 0)))[:, :-1]
    nxt = jnp.pad(u, ((0, 0), (0, 1), (0, 0)))[:, 1:]
    return u + mu_prev * (prev - u) + mu_next * (nxt - u)


def rwkv7_scan(r, w, k, v, kk, b, reverse):
    B, L, H, N = r.shape

    def step(S, inp):
        r_t, w_t, k_t, v_t, kk_t, b_t = inp
        sa = jnp.einsum('bhij,bhj->bhi', S, kk_t)
        S = S * w_t[:, :, None, :] - sa[..., :, None] * b_t[:, :, None, :] + v_t[..., :, None] * k_t[:, :, None, :]
        return S, jnp.einsum('bhij,bhj->bhi', S, r_t)

    xs = tuple(jnp.moveaxis(t, 1, 0) for t in (r, w, k, v, kk, b))
    S0 = jnp.zeros((B, H, N, N), jnp.float32)
    _, y = lax.scan(step, S0, xs, reverse=reverse)
    return jnp.moveaxis(y, 0, 1)


def rwkv7_bidir(u, mu_prev, mu_next, w0, w2, a0, a2, g2, k_k, k_a, r_k, ln_w, ln_b):
    B, L, _ = u.shape
    C, H, N = RWKV_WIDTH, RWKV_HEADS, RWKV_HEAD
    f32 = jnp.float32
    out_dtype = u.dtype
    u = token_shift_centred(u, mu_prev, mu_next).astype(f32)
    idx = [C, 2 * C, 3 * C, 3 * C + 2 * DECAY_LORA, 3 * C + 2 * DECAY_LORA + 2 * ICLR_LORA]
    r, k, v, wd, ad, gd = jnp.split(u, idx, axis=-1)
    wd = wd.reshape(B, L, 2, DECAY_LORA)
    ad = ad.reshape(B, L, 2, ICLR_LORA)
    w_log = -jax.nn.softplus(-(w0.astype(f32) + jnp.einsum('bldr,drc->bldc', jnp.tanh(wd), w2.astype(f32)))) - 0.5
    decay = jnp.exp(-jnp.exp(w_log))
    a = jax.nn.sigmoid(a0.astype(f32) + jnp.einsum('bldr,drc->bldc', ad, a2.astype(f32)))
    g = jax.nn.sigmoid(gd) @ g2.astype(f32)

    def heads(t):
        return t.reshape(t.shape[:-1] + (H, N))

    kk = heads(k * k_k.astype(f32))
    kk = kk / jnp.maximum(jnp.sqrt(jnp.sum(kk * kk, axis=-1, keepdims=True)), 1e-12)
    k_dir = heads(k[:, :, None, :] * (1.0 + (a - 1.0) * k_a.astype(f32)))
    b_dir = kk[:, :, None] * heads(a)
    decay_h = heads(decay)
    r_h, v_h = heads(r), heads(v)
    y_f = rwkv7_scan(r_h, decay_h[:, :, 0], k_dir[:, :, 0], v_h, kk, b_dir[:, :, 0], reverse=False)
    y_b = rwkv7_scan(r_h, decay_h[:, :, 1], k_dir[:, :, 1], v_h, kk, b_dir[:, :, 1], reverse=True)
    y = y_f + y_b
    mean = jnp.mean(y, axis=-1, keepdims=True)
    var = jnp.mean(jnp.square(y - mean), axis=-1, keepdims=True)
    y = (y - mean) * lax.rsqrt(var + GN_EPS) * heads(ln_w.astype(f32)) + heads(ln_b.astype(f32))
    bonus = jnp.sum(r_h[:, :, None] * k_dir * heads(r_k.astype(f32)), axis=(2, -1))[..., None] * v_h
    out = (y + bonus).reshape(B, L, C) * g
    return out.astype(out_dtype)


def setup_inputs(seed: int = 0) -> dict:
    key = jax.random.key(seed)
    ks = jax.random.split(key, 26)
    f32 = jnp.float32
    C = RWKV_WIDTH

    def nrm(k, shape, scale):
        return jax.random.normal(k, shape, f32) * scale

    decay_base = jnp.linspace(-6.5, -1.5, C, dtype=f32)
    return {
        'x': nrm(ks[0], (BATCH, SEQ, D_MODEL), 1.0),
        'meta_tokens': nrm(ks[1], (N_META, D_MODEL), 1.0),
        'norm_mix_w': 1.0 + nrm(ks[2], (DEPTH, D_MODEL), 0.05),
        'w_in': nrm(ks[3], (DEPTH, D_MODEL, IN_WIDTH), D_MODEL ** -0.5),
        'b_gate': nrm(ks[4], (DEPTH, 2, D_MODEL), 0.1),
        'mu_prev': jax.random.uniform(ks[5], (DEPTH, SHIFT_WIDTH), f32, 0.1, 0.5),
        'mu_next': jax.random.uniform(ks[6], (DEPTH, SHIFT_WIDTH), f32, 0.1, 0.5),
        'dec_w0': decay_base + nrm(ks[7], (DEPTH, 2, C), 0.1),
        'dec_w2': nrm(ks[8], (DEPTH, 2, DECAY_LORA, C), 0.1 * DECAY_LORA ** -0.5),
        'iclr_a0': nrm(ks[9], (DEPTH, 2, C), 0.3),
        'iclr_a2': nrm(ks[10], (DEPTH, 2, ICLR_LORA, C), ICLR_LORA ** -0.5),
        'gate_w2': nrm(ks[11], (DEPTH, GATE_LORA, C), GATE_LORA ** -0.5),
        'k_k': 0.85 + nrm(ks[12], (DEPTH, C), 0.05),
        'k_a': 1.0 + nrm(ks[13], (DEPTH, C), 0.05),
        'r_k': nrm(ks[14], (DEPTH, C), 0.1),
        'ln_x_w': 1.0 + nrm(ks[15], (DEPTH, C), 0.05),
        'ln_x_b': nrm(ks[16], (DEPTH, C), 0.01),
        'attn_sink': nrm(ks[17], (DEPTH, ATT_HEADS), 1.0),
        'w_proj_attn': nrm(ks[18], (DEPTH, ATT_WIDTH, D_MODEL), ATT_WIDTH ** -0.5),
        'w_proj_rwkv': nrm(ks[19], (DEPTH, RWKV_WIDTH, D_MODEL), RWKV_WIDTH ** -0.5),
        'w_out': nrm(ks[20], (DEPTH, D_MODEL, D_MODEL), D_MODEL ** -0.5),
        'norm_ffn_w': 1.0 + nrm(ks[21], (DEPTH, D_MODEL), 0.05),
        'w_ffn_gate': nrm(ks[22], (DEPTH, D_MODEL, D_FF), D_MODEL ** -0.5),
        'w_ffn_up': nrm(ks[23], (DEPTH, D_MODEL, D_FF), D_MODEL ** -0.5),
        'w_ffn_down': nrm(ks[24], (DEPTH, D_FF, D_MODEL), D_FF ** -0.5),
        'norm_final_w': 1.0 + nrm(ks[25], (D_MODEL,), 0.05),
    }


def reference(x, meta_tokens, norm_mix_w, w_in, b_gate, mu_prev, mu_next, dec_w0, dec_w2,
              iclr_a0, iclr_a2, gate_w2, k_k, k_a, r_k, ln_x_w, ln_x_b, attn_sink,
              w_proj_attn, w_proj_rwkv, w_out, norm_ffn_w, w_ffn_gate, w_ffn_up, w_ffn_down,
              norm_final_w):
    B = x.shape[0]
    meta = jnp.broadcast_to(meta_tokens.astype(x.dtype)[None], (B, N_META, D_MODEL))
    h_res = jnp.concatenate([meta, x], axis=1)
    L = h_res.shape[1]
    pos = jnp.arange(L, dtype=jnp.int32)
    split_idx = [2 * D_MODEL, 2 * D_MODEL + ATT_WIDTH, 2 * D_MODEL + ATT_WIDTH + KV_WIDTH,
                 2 * D_MODEL + ATT_WIDTH + 2 * KV_WIDTH]
    for layer in range(DEPTH):
        h = rms_norm(h_res, norm_mix_w[layer])
        z = h @ w_in[layer]
        gate_logits, q, k, v, u = jnp.split(z, split_idx, axis=-1)
        gates = jax.nn.sigmoid(gate_logits.reshape(B, L, 2, D_MODEL) + b_gate[layer])
        q = rope_partial(q.reshape(B, L, ATT_HEADS, HEAD_DIM), pos)
        k = rope_partial(k.reshape(B, L, ATT_KV_HEADS, HEAD_DIM), pos)
        v = v.reshape(B, L, ATT_KV_HEADS, HEAD_DIM)
        o_att = windowed_gqa(q, k, v, attn_sink[layer])
        o_rwkv = rwkv7_bidir(u, mu_prev[layer], mu_next[layer], dec_w0[layer], dec_w2[layer],
                             iclr_a0[layer], iclr_a2[layer], gate_w2[layer], k_k[layer],
                             k_a[layer], r_k[layer], ln_x_w[layer], ln_x_b[layer])
        mixed = (gates[:, :, 0] * (o_att @ w_proj_attn[layer])
                 + gates[:, :, 1] * (o_rwkv @ w_proj_rwkv[layer]))
        h_res = h_res + mixed @ w_out[layer]
        h = rms_norm(h_res, norm_ffn_w[layer])
        ffn = (jax.nn.silu(h @ w_ffn_gate[layer]) * (h @ w_ffn_up[layer])) @ w_ffn_down[layer]
        h_res = h_res + ffn
    y = rms_norm(h_res, norm_final_w)
    return y[:, N_META:]
```

```cpp
#include <hip/hip_runtime.h>
#include <cstdio>
#include <cstdint>

#ifndef MK_SPLIT
#define MK_SPLIT 0
#endif

constexpr int NMETA = 16, SEQ = 8192, LTOK = 8208, DM = 4096, MPAD = 8448;
constexpr int INW = 18048, INWP = 18176;
constexpr int ATTW = 2048, KVW = 512, UW = 6784, UPITCH = 6912;
constexpr int RC = 2048, RH = 32, RN = 64;
constexpr int DFF = 11008;
constexpr float RMS_EPS = 1e-6f, GN_EPS = 64e-5f;
constexpr int HT = MPAD / 256;
constexpr int CT_Q = 32, CT_K = 40, CT_V = 42, CT_U = 44, CT_N = 71;

namespace pg8 {
#define PG8_LAS __attribute__((address_space(3)))
typedef unsigned short bf16_t;
typedef short bf16x8 __attribute__((ext_vector_type(8)));
typedef float f32x4 __attribute__((ext_vector_type(4)));
typedef unsigned u32x4 __attribute__((ext_vector_type(4)));
constexpr int BM = 256, BK = 64, HALF = 128, HTB = HALF * BK * 2  , STAGE_BYTES = 8 * HTB, NXCD = 8, WGM = 8;

__host__ __device__ __forceinline__ int lds_byte(int r, int c) { const int st = (r >> 4) * 2 + (c >> 5), rr = r & 15, cc = c & 31, ob = rr * 64 + cc * 2; return st * 1024 + (ob ^ (((ob >> 9) & 1) << 5)); }
__host__ __device__ __forceinline__ void stage_rc(int b, int& R, int& C) { const int st = b / 1024, sb = b % 1024, swz = sb ^ (((sb >> 9) & 1) << 5); R = (st >> 1) * 16 + swz / 64; C = (st & 1) * 32 + (swz % 64) / 2; }
__host__ __device__ __forceinline__ int perm32(int rho) { const int n = rho >> 4, i = rho & 15; return 8 * (i >> 2) + 4 * n + (i & 3); }

struct Unit { int pm, pn; };
struct Gemm { const bf16_t* A; const bf16_t* Bt; int M, N, K; };

struct StaticOrder {
    int nM, nN, nwg, G, c;
    __host__ __device__ void init(int M, int N, int G_, int c_) { nM = M / BM; nN = N / BM; nwg = nM * nN; G = G_; c = c_; }
    __host__ __device__ bool next(int i, Unit& u) const {
        const long L = (long)i * G + c; if (L >= nwg) return false;
        int wgid = (int)L; { const int q = nwg / NXCD, r = nwg % NXCD, xcd = wgid % NXCD, off = wgid / NXCD; wgid = (xcd < r ? xcd * (q + 1) : r * (q + 1) + (xcd - r) * q) + off; }
        const int nig = WGM * nN, gid = wgid / nig, fm = gid * WGM, gsz = (nM - fm) < WGM ? (nM - fm) : WGM;
        u.pm = fm + ((wgid % nig) % gsz); u.pn = (wgid % nig) / gsz; return true;
    }
    __device__ __forceinline__ void a_ready(const Unit&) const {}
    __device__ __forceinline__ void done(const Unit&) const {}
};

__device__ __forceinline__ unsigned cvt_pk_bf16(float lo, float hi) { unsigned r; asm volatile("v_cvt_pk_bf16_f32 %0, %1, %2" : "=v"(r) : "v"(lo), "v"(hi)); return r; }

typedef unsigned u32x2 __attribute__((ext_vector_type(2)));
__device__ __forceinline__ float bflo(unsigned w) { return __uint_as_float(w << 16); }
__device__ __forceinline__ float bfhi(unsigned w) { return __uint_as_float(w & 0xffff0000u); }
__device__ __forceinline__ float sigmoidf_(float x) { return 1.0f / (1.0f + __expf(-x)); }

struct InOrder {
    StaticOrder base; int G, c;
    __device__ void init(int G_, int c_) { base.init(SEQ, INWP, G_, c_); G = G_; c = c_; }
    __device__ bool next(int i, Unit& u) const {
        const long L = (long)i * G + c;
        if (L < base.nwg) {
            base.next(i, u);
            if (u.pn >= CT_V && u.pn < CT_U) { const int e = (u.pn - CT_V) * 32 + u.pm; u.pm = HT + CT_V + e / HT; u.pn = e % HT; }
            else u.pn += HT;
            return true;
        }
        const int x = (int)(L - base.nwg);
        if (x >= 31) return false;
        if (x < 2) { const int e = 64 + x; u.pm = HT + CT_V + e / HT; u.pn = e % HT; }
        else { const int y = x - 2; u.pm = 32; u.pn = HT + (y < 2 ? CT_K + y : CT_U + (y - 2)); }
        return true;
    }
    __device__ __forceinline__ void a_ready(const Unit&) const {}
    __device__ __forceinline__ void done(const Unit&) const {}
};

struct EpiIn {
    static constexpr bool PERM = true, AFTER_DRAIN = false;
    bf16_t *G, *Q, *K, *Vt, *U; const float* bgate; const float* rope;
    __device__ __forceinline__ static void st8(bf16_t* p, const f32x4& v0, const f32x4& v1) {
        u32x4 w; w.x = cvt_pk_bf16(v0[0], v0[1]); w.y = cvt_pk_bf16(v0[2], v0[3]); w.z = cvt_pk_bf16(v1[0], v1[1]); w.w = cvt_pk_bf16(v1[2], v1[3]); *(u32x4*)p = w; }
    __device__ __forceinline__ void plain(const f32x4 (&acc)[2][2][4][2], bf16_t* base, int ldc, int row0, int col0) const {
#pragma unroll
        for (int ai = 0; ai < 2; ++ai)
#pragma unroll
            for (int m = 0; m < 4; ++m) { bf16_t* rowp = base + (size_t)(row0 + ai * HALF + m * 16) * ldc + col0;
#pragma unroll
                for (int bj = 0; bj < 2; ++bj) st8(rowp + bj * HALF, acc[ai][bj][m][0], acc[ai][bj][m][1]); }
    }
    __device__ __forceinline__ void roped(const f32x4 (&acc)[2][2][4][2], bf16_t* base, int ldc, int row0, int col0, int wc, int fq) const {
        if (wc != 0) { plain(acc, base, ldc, row0, col0); return; }
        const float sgn = (fq < 2) ? -1.0f : 1.0f;
#pragma unroll
        for (int ai = 0; ai < 2; ++ai)
#pragma unroll
            for (int m = 0; m < 4; ++m) { const int row = row0 + ai * HALF + m * 16; const int pos = row < SEQ ? row + NMETA : row - SEQ;
                const f32x4* cs = (const f32x4*)(rope + (size_t)pos * 32 + 16 * (fq & 1));
                const f32x4 c0 = cs[0], c1 = cs[1], c2 = cs[2], c3 = cs[3];
                const float cw[8] = {c0[0], c0[2], c1[0], c1[2], c2[0], c2[2], c3[0], c3[2]}, sw[8] = {c0[1], c0[3], c1[1], c1[3], c2[1], c2[3], c3[1], c3[3]};
                bf16_t* rowp = base + (size_t)row * ldc + col0;
#pragma unroll
                for (int bj = 0; bj < 2; ++bj) { f32x4 v0 = acc[ai][bj][m][0], v1 = acc[ai][bj][m][1], o0, o1;
#pragma unroll
                    for (int e = 0; e < 4; ++e) { const float p0 = __shfl_xor(v0[e], 32), p1 = __shfl_xor(v1[e], 32);
                        o0[e] = v0[e] * cw[e] + sgn * p0 * sw[e]; o1[e] = v1[e] * cw[4 + e] + sgn * p1 * sw[4 + e]; }
                    st8(rowp + bj * HALF, o0, o1); } }
    }
    __device__ __forceinline__ void operator()(const f32x4 (&acc)[2][2][4][2], const Unit& u, int wr, int wc, int fr, int fq) const {
        if (u.pm >= HT) {
            plain(acc, Vt, MPAD, (u.pm - HT - CT_V) * BM + wr * 64 + fr, u.pn * BM + wc * 32 + 8 * fq); return; }
        const int ct = u.pn - HT, row0 = u.pm * BM + wr * 64 + fr, cl = wc * 32 + 8 * fq;
        if (ct < CT_Q) {
            const int col0 = ct * BM + cl;
#pragma unroll
            for (int bj = 0; bj < 2; ++bj) { const f32x4 b0 = *(const f32x4*)(bgate + col0 + bj * HALF), b1 = *(const f32x4*)(bgate + col0 + bj * HALF + 4);
#pragma unroll
                for (int ai = 0; ai < 2; ++ai)
#pragma unroll
                    for (int m = 0; m < 4; ++m) { f32x4 v0 = acc[ai][bj][m][0] + b0, v1 = acc[ai][bj][m][1] + b1;
#pragma unroll
                        for (int e = 0; e < 4; ++e) { v0[e] = sigmoidf_(v0[e]); v1[e] = sigmoidf_(v1[e]); }
                        st8(G + (size_t)(row0 + ai * HALF + m * 16) * (2 * DM) + col0 + bj * HALF, v0, v1); } }
        } else if (ct < CT_K) { roped(acc, Q, ATTW, row0, (ct - CT_Q) * BM + cl, wc, fq);
        } else if (ct < CT_V) { roped(acc, K, KVW, row0, (ct - CT_K) * BM + cl, wc, fq);
        } else { plain(acc, U, UPITCH, row0, (ct - CT_U) * BM + cl); }
    }
};

struct EpiProjA {
    static constexpr bool PERM = true, AFTER_DRAIN = false;
    float* P1; const bf16_t* G;
    __device__ __forceinline__ void operator()(const f32x4 (&acc)[2][2][4][2], const Unit& u, int wr, int wc, int fr, int fq) const {
        const int row0 = u.pm * BM + wr * 64 + fr, col0 = u.pn * BM + wc * 32 + 8 * fq;
#pragma unroll
        for (int ai = 0; ai < 2; ++ai)
#pragma unroll
            for (int m = 0; m < 4; ++m) { const size_t r = (size_t)(row0 + ai * HALF + m * 16);
#pragma unroll
                for (int bj = 0; bj < 2; ++bj) { const int c = col0 + bj * HALF; const u32x4 g = *(const u32x4*)(G + r * (2 * DM) + c);
                    f32x4 o0 = acc[ai][bj][m][0], o1 = acc[ai][bj][m][1];
                    o0[0] *= bflo(g.x); o0[1] *= bfhi(g.x); o0[2] *= bflo(g.y); o0[3] *= bfhi(g.y); o1[0] *= bflo(g.z); o1[1] *= bfhi(g.z); o1[2] *= bflo(g.w); o1[3] *= bfhi(g.w);
                    float* p = P1 + r * DM + c; *(f32x4*)p = o0; *(f32x4*)(p + 4) = o1; } }
    }
};
struct EpiProjB {
    static constexpr bool PERM = true, AFTER_DRAIN = false;
    const float* P1; const bf16_t* G; bf16_t* MX;
    __device__ __forceinline__ void operator()(const f32x4 (&acc)[2][2][4][2], const Unit& u, int wr, int wc, int fr, int fq) const {
        const int row0 = u.pm * BM + wr * 64 + fr, col0 = u.pn * BM + wc * 32 + 8 * fq;
#pragma unroll
        for (int ai = 0; ai < 2; ++ai)
#pragma unroll
            for (int m = 0; m < 4; ++m) { const size_t r = (size_t)(row0 + ai * HALF + m * 16);
#pragma unroll
                for (int bj = 0; bj < 2; ++bj) { const int c = col0 + bj * HALF; const u32x4 g = *(const u32x4*)(G + r * (2 * DM) + DM + c);
                    const float* p = P1 + r * DM + c; f32x4 o0 = *(const f32x4*)p, o1 = *(const f32x4*)(p + 4); const f32x4 a0 = acc[ai][bj][m][0], a1 = acc[ai][bj][m][1];
                    o0[0] += a0[0] * bflo(g.x); o0[1] += a0[1] * bfhi(g.x); o0[2] += a0[2] * bflo(g.y); o0[3] += a0[3] * bfhi(g.y);
                    o1[0] += a1[0] * bflo(g.z); o1[1] += a1[1] * bfhi(g.z); o1[2] += a1[2] * bflo(g.w); o1[3] += a1[3] * bfhi(g.w);
                    EpiIn::st8(MX + r * DM + c, o0, o1); }
                asm volatile("" ::: "memory"); }
    }
};
template <bool COPY> struct EpiResid {
    static constexpr bool PERM = true, AFTER_DRAIN = false;
    const float* BASE; float* OUT; bf16_t* CP; float* SS;
    __device__ __forceinline__ void operator()(const f32x4 (&acc)[2][2][4][2], const Unit& u, int wr, int wc, int fr, int fq) const {
        const int row0 = u.pm * BM + wr * 64 + fr, col0 = u.pn * BM + wc * 32 + 8 * fq;
#pragma unroll
        for (int ai = 0; ai < 2; ++ai)
#pragma unroll
            for (int m = 0; m < 4; ++m) { const size_t r = (size_t)(row0 + ai * HALF + m * 16); float ss = 0.f;
#pragma unroll
                for (int bj = 0; bj < 2; ++bj) { const int c = col0 + bj * HALF; const float* bp = BASE + r * DM + c;
                    const f32x4 o0 = *(const f32x4*)bp + acc[ai][bj][m][0], o1 = *(const f32x4*)(bp + 4) + acc[ai][bj][m][1];
                    ss += (o0[0] * o0[0] + o0[1] * o0[1]) + (o0[2] * o0[2] + o0[3] * o0[3]) + (o1[0] * o1[0] + o1[1] * o1[1]) + (o1[2] * o1[2] + o1[3] * o1[3]);
                    float* op = OUT + r * DM + c; *(f32x4*)op = o0; *(f32x4*)(op + 4) = o1;
                    if (COPY) EpiIn::st8(CP + r * DM + c, o0, o1); }
                ss += __shfl_xor(ss, 16); ss += __shfl_xor(ss, 32);
                if (fq == 0) atomicAdd(SS + r, ss);
                asm volatile("" ::: "memory"); }
    }
};
struct EpiSwiGLU {
    static constexpr bool PERM = true, AFTER_DRAIN = false;
    bf16_t* HID; const float* SS;
    __device__ __forceinline__ void operator()(const f32x4 (&acc)[2][2][4][2], const Unit& u, int wr, int wc, int fr, int fq) const {
        const int row0 = u.pm * BM + wr * 64 + fr, col0 = u.pn * HALF + wc * 32 + 8 * fq;
#pragma unroll
        for (int ai = 0; ai < 2; ++ai)
#pragma unroll
            for (int m = 0; m < 4; ++m) { const size_t r = (size_t)(row0 + ai * HALF + m * 16);
                const float rstd = 1.0f / sqrtf(SS[r] * (1.0f / DM) + RMS_EPS);
                f32x4 o0, o1;
#pragma unroll
                for (int e = 0; e < 4; ++e) { const float g0 = acc[ai][0][m][0][e] * rstd, u0 = acc[ai][1][m][0][e] * rstd, g1 = acc[ai][0][m][1][e] * rstd, u1 = acc[ai][1][m][1][e] * rstd;
                    o0[e] = g0 * sigmoidf_(g0) * u0; o1[e] = g1 * sigmoidf_(g1) * u1; }
                EpiIn::st8(HID + r * DFF + col0, o0, o1); }
    }
};

template <class Epi, class Sched, bool ALIGN_EPI = false, bool SP2 = false>
__device__ __forceinline__ void gemm_phase(PG8_LAS unsigned char* lds, const Gemm g, const Sched& S, const Epi& E) {
    const int tid = threadIdx.x, wid = __builtin_amdgcn_readfirstlane(tid >> 6), lane = tid & 63, wr = wid >> 2, wc = wid & 3, fr = lane & 15, fq = lane >> 4;
    const int K = g.K, nt = K / BK;
    unsigned voffA[2], voffB[2];
#pragma unroll
    for (int i = 0; i < 2; ++i) { int R, C; stage_rc(tid * 16 + i * 8192, R, C); const int Rb = Epi::PERM ? ((R & ~31) + perm32(R & 31)) : R;
        voffA[i] = (unsigned)(R * K + C) * 2u; voffB[i] = (unsigned)(Rb * K + C) * 2u; }
    const size_t kstep = (size_t)(BK * 2);
    const size_t hstep = (size_t)HALF * K * 2;
    const size_t tstep = 2 * hstep;
    const unsigned ldsw = (unsigned)wid * 1024u;
    const int aoff = lds_byte(wr * 64 + fr, fq * 8), boff = lds_byte(wc * 32 + fr, fq * 8);
#define PG8_SA(b, h) (((b) * 2 + (h)) * HTB)
#define PG8_SB(b, h) ((4 + (b) * 2 + (h)) * HTB)
#define PG8_STAGE(bufoff, gbase, voff) do { _Pragma("unroll") for (int _i = 0; _i < 2; ++_i) \
        __builtin_amdgcn_global_load_lds((const unsigned*)((const char*)(gbase) + (voff)[_i]), (PG8_LAS unsigned*)(lds + (bufoff) + ldsw + _i * 8192), 16, 0, 0); } while (0)
#define PG8_LDA(dst, b, h) do { _Pragma("unroll") for (int m = 0; m < 4; ++m) _Pragma("unroll") for (int k = 0; k < 2; ++k) dst[m][k] = *(const PG8_LAS bf16x8*)(lds + PG8_SA(b, h) + aoff + m * 2048 + k * 1024); } while (0)
#define PG8_LDB(dst, b, h) do { _Pragma("unroll") for (int n = 0; n < 2; ++n) _Pragma("unroll") for (int k = 0; k < 2; ++k) dst[n][k] = *(const PG8_LAS bf16x8*)(lds + PG8_SB(b, h) + boff + n * 2048 + k * 1024); } while (0)
#define PG8_MMA(ai, bj, At, Bt) do { __builtin_amdgcn_s_setprio(1); _Pragma("unroll") for (int m = 0; m < 4; ++m) _Pragma("unroll") for (int n = 0; n < 2; ++n) _Pragma("unroll") for (int k = 0; k < 2; ++k) \
        acc[ai][bj][m][n] = __builtin_amdgcn_mfma_f32_16x16x32_bf16(Bt[n][k], At[m][k], acc[ai][bj][m][n], 0, 0, 0); __builtin_amdgcn_s_setprio(0); } while (0)
#define PG8_WAIT_V(n) asm volatile("s_waitcnt vmcnt(" #n ")" ::: "memory")
#define PG8_WAIT_L(n) asm volatile("s_waitcnt lgkmcnt(" #n ")" ::: "memory")
#define PG8_BAR __builtin_amdgcn_s_barrier()
#define PG8_SCHED __builtin_amdgcn_sched_barrier(0)
    Unit cur, nxt; int ui = 0;
    if (!S.next(0, cur)) return;
    f32x4 acc[2][2][4][2];
#pragma unroll
    for (int a = 0; a < 2; ++a)
#pragma unroll
        for (int b = 0; b < 2; ++b)
#pragma unroll
            for (int m = 0; m < 4; ++m)
#pragma unroll
                for (int n = 0; n < 2; ++n) acc[a][b][m][n] = (f32x4){0.f, 0.f, 0.f, 0.f};
    bf16x8 At[4][2], B0[2][2], B1[2][2];
    const char* cA = (const char*)g.A + (size_t)cur.pm * tstep; const char* cB = (const char*)g.Bt + (size_t)cur.pn * tstep;
    S.a_ready(cur);
    if constexpr (SP2) {
        PG8_STAGE(PG8_SB(0, 0), cB, voffB); PG8_STAGE(PG8_SB(0, 1), cB + hstep, voffB); PG8_STAGE(PG8_SA(0, 0), cA, voffA); PG8_STAGE(PG8_SA(0, 1), cA + hstep, voffA);
        if (wr == 1) PG8_BAR;
        PG8_WAIT_V(2); PG8_BAR;
        PG8_STAGE(PG8_SB(1, 0), cB + kstep, voffB); PG8_STAGE(PG8_SA(1, 0), cA + kstep, voffA); PG8_STAGE(PG8_SB(1, 1), cB + hstep + kstep, voffB);
        PG8_WAIT_V(6); PG8_BAR;
    } else {
        PG8_STAGE(PG8_SB(0, 0), cB, voffB); PG8_STAGE(PG8_SA(0, 0), cA, voffA); PG8_STAGE(PG8_SB(0, 1), cB + hstep, voffB); PG8_STAGE(PG8_SA(0, 1), cA + hstep, voffA);
        if (wr == 1) PG8_BAR;
        PG8_WAIT_V(4); PG8_BAR;
        PG8_STAGE(PG8_SB(1, 0), cB + kstep, voffB); PG8_STAGE(PG8_SA(1, 0), cA + kstep, voffA); PG8_STAGE(PG8_SB(1, 1), cB + hstep + kstep, voffB);
        PG8_WAIT_V(6); PG8_BAR;
    }
    for (;;) {
        const bool has_next = S.next(ui + 1, nxt);
        const char* nA = has_next ? (const char*)g.A + (size_t)nxt.pm * tstep : cA; const char* nB = has_next ? (const char*)g.Bt + (size_t)nxt.pn * tstep : cB;
        for (int t = 0; t < nt; t += 2) {
            const bool last = (t == nt - 2);
            const char* a1 = cA + (size_t)(t + 1) * kstep;
            const char* a2 = last ? nA : cA + (size_t)(t + 2) * kstep; const char* b2 = last ? nB : cB + (size_t)(t + 2) * kstep;
            const char* a3 = a2 + kstep; const char* b3 = b2 + kstep;
            if (last && has_next) S.a_ready(nxt);
            if constexpr (SP2) {
            PG8_LDB(B0, 0, 0); PG8_LDB(B1, 0, 1); PG8_SCHED; PG8_LDA(At, 0, 0); PG8_STAGE(PG8_SA(1, 1), a1 + hstep, voffA);
            PG8_WAIT_V(8); PG8_WAIT_L(0); PG8_BAR; PG8_MMA(0, 0, At, B0); PG8_MMA(0, 1, At, B1); PG8_BAR; PG8_SCHED;
            PG8_LDA(At, 0, 1); PG8_STAGE(PG8_SB(0, 0), b2, voffB); PG8_STAGE(PG8_SB(0, 1), b2 + hstep, voffB); PG8_STAGE(PG8_SA(0, 0), a2, voffA);
            PG8_WAIT_V(8); PG8_WAIT_L(0); PG8_BAR; PG8_MMA(1, 0, At, B0); PG8_MMA(1, 1, At, B1); PG8_BAR; PG8_SCHED;
            PG8_LDB(B0, 1, 0); PG8_LDB(B1, 1, 1); PG8_SCHED; PG8_LDA(At, 1, 0); PG8_STAGE(PG8_SA(0, 1), a2 + hstep, voffA);
            PG8_WAIT_V(8); PG8_WAIT_L(0); PG8_BAR; PG8_MMA(0, 0, At, B0); PG8_MMA(0, 1, At, B1); PG8_BAR; PG8_SCHED;
            PG8_LDA(At, 1, 1); PG8_STAGE(PG8_SB(1, 0), b3, voffB); PG8_STAGE(PG8_SB(1, 1), b3 + hstep, voffB); PG8_STAGE(PG8_SA(1, 0), a3, voffA);
            PG8_WAIT_V(8); PG8_WAIT_L(0); PG8_BAR; PG8_MMA(1, 0, At, B0); PG8_MMA(1, 1, At, B1); PG8_BAR; PG8_SCHED;
            } else {
            PG8_LDB(B0, 0, 0); PG8_SCHED; PG8_LDA(At, 0, 0); PG8_STAGE(PG8_SA(1, 1), a1 + hstep, voffA);
            PG8_WAIT_L(8); PG8_BAR; PG8_WAIT_L(0); PG8_MMA(0, 0, At, B0); PG8_BAR; PG8_SCHED;
            PG8_LDB(B1, 0, 1); PG8_STAGE(PG8_SB(0, 0), b2, voffB);
            PG8_BAR; PG8_WAIT_L(0); PG8_MMA(0, 1, At, B1); PG8_BAR;
            PG8_LDA(At, 0, 1); PG8_STAGE(PG8_SA(0, 0), a2, voffA);
            PG8_BAR; PG8_WAIT_L(0); PG8_MMA(1, 0, At, B0); PG8_BAR; PG8_SCHED;
            PG8_STAGE(PG8_SB(0, 1), b2 + hstep, voffB);
            PG8_WAIT_V(6); PG8_BAR; PG8_MMA(1, 1, At, B1); PG8_BAR;
            PG8_LDB(B0, 1, 0); PG8_SCHED; PG8_LDA(At, 1, 0); PG8_STAGE(PG8_SA(0, 1), a2 + hstep, voffA);
            PG8_WAIT_L(8); PG8_BAR; PG8_WAIT_L(0); PG8_MMA(0, 0, At, B0); PG8_BAR; PG8_SCHED;
            PG8_LDB(B1, 1, 1); PG8_STAGE(PG8_SB(1, 0), b3, voffB);
            PG8_BAR; PG8_WAIT_L(0); PG8_MMA(0, 1, At, B1); PG8_BAR;
            PG8_LDA(At, 1, 1); PG8_STAGE(PG8_SA(1, 0), a3, voffA);
            PG8_BAR; PG8_WAIT_L(0); PG8_MMA(1, 0, At, B0); PG8_BAR; PG8_SCHED;
            PG8_STAGE(PG8_SB(1, 1), b3 + hstep, voffB);
            PG8_WAIT_V(6); PG8_BAR; PG8_MMA(1, 1, At, B1); PG8_BAR;
            }
        }
        if constexpr (ALIGN_EPI) { if (wr == 0) PG8_BAR; }
        if constexpr (!Epi::AFTER_DRAIN) { E(acc, cur, wr, wc, fr, fq); S.done(cur); }
        if (!has_next) break;
#pragma unroll
        for (int a = 0; a < 2; ++a)
#pragma unroll
            for (int b = 0; b < 2; ++b)
#pragma unroll
                for (int m = 0; m < 4; ++m)
#pragma unroll
                    for (int n = 0; n < 2; ++n) acc[a][b][m][n] = (f32x4){0.f, 0.f, 0.f, 0.f};
        cur = nxt; cA = nA; cB = nB; ++ui;
        if constexpr (ALIGN_EPI) { if (wr == 1) PG8_BAR; }
    }
    PG8_WAIT_V(0);
    if constexpr (!ALIGN_EPI) { if (wr == 0) PG8_BAR; }
    PG8_BAR;
    if constexpr (Epi::AFTER_DRAIN) { E.fused(acc, cur, wr, wc, fr, fq, lds, wid, lane); S.done(cur); }
#undef PG8_SA
#undef PG8_SB
#undef PG8_STAGE
#undef PG8_LDA
#undef PG8_LDB
#undef PG8_MMA
#undef PG8_WAIT_V
#undef PG8_WAIT_L
#undef PG8_BAR
#undef PG8_SCHED
}

}

constexpr size_t MiB = 1u << 20;
constexpr size_t WS_CTL = 0, CTL_ZERO_BYTES = 1 * MiB;
constexpr size_t WS_ROPE = 1 * MiB;
constexpr size_t WS_LW2 = 3 * MiB, WS_LA2 = 4 * MiB, WS_LG2 = 5 * MiB;
constexpr size_t WS_BONUS = 6 * MiB;
constexpr size_t WS_H = 8 * MiB, WS_WIN = WS_H + (size_t)MPAD * DM * 2;
constexpr size_t WS_WPA = 8 * MiB, WS_WPR = 24 * MiB, WS_WOUT = 40 * MiB, WS_OATT = 72 * MiB, WS_ORWKV = 104 * MiB, WS_GG = 136 * MiB;
constexpr size_t WS_G = 216 * MiB, WS_A2 = 216 * MiB;
constexpr size_t WS_Q = 344 * MiB, WS_K = 376 * MiB, WS_VT = 385 * MiB, WS_U = 394 * MiB;
constexpr size_t WS_Y = 344 * MiB, WS_P1 = 344 * MiB, WS_H2 = 344 * MiB, WS_MX = 474 * MiB;
constexpr size_t SCF = (size_t)LTOK * RC * 4, SCB = (size_t)LTOK * RC * 2;
constexpr size_t WS_W0 = 512 * MiB, WS_W1 = WS_W0 + SCF, WS_KD0 = WS_W1 + SCF, WS_KD1 = WS_KD0 + SCB, WS_B0 = WS_KD1 + SCB, WS_B1 = WS_B0 + SCB, WS_KK = WS_B1 + SCB, WS_RR = WS_KK + SCB, WS_VV = WS_RR + SCB, WS_SCEND = WS_VV + SCB;
constexpr size_t WS_WD = 538 * MiB, WS_HID = 640 * MiB;
constexpr size_t WS_WGU = 866 * MiB, WS_END = WS_WGU + (size_t)2 * DFF * DM * 2;
static_assert(WS_WIN + (size_t)INWP * DM * 2 <= WS_G, "map: R");
static_assert(WS_GG + SCB <= WS_G && WS_U + (size_t)MPAD * UPITCH * 2 <= WS_W0 && WS_VT + (size_t)KVW * MPAD * 2 <= WS_U && WS_K + (size_t)MPAD * KVW * 2 <= WS_VT, "map: P1 outputs");
static_assert(WS_Y + 2 * SCF <= WS_MX && WS_MX + (size_t)SEQ * DM * 2 <= WS_WD && WS_WD + (size_t)DM * DFF * 2 <= WS_HID && WS_W1 + SCF >= WS_WD + (size_t)DM * DFF * 2, "map: overlays");
static_assert(WS_SCEND <= WS_WGU && WS_HID + (size_t)SEQ * DFF * 2 <= WS_WGU && WS_VV >= WS_HID + 0, "map: scan arrays");
constexpr int CW_BAR = 4096;
constexpr int CW_SS2 = 65536, CW_SS3 = 65536 + 8192;
static_assert((CW_SS3 + 8192) * 4 <= (int)CTL_ZERO_BYTES, "CTL");

constexpr int RING_BYTES = 131072;
constexpr int LDSCTL_OFF = RING_BYTES, MISC_OFF = LDSCTL_OFF + 320;
constexpr int LDS_BYTES = 147456;

#define GAS __attribute__((address_space(1)))
#define LAS __attribute__((address_space(3)))
typedef unsigned short bf16;
typedef unsigned v4u __attribute__((ext_vector_type(4)));
typedef unsigned v2u __attribute__((ext_vector_type(2)));
typedef float f32x4 __attribute__((ext_vector_type(4)));
typedef float f32x2 __attribute__((ext_vector_type(2)));
typedef float f32x16 __attribute__((ext_vector_type(16)));
typedef short bf16x8 __attribute__((ext_vector_type(8)));
typedef GAS unsigned gu32;
#define RLX_AGENT __ATOMIC_RELAXED, __HIP_MEMORY_SCOPE_AGENT
#define LDS_WAIT() asm volatile("s_waitcnt lgkmcnt(0)" ::: "memory")
__device__ __forceinline__ unsigned f2bf(float f) { unsigned u = __builtin_bit_cast(unsigned, f); return (u + 0x7fffu + ((u >> 16) & 1u)) >> 16; }
__device__ __forceinline__ unsigned pk2(float lo, float hi) { return f2bf(lo) | (f2bf(hi) << 16); }
__device__ __forceinline__ float bf2f(bf16 b) { return __uint_as_float(((unsigned)b) << 16); }
using pg8::bflo; using pg8::bfhi; using pg8::sigmoidf_;

#define XB_TMO      128
#define XB_XCNT(j)  (256  + 64 * (j))
#define XB_XSUB(j)  (1280 + 64 * (j))
#define XB_XGEN(j)  (2304 + 64 * (j))
#define XB_TOP      3328
#define XB_TOPGEN   3392
#define XCD_BAR_WORDS 3456
#define XB_SPIN_CAP (1u << 18)

__device__ __forceinline__ unsigned xb_ld(unsigned* p)              { return __hip_atomic_load(p, __ATOMIC_RELAXED, __HIP_MEMORY_SCOPE_AGENT); }
__device__ __forceinline__ unsigned xb_add(unsigned* p, unsigned v) { return __hip_atomic_fetch_add(p, v, __ATOMIC_RELAXED, __HIP_MEMORY_SCOPE_AGENT); }
__device__ __forceinline__ unsigned xb_xcc_id() { return (unsigned)__builtin_amdgcn_s_getreg((3 << 11) | 20) & 0xFu; }
#define XB_SPIN(cond, bar) do { unsigned _sp = 0; while (cond) { __builtin_amdgcn_s_sleep(1); \
    if ((++_sp & 255u) == 0u) { if (xb_ld(&(bar)[XB_TMO])) break; if (_sp > XB_SPIN_CAP) { atomicAdd(&(bar)[XB_TMO], 1u); break; } } } } while (0)

struct XcdBarrier {
    unsigned* bar; unsigned x;
    volatile LAS unsigned* st;
};

__device__ __forceinline__ XcdBarrier xcd_barrier_post(unsigned* bar, volatile LAS unsigned* st) {
    XcdBarrier b; b.bar = bar; b.x = xb_xcc_id(); b.st = st;
    if (threadIdx.x == 0) (void)xb_add(&bar[XB_XCNT(b.x)], 1u);
    return b;
}
__device__ __forceinline__ void xcd_barrier_complete(unsigned* bar, unsigned x, unsigned& nloc, unsigned& nx) {
    const unsigned G = gridDim.x * gridDim.y * gridDim.z;
    unsigned sum, cnt, mine, sp = 0u;
    for (;;) {
        sum = 0u; cnt = 0u; mine = 0u;
#pragma unroll
        for (unsigned j = 0; j < 16; ++j) { const unsigned c = xb_ld(&bar[XB_XCNT(j)]); sum += c; cnt += (c > 0u) ? 1u : 0u; mine = (j == x) ? c : mine; }
        if (sum == G) break;
        __builtin_amdgcn_s_sleep(1);
        if ((++sp & 255u) == 0u) { if (xb_ld(&bar[XB_TMO])) break; if (sp > XB_SPIN_CAP) { atomicAdd(&bar[XB_TMO], 1u); break; } }
    }
    nloc = mine > 0u ? mine : 1u; nx = cnt > 0u ? cnt : 1u;
}

__device__ __forceinline__ void xcd_barrier(const XcdBarrier& b) {
    asm volatile("s_waitcnt vmcnt(0)" ::: "memory");
    __syncthreads();
    if (threadIdx.x == 0) {
        unsigned* bar = b.bar;
        __builtin_amdgcn_s_waitcnt(0);
        unsigned nloc = b.st[0], nx = b.st[1];
        if (nloc == 0u) { xcd_barrier_complete(bar, b.x, nloc, nx); b.st[0] = nloc; b.st[1] = nx; }
        const unsigned old = xb_add(&bar[XB_XSUB(b.x)], 1u);
        const unsigned gen = old / nloc;
        if (old + 1u == (gen + 1u) * nloc) {
            __builtin_amdgcn_fence(__ATOMIC_RELEASE, "agent");
            asm volatile("s_waitcnt vmcnt(0)" ::: "memory");
            const unsigned og = xb_add(&bar[XB_TOP], 1u);
            const unsigned tg = og / nx;
            if (og + 1u == (tg + 1u) * nx) xb_add(&bar[XB_TOPGEN], 1u);
            else XB_SPIN(xb_ld(&bar[XB_TOPGEN]) == tg, bar);
            __builtin_amdgcn_fence(__ATOMIC_ACQUIRE, "agent");
            xb_add(&bar[XB_XGEN(b.x)], 1u);
            asm volatile("s_waitcnt vmcnt(0)" ::: "memory");
        } else {
            XB_SPIN(xb_ld(&bar[XB_XGEN(b.x)]) == gen, bar);
            __builtin_amdgcn_fence(__ATOMIC_ACQUIRE, "agent");
            asm volatile("s_waitcnt vmcnt(0)" ::: "memory");
        }
    }
    __syncthreads();
}


struct Frame {
    LAS unsigned char* lds;
    volatile LAS unsigned* MISC;
    gu32* ctl;
    int tid, lane, wave, G;
    unsigned char* ws;
    const float* in[26];
    float* out;
};
__device__ __forceinline__ float wave_sum(float v) {
#pragma unroll
    for (int o = 1; o < 64; o <<= 1) v += __shfl_xor(v, o);
    return v;
}

template <int MODE> __device__ __forceinline__ void transpose_item(const float* W, int K, int N, bf16* WT, LAS float* scr, int item, int lane, const float* kscale) {
    const int nblk = N / 32, kb = item / nblk, nb = item % nblk, k0 = 64 * kb, n0 = 32 * nb;
#pragma unroll 8
    for (int i = 0; i < 32; ++i) { const int kk = 2 * i + (lane >> 5); float v = W[(size_t)(k0 + kk) * N + n0 + (lane & 31)]; if (kscale) v *= kscale[k0 + kk]; scr[kk * 33 + (lane & 31)] = v; }
    LDS_WAIT(); asm volatile("" ::: "memory");
    const int c = lane & 7;
#pragma unroll
    for (int j = 0; j < 4; ++j) { const int n = (lane >> 3) + 8 * j; const LAS float* s = scr + (8 * c) * 33 + n;
        v4u o; o.x = pk2(s[0 * 33], s[1 * 33]); o.y = pk2(s[2 * 33], s[3 * 33]); o.z = pk2(s[4 * 33], s[5 * 33]); o.w = pk2(s[6 * 33], s[7 * 33]);
        const int nn = n0 + n; const int dr = (MODE == 0) ? nn : (256 * (nn >> 7) + (nn & 127) + (MODE == 2 ? 128 : 0));
        *(GAS v4u*)(WT + (size_t)dr * K + k0 + 8 * c) = o; }
    LDS_WAIT(); asm volatile("" ::: "memory");
}
__device__ __forceinline__ void rms_row_to_bf16(int lane, const float* xrow, const float* w, bf16* orow) {
    const GAS f32x4* xr = (const GAS f32x4*)xrow + lane;
    f32x4 v[16]; float s = 0.f;
#pragma unroll
    for (int j = 0; j < 16; ++j) { v[j] = xr[64 * j]; s += (v[j].x * v[j].x + v[j].y * v[j].y) + (v[j].z * v[j].z + v[j].w * v[j].w); }
    const float rstd = 1.f / sqrtf(wave_sum(s) * (1.f / DM) + RMS_EPS);
    const GAS f32x4* wr = (const GAS f32x4*)w + lane;
    GAS v2u* o8 = (GAS v2u*)orow + lane;
#pragma unroll
    for (int j = 0; j < 16; ++j) { const f32x4 ww = wr[64 * j]; v2u o; o.x = pk2(v[j].x * rstd * ww.x, v[j].y * rstd * ww.y); o.y = pk2(v[j].z * rstd * ww.z, v[j].w * rstd * ww.w); o8[64 * j] = o; }
}
__device__ const double ROPE_INV[16] = {
    1.0000000000000000000000000e+0,
    4.4036660267178047359198331e-1,
    1.9392274474868577334259386e-1,
    8.5397100285765611280149662e-2,
    3.7606030930863935681246092e-2,
    1.6560440080994445548947445e-2,
    7.2926647372171090477661219e-3,
    3.2114459947525910185434889e-3,
    1.4142135623730950488016887e-3,
    6.2277242191459597955502746e-4,
    2.7424817567620731825332265e-4,
    1.2076973741146503832424826e-4,
    5.3182958969449886162502429e-5,
    2.3419998961409341542188076e-5,
    1.0313385377212458859810127e-5,
    4.5416704806078696531998012e-6
};

__device__ __forceinline__ void p0_prologue(Frame& F) {
    LAS float* scr = (LAS float*)(F.lds + F.wave * 16384);
    const int gw = blockIdx.x * 8 + F.wave, NGW = F.G * 8;
    bf16* Wint = (bf16*)(F.ws + WS_WIN); bf16* Wgu = (bf16*)(F.ws + WS_WGU); bf16* H = (bf16*)(F.ws + WS_H);
    constexpr int I_IN = (DM / 64) * (INW / 32), I_GU = (DM / 64) * (DFF / 32);
    for (int it = gw; it < I_IN + 2 * I_GU; it += NGW) {
        int r = it;
        if (r < I_IN) { transpose_item<0>(F.in[3], DM, INW, Wint, scr, r, F.lane, nullptr); continue; } r -= I_IN;
        if (r < I_GU) { transpose_item<1>(F.in[22], DM, DFF, Wgu, scr, r, F.lane, F.in[21]); continue; } r -= I_GU;
        transpose_item<2>(F.in[23], DM, DFF, Wgu, scr, r, F.lane, F.in[21]);
    }
    for (int m = gw; m < MPAD + (INWP - INW); m += NGW) {
        if (m < SEQ) rms_row_to_bf16(F.lane, F.in[0] + (size_t)m * DM, F.in[2], H + (size_t)m * DM);
        else if (m < LTOK) rms_row_to_bf16(F.lane, F.in[1] + (size_t)(m - SEQ) * DM, F.in[2], H + (size_t)m * DM);
        else { bf16* row = (m < MPAD) ? H + (size_t)m * DM : Wint + (size_t)(INW + (m - MPAD)) * DM; GAS v4u* o = (GAS v4u*)row + F.lane;
#pragma unroll
            for (int j = 0; j < 8; ++j) o[64 * j] = (v4u){0u, 0u, 0u, 0u}; }
    }
    const int gt = blockIdx.x * 512 + F.tid, NGT = F.G * 512;
    float* rope = (float*)(F.ws + WS_ROPE);
    for (int i = gt; i < LTOK * 16; i += NGT) { const int pos = i >> 4, k = i & 15;
        const double ang = (double)pos * ROPE_INV[k]; const double kq = __builtin_rint(ang * 0.15915494309189535);
        const double red = (ang - kq * 6.28318530717958623) - kq * 2.4492935982947064e-16; const float rf = (float)red;
        rope[2 * i] = cosf(rf); rope[2 * i + 1] = sinf(rf); }
    bf16* w2t = (bf16*)(F.ws + WS_LW2); bf16* a2t = (bf16*)(F.ws + WS_LA2); bf16* g2t = (bf16*)(F.ws + WS_LG2);
    for (int i = gt; i < 2 * 96 * RC; i += NGT) { const int c = i % RC, j = (i / RC) % 96, d = i / (RC * 96);
        w2t[((size_t)d * RC + c) * 96 + j] = (bf16)f2bf(F.in[8][i]); a2t[((size_t)d * RC + c) * 96 + j] = (bf16)f2bf(F.in[10][i]); }
    for (int i = gt; i < 256 * RC; i += NGT) { const int c = i % RC, j = i / RC; g2t[(size_t)c * 256 + j] = (bf16)f2bf(F.in[11][i]); }
}

__device__ __forceinline__ int crow(int r, int hi) { return (r & 3) + 8 * (r >> 2) + 4 * hi; }
__device__ __forceinline__ void attn_phase(Frame& F) {
    const bf16* Q = (const bf16*)(F.ws + WS_Q); const bf16* K = (const bf16*)(F.ws + WS_K); const bf16* Vt = (const bf16*)(F.ws + WS_VT); bf16* OA = (bf16*)(F.ws + WS_OATT);
    const float* sink = F.in[17];
    const int gw = blockIdx.x * 8 + F.wave, NGW = F.G * 8, hh = F.lane >> 5, r = F.lane & 31;
    constexpr float SC = 0.08838834764831845f * 1.4426950408889634f, L2E = 1.4426950408889634f;
    for (int item = gw; item < 4096; item += NGW) {
        const int sub = item & 3, hq = (item >> 2) & 15, qb = item >> 6, q0 = qb * 128 + sub * 32, hk = hq >> 2;
        bf16x8 bq[8];
        { const bf16* qp = Q + (size_t)(q0 + r) * ATTW + hq * 128 + 8 * hh;
#pragma unroll
          for (int s = 0; s < 8; ++s) bq[s] = *(const bf16x8*)(qp + 16 * s); }
        f32x16 O[4];
#pragma unroll
        for (int dt = 0; dt < 4; ++dt)
#pragma unroll
            for (int i = 0; i < 16; ++i) O[dt][i] = 0.f;
        float m = sink[hq] * L2E, l = (hh == 0) ? 1.f : 0.f;
        for (int ti = 0; ti < 10; ++ti) {
            const bool meta = (ti == 9);
            const int key0 = meta ? SEQ : q0 + 32 * (ti - 4);
            if (key0 < 0 || (!meta && key0 >= SEQ)) continue;
            f32x16 st;
#pragma unroll
            for (int i = 0; i < 16; ++i) st[i] = 0.f;
            { const bf16* kp = K + (size_t)(key0 + r) * KVW + hk * 128 + 8 * hh;
#pragma unroll
              for (int s = 0; s < 8; ++s) { const bf16x8 ak = *(const bf16x8*)(kp + 16 * s); st = __builtin_amdgcn_mfma_f32_32x32x16_bf16(ak, bq[s], st, 0, 0, 0); } }
            float tmax = -__builtin_inff();
#pragma unroll
            for (int i = 0; i < 16; ++i) { const int kr = crow(i, hh); bool ok;
                if (meta) ok = kr < NMETA; else { const int dlt = (key0 + kr) - (q0 + r); ok = (dlt >= -128) && (dlt <= 128); }
                const float t = ok ? st[i] * SC : -__builtin_inff(); st[i] = t; tmax = fmaxf(tmax, t); }
            tmax = fmaxf(tmax, __shfl_xor(tmax, 32));
            const float mn = fmaxf(m, tmax), alpha = __builtin_amdgcn_exp2f(m - mn); m = mn;
            float ps = 0.f;
#pragma unroll
            for (int i = 0; i < 16; ++i) { const float p = __builtin_amdgcn_exp2f(st[i] - mn); st[i] = p; ps += p; }
            l = l * alpha + ps;
#pragma unroll
            for (int dt = 0; dt < 4; ++dt)
#pragma unroll
                for (int i = 0; i < 16; ++i) O[dt][i] *= alpha;
            bf16x8 pb[2];
#pragma unroll
            for (int s2 = 0; s2 < 2; ++s2) { v4u w; w.x = pg8::cvt_pk_bf16(st[8 * s2 + 0], st[8 * s2 + 1]); w.y = pg8::cvt_pk_bf16(st[8 * s2 + 2], st[8 * s2 + 3]);
                w.z = pg8::cvt_pk_bf16(st[8 * s2 + 4], st[8 * s2 + 5]); w.w = pg8::cvt_pk_bf16(st[8 * s2 + 6], st[8 * s2 + 7]); pb[s2] = __builtin_bit_cast(bf16x8, w); }
#pragma unroll
            for (int dt = 0; dt < 4; ++dt) { const bf16* vp = Vt + (size_t)(hk * 128 + 32 * dt + r) * MPAD + key0 + 4 * hh;
#pragma unroll
                for (int s2 = 0; s2 < 2; ++s2) { const v2u lo = *(const v2u*)(vp + 16 * s2), hi = *(const v2u*)(vp + 16 * s2 + 8);
                    const v4u w = {lo.x, lo.y, hi.x, hi.y}; O[dt] = __builtin_amdgcn_mfma_f32_32x32x16_bf16(__builtin_bit_cast(bf16x8, w), pb[s2], O[dt], 0, 0, 0); } }
        }
        l += __shfl_xor(l, 32);
        const float inv = 1.0f / l;
        bf16* op = OA + (size_t)(q0 + r) * ATTW + hq * 128 + 4 * hh;
#pragma unroll
        for (int dt = 0; dt < 4; ++dt)
#pragma unroll
            for (int g4 = 0; g4 < 4; ++g4) { v2u w; w.x = pg8::cvt_pk_bf16(O[dt][4 * g4 + 0] * inv, O[dt][4 * g4 + 1] * inv); w.y = pg8::cvt_pk_bf16(O[dt][4 * g4 + 2] * inv, O[dt][4 * g4 + 3] * inv);
                *(v2u*)(op + 32 * dt + 8 * g4) = w; }
    }
}

__device__ __forceinline__ int tok2row(int t) { return t < NMETA ? SEQ + t : t - NMETA; }
__device__ __forceinline__ void load_shift16(const bf16* U, int col, float mp, float mn, int t0, int hh, float (&out)[16]) {
#pragma unroll
    for (int q = 0; q < 4; ++q) { const int tb = t0 + 8 * q + 4 * hh; float raw[6];
#pragma unroll
        for (int i = 0; i < 6; ++i) { const int t = tb - 1 + i; raw[i] = (t >= 0 && t < LTOK) ? bf2f(U[(size_t)tok2row(t) * UPITCH + col]) : 0.f; }
#pragma unroll
        for (int e = 0; e < 4; ++e) out[4 * q + e] = raw[e + 1] + mp * (raw[e] - raw[e + 1]) + mn * (raw[e + 2] - raw[e + 1]); }
}
__device__ __forceinline__ void prep_phase(Frame& F) {
    constexpr int XS = 648;
    LAS bf16* Xs = (LAS bf16*)F.lds;
    const bf16* U = (const bf16*)(F.ws + WS_U);
    const float* mu_p = F.in[5]; const float* mu_n = F.in[6];
    const bf16* w2t = (const bf16*)(F.ws + WS_LW2); const bf16* a2t = (const bf16*)(F.ws + WS_LA2); const bf16* g2t = (const bf16*)(F.ws + WS_LG2);
    float* W0 = (float*)(F.ws + WS_W0); float* W1 = (float*)(F.ws + WS_W1);
    bf16* KD0 = (bf16*)(F.ws + WS_KD0); bf16* KD1 = (bf16*)(F.ws + WS_KD1); bf16* B0 = (bf16*)(F.ws + WS_B0); bf16* B1 = (bf16*)(F.ws + WS_B1);
    bf16* KK = (bf16*)(F.ws + WS_KK); bf16* RR = (bf16*)(F.ws + WS_RR); bf16* VV = (bf16*)(F.ws + WS_VV); bf16* GG = (bf16*)(F.ws + WS_GG);
    float* BON = (float*)(F.ws + WS_BONUS);
    const int hh = F.lane >> 5, r = F.lane & 31;
    for (int unit = blockIdx.x; unit < 257 * 4; unit += F.G) {
        const int tt = unit >> 2, t0 = tt * 32, hd = (unit & 3) * 8 + F.wave;
        __syncthreads();
        for (int ci = F.tid; ci < 2560; ci += 512) {
            const int tl = ci / 80, ch = ci % 80, t = t0 + tl, col = 3 * RC + 8 * ch;
            v4u uc = {0u, 0u, 0u, 0u}, up = uc, un = uc;
            if (t < LTOK) uc = *(const v4u*)(U + (size_t)tok2row(t) * UPITCH + col);
            if (t >= 1 && t - 1 < LTOK) up = *(const v4u*)(U + (size_t)tok2row(t - 1) * UPITCH + col);
            if (t + 1 < LTOK) un = *(const v4u*)(U + (size_t)tok2row(t + 1) * UPITCH + col);
            const f32x4 mp0 = *(const f32x4*)(mu_p + col), mp1 = *(const f32x4*)(mu_p + col + 4), mn0 = *(const f32x4*)(mu_n + col), mn1 = *(const f32x4*)(mu_n + col + 4);
            const unsigned ucw[4] = {uc.x, uc.y, uc.z, uc.w}, upw[4] = {up.x, up.y, up.z, up.w}, unw[4] = {un.x, un.y, un.z, un.w};
            const float mpw[8] = {mp0[0], mp0[1], mp0[2], mp0[3], mp1[0], mp1[1], mp1[2], mp1[3]}, mnw[8] = {mn0[0], mn0[1], mn0[2], mn0[3], mn1[0], mn1[1], mn1[2], mn1[3]};
            float x[8];
#pragma unroll
            for (int e = 0; e < 8; ++e) { const float c0 = (e & 1) ? bfhi(ucw[e >> 1]) : bflo(ucw[e >> 1]), p0 = (e & 1) ? bfhi(upw[e >> 1]) : bflo(upw[e >> 1]), n0 = (e & 1) ? bfhi(unw[e >> 1]) : bflo(unw[e >> 1]);
                float v = c0 + mpw[e] * (p0 - c0) + mnw[e] * (n0 - c0);
                if (ch < 24) { const float ex = __expf(2.0f * v); v = 1.0f - 2.0f / (ex + 1.0f); }
                else if (ch >= 48) v = sigmoidf_(v);
                x[e] = v; }
            v4u o; o.x = pk2(x[0], x[1]); o.y = pk2(x[2], x[3]); o.z = pk2(x[4], x[5]); o.w = pk2(x[6], x[7]);
            *(LAS v4u*)(Xs + tl * XS + 8 * ch) = o;
        }
        __syncthreads();
        float kp[2][16], ss[16], bon[16];
#pragma unroll
        for (int i = 0; i < 16; ++i) { ss[i] = 0.f; bon[i] = 0.f; }
#pragma unroll
        for (int ct = 0; ct < 2; ++ct) { const int c = hd * 64 + 32 * ct + r; load_shift16(U, RC + c, mu_p[RC + c], mu_n[RC + c], t0, hh, kp[ct]); const float kkw = F.in[12][c];
#pragma unroll
            for (int i = 0; i < 16; ++i) { const float kr = kp[ct][i] * kkw; ss[i] += kr * kr; } }
#pragma unroll
        for (int i = 0; i < 16; ++i) {
#pragma unroll
            for (int o = 1; o < 32; o <<= 1) ss[i] += __shfl_xor(ss[i], o);
            ss[i] = 1.0f / fmaxf(sqrtf(ss[i]), 1e-12f); }
#pragma unroll
        for (int ct = 0; ct < 2; ++ct) {
            const int c = hd * 64 + 32 * ct + r;
            const float kkw = F.in[12][c], kaw = F.in[13][c], rkw = F.in[14][c];
            float kk[16], rp[16];
#pragma unroll
            for (int i = 0; i < 16; ++i) kk[i] = kp[ct][i] * kkw * ss[i];
            load_shift16(U, c, mu_p[c], mu_n[c], t0, hh, rp);
            { float vp[16]; load_shift16(U, 2 * RC + c, mu_p[2 * RC + c], mu_n[2 * RC + c], t0, hh, vp);
#pragma unroll
              for (int i = 0; i < 16; ++i) { const int t = t0 + crow(i, hh); if (t < LTOK) { const size_t o = (size_t)t * RC + c; KK[o] = (bf16)f2bf(kk[i]); RR[o] = (bf16)f2bf(rp[i]); VV[o] = (bf16)f2bf(vp[i]); } } }
#pragma unroll
            for (int d = 0; d < 2; ++d) {
                f32x16 acc;
#pragma unroll
                for (int i = 0; i < 16; ++i) acc[i] = 0.f;
                const bf16* bp = a2t + ((size_t)d * RC + c) * 96 + 8 * hh; const LAS bf16* ap = Xs + r * XS + 192 + 96 * d + 8 * hh;
#pragma unroll
                for (int s = 0; s < 6; ++s) acc = __builtin_amdgcn_mfma_f32_32x32x16_bf16(*(const LAS bf16x8*)(ap + 16 * s), *(const bf16x8*)(bp + 16 * s), acc, 0, 0, 0);
                const float a0 = F.in[9][d * RC + c]; bf16* KD = d ? KD1 : KD0; bf16* BB = d ? B1 : B0;
#pragma unroll
                for (int i = 0; i < 16; ++i) { const float a = sigmoidf_(a0 + acc[i]); const float kd = kp[ct][i] * (1.0f + (a - 1.0f) * kaw); bon[i] += rp[i] * kd * rkw;
                    const int t = t0 + crow(i, hh); if (t < LTOK) { const size_t o = (size_t)t * RC + c; KD[o] = (bf16)f2bf(kd); BB[o] = (bf16)f2bf(kk[i] * a); } }
            }
#pragma unroll
            for (int d = 0; d < 2; ++d) {
                f32x16 acc;
#pragma unroll
                for (int i = 0; i < 16; ++i) acc[i] = 0.f;
                const bf16* bp = w2t + ((size_t)d * RC + c) * 96 + 8 * hh; const LAS bf16* ap = Xs + r * XS + 96 * d + 8 * hh;
#pragma unroll
                for (int s = 0; s < 6; ++s) acc = __builtin_amdgcn_mfma_f32_32x32x16_bf16(*(const LAS bf16x8*)(ap + 16 * s), *(const bf16x8*)(bp + 16 * s), acc, 0, 0, 0);
                const float w0 = F.in[7][d * RC + c]; float* WW = d ? W1 : W0;
#pragma unroll
                for (int i = 0; i < 16; ++i) { const float z = -(w0 + acc[i]); const float sp = fmaxf(z, 0.f) + log1pf(expf(-fabsf(z))); const float wl = -sp - 0.5f; const float dec = expf(-expf(wl));
                    const int t = t0 + crow(i, hh); if (t < LTOK) WW[(size_t)t * RC + c] = dec; }
            }
            {
                f32x16 acc;
#pragma unroll
                for (int i = 0; i < 16; ++i) acc[i] = 0.f;
                const bf16* bp = g2t + (size_t)c * 256 + 8 * hh; const LAS bf16* ap = Xs + r * XS + 384 + 8 * hh;
#pragma unroll
                for (int s = 0; s < 16; ++s) acc = __builtin_amdgcn_mfma_f32_32x32x16_bf16(*(const LAS bf16x8*)(ap + 16 * s), *(const bf16x8*)(bp + 16 * s), acc, 0, 0, 0);
#pragma unroll
                for (int i = 0; i < 16; ++i) { const int t = t0 + crow(i, hh); if (t < LTOK) GG[(size_t)t * RC + c] = (bf16)f2bf(acc[i]); }
            }
        }
#pragma unroll
        for (int i = 0; i < 16; ++i) {
#pragma unroll
            for (int o = 1; o < 32; o <<= 1) bon[i] += __shfl_xor(bon[i], o);
            const int t = t0 + crow(i, hh); if (r == 0 && t < LTOK) BON[(size_t)t * RH + hd] = bon[i]; }
    }
}

__device__ __forceinline__ float dpp_xor_add(float x, const int ctrl_sel) {
    int y;
    if (ctrl_sel == 0) y = __builtin_amdgcn_update_dpp(0, __float_as_int(x), 0xB1, 0xf, 0xf, true);
    else if (ctrl_sel == 1) y = __builtin_amdgcn_update_dpp(0, __float_as_int(x), 0x4E, 0xf, 0xf, true);
    else if (ctrl_sel == 2) y = __builtin_amdgcn_update_dpp(0, __float_as_int(x), 0x141, 0xf, 0xf, true);
    else y = __builtin_amdgcn_update_dpp(0, __float_as_int(x), 0x140, 0xf, 0xf, true);
    return x + __int_as_float(y);
}
__device__ __forceinline__ float row16_sum(float x) { x = dpp_xor_add(x, 0); x = dpp_xor_add(x, 1); x = dpp_xor_add(x, 2); x = dpp_xor_add(x, 3); return x; }
constexpr int SC_CH = 32, SC_STEP = 336, SC_BUF = SC_CH * SC_STEP;
__device__ __forceinline__ void scan_phase(Frame& F) {
    LAS float* BUF = (LAS float*)F.lds;
    LAS float* YB = (LAS float*)(F.lds + 2 * SC_BUF * 4);
    const float* W0 = (const float*)(F.ws + WS_W0); const float* W1 = (const float*)(F.ws + WS_W1);
    const bf16* KD0 = (const bf16*)(F.ws + WS_KD0); const bf16* KD1 = (const bf16*)(F.ws + WS_KD1); const bf16* B0 = (const bf16*)(F.ws + WS_B0); const bf16* B1 = (const bf16*)(F.ws + WS_B1);
    const bf16* KK = (const bf16*)(F.ws + WS_KK); const bf16* RR = (const bf16*)(F.ws + WS_RR); const bf16* VV = (const bf16*)(F.ws + WS_VV);
    float* Y = (float*)(F.ws + WS_Y);
    for (int item = blockIdx.x; item < 256; item += F.G) {
        const int pair = (item & 7) * 8 + (item >> 5), q4 = (item >> 3) & 3, hd = pair >> 1, dir = pair & 1;
        const int nsteps = dir ? SEQ : LTOK, nchunks = (nsteps + SC_CH - 1) / SC_CH;
        const float* Wd = dir ? W1 : W0; const bf16* KDd = dir ? KD1 : KD0; const bf16* Bd = dir ? B1 : B0;
        float* Yd = Y + (size_t)dir * LTOK * RC;
        const int lt = F.tid - 256;
        __syncthreads();
#define SCAN_LOAD(c) do { LAS float* dst_ = BUF + ((c) & 1) * SC_BUF; \
            for (int pi = lt; pi < SC_CH * 84; pi += 256) { const int sl = pi / 84, pc = pi % 84, s = (c) * SC_CH + sl; if (s >= nsteps) continue; \
                const int t = dir ? (LTOK - 1 - s) : s; const int arr = pc >> 4, q = pc & 15; f32x4 v; \
                if (arr == 0) v = *(const f32x4*)(Wd + (size_t)t * RC + hd * 64 + 4 * q); \
                else { const bf16* src = arr == 1 ? KDd : arr == 2 ? Bd : arr == 3 ? KK : arr == 4 ? RR : VV; \
                    const v2u w = *(const v2u*)(src + (size_t)t * RC + hd * 64 + (arr == 5 ? 16 * q4 + 4 * q : 4 * q)); v = (f32x4){bflo(w.x), bfhi(w.x), bflo(w.y), bfhi(w.y)}; } \
                *(LAS f32x4*)(dst_ + sl * SC_STEP + 64 * arr + 4 * q) = v; } } while (0)
#define SCAN_FLUSH(c) do { const LAS float* yb_ = YB + ((c) & 1) * (SC_CH * 16); \
            for (int pi = lt; pi < SC_CH * 16; pi += 256) { const int sl = pi >> 4, i = pi & 15, s = (c) * SC_CH + sl; if (s >= nsteps) continue; \
                const int t = dir ? (LTOK - 1 - s) : s; Yd[(size_t)t * RC + hd * 64 + 16 * q4 + i] = yb_[pi]; } } while (0)
        if (F.wave >= 4) SCAN_LOAD(0);
        __syncthreads();
        float S0 = 0.f, S1 = 0.f, S2 = 0.f, S3 = 0.f;
        const int g = F.lane >> 4, jg = F.lane & 15, rl = 4 * F.wave + g;
        for (int c = 0; c < nchunks; ++c) {
            if (F.wave >= 4) {
                if (c + 1 < nchunks) SCAN_LOAD(c + 1);
                if (c >= 1) SCAN_FLUSH(c - 1);
            } else {
                const LAS float* base = BUF + (c & 1) * SC_BUF; LAS float* yb = YB + (c & 1) * (SC_CH * 16);
                const int nst = (nsteps - c * SC_CH) < SC_CH ? (nsteps - c * SC_CH) : SC_CH;
#pragma unroll 4
                for (int sl = 0; sl < nst; ++sl) {
                    const LAS float* sp = base + sl * SC_STEP;
                    const f32x4 w4 = *(const LAS f32x4*)(sp + 4 * jg), kd4 = *(const LAS f32x4*)(sp + 64 + 4 * jg), b4 = *(const LAS f32x4*)(sp + 128 + 4 * jg),
                                kk4 = *(const LAS f32x4*)(sp + 192 + 4 * jg), r4 = *(const LAS f32x4*)(sp + 256 + 4 * jg);
                    const float v1 = sp[320 + rl];
                    float p = (S0 * kk4[0] + S1 * kk4[1]) + (S2 * kk4[2] + S3 * kk4[3]);
                    p = row16_sum(p);
                    S0 = S0 * w4[0] + (v1 * kd4[0] - p * b4[0]); S1 = S1 * w4[1] + (v1 * kd4[1] - p * b4[1]);
                    S2 = S2 * w4[2] + (v1 * kd4[2] - p * b4[2]); S3 = S3 * w4[3] + (v1 * kd4[3] - p * b4[3]);
                    float y = (S0 * r4[0] + S1 * r4[1]) + (S2 * r4[2] + S3 * r4[3]);
                    y = row16_sum(y);
                    if (jg == 0) yb[sl * 16 + rl] = y;
                }
            }
            __syncthreads();
        }
        if (F.wave >= 4) SCAN_FLUSH(nchunks - 1);
#undef SCAN_LOAD
#undef SCAN_FLUSH
    }
}

__device__ __forceinline__ void combine_phase(Frame& F) {
    const float* Y0 = (const float*)(F.ws + WS_Y); const float* Y1 = Y0 + (size_t)LTOK * RC;
    const bf16* VV = (const bf16*)(F.ws + WS_VV); const bf16* GG = (const bf16*)(F.ws + WS_GG); const float* BON = (const float*)(F.ws + WS_BONUS);
    bf16* OR = (bf16*)(F.ws + WS_ORWKV);
    const float* lnw = F.in[15]; const float* lnb = F.in[16];
    const int gw = blockIdx.x * 8 + F.wave, NGW = F.G * 8;
    for (int row = gw; row < SEQ; row += NGW) { const int t = row + NMETA;
        for (int hd = 0; hd < RH; ++hd) { const int c = hd * 64 + F.lane; const size_t o = (size_t)t * RC + c;
            const float y = Y0[o] + Y1[o]; const float mean = wave_sum(y) * (1.0f / 64.0f); const float dlt = y - mean; const float var = wave_sum(dlt * dlt) * (1.0f / 64.0f);
            const float yn = dlt * (1.0f / sqrtf(var + GN_EPS)) * lnw[c] + lnb[c];
            const float outv = (yn + BON[(size_t)t * RH + hd] * bf2f(VV[o])) * bf2f(GG[o]);
            OR[(size_t)row * RC + c] = (bf16)f2bf(outv); } }
}
__device__ __forceinline__ void final_phase(Frame& F) {
    const float* SS3 = (const float*)(F.ctl + CW_SS3); const float* w = F.in[25];
    const int gw = blockIdx.x * 8 + F.wave, NGW = F.G * 8;
    for (int row = gw; row < SEQ; row += NGW) { const float rstd = 1.0f / sqrtf(SS3[row] * (1.0f / DM) + RMS_EPS);
        GAS f32x4* p = (GAS f32x4*)(F.out + (size_t)row * DM) + F.lane; const GAS f32x4* wp = (const GAS f32x4*)w + F.lane;
#pragma unroll
        for (int j = 0; j < 16; ++j) { const f32x4 v = p[64 * j], ww = wp[64 * j]; p[64 * j] = v * rstd * ww; } }
}
template <int WHICH> __device__ __forceinline__ void convert_late(Frame& F) {
    LAS float* scr = (LAS float*)(F.lds + 49152 + F.wave * 8448);
    const int gw = blockIdx.x * 8 + F.wave, NGW = F.G * 8;
    if (WHICH == 0) {
        constexpr int I_P = (ATTW / 64) * (DM / 32), I_O = (DM / 64) * (DM / 32);
        for (int it = gw; it < 2 * I_P + I_O; it += NGW) { int r = it;
            if (r < I_P) { transpose_item<0>(F.in[18], ATTW, DM, (bf16*)(F.ws + WS_WPA), scr, r, F.lane, nullptr); continue; } r -= I_P;
            if (r < I_P) { transpose_item<0>(F.in[19], RC, DM, (bf16*)(F.ws + WS_WPR), scr, r, F.lane, nullptr); continue; } r -= I_P;
            transpose_item<0>(F.in[20], DM, DM, (bf16*)(F.ws + WS_WOUT), scr, r, F.lane, nullptr); }
    } else {
        constexpr int I_D = (DFF / 64) * (DM / 32);
        for (int it = gw; it < I_D; it += NGW) transpose_item<0>(F.in[24], DFF, DM, (bf16*)(F.ws + WS_WD), scr, it, F.lane, nullptr);
    }
}

constexpr int N_PHASES = 10;
struct Args { const float* in[26]; float* out; unsigned char* ws; int ph_lo, ph_hi; };
__global__ void __launch_bounds__(512, 2) fwd_kernel(Args args) {
    extern __shared__ __attribute__((aligned(16))) unsigned char lds[];
    Frame F;
    F.lds = (LAS unsigned char*)lds;
    F.MISC = (volatile LAS unsigned*)(F.lds + MISC_OFF);
    F.tid = threadIdx.x; F.lane = F.tid & 63; F.wave = __builtin_amdgcn_readfirstlane(F.tid >> 6); F.G = gridDim.x;
    F.ws = args.ws; F.ctl = (gu32*)(args.ws + WS_CTL); F.out = args.out;
#pragma unroll
    for (int i = 0; i < 26; ++i) F.in[i] = args.in[i];
    for (int u = F.tid; u < (LDS_BYTES - LDSCTL_OFF) / 4; u += 512) ((LAS unsigned*)(F.lds + LDSCTL_OFF))[u] = 0u;
    __syncthreads();
    XcdBarrier bar; bar.bar = (unsigned*)(F.ctl + CW_BAR); bar.x = 0; bar.st = nullptr;
    if (!MK_SPLIT) bar = xcd_barrier_post((unsigned*)(F.ctl + CW_BAR), F.MISC + 8);
    const int lo = args.ph_lo, hi = args.ph_hi;
#define IN(k) (lo <= (k) && (k) < hi)
#define SEAM(k) do { if (IN(k) && IN((k) + 1)) xcd_barrier(bar); } while (0)
    bf16* Rm = (bf16*)(F.ws + WS_H);
    float* SS2 = (float*)(F.ctl + CW_SS2); float* SS3 = (float*)(F.ctl + CW_SS3);

    if (IN(0)) { p0_prologue(F); } SEAM(0);
    if (IN(1)) {
        pg8::Gemm g{Rm, Rm, MPAD + INWP, MPAD + INWP, DM}; pg8::InOrder S; S.init(F.G, (int)blockIdx.x);
        pg8::EpiIn E{(bf16*)(F.ws + WS_G), (bf16*)(F.ws + WS_Q), (bf16*)(F.ws + WS_K), (bf16*)(F.ws + WS_VT), (bf16*)(F.ws + WS_U), F.in[4], (const float*)(F.ws + WS_ROPE)};
        pg8::gemm_phase<pg8::EpiIn, pg8::InOrder, true, true>(F.lds, g, S, E);
    } SEAM(1);
    if (IN(2)) { attn_phase(F); prep_phase(F); convert_late<0>(F); } SEAM(2);
    if (IN(3)) { scan_phase(F); } SEAM(3);
    if (IN(4)) { combine_phase(F); convert_late<1>(F); } SEAM(4);
    if (IN(5)) {
        { pg8::Gemm g{(const bf16*)(F.ws + WS_OATT), (const bf16*)(F.ws + WS_WPA), SEQ, DM, ATTW}; pg8::StaticOrder S; S.init(SEQ, DM, F.G, (int)blockIdx.x);
          pg8::EpiProjA E{(float*)(F.ws + WS_P1), (const bf16*)(F.ws + WS_G)};
          pg8::gemm_phase<pg8::EpiProjA, pg8::StaticOrder, true, true>(F.lds, g, S, E); }
        __syncthreads();
        { pg8::Gemm g{(const bf16*)(F.ws + WS_ORWKV), (const bf16*)(F.ws + WS_WPR), SEQ, DM, RC}; pg8::StaticOrder S; S.init(SEQ, DM, F.G, (int)blockIdx.x);
          pg8::EpiProjB E{(const float*)(F.ws + WS_P1), (const bf16*)(F.ws + WS_G), (bf16*)(F.ws + WS_MX)};
          pg8::gemm_phase<pg8::EpiProjB, pg8::StaticOrder, true, true>(F.lds, g, S, E); }
    } SEAM(5);
    if (IN(6)) {
        pg8::Gemm g{(const bf16*)(F.ws + WS_MX), (const bf16*)(F.ws + WS_WOUT), SEQ, DM, DM}; pg8::StaticOrder S; S.init(SEQ, DM, F.G, (int)blockIdx.x);
        pg8::EpiResid<true> E{F.in[0], (float*)(F.ws + WS_H2), (bf16*)(F.ws + WS_A2), SS2};
        pg8::gemm_phase<pg8::EpiResid<true>, pg8::StaticOrder, true, true>(F.lds, g, S, E);
    } SEAM(6);
    if (IN(7)) {
        pg8::Gemm g{(const bf16*)(F.ws + WS_A2), (const bf16*)(F.ws + WS_WGU), SEQ, 2 * DFF, DM}; pg8::StaticOrder S; S.init(SEQ, 2 * DFF, F.G, (int)blockIdx.x);
        pg8::EpiSwiGLU E{(bf16*)(F.ws + WS_HID), SS2};
        pg8::gemm_phase<pg8::EpiSwiGLU, pg8::StaticOrder, true, true>(F.lds, g, S, E);
    } SEAM(7);
    if (IN(8)) {
        pg8::Gemm g{(const bf16*)(F.ws + WS_HID), (const bf16*)(F.ws + WS_WD), SEQ, DM, DFF}; pg8::StaticOrder S; S.init(SEQ, DM, F.G, (int)blockIdx.x);
        pg8::EpiResid<false> E{(const float*)(F.ws + WS_H2), F.out, nullptr, SS3};
        pg8::gemm_phase<pg8::EpiResid<false>, pg8::StaticOrder, true, true>(F.lds, g, S, E);
    } SEAM(8);
    if (IN(9)) { final_phase(F); }
#undef IN
#undef SEAM
}

extern "C" void kernel_launch(void* const* d_in, const int* in_sizes, int n_in, void* d_out, int out_size, void* d_ws, size_t ws_size, hipStream_t stream) {
    static int grid = 0;
    if (grid == 0) {
        if (n_in != 26 || out_size != SEQ * DM || ws_size < WS_END) { fprintf(stderr, "kernel_launch: unexpected shapes (n_in %d, out %d, ws %zu, need %zu); nothing launched\n", n_in, out_size, ws_size, (size_t)WS_END); grid = -1; return; }
        int dev = 0, cus = 0, per_cu = 0;
        if (hipGetDevice(&dev) != hipSuccess || hipDeviceGetAttribute(&cus, hipDeviceAttributeMultiprocessorCount, dev) != hipSuccess) { grid = -1; return; }
        if (hipFuncSetAttribute((const void*)fwd_kernel, hipFuncAttributeMaxDynamicSharedMemorySize, LDS_BYTES) != hipSuccess) { fprintf(stderr, "kernel_launch: hipFuncSetAttribute failed\n"); grid = -1; return; }
        if (hipOccupancyMaxActiveBlocksPerMultiprocessor(&per_cu, (const void*)fwd_kernel, 512, LDS_BYTES) != hipSuccess || per_cu < 1) fprintf(stderr, "kernel_launch: occupancy query says %d per CU\n", per_cu);
        (void)hipGetLastError();
        grid = cus;
    }
    if (grid < 0) return;
    if (hipMemsetAsync((char*)d_ws + WS_CTL, 0, CTL_ZERO_BYTES, stream) != hipSuccess) return;
    Args a{};
    for (int i = 0; i < 26; ++i) a.in[i] = (const float*)d_in[i];
    a.out = (float*)d_out; a.ws = (unsigned char*)d_ws;
#if MK_SPLIT
    for (int p = 0; p < N_PHASES; ++p) { a.ph_lo = p; a.ph_hi = p + 1; hipLaunchKernelGGL(fwd_kernel, dim3(grid), dim3(512), LDS_BYTES, stream, a); }
#else
    a.ph_lo = 0; a.ph_hi = N_PHASES;
    hipLaunchKernelGGL(fwd_kernel, dim3(grid), dim3(512), LDS_BYTES, stream, a);
#endif
}
```

```cpp
#include <hip/hip_runtime.h>
#include <cstdio>
#include <cstdint>

#ifndef MK_SPLIT
#define MK_SPLIT 0
#endif

constexpr int NMETA = 16, SEQ = 8192, LTOK = 8208, DM = 4096, MPAD = 8448;
constexpr int INW = 18048, INWP = 18176;
constexpr int ATTW = 2048, KVW = 512, UW = 6784, UPITCH = 6912;
constexpr int RC = 2048, RH = 32, RN = 64;
constexpr int DFF = 11008;
constexpr float RMS_EPS = 1e-6f, GN_EPS = 64e-5f;
constexpr int HT = MPAD / 256;
constexpr int CT_Q = 32, CT_K = 40, CT_V = 42, CT_U = 44, CT_N = 71;

namespace pg8 {
#define PG8_LAS __attribute__((address_space(3)))
typedef unsigned short bf16_t;
typedef short bf16x8 __attribute__((ext_vector_type(8)));
typedef float f32x4 __attribute__((ext_vector_type(4)));
typedef unsigned u32x4 __attribute__((ext_vector_type(4)));
constexpr int BM = 256, BK = 64, HALF = 128, HTB = HALF * BK * 2  , STAGE_BYTES = 8 * HTB, NXCD = 8, WGM = 8;

__host__ __device__ __forceinline__ int lds_byte(int r, int c) { const int st = (r >> 4) * 2 + (c >> 5), rr = r & 15, cc = c & 31, ob = rr * 64 + cc * 2; return st * 1024 + (ob ^ (((ob >> 9) & 1) << 5)); }
__host__ __device__ __forceinline__ void stage_rc(int b, int& R, int& C) { const int st = b / 1024, sb = b % 1024, swz = sb ^ (((sb >> 9) & 1) << 5); R = (st >> 1) * 16 + swz / 64; C = (st & 1) * 32 + (swz % 64) / 2; }
__host__ __device__ __forceinline__ int perm32(int rho) { const int n = rho >> 4, i = rho & 15; return 8 * (i >> 2) + 4 * n + (i & 3); }

struct Unit { int pm, pn; };
struct Gemm { const bf16_t* A; const bf16_t* Bt; int M, N, K; };

struct StaticOrder {
    int nM, nN, nwg, G, c;
    __host__ __device__ void init(int M, int N, int G_, int c_) { nM = M / BM; nN = N / BM; nwg = nM * nN; G = G_; c = c_; }
    __host__ __device__ bool next(int i, Unit& u) const {
        const long L = (long)i * G + c; if (L >= nwg) return false;
        int wgid = (int)L; { const int q = nwg / NXCD, r = nwg % NXCD, xcd = wgid % NXCD, off = wgid / NXCD; wgid = (xcd < r ? xcd * (q + 1) : r * (q + 1) + (xcd - r) * q) + off; }
        const int nig = WGM * nN, gid = wgid / nig, fm = gid * WGM, gsz = (nM - fm) < WGM ? (nM - fm) : WGM;
        u.pm = fm + ((wgid % nig) % gsz); u.pn = (wgid % nig) / gsz; return true;
    }
    __device__ __forceinline__ void a_ready(const Unit&) const {}
    __device__ __forceinline__ void done(const Unit&) const {}
};

__device__ __forceinline__ unsigned cvt_pk_bf16(float lo, float hi) { unsigned r; asm volatile("v_cvt_pk_bf16_f32 %0, %1, %2" : "=v"(r) : "v"(lo), "v"(hi)); return r; }

typedef unsigned u32x2 __attribute__((ext_vector_type(2)));
__device__ __forceinline__ float bflo(unsigned w) { return __uint_as_float(w << 16); }
__device__ __forceinline__ float bfhi(unsigned w) { return __uint_as_float(w & 0xffff0000u); }
__device__ __forceinline__ float sigmoidf_(float x) { return 1.0f / (1.0f + __expf(-x)); }

struct InOrder {
    StaticOrder base; int G, c;
    __device__ void init(int G_, int c_) { base.init(SEQ, INWP, G_, c_); G = G_; c = c_; }
    __device__ bool next(int i, Unit& u) const {
        const long L = (long)i * G + c;
        if (L < base.nwg) {
            base.next(i, u);
            if (u.pn >= CT_V && u.pn < CT_U) { const int e = (u.pn - CT_V) * 32 + u.pm; u.pm = HT + CT_V + e / HT; u.pn = e % HT; }
            else u.pn += HT;
            return true;
        }
        const int x = (int)(L - base.nwg);
        if (x >= 31) return false;
        if (x < 2) { const int e = 64 + x; u.pm = HT + CT_V + e / HT; u.pn = e % HT; }
        else { const int y = x - 2; u.pm = 32; u.pn = HT + (y < 2 ? CT_K + y : CT_U + (y - 2)); }
        return true;
    }
    __device__ __forceinline__ void a_ready(const Unit&) const {}
    __device__ __forceinline__ void done(const Unit&) const {}
};

struct EpiIn {
    static constexpr bool PERM = true, AFTER_DRAIN = false;
    bf16_t *G, *Q, *K, *Vt, *U; const float* bgate; const float* rope;
    __device__ __forceinline__ static void st8(bf16_t* p, const f32x4& v0, const f32x4& v1) {
        u32x4 w; w.x = cvt_pk_bf16(v0[0], v0[1]); w.y = cvt_pk_bf16(v0[2], v0[3]); w.z = cvt_pk_bf16(v1[0], v1[1]); w.w = cvt_pk_bf16(v1[2], v1[3]); *(u32x4*)p = w; }
    __device__ __forceinline__ void plain(const f32x4 (&acc)[2][2][4][2], bf16_t* base, int ldc, int row0, int col0) const {
#pragma unroll
        for (int ai = 0; ai < 2; ++ai)
#pragma unroll
            for (int m = 0; m < 4; ++m) { bf16_t* rowp = base + (size_t)(row0 + ai * HALF + m * 16) * ldc + col0;
#pragma unroll
                for (int bj = 0; bj < 2; ++bj) st8(rowp + bj * HALF, acc[ai][bj][m][0], acc[ai][bj][m][1]); }
    }
    __device__ __forceinline__ void roped(const f32x4 (&acc)[2][2][4][2], bf16_t* base, int ldc, int row0, int col0, int wc, int fq) const {
        if (wc != 0) { plain(acc, base, ldc, row0, col0); return; }
        const float sgn = (fq < 2) ? -1.0f : 1.0f;
#pragma unroll
        for (int ai = 0; ai < 2; ++ai)
#pragma unroll
            for (int m = 0; m < 4; ++m) { const int row = row0 + ai * HALF + m * 16; const int pos = row < SEQ ? row + NMETA : row - SEQ;
                const f32x4* cs = (const f32x4*)(rope + (size_t)pos * 32 + 16 * (fq & 1));
                const f32x4 c0 = cs[0], c1 = cs[1], c2 = cs[2], c3 = cs[3];
                const float cw[8] = {c0[0], c0[2], c1[0], c1[2], c2[0], c2[2], c3[0], c3[2]}, sw[8] = {c0[1], c0[3], c1[1], c1[3], c2[1], c2[3], c3[1], c3[3]};
                bf16_t* rowp = base + (size_t)row * ldc + col0;
#pragma unroll
                for (int bj = 0; bj < 2; ++bj) { f32x4 v0 = acc[ai][bj][m][0], v1 = acc[ai][bj][m][1], o0, o1;
#pragma unroll
                    for (int e = 0; e < 4; ++e) { const float p0 = __shfl_xor(v0[e], 32), p1 = __shfl_xor(v1[e], 32);
                        o0[e] = v0[e] * cw[e] + sgn * p0 * sw[e]; o1[e] = v1[e] * cw[4 + e] + sgn * p1 * sw[4 + e]; }
                    st8(rowp + bj * HALF, o0, o1); } }
    }
    __device__ __forceinline__ void operator()(const f32x4 (&acc)[2][2][4][2], const Unit& u, int wr, int wc, int fr, int fq) const {
        if (u.pm >= HT) {
            plain(acc, Vt, MPAD, (u.pm - HT - CT_V) * BM + wr * 64 + fr, u.pn * BM + wc * 32 + 8 * fq); return; }
        const int ct = u.pn - HT, row0 = u.pm * BM + wr * 64 + fr, cl = wc * 32 + 8 * fq;
        if (ct < CT_Q) {
            const int col0 = ct * BM + cl;
#pragma unroll
            for (int bj = 0; bj < 2; ++bj) { const f32x4 b0 = *(const f32x4*)(bgate + col0 + bj * HALF), b1 = *(const f32x4*)(bgate + col0 + bj * HALF + 4);
#pragma unroll
                for (int ai = 0; ai < 2; ++ai)
#pragma unroll
                    for (int m = 0; m < 4; ++m) { f32x4 v0 = acc[ai][bj][m][0] + b0, v1 = acc[ai][bj][m][1] + b1;
#pragma unroll
                        for (int e = 0; e < 4; ++e) { v0[e] = sigmoidf_(v0[e]); v1[e] = sigmoidf_(v1[e]); }
                        st8(G + (size_t)(row0 + ai * HALF + m * 16) * (2 * DM) + col0 + bj * HALF, v0, v1); } }
        } else if (ct < CT_K) { roped(acc, Q, ATTW, row0, (ct - CT_Q) * BM + cl, wc, fq);
        } else if (ct < CT_V) { roped(acc, K, KVW, row0, (ct - CT_K) * BM + cl, wc, fq);
        } else { plain(acc, U, UPITCH, row0, (ct - CT_U) * BM + cl); }
    }
};

struct EpiProjA {
    static constexpr bool PERM = true, AFTER_DRAIN = false;
    float* P1; const bf16_t* G;
    __device__ __forceinline__ void operator()(const f32x4 (&acc)[2][2][4][2], const Unit& u, int wr, int wc, int fr, int fq) const {
        const int row0 = u.pm * BM + wr * 64 + fr, col0 = u.pn * BM + wc * 32 + 8 * fq;
#pragma unroll
        for (int ai = 0; ai < 2; ++ai)
#pragma unroll
            for (int m = 0; m < 4; ++m) { const size_t r = (size_t)(row0 + ai * HALF + m * 16);
#pragma unroll
                for (int bj = 0; bj < 2; ++bj) { const int c = col0 + bj * HALF; const u32x4 g = *(const u32x4*)(G + r * (2 * DM) + c);
                    f32x4 o0 = acc[ai][bj][m][0], o1 = acc[ai][bj][m][1];
                    o0[0] *= bflo(g.x); o0[1] *= bfhi(g.x); o0[2] *= bflo(g.y); o0[3] *= bfhi(g.y); o1[0] *= bflo(g.z); o1[1] *= bfhi(g.z); o1[2] *= bflo(g.w); o1[3] *= bfhi(g.w);
                    float* p = P1 + r * DM + c; *(f32x4*)p = o0; *(f32x4*)(p + 4) = o1; } }
    }
};
struct EpiProjB {
    static constexpr bool PERM = true, AFTER_DRAIN = false;
    const float* P1; const bf16_t* G; bf16_t* MX;
    __device__ __forceinline__ void operator()(const f32x4 (&acc)[2][2][4][2], const Unit& u, int wr, int wc, int fr, int fq) const {
        const int row0 = u.pm * BM + wr * 64 + fr, col0 = u.pn * BM + wc * 32 + 8 * fq;
#pragma unroll
        for (int ai = 0; ai < 2; ++ai)
#pragma unroll
            for (int m = 0; m < 4; ++m) { const size_t r = (size_t)(row0 + ai * HALF + m * 16);
#pragma unroll
                for (int bj = 0; bj < 2; ++bj) { const int c = col0 + bj * HALF; const u32x4 g = *(const u32x4*)(G + r * (2 * DM) + DM + c);
                    const float* p = P1 + r * DM + c; f32x4 o0 = *(const f32x4*)p, o1 = *(const f32x4*)(p + 4); const f32x4 a0 = acc[ai][bj][m][0], a1 = acc[ai][bj][m][1];
                    o0[0] += a0[0] * bflo(g.x); o0[1] += a0[1] * bfhi(g.x); o0[2] += a0[2] * bflo(g.y); o0[3] += a0[3] * bfhi(g.y);
                    o1[0] += a1[0] * bflo(g.z); o1[1] += a1[1] * bfhi(g.z); o1[2] += a1[2] * bflo(g.w); o1[3] += a1[3] * bfhi(g.w);
                    EpiIn::st8(MX + r * DM + c, o0, o1); }
                asm volatile("" ::: "memory"); }
    }
};
template <bool COPY> struct EpiResid {
    static constexpr bool PERM = true, AFTER_DRAIN = false;
    const float* BASE; float* OUT; bf16_t* CP; float* SS;
    __device__ __forceinline__ void operator()(const f32x4 (&acc)[2][2][4][2], const Unit& u, int wr, int wc, int fr, int fq) const {
        const int row0 = u.pm * BM + wr * 64 + fr, col0 = u.pn * BM + wc * 32 + 8 * fq;
#pragma unroll
        for (int ai = 0; ai < 2; ++ai)
#pragma unroll
            for (int m = 0; m < 4; ++m) { const size_t r = (size_t)(row0 + ai * HALF + m * 16); float ss = 0.f;
#pragma unroll
                for (int bj = 0; bj < 2; ++bj) { const int c = col0 + bj * HALF; const float* bp = BASE + r * DM + c;
                    const f32x4 o0 = *(const f32x4*)bp + acc[ai][bj][m][0], o1 = *(const f32x4*)(bp + 4) + acc[ai][bj][m][1];
                    ss += (o0[0] * o0[0] + o0[1] * o0[1]) + (o0[2] * o0[2] + o0[3] * o0[3]) + (o1[0] * o1[0] + o1[1] * o1[1]) + (o1[2] * o1[2] + o1[3] * o1[3]);
                    float* op = OUT + r * DM + c; *(f32x4*)op = o0; *(f32x4*)(op + 4) = o1;
                    if (COPY) EpiIn::st8(CP + r * DM + c, o0, o1); }
                ss += __shfl_xor(ss, 16); ss += __shfl_xor(ss, 32);
                if (fq == 0) atomicAdd(SS + r, ss);
                asm volatile("" ::: "memory"); }
    }
};
struct EpiSwiGLU {
    static constexpr bool PERM = true, AFTER_DRAIN = false;
    bf16_t* HID; const float* SS;
    __device__ __forceinline__ void operator()(const f32x4 (&acc)[2][2][4][2], const Unit& u, int wr, int wc, int fr, int fq) const {
        const int row0 = u.pm * BM + wr * 64 + fr, col0 = u.pn * HALF + wc * 32 + 8 * fq;
#pragma unroll
        for (int ai = 0; ai < 2; ++ai)
#pragma unroll
            for (int m = 0; m < 4; ++m) { const size_t r = (size_t)(row0 + ai * HALF + m * 16);
                const float rstd = 1.0f / sqrtf(SS[r] * (1.0f / DM) + RMS_EPS);
                f32x4 o0, o1;
#pragma unroll
                for (int e = 0; e < 4; ++e) { const float g0 = acc[ai][0][m][0][e] * rstd, u0 = acc[ai][1][m][0][e] * rstd, g1 = acc[ai][0][m][1][e] * rstd, u1 = acc[ai][1][m][1][e] * rstd;
                    o0[e] = g0 * sigmoidf_(g0) * u0; o1[e] = g1 * sigmoidf_(g1) * u1; }
                EpiIn::st8(HID + r * DFF + col0, o0, o1); }
    }
};

template <class Epi, class Sched, bool ALIGN_EPI = false, bool SP2 = false>
__device__ __forceinline__ void gemm_phase(PG8_LAS unsigned char* lds, const Gemm g, const Sched& S, const Epi& E) {
    const int tid = threadIdx.x, wid = __builtin_amdgcn_readfirstlane(tid >> 6), lane = tid & 63, wr = wid >> 2, wc = wid & 3, fr = lane & 15, fq = lane >> 4;
    const int K = g.K, nt = K / BK;
    unsigned voffA[2], voffB[2];
#pragma unroll
    for (int i = 0; i < 2; ++i) { int R, C; stage_rc(tid * 16 + i * 8192, R, C); const int Rb = Epi::PERM ? ((R & ~31) + perm32(R & 31)) : R;
        voffA[i] = (unsigned)(R * K + C) * 2u; voffB[i] = (unsigned)(Rb * K + C) * 2u; }
    const size_t kstep = (size_t)(BK * 2);
    const size_t hstep = (size_t)HALF * K * 2;
    const size_t tstep = 2 * hstep;
    const unsigned ldsw = (unsigned)wid * 1024u;
    const int aoff = lds_byte(wr * 64 + fr, fq * 8), boff = lds_byte(wc * 32 + fr, fq * 8);
#define PG8_SA(b, h) (((b) * 2 + (h)) * HTB)
#define PG8_SB(b, h) ((4 + (b) * 2 + (h)) * HTB)
#define PG8_STAGE(bufoff, gbase, voff) do { _Pragma("unroll") for (int _i = 0; _i < 2; ++_i) \
        __builtin_amdgcn_global_load_lds((const unsigned*)((const char*)(gbase) + (voff)[_i]), (PG8_LAS unsigned*)(lds + (bufoff) + ldsw + _i * 8192), 16, 0, 0); } while (0)
#define PG8_LDA(dst, b, h) do { _Pragma("unroll") for (int m = 0; m < 4; ++m) _Pragma("unroll") for (int k = 0; k < 2; ++k) dst[m][k] = *(const PG8_LAS bf16x8*)(lds + PG8_SA(b, h) + aoff + m * 2048 + k * 1024); } while (0)
#define PG8_LDB(dst, b, h) do { _Pragma("unroll") for (int n = 0; n < 2; ++n) _Pragma("unroll") for (int k = 0; k < 2; ++k) dst[n][k] = *(const PG8_LAS bf16x8*)(lds + PG8_SB(b, h) + boff + n * 2048 + k * 1024); } while (0)
#define PG8_MMA(ai, bj, At, Bt) do { __builtin_amdgcn_s_setprio(1); _Pragma("unroll") for (int m = 0; m < 4; ++m) _Pragma("unroll") for (int n = 0; n < 2; ++n) _Pragma("unroll") for (int k = 0; k < 2; ++k) \
        acc[ai][bj][m][n] = __builtin_amdgcn_mfma_f32_16x16x32_bf16(Bt[n][k], At[m][k], acc[ai][bj][m][n], 0, 0, 0); __builtin_amdgcn_s_setprio(0); } while (0)
#define PG8_WAIT_V(n) asm volatile("s_waitcnt vmcnt(" #n ")" ::: "memory")
#define PG8_WAIT_L(n) asm volatile("s_waitcnt lgkmcnt(" #n ")" ::: "memory")
#define PG8_BAR __builtin_amdgcn_s_barrier()
#define PG8_SCHED __builtin_amdgcn_sched_barrier(0)
    Unit cur, nxt; int ui = 0;
    if (!S.next(0, cur)) return;
    f32x4 acc[2][2][4][2];
#pragma unroll
    for (int a = 0; a < 2; ++a)
#pragma unroll
        for (int b = 0; b < 2; ++b)
#pragma unroll
            for (int m = 0; m < 4; ++m)
#pragma unroll
                for (int n = 0; n < 2; ++n) acc[a][b][m][n] = (f32x4){0.f, 0.f, 0.f, 0.f};
    bf16x8 At[4][2], B0[2][2], B1[2][2];
    const char* cA = (const char*)g.A + (size_t)cur.pm * tstep; const char* cB = (const char*)g.Bt + (size_t)cur.pn * tstep;
    S.a_ready(cur);
    if constexpr (SP2) {
        PG8_STAGE(PG8_SB(0, 0), cB, voffB); PG8_STAGE(PG8_SB(0, 1), cB + hstep, voffB); PG8_STAGE(PG8_SA(0, 0), cA, voffA); PG8_STAGE(PG8_SA(0, 1), cA + hstep, voffA);
        if (wr == 1) PG8_BAR;
        PG8_WAIT_V(2); PG8_BAR;
        PG8_STAGE(PG8_SB(1, 0), cB + kstep, voffB); PG8_STAGE(PG8_SA(1, 0), cA + kstep, voffA); PG8_STAGE(PG8_SB(1, 1), cB + hstep + kstep, voffB);
        PG8_WAIT_V(6); PG8_BAR;
    } else {
        PG8_STAGE(PG8_SB(0, 0), cB, voffB); PG8_STAGE(PG8_SA(0, 0), cA, voffA); PG8_STAGE(PG8_SB(0, 1), cB + hstep, voffB); PG8_STAGE(PG8_SA(0, 1), cA + hstep, voffA);
        if (wr == 1) PG8_BAR;
        PG8_WAIT_V(4); PG8_BAR;
        PG8_STAGE(PG8_SB(1, 0), cB + kstep, voffB); PG8_STAGE(PG8_SA(1, 0), cA + kstep, voffA); PG8_STAGE(PG8_SB(1, 1), cB + hstep + kstep, voffB);
        PG8_WAIT_V(6); PG8_BAR;
    }
    for (;;) {
        const bool has_next = S.next(ui + 1, nxt);
        const char* nA = has_next ? (const char*)g.A + (size_t)nxt.pm * tstep : cA; const char* nB = has_next ? (const char*)g.Bt + (size_t)nxt.pn * tstep : cB;
        for (int t = 0; t < nt; t += 2) {
            const bool last = (t == nt - 2);
            const char* a1 = cA + (size_t)(t + 1) * kstep;
            const char* a2 = last ? nA : cA + (size_t)(t + 2) * kstep; const char* b2 = last ? nB : cB + (size_t)(t + 2) * kstep;
            const char* a3 = a2 + kstep; const char* b3 = b2 + kstep;
            if (last && has_next) S.a_ready(nxt);
            if constexpr (SP2) {
            PG8_LDB(B0, 0, 0); PG8_LDB(B1, 0, 1); PG8_SCHED; PG8_LDA(At, 0, 0); PG8_STAGE(PG8_SA(1, 1), a1 + hstep, voffA);
            PG8_WAIT_V(8); PG8_WAIT_L(0); PG8_BAR; PG8_MMA(0, 0, At, B0); PG8_MMA(0, 1, At, B1); PG8_BAR; PG8_SCHED;
            PG8_LDA(At, 0, 1); PG8_STAGE(PG8_SB(0, 0), b2, voffB); PG8_STAGE(PG8_SB(0, 1), b2 + hstep, voffB); PG8_STAGE(PG8_SA(0, 0), a2, voffA);
            PG8_WAIT_V(8); PG8_WAIT_L(0); PG8_BAR; PG8_MMA(1, 0, At, B0); PG8_MMA(1, 1, At, B1); PG8_BAR; PG8_SCHED;
            PG8_LDB(B0, 1, 0); PG8_LDB(B1, 1, 1); PG8_SCHED; PG8_LDA(At, 1, 0); PG8_STAGE(PG8_SA(0, 1), a2 + hstep, voffA);
            PG8_WAIT_V(8); PG8_WAIT_L(0); PG8_BAR; PG8_MMA(0, 0, At, B0); PG8_MMA(0, 1, At, B1); PG8_BAR; PG8_SCHED;
            PG8_LDA(At, 1, 1); PG8_STAGE(PG8_SB(1, 0), b3, voffB); PG8_STAGE(PG8_SB(1, 1), b3 + hstep, voffB); PG8_STAGE(PG8_SA(1, 0), a3, voffA);
            PG8_WAIT_V(8); PG8_WAIT_L(0); PG8_BAR; PG8_MMA(1, 0, At, B0); PG8_MMA(1, 1, At, B1); PG8_BAR; PG8_SCHED;
            } else {
            PG8_LDB(B0, 0, 0); PG8_SCHED; PG8_LDA(At, 0, 0); PG8_STAGE(PG8_SA(1, 1), a1 + hstep, voffA);
            PG8_WAIT_L(8); PG8_BAR; PG8_WAIT_L(0); PG8_MMA(0, 0, At, B0); PG8_BAR; PG8_SCHED;
            PG8_LDB(B1, 0, 1); PG8_STAGE(PG8_SB(0, 0), b2, voffB);
            PG8_BAR; PG8_WAIT_L(0); PG8_MMA(0, 1, At, B1); PG8_BAR;
            PG8_LDA(At, 0, 1); PG8_STAGE(PG8_SA(0, 0), a2, voffA);
            PG8_BAR; PG8_WAIT_L(0); PG8_MMA(1, 0, At, B0); PG8_BAR; PG8_SCHED;
            PG8_STAGE(PG8_SB(0, 1), b2 + hstep, voffB);
            PG8_WAIT_V(6); PG8_BAR; PG8_MMA(1, 1, At, B1); PG8_BAR;
            PG8_LDB(B0, 1, 0); PG8_SCHED; PG8_LDA(At, 1, 0); PG8_STAGE(PG8_SA(0, 1), a2 + hstep, voffA);
            PG8_WAIT_L(8); PG8_BAR; PG8_WAIT_L(0); PG8_MMA(0, 0, At, B0); PG8_BAR; PG8_SCHED;
            PG8_LDB(B1, 1, 1); PG8_STAGE(PG8_SB(1, 0), b3, voffB);
            PG8_BAR; PG8_WAIT_L(0); PG8_MMA(0, 1, At, B1); PG8_BAR;
            PG8_LDA(At, 1, 1); PG8_STAGE(PG8_SA(1, 0), a3, voffA);
            PG8_BAR; PG8_WAIT_L(0); PG8_MMA(1, 0, At, B0); PG8_BAR; PG8_SCHED;
            PG8_STAGE(PG8_SB(1, 1), b3 + hstep, voffB);
            PG8_WAIT_V(6); PG8_BAR; PG8_MMA(1, 1, At, B1); PG8_BAR;
            }
        }
        if constexpr (ALIGN_EPI) { if (wr == 0) PG8_BAR; }
        if constexpr (!Epi::AFTER_DRAIN) { E(acc, cur, wr, wc, fr, fq); S.done(cur); }
        if (!has_next) break;
#pragma unroll
        for (int a = 0; a < 2; ++a)
#pragma unroll
            for (int b = 0; b < 2; ++b)
#pragma unroll
                for (int m = 0; m < 4; ++m)
#pragma unroll
                    for (int n = 0; n < 2; ++n) acc[a][b][m][n] = (f32x4){0.f, 0.f, 0.f, 0.f};
        cur = nxt; cA = nA; cB = nB; ++ui;
        if constexpr (ALIGN_EPI) { if (wr == 1) PG8_BAR; }
    }
    PG8_WAIT_V(0);
    if constexpr (!ALIGN_EPI) { if (wr == 0) PG8_BAR; }
    PG8_BAR;
    if constexpr (Epi::AFTER_DRAIN) { E.fused(acc, cur, wr, wc, fr, fq, lds, wid, lane); S.done(cur); }
#undef PG8_SA
#undef PG8_SB
#undef PG8_STAGE
#undef PG8_LDA
#undef PG8_LDB
#undef PG8_MMA
#undef PG8_WAIT_V
#undef PG8_WAIT_L
#undef PG8_BAR
#undef PG8_SCHED
}

}

constexpr size_t MiB = 1u << 20;
constexpr size_t WS_CTL = 0, CTL_ZERO_BYTES = 1 * MiB;
constexpr size_t WS_ROPE = 1 * MiB;
constexpr size_t WS_LW2 = 3 * MiB, WS_LA2 = 4 * MiB, WS_LG2 = 5 * MiB;
constexpr size_t WS_BONUS = 6 * MiB;
constexpr size_t WS_H = 8 * MiB, WS_WIN = WS_H + (size_t)MPAD * DM * 2;
constexpr size_t WS_WPA = 8 * MiB, WS_WPR = 24 * MiB, WS_WOUT = 40 * MiB, WS_OATT = 72 * MiB, WS_ORWKV = 104 * MiB, WS_GG = 136 * MiB;
constexpr size_t WS_G = 216 * MiB, WS_A2 = 216 * MiB;
constexpr size_t WS_Q = 344 * MiB, WS_K = 376 * MiB, WS_VT = 385 * MiB, WS_U = 394 * MiB;
constexpr size_t WS_Y = 344 * MiB, WS_P1 = 344 * MiB, WS_H2 = 344 * MiB, WS_MX = 474 * MiB;
constexpr size_t SCF = (size_t)LTOK * RC * 4, SCB = (size_t)LTOK * RC * 2;
constexpr size_t WS_W0 = 512 * MiB, WS_W1 = WS_W0 + SCF, WS_KD0 = WS_W1 + SCF, WS_KD1 = WS_KD0 + SCB, WS_B0 = WS_KD1 + SCB, WS_B1 = WS_B0 + SCB, WS_KK = WS_B1 + SCB, WS_RR = WS_KK + SCB, WS_VV = WS_RR + SCB, WS_SCEND = WS_VV + SCB;
constexpr size_t WS_WD = 538 * MiB, WS_HID = 640 * MiB;
constexpr size_t WS_WGU = 866 * MiB, WS_END = WS_WGU + (size_t)2 * DFF * DM * 2;
static_assert(WS_WIN + (size_t)INWP * DM * 2 <= WS_G, "map: R");
static_assert(WS_GG + SCB <= WS_G && WS_U + (size_t)MPAD * UPITCH * 2 <= WS_W0 && WS_VT + (size_t)KVW * MPAD * 2 <= WS_U && WS_K + (size_t)MPAD * KVW * 2 <= WS_VT, "map: P1 outputs");
static_assert(WS_Y + 2 * SCF <= WS_MX && WS_MX + (size_t)SEQ * DM * 2 <= WS_WD && WS_WD + (size_t)DM * DFF * 2 <= WS_HID && WS_W1 + SCF >= WS_WD + (size_t)DM * DFF * 2, "map: overlays");
static_assert(WS_SCEND <= WS_WGU && WS_HID + (size_t)SEQ * DFF * 2 <= WS_WGU && WS_VV >= WS_HID + 0, "map: scan arrays");
constexpr int CW_BAR = 4096;
constexpr int CW_SS2 = 65536, CW_SS3 = 65536 + 8192;
static_assert((CW_SS3 + 8192) * 4 <= (int)CTL_ZERO_BYTES, "CTL");

constexpr int RING_BYTES = 131072;
constexpr int LDSCTL_OFF = RING_BYTES, MISC_OFF = LDSCTL_OFF + 320;
constexpr int LDS_BYTES = 147456;

#define GAS __attribute__((address_space(1)))
#define LAS __attribute__((address_space(3)))
typedef unsigned short bf16;
typedef unsigned v4u __attribute__((ext_vector_type(4)));
typedef unsigned v2u __attribute__((ext_vector_type(2)));
typedef float f32x4 __attribute__((ext_vector_type(4)));
typedef float f32x2 __attribute__((ext_vector_type(2)));
typedef float f32x16 __attribute__((ext_vector_type(16)));
typedef short bf16x8 __attribute__((ext_vector_type(8)));
typedef GAS unsigned gu32;
#define RLX_AGENT __ATOMIC_RELAXED, __HIP_MEMORY_SCOPE_AGENT
#define LDS_WAIT() asm volatile("s_waitcnt lgkmcnt(0)" ::: "memory")
__device__ __forceinline__ unsigned f2bf(float f) { unsigned u = __builtin_bit_cast(unsigned, f); return (u + 0x7fffu + ((u >> 16) & 1u)) >> 16; }
__device__ __forceinline__ unsigned pk2(float lo, float hi) { return f2bf(lo) | (f2bf(hi) << 16); }
__device__ __forceinline__ float bf2f(bf16 b) { return __uint_as_float(((unsigned)b) << 16); }
using pg8::bflo; using pg8::bfhi; using pg8::sigmoidf_;

#define XB_TMO      128
#define XB_XCNT(j)  (256  + 64 * (j))
#define XB_XSUB(j)  (1280 + 64 * (j))
#define XB_XGEN(j)  (2304 + 64 * (j))
#define XB_TOP      3328
#define XB_TOPGEN   3392
#define XCD_BAR_WORDS 3456
#define XB_SPIN_CAP (1u << 18)

__device__ __forceinline__ unsigned xb_ld(unsigned* p)              { return __hip_atomic_load(p, __ATOMIC_RELAXED, __HIP_MEMORY_SCOPE_AGENT); }
__device__ __forceinline__ unsigned xb_add(unsigned* p, unsigned v) { return __hip_atomic_fetch_add(p, v, __ATOMIC_RELAXED, __HIP_MEMORY_SCOPE_AGENT); }
__device__ __forceinline__ unsigned xb_xcc_id() { return (unsigned)__builtin_amdgcn_s_getreg((3 << 11) | 20) & 0xFu; }
#define XB_SPIN(cond, bar) do { unsigned _sp = 0; while (cond) { __builtin_amdgcn_s_sleep(1); \
    if ((++_sp & 255u) == 0u) { if (xb_ld(&(bar)[XB_TMO])) break; if (_sp > XB_SPIN_CAP) { atomicAdd(&(bar)[XB_TMO], 1u); break; } } } } while (0)

struct XcdBarrier {
    unsigned* bar; unsigned x;
    volatile LAS unsigned* st;
};

__device__ __forceinline__ XcdBarrier xcd_barrier_post(unsigned* bar, volatile LAS unsigned* st) {
    XcdBarrier b; b.bar = bar; b.x = xb_xcc_id(); b.st = st;
    if (threadIdx.x == 0) (void)xb_add(&bar[XB_XCNT(b.x)], 1u);
    return b;
}
__device__ __forceinline__ void xcd_barrier_complete(unsigned* bar, unsigned x, unsigned& nloc, unsigned& nx) {
    const unsigned G = gridDim.x * gridDim.y * gridDim.z;
    unsigned sum, cnt, mine, sp = 0u;
    for (;;) {
        sum = 0u; cnt = 0u; mine = 0u;
#pragma unroll
        for (unsigned j = 0; j < 16; ++j) { const unsigned c = xb_ld(&bar[XB_XCNT(j)]); sum += c; cnt += (c > 0u) ? 1u : 0u; mine = (j == x) ? c : mine; }
        if (sum == G) break;
        __builtin_amdgcn_s_sleep(1);
        if ((++sp & 255u) == 0u) { if (xb_ld(&bar[XB_TMO])) break; if (sp > XB_SPIN_CAP) { atomicAdd(&bar[XB_TMO], 1u); break; } }
    }
    nloc = mine > 0u ? mine : 1u; nx = cnt > 0u ? cnt : 1u;
}

__device__ __forceinline__ void xcd_barrier(const XcdBarrier& b) {
    asm volatile("s_waitcnt vmcnt(0)" ::: "memory");
    __syncthreads();
    if (threadIdx.x == 0) {
        unsigned* bar = b.bar;
        __builtin_amdgcn_s_waitcnt(0);
        unsigned nloc = b.st[0], nx = b.st[1];
        if (nloc == 0u) { xcd_barrier_complete(bar, b.x, nloc, nx); b.st[0] = nloc; b.st[1] = nx; }
        const unsigned old = xb_add(&bar[XB_XSUB(b.x)], 1u);
        const unsigned gen = old / nloc;
        if (old + 1u == (gen + 1u) * nloc) {
            __builtin_amdgcn_fence(__ATOMIC_RELEASE, "agent");
            asm volatile("s_waitcnt vmcnt(0)" ::: "memory");
            const unsigned og = xb_add(&bar[XB_TOP], 1u);
            const unsigned tg = og / nx;
            if (og + 1u == (tg + 1u) * nx) xb_add(&bar[XB_TOPGEN], 1u);
            else XB_SPIN(xb_ld(&bar[XB_TOPGEN]) == tg, bar);
            __builtin_amdgcn_fence(__ATOMIC_ACQUIRE, "agent");
            xb_add(&bar[XB_XGEN(b.x)], 1u);
            asm volatile("s_waitcnt vmcnt(0)" ::: "memory");
        } else {
            XB_SPIN(xb_ld(&bar[XB_XGEN(b.x)]) == gen, bar);
            __builtin_amdgcn_fence(__ATOMIC_ACQUIRE, "agent");
            asm volatile("s_waitcnt vmcnt(0)" ::: "memory");
        }
    }
    __syncthreads();
}


struct Frame {
    LAS unsigned char* lds;
    volatile LAS unsigned* MISC;
    gu32* ctl;
    int tid, lane, wave, G;
    unsigned char* ws;
    const float* in[26];
    float* out;
};
__device__ __forceinline__ float wave_sum(float v) {
#pragma unroll
    for (int o = 1; o < 64; o <<= 1) v += __shfl_xor(v, o);
    return v;
}

template <int MODE> __device__ __forceinline__ void transpose_item(const float* W, int K, int N, bf16* WT, LAS float* scr, int item, int lane, const float* kscale) {
    const int nblk = N / 32, kb = item / nblk, nb = item % nblk, k0 = 64 * kb, n0 = 32 * nb;
#pragma unroll 8
    for (int i = 0; i < 32; ++i) { const int kk = 2 * i + (lane >> 5); float v = W[(size_t)(k0 + kk) * N + n0 + (lane & 31)]; if (kscale) v *= kscale[k0 + kk]; scr[kk * 33 + (lane & 31)] = v; }
    LDS_WAIT(); asm volatile("" ::: "memory");
    const int c = lane & 7;
#pragma unroll
    for (int j = 0; j < 4; ++j) { const int n = (lane >> 3) + 8 * j; const LAS float* s = scr + (8 * c) * 33 + n;
        v4u o; o.x = pk2(s[0 * 33], s[1 * 33]); o.y = pk2(s[2 * 33], s[3 * 33]); o.z = pk2(s[4 * 33], s[5 * 33]); o.w = pk2(s[6 * 33], s[7 * 33]);
        const int nn = n0 + n; const int dr = (MODE == 0) ? nn : (256 * (nn >> 7) + (nn & 127) + (MODE == 2 ? 128 : 0));
        *(GAS v4u*)(WT + (size_t)dr * K + k0 + 8 * c) = o; }
    LDS_WAIT(); asm volatile("" ::: "memory");
}
__device__ __forceinline__ void rms_row_to_bf16(int lane, const float* xrow, const float* w, bf16* orow) {
    const GAS f32x4* xr = (const GAS f32x4*)xrow + lane;
    f32x4 v[16]; float s = 0.f;
#pragma unroll
    for (int j = 0; j < 16; ++j) { v[j] = xr[64 * j]; s += (v[j].x * v[j].x + v[j].y * v[j].y) + (v[j].z * v[j].z + v[j].w * v[j].w); }
    const float rstd = 1.f / sqrtf(wave_sum(s) * (1.f / DM) + RMS_EPS);
    const GAS f32x4* wr = (const GAS f32x4*)w + lane;
    GAS v2u* o8 = (GAS v2u*)orow + lane;
#pragma unroll
    for (int j = 0; j < 16; ++j) { const f32x4 ww = wr[64 * j]; v2u o; o.x = pk2(v[j].x * rstd * ww.x, v[j].y * rstd * ww.y); o.y = pk2(v[j].z * rstd * ww.z, v[j].w * rstd * ww.w); o8[64 * j] = o; }
}
__device__ const double ROPE_INV[16] = {
    1.0000000000000000000000000e+0,
    4.4036660267178047359198331e-1,
    1.9392274474868577334259386e-1,
    8.5397100285765611280149662e-2,
    3.7606030930863935681246092e-2,
    1.6560440080994445548947445e-2,
    7.2926647372171090477661219e-3,
    3.2114459947525910185434889e-3,
    1.4142135623730950488016887e-3,
    6.2277242191459597955502746e-4,
    2.7424817567620731825332265e-4,
    1.2076973741146503832424826e-4,
    5.3182958969449886162502429e-5,
    2.3419998961409341542188076e-5,
    1.0313385377212458859810127e-5,
    4.5416704806078696531998012e-6
};

__device__ __forceinline__ void p0_prologue(Frame& F) {
    LAS float* scr = (LAS float*)(F.lds + F.wave * 16384);
    const int gw = blockIdx.x * 8 + F.wave, NGW = F.G * 8;
    bf16* Wint = (bf16*)(F.ws + WS_WIN); bf16* Wgu = (bf16*)(F.ws + WS_WGU); bf16* H = (bf16*)(F.ws + WS_H);
    constexpr int I_IN = (DM / 64) * (INW / 32), I_GU = (DM / 64) * (DFF / 32);
    for (int it = gw; it < I_IN + 2 * I_GU; it += NGW) {
        int r = it;
        if (r < I_IN) { transpose_item<0>(F.in[3], DM, INW, Wint, scr, r, F.lane, nullptr); continue; } r -= I_IN;
        if (r < I_GU) { transpose_item<1>(F.in[22], DM, DFF, Wgu, scr, r, F.lane, F.in[21]); continue; } r -= I_GU;
        transpose_item<2>(F.in[23], DM, DFF, Wgu, scr, r, F.lane, F.in[21]);
    }
    for (int m = gw; m < MPAD + (INWP - INW); m += NGW) {
        if (m < SEQ) rms_row_to_bf16(F.lane, F.in[0] + (size_t)m * DM, F.in[2], H + (size_t)m * DM);
        else if (m < LTOK) rms_row_to_bf16(F.lane, F.in[1] + (size_t)(m - SEQ) * DM, F.in[2], H + (size_t)m * DM);
        else { bf16* row = (m < MPAD) ? H + (size_t)m * DM : Wint + (size_t)(INW + (m - MPAD)) * DM; GAS v4u* o = (GAS v4u*)row + F.lane;
#pragma unroll
            for (int j = 0; j < 8; ++j) o[64 * j] = (v4u){0u, 0u, 0u, 0u}; }
    }
    const int gt = blockIdx.x * 512 + F.tid, NGT = F.G * 512;
    float* rope = (float*)(F.ws + WS_ROPE);
    for (int i = gt; i < LTOK * 16; i += NGT) { const int pos = i >> 4, k = i & 15;
        const double ang = (double)pos * ROPE_INV[k]; const double kq = __builtin_rint(ang * 0.15915494309189535);
        const double red = (ang - kq * 6.28318530717958623) - kq * 2.4492935982947064e-16; const float rf = (float)red;
        rope[2 * i] = cosf(rf); rope[2 * i + 1] = sinf(rf); }
    bf16* w2t = (bf16*)(F.ws + WS_LW2); bf16* a2t = (bf16*)(F.ws + WS_LA2); bf16* g2t = (bf16*)(F.ws + WS_LG2);
    for (int i = gt; i < 2 * 96 * RC; i += NGT) { const int c = i % RC, j = (i / RC) % 96, d = i / (RC * 96);
        w2t[((size_t)d * RC + c) * 96 + j] = (bf16)f2bf(F.in[8][i]); a2t[((size_t)d * RC + c) * 96 + j] = (bf16)f2bf(F.in[10][i]); }
    for (int i = gt; i < 256 * RC; i += NGT) { const int c = i % RC, j = i / RC; g2t[(size_t)c * 256 + j] = (bf16)f2bf(F.in[11][i]); }
}

__device__ __forceinline__ int crow(int r, int hi) { return (r & 3) + 8 * (r >> 2) + 4 * hi; }
__device__ __forceinline__ void attn_phase(Frame& F) {
    const bf16* Q = (const bf16*)(F.ws + WS_Q); const bf16* K = (const bf16*)(F.ws + WS_K); const bf16* Vt = (const bf16*)(F.ws + WS_VT); bf16* OA = (bf16*)(F.ws + WS_OATT);
    const float* sink = F.in[17];
    const int gw = blockIdx.x * 8 + F.wave, NGW = F.G * 8, hh = F.lane >> 5, r = F.lane & 31;
    constexpr float SC = 0.08838834764831845f * 1.4426950408889634f, L2E = 1.4426950408889634f;
    for (int item = gw; item < 4096; item += NGW) {
        const int sub = item & 3, hq = (item >> 2) & 15, qb = item >> 6, q0 = qb * 128 + sub * 32, hk = hq >> 2;
        bf16x8 bq[8];
        { const bf16* qp = Q + (size_t)(q0 + r) * ATTW + hq * 128 + 8 * hh;
#pragma unroll
          for (int s = 0; s < 8; ++s) bq[s] = *(const bf16x8*)(qp + 16 * s); }
        f32x16 O[4];
#pragma unroll
        for (int dt = 0; dt < 4; ++dt)
#pragma unroll
            for (int i = 0; i < 16; ++i) O[dt][i] = 0.f;
        float m = sink[hq] * L2E, l = (hh == 0) ? 1.f : 0.f;
        for (int ti = 0; ti < 10; ++ti) {
            const bool meta = (ti == 9);
            const int key0 = meta ? SEQ : q0 + 32 * (ti - 4);
            if (key0 < 0 || (!meta && key0 >= SEQ)) continue;
            f32x16 st;
#pragma unroll
            for (int i = 0; i < 16; ++i) st[i] = 0.f;
            { const bf16* kp = K + (size_t)(key0 + r) * KVW + hk * 128 + 8 * hh;
#pragma unroll
              for (int s = 0; s < 8; ++s) { const bf16x8 ak = *(const bf16x8*)(kp + 16 * s); st = __builtin_amdgcn_mfma_f32_32x32x16_bf16(ak, bq[s], st, 0, 0, 0); } }
            float tmax = -__builtin_inff();
#pragma unroll
            for (int i = 0; i < 16; ++i) { const int kr = crow(i, hh); bool ok;
                if (meta) ok = kr < NMETA; else { const int dlt = (key0 + kr) - (q0 + r); ok = (dlt >= -128) && (dlt <= 128); }
                const float t = ok ? st[i] * SC : -__builtin_inff(); st[i] = t; tmax = fmaxf(tmax, t); }
            tmax = fmaxf(tmax, __shfl_xor(tmax, 32));
            const float mn = fmaxf(m, tmax), alpha = __builtin_amdgcn_exp2f(m - mn); m = mn;
            float ps = 0.f;
#pragma unroll
            for (int i = 0; i < 16; ++i) { const float p = __builtin_amdgcn_exp2f(st[i] - mn); st[i] = p; ps += p; }
            l = l * alpha + ps;
#pragma unroll
            for (int dt = 0; dt < 4; ++dt)
#pragma unroll
                for (int i = 0; i < 16; ++i) O[dt][i] *= alpha;
            bf16x8 pb[2];
#pragma unroll
            for (int s2 = 0; s2 < 2; ++s2) { v4u w; w.x = pg8::cvt_pk_bf16(st[8 * s2 + 0], st[8 * s2 + 1]); w.y = pg8::cvt_pk_bf16(st[8 * s2 + 2], st[8 * s2 + 3]);
                w.z = pg8::cvt_pk_bf16(st[8 * s2 + 4], st[8 * s2 + 5]); w.w = pg8::cvt_pk_bf16(st[8 * s2 + 6], st[8 * s2 + 7]); pb[s2] = __builtin_bit_cast(bf16x8, w); }
#pragma unroll
            for (int dt = 0; dt < 4; ++dt) { const bf16* vp = Vt + (size_t)(hk * 128 + 32 * dt + r) * MPAD + key0 + 4 * hh;
#pragma unroll
                for (int s2 = 0; s2 < 2; ++s2) { const v2u lo = *(const v2u*)(vp + 16 * s2), hi = *(const v2u*)(vp + 16 * s2 + 8);
                    const v4u w = {lo.x, lo.y, hi.x, hi.y}; O[dt] = __builtin_amdgcn_mfma_f32_32x32x16_bf16(__builtin_bit_cast(bf16x8, w), pb[s2], O[dt], 0, 0, 0); } }
        }
        l += __shfl_xor(l, 32);
        const float inv = 1.0f / l;
        bf16* op = OA + (size_t)(q0 + r) * ATTW + hq * 128 + 4 * hh;
#pragma unroll
        for (int dt = 0; dt < 4; ++dt)
#pragma unroll
            for (int g4 = 0; g4 < 4; ++g4) { v2u w; w.x = pg8::cvt_pk_bf16(O[dt][4 * g4 + 0] * inv, O[dt][4 * g4 + 1] * inv); w.y = pg8::cvt_pk_bf16(O[dt][4 * g4 + 2] * inv, O[dt][4 * g4 + 3] * inv);
                *(v2u*)(op + 32 * dt + 8 * g4) = w; }
    }
}

__device__ __forceinline__ int tok2row(int t) { return t < NMETA ? SEQ + t : t - NMETA; }
__device__ __forceinline__ void load_shift16(const bf16* U, int col, float mp, float mn, int t0, int hh, float (&out)[16]) {
#pragma unroll
    for (int q = 0; q < 4; ++q) { const int tb = t0 + 8 * q + 4 * hh; float raw[6];
#pragma unroll
        for (int i = 0; i < 6; ++i) { const int t = tb - 1 + i; raw[i] = (t >= 0 && t < LTOK) ? bf2f(U[(size_t)tok2row(t) * UPITCH + col]) : 0.f; }
#pragma unroll
        for (int e = 0; e < 4; ++e) out[4 * q + e] = raw[e + 1] + mp * (raw[e] - raw[e + 1]) + mn * (raw[e + 2] - raw[e + 1]); }
}
__device__ __forceinline__ void prep_phase(Frame& F) {
    constexpr int XS = 648;
    LAS bf16* Xs = (LAS bf16*)F.lds;
    const bf16* U = (const bf16*)(F.ws + WS_U);
    const float* mu_p = F.in[5]; const float* mu_n = F.in[6];
    const bf16* w2t = (const bf16*)(F.ws + WS_LW2); const bf16* a2t = (const bf16*)(F.ws + WS_LA2); const bf16* g2t = (const bf16*)(F.ws + WS_LG2);
    float* W0 = (float*)(F.ws + WS_W0); float* W1 = (float*)(F.ws + WS_W1);
    bf16* KD0 = (bf16*)(F.ws + WS_KD0); bf16* KD1 = (bf16*)(F.ws + WS_KD1); bf16* B0 = (bf16*)(F.ws + WS_B0); bf16* B1 = (bf16*)(F.ws + WS_B1);
    bf16* KK = (bf16*)(F.ws + WS_KK); bf16* RR = (bf16*)(F.ws + WS_RR); bf16* VV = (bf16*)(F.ws + WS_VV); bf16* GG = (bf16*)(F.ws + WS_GG);
    float* BON = (float*)(F.ws + WS_BONUS);
    const int hh = F.lane >> 5, r = F.lane & 31;
    for (int unit = blockIdx.x; unit < 257 * 4; unit += F.G) {
        const int tt = unit >> 2, t0 = tt * 32, hd = (unit & 3) * 8 + F.wave;
        __syncthreads();
        for (int ci = F.tid; ci < 2560; ci += 512) {
            const int tl = ci / 80, ch = ci % 80, t = t0 + tl, col = 3 * RC + 8 * ch;
            v4u uc = {0u, 0u, 0u, 0u}, up = uc, un = uc;
            if (t < LTOK) uc = *(const v4u*)(U + (size_t)tok2row(t) * UPITCH + col);
            if (t >= 1 && t - 1 < LTOK) up = *(const v4u*)(U + (size_t)tok2row(t - 1) * UPITCH + col);
            if (t + 1 < LTOK) un = *(const v4u*)(U + (size_t)tok2row(t + 1) * UPITCH + col);
            const f32x4 mp0 = *(const f32x4*)(mu_p + col), mp1 = *(const f32x4*)(mu_p + col + 4), mn0 = *(const f32x4*)(mu_n + col), mn1 = *(const f32x4*)(mu_n + col + 4);
            const unsigned ucw[4] = {uc.x, uc.y, uc.z, uc.w}, upw[4] = {up.x, up.y, up.z, up.w}, unw[4] = {un.x, un.y, un.z, un.w};
            const float mpw[8] = {mp0[0], mp0[1], mp0[2], mp0[3], mp1[0], mp1[1], mp1[2], mp1[3]}, mnw[8] = {mn0[0], mn0[1], mn0[2], mn0[3], mn1[0], mn1[1], mn1[2], mn1[3]};
            float x[8];
#pragma unroll
            for (int e = 0; e < 8; ++e) { const float c0 = (e & 1) ? bfhi(ucw[e >> 1]) : bflo(ucw[e >> 1]), p0 = (e & 1) ? bfhi(upw[e >> 1]) : bflo(upw[e >> 1]), n0 = (e & 1) ? bfhi(unw[e >> 1]) : bflo(unw[e >> 1]);
                float v = c0 + mpw[e] * (p0 - c0) + mnw[e] * (n0 - c0);
                if (ch < 24) { const float ex = __expf(2.0f * v); v = 1.0f - 2.0f / (ex + 1.0f); }
                else if (ch >= 48) v = sigmoidf_(v);
                x[e] = v; }
            v4u o; o.x = pk2(x[0], x[1]); o.y = pk2(x[2], x[3]); o.z = pk2(x[4], x[5]); o.w = pk2(x[6], x[7]);
            *(LAS v4u*)(Xs + tl * XS + 8 * ch) = o;
        }
        __syncthreads();
        float kp[2][16], ss[16], bon[16];
#pragma unroll
        for (int i = 0; i < 16; ++i) { ss[i] = 0.f; bon[i] = 0.f; }
#pragma unroll
        for (int ct = 0; ct < 2; ++ct) { const int c = hd * 64 + 32 * ct + r; load_shift16(U, RC + c, mu_p[RC + c], mu_n[RC + c], t0, hh, kp[ct]); const float kkw = F.in[12][c];
#pragma unroll
            for (int i = 0; i < 16; ++i) { const float kr = kp[ct][i] * kkw; ss[i] += kr * kr; } }
#pragma unroll
        for (int i = 0; i < 16; ++i) {
#pragma unroll
            for (int o = 1; o < 32; o <<= 1) ss[i] += __shfl_xor(ss[i], o);
            ss[i] = 1.0f / fmaxf(sqrtf(ss[i]), 1e-12f); }
#pragma unroll
        for (int ct = 0; ct < 2; ++ct) {
            const int c = hd * 64 + 32 * ct + r;
            const float kkw = F.in[12][c], kaw = F.in[13][c], rkw = F.in[14][c];
            float kk[16], rp[16];
#pragma unroll
            for (int i = 0; i < 16; ++i) kk[i] = kp[ct][i] * kkw * ss[i];
            load_shift16(U, c, mu_p[c], mu_n[c], t0, hh, rp);
            { float vp[16]; load_shift16(U, 2 * RC + c, mu_p[2 * RC + c], mu_n[2 * RC + c], t0, hh, vp);
#pragma unroll
              for (int i = 0; i < 16; ++i) { const int t = t0 + crow(i, hh); if (t < LTOK) { const size_t o = (size_t)t * RC + c; KK[o] = (bf16)f2bf(kk[i]); RR[o] = (bf16)f2bf(rp[i]); VV[o] = (bf16)f2bf(vp[i]); } } }
#pragma unroll
            for (int d = 0; d < 2; ++d) {
                f32x16 acc;
#pragma unroll
                for (int i = 0; i < 16; ++i) acc[i] = 0.f;
                const bf16* bp = a2t + ((size_t)d * RC + c) * 96 + 8 * hh; const LAS bf16* ap = Xs + r * XS + 192 + 96 * d + 8 * hh;
#pragma unroll
                for (int s = 0; s < 6; ++s) acc = __builtin_amdgcn_mfma_f32_32x32x16_bf16(*(const LAS bf16x8*)(ap + 16 * s), *(const bf16x8*)(bp + 16 * s), acc, 0, 0, 0);
                const float a0 = F.in[9][d * RC + c]; bf16* KD = d ? KD1 : KD0; bf16* BB = d ? B1 : B0;
#pragma unroll
                for (int i = 0; i < 16; ++i) { const float a = sigmoidf_(a0 + acc[i]); const float kd = kp[ct][i] * (1.0f + (a - 1.0f) * kaw); bon[i] += rp[i] * kd * rkw;
                    const int t = t0 + crow(i, hh); if (t < LTOK) { const size_t o = (size_t)t * RC + c; KD[o] = (bf16)f2bf(kd); BB[o] = (bf16)f2bf(kk[i] * a); } }
            }
#pragma unroll
            for (int d = 0; d < 2; ++d) {
                f32x16 acc;
#pragma unroll
                for (int i = 0; i < 16; ++i) acc[i] = 0.f;
                const bf16* bp = w2t + ((size_t)d * RC + c) * 96 + 8 * hh; const LAS bf16* ap = Xs + r * XS + 96 * d + 8 * hh;
#pragma unroll
                for (int s = 0; s < 6; ++s) acc = __builtin_amdgcn_mfma_f32_32x32x16_bf16(*(const LAS bf16x8*)(ap + 16 * s), *(const bf16x8*)(bp + 16 * s), acc, 0, 0, 0);
                const float w0 = F.in[7][d * RC + c]; float* WW = d ? W1 : W0;
#pragma unroll
                for (int i = 0; i < 16; ++i) { const float z = -(w0 + acc[i]); const float sp = fmaxf(z, 0.f) + log1pf(expf(-fabsf(z))); const float wl = -sp - 0.5f; const float dec = expf(-expf(wl));
                    const int t = t0 + crow(i, hh); if (t < LTOK) WW[(size_t)t * RC + c] = dec; }
            }
            {
                f32x16 acc;
#pragma unroll
                for (int i = 0; i < 16; ++i) acc[i] = 0.f;
                const bf16* bp = g2t + (size_t)c * 256 + 8 * hh; const LAS bf16* ap = Xs + r * XS + 384 + 8 * hh;
#pragma unroll
                for (int s = 0; s < 16; ++s) acc = __builtin_amdgcn_mfma_f32_32x32x16_bf16(*(const LAS bf16x8*)(ap + 16 * s), *(const bf16x8*)(bp + 16 * s), acc, 0, 0, 0);
#pragma unroll
                for (int i = 0; i < 16; ++i) { const int t = t0 + crow(i, hh); if (t < LTOK) GG[(size_t)t * RC + c] = (bf16)f2bf(acc[i]); }
            }
        }
#pragma unroll
        for (int i = 0; i < 16; ++i) {
#pragma unroll
            for (int o = 1; o < 32; o <<= 1) bon[i] += __shfl_xor(bon[i], o);
            const int t = t0 + crow(i, hh); if (r == 0 && t < LTOK) BON[(size_t)t * RH + hd] = bon[i]; }
    }
}

__device__ __forceinline__ float dpp_xor_add(float x, const int ctrl_sel) {
    int y;
    if (ctrl_sel == 0) y = __builtin_amdgcn_update_dpp(0, __float_as_int(x), 0xB1, 0xf, 0xf, true);
    else if (ctrl_sel == 1) y = __builtin_amdgcn_update_dpp(0, __float_as_int(x), 0x4E, 0xf, 0xf, true);
    else if (ctrl_sel == 2) y = __builtin_amdgcn_update_dpp(0, __float_as_int(x), 0x141, 0xf, 0xf, true);
    else y = __builtin_amdgcn_update_dpp(0, __float_as_int(x), 0x140, 0xf, 0xf, true);
    return x + __int_as_float(y);
}
__device__ __forceinline__ float row16_sum(float x) { x = dpp_xor_add(x, 0); x = dpp_xor_add(x, 1); x = dpp_xor_add(x, 2); x = dpp_xor_add(x, 3); return x; }
constexpr int SC_CH = 32, SC_STEP = 336, SC_BUF = SC_CH * SC_STEP;
struct ScanOps { f32x4 w, kd, b, kk, r; float v; };
__device__ __forceinline__ ScanOps scan_ld(const LAS float* sp, int jg, int rl) {
    ScanOps o; o.w = *(const LAS f32x4*)(sp + 4 * jg); o.kd = *(const LAS f32x4*)(sp + 64 + 4 * jg); o.b = *(const LAS f32x4*)(sp + 128 + 4 * jg);
    o.kk = *(const LAS f32x4*)(sp + 192 + 4 * jg); o.r = *(const LAS f32x4*)(sp + 256 + 4 * jg); o.v = sp[320 + rl]; return o; }
__device__ __forceinline__ void scan_phase(Frame& F) {
    LAS float* BUF = (LAS float*)F.lds;
    LAS float* YB = (LAS float*)(F.lds + 2 * SC_BUF * 4);
    const float* W0 = (const float*)(F.ws + WS_W0); const float* W1 = (const float*)(F.ws + WS_W1);
    const bf16* KD0 = (const bf16*)(F.ws + WS_KD0); const bf16* KD1 = (const bf16*)(F.ws + WS_KD1); const bf16* B0 = (const bf16*)(F.ws + WS_B0); const bf16* B1 = (const bf16*)(F.ws + WS_B1);
    const bf16* KK = (const bf16*)(F.ws + WS_KK); const bf16* RR = (const bf16*)(F.ws + WS_RR); const bf16* VV = (const bf16*)(F.ws + WS_VV);
    float* Y = (float*)(F.ws + WS_Y);
#define SC_BARRIER() do { asm volatile("s_waitcnt lgkmcnt(0)" ::: "memory"); __builtin_amdgcn_s_barrier(); asm volatile("" ::: "memory"); } while (0)
    for (int item = blockIdx.x; item < 256; item += F.G) {
        const int pair = (item & 7) * 8 + (item >> 5), q4 = (item >> 3) & 3, hd = pair >> 1, dir = pair & 1;
        const int nsteps = dir ? SEQ : LTOK, nchunks = (nsteps + SC_CH - 1) / SC_CH;
        const float* Wd = dir ? W1 : W0; const bf16* KDd = dir ? KD1 : KD0; const bf16* Bd = dir ? B1 : B0;
        float* Yd = Y + (size_t)dir * LTOK * RC;
        const int lt = F.tid - 256, lq = lt & 15, sg = (lt >> 4) & 15, slv = (lt >> 2) & 31, qv = lt & 3;
        f32x4 ld_w[2]; v2u ld_k[2][4]; v2u ld_v;
#define SCAN_ISSUE(c) do { _Pragma("unroll") for (int u_ = 0; u_ < 2; ++u_) { const int s_ = (c) * SC_CH + sg + 16 * u_; const int sc_ = s_ < nsteps ? s_ : nsteps - 1; const int t_ = dir ? (LTOK - 1 - sc_) : sc_; \
                const size_t o_ = (size_t)t_ * RC + hd * 64 + 4 * lq; ld_w[u_] = *(const f32x4*)(Wd + o_); ld_k[u_][0] = *(const v2u*)(KDd + o_); ld_k[u_][1] = *(const v2u*)(Bd + o_); ld_k[u_][2] = *(const v2u*)(KK + o_); ld_k[u_][3] = *(const v2u*)(RR + o_); } \
            { const int s_ = (c) * SC_CH + slv; const int sc_ = s_ < nsteps ? s_ : nsteps - 1; const int t_ = dir ? (LTOK - 1 - sc_) : sc_; ld_v = *(const v2u*)(VV + (size_t)t_ * RC + hd * 64 + 16 * q4 + 4 * qv); } } while (0)
#define SCAN_WRITE(c) do { LAS float* dst_ = BUF + ((c) & 1) * SC_BUF; _Pragma("unroll") for (int u_ = 0; u_ < 2; ++u_) { const int sl_ = sg + 16 * u_; const bool ok_ = (c) * SC_CH + sl_ < nsteps; LAS float* d_ = dst_ + sl_ * SC_STEP + 4 * lq; \
                *(LAS f32x4*)d_ = ok_ ? ld_w[u_] : (f32x4){1.f, 1.f, 1.f, 1.f}; \
                _Pragma("unroll") for (int a_ = 0; a_ < 4; ++a_) { const v2u w_ = ld_k[u_][a_]; *(LAS f32x4*)(d_ + 64 * (a_ + 1)) = ok_ ? (f32x4){bflo(w_.x), bfhi(w_.x), bflo(w_.y), bfhi(w_.y)} : (f32x4){0.f, 0.f, 0.f, 0.f}; } } \
            if (lt < 128) { const bool ok_ = (c) * SC_CH + slv < nsteps; *(LAS f32x4*)(dst_ + slv * SC_STEP + 320 + 4 * qv) = ok_ ? (f32x4){bflo(ld_v.x), bfhi(ld_v.x), bflo(ld_v.y), bfhi(ld_v.y)} : (f32x4){0.f, 0.f, 0.f, 0.f}; } } while (0)
#define SCAN_FLUSH(c) do { const LAS float* yb_ = YB + ((c) & 1) * (SC_CH * 16); _Pragma("unroll") for (int u_ = 0; u_ < 2; ++u_) { const int pi_ = lt + 256 * u_; const int sl_ = pi_ >> 4, s_ = (c) * SC_CH + sl_; \
                if (s_ < nsteps) { const int t_ = dir ? (LTOK - 1 - s_) : s_; Yd[(size_t)t_ * RC + hd * 64 + 16 * q4 + (pi_ & 15)] = yb_[pi_]; } } } while (0)
        SC_BARRIER();
        if (F.wave >= 4) { SCAN_ISSUE(0); SCAN_WRITE(0); if (nchunks > 1) SCAN_ISSUE(1); }
        SC_BARRIER();
        float S0 = 0.f, S1 = 0.f, S2 = 0.f, S3 = 0.f;
        const int g = F.lane >> 4, jg = F.lane & 15, rl = 4 * (F.wave & 3) + g;
        for (int c = 0; c < nchunks; ++c) {
            if (F.wave >= 4) {
                if (c + 1 < nchunks) SCAN_WRITE(c + 1);
                if (c + 2 < nchunks) SCAN_ISSUE(c + 2);
                if (c >= 1) SCAN_FLUSH(c - 1);
            } else {
                const LAS float* base = BUF + (c & 1) * SC_BUF; LAS float* yb = YB + (c & 1) * (SC_CH * 16);
                ScanOps o0 = scan_ld(base, jg, rl), o1 = scan_ld(base + SC_STEP, jg, rl);
#pragma unroll
                for (int sl = 0; sl < SC_CH; ++sl) {
                    ScanOps o2 = o1;
                    if (sl + 2 < SC_CH) o2 = scan_ld(base + (sl + 2) * SC_STEP, jg, rl);
                    float p = (S0 * o0.kk[0] + S1 * o0.kk[1]) + (S2 * o0.kk[2] + S3 * o0.kk[3]);
                    const float u0 = S0 * o0.w[0] + o0.v * o0.kd[0], u1 = S1 * o0.w[1] + o0.v * o0.kd[1], u2 = S2 * o0.w[2] + o0.v * o0.kd[2], u3 = S3 * o0.w[3] + o0.v * o0.kd[3];
                    p = row16_sum(p);
                    S0 = u0 - p * o0.b[0]; S1 = u1 - p * o0.b[1]; S2 = u2 - p * o0.b[2]; S3 = u3 - p * o0.b[3];
                    float y = (S0 * o0.r[0] + S1 * o0.r[1]) + (S2 * o0.r[2] + S3 * o0.r[3]);
                    y = row16_sum(y);
                    if (jg == 0) yb[sl * 16 + rl] = y;
                    o0 = o1; o1 = o2;
                }
            }
            SC_BARRIER();
        }
        if (F.wave >= 4) SCAN_FLUSH(nchunks - 1);
#undef SCAN_ISSUE
#undef SCAN_WRITE
#undef SCAN_FLUSH
    }
#undef SC_BARRIER
}

__device__ __forceinline__ void combine_phase(Frame& F) {
    const float* Y0 = (const float*)(F.ws + WS_Y); const float* Y1 = Y0 + (size_t)LTOK * RC;
    const bf16* VV = (const bf16*)(F.ws + WS_VV); const bf16* GG = (const bf16*)(F.ws + WS_GG); const float* BON = (const float*)(F.ws + WS_BONUS);
    bf16* OR = (bf16*)(F.ws + WS_ORWKV);
    const float* lnw = F.in[15]; const float* lnb = F.in[16];
    const int gw = blockIdx.x * 8 + F.wave, NGW = F.G * 8;
    for (int row = gw; row < SEQ; row += NGW) { const int t = row + NMETA;
        for (int hd = 0; hd < RH; ++hd) { const int c = hd * 64 + F.lane; const size_t o = (size_t)t * RC + c;
            const float y = Y0[o] + Y1[o]; const float mean = wave_sum(y) * (1.0f / 64.0f); const float dlt = y - mean; const float var = wave_sum(dlt * dlt) * (1.0f / 64.0f);
            const float yn = dlt * (1.0f / sqrtf(var + GN_EPS)) * lnw[c] + lnb[c];
            const float outv = (yn + BON[(size_t)t * RH + hd] * bf2f(VV[o])) * bf2f(GG[o]);
            OR[(size_t)row * RC + c] = (bf16)f2bf(outv); } }
}
__device__ __forceinline__ void final_phase(Frame& F) {
    const float* SS3 = (const float*)(F.ctl + CW_SS3); const float* w = F.in[25];
    const int gw = blockIdx.x * 8 + F.wave, NGW = F.G * 8;
    for (int row = gw; row < SEQ; row += NGW) { const float rstd = 1.0f / sqrtf(SS3[row] * (1.0f / DM) + RMS_EPS);
        GAS f32x4* p = (GAS f32x4*)(F.out + (size_t)row * DM) + F.lane; const GAS f32x4* wp = (const GAS f32x4*)w + F.lane;
#pragma unroll
        for (int j = 0; j < 16; ++j) { const f32x4 v = p[64 * j], ww = wp[64 * j]; p[64 * j] = v * rstd * ww; } }
}
template <int WHICH> __device__ __forceinline__ void convert_late(Frame& F) {
    LAS float* scr = (LAS float*)(F.lds + 49152 + F.wave * 8448);
    const int gw = blockIdx.x * 8 + F.wave, NGW = F.G * 8;
    if (WHICH == 0) {
        constexpr int I_P = (ATTW / 64) * (DM / 32), I_O = (DM / 64) * (DM / 32);
        for (int it = gw; it < 2 * I_P + I_O; it += NGW) { int r = it;
            if (r < I_P) { transpose_item<0>(F.in[18], ATTW, DM, (bf16*)(F.ws + WS_WPA), scr, r, F.lane, nullptr); continue; } r -= I_P;
            if (r < I_P) { transpose_item<0>(F.in[19], RC, DM, (bf16*)(F.ws + WS_WPR), scr, r, F.lane, nullptr); continue; } r -= I_P;
            transpose_item<0>(F.in[20], DM, DM, (bf16*)(F.ws + WS_WOUT), scr, r, F.lane, nullptr); }
    } else {
        constexpr int I_D = (DFF / 64) * (DM / 32);
        for (int it = gw; it < I_D; it += NGW) transpose_item<0>(F.in[24], DFF, DM, (bf16*)(F.ws + WS_WD), scr, it, F.lane, nullptr);
    }
}

constexpr int N_PHASES = 10;
struct Args { const float* in[26]; float* out; unsigned char* ws; int ph_lo, ph_hi; };
__global__ void __launch_bounds__(512, 2) fwd_kernel(Args args) {
    extern __shared__ __attribute__((aligned(16))) unsigned char lds[];
    Frame F;
    F.lds = (LAS unsigned char*)lds;
    F.MISC = (volatile LAS unsigned*)(F.lds + MISC_OFF);
    F.tid = threadIdx.x; F.lane = F.tid & 63; F.wave = __builtin_amdgcn_readfirstlane(F.tid >> 6); F.G = gridDim.x;
    F.ws = args.ws; F.ctl = (gu32*)(args.ws + WS_CTL); F.out = args.out;
#pragma unroll
    for (int i = 0; i < 26; ++i) F.in[i] = args.in[i];
    for (int u = F.tid; u < (LDS_BYTES - LDSCTL_OFF) / 4; u += 512) ((LAS unsigned*)(F.lds + LDSCTL_OFF))[u] = 0u;
    __syncthreads();
    XcdBarrier bar; bar.bar = (unsigned*)(F.ctl + CW_BAR); bar.x = 0; bar.st = nullptr;
    if (!MK_SPLIT) bar = xcd_barrier_post((unsigned*)(F.ctl + CW_BAR), F.MISC + 8);
    const int lo = args.ph_lo, hi = args.ph_hi;
#define IN(k) (lo <= (k) && (k) < hi)
#define SEAM(k) do { if (IN(k) && IN((k) + 1)) xcd_barrier(bar); } while (0)
    bf16* Rm = (bf16*)(F.ws + WS_H);
    float* SS2 = (float*)(F.ctl + CW_SS2); float* SS3 = (float*)(F.ctl + CW_SS3);

    if (IN(0)) { p0_prologue(F); } SEAM(0);
    if (IN(1)) {
        pg8::Gemm g{Rm, Rm, MPAD + INWP, MPAD + INWP, DM}; pg8::InOrder S; S.init(F.G, (int)blockIdx.x);
        pg8::EpiIn E{(bf16*)(F.ws + WS_G), (bf16*)(F.ws + WS_Q), (bf16*)(F.ws + WS_K), (bf16*)(F.ws + WS_VT), (bf16*)(F.ws + WS_U), F.in[4], (const float*)(F.ws + WS_ROPE)};
        pg8::gemm_phase<pg8::EpiIn, pg8::InOrder, true, true>(F.lds, g, S, E);
    } SEAM(1);
    if (IN(2)) { attn_phase(F); prep_phase(F); convert_late<0>(F); } SEAM(2);
    if (IN(3)) { scan_phase(F); } SEAM(3);
    if (IN(4)) { combine_phase(F); convert_late<1>(F); } SEAM(4);
    if (IN(5)) {
        { pg8::Gemm g{(const bf16*)(F.ws + WS_OATT), (const bf16*)(F.ws + WS_WPA), SEQ, DM, ATTW}; pg8::StaticOrder S; S.init(SEQ, DM, F.G, (int)blockIdx.x);
          pg8::EpiProjA E{(float*)(F.ws + WS_P1), (const bf16*)(F.ws + WS_G)};
          pg8::gemm_phase<pg8::EpiProjA, pg8::StaticOrder, true, true>(F.lds, g, S, E); }
        __syncthreads();
        { pg8::Gemm g{(const bf16*)(F.ws + WS_ORWKV), (const bf16*)(F.ws + WS_WPR), SEQ, DM, RC}; pg8::StaticOrder S; S.init(SEQ, DM, F.G, (int)blockIdx.x);
          pg8::EpiProjB E{(const float*)(F.ws + WS_P1), (const bf16*)(F.ws + WS_G), (bf16*)(F.ws + WS_MX)};
          pg8::gemm_phase<pg8::EpiProjB, pg8::StaticOrder, true, true>(F.lds, g, S, E); }
    } SEAM(5);
    if (IN(6)) {
        pg8::Gemm g{(const bf16*)(F.ws + WS_MX), (const bf16*)(F.ws + WS_WOUT), SEQ, DM, DM}; pg8::StaticOrder S; S.init(SEQ, DM, F.G, (int)blockIdx.x);
        pg8::EpiResid<true> E{F.in[0], (float*)(F.ws + WS_H2), (bf16*)(F.ws + WS_A2), SS2};
        pg8::gemm_phase<pg8::EpiResid<true>, pg8::StaticOrder, true, true>(F.lds, g, S, E);
    } SEAM(6);
    if (IN(7)) {
        pg8::Gemm g{(const bf16*)(F.ws + WS_A2), (const bf16*)(F.ws + WS_WGU), SEQ, 2 * DFF, DM}; pg8::StaticOrder S; S.init(SEQ, 2 * DFF, F.G, (int)blockIdx.x);
        pg8::EpiSwiGLU E{(bf16*)(F.ws + WS_HID), SS2};
        pg8::gemm_phase<pg8::EpiSwiGLU, pg8::StaticOrder, true, true>(F.lds, g, S, E);
    } SEAM(7);
    if (IN(8)) {
        pg8::Gemm g{(const bf16*)(F.ws + WS_HID), (const bf16*)(F.ws + WS_WD), SEQ, DM, DFF}; pg8::StaticOrder S; S.init(SEQ, DM, F.G, (int)blockIdx.x);
        pg8::EpiResid<false> E{(const float*)(F.ws + WS_H2), F.out, nullptr, SS3};
        pg8::gemm_phase<pg8::EpiResid<false>, pg8::StaticOrder, true, true>(F.lds, g, S, E);
    } SEAM(8);
    if (IN(9)) { final_phase(F); }
#undef IN
#undef SEAM
}

extern "C" void kernel_launch(void* const* d_in, const int* in_sizes, int n_in, void* d_out, int out_size, void* d_ws, size_t ws_size, hipStream_t stream) {
    static int grid = 0;
    if (grid == 0) {
        if (n_in != 26 || out_size != SEQ * DM || ws_size < WS_END) { fprintf(stderr, "kernel_launch: unexpected shapes (n_in %d, out %d, ws %zu, need %zu); nothing launched\n", n_in, out_size, ws_size, (size_t)WS_END); grid = -1; return; }
        int dev = 0, cus = 0, per_cu = 0;
        if (hipGetDevice(&dev) != hipSuccess || hipDeviceGetAttribute(&cus, hipDeviceAttributeMultiprocessorCount, dev) != hipSuccess) { grid = -1; return; }
        if (hipFuncSetAttribute((const void*)fwd_kernel, hipFuncAttributeMaxDynamicSharedMemorySize, LDS_BYTES) != hipSuccess) { fprintf(stderr, "kernel_launch: hipFuncSetAttribute failed\n"); grid = -1; return; }
        if (hipOccupancyMaxActiveBlocksPerMultiprocessor(&per_cu, (const void*)fwd_kernel, 512, LDS_BYTES) != hipSuccess || per_cu < 1) fprintf(stderr, "kernel_launch: occupancy query says %d per CU\n", per_cu);
        (void)hipGetLastError();
        grid = cus;
    }
    if (grid < 0) return;
    if (hipMemsetAsync((char*)d_ws + WS_CTL, 0, CTL_ZERO_BYTES, stream) != hipSuccess) return;
    Args a{};
    for (int i = 0; i < 26; ++i) a.in[i] = (const float*)d_in[i];
    a.out = (float*)d_out; a.ws = (unsigned char*)d_ws;
#if MK_SPLIT
    for (int p = 0; p < N_PHASES; ++p) { a.ph_lo = p; a.ph_hi = p + 1; hipLaunchKernelGGL(fwd_kernel, dim3(grid), dim3(512), LDS_BYTES, stream, a); }
#else
    a.ph_lo = 0; a.ph_hi = N_PHASES;
    hipLaunchKernelGGL(fwd_kernel, dim3(grid), dim3(512), LDS_BYTES, stream, a);
#endif
}
```

```cpp
#include <hip/hip_runtime.h>
#include <cstdio>
#include <cstdint>

#ifndef MK_SPLIT
#define MK_SPLIT 0
#endif

#ifndef PROBE_PHASE
#define PROBE_PHASE 0
#endif
#ifndef PROBE_MULT
#define PROBE_MULT 2
#endif
constexpr int NMETA = 16, SEQ = 8192, LTOK = 8208, DM = 4096, MPAD = 8448;
constexpr int INW = 18048, INWP = 18176;
constexpr int ATTW = 2048, KVW = 512, UW = 6784, UPITCH = 6912;
constexpr int RC = 2048, RH = 32, RN = 64;
constexpr int DFF = 11008;
constexpr float RMS_EPS = 1e-6f, GN_EPS = 64e-5f;
constexpr int HT = MPAD / 256;
constexpr int CT_Q = 32, CT_K = 40, CT_V = 42, CT_U = 44, CT_N = 71;

namespace pg8 {
#define PG8_LAS __attribute__((address_space(3)))
typedef unsigned short bf16_t;
typedef short bf16x8 __attribute__((ext_vector_type(8)));
typedef float f32x4 __attribute__((ext_vector_type(4)));
typedef unsigned u32x4 __attribute__((ext_vector_type(4)));
constexpr int BM = 256, BK = 64, HALF = 128, HTB = HALF * BK * 2  , STAGE_BYTES = 8 * HTB, NXCD = 8, WGM = 8;

__host__ __device__ __forceinline__ int lds_byte(int r, int c) { const int st = (r >> 4) * 2 + (c >> 5), rr = r & 15, cc = c & 31, ob = rr * 64 + cc * 2; return st * 1024 + (ob ^ (((ob >> 9) & 1) << 5)); }
__host__ __device__ __forceinline__ void stage_rc(int b, int& R, int& C) { const int st = b / 1024, sb = b % 1024, swz = sb ^ (((sb >> 9) & 1) << 5); R = (st >> 1) * 16 + swz / 64; C = (st & 1) * 32 + (swz % 64) / 2; }
__host__ __device__ __forceinline__ int perm32(int rho) { const int n = rho >> 4, i = rho & 15; return 8 * (i >> 2) + 4 * n + (i & 3); }

struct Unit { int pm, pn; };
struct Gemm { const bf16_t* A; const bf16_t* Bt; int M, N, K; };

struct StaticOrder {
    int nM, nN, nwg, G, c;
    __host__ __device__ void init(int M, int N, int G_, int c_) { nM = M / BM; nN = N / BM; nwg = nM * nN; G = G_; c = c_; }
    __host__ __device__ bool next(int i, Unit& u) const {
        const long L = (long)i * G + c; if (L >= nwg) return false;
        int wgid = (int)L; { const int q = nwg / NXCD, r = nwg % NXCD, xcd = wgid % NXCD, off = wgid / NXCD; wgid = (xcd < r ? xcd * (q + 1) : r * (q + 1) + (xcd - r) * q) + off; }
        const int nig = WGM * nN, gid = wgid / nig, fm = gid * WGM, gsz = (nM - fm) < WGM ? (nM - fm) : WGM;
        u.pm = fm + ((wgid % nig) % gsz); u.pn = (wgid % nig) / gsz; return true;
    }
    __device__ __forceinline__ void a_ready(const Unit&) const {}
    __device__ __forceinline__ void done(const Unit&) const {}
};

__device__ __forceinline__ unsigned cvt_pk_bf16(float lo, float hi) { unsigned r; asm volatile("v_cvt_pk_bf16_f32 %0, %1, %2" : "=v"(r) : "v"(lo), "v"(hi)); return r; }

typedef unsigned u32x2 __attribute__((ext_vector_type(2)));
__device__ __forceinline__ float bflo(unsigned w) { return __uint_as_float(w << 16); }
__device__ __forceinline__ float bfhi(unsigned w) { return __uint_as_float(w & 0xffff0000u); }
__device__ __forceinline__ float sigmoidf_(float x) { return 1.0f / (1.0f + __expf(-x)); }

struct InOrder {
    StaticOrder base; int G, c;
    __device__ void init(int G_, int c_) { base.init(SEQ, INWP, G_, c_); G = G_; c = c_; }
    __device__ bool next(int i, Unit& u) const {
        const long L = (long)i * G + c;
        if (L < base.nwg) {
            base.next(i, u);
            if (u.pn >= CT_V && u.pn < CT_U) { const int e = (u.pn - CT_V) * 32 + u.pm; u.pm = HT + CT_V + e / HT; u.pn = e % HT; }
            else u.pn += HT;
            return true;
        }
        const int x = (int)(L - base.nwg);
        if (x >= 31) return false;
        if (x < 2) { const int e = 64 + x; u.pm = HT + CT_V + e / HT; u.pn = e % HT; }
        else { const int y = x - 2; u.pm = 32; u.pn = HT + (y < 2 ? CT_K + y : CT_U + (y - 2)); }
        return true;
    }
    __device__ __forceinline__ void a_ready(const Unit&) const {}
    __device__ __forceinline__ void done(const Unit&) const {}
};

struct EpiIn {
    static constexpr bool PERM = true, AFTER_DRAIN = false;
    bf16_t *G, *Q, *K, *Vt, *U; const float* bgate; const float* rope;
    __device__ __forceinline__ static void st8(bf16_t* p, const f32x4& v0, const f32x4& v1) {
        u32x4 w; w.x = cvt_pk_bf16(v0[0], v0[1]); w.y = cvt_pk_bf16(v0[2], v0[3]); w.z = cvt_pk_bf16(v1[0], v1[1]); w.w = cvt_pk_bf16(v1[2], v1[3]); *(u32x4*)p = w; }
    __device__ __forceinline__ void plain(const f32x4 (&acc)[2][2][4][2], bf16_t* base, int ldc, int row0, int col0) const {
#pragma unroll
        for (int ai = 0; ai < 2; ++ai)
#pragma unroll
            for (int m = 0; m < 4; ++m) { bf16_t* rowp = base + (size_t)(row0 + ai * HALF + m * 16) * ldc + col0;
#pragma unroll
                for (int bj = 0; bj < 2; ++bj) st8(rowp + bj * HALF, acc[ai][bj][m][0], acc[ai][bj][m][1]); }
    }
    __device__ __forceinline__ void roped(const f32x4 (&acc)[2][2][4][2], bf16_t* base, int ldc, int row0, int col0, int wc, int fq) const {
        if (wc != 0) { plain(acc, base, ldc, row0, col0); return; }
        const float sgn = (fq < 2) ? -1.0f : 1.0f;
#pragma unroll
        for (int ai = 0; ai < 2; ++ai)
#pragma unroll
            for (int m = 0; m < 4; ++m) { const int row = row0 + ai * HALF + m * 16; const int pos = row < SEQ ? row + NMETA : row - SEQ;
                const f32x4* cs = (const f32x4*)(rope + (size_t)pos * 32 + 16 * (fq & 1));
                const f32x4 c0 = cs[0], c1 = cs[1], c2 = cs[2], c3 = cs[3];
                const float cw[8] = {c0[0], c0[2], c1[0], c1[2], c2[0], c2[2], c3[0], c3[2]}, sw[8] = {c0[1], c0[3], c1[1], c1[3], c2[1], c2[3], c3[1], c3[3]};
                bf16_t* rowp = base + (size_t)row * ldc + col0;
#pragma unroll
                for (int bj = 0; bj < 2; ++bj) { f32x4 v0 = acc[ai][bj][m][0], v1 = acc[ai][bj][m][1], o0, o1;
#pragma unroll
                    for (int e = 0; e < 4; ++e) { const float p0 = __shfl_xor(v0[e], 32), p1 = __shfl_xor(v1[e], 32);
                        o0[e] = v0[e] * cw[e] + sgn * p0 * sw[e]; o1[e] = v1[e] * cw[4 + e] + sgn * p1 * sw[4 + e]; }
                    st8(rowp + bj * HALF, o0, o1); } }
    }
    __device__ __forceinline__ void operator()(const f32x4 (&acc)[2][2][4][2], const Unit& u, int wr, int wc, int fr, int fq) const {
        if (u.pm >= HT) {
            plain(acc, Vt, MPAD, (u.pm - HT - CT_V) * BM + wr * 64 + fr, u.pn * BM + wc * 32 + 8 * fq); return; }
        const int ct = u.pn - HT, row0 = u.pm * BM + wr * 64 + fr, cl = wc * 32 + 8 * fq;
        if (ct < CT_Q) {
            const int col0 = ct * BM + cl;
#pragma unroll
            for (int bj = 0; bj < 2; ++bj) { const f32x4 b0 = *(const f32x4*)(bgate + col0 + bj * HALF), b1 = *(const f32x4*)(bgate + col0 + bj * HALF + 4);
#pragma unroll
                for (int ai = 0; ai < 2; ++ai)
#pragma unroll
                    for (int m = 0; m < 4; ++m) { f32x4 v0 = acc[ai][bj][m][0] + b0, v1 = acc[ai][bj][m][1] + b1;
#pragma unroll
                        for (int e = 0; e < 4; ++e) { v0[e] = sigmoidf_(v0[e]); v1[e] = sigmoidf_(v1[e]); }
                        st8(G + (size_t)(row0 + ai * HALF + m * 16) * (2 * DM) + col0 + bj * HALF, v0, v1); } }
        } else if (ct < CT_K) { roped(acc, Q, ATTW, row0, (ct - CT_Q) * BM + cl, wc, fq);
        } else if (ct < CT_V) { roped(acc, K, KVW, row0, (ct - CT_K) * BM + cl, wc, fq);
        } else { plain(acc, U, UPITCH, row0, (ct - CT_U) * BM + cl); }
    }
};

struct EpiProjA {
    static constexpr bool PERM = true, AFTER_DRAIN = false;
    float* P1; const bf16_t* G;
    __device__ __forceinline__ void operator()(const f32x4 (&acc)[2][2][4][2], const Unit& u, int wr, int wc, int fr, int fq) const {
        const int row0 = u.pm * BM + wr * 64 + fr, col0 = u.pn * BM + wc * 32 + 8 * fq;
#pragma unroll
        for (int ai = 0; ai < 2; ++ai)
#pragma unroll
            for (int m = 0; m < 4; ++m) { const size_t r = (size_t)(row0 + ai * HALF + m * 16);
#pragma unroll
                for (int bj = 0; bj < 2; ++bj) { const int c = col0 + bj * HALF; const u32x4 g = *(const u32x4*)(G + r * (2 * DM) + c);
                    f32x4 o0 = acc[ai][bj][m][0], o1 = acc[ai][bj][m][1];
                    o0[0] *= bflo(g.x); o0[1] *= bfhi(g.x); o0[2] *= bflo(g.y); o0[3] *= bfhi(g.y); o1[0] *= bflo(g.z); o1[1] *= bfhi(g.z); o1[2] *= bflo(g.w); o1[3] *= bfhi(g.w);
                    float* p = P1 + r * DM + c; *(f32x4*)p = o0; *(f32x4*)(p + 4) = o1; } }
    }
};
struct EpiProjB {
    static constexpr bool PERM = true, AFTER_DRAIN = false;
    const float* P1; const bf16_t* G; bf16_t* MX;
    __device__ __forceinline__ void operator()(const f32x4 (&acc)[2][2][4][2], const Unit& u, int wr, int wc, int fr, int fq) const {
        const int row0 = u.pm * BM + wr * 64 + fr, col0 = u.pn * BM + wc * 32 + 8 * fq;
#pragma unroll
        for (int ai = 0; ai < 2; ++ai)
#pragma unroll
            for (int m = 0; m < 4; ++m) { const size_t r = (size_t)(row0 + ai * HALF + m * 16);
#pragma unroll
                for (int bj = 0; bj < 2; ++bj) { const int c = col0 + bj * HALF; const u32x4 g = *(const u32x4*)(G + r * (2 * DM) + DM + c);
                    const float* p = P1 + r * DM + c; f32x4 o0 = *(const f32x4*)p, o1 = *(const f32x4*)(p + 4); const f32x4 a0 = acc[ai][bj][m][0], a1 = acc[ai][bj][m][1];
                    o0[0] += a0[0] * bflo(g.x); o0[1] += a0[1] * bfhi(g.x); o0[2] += a0[2] * bflo(g.y); o0[3] += a0[3] * bfhi(g.y);
                    o1[0] += a1[0] * bflo(g.z); o1[1] += a1[1] * bfhi(g.z); o1[2] += a1[2] * bflo(g.w); o1[3] += a1[3] * bfhi(g.w);
                    EpiIn::st8(MX + r * DM + c, o0, o1); }
                asm volatile("" ::: "memory"); }
    }
};
template <bool COPY> struct EpiResid {
    static constexpr bool PERM = true, AFTER_DRAIN = false;
    const float* BASE; float* OUT; bf16_t* CP; float* SS;
    __device__ __forceinline__ void operator()(const f32x4 (&acc)[2][2][4][2], const Unit& u, int wr, int wc, int fr, int fq) const {
        const int row0 = u.pm * BM + wr * 64 + fr, col0 = u.pn * BM + wc * 32 + 8 * fq;
#pragma unroll
        for (int ai = 0; ai < 2; ++ai)
#pragma unroll
            for (int m = 0; m < 4; ++m) { const size_t r = (size_t)(row0 + ai * HALF + m * 16); float ss = 0.f;
#pragma unroll
                for (int bj = 0; bj < 2; ++bj) { const int c = col0 + bj * HALF; const float* bp = BASE + r * DM + c;
                    const f32x4 o0 = *(const f32x4*)bp + acc[ai][bj][m][0], o1 = *(const f32x4*)(bp + 4) + acc[ai][bj][m][1];
                    ss += (o0[0] * o0[0] + o0[1] * o0[1]) + (o0[2] * o0[2] + o0[3] * o0[3]) + (o1[0] * o1[0] + o1[1] * o1[1]) + (o1[2] * o1[2] + o1[3] * o1[3]);
                    float* op = OUT + r * DM + c; *(f32x4*)op = o0; *(f32x4*)(op + 4) = o1;
                    if (COPY) EpiIn::st8(CP + r * DM + c, o0, o1); }
                ss += __shfl_xor(ss, 16); ss += __shfl_xor(ss, 32);
                if (fq == 0) atomicAdd(SS + r, ss);
                asm volatile("" ::: "memory"); }
    }
};
struct EpiSwiGLU {
    static constexpr bool PERM = true, AFTER_DRAIN = false;
    bf16_t* HID; const float* SS;
    __device__ __forceinline__ void operator()(const f32x4 (&acc)[2][2][4][2], const Unit& u, int wr, int wc, int fr, int fq) const {
        const int row0 = u.pm * BM + wr * 64 + fr, col0 = u.pn * HALF + wc * 32 + 8 * fq;
#pragma unroll
        for (int ai = 0; ai < 2; ++ai)
#pragma unroll
            for (int m = 0; m < 4; ++m) { const size_t r = (size_t)(row0 + ai * HALF + m * 16);
                const float rstd = 1.0f / sqrtf(SS[r] * (1.0f / DM) + RMS_EPS);
                f32x4 o0, o1;
#pragma unroll
                for (int e = 0; e < 4; ++e) { const float g0 = acc[ai][0][m][0][e] * rstd, u0 = acc[ai][1][m][0][e] * rstd, g1 = acc[ai][0][m][1][e] * rstd, u1 = acc[ai][1][m][1][e] * rstd;
                    o0[e] = g0 * sigmoidf_(g0) * u0; o1[e] = g1 * sigmoidf_(g1) * u1; }
                EpiIn::st8(HID + r * DFF + col0, o0, o1); }
    }
};

template <class Epi, class Sched, bool ALIGN_EPI = false, bool SP2 = false>
__device__ __forceinline__ void gemm_phase(PG8_LAS unsigned char* lds, const Gemm g, const Sched& S, const Epi& E) {
    const int tid = threadIdx.x, wid = __builtin_amdgcn_readfirstlane(tid >> 6), lane = tid & 63, wr = wid >> 2, wc = wid & 3, fr = lane & 15, fq = lane >> 4;
    const int K = g.K, nt = K / BK;
    unsigned voffA[2], voffB[2];
#pragma unroll
    for (int i = 0; i < 2; ++i) { int R, C; stage_rc(tid * 16 + i * 8192, R, C); const int Rb = Epi::PERM ? ((R & ~31) + perm32(R & 31)) : R;
        voffA[i] = (unsigned)(R * K + C) * 2u; voffB[i] = (unsigned)(Rb * K + C) * 2u; }
    const size_t kstep = (size_t)(BK * 2);
    const size_t hstep = (size_t)HALF * K * 2;
    const size_t tstep = 2 * hstep;
    const unsigned ldsw = (unsigned)wid * 1024u;
    const int aoff = lds_byte(wr * 64 + fr, fq * 8), boff = lds_byte(wc * 32 + fr, fq * 8);
#define PG8_SA(b, h) (((b) * 2 + (h)) * HTB)
#define PG8_SB(b, h) ((4 + (b) * 2 + (h)) * HTB)
#define PG8_STAGE(bufoff, gbase, voff) do { _Pragma("unroll") for (int _i = 0; _i < 2; ++_i) \
        __builtin_amdgcn_global_load_lds((const unsigned*)((const char*)(gbase) + (voff)[_i]), (PG8_LAS unsigned*)(lds + (bufoff) + ldsw + _i * 8192), 16, 0, 0); } while (0)
#define PG8_LDA(dst, b, h) do { _Pragma("unroll") for (int m = 0; m < 4; ++m) _Pragma("unroll") for (int k = 0; k < 2; ++k) dst[m][k] = *(const PG8_LAS bf16x8*)(lds + PG8_SA(b, h) + aoff + m * 2048 + k * 1024); } while (0)
#define PG8_LDB(dst, b, h) do { _Pragma("unroll") for (int n = 0; n < 2; ++n) _Pragma("unroll") for (int k = 0; k < 2; ++k) dst[n][k] = *(const PG8_LAS bf16x8*)(lds + PG8_SB(b, h) + boff + n * 2048 + k * 1024); } while (0)
#define PG8_MMA(ai, bj, At, Bt) do { __builtin_amdgcn_s_setprio(1); _Pragma("unroll") for (int m = 0; m < 4; ++m) _Pragma("unroll") for (int n = 0; n < 2; ++n) _Pragma("unroll") for (int k = 0; k < 2; ++k) \
        acc[ai][bj][m][n] = __builtin_amdgcn_mfma_f32_16x16x32_bf16(Bt[n][k], At[m][k], acc[ai][bj][m][n], 0, 0, 0); __builtin_amdgcn_s_setprio(0); } while (0)
#define PG8_WAIT_V(n) asm volatile("s_waitcnt vmcnt(" #n ")" ::: "memory")
#define PG8_WAIT_L(n) asm volatile("s_waitcnt lgkmcnt(" #n ")" ::: "memory")
#define PG8_BAR __builtin_amdgcn_s_barrier()
#define PG8_SCHED __builtin_amdgcn_sched_barrier(0)
    Unit cur, nxt; int ui = 0;
    if (!S.next(0, cur)) return;
    f32x4 acc[2][2][4][2];
#pragma unroll
    for (int a = 0; a < 2; ++a)
#pragma unroll
        for (int b = 0; b < 2; ++b)
#pragma unroll
            for (int m = 0; m < 4; ++m)
#pragma unroll
                for (int n = 0; n < 2; ++n) acc[a][b][m][n] = (f32x4){0.f, 0.f, 0.f, 0.f};
    bf16x8 At[4][2], B0[2][2], B1[2][2];
    const char* cA = (const char*)g.A + (size_t)cur.pm * tstep; const char* cB = (const char*)g.Bt + (size_t)cur.pn * tstep;
    S.a_ready(cur);
    if constexpr (SP2) {
        PG8_STAGE(PG8_SB(0, 0), cB, voffB); PG8_STAGE(PG8_SB(0, 1), cB + hstep, voffB); PG8_STAGE(PG8_SA(0, 0), cA, voffA); PG8_STAGE(PG8_SA(0, 1), cA + hstep, voffA);
        if (wr == 1) PG8_BAR;
        PG8_WAIT_V(2); PG8_BAR;
        PG8_STAGE(PG8_SB(1, 0), cB + kstep, voffB); PG8_STAGE(PG8_SA(1, 0), cA + kstep, voffA); PG8_STAGE(PG8_SB(1, 1), cB + hstep + kstep, voffB);
        PG8_WAIT_V(6); PG8_BAR;
    } else {
        PG8_STAGE(PG8_SB(0, 0), cB, voffB); PG8_STAGE(PG8_SA(0, 0), cA, voffA); PG8_STAGE(PG8_SB(0, 1), cB + hstep, voffB); PG8_STAGE(PG8_SA(0, 1), cA + hstep, voffA);
        if (wr == 1) PG8_BAR;
        PG8_WAIT_V(4); PG8_BAR;
        PG8_STAGE(PG8_SB(1, 0), cB + kstep, voffB); PG8_STAGE(PG8_SA(1, 0), cA + kstep, voffA); PG8_STAGE(PG8_SB(1, 1), cB + hstep + kstep, voffB);
        PG8_WAIT_V(6); PG8_BAR;
    }
    for (;;) {
        const bool has_next = S.next(ui + 1, nxt);
        const char* nA = has_next ? (const char*)g.A + (size_t)nxt.pm * tstep : cA; const char* nB = has_next ? (const char*)g.Bt + (size_t)nxt.pn * tstep : cB;
        for (int t = 0; t < nt; t += 2) {
            const bool last = (t == nt - 2);
            const char* a1 = cA + (size_t)(t + 1) * kstep;
            const char* a2 = last ? nA : cA + (size_t)(t + 2) * kstep; const char* b2 = last ? nB : cB + (size_t)(t + 2) * kstep;
            const char* a3 = a2 + kstep; const char* b3 = b2 + kstep;
            if (last && has_next) S.a_ready(nxt);
            if constexpr (SP2) {
            PG8_LDB(B0, 0, 0); PG8_LDB(B1, 0, 1); PG8_SCHED; PG8_LDA(At, 0, 0); PG8_STAGE(PG8_SA(1, 1), a1 + hstep, voffA);
            PG8_WAIT_V(8); PG8_WAIT_L(0); PG8_BAR; PG8_MMA(0, 0, At, B0); PG8_MMA(0, 1, At, B1); PG8_BAR; PG8_SCHED;
            PG8_LDA(At, 0, 1); PG8_STAGE(PG8_SB(0, 0), b2, voffB); PG8_STAGE(PG8_SB(0, 1), b2 + hstep, voffB); PG8_STAGE(PG8_SA(0, 0), a2, voffA);
            PG8_WAIT_V(8); PG8_WAIT_L(0); PG8_BAR; PG8_MMA(1, 0, At, B0); PG8_MMA(1, 1, At, B1); PG8_BAR; PG8_SCHED;
            PG8_LDB(B0, 1, 0); PG8_LDB(B1, 1, 1); PG8_SCHED; PG8_LDA(At, 1, 0); PG8_STAGE(PG8_SA(0, 1), a2 + hstep, voffA);
            PG8_WAIT_V(8); PG8_WAIT_L(0); PG8_BAR; PG8_MMA(0, 0, At, B0); PG8_MMA(0, 1, At, B1); PG8_BAR; PG8_SCHED;
            PG8_LDA(At, 1, 1); PG8_STAGE(PG8_SB(1, 0), b3, voffB); PG8_STAGE(PG8_SB(1, 1), b3 + hstep, voffB); PG8_STAGE(PG8_SA(1, 0), a3, voffA);
            PG8_WAIT_V(8); PG8_WAIT_L(0); PG8_BAR; PG8_MMA(1, 0, At, B0); PG8_MMA(1, 1, At, B1); PG8_BAR; PG8_SCHED;
            } else {
            PG8_LDB(B0, 0, 0); PG8_SCHED; PG8_LDA(At, 0, 0); PG8_STAGE(PG8_SA(1, 1), a1 + hstep, voffA);
            PG8_WAIT_L(8); PG8_BAR; PG8_WAIT_L(0); PG8_MMA(0, 0, At, B0); PG8_BAR; PG8_SCHED;
            PG8_LDB(B1, 0, 1); PG8_STAGE(PG8_SB(0, 0), b2, voffB);
            PG8_BAR; PG8_WAIT_L(0); PG8_MMA(0, 1, At, B1); PG8_BAR;
            PG8_LDA(At, 0, 1); PG8_STAGE(PG8_SA(0, 0), a2, voffA);
            PG8_BAR; PG8_WAIT_L(0); PG8_MMA(1, 0, At, B0); PG8_BAR; PG8_SCHED;
            PG8_STAGE(PG8_SB(0, 1), b2 + hstep, voffB);
            PG8_WAIT_V(6); PG8_BAR; PG8_MMA(1, 1, At, B1); PG8_BAR;
            PG8_LDB(B0, 1, 0); PG8_SCHED; PG8_LDA(At, 1, 0); PG8_STAGE(PG8_SA(0, 1), a2 + hstep, voffA);
            PG8_WAIT_L(8); PG8_BAR; PG8_WAIT_L(0); PG8_MMA(0, 0, At, B0); PG8_BAR; PG8_SCHED;
            PG8_LDB(B1, 1, 1); PG8_STAGE(PG8_SB(1, 0), b3, voffB);
            PG8_BAR; PG8_WAIT_L(0); PG8_MMA(0, 1, At, B1); PG8_BAR;
            PG8_LDA(At, 1, 1); PG8_STAGE(PG8_SA(1, 0), a3, voffA);
            PG8_BAR; PG8_WAIT_L(0); PG8_MMA(1, 0, At, B0); PG8_BAR; PG8_SCHED;
            PG8_STAGE(PG8_SB(1, 1), b3 + hstep, voffB);
            PG8_WAIT_V(6); PG8_BAR; PG8_MMA(1, 1, At, B1); PG8_BAR;
            }
        }
        if constexpr (ALIGN_EPI) { if (wr == 0) PG8_BAR; }
        if constexpr (!Epi::AFTER_DRAIN) { E(acc, cur, wr, wc, fr, fq); S.done(cur); }
        if (!has_next) break;
#pragma unroll
        for (int a = 0; a < 2; ++a)
#pragma unroll
            for (int b = 0; b < 2; ++b)
#pragma unroll
                for (int m = 0; m < 4; ++m)
#pragma unroll
                    for (int n = 0; n < 2; ++n) acc[a][b][m][n] = (f32x4){0.f, 0.f, 0.f, 0.f};
        cur = nxt; cA = nA; cB = nB; ++ui;
        if constexpr (ALIGN_EPI) { if (wr == 1) PG8_BAR; }
    }
    PG8_WAIT_V(0);
    if constexpr (!ALIGN_EPI) { if (wr == 0) PG8_BAR; }
    PG8_BAR;
    if constexpr (Epi::AFTER_DRAIN) { E.fused(acc, cur, wr, wc, fr, fq, lds, wid, lane); S.done(cur); }
#undef PG8_SA
#undef PG8_SB
#undef PG8_STAGE
#undef PG8_LDA
#undef PG8_LDB
#undef PG8_MMA
#undef PG8_WAIT_V
#undef PG8_WAIT_L
#undef PG8_BAR
#undef PG8_SCHED
}

}

constexpr size_t MiB = 1u << 20;
constexpr size_t WS_CTL = 0, CTL_ZERO_BYTES = 1 * MiB;
constexpr size_t WS_ROPE = 1 * MiB;
constexpr size_t WS_LW2 = 3 * MiB, WS_LA2 = 4 * MiB, WS_LG2 = 5 * MiB;
constexpr size_t WS_BONUS = 6 * MiB;
constexpr size_t WS_H = 8 * MiB, WS_WIN = WS_H + (size_t)MPAD * DM * 2;
constexpr size_t WS_WPA = 8 * MiB, WS_WPR = 24 * MiB, WS_WOUT = 40 * MiB, WS_OATT = 72 * MiB, WS_ORWKV = 104 * MiB, WS_GG = 136 * MiB;
constexpr size_t WS_G = 216 * MiB, WS_A2 = 216 * MiB;
constexpr size_t WS_Q = 344 * MiB, WS_K = 376 * MiB, WS_VT = 385 * MiB, WS_U = 394 * MiB;
constexpr size_t WS_Y = 344 * MiB, WS_P1 = 344 * MiB, WS_H2 = 344 * MiB, WS_MX = 474 * MiB;
constexpr size_t SCF = (size_t)LTOK * RC * 4, SCB = (size_t)LTOK * RC * 2;
constexpr size_t WS_W0 = 512 * MiB, WS_W1 = WS_W0 + SCF, WS_KD0 = WS_W1 + SCF, WS_KD1 = WS_KD0 + SCB, WS_B0 = WS_KD1 + SCB, WS_B1 = WS_B0 + SCB, WS_KK = WS_B1 + SCB, WS_RR = WS_KK + SCB, WS_VV = WS_RR + SCB, WS_SCEND = WS_VV + SCB;
constexpr size_t WS_WD = 538 * MiB, WS_HID = 640 * MiB;
constexpr size_t WS_WGU = 866 * MiB, WS_END = WS_WGU + (size_t)2 * DFF * DM * 2;
static_assert(WS_WIN + (size_t)INWP * DM * 2 <= WS_G, "map: R");
static_assert(WS_GG + SCB <= WS_G && WS_U + (size_t)MPAD * UPITCH * 2 <= WS_W0 && WS_VT + (size_t)KVW * MPAD * 2 <= WS_U && WS_K + (size_t)MPAD * KVW * 2 <= WS_VT, "map: P1 outputs");
static_assert(WS_Y + 2 * SCF <= WS_MX && WS_MX + (size_t)SEQ * DM * 2 <= WS_WD && WS_WD + (size_t)DM * DFF * 2 <= WS_HID && WS_W1 + SCF >= WS_WD + (size_t)DM * DFF * 2, "map: overlays");
static_assert(WS_SCEND <= WS_WGU && WS_HID + (size_t)SEQ * DFF * 2 <= WS_WGU && WS_VV >= WS_HID + 0, "map: scan arrays");
constexpr int CW_BAR = 4096;
constexpr int CW_SS2 = 65536, CW_SS3 = 65536 + 8192;
static_assert((CW_SS3 + 8192) * 4 <= (int)CTL_ZERO_BYTES, "CTL");

constexpr int RING_BYTES = 131072;
constexpr int LDSCTL_OFF = RING_BYTES, MISC_OFF = LDSCTL_OFF + 320;
constexpr int LDS_BYTES = 147456;

#define GAS __attribute__((address_space(1)))
#define LAS __attribute__((address_space(3)))
typedef unsigned short bf16;
typedef unsigned v4u __attribute__((ext_vector_type(4)));
typedef unsigned v2u __attribute__((ext_vector_type(2)));
typedef float f32x4 __attribute__((ext_vector_type(4)));
typedef float f32x2 __attribute__((ext_vector_type(2)));
typedef float f32x16 __attribute__((ext_vector_type(16)));
typedef short bf16x8 __attribute__((ext_vector_type(8)));
typedef GAS unsigned gu32;
#define RLX_AGENT __ATOMIC_RELAXED, __HIP_MEMORY_SCOPE_AGENT
#define LDS_WAIT() asm volatile("s_waitcnt lgkmcnt(0)" ::: "memory")
__device__ __forceinline__ unsigned f2bf(float f) { unsigned u = __builtin_bit_cast(unsigned, f); return (u + 0x7fffu + ((u >> 16) & 1u)) >> 16; }
__device__ __forceinline__ unsigned pk2(float lo, float hi) { return f2bf(lo) | (f2bf(hi) << 16); }
__device__ __forceinline__ float bf2f(bf16 b) { return __uint_as_float(((unsigned)b) << 16); }
using pg8::bflo; using pg8::bfhi; using pg8::sigmoidf_;

#define XB_TMO      128
#define XB_XCNT(j)  (256  + 64 * (j))
#define XB_XSUB(j)  (1280 + 64 * (j))
#define XB_XGEN(j)  (2304 + 64 * (j))
#define XB_TOP      3328
#define XB_TOPGEN   3392
#define XCD_BAR_WORDS 3456
#define XB_SPIN_CAP (1u << 18)

__device__ __forceinline__ unsigned xb_ld(unsigned* p)              { return __hip_atomic_load(p, __ATOMIC_RELAXED, __HIP_MEMORY_SCOPE_AGENT); }
__device__ __forceinline__ unsigned xb_add(unsigned* p, unsigned v) { return __hip_atomic_fetch_add(p, v, __ATOMIC_RELAXED, __HIP_MEMORY_SCOPE_AGENT); }
__device__ __forceinline__ unsigned xb_xcc_id() { return (unsigned)__builtin_amdgcn_s_getreg((3 << 11) | 20) & 0xFu; }
#define XB_SPIN(cond, bar) do { unsigned _sp = 0; while (cond) { __builtin_amdgcn_s_sleep(1); \
    if ((++_sp & 255u) == 0u) { if (xb_ld(&(bar)[XB_TMO])) break; if (_sp > XB_SPIN_CAP) { atomicAdd(&(bar)[XB_TMO], 1u); break; } } } } while (0)

struct XcdBarrier {
    unsigned* bar; unsigned x;
    volatile LAS unsigned* st;
};

__device__ __forceinline__ XcdBarrier xcd_barrier_post(unsigned* bar, volatile LAS unsigned* st) {
    XcdBarrier b; b.bar = bar; b.x = xb_xcc_id(); b.st = st;
    if (threadIdx.x == 0) (void)xb_add(&bar[XB_XCNT(b.x)], 1u);
    return b;
}
__device__ __forceinline__ void xcd_barrier_complete(unsigned* bar, unsigned x, unsigned& nloc, unsigned& nx) {
    const unsigned G = gridDim.x * gridDim.y * gridDim.z;
    unsigned sum, cnt, mine, sp = 0u;
    for (;;) {
        sum = 0u; cnt = 0u; mine = 0u;
#pragma unroll
        for (unsigned j = 0; j < 16; ++j) { const unsigned c = xb_ld(&bar[XB_XCNT(j)]); sum += c; cnt += (c > 0u) ? 1u : 0u; mine = (j == x) ? c : mine; }
        if (sum == G) break;
        __builtin_amdgcn_s_sleep(1);
        if ((++sp & 255u) == 0u) { if (xb_ld(&bar[XB_TMO])) break; if (sp > XB_SPIN_CAP) { atomicAdd(&bar[XB_TMO], 1u); break; } }
    }
    nloc = mine > 0u ? mine : 1u; nx = cnt > 0u ? cnt : 1u;
}

__device__ __forceinline__ void xcd_barrier(const XcdBarrier& b) {
    asm volatile("s_waitcnt vmcnt(0)" ::: "memory");
    __syncthreads();
    if (threadIdx.x == 0) {
        unsigned* bar = b.bar;
        __builtin_amdgcn_s_waitcnt(0);
        unsigned nloc = b.st[0], nx = b.st[1];
        if (nloc == 0u) { xcd_barrier_complete(bar, b.x, nloc, nx); b.st[0] = nloc; b.st[1] = nx; }
        const unsigned old = xb_add(&bar[XB_XSUB(b.x)], 1u);
        const unsigned gen = old / nloc;
        if (old + 1u == (gen + 1u) * nloc) {
            __builtin_amdgcn_fence(__ATOMIC_RELEASE, "agent");
            asm volatile("s_waitcnt vmcnt(0)" ::: "memory");
            const unsigned og = xb_add(&bar[XB_TOP], 1u);
            const unsigned tg = og / nx;
            if (og + 1u == (tg + 1u) * nx) xb_add(&bar[XB_TOPGEN], 1u);
            else XB_SPIN(xb_ld(&bar[XB_TOPGEN]) == tg, bar);
            __builtin_amdgcn_fence(__ATOMIC_ACQUIRE, "agent");
            xb_add(&bar[XB_XGEN(b.x)], 1u);
            asm volatile("s_waitcnt vmcnt(0)" ::: "memory");
        } else {
            XB_SPIN(xb_ld(&bar[XB_XGEN(b.x)]) == gen, bar);
            __builtin_amdgcn_fence(__ATOMIC_ACQUIRE, "agent");
            asm volatile("s_waitcnt vmcnt(0)" ::: "memory");
        }
    }
    __syncthreads();
}


struct Frame {
    LAS unsigned char* lds;
    volatile LAS unsigned* MISC;
    gu32* ctl;
    int tid, lane, wave, G;
    unsigned char* ws;
    const float* in[26];
    float* out;
    unsigned long long pb0, pacc;
};
#define FPB0(k) do { if ((PROBE_PHASE >> (k)) & 1) F.pb0 = __builtin_amdgcn_s_memrealtime(); } while (0)
#define FPB1(k) do { if ((PROBE_PHASE >> (k)) & 1) F.pacc += __builtin_amdgcn_s_memrealtime() - F.pb0; } while (0)
__device__ __forceinline__ float wave_sum(float v) {
#pragma unroll
    for (int o = 1; o < 64; o <<= 1) v += __shfl_xor(v, o);
    return v;
}

template <int MODE> __device__ __forceinline__ void transpose_item(const float* W, int K, int N, bf16* WT, LAS float* scr, int item, int lane, const float* kscale) {
    const int nblk = N / 32, kb = item / nblk, nb = item % nblk, k0 = 64 * kb, n0 = 32 * nb;
#pragma unroll 8
    for (int i = 0; i < 32; ++i) { const int kk = 2 * i + (lane >> 5); float v = W[(size_t)(k0 + kk) * N + n0 + (lane & 31)]; if (kscale) v *= kscale[k0 + kk]; scr[kk * 33 + (lane & 31)] = v; }
    LDS_WAIT(); asm volatile("" ::: "memory");
    const int c = lane & 7;
#pragma unroll
    for (int j = 0; j < 4; ++j) { const int n = (lane >> 3) + 8 * j; const LAS float* s = scr + (8 * c) * 33 + n;
        v4u o; o.x = pk2(s[0 * 33], s[1 * 33]); o.y = pk2(s[2 * 33], s[3 * 33]); o.z = pk2(s[4 * 33], s[5 * 33]); o.w = pk2(s[6 * 33], s[7 * 33]);
        const int nn = n0 + n; const int dr = (MODE == 0) ? nn : (256 * (nn >> 7) + (nn & 127) + (MODE == 2 ? 128 : 0));
        *(GAS v4u*)(WT + (size_t)dr * K + k0 + 8 * c) = o; }
    LDS_WAIT(); asm volatile("" ::: "memory");
}
__device__ __forceinline__ void rms_row_to_bf16(int lane, const float* xrow, const float* w, bf16* orow) {
    const GAS f32x4* xr = (const GAS f32x4*)xrow + lane;
    f32x4 v[16]; float s = 0.f;
#pragma unroll
    for (int j = 0; j < 16; ++j) { v[j] = xr[64 * j]; s += (v[j].x * v[j].x + v[j].y * v[j].y) + (v[j].z * v[j].z + v[j].w * v[j].w); }
    const float rstd = 1.f / sqrtf(wave_sum(s) * (1.f / DM) + RMS_EPS);
    const GAS f32x4* wr = (const GAS f32x4*)w + lane;
    GAS v2u* o8 = (GAS v2u*)orow + lane;
#pragma unroll
    for (int j = 0; j < 16; ++j) { const f32x4 ww = wr[64 * j]; v2u o; o.x = pk2(v[j].x * rstd * ww.x, v[j].y * rstd * ww.y); o.y = pk2(v[j].z * rstd * ww.z, v[j].w * rstd * ww.w); o8[64 * j] = o; }
}
__device__ const double ROPE_INV[16] = {
    1.0000000000000000000000000e+0,
    4.4036660267178047359198331e-1,
    1.9392274474868577334259386e-1,
    8.5397100285765611280149662e-2,
    3.7606030930863935681246092e-2,
    1.6560440080994445548947445e-2,
    7.2926647372171090477661219e-3,
    3.2114459947525910185434889e-3,
    1.4142135623730950488016887e-3,
    6.2277242191459597955502746e-4,
    2.7424817567620731825332265e-4,
    1.2076973741146503832424826e-4,
    5.3182958969449886162502429e-5,
    2.3419998961409341542188076e-5,
    1.0313385377212458859810127e-5,
    4.5416704806078696531998012e-6
};

__device__ __forceinline__ void p0_prologue(Frame& F) {
    LAS float* scr = (LAS float*)(F.lds + F.wave * 16384);
    const int gw = blockIdx.x * 8 + F.wave, NGW = F.G * 8;
    bf16* Wint = (bf16*)(F.ws + WS_WIN); bf16* Wgu = (bf16*)(F.ws + WS_WGU); bf16* H = (bf16*)(F.ws + WS_H);
    constexpr int I_IN = (DM / 64) * (INW / 32), I_GU = (DM / 64) * (DFF / 32);
    for (int it = gw; it < I_IN + 2 * I_GU; it += NGW) {
        int r = it;
        if (r < I_IN) { transpose_item<0>(F.in[3], DM, INW, Wint, scr, r, F.lane, nullptr); continue; } r -= I_IN;
        if (r < I_GU) { transpose_item<1>(F.in[22], DM, DFF, Wgu, scr, r, F.lane, F.in[21]); continue; } r -= I_GU;
        transpose_item<2>(F.in[23], DM, DFF, Wgu, scr, r, F.lane, F.in[21]);
    }
    for (int m = gw; m < MPAD + (INWP - INW); m += NGW) {
        if (m < SEQ) rms_row_to_bf16(F.lane, F.in[0] + (size_t)m * DM, F.in[2], H + (size_t)m * DM);
        else if (m < LTOK) rms_row_to_bf16(F.lane, F.in[1] + (size_t)(m - SEQ) * DM, F.in[2], H + (size_t)m * DM);
        else { bf16* row = (m < MPAD) ? H + (size_t)m * DM : Wint + (size_t)(INW + (m - MPAD)) * DM; GAS v4u* o = (GAS v4u*)row + F.lane;
#pragma unroll
            for (int j = 0; j < 8; ++j) o[64 * j] = (v4u){0u, 0u, 0u, 0u}; }
    }
    const int gt = blockIdx.x * 512 + F.tid, NGT = F.G * 512;
    float* rope = (float*)(F.ws + WS_ROPE);
    for (int i = gt; i < LTOK * 16; i += NGT) { const int pos = i >> 4, k = i & 15;
        const double ang = (double)pos * ROPE_INV[k]; const double kq = __builtin_rint(ang * 0.15915494309189535);
        const double red = (ang - kq * 6.28318530717958623) - kq * 2.4492935982947064e-16; const float rf = (float)red;
        rope[2 * i] = cosf(rf); rope[2 * i + 1] = sinf(rf); }
    bf16* w2t = (bf16*)(F.ws + WS_LW2); bf16* a2t = (bf16*)(F.ws + WS_LA2); bf16* g2t = (bf16*)(F.ws + WS_LG2);
    for (int i = gt; i < 2 * 96 * RC; i += NGT) { const int c = i % RC, j = (i / RC) % 96, d = i / (RC * 96);
        w2t[((size_t)d * RC + c) * 96 + j] = (bf16)f2bf(F.in[8][i]); a2t[((size_t)d * RC + c) * 96 + j] = (bf16)f2bf(F.in[10][i]); }
    for (int i = gt; i < 256 * RC; i += NGT) { const int c = i % RC, j = i / RC; g2t[(size_t)c * 256 + j] = (bf16)f2bf(F.in[11][i]); }
}

__device__ __forceinline__ int crow(int r, int hi) { return (r & 3) + 8 * (r >> 2) + 4 * hi; }
__device__ __forceinline__ void attn_phase(Frame& F) {
    const bf16* Q = (const bf16*)(F.ws + WS_Q); const bf16* K = (const bf16*)(F.ws + WS_K); const bf16* Vt = (const bf16*)(F.ws + WS_VT); bf16* OA = (bf16*)(F.ws + WS_OATT);
    const float* sink = F.in[17];
    const int gw = blockIdx.x * 8 + F.wave, NGW = F.G * 8, hh = F.lane >> 5, r = F.lane & 31;
    constexpr float SC = 0.08838834764831845f * 1.4426950408889634f, L2E = 1.4426950408889634f;
    for (int item = gw; item < 4096; item += NGW) {
        const int sub = item & 3, hq = (item >> 2) & 15, qb = item >> 6, q0 = qb * 128 + sub * 32, hk = hq >> 2;
        bf16x8 bq[8];
        { const bf16* qp = Q + (size_t)(q0 + r) * ATTW + hq * 128 + 8 * hh;
#pragma unroll
          for (int s = 0; s < 8; ++s) bq[s] = *(const bf16x8*)(qp + 16 * s); }
        f32x16 O[4];
#pragma unroll
        for (int dt = 0; dt < 4; ++dt)
#pragma unroll
            for (int i = 0; i < 16; ++i) O[dt][i] = 0.f;
        float m = sink[hq] * L2E, l = (hh == 0) ? 1.f : 0.f;
        for (int ti = 0; ti < 10; ++ti) {
            const bool meta = (ti == 9);
            const int key0 = meta ? SEQ : q0 + 32 * (ti - 4);
            if (key0 < 0 || (!meta && key0 >= SEQ)) continue;
            f32x16 st;
#pragma unroll
            for (int i = 0; i < 16; ++i) st[i] = 0.f;
            { const bf16* kp = K + (size_t)(key0 + r) * KVW + hk * 128 + 8 * hh;
#pragma unroll
              for (int s = 0; s < 8; ++s) { const bf16x8 ak = *(const bf16x8*)(kp + 16 * s); st = __builtin_amdgcn_mfma_f32_32x32x16_bf16(ak, bq[s], st, 0, 0, 0); } }
            float tmax = -__builtin_inff();
#pragma unroll
            for (int i = 0; i < 16; ++i) { const int kr = crow(i, hh); bool ok;
                if (meta) ok = kr < NMETA; else { const int dlt = (key0 + kr) - (q0 + r); ok = (dlt >= -128) && (dlt <= 128); }
                const float t = ok ? st[i] * SC : -__builtin_inff(); st[i] = t; tmax = fmaxf(tmax, t); }
            tmax = fmaxf(tmax, __shfl_xor(tmax, 32));
            const float mn = fmaxf(m, tmax), alpha = __builtin_amdgcn_exp2f(m - mn); m = mn;
            float ps = 0.f;
#pragma unroll
            for (int i = 0; i < 16; ++i) { const float p = __builtin_amdgcn_exp2f(st[i] - mn); st[i] = p; ps += p; }
            l = l * alpha + ps;
#pragma unroll
            for (int dt = 0; dt < 4; ++dt)
#pragma unroll
                for (int i = 0; i < 16; ++i) O[dt][i] *= alpha;
            bf16x8 pb[2];
#pragma unroll
            for (int s2 = 0; s2 < 2; ++s2) { v4u w; w.x = pg8::cvt_pk_bf16(st[8 * s2 + 0], st[8 * s2 + 1]); w.y = pg8::cvt_pk_bf16(st[8 * s2 + 2], st[8 * s2 + 3]);
                w.z = pg8::cvt_pk_bf16(st[8 * s2 + 4], st[8 * s2 + 5]); w.w = pg8::cvt_pk_bf16(st[8 * s2 + 6], st[8 * s2 + 7]); pb[s2] = __builtin_bit_cast(bf16x8, w); }
#pragma unroll
            for (int dt = 0; dt < 4; ++dt) { const bf16* vp = Vt + (size_t)(hk * 128 + 32 * dt + r) * MPAD + key0 + 4 * hh;
#pragma unroll
                for (int s2 = 0; s2 < 2; ++s2) { const v2u lo = *(const v2u*)(vp + 16 * s2), hi = *(const v2u*)(vp + 16 * s2 + 8);
                    const v4u w = {lo.x, lo.y, hi.x, hi.y}; O[dt] = __builtin_amdgcn_mfma_f32_32x32x16_bf16(__builtin_bit_cast(bf16x8, w), pb[s2], O[dt], 0, 0, 0); } }
        }
        l += __shfl_xor(l, 32);
        const float inv = 1.0f / l;
        bf16* op = OA + (size_t)(q0 + r) * ATTW + hq * 128 + 4 * hh;
#pragma unroll
        for (int dt = 0; dt < 4; ++dt)
#pragma unroll
            for (int g4 = 0; g4 < 4; ++g4) { v2u w; w.x = pg8::cvt_pk_bf16(O[dt][4 * g4 + 0] * inv, O[dt][4 * g4 + 1] * inv); w.y = pg8::cvt_pk_bf16(O[dt][4 * g4 + 2] * inv, O[dt][4 * g4 + 3] * inv);
                *(v2u*)(op + 32 * dt + 8 * g4) = w; }
    }
}

__device__ __forceinline__ int tok2row(int t) { return t < NMETA ? SEQ + t : t - NMETA; }
struct Sh8 { v4u uc, up, un; };
__device__ __forceinline__ Sh8 shift8_ld(const bf16* U, int t, int col) {
    const int tc = t < LTOK ? t : LTOK - 1, tp = (t >= 1 && t - 1 < LTOK) ? t - 1 : 0, tn = t + 1 < LTOK ? t + 1 : LTOK - 1;
    Sh8 s; s.uc = *(const v4u*)(U + (size_t)tok2row(tc) * UPITCH + col); s.up = *(const v4u*)(U + (size_t)tok2row(tp) * UPITCH + col); s.un = *(const v4u*)(U + (size_t)tok2row(tn) * UPITCH + col); return s; }
__device__ __forceinline__ void shift8_fin(const Sh8& s, int t, int col, const float* mu_p, const float* mu_n, float (&x)[8]) {
    const v4u zz = {0u, 0u, 0u, 0u};
    const v4u uc = t < LTOK ? s.uc : zz, up = (t >= 1 && t - 1 < LTOK) ? s.up : zz, un = t + 1 < LTOK ? s.un : zz;
    const f32x4 mp0 = *(const f32x4*)(mu_p + col), mp1 = *(const f32x4*)(mu_p + col + 4), mn0 = *(const f32x4*)(mu_n + col), mn1 = *(const f32x4*)(mu_n + col + 4);
    const unsigned ucw[4] = {uc.x, uc.y, uc.z, uc.w}, upw[4] = {up.x, up.y, up.z, up.w}, unw[4] = {un.x, un.y, un.z, un.w};
    const float mpw[8] = {mp0[0], mp0[1], mp0[2], mp0[3], mp1[0], mp1[1], mp1[2], mp1[3]}, mnw[8] = {mn0[0], mn0[1], mn0[2], mn0[3], mn1[0], mn1[1], mn1[2], mn1[3]};
#pragma unroll
    for (int e = 0; e < 8; ++e) { const float c0 = (e & 1) ? bfhi(ucw[e >> 1]) : bflo(ucw[e >> 1]), p0 = (e & 1) ? bfhi(upw[e >> 1]) : bflo(upw[e >> 1]), n0 = (e & 1) ? bfhi(unw[e >> 1]) : bflo(unw[e >> 1]);
        x[e] = c0 + mpw[e] * (p0 - c0) + mnw[e] * (n0 - c0); }
}
__device__ __forceinline__ void flush_bf16(const LAS bf16* tile, bf16* ARR, int t0, int cbase, int lane) {
#pragma unroll
    for (int h = 0; h < 2; ++h) { const int row = (lane >> 2) + 16 * h, ch = lane & 3; const v4u v = *(const LAS v4u*)(tile + row * 32 + 8 * ch);
        if (t0 + row < LTOK) *(v4u*)(ARR + (size_t)(t0 + row) * RC + cbase + 8 * ch) = v; }
}
__device__ __forceinline__ void flush_f32(const LAS float* tile, float* ARR, int t0, int cbase, int lane) {
#pragma unroll
    for (int h = 0; h < 4; ++h) { const int row = (lane >> 3) + 8 * h, ch = lane & 7; const f32x4 v = *(const LAS f32x4*)(tile + row * 32 + 4 * ch);
        if (t0 + row < LTOK) *(f32x4*)(ARR + (size_t)(t0 + row) * RC + cbase + 4 * ch) = v; }
}
__device__ __forceinline__ void prep_phase(Frame& F) {
    constexpr int XS = 648;
    LAS bf16* Xs = (LAS bf16*)F.lds;
    LAS bf16* Kt = (LAS bf16*)(F.lds + 41472 + F.wave * 8192);
    LAS bf16* Ot = Kt + 2048;
    const bf16* U = (const bf16*)(F.ws + WS_U);
    const float* mu_p = F.in[5]; const float* mu_n = F.in[6];
    const bf16* w2t = (const bf16*)(F.ws + WS_LW2); const bf16* a2t = (const bf16*)(F.ws + WS_LA2); const bf16* g2t = (const bf16*)(F.ws + WS_LG2);
    float* W0 = (float*)(F.ws + WS_W0); float* W1 = (float*)(F.ws + WS_W1);
    bf16* KD0 = (bf16*)(F.ws + WS_KD0); bf16* KD1 = (bf16*)(F.ws + WS_KD1); bf16* B0 = (bf16*)(F.ws + WS_B0); bf16* B1 = (bf16*)(F.ws + WS_B1);
    bf16* KK = (bf16*)(F.ws + WS_KK); bf16* RR = (bf16*)(F.ws + WS_RR); bf16* VV = (bf16*)(F.ws + WS_VV); bf16* GG = (bf16*)(F.ws + WS_GG);
    const int hh = F.lane >> 5, r = F.lane & 31;
    for (int unit = blockIdx.x; unit < 257 * 4; unit += F.G) {
        const int tt = unit >> 2, t0 = tt * 32, hd = (unit & 3) * 8 + F.wave;
        __syncthreads();
        FPB0(15);
        { Sh8 sx[5];
#pragma unroll
          for (int it = 0; it < 5; ++it) { const int ci = F.tid + 512 * it; sx[it] = shift8_ld(U, t0 + ci / 80, 3 * RC + 8 * (ci % 80)); }
#pragma unroll
          for (int it = 0; it < 5; ++it) { const int ci = F.tid + 512 * it, tl = ci / 80, ch = ci % 80;
            float x[8]; shift8_fin(sx[it], t0 + tl, 3 * RC + 8 * ch, mu_p, mu_n, x);
#pragma unroll
            for (int e = 0; e < 8; ++e) { float v = x[e];
                if (ch < 24) { const float ex = __expf(2.0f * v); v = 1.0f - 2.0f / (ex + 1.0f); }
                else if (ch >= 48) v = sigmoidf_(v);
                x[e] = v; }
            v4u o; o.x = pk2(x[0], x[1]); o.y = pk2(x[2], x[3]); o.z = pk2(x[4], x[5]); o.w = pk2(x[6], x[7]);
            *(LAS v4u*)(Xs + tl * XS + 8 * ch) = o; } }
        { const int c8 = hd * 64 + 8 * (F.lane & 7);
#pragma unroll
          for (int st = 0; st < 3; ++st) { const int col = (st == 0 ? RC : st == 1 ? 0 : 2 * RC) + c8; Sh8 sq[4];
#pragma unroll
            for (int q = 0; q < 4; ++q) sq[q] = shift8_ld(U, t0 + (F.lane >> 3) + 8 * q, col);
#pragma unroll
            for (int q = 0; q < 4; ++q) { const int tl = (F.lane >> 3) + 8 * q, tq = t0 + tl; float x[8]; shift8_fin(sq[q], tq, col, mu_p, mu_n, x);
                v4u o; o.x = pk2(x[0], x[1]); o.y = pk2(x[2], x[3]); o.z = pk2(x[4], x[5]); o.w = pk2(x[6], x[7]);
                if (st == 0) *(LAS v4u*)(Kt + tl * 64 + 8 * (F.lane & 7)) = o;
                else if (tq < LTOK) *(v4u*)((st == 1 ? RR : VV) + (size_t)tq * RC + c8) = o; } } }
        __syncthreads();
        FPB1(15); FPB0(16);
        float kp[2][16], ss[16];
#pragma unroll
        for (int i = 0; i < 16; ++i) ss[i] = 0.f;
#pragma unroll
        for (int ct = 0; ct < 2; ++ct) { const int c = hd * 64 + 32 * ct + r; const float kkw = F.in[12][c];
#pragma unroll
            for (int i = 0; i < 16; ++i) { kp[ct][i] = bf2f(Kt[crow(i, hh) * 64 + 32 * ct + r]); const float kr = kp[ct][i] * kkw; ss[i] += kr * kr; } }
#pragma unroll
        for (int i = 0; i < 16; ++i) {
#pragma unroll
            for (int o = 1; o < 32; o <<= 1) ss[i] += __shfl_xor(ss[i], o);
            ss[i] = 1.0f / fmaxf(sqrtf(ss[i]), 1e-12f); }
#define LDF(dst, ptr, n) do { _Pragma("unroll") for (int s_ = 0; s_ < (n); ++s_) dst[s_] = *(const bf16x8*)((ptr) + 16 * s_); } while (0)
#define MMF(frag, xoff, n) do { _Pragma("unroll") for (int i_ = 0; i_ < 16; ++i_) acc[i_] = 0.f; const LAS bf16* ap_ = Xs + r * XS + (xoff) + 8 * hh; \
            _Pragma("unroll") for (int s_ = 0; s_ < (n); ++s_) acc = __builtin_amdgcn_mfma_f32_32x32x16_bf16(*(const LAS bf16x8*)(ap_ + 16 * s_), frag[s_], acc, 0, 0, 0); } while (0)
#pragma unroll
        for (int ct = 0; ct < 2; ++ct) {
            const int c = hd * 64 + 32 * ct + r, cb = hd * 64 + 32 * ct;
            const float kkw = F.in[12][c], kaw = F.in[13][c];
            const bf16* pa0 = a2t + (size_t)c * 96 + 8 * hh; const bf16* pa1 = a2t + ((size_t)RC + c) * 96 + 8 * hh;
            const bf16* pw0 = w2t + (size_t)c * 96 + 8 * hh; const bf16* pw1 = w2t + ((size_t)RC + c) * 96 + 8 * hh; const bf16* pg = g2t + (size_t)c * 256 + 8 * hh;
            bf16x8 fa[6], fg[16]; f32x16 acc; float kk[16];
            LDF(fa, pa0, 6);
#pragma unroll
            for (int i = 0; i < 16; ++i) { kk[i] = kp[ct][i] * kkw * ss[i]; Ot[crow(i, hh) * 32 + r] = (bf16)f2bf(kk[i]); }
            flush_bf16(Ot, KK, t0, cb, F.lane);
#pragma unroll
            for (int d = 0; d < 2; ++d) {
                if (d == 0) { MMF(fa, 192, 6); LDF(fa, pa1, 6); } else { MMF(fa, 288, 6); LDF(fa, pw0, 6); }
                const float a0 = F.in[9][d * RC + c];
#pragma unroll
                for (int i = 0; i < 16; ++i) { acc[i] = sigmoidf_(a0 + acc[i]); Ot[crow(i, hh) * 32 + r] = (bf16)f2bf(kp[ct][i] * (1.0f + (acc[i] - 1.0f) * kaw)); }
                flush_bf16(Ot, d ? KD1 : KD0, t0, cb, F.lane);
#pragma unroll
                for (int i = 0; i < 16; ++i) Ot[crow(i, hh) * 32 + r] = (bf16)f2bf(kk[i] * acc[i]);
                flush_bf16(Ot, d ? B1 : B0, t0, cb, F.lane);
            }
#pragma unroll
            for (int d = 0; d < 2; ++d) {
                if (d == 0) { MMF(fa, 0, 6); LDF(fa, pw1, 6); } else { MMF(fa, 96, 6); LDF(fg, pg, 16); }
                const float w0 = F.in[7][d * RC + c]; LAS float* Of = (LAS float*)Ot;
#pragma unroll
                for (int i = 0; i < 16; ++i) Of[crow(i, hh) * 32 + r] = __expf(-0.6065306597126334f * sigmoidf_(w0 + acc[i]));
                flush_f32(Of, d ? W1 : W0, t0, cb, F.lane);
            }
            MMF(fg, 384, 16);
#pragma unroll
            for (int i = 0; i < 16; ++i) Ot[crow(i, hh) * 32 + r] = (bf16)f2bf(acc[i]);
            flush_bf16(Ot, GG, t0, cb, F.lane);
        }
#undef LDF
#undef MMF
        FPB1(16);
    }
    __syncthreads();
}

__device__ __forceinline__ float dpp_xor_add(float x, const int ctrl_sel) {
    int y;
    if (ctrl_sel == 0) y = __builtin_amdgcn_update_dpp(0, __float_as_int(x), 0xB1, 0xf, 0xf, true);
    else if (ctrl_sel == 1) y = __builtin_amdgcn_update_dpp(0, __float_as_int(x), 0x4E, 0xf, 0xf, true);
    else if (ctrl_sel == 2) y = __builtin_amdgcn_update_dpp(0, __float_as_int(x), 0x141, 0xf, 0xf, true);
    else y = __builtin_amdgcn_update_dpp(0, __float_as_int(x), 0x140, 0xf, 0xf, true);
    return x + __int_as_float(y);
}
__device__ __forceinline__ float row16_sum(float x) { x = dpp_xor_add(x, 0); x = dpp_xor_add(x, 1); x = dpp_xor_add(x, 2); x = dpp_xor_add(x, 3); return x; }
constexpr int SC_CH = 32, SC_STEP = 336, SC_BUF = SC_CH * SC_STEP;
struct ScanOps { f32x4 w, kd, b, kk, r; float v; };
__device__ __forceinline__ ScanOps scan_ld(const LAS float* sp, int jg, int rl) {
    ScanOps o; o.w = *(const LAS f32x4*)(sp + 4 * jg); o.kd = *(const LAS f32x4*)(sp + 64 + 4 * jg); o.b = *(const LAS f32x4*)(sp + 128 + 4 * jg);
    o.kk = *(const LAS f32x4*)(sp + 192 + 4 * jg); o.r = *(const LAS f32x4*)(sp + 256 + 4 * jg); o.v = sp[320 + rl]; return o; }
__device__ __forceinline__ void scan_consume(const LAS float* base, LAS float* yb, int jg, int rl, f32x2& S01, f32x2& S23) {
    ScanOps o0 = scan_ld(base, jg, rl), o1 = scan_ld(base + SC_STEP, jg, rl);
#pragma unroll
    for (int sl = 0; sl < SC_CH; ++sl) {
        ScanOps o2 = o1;
        if (sl + 2 < SC_CH) o2 = scan_ld(base + (sl + 2) * SC_STEP, jg, rl);
        const f32x2 kklo = __builtin_shufflevector(o0.kk, o0.kk, 0, 1), kkhi = __builtin_shufflevector(o0.kk, o0.kk, 2, 3);
        const f32x2 wlo = __builtin_shufflevector(o0.w, o0.w, 0, 1), whi = __builtin_shufflevector(o0.w, o0.w, 2, 3);
        const f32x2 kdlo = __builtin_shufflevector(o0.kd, o0.kd, 0, 1), kdhi = __builtin_shufflevector(o0.kd, o0.kd, 2, 3);
        const f32x2 blo = __builtin_shufflevector(o0.b, o0.b, 0, 1), bhi = __builtin_shufflevector(o0.b, o0.b, 2, 3);
        const f32x2 rlo = __builtin_shufflevector(o0.r, o0.r, 0, 1), rhi = __builtin_shufflevector(o0.r, o0.r, 2, 3);
        const f32x2 vv = {o0.v, o0.v};
        f32x2 m = S01 * kklo; m = S23 * kkhi + m;
        float p = m.x + m.y;
        const f32x2 u01 = S01 * wlo + vv * kdlo, u23 = S23 * whi + vv * kdhi;
        p = row16_sum(p);
        const f32x2 pp = {p, p};
        S01 = u01 - pp * blo; S23 = u23 - pp * bhi;
        f32x2 ym = S01 * rlo; ym = S23 * rhi + ym;
        float y = ym.x + ym.y;
        y = dpp_xor_add(y, 0); y = dpp_xor_add(y, 1); y = dpp_xor_add(y, 2);
        yb[sl * 64] = y;
        o0 = o1; o1 = o2;
    }
}
__device__ __forceinline__ void scan_phase(Frame& F) {
    LAS float* BUF = (LAS float*)F.lds;
    LAS float* YB = (LAS float*)(F.lds + 2 * SC_BUF * 4);
    const float* W0 = (const float*)(F.ws + WS_W0); const float* W1 = (const float*)(F.ws + WS_W1);
    const bf16* KD0 = (const bf16*)(F.ws + WS_KD0); const bf16* KD1 = (const bf16*)(F.ws + WS_KD1); const bf16* B0 = (const bf16*)(F.ws + WS_B0); const bf16* B1 = (const bf16*)(F.ws + WS_B1);
    const bf16* KK = (const bf16*)(F.ws + WS_KK); const bf16* RR = (const bf16*)(F.ws + WS_RR); const bf16* VV = (const bf16*)(F.ws + WS_VV);
    float* Y = (float*)(F.ws + WS_Y);
#define SC_BARRIER() do { asm volatile("s_waitcnt lgkmcnt(0)" ::: "memory"); __builtin_amdgcn_s_barrier(); asm volatile("" ::: "memory"); } while (0)
    for (int item = blockIdx.x; item < 256; item += F.G) {
        const int pair = (item & 7) * 8 + (item >> 5), q4 = (item >> 3) & 3, hd = pair >> 1, dir = pair & 1;
        const int nsteps = dir ? SEQ : LTOK, nchunks = (nsteps + SC_CH - 1) / SC_CH;
        const float* Wd = dir ? W1 : W0; const bf16* KDd = dir ? KD1 : KD0; const bf16* Bd = dir ? B1 : B0;
        float* Yd = Y + (size_t)dir * LTOK * RC;
        const int lt = F.tid - 256, lq = lt & 15, sg = (lt >> 4) & 15, slv = (lt >> 2) & 31, qv = lt & 3;
        f32x4 lA_w[2], lB_w[2]; v2u lA_k[2][4], lB_k[2][4]; v2u lA_v, lB_v;
#define SCAN_ISSUE(c, ld_w, ld_k, ld_v) do { _Pragma("unroll") for (int u_ = 0; u_ < 2; ++u_) { const int s_ = (c) * SC_CH + sg + 16 * u_; const int sc_ = s_ < nsteps ? s_ : nsteps - 1; const int t_ = dir ? (LTOK - 1 - sc_) : sc_; \
                const size_t o_ = (size_t)t_ * RC + hd * 64 + 4 * lq; ld_w[u_] = *(const f32x4*)(Wd + o_); ld_k[u_][0] = *(const v2u*)(KDd + o_); ld_k[u_][1] = *(const v2u*)(Bd + o_); ld_k[u_][2] = *(const v2u*)(KK + o_); ld_k[u_][3] = *(const v2u*)(RR + o_); } \
            { const int s_ = (c) * SC_CH + slv; const int sc_ = s_ < nsteps ? s_ : nsteps - 1; const int t_ = dir ? (LTOK - 1 - sc_) : sc_; ld_v = *(const v2u*)(VV + (size_t)t_ * RC + hd * 64 + 16 * q4 + 4 * qv); } } while (0)
#define SCAN_WRITE(c, ld_w, ld_k, ld_v) do { LAS float* dst_ = BUF + ((c) & 1) * SC_BUF; _Pragma("unroll") for (int u_ = 0; u_ < 2; ++u_) { const int sl_ = sg + 16 * u_; const bool ok_ = (c) * SC_CH + sl_ < nsteps; LAS float* d_ = dst_ + sl_ * SC_STEP + 4 * lq; \
                *(LAS f32x4*)d_ = ok_ ? ld_w[u_] : (f32x4){1.f, 1.f, 1.f, 1.f}; \
                _Pragma("unroll") for (int a_ = 0; a_ < 4; ++a_) { const v2u w_ = ld_k[u_][a_]; *(LAS f32x4*)(d_ + 64 * (a_ + 1)) = ok_ ? (f32x4){bflo(w_.x), bfhi(w_.x), bflo(w_.y), bfhi(w_.y)} : (f32x4){0.f, 0.f, 0.f, 0.f}; } } \
            if (lt < 128) { const bool ok_ = (c) * SC_CH + slv < nsteps; *(LAS f32x4*)(dst_ + slv * SC_STEP + 320 + 4 * qv) = ok_ ? (f32x4){bflo(ld_v.x), bfhi(ld_v.x), bflo(ld_v.y), bfhi(ld_v.y)} : (f32x4){0.f, 0.f, 0.f, 0.f}; } } while (0)
#define SCAN_FLUSH(c) do { const LAS float* yb_ = YB + ((c) & 1) * (SC_CH * 64); _Pragma("unroll") for (int u_ = 0; u_ < 2; ++u_) { const int pi_ = lt + 256 * u_; const int sl_ = pi_ >> 4, s_ = (c) * SC_CH + sl_; \
                if (s_ < nsteps) { const int t_ = dir ? (LTOK - 1 - s_) : s_; const f32x2 y2_ = *(const LAS f32x2*)(yb_ + sl_ * 64 + 2 * (pi_ & 15)); Yd[(size_t)t_ * RC + hd * 64 + 16 * q4 + (pi_ & 15)] = y2_.x + y2_.y; } } } while (0)
        SC_BARRIER();
        if (F.wave >= 4) { SCAN_ISSUE(0, lA_w, lA_k, lA_v); SCAN_WRITE(0, lA_w, lA_k, lA_v); SCAN_ISSUE(1, lB_w, lB_k, lB_v); SCAN_ISSUE(2, lA_w, lA_k, lA_v); }
        SC_BARRIER();
        f32x2 S01 = {0.f, 0.f}, S23 = {0.f, 0.f};
        const int g = F.lane >> 4, jg = F.lane & 15, rl = 4 * (F.wave & 3) + g;
        const int yslot = ((jg & 7) == 0) ? (2 * rl + (jg >> 3)) : (32 + (F.lane & 31));
        if (F.wave >= 4) {
#define SCAN_LITER(c, ld_w, ld_k, ld_v) do { \
                if ((c) + 1 < nchunks) SCAN_WRITE((c) + 1, ld_w, ld_k, ld_v);         \
                if ((c) + 3 < nchunks) SCAN_ISSUE((c) + 3, ld_w, ld_k, ld_v);         \
                if ((c) >= 1) SCAN_FLUSH((c) - 1); \
                SC_BARRIER(); } while (0)
            for (int c = 0; c < nchunks; c += 2) {
                SCAN_LITER(c, lB_w, lB_k, lB_v);
                if (c + 1 < nchunks) SCAN_LITER(c + 1, lA_w, lA_k, lA_v);
            }
#undef SCAN_LITER
        } else {
            for (int c = 0; c < nchunks; ++c) { scan_consume(BUF + (c & 1) * SC_BUF, YB + (c & 1) * (SC_CH * 64) + yslot, jg, rl, S01, S23); SC_BARRIER(); }
        }
        if (F.wave >= 4) SCAN_FLUSH(nchunks - 1);
#undef SCAN_ISSUE
#undef SCAN_WRITE
#undef SCAN_FLUSH
    }
#undef SC_BARRIER
}

__device__ __forceinline__ void combine_phase(Frame& F) {
    const float* Y0 = (const float*)(F.ws + WS_Y); const float* Y1 = Y0 + (size_t)LTOK * RC;
    const bf16* VV = (const bf16*)(F.ws + WS_VV); const bf16* GG = (const bf16*)(F.ws + WS_GG); const bf16* RR = (const bf16*)(F.ws + WS_RR);
    const bf16* KD0 = (const bf16*)(F.ws + WS_KD0); const bf16* KD1 = (const bf16*)(F.ws + WS_KD1);
    bf16* OR = (bf16*)(F.ws + WS_ORWKV);
    const float* lnw = F.in[15]; const float* lnb = F.in[16]; const float* rk = F.in[14];
    const int gw = blockIdx.x * 8 + F.wave, NGW = F.G * 8;
    for (int row = gw; row < SEQ; row += NGW) { const int t = row + NMETA;
#pragma unroll 4
        for (int hd = 0; hd < RH; ++hd) { const int c = hd * 64 + F.lane; const size_t o = (size_t)t * RC + c;
            const float y = Y0[o] + Y1[o]; const float bterm = bf2f(RR[o]) * (bf2f(KD0[o]) + bf2f(KD1[o])) * rk[c];
            const float mean = wave_sum(y) * (1.0f / 64.0f); const float dlt = y - mean; const float var = wave_sum(dlt * dlt) * (1.0f / 64.0f); const float bonus = wave_sum(bterm);
            const float yn = dlt * (1.0f / sqrtf(var + GN_EPS)) * lnw[c] + lnb[c];
            const float outv = (yn + bonus * bf2f(VV[o])) * bf2f(GG[o]);
            OR[(size_t)row * RC + c] = (bf16)f2bf(outv); } }
}
__device__ __forceinline__ void final_phase(Frame& F) {
    const float* SS3 = (const float*)(F.ctl + CW_SS3); const float* w = F.in[25];
    const int gw = blockIdx.x * 8 + F.wave, NGW = F.G * 8;
    for (int row = gw; row < SEQ; row += NGW) { const float rstd = 1.0f / sqrtf(SS3[row] * (1.0f / DM) + RMS_EPS);
        GAS f32x4* p = (GAS f32x4*)(F.out + (size_t)row * DM) + F.lane; const GAS f32x4* wp = (const GAS f32x4*)w + F.lane;
#pragma unroll
        for (int j = 0; j < 16; ++j) { const f32x4 v = p[64 * j], ww = wp[64 * j]; p[64 * j] = v * rstd * ww; } }
}
template <int WHICH> __device__ __forceinline__ void convert_late(Frame& F) {
    LAS float* scr = (LAS float*)(F.lds + 49152 + F.wave * 8448);
    const int gw = blockIdx.x * 8 + F.wave, NGW = F.G * 8;
    if (WHICH == 0) {
        constexpr int I_P = (ATTW / 64) * (DM / 32), I_O = (DM / 64) * (DM / 32);
        for (int it = gw; it < 2 * I_P + I_O; it += NGW) { int r = it;
            if (r < I_P) { transpose_item<0>(F.in[18], ATTW, DM, (bf16*)(F.ws + WS_WPA), scr, r, F.lane, nullptr); continue; } r -= I_P;
            if (r < I_P) { transpose_item<0>(F.in[19], RC, DM, (bf16*)(F.ws + WS_WPR), scr, r, F.lane, nullptr); continue; } r -= I_P;
            transpose_item<0>(F.in[20], DM, DM, (bf16*)(F.ws + WS_WOUT), scr, r, F.lane, nullptr); }
    } else {
        constexpr int I_D = (DFF / 64) * (DM / 32);
        for (int it = gw; it < I_D; it += NGW) transpose_item<0>(F.in[24], DFF, DM, (bf16*)(F.ws + WS_WD), scr, it, F.lane, nullptr);
    }
}

constexpr int N_PHASES = 10;
struct Args { const float* in[26]; float* out; unsigned char* ws; int ph_lo, ph_hi; };
__global__ void __launch_bounds__(512, 2) fwd_kernel(Args args) {
    extern __shared__ __attribute__((aligned(16))) unsigned char lds[];
    Frame F;
    F.lds = (LAS unsigned char*)lds;
    F.MISC = (volatile LAS unsigned*)(F.lds + MISC_OFF);
    F.tid = threadIdx.x; F.lane = F.tid & 63; F.wave = __builtin_amdgcn_readfirstlane(F.tid >> 6); F.G = gridDim.x;
    F.ws = args.ws; F.ctl = (gu32*)(args.ws + WS_CTL); F.out = args.out; F.pb0 = 0; F.pacc = 0;
#pragma unroll
    for (int i = 0; i < 26; ++i) F.in[i] = args.in[i];
    for (int u = F.tid; u < (LDS_BYTES - LDSCTL_OFF) / 4; u += 512) ((LAS unsigned*)(F.lds + LDSCTL_OFF))[u] = 0u;
    __syncthreads();
    XcdBarrier bar; bar.bar = (unsigned*)(F.ctl + CW_BAR); bar.x = 0; bar.st = nullptr;
    if (!MK_SPLIT) bar = xcd_barrier_post((unsigned*)(F.ctl + CW_BAR), F.MISC + 8);
    const int lo = args.ph_lo, hi = args.ph_hi;
#define IN(k) (lo <= (k) && (k) < hi)
#define SEAM(k) do { if (IN(k) && IN((k) + 1)) xcd_barrier(bar); } while (0)
    bf16* Rm = (bf16*)(F.ws + WS_H);
    float* SS2 = (float*)(F.ctl + CW_SS2); float* SS3 = (float*)(F.ctl + CW_SS3);

    unsigned long long pt0 = 0, pt1 = 0;
#define PB0(k) do { if ((PROBE_PHASE >> (k)) & 1) pt0 = __builtin_amdgcn_s_memrealtime(); } while (0)
#define PB1(k) do { if ((PROBE_PHASE >> (k)) & 1) pt1 += __builtin_amdgcn_s_memrealtime() - pt0; } while (0)
    PB0(0); if (IN(0)) { p0_prologue(F); } SEAM(0); PB1(0);
    PB0(1); if (IN(1)) {
        pg8::Gemm g{Rm, Rm, MPAD + INWP, MPAD + INWP, DM}; pg8::InOrder S; S.init(F.G, (int)blockIdx.x);
        pg8::EpiIn E{(bf16*)(F.ws + WS_G), (bf16*)(F.ws + WS_Q), (bf16*)(F.ws + WS_K), (bf16*)(F.ws + WS_VT), (bf16*)(F.ws + WS_U), F.in[4], (const float*)(F.ws + WS_ROPE)};
        pg8::gemm_phase<pg8::EpiIn, pg8::InOrder, true, true>(F.lds, g, S, E);
    } SEAM(1); PB1(1);
    PB0(2); if (IN(2)) { PB0(10); attn_phase(F); PB1(10); PB0(11); prep_phase(F); PB1(11); PB0(12); convert_late<0>(F); PB1(12); } SEAM(2); PB1(2);
    PB0(3); if (IN(3)) { scan_phase(F); } SEAM(3); PB1(3);
    PB0(4); if (IN(4)) { PB0(13); combine_phase(F); PB1(13); PB0(14); convert_late<1>(F); PB1(14); } SEAM(4); PB1(4);
    PB0(5); if (IN(5)) {
        { pg8::Gemm g{(const bf16*)(F.ws + WS_OATT), (const bf16*)(F.ws + WS_WPA), SEQ, DM, ATTW}; pg8::StaticOrder S; S.init(SEQ, DM, F.G, (int)blockIdx.x);
          pg8::EpiProjA E{(float*)(F.ws + WS_P1), (const bf16*)(F.ws + WS_G)};
          pg8::gemm_phase<pg8::EpiProjA, pg8::StaticOrder, true, true>(F.lds, g, S, E); }
        __syncthreads();
        { pg8::Gemm g{(const bf16*)(F.ws + WS_ORWKV), (const bf16*)(F.ws + WS_WPR), SEQ, DM, RC}; pg8::StaticOrder S; S.init(SEQ, DM, F.G, (int)blockIdx.x);
          pg8::EpiProjB E{(const float*)(F.ws + WS_P1), (const bf16*)(F.ws + WS_G), (bf16*)(F.ws + WS_MX)};
          pg8::gemm_phase<pg8::EpiProjB, pg8::StaticOrder, true, true>(F.lds, g, S, E); }
    } SEAM(5); PB1(5);
    PB0(6); if (IN(6)) {
        pg8::Gemm g{(const bf16*)(F.ws + WS_MX), (const bf16*)(F.ws + WS_WOUT), SEQ, DM, DM}; pg8::StaticOrder S; S.init(SEQ, DM, F.G, (int)blockIdx.x);
        pg8::EpiResid<true> E{F.in[0], (float*)(F.ws + WS_H2), (bf16*)(F.ws + WS_A2), SS2};
        pg8::gemm_phase<pg8::EpiResid<true>, pg8::StaticOrder, true, true>(F.lds, g, S, E);
    } SEAM(6); PB1(6);
    PB0(7); if (IN(7)) {
        pg8::Gemm g{(const bf16*)(F.ws + WS_A2), (const bf16*)(F.ws + WS_WGU), SEQ, 2 * DFF, DM}; pg8::StaticOrder S; S.init(SEQ, 2 * DFF, F.G, (int)blockIdx.x);
        pg8::EpiSwiGLU E{(bf16*)(F.ws + WS_HID), SS2};
        pg8::gemm_phase<pg8::EpiSwiGLU, pg8::StaticOrder, true, true>(F.lds, g, S, E);
    } SEAM(7); PB1(7);
    PB0(8); if (IN(8)) {
        pg8::Gemm g{(const bf16*)(F.ws + WS_HID), (const bf16*)(F.ws + WS_WD), SEQ, DM, DFF}; pg8::StaticOrder S; S.init(SEQ, DM, F.G, (int)blockIdx.x);
        pg8::EpiResid<false> E{(const float*)(F.ws + WS_H2), F.out, nullptr, SS3};
        pg8::gemm_phase<pg8::EpiResid<false>, pg8::StaticOrder, true, true>(F.lds, g, S, E);
    } SEAM(8); PB1(8);
    PB0(9); if (IN(9)) { final_phase(F); } PB1(9);
    if (PROBE_PHASE != 0 && blockIdx.x == 0 && F.tid == 0) { const unsigned long long te = __builtin_amdgcn_s_memrealtime(), want = (unsigned long long)PROBE_MULT * (pt1 + F.pacc);
        while (__builtin_amdgcn_s_memrealtime() - te < want && want < 2000000ull) __builtin_amdgcn_s_sleep(32); }
#undef PB0
#undef PB1
#undef IN
#undef SEAM
}

extern "C" void kernel_launch(void* const* d_in, const int* in_sizes, int n_in, void* d_out, int out_size, void* d_ws, size_t ws_size, hipStream_t stream) {
    static int grid = 0;
    if (grid == 0) {
        if (n_in != 26 || out_size != SEQ * DM || ws_size < WS_END) { fprintf(stderr, "kernel_launch: unexpected shapes (n_in %d, out %d, ws %zu, need %zu); nothing launched\n", n_in, out_size, ws_size, (size_t)WS_END); grid = -1; return; }
        int dev = 0, cus = 0, per_cu = 0;
        if (hipGetDevice(&dev) != hipSuccess || hipDeviceGetAttribute(&cus, hipDeviceAttributeMultiprocessorCount, dev) != hipSuccess) { grid = -1; return; }
        if (hipFuncSetAttribute((const void*)fwd_kernel, hipFuncAttributeMaxDynamicSharedMemorySize, LDS_BYTES) != hipSuccess) { fprintf(stderr, "kernel_launch: hipFuncSetAttribute failed\n"); grid = -1; return; }
        if (hipOccupancyMaxActiveBlocksPerMultiprocessor(&per_cu, (const void*)fwd_kernel, 512, LDS_BYTES) != hipSuccess || per_cu < 1) fprintf(stderr, "kernel_launch: occupancy query says %d per CU\n", per_cu);
        (void)hipGetLastError();
        grid = cus;
    }
    if (grid < 0) return;
    if (hipMemsetAsync((char*)d_ws + WS_CTL, 0, CTL_ZERO_BYTES, stream) != hipSuccess) return;
    Args a{};
    for (int i = 0; i < 26; ++i) a.in[i] = (const float*)d_in[i];
    a.out = (float*)d_out; a.ws = (unsigned char*)d_ws;
#if MK_SPLIT
    for (int p = 0; p < N_PHASES; ++p) { a.ph_lo = p; a.ph_hi = p + 1; hipLaunchKernelGGL(fwd_kernel, dim3(grid), dim3(512), LDS_BYTES, stream, a); }
#else
    a.ph_lo = 0; a.ph_hi = N_PHASES;
    hipLaunchKernelGGL(fwd_kernel, dim3(grid), dim3(512), LDS_BYTES, stream, a);
#endif
}
```

```cpp
#include <hip/hip_runtime.h>
#include <cstdio>
#include <cstdint>

#ifndef MK_SPLIT
#define MK_SPLIT 0
#endif

#ifndef PROBE_PHASE
#define PROBE_PHASE 0
#endif
#ifndef PROBE_MULT
#define PROBE_MULT 2
#endif
constexpr int NMETA = 16, SEQ = 8192, LTOK = 8208, DM = 4096, MPAD = 8448;
constexpr int INW = 18048, INWP = 18176;
constexpr int ATTW = 2048, KVW = 512, UW = 6784, UPITCH = 6912;
constexpr int RC = 2048, RH = 32, RN = 64;
constexpr int DFF = 11008;
constexpr float RMS_EPS = 1e-6f, GN_EPS = 64e-5f;
constexpr int HT = MPAD / 256;
constexpr int CT_Q = 32, CT_K = 40, CT_V = 42, CT_U = 44, CT_N = 71;

namespace pg8 {
#define PG8_LAS __attribute__((address_space(3)))
typedef unsigned short bf16_t;
typedef short bf16x8 __attribute__((ext_vector_type(8)));
typedef float f32x4 __attribute__((ext_vector_type(4)));
typedef unsigned u32x4 __attribute__((ext_vector_type(4)));
constexpr int BM = 256, BK = 64, HALF = 128, HTB = HALF * BK * 2  , STAGE_BYTES = 8 * HTB, NXCD = 8, WGM = 8;

__host__ __device__ __forceinline__ int lds_byte(int r, int c) { const int st = (r >> 4) * 2 + (c >> 5), rr = r & 15, cc = c & 31, ob = rr * 64 + cc * 2; return st * 1024 + (ob ^ (((ob >> 9) & 1) << 5)); }
__host__ __device__ __forceinline__ void stage_rc(int b, int& R, int& C) { const int st = b / 1024, sb = b % 1024, swz = sb ^ (((sb >> 9) & 1) << 5); R = (st >> 1) * 16 + swz / 64; C = (st & 1) * 32 + (swz % 64) / 2; }
__host__ __device__ __forceinline__ int perm32(int rho) { const int n = rho >> 4, i = rho & 15; return 8 * (i >> 2) + 4 * n + (i & 3); }

struct Unit { int pm, pn; };
struct Gemm { const bf16_t* A; const bf16_t* Bt; int M, N, K; };

struct StaticOrder {
    int nM, nN, nwg, G, c;
    __host__ __device__ void init(int M, int N, int G_, int c_) { nM = M / BM; nN = N / BM; nwg = nM * nN; G = G_; c = c_; }
    __host__ __device__ bool next(int i, Unit& u) const {
        const long L = (long)i * G + c; if (L >= nwg) return false;
        int wgid = (int)L; { const int q = nwg / NXCD, r = nwg % NXCD, xcd = wgid % NXCD, off = wgid / NXCD; wgid = (xcd < r ? xcd * (q + 1) : r * (q + 1) + (xcd - r) * q) + off; }
        const int nig = WGM * nN, gid = wgid / nig, fm = gid * WGM, gsz = (nM - fm) < WGM ? (nM - fm) : WGM;
        u.pm = fm + ((wgid % nig) % gsz); u.pn = (wgid % nig) / gsz; return true;
    }
    __device__ __forceinline__ void a_ready(const Unit&) const {}
    __device__ __forceinline__ void done(const Unit&) const {}
};

__device__ __forceinline__ unsigned cvt_pk_bf16(float lo, float hi) { unsigned r; asm volatile("v_cvt_pk_bf16_f32 %0, %1, %2" : "=v"(r) : "v"(lo), "v"(hi)); return r; }

typedef unsigned u32x2 __attribute__((ext_vector_type(2)));
__device__ __forceinline__ float bflo(unsigned w) { return __uint_as_float(w << 16); }
__device__ __forceinline__ float bfhi(unsigned w) { return __uint_as_float(w & 0xffff0000u); }
__device__ __forceinline__ float sigmoidf_(float x) { return 1.0f / (1.0f + __expf(-x)); }

struct InOrder {
    StaticOrder base; int G, c;
    __device__ void init(int G_, int c_) { base.init(SEQ, INWP, G_, c_); G = G_; c = c_; }
    __device__ bool next(int i, Unit& u) const {
        const long L = (long)i * G + c;
        if (L < base.nwg) {
            base.next(i, u);
            if (u.pn >= CT_V && u.pn < CT_U) { const int e = (u.pn - CT_V) * 32 + u.pm; u.pm = HT + CT_V + e / HT; u.pn = e % HT; }
            else u.pn += HT;
            return true;
        }
        const int x = (int)(L - base.nwg);
        if (x >= 31) return false;
        if (x < 2) { const int e = 64 + x; u.pm = HT + CT_V + e / HT; u.pn = e % HT; }
        else { const int y = x - 2; u.pm = 32; u.pn = HT + (y < 2 ? CT_K + y : CT_U + (y - 2)); }
        return true;
    }
    __device__ __forceinline__ void a_ready(const Unit&) const {}
    __device__ __forceinline__ void done(const Unit&) const {}
};

struct EpiIn {
    static constexpr bool PERM = true, AFTER_DRAIN = false;
    bf16_t *G, *Q, *K, *Vt, *U; const float* bgate; const float* rope;
    __device__ __forceinline__ static void st8(bf16_t* p, const f32x4& v0, const f32x4& v1) {
        u32x4 w; w.x = cvt_pk_bf16(v0[0], v0[1]); w.y = cvt_pk_bf16(v0[2], v0[3]); w.z = cvt_pk_bf16(v1[0], v1[1]); w.w = cvt_pk_bf16(v1[2], v1[3]); *(u32x4*)p = w; }
    __device__ __forceinline__ void plain(const f32x4 (&acc)[2][2][4][2], bf16_t* base, int ldc, int row0, int col0) const {
#pragma unroll
        for (int ai = 0; ai < 2; ++ai)
#pragma unroll
            for (int m = 0; m < 4; ++m) { bf16_t* rowp = base + (size_t)(row0 + ai * HALF + m * 16) * ldc + col0;
#pragma unroll
                for (int bj = 0; bj < 2; ++bj) st8(rowp + bj * HALF, acc[ai][bj][m][0], acc[ai][bj][m][1]); }
    }
    __device__ __forceinline__ void roped(const f32x4 (&acc)[2][2][4][2], bf16_t* base, int ldc, int row0, int col0, int wc, int fq) const {
        if (wc != 0) { plain(acc, base, ldc, row0, col0); return; }
        const float sgn = (fq < 2) ? -1.0f : 1.0f;
#pragma unroll
        for (int ai = 0; ai < 2; ++ai)
#pragma unroll
            for (int m = 0; m < 4; ++m) { const int row = row0 + ai * HALF + m * 16; const int pos = row < SEQ ? row + NMETA : row - SEQ;
                const f32x4* cs = (const f32x4*)(rope + (size_t)pos * 32 + 16 * (fq & 1));
                const f32x4 c0 = cs[0], c1 = cs[1], c2 = cs[2], c3 = cs[3];
                const float cw[8] = {c0[0], c0[2], c1[0], c1[2], c2[0], c2[2], c3[0], c3[2]}, sw[8] = {c0[1], c0[3], c1[1], c1[3], c2[1], c2[3], c3[1], c3[3]};
                bf16_t* rowp = base + (size_t)row * ldc + col0;
#pragma unroll
                for (int bj = 0; bj < 2; ++bj) { f32x4 v0 = acc[ai][bj][m][0], v1 = acc[ai][bj][m][1], o0, o1;
#pragma unroll
                    for (int e = 0; e < 4; ++e) { const float p0 = __shfl_xor(v0[e], 32), p1 = __shfl_xor(v1[e], 32);
                        o0[e] = v0[e] * cw[e] + sgn * p0 * sw[e]; o1[e] = v1[e] * cw[4 + e] + sgn * p1 * sw[4 + e]; }
                    st8(rowp + bj * HALF, o0, o1); } }
    }
    __device__ __forceinline__ void operator()(const f32x4 (&acc)[2][2][4][2], const Unit& u, int wr, int wc, int fr, int fq) const {
        if (u.pm >= HT) {
            plain(acc, Vt, MPAD, (u.pm - HT - CT_V) * BM + wr * 64 + fr, u.pn * BM + wc * 32 + 8 * fq); return; }
        const int ct = u.pn - HT, row0 = u.pm * BM + wr * 64 + fr, cl = wc * 32 + 8 * fq;
        if (ct < CT_Q) {
            const int col0 = ct * BM + cl;
#pragma unroll
            for (int bj = 0; bj < 2; ++bj) { const f32x4 b0 = *(const f32x4*)(bgate + col0 + bj * HALF), b1 = *(const f32x4*)(bgate + col0 + bj * HALF + 4);
#pragma unroll
                for (int ai = 0; ai < 2; ++ai)
#pragma unroll
                    for (int m = 0; m < 4; ++m) { f32x4 v0 = acc[ai][bj][m][0] + b0, v1 = acc[ai][bj][m][1] + b1;
#pragma unroll
                        for (int e = 0; e < 4; ++e) { v0[e] = sigmoidf_(v0[e]); v1[e] = sigmoidf_(v1[e]); }
                        st8(G + (size_t)(row0 + ai * HALF + m * 16) * (2 * DM) + col0 + bj * HALF, v0, v1); } }
        } else if (ct < CT_K) { roped(acc, Q, ATTW, row0, (ct - CT_Q) * BM + cl, wc, fq);
        } else if (ct < CT_V) { roped(acc, K, KVW, row0, (ct - CT_K) * BM + cl, wc, fq);
        } else { plain(acc, U, UPITCH, row0, (ct - CT_U) * BM + cl); }
    }
};

struct EpiProjA {
    static constexpr bool PERM = true, AFTER_DRAIN = false;
    float* P1; const bf16_t* G;
    __device__ __forceinline__ void operator()(const f32x4 (&acc)[2][2][4][2], const Unit& u, int wr, int wc, int fr, int fq) const {
        const int row0 = u.pm * BM + wr * 64 + fr, col0 = u.pn * BM + wc * 32 + 8 * fq;
#pragma unroll
        for (int ai = 0; ai < 2; ++ai)
#pragma unroll
            for (int m = 0; m < 4; ++m) { const size_t r = (size_t)(row0 + ai * HALF + m * 16);
#pragma unroll
                for (int bj = 0; bj < 2; ++bj) { const int c = col0 + bj * HALF; const u32x4 g = *(const u32x4*)(G + r * (2 * DM) + c);
                    f32x4 o0 = acc[ai][bj][m][0], o1 = acc[ai][bj][m][1];
                    o0[0] *= bflo(g.x); o0[1] *= bfhi(g.x); o0[2] *= bflo(g.y); o0[3] *= bfhi(g.y); o1[0] *= bflo(g.z); o1[1] *= bfhi(g.z); o1[2] *= bflo(g.w); o1[3] *= bfhi(g.w);
                    float* p = P1 + r * DM + c; *(f32x4*)p = o0; *(f32x4*)(p + 4) = o1; } }
    }
};
struct EpiProjB {
    static constexpr bool PERM = true, AFTER_DRAIN = false;
    const float* P1; const bf16_t* G; bf16_t* MX;
    __device__ __forceinline__ void operator()(const f32x4 (&acc)[2][2][4][2], const Unit& u, int wr, int wc, int fr, int fq) const {
        const int row0 = u.pm * BM + wr * 64 + fr, col0 = u.pn * BM + wc * 32 + 8 * fq;
#pragma unroll
        for (int ai = 0; ai < 2; ++ai)
#pragma unroll
            for (int m = 0; m < 4; ++m) { const size_t r = (size_t)(row0 + ai * HALF + m * 16);
#pragma unroll
                for (int bj = 0; bj < 2; ++bj) { const int c = col0 + bj * HALF; const u32x4 g = *(const u32x4*)(G + r * (2 * DM) + DM + c);
                    const float* p = P1 + r * DM + c; f32x4 o0 = *(const f32x4*)p, o1 = *(const f32x4*)(p + 4); const f32x4 a0 = acc[ai][bj][m][0], a1 = acc[ai][bj][m][1];
                    o0[0] += a0[0] * bflo(g.x); o0[1] += a0[1] * bfhi(g.x); o0[2] += a0[2] * bflo(g.y); o0[3] += a0[3] * bfhi(g.y);
                    o1[0] += a1[0] * bflo(g.z); o1[1] += a1[1] * bfhi(g.z); o1[2] += a1[2] * bflo(g.w); o1[3] += a1[3] * bfhi(g.w);
                    EpiIn::st8(MX + r * DM + c, o0, o1); }
                asm volatile("" ::: "memory"); }
    }
};
template <bool COPY> struct EpiResid {
    static constexpr bool PERM = true, AFTER_DRAIN = false;
    const float* BASE; float* OUT; bf16_t* CP; float* SS;
    __device__ __forceinline__ void operator()(const f32x4 (&acc)[2][2][4][2], const Unit& u, int wr, int wc, int fr, int fq) const {
        const int row0 = u.pm * BM + wr * 64 + fr, col0 = u.pn * BM + wc * 32 + 8 * fq;
#pragma unroll
        for (int ai = 0; ai < 2; ++ai)
#pragma unroll
            for (int m = 0; m < 4; ++m) { const size_t r = (size_t)(row0 + ai * HALF + m * 16); float ss = 0.f;
#pragma unroll
                for (int bj = 0; bj < 2; ++bj) { const int c = col0 + bj * HALF; const float* bp = BASE + r * DM + c;
                    const f32x4 o0 = *(const f32x4*)bp + acc[ai][bj][m][0], o1 = *(const f32x4*)(bp + 4) + acc[ai][bj][m][1];
                    ss += (o0[0] * o0[0] + o0[1] * o0[1]) + (o0[2] * o0[2] + o0[3] * o0[3]) + (o1[0] * o1[0] + o1[1] * o1[1]) + (o1[2] * o1[2] + o1[3] * o1[3]);
                    float* op = OUT + r * DM + c; *(f32x4*)op = o0; *(f32x4*)(op + 4) = o1;
                    if (COPY) EpiIn::st8(CP + r * DM + c, o0, o1); }
                ss += __shfl_xor(ss, 16); ss += __shfl_xor(ss, 32);
                if (fq == 0) atomicAdd(SS + r, ss);
                asm volatile("" ::: "memory"); }
    }
};
struct EpiSwiGLU {
    static constexpr bool PERM = true, AFTER_DRAIN = false;
    bf16_t* HID; const float* SS;
    __device__ __forceinline__ void operator()(const f32x4 (&acc)[2][2][4][2], const Unit& u, int wr, int wc, int fr, int fq) const {
        const int row0 = u.pm * BM + wr * 64 + fr, col0 = u.pn * HALF + wc * 32 + 8 * fq;
#pragma unroll
        for (int ai = 0; ai < 2; ++ai)
#pragma unroll
            for (int m = 0; m < 4; ++m) { const size_t r = (size_t)(row0 + ai * HALF + m * 16);
                const float rstd = 1.0f / sqrtf(SS[r] * (1.0f / DM) + RMS_EPS);
                f32x4 o0, o1;
#pragma unroll
                for (int e = 0; e < 4; ++e) { const float g0 = acc[ai][0][m][0][e] * rstd, u0 = acc[ai][1][m][0][e] * rstd, g1 = acc[ai][0][m][1][e] * rstd, u1 = acc[ai][1][m][1][e] * rstd;
                    o0[e] = g0 * sigmoidf_(g0) * u0; o1[e] = g1 * sigmoidf_(g1) * u1; }
                EpiIn::st8(HID + r * DFF + col0, o0, o1); }
    }
};

template <class Epi, class Sched, bool ALIGN_EPI = false, bool SP2 = false>
__device__ __forceinline__ void gemm_phase(PG8_LAS unsigned char* lds, const Gemm g, const Sched& S, const Epi& E) {
    const int tid = threadIdx.x, wid = __builtin_amdgcn_readfirstlane(tid >> 6), lane = tid & 63, wr = wid >> 2, wc = wid & 3, fr = lane & 15, fq = lane >> 4;
    const int K = g.K, nt = K / BK;
    unsigned voffA[2], voffB[2];
#pragma unroll
    for (int i = 0; i < 2; ++i) { int R, C; stage_rc(tid * 16 + i * 8192, R, C); const int Rb = Epi::PERM ? ((R & ~31) + perm32(R & 31)) : R;
        voffA[i] = (unsigned)(R * K + C) * 2u; voffB[i] = (unsigned)(Rb * K + C) * 2u; }
    const size_t kstep = (size_t)(BK * 2);
    const size_t hstep = (size_t)HALF * K * 2;
    const size_t tstep = 2 * hstep;
    const unsigned ldsw = (unsigned)wid * 1024u;
    const int aoff = lds_byte(wr * 64 + fr, fq * 8), boff = lds_byte(wc * 32 + fr, fq * 8);
#define PG8_SA(b, h) (((b) * 2 + (h)) * HTB)
#define PG8_SB(b, h) ((4 + (b) * 2 + (h)) * HTB)
#define PG8_STAGE(bufoff, gbase, voff) do { _Pragma("unroll") for (int _i = 0; _i < 2; ++_i) \
        __builtin_amdgcn_global_load_lds((const unsigned*)((const char*)(gbase) + (voff)[_i]), (PG8_LAS unsigned*)(lds + (bufoff) + ldsw + _i * 8192), 16, 0, 0); } while (0)
#define PG8_LDA(dst, b, h) do { _Pragma("unroll") for (int m = 0; m < 4; ++m) _Pragma("unroll") for (int k = 0; k < 2; ++k) dst[m][k] = *(const PG8_LAS bf16x8*)(lds + PG8_SA(b, h) + aoff + m * 2048 + k * 1024); } while (0)
#define PG8_LDB(dst, b, h) do { _Pragma("unroll") for (int n = 0; n < 2; ++n) _Pragma("unroll") for (int k = 0; k < 2; ++k) dst[n][k] = *(const PG8_LAS bf16x8*)(lds + PG8_SB(b, h) + boff + n * 2048 + k * 1024); } while (0)
#define PG8_MMA(ai, bj, At, Bt) do { __builtin_amdgcn_s_setprio(1); _Pragma("unroll") for (int m = 0; m < 4; ++m) _Pragma("unroll") for (int n = 0; n < 2; ++n) _Pragma("unroll") for (int k = 0; k < 2; ++k) \
        acc[ai][bj][m][n] = __builtin_amdgcn_mfma_f32_16x16x32_bf16(Bt[n][k], At[m][k], acc[ai][bj][m][n], 0, 0, 0); __builtin_amdgcn_s_setprio(0); } while (0)
#define PG8_WAIT_V(n) asm volatile("s_waitcnt vmcnt(" #n ")" ::: "memory")
#define PG8_WAIT_L(n) asm volatile("s_waitcnt lgkmcnt(" #n ")" ::: "memory")
#define PG8_BAR __builtin_amdgcn_s_barrier()
#define PG8_SCHED __builtin_amdgcn_sched_barrier(0)
    Unit cur, nxt; int ui = 0;
    if (!S.next(0, cur)) return;
    f32x4 acc[2][2][4][2];
#pragma unroll
    for (int a = 0; a < 2; ++a)
#pragma unroll
        for (int b = 0; b < 2; ++b)
#pragma unroll
            for (int m = 0; m < 4; ++m)
#pragma unroll
                for (int n = 0; n < 2; ++n) acc[a][b][m][n] = (f32x4){0.f, 0.f, 0.f, 0.f};
    bf16x8 At[4][2], B0[2][2], B1[2][2];
    const char* cA = (const char*)g.A + (size_t)cur.pm * tstep; const char* cB = (const char*)g.Bt + (size_t)cur.pn * tstep;
    S.a_ready(cur);
    if constexpr (SP2) {
        PG8_STAGE(PG8_SB(0, 0), cB, voffB); PG8_STAGE(PG8_SB(0, 1), cB + hstep, voffB); PG8_STAGE(PG8_SA(0, 0), cA, voffA); PG8_STAGE(PG8_SA(0, 1), cA + hstep, voffA);
        if (wr == 1) PG8_BAR;
        PG8_WAIT_V(2); PG8_BAR;
        PG8_STAGE(PG8_SB(1, 0), cB + kstep, voffB); PG8_STAGE(PG8_SA(1, 0), cA + kstep, voffA); PG8_STAGE(PG8_SB(1, 1), cB + hstep + kstep, voffB);
        PG8_WAIT_V(6); PG8_BAR;
    } else {
        PG8_STAGE(PG8_SB(0, 0), cB, voffB); PG8_STAGE(PG8_SA(0, 0), cA, voffA); PG8_STAGE(PG8_SB(0, 1), cB + hstep, voffB); PG8_STAGE(PG8_SA(0, 1), cA + hstep, voffA);
        if (wr == 1) PG8_BAR;
        PG8_WAIT_V(4); PG8_BAR;
        PG8_STAGE(PG8_SB(1, 0), cB + kstep, voffB); PG8_STAGE(PG8_SA(1, 0), cA + kstep, voffA); PG8_STAGE(PG8_SB(1, 1), cB + hstep + kstep, voffB);
        PG8_WAIT_V(6); PG8_BAR;
    }
    for (;;) {
        const bool has_next = S.next(ui + 1, nxt);
        const char* nA = has_next ? (const char*)g.A + (size_t)nxt.pm * tstep : cA; const char* nB = has_next ? (const char*)g.Bt + (size_t)nxt.pn * tstep : cB;
        for (int t = 0; t < nt; t += 2) {
            const bool last = (t == nt - 2);
            const char* a1 = cA + (size_t)(t + 1) * kstep;
            const char* a2 = last ? nA : cA + (size_t)(t + 2) * kstep; const char* b2 = last ? nB : cB + (size_t)(t + 2) * kstep;
            const char* a3 = a2 + kstep; const char* b3 = b2 + kstep;
            if (last && has_next) S.a_ready(nxt);
            if constexpr (SP2) {
            PG8_LDB(B0, 0, 0); PG8_LDB(B1, 0, 1); PG8_SCHED; PG8_LDA(At, 0, 0); PG8_STAGE(PG8_SA(1, 1), a1 + hstep, voffA);
            PG8_WAIT_V(8); PG8_WAIT_L(0); PG8_BAR; PG8_MMA(0, 0, At, B0); PG8_MMA(0, 1, At, B1); PG8_BAR; PG8_SCHED;
            PG8_LDA(At, 0, 1); PG8_STAGE(PG8_SB(0, 0), b2, voffB); PG8_STAGE(PG8_SB(0, 1), b2 + hstep, voffB); PG8_STAGE(PG8_SA(0, 0), a2, voffA);
            PG8_WAIT_V(8); PG8_WAIT_L(0); PG8_BAR; PG8_MMA(1, 0, At, B0); PG8_MMA(1, 1, At, B1); PG8_BAR; PG8_SCHED;
            PG8_LDB(B0, 1, 0); PG8_LDB(B1, 1, 1); PG8_SCHED; PG8_LDA(At, 1, 0); PG8_STAGE(PG8_SA(0, 1), a2 + hstep, voffA);
            PG8_WAIT_V(8); PG8_WAIT_L(0); PG8_BAR; PG8_MMA(0, 0, At, B0); PG8_MMA(0, 1, At, B1); PG8_BAR; PG8_SCHED;
            PG8_LDA(At, 1, 1); PG8_STAGE(PG8_SB(1, 0), b3, voffB); PG8_STAGE(PG8_SB(1, 1), b3 + hstep, voffB); PG8_STAGE(PG8_SA(1, 0), a3, voffA);
            PG8_WAIT_V(8); PG8_WAIT_L(0); PG8_BAR; PG8_MMA(1, 0, At, B0); PG8_MMA(1, 1, At, B1); PG8_BAR; PG8_SCHED;
            } else {
            PG8_LDB(B0, 0, 0); PG8_SCHED; PG8_LDA(At, 0, 0); PG8_STAGE(PG8_SA(1, 1), a1 + hstep, voffA);
            PG8_WAIT_L(8); PG8_BAR; PG8_WAIT_L(0); PG8_MMA(0, 0, At, B0); PG8_BAR; PG8_SCHED;
            PG8_LDB(B1, 0, 1); PG8_STAGE(PG8_SB(0, 0), b2, voffB);
            PG8_BAR; PG8_WAIT_L(0); PG8_MMA(0, 1, At, B1); PG8_BAR;
            PG8_LDA(At, 0, 1); PG8_STAGE(PG8_SA(0, 0), a2, voffA);
            PG8_BAR; PG8_WAIT_L(0); PG8_MMA(1, 0, At, B0); PG8_BAR; PG8_SCHED;
            PG8_STAGE(PG8_SB(0, 1), b2 + hstep, voffB);
            PG8_WAIT_V(6); PG8_BAR; PG8_MMA(1, 1, At, B1); PG8_BAR;
            PG8_LDB(B0, 1, 0); PG8_SCHED; PG8_LDA(At, 1, 0); PG8_STAGE(PG8_SA(0, 1), a2 + hstep, voffA);
            PG8_WAIT_L(8); PG8_BAR; PG8_WAIT_L(0); PG8_MMA(0, 0, At, B0); PG8_BAR; PG8_SCHED;
            PG8_LDB(B1, 1, 1); PG8_STAGE(PG8_SB(1, 0), b3, voffB);
            PG8_BAR; PG8_WAIT_L(0); PG8_MMA(0, 1, At, B1); PG8_BAR;
            PG8_LDA(At, 1, 1); PG8_STAGE(PG8_SA(1, 0), a3, voffA);
            PG8_BAR; PG8_WAIT_L(0); PG8_MMA(1, 0, At, B0); PG8_BAR; PG8_SCHED;
            PG8_STAGE(PG8_SB(1, 1), b3 + hstep, voffB);
            PG8_WAIT_V(6); PG8_BAR; PG8_MMA(1, 1, At, B1); PG8_BAR;
            }
        }
        if constexpr (ALIGN_EPI) { if (wr == 0) PG8_BAR; }
        if constexpr (!Epi::AFTER_DRAIN) { E(acc, cur, wr, wc, fr, fq); S.done(cur); }
        if (!has_next) break;
#pragma unroll
        for (int a = 0; a < 2; ++a)
#pragma unroll
            for (int b = 0; b < 2; ++b)
#pragma unroll
                for (int m = 0; m < 4; ++m)
#pragma unroll
                    for (int n = 0; n < 2; ++n) acc[a][b][m][n] = (f32x4){0.f, 0.f, 0.f, 0.f};
        cur = nxt; cA = nA; cB = nB; ++ui;
        if constexpr (ALIGN_EPI) { if (wr == 1) PG8_BAR; }
    }
    PG8_WAIT_V(0);
    if constexpr (!ALIGN_EPI) { if (wr == 0) PG8_BAR; }
    PG8_BAR;
    if constexpr (Epi::AFTER_DRAIN) { E.fused(acc, cur, wr, wc, fr, fq, lds, wid, lane); S.done(cur); }
#undef PG8_SA
#undef PG8_SB
#undef PG8_STAGE
#undef PG8_LDA
#undef PG8_LDB
#undef PG8_MMA
#undef PG8_WAIT_V
#undef PG8_WAIT_L
#undef PG8_BAR
#undef PG8_SCHED
}

}

constexpr size_t MiB = 1u << 20;
constexpr size_t WS_CTL = 0, CTL_ZERO_BYTES = 1 * MiB;
constexpr size_t WS_ROPE = 1 * MiB;
constexpr size_t WS_LW2 = 3 * MiB, WS_LA2 = 4 * MiB, WS_LG2 = 5 * MiB;
constexpr size_t WS_H = 8 * MiB, WS_WIN = WS_H + (size_t)MPAD * DM * 2;
constexpr size_t WS_WPA = 8 * MiB, WS_WPR = 24 * MiB, WS_WOUT = 40 * MiB, WS_OATT = 72 * MiB, WS_WD = 104 * MiB;
constexpr size_t WS_G = 216 * MiB, WS_A2 = 216 * MiB;
constexpr size_t WS_Q = 344 * MiB, WS_K = 376 * MiB, WS_VT = 385 * MiB, WS_U = 394 * MiB;
constexpr size_t WS_Y = 394 * MiB;
constexpr size_t WS_P1 = 344 * MiB, WS_H2 = 344 * MiB, WS_MX = 474 * MiB;
constexpr size_t SCF = (size_t)LTOK * RC * 4, SCB = (size_t)LTOK * RC * 2;
constexpr size_t WS_W0 = 524 * MiB, WS_W1 = WS_W0 + SCF, WS_KD0 = WS_W1 + SCF, WS_KD1 = WS_KD0 + SCB, WS_B0 = WS_KD1 + SCB, WS_B1 = WS_B0 + SCB, WS_KK = WS_B1 + SCB, WS_RR = WS_KK + SCB, WS_VV = WS_RR + SCB, WS_SCEND = WS_VV + SCB;
constexpr size_t WS_HID = 640 * MiB;
constexpr size_t WS_WGU = 878 * MiB, WS_GG = 1050 * MiB, WS_ORWKV = 1083 * MiB, WS_END = 1115 * MiB;
static_assert(WS_WIN + (size_t)INWP * DM * 2 <= WS_G && WS_WD + (size_t)DM * DFF * 2 <= WS_G && WS_OATT + (size_t)SEQ * ATTW * 2 <= WS_WD, "map: R");
static_assert(WS_U + (size_t)MPAD * UPITCH * 2 <= WS_W0 && WS_VT + (size_t)KVW * MPAD * 2 <= WS_U && WS_K + (size_t)MPAD * KVW * 2 <= WS_VT && WS_Q + (size_t)SEQ * ATTW * 2 <= WS_K, "map: P1 outputs");
static_assert(WS_Y + 2 * SCF <= WS_W0 && WS_P1 + (size_t)SEQ * DM * 4 <= WS_MX && WS_MX + (size_t)SEQ * DM * 2 <= WS_HID, "map: overlays");
static_assert(WS_SCEND <= WS_WGU && WS_HID + (size_t)SEQ * DFF * 2 <= WS_WGU && WS_WGU + (size_t)2 * DFF * DM * 2 <= WS_GG && WS_GG + SCB <= WS_ORWKV && WS_ORWKV + (size_t)SEQ * RC * 2 <= WS_END, "map: tail");
constexpr int CW_BAR = 4096;
constexpr int CW_SS2 = 65536, CW_SS3 = 65536 + 8192;
static_assert((CW_SS3 + 8192) * 4 <= (int)CTL_ZERO_BYTES, "CTL");

constexpr int RING_BYTES = 131072;
constexpr int LDSCTL_OFF = RING_BYTES, MISC_OFF = LDSCTL_OFF + 320;
constexpr int LDS_BYTES = 147456;

#define GAS __attribute__((address_space(1)))
#define LAS __attribute__((address_space(3)))
typedef unsigned short bf16;
typedef unsigned v4u __attribute__((ext_vector_type(4)));
typedef unsigned v2u __attribute__((ext_vector_type(2)));
typedef float f32x4 __attribute__((ext_vector_type(4)));
typedef float f32x2 __attribute__((ext_vector_type(2)));
typedef float f32x16 __attribute__((ext_vector_type(16)));
typedef short bf16x8 __attribute__((ext_vector_type(8)));
typedef GAS unsigned gu32;
#define RLX_AGENT __ATOMIC_RELAXED, __HIP_MEMORY_SCOPE_AGENT
#define LDS_WAIT() asm volatile("s_waitcnt lgkmcnt(0)" ::: "memory")
__device__ __forceinline__ unsigned f2bf(float f) { unsigned u = __builtin_bit_cast(unsigned, f); return (u + 0x7fffu + ((u >> 16) & 1u)) >> 16; }
__device__ __forceinline__ unsigned pk2(float lo, float hi) { return f2bf(lo) | (f2bf(hi) << 16); }
__device__ __forceinline__ float bf2f(bf16 b) { return __uint_as_float(((unsigned)b) << 16); }
using pg8::bflo; using pg8::bfhi; using pg8::sigmoidf_;

#define XB_TMO      128
#define XB_XCNT(j)  (256  + 64 * (j))
#define XB_XSUB(j)  (1280 + 64 * (j))
#define XB_XGEN(j)  (2304 + 64 * (j))
#define XB_TOP      3328
#define XB_TOPGEN   3392
#define XCD_BAR_WORDS 3456
#define XB_SPIN_CAP (1u << 18)

__device__ __forceinline__ unsigned xb_ld(unsigned* p)              { return __hip_atomic_load(p, __ATOMIC_RELAXED, __HIP_MEMORY_SCOPE_AGENT); }
__device__ __forceinline__ unsigned xb_add(unsigned* p, unsigned v) { return __hip_atomic_fetch_add(p, v, __ATOMIC_RELAXED, __HIP_MEMORY_SCOPE_AGENT); }
__device__ __forceinline__ unsigned xb_xcc_id() { return (unsigned)__builtin_amdgcn_s_getreg((3 << 11) | 20) & 0xFu; }
#define XB_SPIN(cond, bar) do { unsigned _sp = 0; while (cond) { __builtin_amdgcn_s_sleep(1); \
    if ((++_sp & 255u) == 0u) { if (xb_ld(&(bar)[XB_TMO])) break; if (_sp > XB_SPIN_CAP) { atomicAdd(&(bar)[XB_TMO], 1u); break; } } } } while (0)

struct XcdBarrier {
    unsigned* bar; unsigned x;
    volatile LAS unsigned* st;
};

__device__ __forceinline__ XcdBarrier xcd_barrier_post(unsigned* bar, volatile LAS unsigned* st) {
    XcdBarrier b; b.bar = bar; b.x = xb_xcc_id(); b.st = st;
    if (threadIdx.x == 0) (void)xb_add(&bar[XB_XCNT(b.x)], 1u);
    return b;
}
__device__ __forceinline__ void xcd_barrier_complete(unsigned* bar, unsigned x, unsigned& nloc, unsigned& nx) {
    const unsigned G = gridDim.x * gridDim.y * gridDim.z;
    unsigned sum, cnt, mine, sp = 0u;
    for (;;) {
        sum = 0u; cnt = 0u; mine = 0u;
#pragma unroll
        for (unsigned j = 0; j < 16; ++j) { const unsigned c = xb_ld(&bar[XB_XCNT(j)]); sum += c; cnt += (c > 0u) ? 1u : 0u; mine = (j == x) ? c : mine; }
        if (sum == G) break;
        __builtin_amdgcn_s_sleep(1);
        if ((++sp & 255u) == 0u) { if (xb_ld(&bar[XB_TMO])) break; if (sp > XB_SPIN_CAP) { atomicAdd(&bar[XB_TMO], 1u); break; } }
    }
    nloc = mine > 0u ? mine : 1u; nx = cnt > 0u ? cnt : 1u;
}

__device__ __forceinline__ void xcd_barrier(const XcdBarrier& b) {
    asm volatile("s_waitcnt vmcnt(0)" ::: "memory");
    __syncthreads();
    if (threadIdx.x == 0) {
        unsigned* bar = b.bar;
        __builtin_amdgcn_s_waitcnt(0);
        unsigned nloc = b.st[0], nx = b.st[1];
        if (nloc == 0u) { xcd_barrier_complete(bar, b.x, nloc, nx); b.st[0] = nloc; b.st[1] = nx; }
        const unsigned old = xb_add(&bar[XB_XSUB(b.x)], 1u);
        const unsigned gen = old / nloc;
        if (old + 1u == (gen + 1u) * nloc) {
            __builtin_amdgcn_fence(__ATOMIC_RELEASE, "agent");
            asm volatile("s_waitcnt vmcnt(0)" ::: "memory");
            const unsigned og = xb_add(&bar[XB_TOP], 1u);
            const unsigned tg = og / nx;
            if (og + 1u == (tg + 1u) * nx) xb_add(&bar[XB_TOPGEN], 1u);
            else XB_SPIN(xb_ld(&bar[XB_TOPGEN]) == tg, bar);
            __builtin_amdgcn_fence(__ATOMIC_ACQUIRE, "agent");
            xb_add(&bar[XB_XGEN(b.x)], 1u);
            asm volatile("s_waitcnt vmcnt(0)" ::: "memory");
        } else {
            XB_SPIN(xb_ld(&bar[XB_XGEN(b.x)]) == gen, bar);
            __builtin_amdgcn_fence(__ATOMIC_ACQUIRE, "agent");
            asm volatile("s_waitcnt vmcnt(0)" ::: "memory");
        }
    }
    __syncthreads();
}


struct Frame {
    LAS unsigned char* lds;
    volatile LAS unsigned* MISC;
    gu32* ctl;
    int tid, lane, wave, G;
    unsigned char* ws;
    const float* in[26];
    float* out;
    unsigned long long pb0, pacc;
};
#define FPB0(k) do { if ((PROBE_PHASE >> (k)) & 1) F.pb0 = __builtin_amdgcn_s_memrealtime(); } while (0)
#define FPB1(k) do { if ((PROBE_PHASE >> (k)) & 1) F.pacc += __builtin_amdgcn_s_memrealtime() - F.pb0; } while (0)
__device__ __forceinline__ float wave_sum(float v) {
#pragma unroll
    for (int o = 1; o < 64; o <<= 1) v += __shfl_xor(v, o);
    return v;
}

template <int MODE> __device__ __forceinline__ void transpose_item(const float* W, int K, int N, bf16* WT, LAS float* scr, int item, int lane, const float* kscale) {
    const int nblk = N / 32, kb = item / nblk, nb = item % nblk, k0 = 64 * kb, n0 = 32 * nb;
    float wv[32];
#pragma unroll
    for (int i = 0; i < 32; ++i) wv[i] = W[(size_t)(k0 + 2 * i + (lane >> 5)) * N + n0 + (lane & 31)];
#pragma unroll
    for (int i = 0; i < 32; ++i) { const int kk = 2 * i + (lane >> 5); float v = wv[i]; if (kscale) v *= kscale[k0 + kk]; scr[kk * 33 + (lane & 31)] = v; }
    LDS_WAIT(); asm volatile("" ::: "memory");
    const int c = lane & 7;
#pragma unroll
    for (int j = 0; j < 4; ++j) { const int n = (lane >> 3) + 8 * j; const LAS float* s = scr + (8 * c) * 33 + n;
        v4u o; o.x = pk2(s[0 * 33], s[1 * 33]); o.y = pk2(s[2 * 33], s[3 * 33]); o.z = pk2(s[4 * 33], s[5 * 33]); o.w = pk2(s[6 * 33], s[7 * 33]);
        const int nn = n0 + n; const int dr = (MODE == 0) ? nn : (256 * (nn >> 7) + (nn & 127) + (MODE == 2 ? 128 : 0));
        *(GAS v4u*)(WT + (size_t)dr * K + k0 + 8 * c) = o; }
    LDS_WAIT(); asm volatile("" ::: "memory");
}
__device__ __forceinline__ void rms_row_to_bf16(int lane, const float* xrow, const float* w, bf16* orow) {
    const GAS f32x4* xr = (const GAS f32x4*)xrow + lane;
    f32x4 v[16]; float s = 0.f;
#pragma unroll
    for (int j = 0; j < 16; ++j) { v[j] = xr[64 * j]; s += (v[j].x * v[j].x + v[j].y * v[j].y) + (v[j].z * v[j].z + v[j].w * v[j].w); }
    const float rstd = 1.f / sqrtf(wave_sum(s) * (1.f / DM) + RMS_EPS);
    const GAS f32x4* wr = (const GAS f32x4*)w + lane;
    GAS v2u* o8 = (GAS v2u*)orow + lane;
#pragma unroll
    for (int j = 0; j < 16; ++j) { const f32x4 ww = wr[64 * j]; v2u o; o.x = pk2(v[j].x * rstd * ww.x, v[j].y * rstd * ww.y); o.y = pk2(v[j].z * rstd * ww.z, v[j].w * rstd * ww.w); o8[64 * j] = o; }
}
__device__ const double ROPE_INV[16] = {
    1.0000000000000000000000000e+0,
    4.4036660267178047359198331e-1,
    1.9392274474868577334259386e-1,
    8.5397100285765611280149662e-2,
    3.7606030930863935681246092e-2,
    1.6560440080994445548947445e-2,
    7.2926647372171090477661219e-3,
    3.2114459947525910185434889e-3,
    1.4142135623730950488016887e-3,
    6.2277242191459597955502746e-4,
    2.7424817567620731825332265e-4,
    1.2076973741146503832424826e-4,
    5.3182958969449886162502429e-5,
    2.3419998961409341542188076e-5,
    1.0313385377212458859810127e-5,
    4.5416704806078696531998012e-6
};

__device__ __forceinline__ void p0_prologue(Frame& F) {
    LAS float* scr = (LAS float*)(F.lds + F.wave * 16384);
    const int gw = blockIdx.x * 8 + F.wave, NGW = F.G * 8;
    bf16* Wint = (bf16*)(F.ws + WS_WIN); bf16* H = (bf16*)(F.ws + WS_H);
    constexpr int I_IN = (DM / 64) * (INW / 32);
    for (int it = gw; it < I_IN; it += NGW) transpose_item<0>(F.in[3], DM, INW, Wint, scr, it, F.lane, nullptr);
    for (int m = gw; m < MPAD + (INWP - INW); m += NGW) {
        if (m < SEQ) rms_row_to_bf16(F.lane, F.in[0] + (size_t)m * DM, F.in[2], H + (size_t)m * DM);
        else if (m < LTOK) rms_row_to_bf16(F.lane, F.in[1] + (size_t)(m - SEQ) * DM, F.in[2], H + (size_t)m * DM);
        else { bf16* row = (m < MPAD) ? H + (size_t)m * DM : Wint + (size_t)(INW + (m - MPAD)) * DM; GAS v4u* o = (GAS v4u*)row + F.lane;
#pragma unroll
            for (int j = 0; j < 8; ++j) o[64 * j] = (v4u){0u, 0u, 0u, 0u}; }
    }
    const int gt = blockIdx.x * 512 + F.tid, NGT = F.G * 512;
    float* rope = (float*)(F.ws + WS_ROPE);
    for (int i = gt; i < LTOK * 16; i += NGT) { const int pos = i >> 4, k = i & 15;
        const double ang = (double)pos * ROPE_INV[k]; const double kq = __builtin_rint(ang * 0.15915494309189535);
        const double red = (ang - kq * 6.28318530717958623) - kq * 2.4492935982947064e-16; const float rf = (float)red;
        rope[2 * i] = cosf(rf); rope[2 * i + 1] = sinf(rf); }
    bf16* w2t = (bf16*)(F.ws + WS_LW2); bf16* a2t = (bf16*)(F.ws + WS_LA2); bf16* g2t = (bf16*)(F.ws + WS_LG2);
    for (int i = gt; i < 2 * 96 * RC; i += NGT) { const int c = i % RC, j = (i / RC) % 96, d = i / (RC * 96);
        w2t[((size_t)d * RC + c) * 96 + j] = (bf16)f2bf(F.in[8][i]); a2t[((size_t)d * RC + c) * 96 + j] = (bf16)f2bf(F.in[10][i]); }
    for (int i = gt; i < 256 * RC; i += NGT) { const int c = i % RC, j = i / RC; g2t[(size_t)c * 256 + j] = (bf16)f2bf(F.in[11][i]); }
}

__device__ __forceinline__ int crow(int r, int hi) { return (r & 3) + 8 * (r >> 2) + 4 * hi; }
__device__ __forceinline__ void attn_phase(Frame& F, const int gw, const int NGW) {
    const bf16* Q = (const bf16*)(F.ws + WS_Q); const bf16* K = (const bf16*)(F.ws + WS_K); const bf16* Vt = (const bf16*)(F.ws + WS_VT); bf16* OA = (bf16*)(F.ws + WS_OATT);
    const float* sink = F.in[17];
    const int hh = F.lane >> 5, r = F.lane & 31;
    constexpr float SC = 0.08838834764831845f * 1.4426950408889634f, L2E = 1.4426950408889634f;
    for (int item = gw; item < 4096; item += NGW) {
        const int sub = item & 3, hq = (item >> 2) & 15, qb = item >> 6, q0 = qb * 128 + sub * 32, hk = hq >> 2;
        bf16x8 bq[8];
        { const bf16* qp = Q + (size_t)(q0 + r) * ATTW + hq * 128 + 8 * hh;
#pragma unroll
          for (int s = 0; s < 8; ++s) bq[s] = *(const bf16x8*)(qp + 16 * s); }
        f32x16 O[4];
#pragma unroll
        for (int dt = 0; dt < 4; ++dt)
#pragma unroll
            for (int i = 0; i < 16; ++i) O[dt][i] = 0.f;
        float m = sink[hq] * L2E, l = (hh == 0) ? 1.f : 0.f;
        for (int ti = 0; ti < 10; ++ti) {
            const bool meta = (ti == 9);
            const int key0 = meta ? SEQ : q0 + 32 * (ti - 4);
            if (key0 < 0 || (!meta && key0 >= SEQ)) continue;
            f32x16 st;
#pragma unroll
            for (int i = 0; i < 16; ++i) st[i] = 0.f;
            { const bf16* kp = K + (size_t)(key0 + r) * KVW + hk * 128 + 8 * hh;
#pragma unroll
              for (int s = 0; s < 8; ++s) { const bf16x8 ak = *(const bf16x8*)(kp + 16 * s); st = __builtin_amdgcn_mfma_f32_32x32x16_bf16(ak, bq[s], st, 0, 0, 0); } }
            float tmax = -__builtin_inff();
#pragma unroll
            for (int i = 0; i < 16; ++i) { const int kr = crow(i, hh); bool ok;
                if (meta) ok = kr < NMETA; else { const int dlt = (key0 + kr) - (q0 + r); ok = (dlt >= -128) && (dlt <= 128); }
                const float t = ok ? st[i] * SC : -__builtin_inff(); st[i] = t; tmax = fmaxf(tmax, t); }
            tmax = fmaxf(tmax, __shfl_xor(tmax, 32));
            const float mn = fmaxf(m, tmax), alpha = __builtin_amdgcn_exp2f(m - mn); m = mn;
            float ps = 0.f;
#pragma unroll
            for (int i = 0; i < 16; ++i) { const float p = __builtin_amdgcn_exp2f(st[i] - mn); st[i] = p; ps += p; }
            l = l * alpha + ps;
#pragma unroll
            for (int dt = 0; dt < 4; ++dt)
#pragma unroll
                for (int i = 0; i < 16; ++i) O[dt][i] *= alpha;
            bf16x8 pb[2];
#pragma unroll
            for (int s2 = 0; s2 < 2; ++s2) { v4u w; w.x = pg8::cvt_pk_bf16(st[8 * s2 + 0], st[8 * s2 + 1]); w.y = pg8::cvt_pk_bf16(st[8 * s2 + 2], st[8 * s2 + 3]);
                w.z = pg8::cvt_pk_bf16(st[8 * s2 + 4], st[8 * s2 + 5]); w.w = pg8::cvt_pk_bf16(st[8 * s2 + 6], st[8 * s2 + 7]); pb[s2] = __builtin_bit_cast(bf16x8, w); }
#pragma unroll
            for (int dt = 0; dt < 4; ++dt) { const bf16* vp = Vt + (size_t)(hk * 128 + 32 * dt + r) * MPAD + key0 + 4 * hh;
#pragma unroll
                for (int s2 = 0; s2 < 2; ++s2) { const v2u lo = *(const v2u*)(vp + 16 * s2), hi = *(const v2u*)(vp + 16 * s2 + 8);
                    const v4u w = {lo.x, lo.y, hi.x, hi.y}; O[dt] = __builtin_amdgcn_mfma_f32_32x32x16_bf16(__builtin_bit_cast(bf16x8, w), pb[s2], O[dt], 0, 0, 0); } }
        }
        l += __shfl_xor(l, 32);
        const float inv = 1.0f / l;
        bf16* op = OA + (size_t)(q0 + r) * ATTW + hq * 128 + 4 * hh;
#pragma unroll
        for (int dt = 0; dt < 4; ++dt)
#pragma unroll
            for (int g4 = 0; g4 < 4; ++g4) { v2u w; w.x = pg8::cvt_pk_bf16(O[dt][4 * g4 + 0] * inv, O[dt][4 * g4 + 1] * inv); w.y = pg8::cvt_pk_bf16(O[dt][4 * g4 + 2] * inv, O[dt][4 * g4 + 3] * inv);
                *(v2u*)(op + 32 * dt + 8 * g4) = w; }
    }
}

__device__ __forceinline__ int tok2row(int t) { return t < NMETA ? SEQ + t : t - NMETA; }
struct Sh8 { v4u uc, up, un; };
__device__ __forceinline__ Sh8 shift8_ld(const bf16* U, int t, int col) {
    const int tc = t < LTOK ? t : LTOK - 1, tp = (t >= 1 && t - 1 < LTOK) ? t - 1 : 0, tn = t + 1 < LTOK ? t + 1 : LTOK - 1;
    Sh8 s; s.uc = *(const v4u*)(U + (size_t)tok2row(tc) * UPITCH + col); s.up = *(const v4u*)(U + (size_t)tok2row(tp) * UPITCH + col); s.un = *(const v4u*)(U + (size_t)tok2row(tn) * UPITCH + col); return s; }
__device__ __forceinline__ void shift8_fin(const Sh8& s, int t, int col, const float* mu_p, const float* mu_n, float (&x)[8]) {
    const v4u zz = {0u, 0u, 0u, 0u};
    const v4u uc = t < LTOK ? s.uc : zz, up = (t >= 1 && t - 1 < LTOK) ? s.up : zz, un = t + 1 < LTOK ? s.un : zz;
    const f32x4 mp0 = *(const f32x4*)(mu_p + col), mp1 = *(const f32x4*)(mu_p + col + 4), mn0 = *(const f32x4*)(mu_n + col), mn1 = *(const f32x4*)(mu_n + col + 4);
    const unsigned ucw[4] = {uc.x, uc.y, uc.z, uc.w}, upw[4] = {up.x, up.y, up.z, up.w}, unw[4] = {un.x, un.y, un.z, un.w};
    const float mpw[8] = {mp0[0], mp0[1], mp0[2], mp0[3], mp1[0], mp1[1], mp1[2], mp1[3]}, mnw[8] = {mn0[0], mn0[1], mn0[2], mn0[3], mn1[0], mn1[1], mn1[2], mn1[3]};
#pragma unroll
    for (int e = 0; e < 8; ++e) { const float c0 = (e & 1) ? bfhi(ucw[e >> 1]) : bflo(ucw[e >> 1]), p0 = (e & 1) ? bfhi(upw[e >> 1]) : bflo(upw[e >> 1]), n0 = (e & 1) ? bfhi(unw[e >> 1]) : bflo(unw[e >> 1]);
        x[e] = c0 + mpw[e] * (p0 - c0) + mnw[e] * (n0 - c0); }
}
__device__ __forceinline__ void flush_bf16(const LAS bf16* tile, bf16* ARR, int t0, int cbase, int lane) {
#pragma unroll
    for (int h = 0; h < 2; ++h) { const int row = (lane >> 2) + 16 * h, ch = lane & 3; const v4u v = *(const LAS v4u*)(tile + row * 32 + 8 * ch);
        if (t0 + row < LTOK) *(v4u*)(ARR + (size_t)(t0 + row) * RC + cbase + 8 * ch) = v; }
}
__device__ __forceinline__ void flush_f32(const LAS float* tile, float* ARR, int t0, int cbase, int lane) {
#pragma unroll
    for (int h = 0; h < 4; ++h) { const int row = (lane >> 3) + 8 * h, ch = lane & 7; const f32x4 v = *(const LAS f32x4*)(tile + row * 32 + 4 * ch);
        if (t0 + row < LTOK) *(f32x4*)(ARR + (size_t)(t0 + row) * RC + cbase + 4 * ch) = v; }
}
__device__ __forceinline__ void prep_phase(Frame& F) {
    constexpr int XS = 648;
    LAS bf16* Xs = (LAS bf16*)F.lds;
    LAS bf16* Kt = (LAS bf16*)(F.lds + 41472 + F.wave * 8192);
    LAS bf16* Ot = Kt + 2048;
    const bf16* U = (const bf16*)(F.ws + WS_U);
    const float* mu_p = F.in[5]; const float* mu_n = F.in[6];
    const bf16* w2t = (const bf16*)(F.ws + WS_LW2); const bf16* a2t = (const bf16*)(F.ws + WS_LA2); const bf16* g2t = (const bf16*)(F.ws + WS_LG2);
    float* W0 = (float*)(F.ws + WS_W0); float* W1 = (float*)(F.ws + WS_W1);
    bf16* KD0 = (bf16*)(F.ws + WS_KD0); bf16* KD1 = (bf16*)(F.ws + WS_KD1); bf16* B0 = (bf16*)(F.ws + WS_B0); bf16* B1 = (bf16*)(F.ws + WS_B1);
    bf16* KK = (bf16*)(F.ws + WS_KK); bf16* RR = (bf16*)(F.ws + WS_RR); bf16* VV = (bf16*)(F.ws + WS_VV); bf16* GG = (bf16*)(F.ws + WS_GG);
    const int hh = F.lane >> 5, r = F.lane & 31;
    for (int unit = blockIdx.x; unit < 257 * 4; unit += F.G) {
        const int tt = unit >> 2, t0 = tt * 32, hd = (unit & 3) * 8 + F.wave;
        __syncthreads();
        FPB0(15);
        { Sh8 sx[5];
#pragma unroll
          for (int it = 0; it < 5; ++it) { const int ci = F.tid + 512 * it; sx[it] = shift8_ld(U, t0 + ci / 80, 3 * RC + 8 * (ci % 80)); }
#pragma unroll
          for (int it = 0; it < 5; ++it) { const int ci = F.tid + 512 * it, tl = ci / 80, ch = ci % 80;
            float x[8]; shift8_fin(sx[it], t0 + tl, 3 * RC + 8 * ch, mu_p, mu_n, x);
#pragma unroll
            for (int e = 0; e < 8; ++e) { float v = x[e];
                if (ch < 24) { const float ex = __expf(2.0f * v); v = 1.0f - 2.0f / (ex + 1.0f); }
                else if (ch >= 48) v = sigmoidf_(v);
                x[e] = v; }
            v4u o; o.x = pk2(x[0], x[1]); o.y = pk2(x[2], x[3]); o.z = pk2(x[4], x[5]); o.w = pk2(x[6], x[7]);
            *(LAS v4u*)(Xs + tl * XS + 8 * ch) = o; } }
        { const int c8 = hd * 64 + 8 * (F.lane & 7);
#pragma unroll
          for (int st = 0; st < 3; ++st) { const int col = (st == 0 ? RC : st == 1 ? 0 : 2 * RC) + c8; Sh8 sq[4];
#pragma unroll
            for (int q = 0; q < 4; ++q) sq[q] = shift8_ld(U, t0 + (F.lane >> 3) + 8 * q, col);
#pragma unroll
            for (int q = 0; q < 4; ++q) { const int tl = (F.lane >> 3) + 8 * q, tq = t0 + tl; float x[8]; shift8_fin(sq[q], tq, col, mu_p, mu_n, x);
                v4u o; o.x = pk2(x[0], x[1]); o.y = pk2(x[2], x[3]); o.z = pk2(x[4], x[5]); o.w = pk2(x[6], x[7]);
                if (st == 0) *(LAS v4u*)(Kt + tl * 64 + 8 * (F.lane & 7)) = o;
                else if (tq < LTOK) *(v4u*)((st == 1 ? RR : VV) + (size_t)tq * RC + c8) = o; } } }
        __syncthreads();
        FPB1(15); FPB0(16);
        float kp[2][16], ss[16];
#pragma unroll
        for (int i = 0; i < 16; ++i) ss[i] = 0.f;
#pragma unroll
        for (int ct = 0; ct < 2; ++ct) { const int c = hd * 64 + 32 * ct + r; const float kkw = F.in[12][c];
#pragma unroll
            for (int i = 0; i < 16; ++i) { kp[ct][i] = bf2f(Kt[crow(i, hh) * 64 + 32 * ct + r]); const float kr = kp[ct][i] * kkw; ss[i] += kr * kr; } }
#pragma unroll
        for (int i = 0; i < 16; ++i) {
#pragma unroll
            for (int o = 1; o < 32; o <<= 1) ss[i] += __shfl_xor(ss[i], o);
            ss[i] = 1.0f / fmaxf(sqrtf(ss[i]), 1e-12f); }
#define LDF(dst, ptr, n) do { _Pragma("unroll") for (int s_ = 0; s_ < (n); ++s_) dst[s_] = *(const bf16x8*)((ptr) + 16 * s_); } while (0)
#define MMF(frag, xoff, n) do { _Pragma("unroll") for (int i_ = 0; i_ < 16; ++i_) acc[i_] = 0.f; const LAS bf16* ap_ = Xs + r * XS + (xoff) + 8 * hh; \
            _Pragma("unroll") for (int s_ = 0; s_ < (n); ++s_) acc = __builtin_amdgcn_mfma_f32_32x32x16_bf16(*(const LAS bf16x8*)(ap_ + 16 * s_), frag[s_], acc, 0, 0, 0); } while (0)
#pragma unroll
        for (int ct = 0; ct < 2; ++ct) {
            const int c = hd * 64 + 32 * ct + r, cb = hd * 64 + 32 * ct;
            const float kkw = F.in[12][c], kaw = F.in[13][c];
            const bf16* pa0 = a2t + (size_t)c * 96 + 8 * hh; const bf16* pa1 = a2t + ((size_t)RC + c) * 96 + 8 * hh;
            const bf16* pw0 = w2t + (size_t)c * 96 + 8 * hh; const bf16* pw1 = w2t + ((size_t)RC + c) * 96 + 8 * hh; const bf16* pg = g2t + (size_t)c * 256 + 8 * hh;
            bf16x8 fa[6], fg[16]; f32x16 acc; float kk[16];
            LDF(fa, pa0, 6);
#pragma unroll
            for (int i = 0; i < 16; ++i) { kk[i] = kp[ct][i] * kkw * ss[i]; Ot[crow(i, hh) * 32 + r] = (bf16)f2bf(kk[i]); }
            flush_bf16(Ot, KK, t0, cb, F.lane);
#pragma unroll
            for (int d = 0; d < 2; ++d) {
                if (d == 0) { MMF(fa, 192, 6); LDF(fa, pa1, 6); } else { MMF(fa, 288, 6); LDF(fa, pw0, 6); }
                const float a0 = F.in[9][d * RC + c];
#pragma unroll
                for (int i = 0; i < 16; ++i) { acc[i] = sigmoidf_(a0 + acc[i]); Ot[crow(i, hh) * 32 + r] = (bf16)f2bf(kp[ct][i] * (1.0f + (acc[i] - 1.0f) * kaw)); }
                flush_bf16(Ot, d ? KD1 : KD0, t0, cb, F.lane);
#pragma unroll
                for (int i = 0; i < 16; ++i) Ot[crow(i, hh) * 32 + r] = (bf16)f2bf(kk[i] * acc[i]);
                flush_bf16(Ot, d ? B1 : B0, t0, cb, F.lane);
            }
#pragma unroll
            for (int d = 0; d < 2; ++d) {
                if (d == 0) { MMF(fa, 0, 6); LDF(fa, pw1, 6); } else { MMF(fa, 96, 6); LDF(fg, pg, 16); }
                const float w0 = F.in[7][d * RC + c]; LAS float* Of = (LAS float*)Ot;
#pragma unroll
                for (int i = 0; i < 16; ++i) Of[crow(i, hh) * 32 + r] = __expf(-0.6065306597126334f * sigmoidf_(w0 + acc[i]));
                flush_f32(Of, d ? W1 : W0, t0, cb, F.lane);
            }
            MMF(fg, 384, 16);
#pragma unroll
            for (int i = 0; i < 16; ++i) Ot[crow(i, hh) * 32 + r] = (bf16)f2bf(acc[i]);
            flush_bf16(Ot, GG, t0, cb, F.lane);
        }
#undef LDF
#undef MMF
        FPB1(16);
    }
    __syncthreads();
}

__device__ __forceinline__ float dpp_xor_add(float x, const int ctrl_sel) {
    int y;
    if (ctrl_sel == 0) y = __builtin_amdgcn_update_dpp(0, __float_as_int(x), 0xB1, 0xf, 0xf, true);
    else if (ctrl_sel == 1) y = __builtin_amdgcn_update_dpp(0, __float_as_int(x), 0x4E, 0xf, 0xf, true);
    else if (ctrl_sel == 2) y = __builtin_amdgcn_update_dpp(0, __float_as_int(x), 0x141, 0xf, 0xf, true);
    else y = __builtin_amdgcn_update_dpp(0, __float_as_int(x), 0x140, 0xf, 0xf, true);
    return x + __int_as_float(y);
}
__device__ __forceinline__ float row16_sum(float x) { x = dpp_xor_add(x, 0); x = dpp_xor_add(x, 1); x = dpp_xor_add(x, 2); x = dpp_xor_add(x, 3); return x; }
constexpr int SC_CH = 32, SC_STEP = 336, SC_BUF = SC_CH * SC_STEP;
struct ScanOps { f32x4 w, kd, b, kk, r; float v; };
__device__ __forceinline__ ScanOps scan_ld(const LAS float* sp, int jg, int rl) {
    ScanOps o; o.w = *(const LAS f32x4*)(sp + 4 * jg); o.kd = *(const LAS f32x4*)(sp + 64 + 4 * jg); o.b = *(const LAS f32x4*)(sp + 128 + 4 * jg);
    o.kk = *(const LAS f32x4*)(sp + 192 + 4 * jg); o.r = *(const LAS f32x4*)(sp + 256 + 4 * jg); o.v = sp[320 + rl]; return o; }
__device__ __forceinline__ void scan_consume(const LAS float* base, LAS float* yb, int jg, int rl, f32x2& S01, f32x2& S23) {
    ScanOps o0 = scan_ld(base, jg, rl), o1 = scan_ld(base + SC_STEP, jg, rl);
#pragma unroll
    for (int sl = 0; sl < SC_CH; ++sl) {
        ScanOps o2 = o1;
        if (sl + 2 < SC_CH) o2 = scan_ld(base + (sl + 2) * SC_STEP, jg, rl);
        const f32x2 kklo = __builtin_shufflevector(o0.kk, o0.kk, 0, 1), kkhi = __builtin_shufflevector(o0.kk, o0.kk, 2, 3);
        const f32x2 wlo = __builtin_shufflevector(o0.w, o0.w, 0, 1), whi = __builtin_shufflevector(o0.w, o0.w, 2, 3);
        const f32x2 kdlo = __builtin_shufflevector(o0.kd, o0.kd, 0, 1), kdhi = __builtin_shufflevector(o0.kd, o0.kd, 2, 3);
        const f32x2 blo = __builtin_shufflevector(o0.b, o0.b, 0, 1), bhi = __builtin_shufflevector(o0.b, o0.b, 2, 3);
        const f32x2 rlo = __builtin_shufflevector(o0.r, o0.r, 0, 1), rhi = __builtin_shufflevector(o0.r, o0.r, 2, 3);
        const f32x2 vv = {o0.v, o0.v};
        f32x2 m = S01 * kklo; m = S23 * kkhi + m;
        float p = m.x + m.y;
        const f32x2 u01 = S01 * wlo + vv * kdlo, u23 = S23 * whi + vv * kdhi;
        p = row16_sum(p);
        const f32x2 pp = {p, p};
        S01 = u01 - pp * blo; S23 = u23 - pp * bhi;
        f32x2 ym = S01 * rlo; ym = S23 * rhi + ym;
        float y = ym.x + ym.y;
        y = dpp_xor_add(y, 0); y = dpp_xor_add(y, 1); y = dpp_xor_add(y, 2);
        yb[sl * 64] = y;
        o0 = o1; o1 = o2;
    }
}
__device__ __forceinline__ void convert_item(Frame& F, LAS float* scr, int it) {
    constexpr int I_GU = (DM / 64) * (DFF / 32), I_P = (ATTW / 64) * (DM / 32), I_O = (DM / 64) * (DM / 32);
    int r = it;
    if (r < I_GU) { transpose_item<1>(F.in[22], DM, DFF, (bf16*)(F.ws + WS_WGU), scr, r, F.lane, F.in[21]); return; } r -= I_GU;
    if (r < I_GU) { transpose_item<2>(F.in[23], DM, DFF, (bf16*)(F.ws + WS_WGU), scr, r, F.lane, F.in[21]); return; } r -= I_GU;
    if (r < I_P) { transpose_item<0>(F.in[18], ATTW, DM, (bf16*)(F.ws + WS_WPA), scr, r, F.lane, nullptr); return; } r -= I_P;
    if (r < I_P) { transpose_item<0>(F.in[19], RC, DM, (bf16*)(F.ws + WS_WPR), scr, r, F.lane, nullptr); return; } r -= I_P;
    if (r < I_O) { transpose_item<0>(F.in[20], DM, DM, (bf16*)(F.ws + WS_WOUT), scr, r, F.lane, nullptr); return; } r -= I_O;
    transpose_item<0>(F.in[24], DFF, DM, (bf16*)(F.ws + WS_WD), scr, r, F.lane, nullptr);
}
constexpr int N_CONVERT_ITEMS = 2 * (DM / 64) * (DFF / 32) + 2 * (ATTW / 64) * (DM / 32) + (DM / 64) * (DM / 32) + (DFF / 64) * (DM / 32);
constexpr int SC_FLAGS_OFF = 102400, SC_WSCR_OFF = 103424;
__device__ __forceinline__ void scan_phase(Frame& F) {
    LAS float* BUF = (LAS float*)F.lds;
    LAS float* YB = (LAS float*)(F.lds + 2 * SC_BUF * 4);
    volatile LAS unsigned* FL = (volatile LAS unsigned*)(F.lds + SC_FLAGS_OFF);
    const float* W0 = (const float*)(F.ws + WS_W0); const float* W1 = (const float*)(F.ws + WS_W1);
    const bf16* KD0 = (const bf16*)(F.ws + WS_KD0); const bf16* KD1 = (const bf16*)(F.ws + WS_KD1); const bf16* B0 = (const bf16*)(F.ws + WS_B0); const bf16* B1 = (const bf16*)(F.ws + WS_B1);
    const bf16* KK = (const bf16*)(F.ws + WS_KK); const bf16* RR = (const bf16*)(F.ws + WS_RR); const bf16* VV = (const bf16*)(F.ws + WS_VV);
    float* Y = (float*)(F.ws + WS_Y);
    constexpr unsigned SPIN_CAP = 1u << 22;
    for (int item = blockIdx.x; item < 256; item += F.G) {
        __syncthreads();
        if (F.tid < 96) FL[F.tid] = 0u;
        __syncthreads();
        const int pair = (item & 7) * 8 + (item >> 5), q4 = (item >> 3) & 3, hd = pair >> 1, dir = pair & 1;
        const int nsteps = dir ? SEQ : LTOK, nchunks = (nsteps + SC_CH - 1) / SC_CH;
        if (F.wave < 4) {
            __builtin_amdgcn_s_setprio(3);
            f32x2 S01 = {0.f, 0.f}, S23 = {0.f, 0.f};
            const int g = F.lane >> 4, jg = F.lane & 15, rl = 4 * F.wave + g;
            const int yslot = ((jg & 7) == 0) ? (2 * rl + (jg >> 3)) : (32 + (F.lane & 31));
            for (int c = 0; c < nchunks; ++c) {
                { unsigned sp = 0; while (FL[0] <= (unsigned)c) { __builtin_amdgcn_s_sleep(1); if (++sp > SPIN_CAP) break; } }
                asm volatile("" ::: "memory");
                scan_consume(BUF + (c & 1) * SC_BUF, YB + (c & 1) * (SC_CH * 64) + yslot, jg, rl, S01, S23);
                asm volatile("s_waitcnt lgkmcnt(0)" ::: "memory");
                if (F.lane == 0) FL[16 + 16 * F.wave] = (unsigned)(c + 1);
            }
            __builtin_amdgcn_s_setprio(0);
        } else if (F.wave == 4) {
            __builtin_amdgcn_s_setprio(2);
            const float* Wd = dir ? W1 : W0; const bf16* KDd = dir ? KD1 : KD0; const bf16* Bd = dir ? B1 : B0;
            float* Yd = Y + (size_t)dir * LTOK * RC;
            const int lq = F.lane & 15, s4 = F.lane >> 4, slv = F.lane >> 1, qv0 = (F.lane & 1) * 2;
            f32x4 lw[8]; v2u lk[8][4]; v2u lv[2];
#define SCAN_ISSUE(c) do { _Pragma("unroll") for (int k_ = 0; k_ < 8; ++k_) { const int s_ = (c) * SC_CH + s4 + 4 * k_; const int sc_ = s_ < nsteps ? s_ : nsteps - 1; const int t_ = dir ? (LTOK - 1 - sc_) : sc_; \
                const size_t o_ = (size_t)t_ * RC + hd * 64 + 4 * lq; lw[k_] = *(const f32x4*)(Wd + o_); lk[k_][0] = *(const v2u*)(KDd + o_); lk[k_][1] = *(const v2u*)(Bd + o_); lk[k_][2] = *(const v2u*)(KK + o_); lk[k_][3] = *(const v2u*)(RR + o_); } \
            { const int s_ = (c) * SC_CH + slv; const int sc_ = s_ < nsteps ? s_ : nsteps - 1; const int t_ = dir ? (LTOK - 1 - sc_) : sc_; \
              _Pragma("unroll") for (int u_ = 0; u_ < 2; ++u_) lv[u_] = *(const v2u*)(VV + (size_t)t_ * RC + hd * 64 + 16 * q4 + 4 * (qv0 + u_)); } } while (0)
#define SCAN_WRITE(c) do { LAS float* dst_ = BUF + ((c) & 1) * SC_BUF; _Pragma("unroll") for (int k_ = 0; k_ < 8; ++k_) { const int sl_ = s4 + 4 * k_; const bool ok_ = (c) * SC_CH + sl_ < nsteps; LAS float* d_ = dst_ + sl_ * SC_STEP + 4 * lq; \
                *(LAS f32x4*)d_ = ok_ ? lw[k_] : (f32x4){1.f, 1.f, 1.f, 1.f}; \
                _Pragma("unroll") for (int a_ = 0; a_ < 4; ++a_) { const v2u w_ = lk[k_][a_]; *(LAS f32x4*)(d_ + 64 * (a_ + 1)) = ok_ ? (f32x4){bflo(w_.x), bfhi(w_.x), bflo(w_.y), bfhi(w_.y)} : (f32x4){0.f, 0.f, 0.f, 0.f}; } } \
            { const bool ok_ = (c) * SC_CH + slv < nsteps; _Pragma("unroll") for (int u_ = 0; u_ < 2; ++u_) { const v2u w_ = lv[u_]; \
                *(LAS f32x4*)(dst_ + slv * SC_STEP + 320 + 4 * (qv0 + u_)) = ok_ ? (f32x4){bflo(w_.x), bfhi(w_.x), bflo(w_.y), bfhi(w_.y)} : (f32x4){0.f, 0.f, 0.f, 0.f}; } } } while (0)
#define SCAN_FLUSH(c) do { const LAS float* yb_ = YB + ((c) & 1) * (SC_CH * 64); _Pragma("unroll") for (int u_ = 0; u_ < 8; ++u_) { const int pi_ = F.lane + 64 * u_; const int sl_ = pi_ >> 4, s_ = (c) * SC_CH + sl_; \
                if (s_ < nsteps) { const int t_ = dir ? (LTOK - 1 - s_) : s_; const f32x2 y2_ = *(const LAS f32x2*)(yb_ + sl_ * 64 + 2 * (pi_ & 15)); Yd[(size_t)t_ * RC + hd * 64 + 16 * q4 + (pi_ & 15)] = y2_.x + y2_.y; } } } while (0)
#define SCAN_WAIT_DONE(n) do { unsigned sp_ = 0; for (;;) { const unsigned d0_ = FL[16], d1_ = FL[32], d2_ = FL[48], d3_ = FL[64]; \
                const unsigned mn_ = min(min(d0_, d1_), min(d2_, d3_)); if (mn_ >= (unsigned)(n)) break; __builtin_amdgcn_s_sleep(1); if (++sp_ > SPIN_CAP) break; } asm volatile("" ::: "memory"); } while (0)
            SCAN_ISSUE(0); SCAN_WRITE(0);
            asm volatile("s_waitcnt lgkmcnt(0)" ::: "memory");
            if (F.lane == 0) FL[0] = 1u;
            SCAN_ISSUE(1);
            for (int c = 0; c < nchunks; ++c) {
                if (c >= 1) { SCAN_WAIT_DONE(c); SCAN_FLUSH(c - 1); }
                if (c + 1 < nchunks) { SCAN_WRITE(c + 1); asm volatile("s_waitcnt lgkmcnt(0)" ::: "memory"); if (F.lane == 0) FL[0] = (unsigned)(c + 2); }
                if (c + 2 < nchunks) SCAN_ISSUE(c + 2);
            }
            SCAN_WAIT_DONE(nchunks); SCAN_FLUSH(nchunks - 1);
            __builtin_amdgcn_s_setprio(0);
#undef SCAN_ISSUE
#undef SCAN_WRITE
#undef SCAN_FLUSH
#undef SCAN_WAIT_DONE
        } else if (item == (int)blockIdx.x) {
            const int gwk = blockIdx.x * 3 + (F.wave - 5), NWK = F.G * 3;
            attn_phase(F, gwk, NWK);
            LAS float* scr = (LAS float*)(F.lds + SC_WSCR_OFF + (F.wave - 5) * 8448);
            for (int it = gwk; it < N_CONVERT_ITEMS; it += NWK) convert_item(F, scr, it);
        }
    }
}

__device__ __forceinline__ void combine_phase(Frame& F) {
    const float* Y0 = (const float*)(F.ws + WS_Y); const float* Y1 = Y0 + (size_t)LTOK * RC;
    const bf16* VV = (const bf16*)(F.ws + WS_VV); const bf16* GG = (const bf16*)(F.ws + WS_GG); const bf16* RR = (const bf16*)(F.ws + WS_RR);
    const bf16* KD0 = (const bf16*)(F.ws + WS_KD0); const bf16* KD1 = (const bf16*)(F.ws + WS_KD1);
    bf16* OR = (bf16*)(F.ws + WS_ORWKV);
    const float* lnw = F.in[15]; const float* lnb = F.in[16]; const float* rk = F.in[14];
    const int gw = blockIdx.x * 8 + F.wave, NGW = F.G * 8;
    for (int row = gw; row < SEQ; row += NGW) { const int t = row + NMETA;
#pragma unroll 4
        for (int hd = 0; hd < RH; ++hd) { const int c = hd * 64 + F.lane; const size_t o = (size_t)t * RC + c;
            const float y = Y0[o] + Y1[o]; const float bterm = bf2f(RR[o]) * (bf2f(KD0[o]) + bf2f(KD1[o])) * rk[c];
            const float mean = wave_sum(y) * (1.0f / 64.0f); const float dlt = y - mean; const float var = wave_sum(dlt * dlt) * (1.0f / 64.0f); const float bonus = wave_sum(bterm);
            const float yn = dlt * (1.0f / sqrtf(var + GN_EPS)) * lnw[c] + lnb[c];
            const float outv = (yn + bonus * bf2f(VV[o])) * bf2f(GG[o]);
            OR[(size_t)row * RC + c] = (bf16)f2bf(outv); } }
}
__device__ __forceinline__ void final_phase(Frame& F) {
    const float* SS3 = (const float*)(F.ctl + CW_SS3); const float* w = F.in[25];
    const int gw = blockIdx.x * 8 + F.wave, NGW = F.G * 8;
    for (int row = gw; row < SEQ; row += NGW) { const float rstd = 1.0f / sqrtf(SS3[row] * (1.0f / DM) + RMS_EPS);
        GAS f32x4* p = (GAS f32x4*)(F.out + (size_t)row * DM) + F.lane; const GAS f32x4* wp = (const GAS f32x4*)w + F.lane;
#pragma unroll
        for (int j = 0; j < 16; ++j) { const f32x4 v = p[64 * j], ww = wp[64 * j]; p[64 * j] = v * rstd * ww; } }
}
constexpr int N_PHASES = 10;
struct Args { const float* in[26]; float* out; unsigned char* ws; int ph_lo, ph_hi; };
__global__ void __launch_bounds__(512, 2) fwd_kernel(Args args) {
    extern __shared__ __attribute__((aligned(16))) unsigned char lds[];
    Frame F;
    F.lds = (LAS unsigned char*)lds;
    F.MISC = (volatile LAS unsigned*)(F.lds + MISC_OFF);
    F.tid = threadIdx.x; F.lane = F.tid & 63; F.wave = __builtin_amdgcn_readfirstlane(F.tid >> 6); F.G = gridDim.x;
    F.ws = args.ws; F.ctl = (gu32*)(args.ws + WS_CTL); F.out = args.out; F.pb0 = 0; F.pacc = 0;
#pragma unroll
    for (int i = 0; i < 26; ++i) F.in[i] = args.in[i];
    for (int u = F.tid; u < (LDS_BYTES - LDSCTL_OFF) / 4; u += 512) ((LAS unsigned*)(F.lds + LDSCTL_OFF))[u] = 0u;
    __syncthreads();
    XcdBarrier bar; bar.bar = (unsigned*)(F.ctl + CW_BAR); bar.x = 0; bar.st = nullptr;
    if (!MK_SPLIT) bar = xcd_barrier_post((unsigned*)(F.ctl + CW_BAR), F.MISC + 8);
    const int lo = args.ph_lo, hi = args.ph_hi;
#define IN(k) (lo <= (k) && (k) < hi)
#define SEAM(k) do { if (IN(k) && IN((k) + 1)) xcd_barrier(bar); } while (0)
    bf16* Rm = (bf16*)(F.ws + WS_H);
    float* SS2 = (float*)(F.ctl + CW_SS2); float* SS3 = (float*)(F.ctl + CW_SS3);

    unsigned long long pt0 = 0, pt1 = 0;
#define PB0(k) do { if ((PROBE_PHASE >> (k)) & 1) pt0 = __builtin_amdgcn_s_memrealtime(); } while (0)
#define PB1(k) do { if ((PROBE_PHASE >> (k)) & 1) pt1 += __builtin_amdgcn_s_memrealtime() - pt0; } while (0)
    PB0(0); if (IN(0)) { p0_prologue(F); } SEAM(0); PB1(0);
    PB0(1); if (IN(1)) {
        pg8::Gemm g{Rm, Rm, MPAD + INWP, MPAD + INWP, DM}; pg8::InOrder S; S.init(F.G, (int)blockIdx.x);
        pg8::EpiIn E{(bf16*)(F.ws + WS_G), (bf16*)(F.ws + WS_Q), (bf16*)(F.ws + WS_K), (bf16*)(F.ws + WS_VT), (bf16*)(F.ws + WS_U), F.in[4], (const float*)(F.ws + WS_ROPE)};
        pg8::gemm_phase<pg8::EpiIn, pg8::InOrder, true, true>(F.lds, g, S, E);
    } SEAM(1); PB1(1);
    PB0(2); if (IN(2)) { prep_phase(F); } SEAM(2); PB1(2);
    PB0(3); if (IN(3)) { scan_phase(F); } SEAM(3); PB1(3);
    PB0(4); if (IN(4)) { combine_phase(F); } SEAM(4); PB1(4);
    PB0(5); if (IN(5)) {
        { pg8::Gemm g{(const bf16*)(F.ws + WS_OATT), (const bf16*)(F.ws + WS_WPA), SEQ, DM, ATTW}; pg8::StaticOrder S; S.init(SEQ, DM, F.G, (int)blockIdx.x);
          pg8::EpiProjA E{(float*)(F.ws + WS_P1), (const bf16*)(F.ws + WS_G)};
          pg8::gemm_phase<pg8::EpiProjA, pg8::StaticOrder, true, true>(F.lds, g, S, E); }
        __syncthreads();
        { pg8::Gemm g{(const bf16*)(F.ws + WS_ORWKV), (const bf16*)(F.ws + WS_WPR), SEQ, DM, RC}; pg8::StaticOrder S; S.init(SEQ, DM, F.G, (int)blockIdx.x);
          pg8::EpiProjB E{(const float*)(F.ws + WS_P1), (const bf16*)(F.ws + WS_G), (bf16*)(F.ws + WS_MX)};
          pg8::gemm_phase<pg8::EpiProjB, pg8::StaticOrder, true, true>(F.lds, g, S, E); }
    } SEAM(5); PB1(5);
    PB0(6); if (IN(6)) {
        pg8::Gemm g{(const bf16*)(F.ws + WS_MX), (const bf16*)(F.ws + WS_WOUT), SEQ, DM, DM}; pg8::StaticOrder S; S.init(SEQ, DM, F.G, (int)blockIdx.x);
        pg8::EpiResid<true> E{F.in[0], (float*)(F.ws + WS_H2), (bf16*)(F.ws + WS_A2), SS2};
        pg8::gemm_phase<pg8::EpiResid<true>, pg8::StaticOrder, true, true>(F.lds, g, S, E);
    } SEAM(6); PB1(6);
    PB0(7); if (IN(7)) {
        pg8::Gemm g{(const bf16*)(F.ws + WS_A2), (const bf16*)(F.ws + WS_WGU), SEQ, 2 * DFF, DM}; pg8::StaticOrder S; S.init(SEQ, 2 * DFF, F.G, (int)blockIdx.x);
        pg8::EpiSwiGLU E{(bf16*)(F.ws + WS_HID), SS2};
        pg8::gemm_phase<pg8::EpiSwiGLU, pg8::StaticOrder, true, true>(F.lds, g, S, E);
    } SEAM(7); PB1(7);
    PB0(8); if (IN(8)) {
        pg8::Gemm g{(const bf16*)(F.ws + WS_HID), (const bf16*)(F.ws + WS_WD), SEQ, DM, DFF}; pg8::StaticOrder S; S.init(SEQ, DM, F.G, (int)blockIdx.x);
        pg8::EpiResid<false> E{(const float*)(F.ws + WS_H2), F.out, nullptr, SS3};
        pg8::gemm_phase<pg8::EpiResid<false>, pg8::StaticOrder, true, true>(F.lds, g, S, E);
    } SEAM(8); PB1(8);
    PB0(9); if (IN(9)) { final_phase(F); } PB1(9);
    if (PROBE_PHASE != 0 && blockIdx.x == 0 && F.tid == 0) { const unsigned long long te = __builtin_amdgcn_s_memrealtime(), want = (unsigned long long)PROBE_MULT * (pt1 + F.pacc);
        while (__builtin_amdgcn_s_memrealtime() - te < want && want < 2000000ull) __builtin_amdgcn_s_sleep(32); }
#undef PB0
#undef PB1
#undef IN
#undef SEAM
}

extern "C" void kernel_launch(void* const* d_in, const int* in_sizes, int n_in, void* d_out, int out_size, void* d_ws, size_t ws_size, hipStream_t stream) {
    static int grid = 0;
    if (grid == 0) {
        if (n_in != 26 || out_size != SEQ * DM || ws_size < WS_END) { fprintf(stderr, "kernel_launch: unexpected shapes (n_in %d, out %d, ws %zu, need %zu); nothing launched\n", n_in, out_size, ws_size, (size_t)WS_END); grid = -1; return; }
        int dev = 0, cus = 0, per_cu = 0;
        if (hipGetDevice(&dev) != hipSuccess || hipDeviceGetAttribute(&cus, hipDeviceAttributeMultiprocessorCount, dev) != hipSuccess) { grid = -1; return; }
        if (hipFuncSetAttribute((const void*)fwd_kernel, hipFuncAttributeMaxDynamicSharedMemorySize, LDS_BYTES) != hipSuccess) { fprintf(stderr, "kernel_launch: hipFuncSetAttribute failed\n"); grid = -1; return; }
        if (hipOccupancyMaxActiveBlocksPerMultiprocessor(&per_cu, (const void*)fwd_kernel, 512, LDS_BYTES) != hipSuccess || per_cu < 1) fprintf(stderr, "kernel_launch: occupancy query says %d per CU\n", per_cu);
        (void)hipGetLastError();
        grid = cus;
    }
    if (grid < 0) return;
    if (hipMemsetAsync((char*)d_ws + WS_CTL, 0, CTL_ZERO_BYTES, stream) != hipSuccess) return;
    Args a{};
    for (int i = 0; i < 26; ++i) a.in[i] = (const float*)d_in[i];
    a.out = (float*)d_out; a.ws = (unsigned char*)d_ws;
#if MK_SPLIT
    for (int p = 0; p < N_PHASES; ++p) { a.ph_lo = p; a.ph_hi = p + 1; hipLaunchKernelGGL(fwd_kernel, dim3(grid), dim3(512), LDS_BYTES, stream, a); }
#else
    a.ph_lo = 0; a.ph_hi = N_PHASES;
    hipLaunchKernelGGL(fwd_kernel, dim3(grid), dim3(512), LDS_BYTES, stream, a);
#endif
}
```

```cpp
#include <hip/hip_runtime.h>
#include <cstdio>
#include <cstdint>

#ifndef MK_SPLIT
#define MK_SPLIT 0
#endif

#ifndef PROBE_PHASE
#define PROBE_PHASE 0
#endif
#ifndef PROBE_MULT
#define PROBE_MULT 2
#endif
constexpr int NMETA = 16, SEQ = 8192, LTOK = 8208, DM = 4096, MPAD = 8448;
constexpr int INW = 18048, INWP = 18176;
constexpr int ATTW = 2048, KVW = 512, UW = 6784, UPITCH = 6912;
constexpr int RC = 2048, RH = 32, RN = 64;
constexpr int DFF = 11008;
constexpr float RMS_EPS = 1e-6f, GN_EPS = 64e-5f;
constexpr int HT = MPAD / 256;
constexpr int CT_Q = 32, CT_K = 40, CT_V = 42, CT_U = 44, CT_N = 71;

namespace pg8 {
#define PG8_LAS __attribute__((address_space(3)))
typedef unsigned short bf16_t;
typedef short bf16x8 __attribute__((ext_vector_type(8)));
typedef float f32x4 __attribute__((ext_vector_type(4)));
typedef unsigned u32x4 __attribute__((ext_vector_type(4)));
constexpr int BM = 256, BK = 64, HALF = 128, HTB = HALF * BK * 2  , STAGE_BYTES = 8 * HTB, NXCD = 8, WGM = 8;

__host__ __device__ __forceinline__ int lds_byte(int r, int c) { const int st = (r >> 4) * 2 + (c >> 5), rr = r & 15, cc = c & 31, ob = rr * 64 + cc * 2; return st * 1024 + (ob ^ (((ob >> 9) & 1) << 5)); }
__host__ __device__ __forceinline__ void stage_rc(int b, int& R, int& C) { const int st = b / 1024, sb = b % 1024, swz = sb ^ (((sb >> 9) & 1) << 5); R = (st >> 1) * 16 + swz / 64; C = (st & 1) * 32 + (swz % 64) / 2; }
__host__ __device__ __forceinline__ int perm32(int rho) { const int n = rho >> 4, i = rho & 15; return 8 * (i >> 2) + 4 * n + (i & 3); }

struct Unit { int pm, pn; };
struct Gemm { const bf16_t* A; const bf16_t* Bt; int M, N, K; };

struct StaticOrder {
    int nM, nN, nwg, G, c;
    __host__ __device__ void init(int M, int N, int G_, int c_) { nM = M / BM; nN = N / BM; nwg = nM * nN; G = G_; c = c_; }
    __host__ __device__ bool next(int i, Unit& u) const {
        const long L = (long)i * G + c; if (L >= nwg) return false;
        int wgid = (int)L; { const int q = nwg / NXCD, r = nwg % NXCD, xcd = wgid % NXCD, off = wgid / NXCD; wgid = (xcd < r ? xcd * (q + 1) : r * (q + 1) + (xcd - r) * q) + off; }
        const int nig = WGM * nN, gid = wgid / nig, fm = gid * WGM, gsz = (nM - fm) < WGM ? (nM - fm) : WGM;
        u.pm = fm + ((wgid % nig) % gsz); u.pn = (wgid % nig) / gsz; return true;
    }
    __device__ __forceinline__ void a_ready(const Unit&) const {}
    __device__ __forceinline__ void done(const Unit&) const {}
};

typedef float f32x2c __attribute__((ext_vector_type(2)));
typedef __bf16 bf16x2c __attribute__((ext_vector_type(2)));
__device__ __forceinline__ unsigned cvt_pk_bf16(float lo, float hi) { const f32x2c v = {lo, hi}; const bf16x2c r = __builtin_convertvector(v, bf16x2c); return __builtin_bit_cast(unsigned, r); }

typedef unsigned u32x2 __attribute__((ext_vector_type(2)));
__device__ __forceinline__ float bflo(unsigned w) { return __uint_as_float(w << 16); }
__device__ __forceinline__ float bfhi(unsigned w) { return __uint_as_float(w & 0xffff0000u); }
__device__ __forceinline__ float sigmoidf_(float x) { return __builtin_amdgcn_rcpf(1.0f + __expf(-x)); }

struct InOrder {
    StaticOrder base; int G, c;
    __device__ void init(int G_, int c_) { base.init(SEQ, INWP, G_, c_); G = G_; c = c_; }
    __device__ bool next(int i, Unit& u) const {
        const long L = (long)i * G + c;
        if (L < base.nwg) {
            base.next(i, u);
            if (u.pn >= CT_V && u.pn < CT_U) { const int e = (u.pn - CT_V) * 32 + u.pm; u.pm = HT + CT_V + e / HT; u.pn = e % HT; }
            else u.pn += HT;
            return true;
        }
        const int x = (int)(L - base.nwg);
        if (x >= 31) return false;
        if (x < 2) { const int e = 64 + x; u.pm = HT + CT_V + e / HT; u.pn = e % HT; }
        else { const int y = x - 2; u.pm = 32; u.pn = HT + (y < 2 ? CT_K + y : CT_U + (y - 2)); }
        return true;
    }
    __device__ __forceinline__ void a_ready(const Unit&) const {}
    __device__ __forceinline__ void done(const Unit&) const {}
};

struct EpiIn {
    static constexpr bool PERM = true, AFTER_DRAIN = false;
    bf16_t *G, *Q, *K, *Vt, *U; const float* bgate; const float* rope;
    __device__ __forceinline__ static void st8(bf16_t* p, const f32x4& v0, const f32x4& v1) {
        u32x4 w; w.x = cvt_pk_bf16(v0[0], v0[1]); w.y = cvt_pk_bf16(v0[2], v0[3]); w.z = cvt_pk_bf16(v1[0], v1[1]); w.w = cvt_pk_bf16(v1[2], v1[3]); *(u32x4*)p = w; }
    __device__ __forceinline__ void plain(const f32x4 (&acc)[2][2][4][2], bf16_t* base, int ldc, int row0, int col0) const {
#pragma unroll
        for (int ai = 0; ai < 2; ++ai)
#pragma unroll
            for (int m = 0; m < 4; ++m) { bf16_t* rowp = base + (size_t)(row0 + ai * HALF + m * 16) * ldc + col0;
#pragma unroll
                for (int bj = 0; bj < 2; ++bj) st8(rowp + bj * HALF, acc[ai][bj][m][0], acc[ai][bj][m][1]); }
    }
    __device__ __forceinline__ void roped(const f32x4 (&acc)[2][2][4][2], bf16_t* base, int ldc, int row0, int col0, int wc, int fq) const {
        if (wc != 0) { plain(acc, base, ldc, row0, col0); return; }
        const float sgn = (fq < 2) ? -1.0f : 1.0f;
#pragma unroll
        for (int ai = 0; ai < 2; ++ai)
#pragma unroll
            for (int m = 0; m < 4; ++m) { const int row = row0 + ai * HALF + m * 16; const int pos = row < SEQ ? row + NMETA : row - SEQ;
                const f32x4* cs = (const f32x4*)(rope + (size_t)pos * 32 + 16 * (fq & 1));
                const f32x4 c0 = cs[0], c1 = cs[1], c2 = cs[2], c3 = cs[3];
                const float cw[8] = {c0[0], c0[2], c1[0], c1[2], c2[0], c2[2], c3[0], c3[2]}, sw[8] = {c0[1], c0[3], c1[1], c1[3], c2[1], c2[3], c3[1], c3[3]};
                bf16_t* rowp = base + (size_t)row * ldc + col0;
#pragma unroll
                for (int bj = 0; bj < 2; ++bj) { f32x4 v0 = acc[ai][bj][m][0], v1 = acc[ai][bj][m][1], o0, o1;
#pragma unroll
                    for (int e = 0; e < 4; ++e) { const float p0 = __shfl_xor(v0[e], 32), p1 = __shfl_xor(v1[e], 32);
                        o0[e] = v0[e] * cw[e] + sgn * p0 * sw[e]; o1[e] = v1[e] * cw[4 + e] + sgn * p1 * sw[4 + e]; }
                    st8(rowp + bj * HALF, o0, o1); } }
    }
    __device__ __forceinline__ void operator()(const f32x4 (&acc)[2][2][4][2], const Unit& u, int wr, int wc, int fr, int fq) const {
        if (u.pm >= HT) {
            plain(acc, Vt, MPAD, (u.pm - HT - CT_V) * BM + wr * 64 + fr, u.pn * BM + wc * 32 + 8 * fq); return; }
        const int ct = u.pn - HT, row0 = u.pm * BM + wr * 64 + fr, cl = wc * 32 + 8 * fq;
        if (ct < CT_Q) {
            const int col0 = ct * BM + cl;
#pragma unroll
            for (int bj = 0; bj < 2; ++bj) { const f32x4 b0 = *(const f32x4*)(bgate + col0 + bj * HALF), b1 = *(const f32x4*)(bgate + col0 + bj * HALF + 4);
#pragma unroll
                for (int ai = 0; ai < 2; ++ai)
#pragma unroll
                    for (int m = 0; m < 4; ++m) { f32x4 v0 = acc[ai][bj][m][0] + b0, v1 = acc[ai][bj][m][1] + b1;
#pragma unroll
                        for (int e = 0; e < 4; ++e) { v0[e] = sigmoidf_(v0[e]); v1[e] = sigmoidf_(v1[e]); }
                        st8(G + (size_t)(row0 + ai * HALF + m * 16) * (2 * DM) + col0 + bj * HALF, v0, v1); } }
        } else if (ct < CT_K) { roped(acc, Q, ATTW, row0, (ct - CT_Q) * BM + cl, wc, fq);
        } else if (ct < CT_V) { roped(acc, K, KVW, row0, (ct - CT_K) * BM + cl, wc, fq);
        } else { plain(acc, U, UPITCH, row0, (ct - CT_U) * BM + cl); }
    }
};

struct EpiProjA {
    static constexpr bool PERM = true, AFTER_DRAIN = false;
    bf16_t* P1; const bf16_t* G;
    __device__ __forceinline__ void operator()(const f32x4 (&acc)[2][2][4][2], const Unit& u, int wr, int wc, int fr, int fq) const {
        const int row0 = u.pm * BM + wr * 64 + fr, col0 = u.pn * BM + wc * 32 + 8 * fq;
#pragma unroll
        for (int ai = 0; ai < 2; ++ai)
#pragma unroll
            for (int m = 0; m < 4; ++m) { const size_t r = (size_t)(row0 + ai * HALF + m * 16);
#pragma unroll
                for (int bj = 0; bj < 2; ++bj) { const int c = col0 + bj * HALF; const u32x4 g = *(const u32x4*)(G + r * (2 * DM) + c);
                    f32x4 o0 = acc[ai][bj][m][0], o1 = acc[ai][bj][m][1];
                    o0[0] *= bflo(g.x); o0[1] *= bfhi(g.x); o0[2] *= bflo(g.y); o0[3] *= bfhi(g.y); o1[0] *= bflo(g.z); o1[1] *= bfhi(g.z); o1[2] *= bflo(g.w); o1[3] *= bfhi(g.w);
                    EpiIn::st8(P1 + r * DM + c, o0, o1); } }
    }
};
struct EpiProjB {
    static constexpr bool PERM = true, AFTER_DRAIN = false;
    const bf16_t* P1; const bf16_t* G; bf16_t* MX;
    __device__ __forceinline__ void operator()(const f32x4 (&acc)[2][2][4][2], const Unit& u, int wr, int wc, int fr, int fq) const {
        const int row0 = u.pm * BM + wr * 64 + fr, col0 = u.pn * BM + wc * 32 + 8 * fq;
#pragma unroll
        for (int ai = 0; ai < 2; ++ai)
#pragma unroll
            for (int m = 0; m < 4; ++m) { const size_t r = (size_t)(row0 + ai * HALF + m * 16);
#pragma unroll
                for (int bj = 0; bj < 2; ++bj) { const int c = col0 + bj * HALF; const u32x4 g = *(const u32x4*)(G + r * (2 * DM) + DM + c); const u32x4 q = *(const u32x4*)(P1 + r * DM + c);
                    f32x4 o0 = {bflo(q.x), bfhi(q.x), bflo(q.y), bfhi(q.y)}, o1 = {bflo(q.z), bfhi(q.z), bflo(q.w), bfhi(q.w)}; const f32x4 a0 = acc[ai][bj][m][0], a1 = acc[ai][bj][m][1];
                    o0[0] += a0[0] * bflo(g.x); o0[1] += a0[1] * bfhi(g.x); o0[2] += a0[2] * bflo(g.y); o0[3] += a0[3] * bfhi(g.y);
                    o1[0] += a1[0] * bflo(g.z); o1[1] += a1[1] * bfhi(g.z); o1[2] += a1[2] * bflo(g.w); o1[3] += a1[3] * bfhi(g.w);
                    EpiIn::st8(MX + r * DM + c, o0, o1); }
                asm volatile("" ::: "memory"); }
    }
};
template <bool BASE_BF16> struct EpiResid {
    static constexpr bool PERM = true, AFTER_DRAIN = false;
    const float* BASEF; const bf16_t* BASEB; float* OUTF; bf16_t* OUTB; float* SS;
    __device__ __forceinline__ void operator()(const f32x4 (&acc)[2][2][4][2], const Unit& u, int wr, int wc, int fr, int fq) const {
        const int row0 = u.pm * BM + wr * 64 + fr, col0 = u.pn * BM + wc * 32 + 8 * fq;
#pragma unroll
        for (int ai = 0; ai < 2; ++ai)
#pragma unroll
            for (int m = 0; m < 4; ++m) { const size_t r = (size_t)(row0 + ai * HALF + m * 16); float ss = 0.f;
#pragma unroll
                for (int bj = 0; bj < 2; ++bj) { const int c = col0 + bj * HALF; f32x4 o0, o1;
                    if (BASE_BF16) { const u32x4 g = *(const u32x4*)(BASEB + r * DM + c); o0 = (f32x4){bflo(g.x), bfhi(g.x), bflo(g.y), bfhi(g.y)}; o1 = (f32x4){bflo(g.z), bfhi(g.z), bflo(g.w), bfhi(g.w)}; }
                    else { const float* bp = BASEF + r * DM + c; o0 = *(const f32x4*)bp; o1 = *(const f32x4*)(bp + 4); }
                    o0 += acc[ai][bj][m][0]; o1 += acc[ai][bj][m][1];
                    if (BASE_BF16) { float* op = OUTF + r * DM + c; *(f32x4*)op = o0; *(f32x4*)(op + 4) = o1; }
                    else { u32x4 w; w.x = cvt_pk_bf16(o0[0], o0[1]); w.y = cvt_pk_bf16(o0[2], o0[3]); w.z = cvt_pk_bf16(o1[0], o1[1]); w.w = cvt_pk_bf16(o1[2], o1[3]); *(u32x4*)(OUTB + r * DM + c) = w;
                        o0 = (f32x4){bflo(w.x), bfhi(w.x), bflo(w.y), bfhi(w.y)}; o1 = (f32x4){bflo(w.z), bfhi(w.z), bflo(w.w), bfhi(w.w)}; }
                    ss += (o0[0] * o0[0] + o0[1] * o0[1]) + (o0[2] * o0[2] + o0[3] * o0[3]) + (o1[0] * o1[0] + o1[1] * o1[1]) + (o1[2] * o1[2] + o1[3] * o1[3]); }
                ss += __shfl_xor(ss, 16); ss += __shfl_xor(ss, 32);
                if (fq == 0) atomicAdd(SS + r, ss);
                asm volatile("" ::: "memory"); }
    }
};
struct EpiSwiGLU {
    static constexpr bool PERM = true, AFTER_DRAIN = false;
    bf16_t* HID; const float* SS;
    __device__ __forceinline__ void operator()(const f32x4 (&acc)[2][2][4][2], const Unit& u, int wr, int wc, int fr, int fq) const {
        const int row0 = u.pm * BM + wr * 64 + fr, col0 = u.pn * HALF + wc * 32 + 8 * fq;
#pragma unroll
        for (int ai = 0; ai < 2; ++ai)
#pragma unroll
            for (int m = 0; m < 4; ++m) { const size_t r = (size_t)(row0 + ai * HALF + m * 16);
                const float rstd = __builtin_amdgcn_rsqf(SS[r] * (1.0f / DM) + RMS_EPS);
                f32x4 o0, o1;
#pragma unroll
                for (int e = 0; e < 4; ++e) { const float g0 = acc[ai][0][m][0][e] * rstd, u0 = acc[ai][1][m][0][e] * rstd, g1 = acc[ai][0][m][1][e] * rstd, u1 = acc[ai][1][m][1][e] * rstd;
                    o0[e] = g0 * sigmoidf_(g0) * u0; o1[e] = g1 * sigmoidf_(g1) * u1; }
                EpiIn::st8(HID + r * DFF + col0, o0, o1); }
    }
};

#define PG8_EPI_T0 unsigned long long epi_t0_ = 0; do { if ((PROBE_PHASE >> 20) & 1) epi_t0_ = __builtin_amdgcn_s_memrealtime(); } while (0)
#define PG8_EPI_T1 do { if ((PROBE_PHASE >> 20) & 1) epi_acc += __builtin_amdgcn_s_memrealtime() - epi_t0_; } while (0)
template <class Epi, class Sched, bool ALIGN_EPI = false, bool SP2 = false>
__device__ __forceinline__ void gemm_phase(PG8_LAS unsigned char* lds, const Gemm g, const Sched& S, const Epi& E, unsigned long long& epi_acc) {
    const int tid = threadIdx.x, wid = __builtin_amdgcn_readfirstlane(tid >> 6), lane = tid & 63, wr = wid >> 2, wc = wid & 3, fr = lane & 15, fq = lane >> 4;
    const int K = g.K, nt = K / BK;
    unsigned voffA[2], voffB[2];
#pragma unroll
    for (int i = 0; i < 2; ++i) { int R, C; stage_rc(tid * 16 + i * 8192, R, C); const int Rb = Epi::PERM ? ((R & ~31) + perm32(R & 31)) : R;
        voffA[i] = (unsigned)(R * K + C) * 2u; voffB[i] = (unsigned)(Rb * K + C) * 2u; }
    const size_t kstep = (size_t)(BK * 2);
    const size_t hstep = (size_t)HALF * K * 2;
    const size_t tstep = 2 * hstep;
    const unsigned ldsw = (unsigned)wid * 1024u;
    const int aoff = lds_byte(wr * 64 + fr, fq * 8), boff = lds_byte(wc * 32 + fr, fq * 8);
#define PG8_SA(b, h) (((b) * 2 + (h)) * HTB)
#define PG8_SB(b, h) ((4 + (b) * 2 + (h)) * HTB)
#define PG8_STAGE(bufoff, gbase, voff) do { _Pragma("unroll") for (int _i = 0; _i < 2; ++_i) \
        __builtin_amdgcn_global_load_lds((const unsigned*)((const char*)(gbase) + (voff)[_i]), (PG8_LAS unsigned*)(lds + (bufoff) + ldsw + _i * 8192), 16, 0, 0); } while (0)
#define PG8_LDA(dst, b, h) do { _Pragma("unroll") for (int m = 0; m < 4; ++m) _Pragma("unroll") for (int k = 0; k < 2; ++k) dst[m][k] = *(const PG8_LAS bf16x8*)(lds + PG8_SA(b, h) + aoff + m * 2048 + k * 1024); } while (0)
#define PG8_LDB(dst, b, h) do { _Pragma("unroll") for (int n = 0; n < 2; ++n) _Pragma("unroll") for (int k = 0; k < 2; ++k) dst[n][k] = *(const PG8_LAS bf16x8*)(lds + PG8_SB(b, h) + boff + n * 2048 + k * 1024); } while (0)
#define PG8_MMA(ai, bj, At, Bt) do { __builtin_amdgcn_s_setprio(1); _Pragma("unroll") for (int m = 0; m < 4; ++m) _Pragma("unroll") for (int n = 0; n < 2; ++n) _Pragma("unroll") for (int k = 0; k < 2; ++k) \
        acc[ai][bj][m][n] = __builtin_amdgcn_mfma_f32_16x16x32_bf16(Bt[n][k], At[m][k], acc[ai][bj][m][n], 0, 0, 0); __builtin_amdgcn_s_setprio(0); } while (0)
#define PG8_WAIT_V(n) asm volatile("s_waitcnt vmcnt(" #n ")" ::: "memory")
#define PG8_WAIT_L(n) asm volatile("s_waitcnt lgkmcnt(" #n ")" ::: "memory")
#define PG8_BAR __builtin_amdgcn_s_barrier()
#define PG8_SCHED __builtin_amdgcn_sched_barrier(0)
    Unit cur, nxt; int ui = 0;
    if (!S.next(0, cur)) return;
    f32x4 acc[2][2][4][2];
#pragma unroll
    for (int a = 0; a < 2; ++a)
#pragma unroll
        for (int b = 0; b < 2; ++b)
#pragma unroll
            for (int m = 0; m < 4; ++m)
#pragma unroll
                for (int n = 0; n < 2; ++n) acc[a][b][m][n] = (f32x4){0.f, 0.f, 0.f, 0.f};
    bf16x8 At[4][2], B0[2][2], B1[2][2];
    const char* cA = (const char*)g.A + (size_t)cur.pm * tstep; const char* cB = (const char*)g.Bt + (size_t)cur.pn * tstep;
    S.a_ready(cur);
    if constexpr (SP2) {
        PG8_STAGE(PG8_SB(0, 0), cB, voffB); PG8_STAGE(PG8_SB(0, 1), cB + hstep, voffB); PG8_STAGE(PG8_SA(0, 0), cA, voffA); PG8_STAGE(PG8_SA(0, 1), cA + hstep, voffA);
        if (wr == 1) PG8_BAR;
        PG8_WAIT_V(2); PG8_BAR;
        PG8_STAGE(PG8_SB(1, 0), cB + kstep, voffB); PG8_STAGE(PG8_SA(1, 0), cA + kstep, voffA); PG8_STAGE(PG8_SB(1, 1), cB + hstep + kstep, voffB);
        PG8_WAIT_V(6); PG8_BAR;
    } else {
        PG8_STAGE(PG8_SB(0, 0), cB, voffB); PG8_STAGE(PG8_SA(0, 0), cA, voffA); PG8_STAGE(PG8_SB(0, 1), cB + hstep, voffB); PG8_STAGE(PG8_SA(0, 1), cA + hstep, voffA);
        if (wr == 1) PG8_BAR;
        PG8_WAIT_V(4); PG8_BAR;
        PG8_STAGE(PG8_SB(1, 0), cB + kstep, voffB); PG8_STAGE(PG8_SA(1, 0), cA + kstep, voffA); PG8_STAGE(PG8_SB(1, 1), cB + hstep + kstep, voffB);
        PG8_WAIT_V(6); PG8_BAR;
    }
    for (;;) {
        const bool has_next = S.next(ui + 1, nxt);
        const char* nA = has_next ? (const char*)g.A + (size_t)nxt.pm * tstep : cA; const char* nB = has_next ? (const char*)g.Bt + (size_t)nxt.pn * tstep : cB;
        for (int t = 0; t < nt; t += 2) {
            const bool last = (t == nt - 2);
            const char* a1 = cA + (size_t)(t + 1) * kstep;
            const char* a2 = last ? nA : cA + (size_t)(t + 2) * kstep; const char* b2 = last ? nB : cB + (size_t)(t + 2) * kstep;
            const char* a3 = a2 + kstep; const char* b3 = b2 + kstep;
            if (last && has_next) S.a_ready(nxt);
            if constexpr (SP2) {
            PG8_LDB(B0, 0, 0); PG8_LDB(B1, 0, 1); PG8_SCHED; PG8_LDA(At, 0, 0); PG8_STAGE(PG8_SA(1, 1), a1 + hstep, voffA);
            PG8_WAIT_V(8); PG8_WAIT_L(0); PG8_BAR; PG8_MMA(0, 0, At, B0); PG8_MMA(0, 1, At, B1); PG8_BAR; PG8_SCHED;
            PG8_LDA(At, 0, 1); PG8_STAGE(PG8_SB(0, 0), b2, voffB); PG8_STAGE(PG8_SB(0, 1), b2 + hstep, voffB); PG8_STAGE(PG8_SA(0, 0), a2, voffA);
            PG8_WAIT_V(8); PG8_WAIT_L(0); PG8_BAR; PG8_MMA(1, 0, At, B0); PG8_MMA(1, 1, At, B1); PG8_BAR; PG8_SCHED;
            PG8_LDB(B0, 1, 0); PG8_LDB(B1, 1, 1); PG8_SCHED; PG8_LDA(At, 1, 0); PG8_STAGE(PG8_SA(0, 1), a2 + hstep, voffA);
            PG8_WAIT_V(8); PG8_WAIT_L(0); PG8_BAR; PG8_MMA(0, 0, At, B0); PG8_MMA(0, 1, At, B1); PG8_BAR; PG8_SCHED;
            PG8_LDA(At, 1, 1); PG8_STAGE(PG8_SB(1, 0), b3, voffB); PG8_STAGE(PG8_SB(1, 1), b3 + hstep, voffB); PG8_STAGE(PG8_SA(1, 0), a3, voffA);
            PG8_WAIT_V(8); PG8_WAIT_L(0); PG8_BAR; PG8_MMA(1, 0, At, B0); PG8_MMA(1, 1, At, B1); PG8_BAR; PG8_SCHED;
            } else {
            PG8_LDB(B0, 0, 0); PG8_SCHED; PG8_LDA(At, 0, 0); PG8_STAGE(PG8_SA(1, 1), a1 + hstep, voffA);
            PG8_WAIT_L(8); PG8_BAR; PG8_WAIT_L(0); PG8_MMA(0, 0, At, B0); PG8_BAR; PG8_SCHED;
            PG8_LDB(B1, 0, 1); PG8_STAGE(PG8_SB(0, 0), b2, voffB);
            PG8_BAR; PG8_WAIT_L(0); PG8_MMA(0, 1, At, B1); PG8_BAR;
            PG8_LDA(At, 0, 1); PG8_STAGE(PG8_SA(0, 0), a2, voffA);
            PG8_BAR; PG8_WAIT_L(0); PG8_MMA(1, 0, At, B0); PG8_BAR; PG8_SCHED;
            PG8_STAGE(PG8_SB(0, 1), b2 + hstep, voffB);
            PG8_WAIT_V(6); PG8_BAR; PG8_MMA(1, 1, At, B1); PG8_BAR;
            PG8_LDB(B0, 1, 0); PG8_SCHED; PG8_LDA(At, 1, 0); PG8_STAGE(PG8_SA(0, 1), a2 + hstep, voffA);
            PG8_WAIT_L(8); PG8_BAR; PG8_WAIT_L(0); PG8_MMA(0, 0, At, B0); PG8_BAR; PG8_SCHED;
            PG8_LDB(B1, 1, 1); PG8_STAGE(PG8_SB(1, 0), b3, voffB);
            PG8_BAR; PG8_WAIT_L(0); PG8_MMA(0, 1, At, B1); PG8_BAR;
            PG8_LDA(At, 1, 1); PG8_STAGE(PG8_SA(1, 0), a3, voffA);
            PG8_BAR; PG8_WAIT_L(0); PG8_MMA(1, 0, At, B0); PG8_BAR; PG8_SCHED;
            PG8_STAGE(PG8_SB(1, 1), b3 + hstep, voffB);
            PG8_WAIT_V(6); PG8_BAR; PG8_MMA(1, 1, At, B1); PG8_BAR;
            }
        }
        if constexpr (ALIGN_EPI) { if (wr == 0) PG8_BAR; }
        if constexpr (!Epi::AFTER_DRAIN) { PG8_EPI_T0; E(acc, cur, wr, wc, fr, fq); S.done(cur); PG8_EPI_T1; }
        if (!has_next) break;
#pragma unroll
        for (int a = 0; a < 2; ++a)
#pragma unroll
            for (int b = 0; b < 2; ++b)
#pragma unroll
                for (int m = 0; m < 4; ++m)
#pragma unroll
                    for (int n = 0; n < 2; ++n) acc[a][b][m][n] = (f32x4){0.f, 0.f, 0.f, 0.f};
        cur = nxt; cA = nA; cB = nB; ++ui;
        if constexpr (ALIGN_EPI) { if (wr == 1) PG8_BAR; }
    }
    PG8_WAIT_V(0);
    if constexpr (!ALIGN_EPI) { if (wr == 0) PG8_BAR; }
    PG8_BAR;
    if constexpr (Epi::AFTER_DRAIN) { E.fused(acc, cur, wr, wc, fr, fq, lds, wid, lane); S.done(cur); }
#undef PG8_SA
#undef PG8_SB
#undef PG8_STAGE
#undef PG8_LDA
#undef PG8_LDB
#undef PG8_MMA
#undef PG8_WAIT_V
#undef PG8_WAIT_L
#undef PG8_BAR
#undef PG8_SCHED
}

}

constexpr size_t MiB = 1u << 20;
constexpr size_t WS_CTL = 0, CTL_ZERO_BYTES = 1 * MiB;
constexpr size_t WS_ROPE = 1 * MiB;
constexpr size_t WS_LW2 = 3 * MiB, WS_LA2 = 4 * MiB, WS_LG2 = 5 * MiB;
constexpr size_t WS_H = 8 * MiB, WS_WIN = WS_H + (size_t)MPAD * DM * 2;
constexpr size_t WS_WPA = 8 * MiB, WS_WPR = 24 * MiB, WS_WOUT = 40 * MiB, WS_OATT = 72 * MiB, WS_WD = 104 * MiB;
constexpr size_t WS_G = 216 * MiB, WS_A2 = 216 * MiB;
constexpr size_t WS_Q = 344 * MiB, WS_K = 376 * MiB, WS_VT = 385 * MiB, WS_U = 394 * MiB;
constexpr size_t WS_Y = 394 * MiB;
constexpr size_t WS_P1 = 344 * MiB, WS_H2 = 344 * MiB, WS_MX = 474 * MiB;
constexpr size_t SCF = (size_t)LTOK * RC * 4, SCB = (size_t)LTOK * RC * 2;
constexpr size_t WS_W0 = 524 * MiB, WS_W1 = WS_W0 + SCF, WS_KD0 = WS_W1 + SCF, WS_KD1 = WS_KD0 + SCB, WS_B0 = WS_KD1 + SCB, WS_B1 = WS_B0 + SCB, WS_KK = WS_B1 + SCB, WS_RR = WS_KK + SCB, WS_VV = WS_RR + SCB, WS_SCEND = WS_VV + SCB;
constexpr size_t WS_HID = 640 * MiB;
constexpr size_t WS_WGU = 878 * MiB, WS_GG = 1050 * MiB, WS_ORWKV = 1083 * MiB, WS_END = 1115 * MiB;
static_assert(WS_WIN + (size_t)INWP * DM * 2 <= WS_G && WS_WD + (size_t)DM * DFF * 2 <= WS_G && WS_OATT + (size_t)SEQ * ATTW * 2 <= WS_WD, "map: R");
static_assert(WS_U + (size_t)MPAD * UPITCH * 2 <= WS_W0 && WS_VT + (size_t)KVW * MPAD * 2 <= WS_U && WS_K + (size_t)MPAD * KVW * 2 <= WS_VT && WS_Q + (size_t)SEQ * ATTW * 2 <= WS_K, "map: P1 outputs");
static_assert(WS_Y + 2 * SCF <= WS_W0 && WS_P1 + (size_t)SEQ * DM * 4 <= WS_MX && WS_MX + (size_t)SEQ * DM * 2 <= WS_HID, "map: overlays");
static_assert(WS_SCEND <= WS_WGU && WS_HID + (size_t)SEQ * DFF * 2 <= WS_WGU && WS_WGU + (size_t)2 * DFF * DM * 2 <= WS_GG && WS_GG + SCB <= WS_ORWKV && WS_ORWKV + (size_t)SEQ * RC * 2 <= WS_END, "map: tail");
constexpr int CW_BAR = 4096;
constexpr int CW_SS2 = 65536, CW_SS3 = 65536 + 8192;
static_assert((CW_SS3 + 8192) * 4 <= (int)CTL_ZERO_BYTES, "CTL");

constexpr int RING_BYTES = 131072;
constexpr int LDSCTL_OFF = RING_BYTES, MISC_OFF = LDSCTL_OFF + 320;
constexpr int LDS_BYTES = 147456;

#define GAS __attribute__((address_space(1)))
#define LAS __attribute__((address_space(3)))
typedef unsigned short bf16;
typedef unsigned v4u __attribute__((ext_vector_type(4)));
typedef unsigned v2u __attribute__((ext_vector_type(2)));
typedef float f32x4 __attribute__((ext_vector_type(4)));
typedef float f32x2 __attribute__((ext_vector_type(2)));
typedef float f32x16 __attribute__((ext_vector_type(16)));
typedef short bf16x8 __attribute__((ext_vector_type(8)));
typedef GAS unsigned gu32;
#define RLX_AGENT __ATOMIC_RELAXED, __HIP_MEMORY_SCOPE_AGENT
#define LDS_WAIT() asm volatile("s_waitcnt lgkmcnt(0)" ::: "memory")
__device__ __forceinline__ unsigned pk2(float lo, float hi) { return pg8::cvt_pk_bf16(lo, hi); }
__device__ __forceinline__ unsigned f2bf(float f) { return pg8::cvt_pk_bf16(f, 0.f) & 0xffffu; }
__device__ __forceinline__ float bf2f(bf16 b) { return __uint_as_float(((unsigned)b) << 16); }
using pg8::bflo; using pg8::bfhi; using pg8::sigmoidf_;

#define XB_TMO      128
#define XB_XCNT(j)  (256  + 64 * (j))
#define XB_XSUB(j)  (1280 + 64 * (j))
#define XB_XGEN(j)  (2304 + 64 * (j))
#define XB_TOP      3328
#define XB_TOPGEN   3392
#define XCD_BAR_WORDS 3456
#define XB_SPIN_CAP (1u << 18)

__device__ __forceinline__ unsigned xb_ld(unsigned* p)              { return __hip_atomic_load(p, __ATOMIC_RELAXED, __HIP_MEMORY_SCOPE_AGENT); }
__device__ __forceinline__ unsigned xb_add(unsigned* p, unsigned v) { return __hip_atomic_fetch_add(p, v, __ATOMIC_RELAXED, __HIP_MEMORY_SCOPE_AGENT); }
__device__ __forceinline__ unsigned xb_xcc_id() { return (unsigned)__builtin_amdgcn_s_getreg((3 << 11) | 20) & 0xFu; }
#define XB_SPIN(cond, bar) do { unsigned _sp = 0; while (cond) { __builtin_amdgcn_s_sleep(1); \
    if ((++_sp & 255u) == 0u) { if (xb_ld(&(bar)[XB_TMO])) break; if (_sp > XB_SPIN_CAP) { atomicAdd(&(bar)[XB_TMO], 1u); break; } } } } while (0)

struct XcdBarrier {
    unsigned* bar; unsigned x;
    volatile LAS unsigned* st;
};

__device__ __forceinline__ XcdBarrier xcd_barrier_post(unsigned* bar, volatile LAS unsigned* st) {
    XcdBarrier b; b.bar = bar; b.x = xb_xcc_id(); b.st = st;
    if (threadIdx.x == 0) (void)xb_add(&bar[XB_XCNT(b.x)], 1u);
    return b;
}
__device__ __forceinline__ void xcd_barrier_complete(unsigned* bar, unsigned x, unsigned& nloc, unsigned& nx) {
    const unsigned G = gridDim.x * gridDim.y * gridDim.z;
    unsigned sum, cnt, mine, sp = 0u;
    for (;;) {
        sum = 0u; cnt = 0u; mine = 0u;
#pragma unroll
        for (unsigned j = 0; j < 16; ++j) { const unsigned c = xb_ld(&bar[XB_XCNT(j)]); sum += c; cnt += (c > 0u) ? 1u : 0u; mine = (j == x) ? c : mine; }
        if (sum == G) break;
        __builtin_amdgcn_s_sleep(1);
        if ((++sp & 255u) == 0u) { if (xb_ld(&bar[XB_TMO])) break; if (sp > XB_SPIN_CAP) { atomicAdd(&bar[XB_TMO], 1u); break; } }
    }
    nloc = mine > 0u ? mine : 1u; nx = cnt > 0u ? cnt : 1u;
}

__device__ __forceinline__ void xcd_barrier(const XcdBarrier& b) {
    asm volatile("s_waitcnt vmcnt(0)" ::: "memory");
    __syncthreads();
    if (threadIdx.x == 0) {
        unsigned* bar = b.bar;
        __builtin_amdgcn_s_waitcnt(0);
        unsigned nloc = b.st[0], nx = b.st[1];
        if (nloc == 0u) { xcd_barrier_complete(bar, b.x, nloc, nx); b.st[0] = nloc; b.st[1] = nx; }
        const unsigned old = xb_add(&bar[XB_XSUB(b.x)], 1u);
        const unsigned gen = old / nloc;
        if (old + 1u == (gen + 1u) * nloc) {
            __builtin_amdgcn_fence(__ATOMIC_RELEASE, "agent");
            asm volatile("s_waitcnt vmcnt(0)" ::: "memory");
            const unsigned og = xb_add(&bar[XB_TOP], 1u);
            const unsigned tg = og / nx;
            if (og + 1u == (tg + 1u) * nx) xb_add(&bar[XB_TOPGEN], 1u);
            else XB_SPIN(xb_ld(&bar[XB_TOPGEN]) == tg, bar);
            __builtin_amdgcn_fence(__ATOMIC_ACQUIRE, "agent");
            xb_add(&bar[XB_XGEN(b.x)], 1u);
            asm volatile("s_waitcnt vmcnt(0)" ::: "memory");
        } else {
            XB_SPIN(xb_ld(&bar[XB_XGEN(b.x)]) == gen, bar);
            __builtin_amdgcn_fence(__ATOMIC_ACQUIRE, "agent");
            asm volatile("s_waitcnt vmcnt(0)" ::: "memory");
        }
    }
    __syncthreads();
}


struct Frame {
    LAS unsigned char* lds;
    volatile LAS unsigned* MISC;
    gu32* ctl;
    int tid, lane, wave, G;
    unsigned char* ws;
    const float* in[26];
    float* out;
    unsigned long long pb0, pacc, pacc2;
};
#define FPB0(k) do { if ((PROBE_PHASE >> (k)) & 1) F.pb0 = __builtin_amdgcn_s_memrealtime(); } while (0)
#define FPB1(k) do { if ((PROBE_PHASE >> (k)) & 1) F.pacc += __builtin_amdgcn_s_memrealtime() - F.pb0; } while (0)
__device__ __forceinline__ float wave_sum(float v) {
#pragma unroll
    for (int o = 1; o < 64; o <<= 1) v += __shfl_xor(v, o);
    return v;
}

template <int MODE> __device__ __forceinline__ void transpose_item(const float* W, int K, int N, bf16* WT, LAS float* scr, int item, int lane, const float* kscale) {
    const int nblk = N / 32, kb = item / nblk, nb = item % nblk, k0 = 64 * kb, n0 = 32 * nb;
    float wv[32];
#pragma unroll
    for (int i = 0; i < 32; ++i) wv[i] = W[(size_t)(k0 + 2 * i + (lane >> 5)) * N + n0 + (lane & 31)];
#pragma unroll
    for (int i = 0; i < 32; ++i) { const int kk = 2 * i + (lane >> 5); float v = wv[i]; if (kscale) v *= kscale[k0 + kk]; scr[kk * 33 + (lane & 31)] = v; }
    LDS_WAIT(); asm volatile("" ::: "memory");
    const int c = lane & 7;
#pragma unroll
    for (int j = 0; j < 4; ++j) { const int n = (lane >> 3) + 8 * j; const LAS float* s = scr + (8 * c) * 33 + n;
        v4u o; o.x = pk2(s[0 * 33], s[1 * 33]); o.y = pk2(s[2 * 33], s[3 * 33]); o.z = pk2(s[4 * 33], s[5 * 33]); o.w = pk2(s[6 * 33], s[7 * 33]);
        const int nn = n0 + n; const int dr = (MODE == 0) ? nn : (256 * (nn >> 7) + (nn & 127) + (MODE == 2 ? 128 : 0));
        *(GAS v4u*)(WT + (size_t)dr * K + k0 + 8 * c) = o; }
    LDS_WAIT(); asm volatile("" ::: "memory");
}
__device__ __forceinline__ void rms_row_to_bf16(int lane, const float* xrow, const float* w, bf16* orow) {
    const GAS f32x4* xr = (const GAS f32x4*)xrow + lane;
    f32x4 v[16]; float s = 0.f;
#pragma unroll
    for (int j = 0; j < 16; ++j) { v[j] = xr[64 * j]; s += (v[j].x * v[j].x + v[j].y * v[j].y) + (v[j].z * v[j].z + v[j].w * v[j].w); }
    const float rstd = 1.f / sqrtf(wave_sum(s) * (1.f / DM) + RMS_EPS);
    const GAS f32x4* wr = (const GAS f32x4*)w + lane;
    GAS v2u* o8 = (GAS v2u*)orow + lane;
#pragma unroll
    for (int j = 0; j < 16; ++j) { const f32x4 ww = wr[64 * j]; v2u o; o.x = pk2(v[j].x * rstd * ww.x, v[j].y * rstd * ww.y); o.y = pk2(v[j].z * rstd * ww.z, v[j].w * rstd * ww.w); o8[64 * j] = o; }
}
__device__ const double ROPE_INV[16] = {
    1.0000000000000000000000000e+0,
    4.4036660267178047359198331e-1,
    1.9392274474868577334259386e-1,
    8.5397100285765611280149662e-2,
    3.7606030930863935681246092e-2,
    1.6560440080994445548947445e-2,
    7.2926647372171090477661219e-3,
    3.2114459947525910185434889e-3,
    1.4142135623730950488016887e-3,
    6.2277242191459597955502746e-4,
    2.7424817567620731825332265e-4,
    1.2076973741146503832424826e-4,
    5.3182958969449886162502429e-5,
    2.3419998961409341542188076e-5,
    1.0313385377212458859810127e-5,
    4.5416704806078696531998012e-6
};

__device__ __forceinline__ void p0_prologue(Frame& F) {
    LAS float* scr = (LAS float*)(F.lds + F.wave * 16384);
    const int gw = blockIdx.x * 8 + F.wave, NGW = F.G * 8;
    bf16* Wint = (bf16*)(F.ws + WS_WIN); bf16* H = (bf16*)(F.ws + WS_H);
    constexpr int I_IN = (DM / 64) * (INW / 32);
    for (int it = gw; it < I_IN; it += NGW) transpose_item<0>(F.in[3], DM, INW, Wint, scr, it, F.lane, nullptr);
    for (int m = gw; m < MPAD + (INWP - INW); m += NGW) {
        if (m < SEQ) rms_row_to_bf16(F.lane, F.in[0] + (size_t)m * DM, F.in[2], H + (size_t)m * DM);
        else if (m < LTOK) rms_row_to_bf16(F.lane, F.in[1] + (size_t)(m - SEQ) * DM, F.in[2], H + (size_t)m * DM);
        else { bf16* row = (m < MPAD) ? H + (size_t)m * DM : Wint + (size_t)(INW + (m - MPAD)) * DM; GAS v4u* o = (GAS v4u*)row + F.lane;
#pragma unroll
            for (int j = 0; j < 8; ++j) o[64 * j] = (v4u){0u, 0u, 0u, 0u}; }
    }
    const int gt = blockIdx.x * 512 + F.tid, NGT = F.G * 512;
    float* rope = (float*)(F.ws + WS_ROPE);
    for (int i = gt; i < LTOK * 16; i += NGT) { const int pos = i >> 4, k = i & 15;
        const double ang = (double)pos * ROPE_INV[k]; const double kq = __builtin_rint(ang * 0.15915494309189535);
        const double red = (ang - kq * 6.28318530717958623) - kq * 2.4492935982947064e-16; const float rf = (float)red;
        rope[2 * i] = cosf(rf); rope[2 * i + 1] = sinf(rf); }
    bf16* w2t = (bf16*)(F.ws + WS_LW2); bf16* a2t = (bf16*)(F.ws + WS_LA2); bf16* g2t = (bf16*)(F.ws + WS_LG2);
    for (int i = gt; i < 2 * 96 * RC; i += NGT) { const int c = i % RC, j = (i / RC) % 96, d = i / (RC * 96);
        w2t[((size_t)d * RC + c) * 96 + j] = (bf16)f2bf(F.in[8][i]); a2t[((size_t)d * RC + c) * 96 + j] = (bf16)f2bf(F.in[10][i]); }
    for (int i = gt; i < 256 * RC; i += NGT) { const int c = i % RC, j = i / RC; g2t[(size_t)c * 256 + j] = (bf16)f2bf(F.in[11][i]); }
}

__device__ __forceinline__ int crow(int r, int hi) { return (r & 3) + 8 * (r >> 2) + 4 * hi; }
__device__ __forceinline__ void attn_phase(Frame& F, const int gw, const int NGW) {
    const bf16* Q = (const bf16*)(F.ws + WS_Q); const bf16* K = (const bf16*)(F.ws + WS_K); const bf16* Vt = (const bf16*)(F.ws + WS_VT); bf16* OA = (bf16*)(F.ws + WS_OATT);
    const float* sink = F.in[17];
    const int hh = F.lane >> 5, r = F.lane & 31;
    constexpr float SC = 0.08838834764831845f * 1.4426950408889634f, L2E = 1.4426950408889634f;
    for (int item = gw; item < 4096; item += NGW) {
        const int sub = item & 3, hq = (item >> 2) & 15, qb = item >> 6, q0 = qb * 128 + sub * 32, hk = hq >> 2;
        bf16x8 bq[8];
        { const bf16* qp = Q + (size_t)(q0 + r) * ATTW + hq * 128 + 8 * hh;
#pragma unroll
          for (int s = 0; s < 8; ++s) bq[s] = *(const bf16x8*)(qp + 16 * s); }
        f32x16 O[4];
#pragma unroll
        for (int dt = 0; dt < 4; ++dt)
#pragma unroll
            for (int i = 0; i < 16; ++i) O[dt][i] = 0.f;
        float m = sink[hq] * L2E, l = (hh == 0) ? 1.f : 0.f;
        for (int ti = 0; ti < 10; ++ti) {
            const bool meta = (ti == 9);
            const int key0 = meta ? SEQ : q0 + 32 * (ti - 4);
            if (key0 < 0 || (!meta && key0 >= SEQ)) continue;
            f32x16 st;
#pragma unroll
            for (int i = 0; i < 16; ++i) st[i] = 0.f;
            { const bf16* kp = K + (size_t)(key0 + r) * KVW + hk * 128 + 8 * hh;
#pragma unroll
              for (int s = 0; s < 8; ++s) { const bf16x8 ak = *(const bf16x8*)(kp + 16 * s); st = __builtin_amdgcn_mfma_f32_32x32x16_bf16(ak, bq[s], st, 0, 0, 0); } }
            float tmax = -__builtin_inff();
#pragma unroll
            for (int i = 0; i < 16; ++i) { const int kr = crow(i, hh); bool ok;
                if (meta) ok = kr < NMETA; else { const int dlt = (key0 + kr) - (q0 + r); ok = (dlt >= -128) && (dlt <= 128); }
                const float t = ok ? st[i] * SC : -__builtin_inff(); st[i] = t; tmax = fmaxf(tmax, t); }
            tmax = fmaxf(tmax, __shfl_xor(tmax, 32));
            const float mn = fmaxf(m, tmax), alpha = __builtin_amdgcn_exp2f(m - mn); m = mn;
            float ps = 0.f;
#pragma unroll
            for (int i = 0; i < 16; ++i) { const float p = __builtin_amdgcn_exp2f(st[i] - mn); st[i] = p; ps += p; }
            l = l * alpha + ps;
#pragma unroll
            for (int dt = 0; dt < 4; ++dt)
#pragma unroll
                for (int i = 0; i < 16; ++i) O[dt][i] *= alpha;
            bf16x8 pb[2];
#pragma unroll
            for (int s2 = 0; s2 < 2; ++s2) { v4u w; w.x = pg8::cvt_pk_bf16(st[8 * s2 + 0], st[8 * s2 + 1]); w.y = pg8::cvt_pk_bf16(st[8 * s2 + 2], st[8 * s2 + 3]);
                w.z = pg8::cvt_pk_bf16(st[8 * s2 + 4], st[8 * s2 + 5]); w.w = pg8::cvt_pk_bf16(st[8 * s2 + 6], st[8 * s2 + 7]); pb[s2] = __builtin_bit_cast(bf16x8, w); }
#pragma unroll
            for (int dt = 0; dt < 4; ++dt) { const bf16* vp = Vt + (size_t)(hk * 128 + 32 * dt + r) * MPAD + key0 + 4 * hh;
#pragma unroll
                for (int s2 = 0; s2 < 2; ++s2) { const v2u lo = *(const v2u*)(vp + 16 * s2), hi = *(const v2u*)(vp + 16 * s2 + 8);
                    const v4u w = {lo.x, lo.y, hi.x, hi.y}; O[dt] = __builtin_amdgcn_mfma_f32_32x32x16_bf16(__builtin_bit_cast(bf16x8, w), pb[s2], O[dt], 0, 0, 0); } }
        }
        l += __shfl_xor(l, 32);
        const float inv = 1.0f / l;
        bf16* op = OA + (size_t)(q0 + r) * ATTW + hq * 128 + 4 * hh;
#pragma unroll
        for (int dt = 0; dt < 4; ++dt)
#pragma unroll
            for (int g4 = 0; g4 < 4; ++g4) { v2u w; w.x = pg8::cvt_pk_bf16(O[dt][4 * g4 + 0] * inv, O[dt][4 * g4 + 1] * inv); w.y = pg8::cvt_pk_bf16(O[dt][4 * g4 + 2] * inv, O[dt][4 * g4 + 3] * inv);
                *(v2u*)(op + 32 * dt + 8 * g4) = w; }
    }
}

__device__ __forceinline__ int tok2row(int t) { return t < NMETA ? SEQ + t : t - NMETA; }
struct Sh8 { v4u uc, up, un; };
__device__ __forceinline__ Sh8 shift8_ld(const bf16* U, int t, int col) {
    const int tc = t < LTOK ? t : LTOK - 1, tp = (t >= 1 && t - 1 < LTOK) ? t - 1 : 0, tn = t + 1 < LTOK ? t + 1 : LTOK - 1;
    Sh8 s; s.uc = *(const v4u*)(U + (size_t)tok2row(tc) * UPITCH + col); s.up = *(const v4u*)(U + (size_t)tok2row(tp) * UPITCH + col); s.un = *(const v4u*)(U + (size_t)tok2row(tn) * UPITCH + col); return s; }
__device__ __forceinline__ void shift8_fin(const Sh8& s, int t, int col, const float* mu_p, const float* mu_n, float (&x)[8]) {
    const v4u zz = {0u, 0u, 0u, 0u};
    const v4u uc = t < LTOK ? s.uc : zz, up = (t >= 1 && t - 1 < LTOK) ? s.up : zz, un = t + 1 < LTOK ? s.un : zz;
    const f32x4 mp0 = *(const f32x4*)(mu_p + col), mp1 = *(const f32x4*)(mu_p + col + 4), mn0 = *(const f32x4*)(mu_n + col), mn1 = *(const f32x4*)(mu_n + col + 4);
    const unsigned ucw[4] = {uc.x, uc.y, uc.z, uc.w}, upw[4] = {up.x, up.y, up.z, up.w}, unw[4] = {un.x, un.y, un.z, un.w};
    const float mpw[8] = {mp0[0], mp0[1], mp0[2], mp0[3], mp1[0], mp1[1], mp1[2], mp1[3]}, mnw[8] = {mn0[0], mn0[1], mn0[2], mn0[3], mn1[0], mn1[1], mn1[2], mn1[3]};
#pragma unroll
    for (int e = 0; e < 8; ++e) { const float c0 = (e & 1) ? bfhi(ucw[e >> 1]) : bflo(ucw[e >> 1]), p0 = (e & 1) ? bfhi(upw[e >> 1]) : bflo(upw[e >> 1]), n0 = (e & 1) ? bfhi(unw[e >> 1]) : bflo(unw[e >> 1]);
        x[e] = c0 + mpw[e] * (p0 - c0) + mnw[e] * (n0 - c0); }
}
__device__ __forceinline__ void flush_bf16(const LAS bf16* tile, bf16* ARR, int t0, int cbase, int lane) {
#pragma unroll
    for (int h = 0; h < 2; ++h) { const int row = (lane >> 2) + 16 * h, ch = lane & 3; const v4u v = *(const LAS v4u*)(tile + row * 32 + 8 * ch);
        if (t0 + row < LTOK) *(v4u*)(ARR + (size_t)(t0 + row) * RC + cbase + 8 * ch) = v; }
}
__device__ __forceinline__ void flush_f32(const LAS float* tile, float* ARR, int t0, int cbase, int lane) {
#pragma unroll
    for (int h = 0; h < 4; ++h) { const int row = (lane >> 3) + 8 * h, ch = lane & 7; const f32x4 v = *(const LAS f32x4*)(tile + row * 32 + 4 * ch);
        if (t0 + row < LTOK) *(f32x4*)(ARR + (size_t)(t0 + row) * RC + cbase + 4 * ch) = v; }
}
__device__ __forceinline__ void prep_phase(Frame& F) {
    constexpr int XS = 648;
    LAS bf16* Xs = (LAS bf16*)F.lds;
    LAS bf16* Kt = (LAS bf16*)(F.lds + 41472 + F.wave * 8192);
    LAS bf16* Ot = Kt + 2048;
    const bf16* U = (const bf16*)(F.ws + WS_U);
    const float* mu_p = F.in[5]; const float* mu_n = F.in[6];
    const bf16* w2t = (const bf16*)(F.ws + WS_LW2); const bf16* a2t = (const bf16*)(F.ws + WS_LA2); const bf16* g2t = (const bf16*)(F.ws + WS_LG2);
    float* W0 = (float*)(F.ws + WS_W0); float* W1 = (float*)(F.ws + WS_W1);
    bf16* KD0 = (bf16*)(F.ws + WS_KD0); bf16* KD1 = (bf16*)(F.ws + WS_KD1); bf16* B0 = (bf16*)(F.ws + WS_B0); bf16* B1 = (bf16*)(F.ws + WS_B1);
    bf16* KK = (bf16*)(F.ws + WS_KK); bf16* RR = (bf16*)(F.ws + WS_RR); bf16* VV = (bf16*)(F.ws + WS_VV); bf16* GG = (bf16*)(F.ws + WS_GG);
    const int hh = F.lane >> 5, r = F.lane & 31;
    for (int unit = blockIdx.x; unit < 257 * 4; unit += F.G) {
        const int tt = unit >> 2, t0 = tt * 32, hd = (unit & 3) * 8 + F.wave;
        __syncthreads();
        FPB0(15);
        { Sh8 sx[5];
#pragma unroll
          for (int it = 0; it < 5; ++it) { const int ci = F.tid + 512 * it; sx[it] = shift8_ld(U, t0 + ci / 80, 3 * RC + 8 * (ci % 80)); }
#pragma unroll
          for (int it = 0; it < 5; ++it) { const int ci = F.tid + 512 * it, tl = ci / 80, ch = ci % 80;
            float x[8]; shift8_fin(sx[it], t0 + tl, 3 * RC + 8 * ch, mu_p, mu_n, x);
#pragma unroll
            for (int e = 0; e < 8; ++e) { float v = x[e];
                if (ch < 24) { const float ex = __expf(2.0f * v); v = 1.0f - 2.0f / (ex + 1.0f); }
                else if (ch >= 48) v = sigmoidf_(v);
                x[e] = v; }
            v4u o; o.x = pk2(x[0], x[1]); o.y = pk2(x[2], x[3]); o.z = pk2(x[4], x[5]); o.w = pk2(x[6], x[7]);
            *(LAS v4u*)(Xs + tl * XS + 8 * ch) = o; } }
        { const int c8 = hd * 64 + 8 * (F.lane & 7);
#pragma unroll
          for (int st = 0; st < 3; ++st) { const int col = (st == 0 ? RC : st == 1 ? 0 : 2 * RC) + c8; Sh8 sq[4];
#pragma unroll
            for (int q = 0; q < 4; ++q) sq[q] = shift8_ld(U, t0 + (F.lane >> 3) + 8 * q, col);
#pragma unroll
            for (int q = 0; q < 4; ++q) { const int tl = (F.lane >> 3) + 8 * q, tq = t0 + tl; float x[8]; shift8_fin(sq[q], tq, col, mu_p, mu_n, x);
                v4u o; o.x = pk2(x[0], x[1]); o.y = pk2(x[2], x[3]); o.z = pk2(x[4], x[5]); o.w = pk2(x[6], x[7]);
                if (st == 0) *(LAS v4u*)(Kt + tl * 64 + 8 * (F.lane & 7)) = o;
                else if (tq < LTOK) *(v4u*)((st == 1 ? RR : VV) + (size_t)tq * RC + c8) = o; } } }
        __syncthreads();
        FPB1(15); FPB0(16);
        float kp[2][16], ss[16];
#pragma unroll
        for (int i = 0; i < 16; ++i) ss[i] = 0.f;
#pragma unroll
        for (int ct = 0; ct < 2; ++ct) { const int c = hd * 64 + 32 * ct + r; const float kkw = F.in[12][c];
#pragma unroll
            for (int i = 0; i < 16; ++i) { kp[ct][i] = bf2f(Kt[crow(i, hh) * 64 + 32 * ct + r]); const float kr = kp[ct][i] * kkw; ss[i] += kr * kr; } }
#pragma unroll
        for (int i = 0; i < 16; ++i) {
#pragma unroll
            for (int o = 1; o < 32; o <<= 1) ss[i] += __shfl_xor(ss[i], o);
            ss[i] = 1.0f / fmaxf(sqrtf(ss[i]), 1e-12f); }
#define LDF(dst, ptr, n) do { _Pragma("unroll") for (int s_ = 0; s_ < (n); ++s_) dst[s_] = *(const bf16x8*)((ptr) + 16 * s_); } while (0)
#define MMF(frag, xoff, n) do { _Pragma("unroll") for (int i_ = 0; i_ < 16; ++i_) acc[i_] = 0.f; const LAS bf16* ap_ = Xs + r * XS + (xoff) + 8 * hh; \
            _Pragma("unroll") for (int s_ = 0; s_ < (n); ++s_) acc = __builtin_amdgcn_mfma_f32_32x32x16_bf16(*(const LAS bf16x8*)(ap_ + 16 * s_), frag[s_], acc, 0, 0, 0); } while (0)
#pragma unroll
        for (int ct = 0; ct < 2; ++ct) {
            const int c = hd * 64 + 32 * ct + r, cb = hd * 64 + 32 * ct;
            const float kkw = F.in[12][c], kaw = F.in[13][c];
            const bf16* pa0 = a2t + (size_t)c * 96 + 8 * hh; const bf16* pa1 = a2t + ((size_t)RC + c) * 96 + 8 * hh;
            const bf16* pw0 = w2t + (size_t)c * 96 + 8 * hh; const bf16* pw1 = w2t + ((size_t)RC + c) * 96 + 8 * hh; const bf16* pg = g2t + (size_t)c * 256 + 8 * hh;
            bf16x8 fa[6], fg[16]; f32x16 acc; float kk[16];
            LDF(fa, pa0, 6);
#pragma unroll
            for (int i = 0; i < 16; ++i) { kk[i] = kp[ct][i] * kkw * ss[i]; Ot[crow(i, hh) * 32 + r] = (bf16)f2bf(kk[i]); }
            flush_bf16(Ot, KK, t0, cb, F.lane);
#pragma unroll
            for (int d = 0; d < 2; ++d) {
                if (d == 0) { MMF(fa, 192, 6); LDF(fa, pa1, 6); } else { MMF(fa, 288, 6); LDF(fa, pw0, 6); }
                const float a0 = F.in[9][d * RC + c];
#pragma unroll
                for (int i = 0; i < 16; ++i) { acc[i] = sigmoidf_(a0 + acc[i]); Ot[crow(i, hh) * 32 + r] = (bf16)f2bf(kp[ct][i] * (1.0f + (acc[i] - 1.0f) * kaw)); }
                flush_bf16(Ot, d ? KD1 : KD0, t0, cb, F.lane);
#pragma unroll
                for (int i = 0; i < 16; ++i) Ot[crow(i, hh) * 32 + r] = (bf16)f2bf(kk[i] * acc[i]);
                flush_bf16(Ot, d ? B1 : B0, t0, cb, F.lane);
            }
#pragma unroll
            for (int d = 0; d < 2; ++d) {
                if (d == 0) { MMF(fa, 0, 6); LDF(fa, pw1, 6); } else { MMF(fa, 96, 6); LDF(fg, pg, 16); }
                const float w0 = F.in[7][d * RC + c]; LAS float* Of = (LAS float*)Ot;
#pragma unroll
                for (int i = 0; i < 16; ++i) Of[crow(i, hh) * 32 + r] = __expf(-0.6065306597126334f * sigmoidf_(w0 + acc[i]));
                flush_f32(Of, d ? W1 : W0, t0, cb, F.lane);
            }
            MMF(fg, 384, 16);
#pragma unroll
            for (int i = 0; i < 16; ++i) Ot[crow(i, hh) * 32 + r] = (bf16)f2bf(acc[i]);
            flush_bf16(Ot, GG, t0, cb, F.lane);
        }
#undef LDF
#undef MMF
        FPB1(16);
    }
    __syncthreads();
}

__device__ __forceinline__ float dpp_xor_add(float x, const int ctrl_sel) {
    int y;
    if (ctrl_sel == 0) y = __builtin_amdgcn_update_dpp(0, __float_as_int(x), 0xB1, 0xf, 0xf, true);
    else if (ctrl_sel == 1) y = __builtin_amdgcn_update_dpp(0, __float_as_int(x), 0x4E, 0xf, 0xf, true);
    else if (ctrl_sel == 2) y = __builtin_amdgcn_update_dpp(0, __float_as_int(x), 0x141, 0xf, 0xf, true);
    else y = __builtin_amdgcn_update_dpp(0, __float_as_int(x), 0x140, 0xf, 0xf, true);
    return x + __int_as_float(y);
}
__device__ __forceinline__ float row16_sum(float x) { x = dpp_xor_add(x, 0); x = dpp_xor_add(x, 1); x = dpp_xor_add(x, 2); x = dpp_xor_add(x, 3); return x; }
constexpr int SC_CH = 32, SC_STEP = 336, SC_BUF = SC_CH * SC_STEP;
struct ScanOps { f32x4 w, kd, b, kk, r; float v; };
__device__ __forceinline__ ScanOps scan_ld(const LAS float* sp, int jg, int rl) {
    ScanOps o; o.w = *(const LAS f32x4*)(sp + 4 * jg); o.kd = *(const LAS f32x4*)(sp + 64 + 4 * jg); o.b = *(const LAS f32x4*)(sp + 128 + 4 * jg);
    o.kk = *(const LAS f32x4*)(sp + 192 + 4 * jg); o.r = *(const LAS f32x4*)(sp + 256 + 4 * jg); o.v = sp[320 + rl]; return o; }
__device__ __forceinline__ void scan_consume(const LAS float* base, LAS float* yb, int jg, int rl, f32x2& S01, f32x2& S23) {
    ScanOps o0 = scan_ld(base, jg, rl), o1 = scan_ld(base + SC_STEP, jg, rl);
#pragma unroll
    for (int sl = 0; sl < SC_CH; ++sl) {
        ScanOps o2 = o1;
        if (sl + 2 < SC_CH) o2 = scan_ld(base + (sl + 2) * SC_STEP, jg, rl);
        const f32x2 kklo = __builtin_shufflevector(o0.kk, o0.kk, 0, 1), kkhi = __builtin_shufflevector(o0.kk, o0.kk, 2, 3);
        const f32x2 wlo = __builtin_shufflevector(o0.w, o0.w, 0, 1), whi = __builtin_shufflevector(o0.w, o0.w, 2, 3);
        const f32x2 kdlo = __builtin_shufflevector(o0.kd, o0.kd, 0, 1), kdhi = __builtin_shufflevector(o0.kd, o0.kd, 2, 3);
        const f32x2 blo = __builtin_shufflevector(o0.b, o0.b, 0, 1), bhi = __builtin_shufflevector(o0.b, o0.b, 2, 3);
        const f32x2 rlo = __builtin_shufflevector(o0.r, o0.r, 0, 1), rhi = __builtin_shufflevector(o0.r, o0.r, 2, 3);
        const f32x2 vv = {o0.v, o0.v};
        f32x2 m = S01 * kklo; m = S23 * kkhi + m;
        float p = m.x + m.y;
        const f32x2 u01 = S01 * wlo + vv * kdlo, u23 = S23 * whi + vv * kdhi;
        p = row16_sum(p);
        const f32x2 pp = {p, p};
        S01 = u01 - pp * blo; S23 = u23 - pp * bhi;
        f32x2 ym = S01 * rlo; ym = S23 * rhi + ym;
        float y = ym.x + ym.y;
        y = dpp_xor_add(y, 0); y = dpp_xor_add(y, 1); y = dpp_xor_add(y, 2);
        yb[sl * 64] = y;
        o0 = o1; o1 = o2;
    }
}
__device__ __forceinline__ void convert_item(Frame& F, LAS float* scr, int it) {
    constexpr int I_GU = (DM / 64) * (DFF / 32), I_P = (ATTW / 64) * (DM / 32), I_O = (DM / 64) * (DM / 32);
    int r = it;
    if (r < I_GU) { transpose_item<1>(F.in[22], DM, DFF, (bf16*)(F.ws + WS_WGU), scr, r, F.lane, F.in[21]); return; } r -= I_GU;
    if (r < I_GU) { transpose_item<2>(F.in[23], DM, DFF, (bf16*)(F.ws + WS_WGU), scr, r, F.lane, F.in[21]); return; } r -= I_GU;
    if (r < I_P) { transpose_item<0>(F.in[18], ATTW, DM, (bf16*)(F.ws + WS_WPA), scr, r, F.lane, nullptr); return; } r -= I_P;
    if (r < I_P) { transpose_item<0>(F.in[19], RC, DM, (bf16*)(F.ws + WS_WPR), scr, r, F.lane, nullptr); return; } r -= I_P;
    if (r < I_O) { transpose_item<0>(F.in[20], DM, DM, (bf16*)(F.ws + WS_WOUT), scr, r, F.lane, nullptr); return; } r -= I_O;
    transpose_item<0>(F.in[24], DFF, DM, (bf16*)(F.ws + WS_WD), scr, r, F.lane, nullptr);
}
constexpr int N_CONVERT_ITEMS = 2 * (DM / 64) * (DFF / 32) + 2 * (ATTW / 64) * (DM / 32) + (DM / 64) * (DM / 32) + (DFF / 64) * (DM / 32);
constexpr int SC_FLAGS_OFF = 102400, SC_WSCR_OFF = 103424;
__device__ __forceinline__ void scan_phase(Frame& F) {
    LAS float* BUF = (LAS float*)F.lds;
    LAS float* YB = (LAS float*)(F.lds + 2 * SC_BUF * 4);
    volatile LAS unsigned* FL = (volatile LAS unsigned*)(F.lds + SC_FLAGS_OFF);
    const float* W0 = (const float*)(F.ws + WS_W0); const float* W1 = (const float*)(F.ws + WS_W1);
    const bf16* KD0 = (const bf16*)(F.ws + WS_KD0); const bf16* KD1 = (const bf16*)(F.ws + WS_KD1); const bf16* B0 = (const bf16*)(F.ws + WS_B0); const bf16* B1 = (const bf16*)(F.ws + WS_B1);
    const bf16* KK = (const bf16*)(F.ws + WS_KK); const bf16* RR = (const bf16*)(F.ws + WS_RR); const bf16* VV = (const bf16*)(F.ws + WS_VV);
    float* Y = (float*)(F.ws + WS_Y);
    constexpr unsigned SPIN_CAP = 1u << 22;
    for (int item = blockIdx.x; item < 256; item += F.G) {
        __syncthreads();
        if (F.tid < 96) FL[F.tid] = 0u;
        __syncthreads();
        const int pair = (item & 7) * 8 + (item >> 5), q4 = (item >> 3) & 3, hd = pair >> 1, dir = pair & 1;
        const int nsteps = dir ? SEQ : LTOK, nchunks = (nsteps + SC_CH - 1) / SC_CH;
        if (F.wave < 4) {
            __builtin_amdgcn_s_setprio(3);
            f32x2 S01 = {0.f, 0.f}, S23 = {0.f, 0.f};
            const int g = F.lane >> 4, jg = F.lane & 15, rl = 4 * F.wave + g;
            const int yslot = ((jg & 7) == 0) ? (2 * rl + (jg >> 3)) : (32 + (F.lane & 31));
            for (int c = 0; c < nchunks; ++c) {
                { unsigned sp = 0; while (FL[0] <= (unsigned)c) { __builtin_amdgcn_s_sleep(1); if (++sp > SPIN_CAP) break; } }
                asm volatile("" ::: "memory");
                scan_consume(BUF + (c & 1) * SC_BUF, YB + (c & 1) * (SC_CH * 64) + yslot, jg, rl, S01, S23);
                asm volatile("s_waitcnt lgkmcnt(0)" ::: "memory");
                if (F.lane == 0) FL[16 + 16 * F.wave] = (unsigned)(c + 1);
            }
            __builtin_amdgcn_s_setprio(0);
        } else if (F.wave == 4) {
            __builtin_amdgcn_s_setprio(2);
            const float* Wd = dir ? W1 : W0; const bf16* KDd = dir ? KD1 : KD0; const bf16* Bd = dir ? B1 : B0;
            float* Yd = Y + (size_t)dir * LTOK * RC;
            const int lq = F.lane & 15, s4 = F.lane >> 4, slv = F.lane >> 1, qv0 = (F.lane & 1) * 2;
            f32x4 lw[8]; v2u lk[8][4]; v2u lv[2];
#define SCAN_ISSUE(c) do { _Pragma("unroll") for (int k_ = 0; k_ < 8; ++k_) { const int s_ = (c) * SC_CH + s4 + 4 * k_; const int sc_ = s_ < nsteps ? s_ : nsteps - 1; const int t_ = dir ? (LTOK - 1 - sc_) : sc_; \
                const size_t o_ = (size_t)t_ * RC + hd * 64 + 4 * lq; lw[k_] = *(const f32x4*)(Wd + o_); lk[k_][0] = *(const v2u*)(KDd + o_); lk[k_][1] = *(const v2u*)(Bd + o_); lk[k_][2] = *(const v2u*)(KK + o_); lk[k_][3] = *(const v2u*)(RR + o_); } \
            { const int s_ = (c) * SC_CH + slv; const int sc_ = s_ < nsteps ? s_ : nsteps - 1; const int t_ = dir ? (LTOK - 1 - sc_) : sc_; \
              _Pragma("unroll") for (int u_ = 0; u_ < 2; ++u_) lv[u_] = *(const v2u*)(VV + (size_t)t_ * RC + hd * 64 + 16 * q4 + 4 * (qv0 + u_)); } } while (0)
#define SCAN_WRITE(c) do { LAS float* dst_ = BUF + ((c) & 1) * SC_BUF; _Pragma("unroll") for (int k_ = 0; k_ < 8; ++k_) { const int sl_ = s4 + 4 * k_; const bool ok_ = (c) * SC_CH + sl_ < nsteps; LAS float* d_ = dst_ + sl_ * SC_STEP + 4 * lq; \
                *(LAS f32x4*)d_ = ok_ ? lw[k_] : (f32x4){1.f, 1.f, 1.f, 1.f}; \
                _Pragma("unroll") for (int a_ = 0; a_ < 4; ++a_) { const v2u w_ = lk[k_][a_]; *(LAS f32x4*)(d_ + 64 * (a_ + 1)) = ok_ ? (f32x4){bflo(w_.x), bfhi(w_.x), bflo(w_.y), bfhi(w_.y)} : (f32x4){0.f, 0.f, 0.f, 0.f}; } } \
            { const bool ok_ = (c) * SC_CH + slv < nsteps; _Pragma("unroll") for (int u_ = 0; u_ < 2; ++u_) { const v2u w_ = lv[u_]; \
                *(LAS f32x4*)(dst_ + slv * SC_STEP + 320 + 4 * (qv0 + u_)) = ok_ ? (f32x4){bflo(w_.x), bfhi(w_.x), bflo(w_.y), bfhi(w_.y)} : (f32x4){0.f, 0.f, 0.f, 0.f}; } } } while (0)
#define SCAN_FLUSH(c) do { const LAS float* yb_ = YB + ((c) & 1) * (SC_CH * 64); _Pragma("unroll") for (int u_ = 0; u_ < 8; ++u_) { const int pi_ = F.lane + 64 * u_; const int sl_ = pi_ >> 4, s_ = (c) * SC_CH + sl_; \
                if (s_ < nsteps) { const int t_ = dir ? (LTOK - 1 - s_) : s_; const f32x2 y2_ = *(const LAS f32x2*)(yb_ + sl_ * 64 + 2 * (pi_ & 15)); Yd[(size_t)t_ * RC + hd * 64 + 16 * q4 + (pi_ & 15)] = y2_.x + y2_.y; } } } while (0)
#define SCAN_WAIT_DONE(n) do { unsigned sp_ = 0; for (;;) { const unsigned d0_ = FL[16], d1_ = FL[32], d2_ = FL[48], d3_ = FL[64]; \
                const unsigned mn_ = min(min(d0_, d1_), min(d2_, d3_)); if (mn_ >= (unsigned)(n)) break; __builtin_amdgcn_s_sleep(1); if (++sp_ > SPIN_CAP) break; } asm volatile("" ::: "memory"); } while (0)
            SCAN_ISSUE(0); SCAN_WRITE(0);
            asm volatile("s_waitcnt lgkmcnt(0)" ::: "memory");
            if (F.lane == 0) FL[0] = 1u;
            SCAN_ISSUE(1);
            for (int c = 0; c < nchunks; ++c) {
                if (c >= 1) { SCAN_WAIT_DONE(c); SCAN_FLUSH(c - 1); }
                if (c + 1 < nchunks) { SCAN_WRITE(c + 1); asm volatile("s_waitcnt lgkmcnt(0)" ::: "memory"); if (F.lane == 0) FL[0] = (unsigned)(c + 2); }
                if (c + 2 < nchunks) SCAN_ISSUE(c + 2);
            }
            SCAN_WAIT_DONE(nchunks); SCAN_FLUSH(nchunks - 1);
            __builtin_amdgcn_s_setprio(0);
#undef SCAN_ISSUE
#undef SCAN_WRITE
#undef SCAN_FLUSH
#undef SCAN_WAIT_DONE
        } else if (item == (int)blockIdx.x) {
            const int gwk = blockIdx.x * 3 + (F.wave - 5), NWK = F.G * 3;
            attn_phase(F, gwk, NWK);
            LAS float* scr = (LAS float*)(F.lds + SC_WSCR_OFF + (F.wave - 5) * 8448);
            for (int it = gwk; it < N_CONVERT_ITEMS; it += NWK) convert_item(F, scr, it);
        }
    }
}

__device__ __forceinline__ void combine_phase(Frame& F) {
    const float* Y0 = (const float*)(F.ws + WS_Y); const float* Y1 = Y0 + (size_t)LTOK * RC;
    const bf16* VV = (const bf16*)(F.ws + WS_VV); const bf16* GG = (const bf16*)(F.ws + WS_GG); const bf16* RR = (const bf16*)(F.ws + WS_RR);
    const bf16* KD0 = (const bf16*)(F.ws + WS_KD0); const bf16* KD1 = (const bf16*)(F.ws + WS_KD1);
    bf16* OR = (bf16*)(F.ws + WS_ORWKV);
    const float* lnw = F.in[15]; const float* lnb = F.in[16]; const float* rk = F.in[14];
    const int gw = blockIdx.x * 8 + F.wave, NGW = F.G * 8;
    for (int row = gw; row < SEQ; row += NGW) { const int t = row + NMETA;
#pragma unroll 4
        for (int hd = 0; hd < RH; ++hd) { const int c = hd * 64 + F.lane; const size_t o = (size_t)t * RC + c;
            const float y = Y0[o] + Y1[o]; const float bterm = bf2f(RR[o]) * (bf2f(KD0[o]) + bf2f(KD1[o])) * rk[c];
            const float mean = wave_sum(y) * (1.0f / 64.0f); const float dlt = y - mean; const float var = wave_sum(dlt * dlt) * (1.0f / 64.0f); const float bonus = wave_sum(bterm);
            const float yn = dlt * (1.0f / sqrtf(var + GN_EPS)) * lnw[c] + lnb[c];
            const float outv = (yn + bonus * bf2f(VV[o])) * bf2f(GG[o]);
            OR[(size_t)row * RC + c] = (bf16)f2bf(outv); } }
}
__device__ __forceinline__ void final_phase(Frame& F) {
    const float* SS3 = (const float*)(F.ctl + CW_SS3); const float* w = F.in[25];
    const int gw = blockIdx.x * 8 + F.wave, NGW = F.G * 8;
    for (int row = gw; row < SEQ; row += NGW) { const float rstd = 1.0f / sqrtf(SS3[row] * (1.0f / DM) + RMS_EPS);
        GAS f32x4* p = (GAS f32x4*)(F.out + (size_t)row * DM) + F.lane; const GAS f32x4* wp = (const GAS f32x4*)w + F.lane;
#pragma unroll
        for (int j = 0; j < 16; ++j) { const f32x4 v = p[64 * j], ww = wp[64 * j]; p[64 * j] = v * rstd * ww; } }
}
constexpr int N_PHASES = 10;
struct Args { const float* in[26]; float* out; unsigned char* ws; int ph_lo, ph_hi; };
__global__ void __launch_bounds__(512, 2) fwd_kernel(Args args) {
    extern __shared__ __attribute__((aligned(16))) unsigned char lds[];
    Frame F;
    F.lds = (LAS unsigned char*)lds;
    F.MISC = (volatile LAS unsigned*)(F.lds + MISC_OFF);
    F.tid = threadIdx.x; F.lane = F.tid & 63; F.wave = __builtin_amdgcn_readfirstlane(F.tid >> 6); F.G = gridDim.x;
    F.ws = args.ws; F.ctl = (gu32*)(args.ws + WS_CTL); F.out = args.out; F.pb0 = 0; F.pacc = 0; F.pacc2 = 0;
#pragma unroll
    for (int i = 0; i < 26; ++i) F.in[i] = args.in[i];
    for (int u = F.tid; u < (LDS_BYTES - LDSCTL_OFF) / 4; u += 512) ((LAS unsigned*)(F.lds + LDSCTL_OFF))[u] = 0u;
    __syncthreads();
    XcdBarrier bar; bar.bar = (unsigned*)(F.ctl + CW_BAR); bar.x = 0; bar.st = nullptr;
    if (!MK_SPLIT) bar = xcd_barrier_post((unsigned*)(F.ctl + CW_BAR), F.MISC + 8);
    const int lo = args.ph_lo, hi = args.ph_hi;
#define IN(k) (lo <= (k) && (k) < hi)
#define SEAM(k) do { if (IN(k) && IN((k) + 1)) xcd_barrier(bar); } while (0)
    bf16* Rm = (bf16*)(F.ws + WS_H);
    float* SS2 = (float*)(F.ctl + CW_SS2); float* SS3 = (float*)(F.ctl + CW_SS3);

    unsigned long long pt0 = 0, pt1 = 0;
#define PB0(k) do { if ((PROBE_PHASE >> (k)) & 1) pt0 = __builtin_amdgcn_s_memrealtime(); } while (0)
#define PB1(k) do { if ((PROBE_PHASE >> (k)) & 1) pt1 += __builtin_amdgcn_s_memrealtime() - pt0; } while (0)
    PB0(0); if (IN(0)) { p0_prologue(F); } SEAM(0); PB1(0);
    PB0(1); if (IN(1)) {
        pg8::Gemm g{Rm, Rm, MPAD + INWP, MPAD + INWP, DM}; pg8::InOrder S; S.init(F.G, (int)blockIdx.x);
        pg8::EpiIn E{(bf16*)(F.ws + WS_G), (bf16*)(F.ws + WS_Q), (bf16*)(F.ws + WS_K), (bf16*)(F.ws + WS_VT), (bf16*)(F.ws + WS_U), F.in[4], (const float*)(F.ws + WS_ROPE)};
        pg8::gemm_phase<pg8::EpiIn, pg8::InOrder, true, true>(F.lds, g, S, E, F.pacc2);
    } SEAM(1); PB1(1);
    PB0(2); if (IN(2)) { prep_phase(F); } SEAM(2); PB1(2);
    PB0(3); if (IN(3)) { scan_phase(F); } SEAM(3); PB1(3);
    PB0(4); if (IN(4)) { combine_phase(F); } SEAM(4); PB1(4);
    PB0(5); if (IN(5)) {
        { pg8::Gemm g{(const bf16*)(F.ws + WS_OATT), (const bf16*)(F.ws + WS_WPA), SEQ, DM, ATTW}; pg8::StaticOrder S; S.init(SEQ, DM, F.G, (int)blockIdx.x);
          pg8::EpiProjA E{(bf16*)(F.ws + WS_P1), (const bf16*)(F.ws + WS_G)};
          pg8::gemm_phase<pg8::EpiProjA, pg8::StaticOrder, true, true>(F.lds, g, S, E, F.pacc2); }
        __syncthreads();
        { pg8::Gemm g{(const bf16*)(F.ws + WS_ORWKV), (const bf16*)(F.ws + WS_WPR), SEQ, DM, RC}; pg8::StaticOrder S; S.init(SEQ, DM, F.G, (int)blockIdx.x);
          pg8::EpiProjB E{(const bf16*)(F.ws + WS_P1), (const bf16*)(F.ws + WS_G), (bf16*)(F.ws + WS_MX)};
          pg8::gemm_phase<pg8::EpiProjB, pg8::StaticOrder, true, true>(F.lds, g, S, E, F.pacc2); }
    } SEAM(5); PB1(5);
    PB0(6); if (IN(6)) {
        pg8::Gemm g{(const bf16*)(F.ws + WS_MX), (const bf16*)(F.ws + WS_WOUT), SEQ, DM, DM}; pg8::StaticOrder S; S.init(SEQ, DM, F.G, (int)blockIdx.x);
        pg8::EpiResid<false> E{F.in[0], nullptr, nullptr, (bf16*)(F.ws + WS_A2), SS2};
        pg8::gemm_phase<pg8::EpiResid<false>, pg8::StaticOrder, true, true>(F.lds, g, S, E, F.pacc2);
    } SEAM(6); PB1(6);
    PB0(7); if (IN(7)) {
        pg8::Gemm g{(const bf16*)(F.ws + WS_A2), (const bf16*)(F.ws + WS_WGU), SEQ, 2 * DFF, DM}; pg8::StaticOrder S; S.init(SEQ, 2 * DFF, F.G, (int)blockIdx.x);
        pg8::EpiSwiGLU E{(bf16*)(F.ws + WS_HID), SS2};
        pg8::gemm_phase<pg8::EpiSwiGLU, pg8::StaticOrder, true, true>(F.lds, g, S, E, F.pacc2);
    } SEAM(7); PB1(7);
    PB0(8); if (IN(8)) {
        pg8::Gemm g{(const bf16*)(F.ws + WS_HID), (const bf16*)(F.ws + WS_WD), SEQ, DM, DFF}; pg8::StaticOrder S; S.init(SEQ, DM, F.G, (int)blockIdx.x);
        pg8::EpiResid<true> E{nullptr, (const bf16*)(F.ws + WS_A2), F.out, nullptr, SS3};
        pg8::gemm_phase<pg8::EpiResid<true>, pg8::StaticOrder, true, true>(F.lds, g, S, E, F.pacc2);
    } SEAM(8); PB1(8);
    PB0(9); if (IN(9)) { final_phase(F); } PB1(9);
    if (PROBE_PHASE != 0 && blockIdx.x == 0 && F.tid == 0) { const unsigned long long te = __builtin_amdgcn_s_memrealtime(), want = (unsigned long long)PROBE_MULT * (((PROBE_PHASE >> 20) & 1) ? F.pacc2 : (pt1 + F.pacc));
        while (__builtin_amdgcn_s_memrealtime() - te < want && want < 2000000ull) __builtin_amdgcn_s_sleep(32); }
#undef PB0
#undef PB1
#undef IN
#undef SEAM
}

extern "C" void kernel_launch(void* const* d_in, const int* in_sizes, int n_in, void* d_out, int out_size, void* d_ws, size_t ws_size, hipStream_t stream) {
    static int grid = 0;
    if (grid == 0) {
        if (n_in != 26 || out_size != SEQ * DM || ws_size < WS_END) { fprintf(stderr, "kernel_launch: unexpected shapes (n_in %d, out %d, ws %zu, need %zu); nothing launched\n", n_in, out_size, ws_size, (size_t)WS_END); grid = -1; return; }
        int dev = 0, cus = 0, per_cu = 0;
        if (hipGetDevice(&dev) != hipSuccess || hipDeviceGetAttribute(&cus, hipDeviceAttributeMultiprocessorCount, dev) != hipSuccess) { grid = -1; return; }
        if (hipFuncSetAttribute((const void*)fwd_kernel, hipFuncAttributeMaxDynamicSharedMemorySize, LDS_BYTES) != hipSuccess) { fprintf(stderr, "kernel_launch: hipFuncSetAttribute failed\n"); grid = -1; return; }
        if (hipOccupancyMaxActiveBlocksPerMultiprocessor(&per_cu, (const void*)fwd_kernel, 512, LDS_BYTES) != hipSuccess || per_cu < 1) fprintf(stderr, "kernel_launch: occupancy query says %d per CU\n", per_cu);
        (void)hipGetLastError();
        grid = cus;
    }
    if (grid < 0) return;
    if (hipMemsetAsync((char*)d_ws + WS_CTL, 0, CTL_ZERO_BYTES, stream) != hipSuccess) return;
    Args a{};
    for (int i = 0; i < 26; ++i) a.in[i] = (const float*)d_in[i];
    a.out = (float*)d_out; a.ws = (unsigned char*)d_ws;
#if MK_SPLIT
    for (int p = 0; p < N_PHASES; ++p) { a.ph_lo = p; a.ph_hi = p + 1; hipLaunchKernelGGL(fwd_kernel, dim3(grid), dim3(512), LDS_BYTES, stream, a); }
#else
    a.ph_lo = 0; a.ph_hi = N_PHASES;
    hipLaunchKernelGGL(fwd_kernel, dim3(grid), dim3(512), LDS_BYTES, stream, a);
#endif
}
```

```cpp
#include <hip/hip_runtime.h>
#include <cstdio>
#include <cstdint>

#ifndef MK_SPLIT
#define MK_SPLIT 0
#endif

#ifndef PROBE_PHASE
#define PROBE_PHASE 0
#endif
#ifndef PROBE_MULT
#define PROBE_MULT 2
#endif
constexpr int NMETA = 16, SEQ = 8192, LTOK = 8208, DM = 4096, MPAD = 8448;
constexpr int INW = 18048, INWP = 18176;
constexpr int ATTW = 2048, KVW = 512, UW = 6784, UPITCH = 6912;
constexpr int RC = 2048, RH = 32, RN = 64;
constexpr int DFF = 11008;
constexpr float RMS_EPS = 1e-6f, GN_EPS = 64e-5f;
constexpr int HT = MPAD / 256;
constexpr int CT_Q = 32, CT_K = 40, CT_V = 42, CT_U = 44, CT_N = 71;

namespace pg8 {
#define PG8_LAS __attribute__((address_space(3)))
typedef unsigned short bf16_t;
typedef short bf16x8 __attribute__((ext_vector_type(8)));
typedef float f32x4 __attribute__((ext_vector_type(4)));
typedef unsigned u32x4 __attribute__((ext_vector_type(4)));
constexpr int BM = 256, BK = 64, HALF = 128, HTB = HALF * BK * 2  , STAGE_BYTES = 8 * HTB, NXCD = 8, WGM = 8;

__host__ __device__ __forceinline__ int lds_byte(int r, int c) { const int st = (r >> 4) * 2 + (c >> 5), rr = r & 15, cc = c & 31, ob = rr * 64 + cc * 2; return st * 1024 + (ob ^ (((ob >> 9) & 1) << 5)); }
__host__ __device__ __forceinline__ void stage_rc(int b, int& R, int& C) { const int st = b / 1024, sb = b % 1024, swz = sb ^ (((sb >> 9) & 1) << 5); R = (st >> 1) * 16 + swz / 64; C = (st & 1) * 32 + (swz % 64) / 2; }
__host__ __device__ __forceinline__ int perm32(int rho) { const int n = rho >> 4, i = rho & 15; return 8 * (i >> 2) + 4 * n + (i & 3); }

struct Unit { int pm, pn; };
struct Gemm { const bf16_t* A; const bf16_t* Bt; int M, N, K; };

struct StaticOrder {
    int nM, nN, nwg, G, c;
    __host__ __device__ void init(int M, int N, int G_, int c_) { nM = M / BM; nN = N / BM; nwg = nM * nN; G = G_; c = c_; }
    __host__ __device__ bool next(int i, Unit& u) const {
        const long L = (long)i * G + c; if (L >= nwg) return false;
        int wgid = (int)L; { const int q = nwg / NXCD, r = nwg % NXCD, xcd = wgid % NXCD, off = wgid / NXCD; wgid = (xcd < r ? xcd * (q + 1) : r * (q + 1) + (xcd - r) * q) + off; }
        const int nig = WGM * nN, gid = wgid / nig, fm = gid * WGM, gsz = (nM - fm) < WGM ? (nM - fm) : WGM;
        u.pm = fm + ((wgid % nig) % gsz); u.pn = (wgid % nig) / gsz; return true;
    }
    __device__ __forceinline__ void a_ready(const Unit&) const {}
    __device__ __forceinline__ void done(const Unit&) const {}
};

typedef float f32x2c __attribute__((ext_vector_type(2)));
typedef __bf16 bf16x2c __attribute__((ext_vector_type(2)));
__device__ __forceinline__ unsigned cvt_pk_bf16(float lo, float hi) { const f32x2c v = {lo, hi}; const bf16x2c r = __builtin_convertvector(v, bf16x2c); return __builtin_bit_cast(unsigned, r); }

typedef unsigned u32x2 __attribute__((ext_vector_type(2)));
__device__ __forceinline__ float bflo(unsigned w) { return __uint_as_float(w << 16); }
__device__ __forceinline__ float bfhi(unsigned w) { return __uint_as_float(w & 0xffff0000u); }
__device__ __forceinline__ float sigmoidf_(float x) { return __builtin_amdgcn_rcpf(1.0f + __expf(-x)); }

struct InOrder {
    StaticOrder base; int G, c;
    __device__ void init(int G_, int c_) { base.init(SEQ, INWP, G_, c_); G = G_; c = c_; }
    __device__ bool next(int i, Unit& u) const {
        const long L = (long)i * G + c;
        if (L < base.nwg) {
            base.next(i, u);
            if (u.pn >= CT_V && u.pn < CT_U) { const int e = (u.pn - CT_V) * 32 + u.pm; u.pm = HT + CT_V + e / HT; u.pn = e % HT; }
            else u.pn += HT;
            return true;
        }
        const int x = (int)(L - base.nwg);
        if (x >= 31) return false;
        if (x < 2) { const int e = 64 + x; u.pm = HT + CT_V + e / HT; u.pn = e % HT; }
        else { const int y = x - 2; u.pm = 32; u.pn = HT + (y < 2 ? CT_K + y : CT_U + (y - 2)); }
        return true;
    }
    __device__ __forceinline__ void a_ready(const Unit&) const {}
    __device__ __forceinline__ void done(const Unit&) const {}
};

struct EpiIn {
    static constexpr bool PERM = true, AFTER_DRAIN = false;
    bf16_t *G, *Q, *K, *Vt, *U; const float* bgate; const float* rope;
    __device__ __forceinline__ static void st8(bf16_t* p, const f32x4& v0, const f32x4& v1) {
        u32x4 w; w.x = cvt_pk_bf16(v0[0], v0[1]); w.y = cvt_pk_bf16(v0[2], v0[3]); w.z = cvt_pk_bf16(v1[0], v1[1]); w.w = cvt_pk_bf16(v1[2], v1[3]); *(u32x4*)p = w; }
    __device__ __forceinline__ void plain(const f32x4 (&acc)[2][2][4][2], bf16_t* base, int ldc, int row0, int col0) const {
#pragma unroll
        for (int ai = 0; ai < 2; ++ai)
#pragma unroll
            for (int m = 0; m < 4; ++m) { bf16_t* rowp = base + (size_t)(row0 + ai * HALF + m * 16) * ldc + col0;
#pragma unroll
                for (int bj = 0; bj < 2; ++bj) st8(rowp + bj * HALF, acc[ai][bj][m][0], acc[ai][bj][m][1]); }
    }
    __device__ __forceinline__ void roped(const f32x4 (&acc)[2][2][4][2], bf16_t* base, int ldc, int row0, int col0, int wc, int fq) const {
        if (wc != 0) { plain(acc, base, ldc, row0, col0); return; }
        const float sgn = (fq < 2) ? -1.0f : 1.0f;
#pragma unroll
        for (int ai = 0; ai < 2; ++ai)
#pragma unroll
            for (int m = 0; m < 4; ++m) { const int row = row0 + ai * HALF + m * 16; const int pos = row < SEQ ? row + NMETA : row - SEQ;
                const f32x4* cs = (const f32x4*)(rope + (size_t)pos * 32 + 16 * (fq & 1));
                const f32x4 c0 = cs[0], c1 = cs[1], c2 = cs[2], c3 = cs[3];
                const float cw[8] = {c0[0], c0[2], c1[0], c1[2], c2[0], c2[2], c3[0], c3[2]}, sw[8] = {c0[1], c0[3], c1[1], c1[3], c2[1], c2[3], c3[1], c3[3]};
                bf16_t* rowp = base + (size_t)row * ldc + col0;
#pragma unroll
                for (int bj = 0; bj < 2; ++bj) { f32x4 v0 = acc[ai][bj][m][0], v1 = acc[ai][bj][m][1], o0, o1;
#pragma unroll
                    for (int e = 0; e < 4; ++e) { const float p0 = __shfl_xor(v0[e], 32), p1 = __shfl_xor(v1[e], 32);
                        o0[e] = v0[e] * cw[e] + sgn * p0 * sw[e]; o1[e] = v1[e] * cw[4 + e] + sgn * p1 * sw[4 + e]; }
                    st8(rowp + bj * HALF, o0, o1); } }
    }
    __device__ __forceinline__ void operator()(const f32x4 (&acc)[2][2][4][2], const Unit& u, int wr, int wc, int fr, int fq) const {
        if (u.pm >= HT) {
            plain(acc, Vt, MPAD, (u.pm - HT - CT_V) * BM + wr * 64 + fr, u.pn * BM + wc * 32 + 8 * fq); return; }
        const int ct = u.pn - HT, row0 = u.pm * BM + wr * 64 + fr, cl = wc * 32 + 8 * fq;
        if (ct < CT_Q) {
            const int col0 = ct * BM + cl;
#pragma unroll
            for (int bj = 0; bj < 2; ++bj) { const f32x4 b0 = *(const f32x4*)(bgate + col0 + bj * HALF), b1 = *(const f32x4*)(bgate + col0 + bj * HALF + 4);
#pragma unroll
                for (int ai = 0; ai < 2; ++ai)
#pragma unroll
                    for (int m = 0; m < 4; ++m) { f32x4 v0 = acc[ai][bj][m][0] + b0, v1 = acc[ai][bj][m][1] + b1;
#pragma unroll
                        for (int e = 0; e < 4; ++e) { v0[e] = sigmoidf_(v0[e]); v1[e] = sigmoidf_(v1[e]); }
                        st8(G + (size_t)(row0 + ai * HALF + m * 16) * (2 * DM) + col0 + bj * HALF, v0, v1); } }
        } else if (ct < CT_K) { roped(acc, Q, ATTW, row0, (ct - CT_Q) * BM + cl, wc, fq);
        } else if (ct < CT_V) { roped(acc, K, KVW, row0, (ct - CT_K) * BM + cl, wc, fq);
        } else { plain(acc, U, UPITCH, row0, (ct - CT_U) * BM + cl); }
    }
};

struct EpiProjA {
    static constexpr bool PERM = true, AFTER_DRAIN = false;
    bf16_t* P1; const bf16_t* G;
    __device__ __forceinline__ void operator()(const f32x4 (&acc)[2][2][4][2], const Unit& u, int wr, int wc, int fr, int fq) const {
        const int row0 = u.pm * BM + wr * 64 + fr, col0 = u.pn * BM + wc * 32 + 8 * fq;
#pragma unroll
        for (int ai = 0; ai < 2; ++ai)
#pragma unroll
            for (int m = 0; m < 4; ++m) { const size_t r = (size_t)(row0 + ai * HALF + m * 16);
#pragma unroll
                for (int bj = 0; bj < 2; ++bj) { const int c = col0 + bj * HALF; const u32x4 g = *(const u32x4*)(G + r * (2 * DM) + c);
                    f32x4 o0 = acc[ai][bj][m][0], o1 = acc[ai][bj][m][1];
                    o0[0] *= bflo(g.x); o0[1] *= bfhi(g.x); o0[2] *= bflo(g.y); o0[3] *= bfhi(g.y); o1[0] *= bflo(g.z); o1[1] *= bfhi(g.z); o1[2] *= bflo(g.w); o1[3] *= bfhi(g.w);
                    EpiIn::st8(P1 + r * DM + c, o0, o1); } }
    }
};
struct EpiProjB {
    static constexpr bool PERM = true, AFTER_DRAIN = false;
    const bf16_t* P1; const bf16_t* G; bf16_t* MX;
    __device__ __forceinline__ void operator()(const f32x4 (&acc)[2][2][4][2], const Unit& u, int wr, int wc, int fr, int fq) const {
        const int row0 = u.pm * BM + wr * 64 + fr, col0 = u.pn * BM + wc * 32 + 8 * fq;
#pragma unroll
        for (int ai = 0; ai < 2; ++ai)
#pragma unroll
            for (int m = 0; m < 4; ++m) { const size_t r = (size_t)(row0 + ai * HALF + m * 16);
#pragma unroll
                for (int bj = 0; bj < 2; ++bj) { const int c = col0 + bj * HALF; const u32x4 g = *(const u32x4*)(G + r * (2 * DM) + DM + c); const u32x4 q = *(const u32x4*)(P1 + r * DM + c);
                    f32x4 o0 = {bflo(q.x), bfhi(q.x), bflo(q.y), bfhi(q.y)}, o1 = {bflo(q.z), bfhi(q.z), bflo(q.w), bfhi(q.w)}; const f32x4 a0 = acc[ai][bj][m][0], a1 = acc[ai][bj][m][1];
                    o0[0] += a0[0] * bflo(g.x); o0[1] += a0[1] * bfhi(g.x); o0[2] += a0[2] * bflo(g.y); o0[3] += a0[3] * bfhi(g.y);
                    o1[0] += a1[0] * bflo(g.z); o1[1] += a1[1] * bfhi(g.z); o1[2] += a1[2] * bflo(g.w); o1[3] += a1[3] * bfhi(g.w);
                    EpiIn::st8(MX + r * DM + c, o0, o1); }
                asm volatile("" ::: "memory"); }
    }
};
template <bool BASE_BF16> struct EpiResid {
    static constexpr bool PERM = true, AFTER_DRAIN = false;
    const float* BASEF; const bf16_t* BASEB; float* OUTF; bf16_t* OUTB; float* SS;
    __device__ __forceinline__ void operator()(const f32x4 (&acc)[2][2][4][2], const Unit& u, int wr, int wc, int fr, int fq) const {
        const int row0 = u.pm * BM + wr * 64 + fr, col0 = u.pn * BM + wc * 32 + 8 * fq;
#pragma unroll
        for (int ai = 0; ai < 2; ++ai)
#pragma unroll
            for (int m = 0; m < 4; ++m) { const size_t r = (size_t)(row0 + ai * HALF + m * 16); float ss = 0.f;
#pragma unroll
                for (int bj = 0; bj < 2; ++bj) { const int c = col0 + bj * HALF; f32x4 o0, o1;
                    if (BASE_BF16) { const u32x4 g = *(const u32x4*)(BASEB + r * DM + c); o0 = (f32x4){bflo(g.x), bfhi(g.x), bflo(g.y), bfhi(g.y)}; o1 = (f32x4){bflo(g.z), bfhi(g.z), bflo(g.w), bfhi(g.w)}; }
                    else { const float* bp = BASEF + r * DM + c; o0 = *(const f32x4*)bp; o1 = *(const f32x4*)(bp + 4); }
                    o0 += acc[ai][bj][m][0]; o1 += acc[ai][bj][m][1];
                    if (BASE_BF16) { float* op = OUTF + r * DM + c; *(f32x4*)op = o0; *(f32x4*)(op + 4) = o1; }
                    else { u32x4 w; w.x = cvt_pk_bf16(o0[0], o0[1]); w.y = cvt_pk_bf16(o0[2], o0[3]); w.z = cvt_pk_bf16(o1[0], o1[1]); w.w = cvt_pk_bf16(o1[2], o1[3]); *(u32x4*)(OUTB + r * DM + c) = w;
                        o0 = (f32x4){bflo(w.x), bfhi(w.x), bflo(w.y), bfhi(w.y)}; o1 = (f32x4){bflo(w.z), bfhi(w.z), bflo(w.w), bfhi(w.w)}; }
                    ss += (o0[0] * o0[0] + o0[1] * o0[1]) + (o0[2] * o0[2] + o0[3] * o0[3]) + (o1[0] * o1[0] + o1[1] * o1[1]) + (o1[2] * o1[2] + o1[3] * o1[3]); }
                ss += __shfl_xor(ss, 16); ss += __shfl_xor(ss, 32);
                if (fq == 0) atomicAdd(SS + r, ss);
                asm volatile("" ::: "memory"); }
    }
};
struct EpiSwiGLU {
    static constexpr bool PERM = true, AFTER_DRAIN = false;
    bf16_t* HID; const float* SS;
    __device__ __forceinline__ void operator()(const f32x4 (&acc)[2][2][4][2], const Unit& u, int wr, int wc, int fr, int fq) const {
        const int row0 = u.pm * BM + wr * 64 + fr, col0 = u.pn * HALF + wc * 32 + 8 * fq;
#pragma unroll
        for (int ai = 0; ai < 2; ++ai)
#pragma unroll
            for (int m = 0; m < 4; ++m) { const size_t r = (size_t)(row0 + ai * HALF + m * 16);
                const float rstd = __builtin_amdgcn_rsqf(SS[r] * (1.0f / DM) + RMS_EPS);
                f32x4 o0, o1;
#pragma unroll
                for (int e = 0; e < 4; ++e) { const float g0 = acc[ai][0][m][0][e] * rstd, u0 = acc[ai][1][m][0][e] * rstd, g1 = acc[ai][0][m][1][e] * rstd, u1 = acc[ai][1][m][1][e] * rstd;
                    o0[e] = g0 * sigmoidf_(g0) * u0; o1[e] = g1 * sigmoidf_(g1) * u1; }
                EpiIn::st8(HID + r * DFF + col0, o0, o1); }
    }
};

#define PG8_EPI_T0 unsigned long long epi_t0_ = 0; do { if ((PROBE_PHASE >> 20) & 1) epi_t0_ = __builtin_amdgcn_s_memrealtime(); } while (0)
#define PG8_EPI_T1 do { if ((PROBE_PHASE >> 20) & 1) epi_acc += __builtin_amdgcn_s_memrealtime() - epi_t0_; } while (0)
template <class Epi, class Sched, bool ALIGN_EPI = false, bool SP2 = false>
__device__ __forceinline__ void gemm_phase(PG8_LAS unsigned char* lds, const Gemm g, const Sched& S, const Epi& E, unsigned long long& epi_acc) {
    const int tid = threadIdx.x, wid = __builtin_amdgcn_readfirstlane(tid >> 6), lane = tid & 63, wr = wid >> 2, wc = wid & 3, fr = lane & 15, fq = lane >> 4;
    const int K = g.K, nt = K / BK;
    unsigned voffA[2], voffB[2];
#pragma unroll
    for (int i = 0; i < 2; ++i) { int R, C; stage_rc(tid * 16 + i * 8192, R, C); const int Rb = Epi::PERM ? ((R & ~31) + perm32(R & 31)) : R;
        voffA[i] = (unsigned)(R * K + C) * 2u; voffB[i] = (unsigned)(Rb * K + C) * 2u; }
    const size_t kstep = (size_t)(BK * 2);
    const size_t hstep = (size_t)HALF * K * 2;
    const size_t tstep = 2 * hstep;
    const unsigned ldsw = (unsigned)wid * 1024u;
    const int aoff = lds_byte(wr * 64 + fr, fq * 8), boff = lds_byte(wc * 32 + fr, fq * 8);
#define PG8_SA(b, h) (((b) * 2 + (h)) * HTB)
#define PG8_SB(b, h) ((4 + (b) * 2 + (h)) * HTB)
#define PG8_STAGE(bufoff, gbase, voff) do { _Pragma("unroll") for (int _i = 0; _i < 2; ++_i) \
        __builtin_amdgcn_global_load_lds((const unsigned*)((const char*)(gbase) + (voff)[_i]), (PG8_LAS unsigned*)(lds + (bufoff) + ldsw + _i * 8192), 16, 0, 0); } while (0)
#define PG8_LDA(dst, b, h) do { _Pragma("unroll") for (int m = 0; m < 4; ++m) _Pragma("unroll") for (int k = 0; k < 2; ++k) dst[m][k] = *(const PG8_LAS bf16x8*)(lds + PG8_SA(b, h) + aoff + m * 2048 + k * 1024); } while (0)
#define PG8_LDB(dst, b, h) do { _Pragma("unroll") for (int n = 0; n < 2; ++n) _Pragma("unroll") for (int k = 0; k < 2; ++k) dst[n][k] = *(const PG8_LAS bf16x8*)(lds + PG8_SB(b, h) + boff + n * 2048 + k * 1024); } while (0)
#define PG8_MMA(ai, bj, At, Bt) do { __builtin_amdgcn_s_setprio(1); _Pragma("unroll") for (int m = 0; m < 4; ++m) _Pragma("unroll") for (int n = 0; n < 2; ++n) _Pragma("unroll") for (int k = 0; k < 2; ++k) \
        acc[ai][bj][m][n] = __builtin_amdgcn_mfma_f32_16x16x32_bf16(Bt[n][k], At[m][k], acc[ai][bj][m][n], 0, 0, 0); __builtin_amdgcn_s_setprio(0); } while (0)
#define PG8_WAIT_V(n) asm volatile("s_waitcnt vmcnt(" #n ")" ::: "memory")
#define PG8_WAIT_L(n) asm volatile("s_waitcnt lgkmcnt(" #n ")" ::: "memory")
#define PG8_BAR __builtin_amdgcn_s_barrier()
#define PG8_SCHED __builtin_amdgcn_sched_barrier(0)
    Unit cur, nxt; int ui = 0;
    if (!S.next(0, cur)) return;
    f32x4 acc[2][2][4][2];
#pragma unroll
    for (int a = 0; a < 2; ++a)
#pragma unroll
        for (int b = 0; b < 2; ++b)
#pragma unroll
            for (int m = 0; m < 4; ++m)
#pragma unroll
                for (int n = 0; n < 2; ++n) acc[a][b][m][n] = (f32x4){0.f, 0.f, 0.f, 0.f};
    bf16x8 At[4][2], B0[2][2], B1[2][2];
    const char* cA = (const char*)g.A + (size_t)cur.pm * tstep; const char* cB = (const char*)g.Bt + (size_t)cur.pn * tstep;
    S.a_ready(cur);
    if constexpr (SP2) {
        PG8_STAGE(PG8_SB(0, 0), cB, voffB); PG8_STAGE(PG8_SB(0, 1), cB + hstep, voffB); PG8_STAGE(PG8_SA(0, 0), cA, voffA); PG8_STAGE(PG8_SA(0, 1), cA + hstep, voffA);
        if (wr == 1) PG8_BAR;
        PG8_WAIT_V(2); PG8_BAR;
        PG8_STAGE(PG8_SB(1, 0), cB + kstep, voffB); PG8_STAGE(PG8_SA(1, 0), cA + kstep, voffA); PG8_STAGE(PG8_SB(1, 1), cB + hstep + kstep, voffB);
        PG8_WAIT_V(6); PG8_BAR;
    } else {
        PG8_STAGE(PG8_SB(0, 0), cB, voffB); PG8_STAGE(PG8_SA(0, 0), cA, voffA); PG8_STAGE(PG8_SB(0, 1), cB + hstep, voffB); PG8_STAGE(PG8_SA(0, 1), cA + hstep, voffA);
        if (wr == 1) PG8_BAR;
        PG8_WAIT_V(4); PG8_BAR;
        PG8_STAGE(PG8_SB(1, 0), cB + kstep, voffB); PG8_STAGE(PG8_SA(1, 0), cA + kstep, voffA); PG8_STAGE(PG8_SB(1, 1), cB + hstep + kstep, voffB);
        PG8_WAIT_V(6); PG8_BAR;
    }
    for (;;) {
        const bool has_next = S.next(ui + 1, nxt);
        const char* nA = has_next ? (const char*)g.A + (size_t)nxt.pm * tstep : cA; const char* nB = has_next ? (const char*)g.Bt + (size_t)nxt.pn * tstep : cB;
        for (int t = 0; t < nt; t += 2) {
            const bool last = (t == nt - 2);
            const char* a1 = cA + (size_t)(t + 1) * kstep;
            const char* a2 = last ? nA : cA + (size_t)(t + 2) * kstep; const char* b2 = last ? nB : cB + (size_t)(t + 2) * kstep;
            const char* a3 = a2 + kstep; const char* b3 = b2 + kstep;
            if (last && has_next) S.a_ready(nxt);
            if constexpr (SP2) {
            PG8_LDB(B0, 0, 0); PG8_LDB(B1, 0, 1); PG8_SCHED; PG8_LDA(At, 0, 0); PG8_STAGE(PG8_SA(1, 1), a1 + hstep, voffA);
            PG8_WAIT_V(8); PG8_WAIT_L(0); PG8_BAR; PG8_MMA(0, 0, At, B0); PG8_MMA(0, 1, At, B1); PG8_BAR; PG8_SCHED;
            PG8_LDA(At, 0, 1); PG8_STAGE(PG8_SB(0, 0), b2, voffB); PG8_STAGE(PG8_SB(0, 1), b2 + hstep, voffB); PG8_STAGE(PG8_SA(0, 0), a2, voffA);
            PG8_WAIT_V(8); PG8_WAIT_L(0); PG8_BAR; PG8_MMA(1, 0, At, B0); PG8_MMA(1, 1, At, B1); PG8_BAR; PG8_SCHED;
            PG8_LDB(B0, 1, 0); PG8_LDB(B1, 1, 1); PG8_SCHED; PG8_LDA(At, 1, 0); PG8_STAGE(PG8_SA(0, 1), a2 + hstep, voffA);
            PG8_WAIT_V(8); PG8_WAIT_L(0); PG8_BAR; PG8_MMA(0, 0, At, B0); PG8_MMA(0, 1, At, B1); PG8_BAR; PG8_SCHED;
            PG8_LDA(At, 1, 1); PG8_STAGE(PG8_SB(1, 0), b3, voffB); PG8_STAGE(PG8_SB(1, 1), b3 + hstep, voffB); PG8_STAGE(PG8_SA(1, 0), a3, voffA);
            PG8_WAIT_V(8); PG8_WAIT_L(0); PG8_BAR; PG8_MMA(1, 0, At, B0); PG8_MMA(1, 1, At, B1); PG8_BAR; PG8_SCHED;
            } else {
            PG8_LDB(B0, 0, 0); PG8_SCHED; PG8_LDA(At, 0, 0); PG8_STAGE(PG8_SA(1, 1), a1 + hstep, voffA);
            PG8_WAIT_L(8); PG8_BAR; PG8_WAIT_L(0); PG8_MMA(0, 0, At, B0); PG8_BAR; PG8_SCHED;
            PG8_LDB(B1, 0, 1); PG8_STAGE(PG8_SB(0, 0), b2, voffB);
            PG8_BAR; PG8_WAIT_L(0); PG8_MMA(0, 1, At, B1); PG8_BAR;
            PG8_LDA(At, 0, 1); PG8_STAGE(PG8_SA(0, 0), a2, voffA);
            PG8_BAR; PG8_WAIT_L(0); PG8_MMA(1, 0, At, B0); PG8_BAR; PG8_SCHED;
            PG8_STAGE(PG8_SB(0, 1), b2 + hstep, voffB);
            PG8_WAIT_V(6); PG8_BAR; PG8_MMA(1, 1, At, B1); PG8_BAR;
            PG8_LDB(B0, 1, 0); PG8_SCHED; PG8_LDA(At, 1, 0); PG8_STAGE(PG8_SA(0, 1), a2 + hstep, voffA);
            PG8_WAIT_L(8); PG8_BAR; PG8_WAIT_L(0); PG8_MMA(0, 0, At, B0); PG8_BAR; PG8_SCHED;
            PG8_LDB(B1, 1, 1); PG8_STAGE(PG8_SB(1, 0), b3, voffB);
            PG8_BAR; PG8_WAIT_L(0); PG8_MMA(0, 1, At, B1); PG8_BAR;
            PG8_LDA(At, 1, 1); PG8_STAGE(PG8_SA(1, 0), a3, voffA);
            PG8_BAR; PG8_WAIT_L(0); PG8_MMA(1, 0, At, B0); PG8_BAR; PG8_SCHED;
            PG8_STAGE(PG8_SB(1, 1), b3 + hstep, voffB);
            PG8_WAIT_V(6); PG8_BAR; PG8_MMA(1, 1, At, B1); PG8_BAR;
            }
        }
        if constexpr (ALIGN_EPI) { if (wr == 0) PG8_BAR; }
        if constexpr (!Epi::AFTER_DRAIN) { PG8_EPI_T0; E(acc, cur, wr, wc, fr, fq); S.done(cur); PG8_EPI_T1; }
        if (!has_next) break;
#pragma unroll
        for (int a = 0; a < 2; ++a)
#pragma unroll
            for (int b = 0; b < 2; ++b)
#pragma unroll
                for (int m = 0; m < 4; ++m)
#pragma unroll
                    for (int n = 0; n < 2; ++n) acc[a][b][m][n] = (f32x4){0.f, 0.f, 0.f, 0.f};
        cur = nxt; cA = nA; cB = nB; ++ui;
        if constexpr (ALIGN_EPI) { if (wr == 1) PG8_BAR; }
    }
    PG8_WAIT_V(0);
    if constexpr (!ALIGN_EPI) { if (wr == 0) PG8_BAR; }
    PG8_BAR;
    if constexpr (Epi::AFTER_DRAIN) { E.fused(acc, cur, wr, wc, fr, fq, lds, wid, lane); S.done(cur); }
#undef PG8_SA
#undef PG8_SB
#undef PG8_STAGE
#undef PG8_LDA
#undef PG8_LDB
#undef PG8_MMA
#undef PG8_WAIT_V
#undef PG8_WAIT_L
#undef PG8_BAR
#undef PG8_SCHED
}

}

constexpr size_t MiB = 1u << 20;
constexpr size_t WS_CTL = 0;
constexpr size_t WS_ROPE = 1 * MiB;
constexpr size_t WS_LW2 = 3 * MiB, WS_LA2 = 4 * MiB, WS_LG2 = 5 * MiB;
constexpr size_t WS_BONUS = 6 * MiB;
constexpr size_t ZERO_BYTES = 8 * MiB;
constexpr size_t SCF = (size_t)LTOK * RC * 4, SCB = (size_t)LTOK * RC * 2;
constexpr size_t WS_H = 8 * MiB, WS_WIN = WS_H + (size_t)MPAD * DM * 2;
constexpr size_t WS_KD0 = 8 * MiB, WS_KD1 = WS_KD0 + SCB, WS_B0 = WS_KD1 + SCB, WS_B1 = WS_B0 + SCB, WS_KK = WS_B1 + SCB, WS_RR = WS_KK + SCB;
constexpr size_t WS_WGU = 8 * MiB;
constexpr size_t WS_G = 216 * MiB, WS_A2 = 216 * MiB;
constexpr size_t WS_Q = 344 * MiB, WS_K = 376 * MiB, WS_VT = 385 * MiB, WS_U = 394 * MiB;
constexpr size_t WS_P1 = 344 * MiB;
constexpr size_t WS_Y = 394 * MiB;
constexpr size_t WS_W0 = 506 * MiB, WS_W1 = WS_W0 + SCF;
constexpr size_t WS_WPA = 506 * MiB, WS_WPR = 522 * MiB, WS_WOUT = 538 * MiB, WS_OATT = 570 * MiB;
constexpr size_t WS_VV = 635 * MiB, WS_GG = 668 * MiB;
constexpr size_t WS_BO = 701 * MiB;
constexpr size_t WS_HID = 701 * MiB, WS_MX = 873 * MiB;
constexpr int NB0 = 513, NB1 = 512, NBT = NB0 + NB1;
constexpr int BO_FA = 0, BO_FH = 4096, BO_FB = 5120, BO_FG = 9216, BO_ITEM = 9472;
constexpr size_t WS_WD = 998 * MiB, WS_ORWKV = 1084 * MiB, WS_END = 1116 * MiB;
static_assert(WS_WIN + (size_t)INWP * DM * 2 <= WS_G && WS_RR + SCB <= WS_G && WS_WGU + (size_t)2 * DFF * DM * 2 <= WS_G, "map: A0");
static_assert(WS_U + (size_t)MPAD * UPITCH * 2 <= WS_W0 && WS_VT + (size_t)KVW * MPAD * 2 <= WS_U && WS_K + (size_t)MPAD * KVW * 2 <= WS_VT && WS_Q + (size_t)SEQ * ATTW * 2 <= WS_K && WS_Y + 2 * SCB <= WS_W0, "map: P1 outputs");
static_assert(WS_W1 + SCF <= WS_VV && WS_OATT + (size_t)SEQ * ATTW * 2 <= WS_VV && WS_VV + SCB <= WS_GG && WS_GG + SCB <= WS_BO && WS_P1 + (size_t)SEQ * DM * 2 <= WS_W0, "map: mid");
static_assert(WS_BO + (size_t)RH * NBT * BO_ITEM <= WS_WD && WS_HID + (size_t)SEQ * DFF * 2 <= WS_MX && WS_MX + (size_t)SEQ * DM * 2 <= WS_WD && WS_WD + (size_t)DM * DFF * 2 <= WS_ORWKV && WS_ORWKV + (size_t)SEQ * RC * 2 <= WS_END, "map: tail");
constexpr int CW_BAR = 4096;
constexpr int CW_SS2 = 65536, CW_SS3 = 65536 + 8192;
static_assert((CW_SS3 + 8192) * 4 <= (int)(1 * MiB), "CTL");

constexpr int RING_BYTES = 131072;
constexpr int LDSCTL_OFF = RING_BYTES, MISC_OFF = LDSCTL_OFF + 320;
constexpr int LDS_BYTES = 147456;

#define GAS __attribute__((address_space(1)))
#define LAS __attribute__((address_space(3)))
typedef unsigned short bf16;
typedef unsigned v4u __attribute__((ext_vector_type(4)));
typedef unsigned v2u __attribute__((ext_vector_type(2)));
typedef float f32x4 __attribute__((ext_vector_type(4)));
typedef float f32x2 __attribute__((ext_vector_type(2)));
typedef float f32x16 __attribute__((ext_vector_type(16)));
typedef short bf16x8 __attribute__((ext_vector_type(8)));
typedef GAS unsigned gu32;
#define RLX_AGENT __ATOMIC_RELAXED, __HIP_MEMORY_SCOPE_AGENT
#define LDS_WAIT() asm volatile("s_waitcnt lgkmcnt(0)" ::: "memory")
__device__ __forceinline__ unsigned pk2(float lo, float hi) { return pg8::cvt_pk_bf16(lo, hi); }
__device__ __forceinline__ unsigned f2bf(float f) { return pg8::cvt_pk_bf16(f, 0.f) & 0xffffu; }
__device__ __forceinline__ float bf2f(bf16 b) { return __uint_as_float(((unsigned)b) << 16); }
using pg8::bflo; using pg8::bfhi; using pg8::sigmoidf_;

#define XB_TMO      128
#define XB_XCNT(j)  (256  + 64 * (j))
#define XB_XSUB(j)  (1280 + 64 * (j))
#define XB_XGEN(j)  (2304 + 64 * (j))
#define XB_TOP      3328
#define XB_TOPGEN   3392
#define XCD_BAR_WORDS 3456
#define XB_SPIN_CAP (1u << 18)

__device__ __forceinline__ unsigned xb_ld(unsigned* p)              { return __hip_atomic_load(p, __ATOMIC_RELAXED, __HIP_MEMORY_SCOPE_AGENT); }
__device__ __forceinline__ unsigned xb_add(unsigned* p, unsigned v) { return __hip_atomic_fetch_add(p, v, __ATOMIC_RELAXED, __HIP_MEMORY_SCOPE_AGENT); }
__device__ __forceinline__ unsigned xb_xcc_id() { return (unsigned)__builtin_amdgcn_s_getreg((3 << 11) | 20) & 0xFu; }
#define XB_SPIN(cond, bar) do { unsigned _sp = 0; while (cond) { __builtin_amdgcn_s_sleep(1); \
    if ((++_sp & 255u) == 0u) { if (xb_ld(&(bar)[XB_TMO])) break; if (_sp > XB_SPIN_CAP) { atomicAdd(&(bar)[XB_TMO], 1u); break; } } } } while (0)

struct XcdBarrier {
    unsigned* bar; unsigned x;
    volatile LAS unsigned* st;
};

__device__ __forceinline__ XcdBarrier xcd_barrier_post(unsigned* bar, volatile LAS unsigned* st) {
    XcdBarrier b; b.bar = bar; b.x = xb_xcc_id(); b.st = st;
    if (threadIdx.x == 0) (void)xb_add(&bar[XB_XCNT(b.x)], 1u);
    return b;
}
__device__ __forceinline__ void xcd_barrier_complete(unsigned* bar, unsigned x, unsigned& nloc, unsigned& nx) {
    const unsigned G = gridDim.x * gridDim.y * gridDim.z;
    unsigned sum, cnt, mine, sp = 0u;
    for (;;) {
        sum = 0u; cnt = 0u; mine = 0u;
#pragma unroll
        for (unsigned j = 0; j < 16; ++j) { const unsigned c = xb_ld(&bar[XB_XCNT(j)]); sum += c; cnt += (c > 0u) ? 1u : 0u; mine = (j == x) ? c : mine; }
        if (sum == G) break;
        __builtin_amdgcn_s_sleep(1);
        if ((++sp & 255u) == 0u) { if (xb_ld(&bar[XB_TMO])) break; if (sp > XB_SPIN_CAP) { atomicAdd(&bar[XB_TMO], 1u); break; } }
    }
    nloc = mine > 0u ? mine : 1u; nx = cnt > 0u ? cnt : 1u;
}

__device__ __forceinline__ void xcd_barrier(const XcdBarrier& b) {
    asm volatile("s_waitcnt vmcnt(0)" ::: "memory");
    __syncthreads();
    if (threadIdx.x == 0) {
        unsigned* bar = b.bar;
        __builtin_amdgcn_s_waitcnt(0);
        unsigned nloc = b.st[0], nx = b.st[1];
        if (nloc == 0u) { xcd_barrier_complete(bar, b.x, nloc, nx); b.st[0] = nloc; b.st[1] = nx; }
        const unsigned old = xb_add(&bar[XB_XSUB(b.x)], 1u);
        const unsigned gen = old / nloc;
        if (old + 1u == (gen + 1u) * nloc) {
            __builtin_amdgcn_fence(__ATOMIC_RELEASE, "agent");
            asm volatile("s_waitcnt vmcnt(0)" ::: "memory");
            const unsigned og = xb_add(&bar[XB_TOP], 1u);
            const unsigned tg = og / nx;
            if (og + 1u == (tg + 1u) * nx) xb_add(&bar[XB_TOPGEN], 1u);
            else XB_SPIN(xb_ld(&bar[XB_TOPGEN]) == tg, bar);
            __builtin_amdgcn_fence(__ATOMIC_ACQUIRE, "agent");
            xb_add(&bar[XB_XGEN(b.x)], 1u);
            asm volatile("s_waitcnt vmcnt(0)" ::: "memory");
        } else {
            XB_SPIN(xb_ld(&bar[XB_XGEN(b.x)]) == gen, bar);
            __builtin_amdgcn_fence(__ATOMIC_ACQUIRE, "agent");
            asm volatile("s_waitcnt vmcnt(0)" ::: "memory");
        }
    }
    __syncthreads();
}


struct Frame {
    LAS unsigned char* lds;
    volatile LAS unsigned* MISC;
    gu32* ctl;
    int tid, lane, wave, G;
    unsigned char* ws;
    const float* in[26];
    float* out;
    unsigned long long pb0, pacc, pacc2;
};
#define FPB0(k) do { if ((PROBE_PHASE >> (k)) & 1) F.pb0 = __builtin_amdgcn_s_memrealtime(); } while (0)
#define FPB1(k) do { if ((PROBE_PHASE >> (k)) & 1) F.pacc += __builtin_amdgcn_s_memrealtime() - F.pb0; } while (0)
__device__ __forceinline__ float wave_sum(float v) {
#pragma unroll
    for (int o = 1; o < 64; o <<= 1) v += __shfl_xor(v, o);
    return v;
}

template <int MODE> __device__ __forceinline__ void transpose_item(const float* W, int K, int N, bf16* WT, LAS float* scr, int item, int lane, const float* kscale) {
    const int nblk = N / 32, kb = item / nblk, nb = item % nblk, k0 = 64 * kb, n0 = 32 * nb;
    float wv[32];
#pragma unroll
    for (int i = 0; i < 32; ++i) wv[i] = W[(size_t)(k0 + 2 * i + (lane >> 5)) * N + n0 + (lane & 31)];
#pragma unroll
    for (int i = 0; i < 32; ++i) { const int kk = 2 * i + (lane >> 5); float v = wv[i]; if (kscale) v *= kscale[k0 + kk]; scr[kk * 33 + (lane & 31)] = v; }
    LDS_WAIT(); asm volatile("" ::: "memory");
    const int c = lane & 7;
#pragma unroll
    for (int j = 0; j < 4; ++j) { const int n = (lane >> 3) + 8 * j; const LAS float* s = scr + (8 * c) * 33 + n;
        v4u o; o.x = pk2(s[0 * 33], s[1 * 33]); o.y = pk2(s[2 * 33], s[3 * 33]); o.z = pk2(s[4 * 33], s[5 * 33]); o.w = pk2(s[6 * 33], s[7 * 33]);
        const int nn = n0 + n; const int dr = (MODE == 0) ? nn : (256 * (nn >> 7) + (nn & 127) + (MODE == 2 ? 128 : 0));
        *(GAS v4u*)(WT + (size_t)dr * K + k0 + 8 * c) = o; }
    LDS_WAIT(); asm volatile("" ::: "memory");
}
__device__ __forceinline__ void rms_row_to_bf16(int lane, const float* xrow, const float* w, bf16* orow) {
    const GAS f32x4* xr = (const GAS f32x4*)xrow + lane;
    f32x4 v[16]; float s = 0.f;
#pragma unroll
    for (int j = 0; j < 16; ++j) { v[j] = xr[64 * j]; s += (v[j].x * v[j].x + v[j].y * v[j].y) + (v[j].z * v[j].z + v[j].w * v[j].w); }
    const float rstd = 1.f / sqrtf(wave_sum(s) * (1.f / DM) + RMS_EPS);
    const GAS f32x4* wr = (const GAS f32x4*)w + lane;
    GAS v2u* o8 = (GAS v2u*)orow + lane;
#pragma unroll
    for (int j = 0; j < 16; ++j) { const f32x4 ww = wr[64 * j]; v2u o; o.x = pk2(v[j].x * rstd * ww.x, v[j].y * rstd * ww.y); o.y = pk2(v[j].z * rstd * ww.z, v[j].w * rstd * ww.w); o8[64 * j] = o; }
}
__device__ const double ROPE_INV[16] = {
    1.0000000000000000000000000e+0,
    4.4036660267178047359198331e-1,
    1.9392274474868577334259386e-1,
    8.5397100285765611280149662e-2,
    3.7606030930863935681246092e-2,
    1.6560440080994445548947445e-2,
    7.2926647372171090477661219e-3,
    3.2114459947525910185434889e-3,
    1.4142135623730950488016887e-3,
    6.2277242191459597955502746e-4,
    2.7424817567620731825332265e-4,
    1.2076973741146503832424826e-4,
    5.3182958969449886162502429e-5,
    2.3419998961409341542188076e-5,
    1.0313385377212458859810127e-5,
    4.5416704806078696531998012e-6
};

__device__ __forceinline__ void p0_prologue(Frame& F) {
    LAS float* scr = (LAS float*)(F.lds + F.wave * 16384);
    const int gw = blockIdx.x * 8 + F.wave, NGW = F.G * 8;
    bf16* Wint = (bf16*)(F.ws + WS_WIN); bf16* H = (bf16*)(F.ws + WS_H);
    constexpr int I_IN = (DM / 64) * (INW / 32);
    for (int it = gw; it < I_IN; it += NGW) transpose_item<0>(F.in[3], DM, INW, Wint, scr, it, F.lane, nullptr);
    for (int m = gw; m < MPAD + (INWP - INW); m += NGW) {
        if (m < SEQ) rms_row_to_bf16(F.lane, F.in[0] + (size_t)m * DM, F.in[2], H + (size_t)m * DM);
        else if (m < LTOK) rms_row_to_bf16(F.lane, F.in[1] + (size_t)(m - SEQ) * DM, F.in[2], H + (size_t)m * DM);
        else { bf16* row = (m < MPAD) ? H + (size_t)m * DM : Wint + (size_t)(INW + (m - MPAD)) * DM; GAS v4u* o = (GAS v4u*)row + F.lane;
#pragma unroll
            for (int j = 0; j < 8; ++j) o[64 * j] = (v4u){0u, 0u, 0u, 0u}; }
    }
    const int gt = blockIdx.x * 512 + F.tid, NGT = F.G * 512;
    float* rope = (float*)(F.ws + WS_ROPE);
    for (int i = gt; i < LTOK * 16; i += NGT) { const int pos = i >> 4, k = i & 15;
        const double ang = (double)pos * ROPE_INV[k]; const double kq = __builtin_rint(ang * 0.15915494309189535);
        const double red = (ang - kq * 6.28318530717958623) - kq * 2.4492935982947064e-16; const float rf = (float)red;
        rope[2 * i] = cosf(rf); rope[2 * i + 1] = sinf(rf); }
    bf16* w2t = (bf16*)(F.ws + WS_LW2); bf16* a2t = (bf16*)(F.ws + WS_LA2); bf16* g2t = (bf16*)(F.ws + WS_LG2);
    for (int i = gt; i < 2 * 96 * RC; i += NGT) { const int c = i % RC, j = (i / RC) % 96, d = i / (RC * 96);
        w2t[((size_t)d * RC + c) * 96 + j] = (bf16)f2bf(F.in[8][i]); a2t[((size_t)d * RC + c) * 96 + j] = (bf16)f2bf(F.in[10][i]); }
    for (int i = gt; i < 256 * RC; i += NGT) { const int c = i % RC, j = i / RC; g2t[(size_t)c * 256 + j] = (bf16)f2bf(F.in[11][i]); }
}

__device__ __forceinline__ int crow(int r, int hi) { return (r & 3) + 8 * (r >> 2) + 4 * hi; }
__device__ __forceinline__ void attn_phase(Frame& F, const int gw, const int NGW) {
    const bf16* Q = (const bf16*)(F.ws + WS_Q); const bf16* K = (const bf16*)(F.ws + WS_K); const bf16* Vt = (const bf16*)(F.ws + WS_VT); bf16* OA = (bf16*)(F.ws + WS_OATT);
    const float* sink = F.in[17];
    const int hh = F.lane >> 5, r = F.lane & 31;
    constexpr float SC = 0.08838834764831845f * 1.4426950408889634f, L2E = 1.4426950408889634f;
    for (int item = gw; item < 4096; item += NGW) {
        const int sub = item & 3, hq = (item >> 2) & 15, qb = item >> 6, q0 = qb * 128 + sub * 32, hk = hq >> 2;
        bf16x8 bq[8];
        { const bf16* qp = Q + (size_t)(q0 + r) * ATTW + hq * 128 + 8 * hh;
#pragma unroll
          for (int s = 0; s < 8; ++s) bq[s] = *(const bf16x8*)(qp + 16 * s); }
        f32x16 O[4];
#pragma unroll
        for (int dt = 0; dt < 4; ++dt)
#pragma unroll
            for (int i = 0; i < 16; ++i) O[dt][i] = 0.f;
        float m = sink[hq] * L2E, l = (hh == 0) ? 1.f : 0.f;
        for (int ti = 0; ti < 10; ++ti) {
            const bool meta = (ti == 9);
            const int key0 = meta ? SEQ : q0 + 32 * (ti - 4);
            if (key0 < 0 || (!meta && key0 >= SEQ)) continue;
            f32x16 st;
#pragma unroll
            for (int i = 0; i < 16; ++i) st[i] = 0.f;
            { const bf16* kp = K + (size_t)(key0 + r) * KVW + hk * 128 + 8 * hh;
#pragma unroll
              for (int s = 0; s < 8; ++s) { const bf16x8 ak = *(const bf16x8*)(kp + 16 * s); st = __builtin_amdgcn_mfma_f32_32x32x16_bf16(ak, bq[s], st, 0, 0, 0); } }
            float tmax = -__builtin_inff();
#pragma unroll
            for (int i = 0; i < 16; ++i) { const int kr = crow(i, hh); bool ok;
                if (meta) ok = kr < NMETA; else { const int dlt = (key0 + kr) - (q0 + r); ok = (dlt >= -128) && (dlt <= 128); }
                const float t = ok ? st[i] * SC : -__builtin_inff(); st[i] = t; tmax = fmaxf(tmax, t); }
            tmax = fmaxf(tmax, __shfl_xor(tmax, 32));
            const float mn = fmaxf(m, tmax), alpha = __builtin_amdgcn_exp2f(m - mn); m = mn;
            float ps = 0.f;
#pragma unroll
            for (int i = 0; i < 16; ++i) { const float p = __builtin_amdgcn_exp2f(st[i] - mn); st[i] = p; ps += p; }
            l = l * alpha + ps;
#pragma unroll
            for (int dt = 0; dt < 4; ++dt)
#pragma unroll
                for (int i = 0; i < 16; ++i) O[dt][i] *= alpha;
            bf16x8 pb[2];
#pragma unroll
            for (int s2 = 0; s2 < 2; ++s2) { v4u w; w.x = pg8::cvt_pk_bf16(st[8 * s2 + 0], st[8 * s2 + 1]); w.y = pg8::cvt_pk_bf16(st[8 * s2 + 2], st[8 * s2 + 3]);
                w.z = pg8::cvt_pk_bf16(st[8 * s2 + 4], st[8 * s2 + 5]); w.w = pg8::cvt_pk_bf16(st[8 * s2 + 6], st[8 * s2 + 7]); pb[s2] = __builtin_bit_cast(bf16x8, w); }
#pragma unroll
            for (int dt = 0; dt < 4; ++dt) { const bf16* vp = Vt + (size_t)(hk * 128 + 32 * dt + r) * MPAD + key0 + 4 * hh;
#pragma unroll
                for (int s2 = 0; s2 < 2; ++s2) { const v2u lo = *(const v2u*)(vp + 16 * s2), hi = *(const v2u*)(vp + 16 * s2 + 8);
                    const v4u w = {lo.x, lo.y, hi.x, hi.y}; O[dt] = __builtin_amdgcn_mfma_f32_32x32x16_bf16(__builtin_bit_cast(bf16x8, w), pb[s2], O[dt], 0, 0, 0); } }
        }
        l += __shfl_xor(l, 32);
        const float inv = 1.0f / l;
        bf16* op = OA + (size_t)(q0 + r) * ATTW + hq * 128 + 4 * hh;
#pragma unroll
        for (int dt = 0; dt < 4; ++dt)
#pragma unroll
            for (int g4 = 0; g4 < 4; ++g4) { v2u w; w.x = pg8::cvt_pk_bf16(O[dt][4 * g4 + 0] * inv, O[dt][4 * g4 + 1] * inv); w.y = pg8::cvt_pk_bf16(O[dt][4 * g4 + 2] * inv, O[dt][4 * g4 + 3] * inv);
                *(v2u*)(op + 32 * dt + 8 * g4) = w; }
    }
}

__device__ __forceinline__ int tok2row(int t) { return t < NMETA ? SEQ + t : t - NMETA; }
struct Sh8 { v4u uc, up, un; };
__device__ __forceinline__ Sh8 shift8_ld(const bf16* U, int t, int col) {
    const int tc = t < LTOK ? t : LTOK - 1, tp = (t >= 1 && t - 1 < LTOK) ? t - 1 : 0, tn = t + 1 < LTOK ? t + 1 : LTOK - 1;
    Sh8 s; s.uc = *(const v4u*)(U + (size_t)tok2row(tc) * UPITCH + col); s.up = *(const v4u*)(U + (size_t)tok2row(tp) * UPITCH + col); s.un = *(const v4u*)(U + (size_t)tok2row(tn) * UPITCH + col); return s; }
__device__ __forceinline__ void shift8_fin(const Sh8& s, int t, int col, const float* mu_p, const float* mu_n, float (&x)[8]) {
    const v4u zz = {0u, 0u, 0u, 0u};
    const v4u uc = t < LTOK ? s.uc : zz, up = (t >= 1 && t - 1 < LTOK) ? s.up : zz, un = t + 1 < LTOK ? s.un : zz;
    const f32x4 mp0 = *(const f32x4*)(mu_p + col), mp1 = *(const f32x4*)(mu_p + col + 4), mn0 = *(const f32x4*)(mu_n + col), mn1 = *(const f32x4*)(mu_n + col + 4);
    const unsigned ucw[4] = {uc.x, uc.y, uc.z, uc.w}, upw[4] = {up.x, up.y, up.z, up.w}, unw[4] = {un.x, un.y, un.z, un.w};
    const float mpw[8] = {mp0[0], mp0[1], mp0[2], mp0[3], mp1[0], mp1[1], mp1[2], mp1[3]}, mnw[8] = {mn0[0], mn0[1], mn0[2], mn0[3], mn1[0], mn1[1], mn1[2], mn1[3]};
#pragma unroll
    for (int e = 0; e < 8; ++e) { const float c0 = (e & 1) ? bfhi(ucw[e >> 1]) : bflo(ucw[e >> 1]), p0 = (e & 1) ? bfhi(upw[e >> 1]) : bflo(upw[e >> 1]), n0 = (e & 1) ? bfhi(unw[e >> 1]) : bflo(unw[e >> 1]);
        x[e] = c0 + mpw[e] * (p0 - c0) + mnw[e] * (n0 - c0); }
}
__device__ __forceinline__ void flush_bf16(const LAS bf16* tile, bf16* ARR, int t0, int cbase, int lane) {
#pragma unroll
    for (int h = 0; h < 2; ++h) { const int row = (lane >> 2) + 16 * h, ch = lane & 3; const v4u v = *(const LAS v4u*)(tile + row * 32 + 8 * ch);
        if (t0 + row < LTOK) *(v4u*)(ARR + (size_t)(t0 + row) * RC + cbase + 8 * ch) = v; }
}
__device__ __forceinline__ void flush_f32(const LAS float* tile, float* ARR, int t0, int cbase, int lane) {
#pragma unroll
    for (int h = 0; h < 4; ++h) { const int row = (lane >> 3) + 8 * h, ch = lane & 7; const f32x4 v = *(const LAS f32x4*)(tile + row * 32 + 4 * ch);
        if (t0 + row < LTOK) *(f32x4*)(ARR + (size_t)(t0 + row) * RC + cbase + 4 * ch) = v; }
}
__device__ __forceinline__ void prep_phase(Frame& F) {
    constexpr int XS = 648;
    LAS bf16* Xs = (LAS bf16*)F.lds;
    LAS bf16* Kt = (LAS bf16*)(F.lds + 41472 + F.wave * 8192);
    LAS bf16* Ot = Kt + 2048;
    const bf16* U = (const bf16*)(F.ws + WS_U);
    const float* mu_p = F.in[5]; const float* mu_n = F.in[6];
    const bf16* w2t = (const bf16*)(F.ws + WS_LW2); const bf16* a2t = (const bf16*)(F.ws + WS_LA2); const bf16* g2t = (const bf16*)(F.ws + WS_LG2);
    float* W0 = (float*)(F.ws + WS_W0); float* W1 = (float*)(F.ws + WS_W1);
    bf16* KD0 = (bf16*)(F.ws + WS_KD0); bf16* KD1 = (bf16*)(F.ws + WS_KD1); bf16* B0 = (bf16*)(F.ws + WS_B0); bf16* B1 = (bf16*)(F.ws + WS_B1);
    bf16* KK = (bf16*)(F.ws + WS_KK); bf16* RR = (bf16*)(F.ws + WS_RR); bf16* VV = (bf16*)(F.ws + WS_VV); bf16* GG = (bf16*)(F.ws + WS_GG);
    const int hh = F.lane >> 5, r = F.lane & 31;
    for (int unit = blockIdx.x; unit < 257 * 4; unit += F.G) {
        const int tt = unit >> 2, t0 = tt * 32, hd = (unit & 3) * 8 + F.wave;
        __syncthreads();
        FPB0(15);
        { Sh8 sx[5];
#pragma unroll
          for (int it = 0; it < 5; ++it) { const int ci = F.tid + 512 * it; sx[it] = shift8_ld(U, t0 + ci / 80, 3 * RC + 8 * (ci % 80)); }
#pragma unroll
          for (int it = 0; it < 5; ++it) { const int ci = F.tid + 512 * it, tl = ci / 80, ch = ci % 80;
            float x[8]; shift8_fin(sx[it], t0 + tl, 3 * RC + 8 * ch, mu_p, mu_n, x);
#pragma unroll
            for (int e = 0; e < 8; ++e) { float v = x[e];
                if (ch < 24) { const float ex = __expf(2.0f * v); v = 1.0f - 2.0f / (ex + 1.0f); }
                else if (ch >= 48) v = sigmoidf_(v);
                x[e] = v; }
            v4u o; o.x = pk2(x[0], x[1]); o.y = pk2(x[2], x[3]); o.z = pk2(x[4], x[5]); o.w = pk2(x[6], x[7]);
            *(LAS v4u*)(Xs + tl * XS + 8 * ch) = o; } }
        { const int c8 = hd * 64 + 8 * (F.lane & 7);
#pragma unroll
          for (int st = 0; st < 3; ++st) { const int col = (st == 0 ? RC : st == 1 ? 0 : 2 * RC) + c8; Sh8 sq[4];
#pragma unroll
            for (int q = 0; q < 4; ++q) sq[q] = shift8_ld(U, t0 + (F.lane >> 3) + 8 * q, col);
#pragma unroll
            for (int q = 0; q < 4; ++q) { const int tl = (F.lane >> 3) + 8 * q, tq = t0 + tl; float x[8]; shift8_fin(sq[q], tq, col, mu_p, mu_n, x);
                v4u o; o.x = pk2(x[0], x[1]); o.y = pk2(x[2], x[3]); o.z = pk2(x[4], x[5]); o.w = pk2(x[6], x[7]);
                if (st == 0) *(LAS v4u*)(Kt + tl * 64 + 8 * (F.lane & 7)) = o;
                else if (tq < LTOK) *(v4u*)((st == 1 ? RR : VV) + (size_t)tq * RC + c8) = o; } } }
        __syncthreads();
        FPB1(15); FPB0(16);
        float kp[2][16], ss[16];
#pragma unroll
        for (int i = 0; i < 16; ++i) ss[i] = 0.f;
#pragma unroll
        for (int ct = 0; ct < 2; ++ct) { const int c = hd * 64 + 32 * ct + r; const float kkw = F.in[12][c];
#pragma unroll
            for (int i = 0; i < 16; ++i) { kp[ct][i] = bf2f(Kt[crow(i, hh) * 64 + 32 * ct + r]); const float kr = kp[ct][i] * kkw; ss[i] += kr * kr; } }
#pragma unroll
        for (int i = 0; i < 16; ++i) {
#pragma unroll
            for (int o = 1; o < 32; o <<= 1) ss[i] += __shfl_xor(ss[i], o);
            ss[i] = 1.0f / fmaxf(sqrtf(ss[i]), 1e-12f); }
#define LDF(dst, ptr, n) do { _Pragma("unroll") for (int s_ = 0; s_ < (n); ++s_) dst[s_] = *(const bf16x8*)((ptr) + 16 * s_); } while (0)
#define MMF(frag, xoff, n) do { _Pragma("unroll") for (int i_ = 0; i_ < 16; ++i_) acc[i_] = 0.f; const LAS bf16* ap_ = Xs + r * XS + (xoff) + 8 * hh; \
            _Pragma("unroll") for (int s_ = 0; s_ < (n); ++s_) acc = __builtin_amdgcn_mfma_f32_32x32x16_bf16(*(const LAS bf16x8*)(ap_ + 16 * s_), frag[s_], acc, 0, 0, 0); } while (0)
#pragma unroll
        for (int ct = 0; ct < 2; ++ct) {
            const int c = hd * 64 + 32 * ct + r, cb = hd * 64 + 32 * ct;
            const float kkw = F.in[12][c], kaw = F.in[13][c];
            const bf16* pa0 = a2t + (size_t)c * 96 + 8 * hh; const bf16* pa1 = a2t + ((size_t)RC + c) * 96 + 8 * hh;
            const bf16* pw0 = w2t + (size_t)c * 96 + 8 * hh; const bf16* pw1 = w2t + ((size_t)RC + c) * 96 + 8 * hh; const bf16* pg = g2t + (size_t)c * 256 + 8 * hh;
            bf16x8 fa[6], fg[16]; f32x16 acc; float kk[16];
            LDF(fa, pa0, 6);
#pragma unroll
            for (int i = 0; i < 16; ++i) { kk[i] = kp[ct][i] * kkw * ss[i]; Ot[crow(i, hh) * 32 + r] = (bf16)f2bf(kk[i]); }
            flush_bf16(Ot, KK, t0, cb, F.lane);
#pragma unroll
            for (int d = 0; d < 2; ++d) {
                if (d == 0) { MMF(fa, 192, 6); LDF(fa, pa1, 6); } else { MMF(fa, 288, 6); LDF(fa, pw0, 6); }
                const float a0 = F.in[9][d * RC + c];
#pragma unroll
                for (int i = 0; i < 16; ++i) { acc[i] = sigmoidf_(a0 + acc[i]); Ot[crow(i, hh) * 32 + r] = (bf16)f2bf(kp[ct][i] * (1.0f + (acc[i] - 1.0f) * kaw)); }
                flush_bf16(Ot, d ? KD1 : KD0, t0, cb, F.lane);
#pragma unroll
                for (int i = 0; i < 16; ++i) Ot[crow(i, hh) * 32 + r] = (bf16)f2bf(kk[i] * acc[i]);
                flush_bf16(Ot, d ? B1 : B0, t0, cb, F.lane);
            }
#pragma unroll
            for (int d = 0; d < 2; ++d) {
                if (d == 0) { MMF(fa, 0, 6); LDF(fa, pw1, 6); } else { MMF(fa, 96, 6); LDF(fg, pg, 16); }
                const float w0 = F.in[7][d * RC + c]; LAS float* Of = (LAS float*)Ot;
#pragma unroll
                for (int i = 0; i < 16; ++i) Of[crow(i, hh) * 32 + r] = __expf(-0.6065306597126334f * sigmoidf_(w0 + acc[i]));
                flush_f32(Of, d ? W1 : W0, t0, cb, F.lane);
            }
            MMF(fg, 384, 16);
#pragma unroll
            for (int i = 0; i < 16; ++i) Ot[crow(i, hh) * 32 + r] = (bf16)f2bf(acc[i]);
            flush_bf16(Ot, GG, t0, cb, F.lane);
        }
#undef LDF
#undef MMF
        FPB1(16);
    }
    __syncthreads();
}

__device__ __forceinline__ int blk_tok(int d, int blk, int u) { return d ? (LTOK - 1 - 16 * blk - u) : (16 * blk + u); }
__device__ __forceinline__ size_t bo_item(int hd, int d, int blk) { return (size_t)(hd * NBT + (d ? NB0 : 0) + blk) * BO_ITEM; }
__device__ __forceinline__ v4u pack8(const float (&x)[8]) { v4u o; o.x = pk2(x[0], x[1]); o.y = pk2(x[2], x[3]); o.z = pk2(x[4], x[5]); o.w = pk2(x[6], x[7]); return o; }
__device__ __forceinline__ void blockprep_phase(Frame& F) {
    LAS unsigned char* wl = F.lds + F.wave * 16384;
    constexpr int LP = 72;
    LAS bf16* LT = (LAS bf16*)wl;
    LAS float* GM = (LAS float*)(wl + 9216);
    LAS float* TM = (LAS float*)(wl + 13312);
    LAS float* TB = (LAS float*)(wl + 14336);
    LAS float* AH = (LAS float*)(wl + 15360);
    const float* W0 = (const float*)(F.ws + WS_W0); const float* W1 = (const float*)(F.ws + WS_W1);
    const bf16* KD0 = (const bf16*)(F.ws + WS_KD0); const bf16* KD1 = (const bf16*)(F.ws + WS_KD1); const bf16* B0 = (const bf16*)(F.ws + WS_B0); const bf16* B1 = (const bf16*)(F.ws + WS_B1);
    const bf16* KK = (const bf16*)(F.ws + WS_KK); const bf16* RR = (const bf16*)(F.ws + WS_RR);
    float* BON = (float*)(F.ws + WS_BONUS); unsigned char* BO = F.ws + WS_BO;
    const int gw = blockIdx.x * 8 + F.wave, NGW = F.G * 8, j = F.lane, hh = F.lane >> 5, r31 = F.lane & 31, c16 = F.lane & 15;
    for (int it = gw; it < RH * NBT; it += NGW) {
        const int hd = it / NBT, rem = it % NBT, d = rem >= NB0 ? 1 : 0, blk = d ? rem - NB0 : rem, c = hd * 64 + j;
        const float* Wd = d ? W1 : W0; const bf16* KDd = d ? KD1 : KD0; const bf16* Bd = d ? B1 : B0;
        float kt[16], rt[16], kdh[16], bh[16]; float G15;
        { float G[16];
          { float g = 1.f;
#pragma unroll
            for (int u = 0; u < 16; ++u) { g *= Wd[(size_t)blk_tok(d, blk, u) * RC + c]; G[u] = g; } }
          asm volatile("" ::: "memory");
          const float rkw = F.in[14][c];
#pragma unroll
          for (int u = 0; u < 16; ++u) { const size_t o = (size_t)blk_tok(d, blk, u) * RC + c; kdh[u] = bf2f(KDd[o]); rt[u] = bf2f(RR[o]); }
#pragma unroll
          for (int u = 0; u < 16; ++u) { const float s = wave_sum(rt[u] * kdh[u] * rkw); if (F.lane == 0) atomicAdd(BON + (size_t)blk_tok(d, blk, u) * RH + hd, s);
              kdh[u] = kdh[u] / G[u]; rt[u] = rt[u] * G[u]; LT[(0 * 16 + u) * LP + j] = (bf16)f2bf(kdh[u]); LT[(3 * 16 + u) * LP + j] = (bf16)f2bf(rt[u]); }
          asm volatile("" ::: "memory");
#pragma unroll
          for (int u = 0; u < 16; ++u) { const size_t o = (size_t)blk_tok(d, blk, u) * RC + c; kt[u] = bf2f(KK[o]); bh[u] = bf2f(Bd[o]); }
#pragma unroll
          for (int u = 0; u < 16; ++u) { kt[u] = kt[u] * (u ? G[u - 1] : 1.f); bh[u] = bh[u] / G[u]; LT[(2 * 16 + u) * LP + j] = (bf16)f2bf(kt[u]); LT[(1 * 16 + u) * LP + j] = (bf16)f2bf(bh[u]); }
          G15 = G[15]; }
        asm volatile("" ::: "memory");
        { f32x16 acc;
#pragma unroll
          for (int i = 0; i < 16; ++i) acc[i] = 0.f;
          const LAS bf16* ap = LT + ((r31 < 16 ? 0 : 1) * 16 + (r31 & 15)) * LP + 8 * hh; const LAS bf16* bp = LT + ((r31 < 16 ? 2 : 3) * 16 + (r31 & 15)) * LP + 8 * hh;
#pragma unroll
          for (int s = 0; s < 4; ++s) acc = __builtin_amdgcn_mfma_f32_32x32x16_bf16(*(const LAS bf16x8*)(ap + 16 * s), *(const LAS bf16x8*)(bp + 16 * s), acc, 0, 0, 0);
#pragma unroll
          for (int i = 0; i < 16; ++i) { const int row = crow(i, hh), m = row & 15, u = r31 & 15, q = (row >> 4) * 2 + (r31 >> 4);
              const bool ok = (q & 1) ? (m <= u) : (m < u); GM[q * 256 + m * 16 + u] = ok ? acc[i] : 0.f; } }
#define CFENCE() asm volatile("" ::: "memory")
        CFENCE();
        { float Tr[16];
#pragma unroll
          for (int m = 15; m >= 0; --m) { float s = (c16 == m) ? 1.f : 0.f;
#pragma unroll
              for (int u = m + 1; u < 16; ++u) s -= GM[2 * 256 + m * 16 + u] * Tr[u];
              Tr[m] = s; CFENCE(); }
#pragma unroll
          for (int m = 0; m < 16; ++m) TM[m * 16 + c16] = Tr[m]; }
        CFENCE();
        { float bpc[16];
#pragma unroll
          for (int u = 0; u < 16; ++u) bpc[u] = GM[3 * 256 + u * 16 + c16];
#pragma unroll
          for (int m = 0; m < 16; ++m) { float s = 0.f;
#pragma unroll
              for (int u = m; u < 16; ++u) s += TM[m * 16 + u] * bpc[u];
              bpc[m] = s; CFENCE(); }
#pragma unroll
          for (int m = 0; m < 16; ++m) TB[c16 * 16 + m] = bpc[m];
          CFENCE();
#pragma unroll
          for (int m = 0; m < 16; ++m) { float s = GM[1 * 256 + m * 16 + c16];
#pragma unroll
              for (int u = m + 1; u < 16; ++u) s -= GM[0 * 256 + m * 16 + u] * bpc[u];
              AH[m * 16 + c16] = s; CFENCE(); } }
        float M1[16], M2[16];
#pragma unroll
        for (int m = 0; m < 16; ++m) { float s = 0.f;
#pragma unroll
            for (int u = m; u < 16; ++u) s += TM[m * 16 + u] * bh[u];
            M1[m] = s * G15; CFENCE(); }
#pragma unroll
        for (int m = 0; m < 16; ++m) { float s = kdh[m] * G15;
#pragma unroll
            for (int u = m + 1; u < 16; ++u) s -= GM[0 * 256 + m * 16 + u] * M1[u];
            M2[m] = s; CFENCE(); }
#pragma unroll
        for (int u = 0; u < 16; ++u) { float s = rt[u];
#pragma unroll
            for (int m = 0; m <= u; ++m) s -= TB[u * 16 + m] * kt[m];
            rt[u] = s; CFENCE(); }
        unsigned char* base = BO + bo_item(hd, d, blk);
        { const int a = j >> 5, jp = j & 31;
#pragma unroll
          for (int h2 = 0; h2 < 2; ++h2) { float x0[8], x1[8];
#pragma unroll
              for (int e = 0; e < 8; ++e) { x0[e] = -M1[8 * (e >> 2) + 4 * h2 + (e & 3)]; x1[e] = M2[8 * h2 + e]; }
              *(v4u*)(base + BO_FB + ((a * 2 + 0) * 64 + jp + 32 * h2) * 16) = pack8(x0); *(v4u*)(base + BO_FB + ((a * 2 + 1) * 64 + jp + 32 * h2) * 16) = pack8(x1); } }
        *(float*)(base + BO_FG + 4 * j) = G15;
#pragma unroll
        for (int u = 0; u < 16; ++u) { LT[u * LP + j] = (bf16)f2bf(kt[u]); LT[(16 + u) * LP + j] = (bf16)f2bf(rt[u]); }
#pragma unroll
        for (int ks = 0; ks < 4; ++ks) { const int j0 = 32 * (ks >> 1) + 16 * (ks & 1) + 4 * hh; const v2u lo = *(const LAS v2u*)(LT + r31 * LP + j0), hi = *(const LAS v2u*)(LT + r31 * LP + j0 + 8);
            *(v4u*)(base + BO_FA + (ks * 64 + F.lane) * 16) = (v4u){lo.x, lo.y, hi.x, hi.y}; }
        { float x[8];
#pragma unroll
          for (int e = 0; e < 8; ++e) x[e] = (r31 >= 16) ? AH[(8 * hh + e) * 16 + (r31 - 16)] : 0.f;
          *(v4u*)(base + BO_FH + F.lane * 16) = pack8(x); }
        CFENCE();
    }
#undef CFENCE
}

constexpr int N_SCAN_WAVES = 128;
__device__ __forceinline__ void convert_item(Frame& F, LAS float* scr, int it) {
    constexpr int I_GU = (DM / 64) * (DFF / 32), I_P = (ATTW / 64) * (DM / 32), I_O = (DM / 64) * (DM / 32);
    int r = it;
    if (r < I_GU) { transpose_item<1>(F.in[22], DM, DFF, (bf16*)(F.ws + WS_WGU), scr, r, F.lane, F.in[21]); return; } r -= I_GU;
    if (r < I_GU) { transpose_item<2>(F.in[23], DM, DFF, (bf16*)(F.ws + WS_WGU), scr, r, F.lane, F.in[21]); return; } r -= I_GU;
    if (r < I_P) { transpose_item<0>(F.in[18], ATTW, DM, (bf16*)(F.ws + WS_WPA), scr, r, F.lane, nullptr); return; } r -= I_P;
    if (r < I_P) { transpose_item<0>(F.in[19], RC, DM, (bf16*)(F.ws + WS_WPR), scr, r, F.lane, nullptr); return; } r -= I_P;
    if (r < I_O) { transpose_item<0>(F.in[20], DM, DM, (bf16*)(F.ws + WS_WOUT), scr, r, F.lane, nullptr); return; } r -= I_O;
    transpose_item<0>(F.in[24], DFF, DM, (bf16*)(F.ws + WS_WD), scr, r, F.lane, nullptr);
}
constexpr int N_CONVERT_ITEMS = 2 * (DM / 64) * (DFF / 32) + 2 * (ATTW / 64) * (DM / 32) + (DM / 64) * (DM / 32) + (DFF / 64) * (DM / 32);
constexpr int SR_SLOTS = 9, SR_STRIDE = 11264, SR_FV = 10240, SR_FLAGS = SR_SLOTS * SR_STRIDE, SR_WSCR = SR_FLAGS + 512, SR_NL = 4;
struct LdSet { v4u p[10]; unsigned short v[8]; };
__device__ __forceinline__ void sr_issue(LdSet& s, const unsigned char* item, const bf16* VV, int hd, int d, int blk, int ih, int lane) {
#pragma unroll
    for (int k = 0; k < 10; ++k) { const int pc = k * 64 + lane; s.p[k] = *(const v4u*)(item + (pc < BO_ITEM / 16 ? pc : BO_ITEM / 16 - 1) * 16); }
    const int hh = lane >> 5, il = lane & 31;
#pragma unroll
    for (int e = 0; e < 8; ++e) s.v[e] = VV[(size_t)blk_tok(d, blk, 8 * hh + e) * RC + hd * 64 + 32 * ih + il];
}
__device__ __forceinline__ void sr_write(const LdSet& s, LAS unsigned char* slot, int lane) {
#pragma unroll
    for (int k = 0; k < 10; ++k) *(LAS v4u*)(slot + (k * 64 + lane) * 16) = s.p[k];
    const v4u vw = {(unsigned)s.v[0] | ((unsigned)s.v[1] << 16), (unsigned)s.v[2] | ((unsigned)s.v[3] << 16), (unsigned)s.v[4] | ((unsigned)s.v[5] << 16), (unsigned)s.v[6] | ((unsigned)s.v[7] << 16)};
    *(LAS v4u*)(slot + SR_FV + lane * 16) = vw;
}
__device__ __forceinline__ bf16x8 pack_half(const f32x16& x, int s) {
    const v4u w = {pk2(x[8 * s + 0], x[8 * s + 1]), pk2(x[8 * s + 2], x[8 * s + 3]), pk2(x[8 * s + 4], x[8 * s + 5]), pk2(x[8 * s + 6], x[8 * s + 7])}; return __builtin_bit_cast(bf16x8, w); }
__device__ __forceinline__ void scan_phase(Frame& F) {
    const bf16* VV = (const bf16*)(F.ws + WS_VV); bf16* Y = (bf16*)(F.ws + WS_Y); const unsigned char* BO = F.ws + WS_BO;
    const bool sblock = (int)blockIdx.x < N_SCAN_WAVES;
    volatile LAS unsigned* FL = (volatile LAS unsigned*)(F.lds + SR_FLAGS);
    constexpr unsigned SPIN_CAP = 1u << 22;
    __syncthreads();
    if (F.tid < 128) FL[F.tid] = 0u;
    __syncthreads();
    const int pair = (int)blockIdx.x >> 1, ih = (int)blockIdx.x & 1, hd = pair >> 1, d = pair & 1, nblk = d ? NB1 : NB0, hh = F.lane >> 5, il = F.lane & 31;
    if (sblock && F.wave == 0) {
        __builtin_amdgcn_s_setprio(3);
        f32x16 St[2];
#pragma unroll
        for (int a = 0; a < 2; ++a)
#pragma unroll
            for (int i = 0; i < 16; ++i) St[a][i] = 0.f;
        FPB0(17);
        for (int blk = 0; blk < nblk; ++blk) {
            const int sl = blk % SR_SLOTS; const LAS unsigned char* slot = F.lds + sl * SR_STRIDE;
            { unsigned sp = 0; while (FL[sl] != (unsigned)(blk + 1)) { __builtin_amdgcn_s_sleep(1); if (++sp > SPIN_CAP) break; } }
            asm volatile("" ::: "memory");
            bf16x8 fa[4], fb[2][2]; f32x4 gm[2][4];
#pragma unroll
            for (int ks = 0; ks < 4; ++ks) fa[ks] = *(const LAS bf16x8*)(slot + BO_FA + (ks * 64 + F.lane) * 16);
            const bf16x8 fh = *(const LAS bf16x8*)(slot + BO_FH + F.lane * 16), vf = *(const LAS bf16x8*)(slot + SR_FV + F.lane * 16);
#pragma unroll
            for (int a = 0; a < 2; ++a)
#pragma unroll
                for (int k = 0; k < 2; ++k) fb[a][k] = *(const LAS bf16x8*)(slot + BO_FB + ((a * 2 + k) * 64 + F.lane) * 16);
#pragma unroll
            for (int a = 0; a < 2; ++a)
#pragma unroll
                for (int q = 0; q < 4; ++q) gm[a][q] = *(const LAS f32x4*)(slot + BO_FG + (32 * a + 8 * q + 4 * hh) * 4);
            asm volatile("s_waitcnt lgkmcnt(0)" ::: "memory");
            if (F.lane == 0) FL[16] = (unsigned)(blk + 1);
            f32x16 acc;
#pragma unroll
            for (int i = 0; i < 16; ++i) acc[i] = 0.f;
            acc = __builtin_amdgcn_mfma_f32_32x32x16_bf16(fh, vf, acc, 0, 0, 0);
#pragma unroll
            for (int a = 0; a < 2; ++a)
#pragma unroll
                for (int s = 0; s < 2; ++s) acc = __builtin_amdgcn_mfma_f32_32x32x16_bf16(fa[2 * a + s], pack_half(St[a], s), acc, 0, 0, 0);
#pragma unroll
            for (int e = 0; e < 8; ++e) { const int u = 8 * (e >> 2) + 4 * hh + (e & 3);
                Y[((size_t)d * LTOK + blk_tok(d, blk, u)) * RC + hd * 64 + 32 * ih + il] = (bf16)f2bf(acc[8 + e]); }
            const bf16x8 zb = pack_half(acc, 0);
#pragma unroll
            for (int a = 0; a < 2; ++a) {
#pragma unroll
                for (int i = 0; i < 16; ++i) St[a][i] *= gm[a][i >> 2][i & 3];
                St[a] = __builtin_amdgcn_mfma_f32_32x32x16_bf16(fb[a][0], zb, St[a], 0, 0, 0);
                St[a] = __builtin_amdgcn_mfma_f32_32x32x16_bf16(fb[a][1], vf, St[a], 0, 0, 0);
            }
        }
        FPB1(17);
        __builtin_amdgcn_s_setprio(0);
    } else if (sblock && F.wave <= SR_NL) {
        __builtin_amdgcn_s_setprio(2);
        const int lw = F.wave - 1;
        LdSet sA, sB;
#define SR_PUT(set, b_) do { const int sl_ = (b_) % SR_SLOTS; if ((b_) >= SR_SLOTS) { unsigned sp_ = 0; while (FL[16] < (unsigned)((b_) - SR_SLOTS + 1)) { __builtin_amdgcn_s_sleep(1); if (++sp_ > SPIN_CAP) break; } } \
            asm volatile("" ::: "memory"); sr_write(set, F.lds + sl_ * SR_STRIDE, F.lane); asm volatile("s_waitcnt lgkmcnt(0)" ::: "memory"); if (F.lane == 0) FL[sl_] = (unsigned)((b_) + 1); } while (0)
        int bA = lw, bB = lw + SR_NL;
        if (bA < nblk) sr_issue(sA, BO + bo_item(hd, d, bA), VV, hd, d, bA, ih, F.lane);
        if (bB < nblk) sr_issue(sB, BO + bo_item(hd, d, bB), VV, hd, d, bB, ih, F.lane);
        while (bA < nblk) {
            SR_PUT(sA, bA); bA += 2 * SR_NL; if (bA < nblk) sr_issue(sA, BO + bo_item(hd, d, bA), VV, hd, d, bA, ih, F.lane);
            if (bB < nblk) { SR_PUT(sB, bB); bB += 2 * SR_NL; if (bB < nblk) sr_issue(sB, BO + bo_item(hd, d, bB), VV, hd, d, bB, ih, F.lane); }
        }
#undef SR_PUT
        __builtin_amdgcn_s_setprio(0);
    } else {
        const int b = (int)blockIdx.x, nsb = F.G < N_SCAN_WAVES ? F.G : N_SCAN_WAVES, wps = 7 - SR_NL;
        const int widx = b < N_SCAN_WAVES ? b * wps + (F.wave - 1 - SR_NL) : nsb * wps + (b - N_SCAN_WAVES) * 8 + F.wave;
        const int NWK = nsb * wps + (F.G - nsb) * 8;
        attn_phase(F, widx, NWK);
        LAS float* scr = (LAS float*)(F.lds + (sblock ? SR_WSCR + (F.wave - 1 - SR_NL) * 8448 : F.wave * 8448));
        for (int it = widx; it < N_CONVERT_ITEMS; it += NWK) convert_item(F, scr, it);
    }
}

__device__ __forceinline__ void combine_phase(Frame& F) {
    const bf16* Y0 = (const bf16*)(F.ws + WS_Y); const bf16* Y1 = Y0 + (size_t)LTOK * RC; const float* BON = (const float*)(F.ws + WS_BONUS);
    const bf16* VV = (const bf16*)(F.ws + WS_VV); const bf16* GG = (const bf16*)(F.ws + WS_GG);
    bf16* OR = (bf16*)(F.ws + WS_ORWKV);
    const float* lnw = F.in[15]; const float* lnb = F.in[16];
    const int gw = blockIdx.x * 8 + F.wave, NGW = F.G * 8;
    for (int row = gw; row < SEQ; row += NGW) { const int t = row + NMETA;
#pragma unroll 4
        for (int hd = 0; hd < RH; ++hd) { const int c = hd * 64 + F.lane; const size_t o = (size_t)t * RC + c;
            const float y = bf2f(Y0[o]) + bf2f(Y1[o]);
            const float mean = wave_sum(y) * (1.0f / 64.0f); const float dlt = y - mean; const float var = wave_sum(dlt * dlt) * (1.0f / 64.0f);
            const float yn = dlt * __builtin_amdgcn_rsqf(var + GN_EPS) * lnw[c] + lnb[c];
            const float outv = (yn + BON[(size_t)t * RH + hd] * bf2f(VV[o])) * bf2f(GG[o]);
            OR[(size_t)row * RC + c] = (bf16)f2bf(outv); } }
}
__device__ __forceinline__ void final_phase(Frame& F) {
    const float* SS3 = (const float*)(F.ctl + CW_SS3); const float* w = F.in[25];
    const int gw = blockIdx.x * 8 + F.wave, NGW = F.G * 8;
    for (int row = gw; row < SEQ; row += NGW) { const float rstd = 1.0f / sqrtf(SS3[row] * (1.0f / DM) + RMS_EPS);
        GAS f32x4* p = (GAS f32x4*)(F.out + (size_t)row * DM) + F.lane; const GAS f32x4* wp = (const GAS f32x4*)w + F.lane;
#pragma unroll
        for (int j = 0; j < 16; ++j) { const f32x4 v = p[64 * j], ww = wp[64 * j]; p[64 * j] = v * rstd * ww; } }
}
constexpr int N_PHASES = 11;
struct Args { const float* in[26]; float* out; unsigned char* ws; int ph_lo, ph_hi; };
__global__ void __launch_bounds__(512, 2) fwd_kernel(Args args) {
    extern __shared__ __attribute__((aligned(16))) unsigned char lds[];
    Frame F;
    F.lds = (LAS unsigned char*)lds;
    F.MISC = (volatile LAS unsigned*)(F.lds + MISC_OFF);
    F.tid = threadIdx.x; F.lane = F.tid & 63; F.wave = __builtin_amdgcn_readfirstlane(F.tid >> 6); F.G = gridDim.x;
    F.ws = args.ws; F.ctl = (gu32*)(args.ws + WS_CTL); F.out = args.out; F.pb0 = 0; F.pacc = 0; F.pacc2 = 0;
#pragma unroll
    for (int i = 0; i < 26; ++i) F.in[i] = args.in[i];
    for (int u = F.tid; u < (LDS_BYTES - LDSCTL_OFF) / 4; u += 512) ((LAS unsigned*)(F.lds + LDSCTL_OFF))[u] = 0u;
    __syncthreads();
    XcdBarrier bar; bar.bar = (unsigned*)(F.ctl + CW_BAR); bar.x = 0; bar.st = nullptr;
    if (!MK_SPLIT) bar = xcd_barrier_post((unsigned*)(F.ctl + CW_BAR), F.MISC + 8);
    const int lo = args.ph_lo, hi = args.ph_hi;
#define IN(k) (lo <= (k) && (k) < hi)
#define SEAM(k) do { if (IN(k) && IN((k) + 1)) xcd_barrier(bar); } while (0)
    bf16* Rm = (bf16*)(F.ws + WS_H);
    float* SS2 = (float*)(F.ctl + CW_SS2); float* SS3 = (float*)(F.ctl + CW_SS3);

    unsigned long long pt0 = 0, pt1 = 0;
#define PB0(k) do { if ((PROBE_PHASE >> (k)) & 1) pt0 = __builtin_amdgcn_s_memrealtime(); } while (0)
#define PB1(k) do { if ((PROBE_PHASE >> (k)) & 1) pt1 += __builtin_amdgcn_s_memrealtime() - pt0; } while (0)
    PB0(0); if (IN(0)) { p0_prologue(F); } SEAM(0); PB1(0);
    PB0(1); if (IN(1)) {
        pg8::Gemm g{Rm, Rm, MPAD + INWP, MPAD + INWP, DM}; pg8::InOrder S; S.init(F.G, (int)blockIdx.x);
        pg8::EpiIn E{(bf16*)(F.ws + WS_G), (bf16*)(F.ws + WS_Q), (bf16*)(F.ws + WS_K), (bf16*)(F.ws + WS_VT), (bf16*)(F.ws + WS_U), F.in[4], (const float*)(F.ws + WS_ROPE)};
        pg8::gemm_phase<pg8::EpiIn, pg8::InOrder, true, true>(F.lds, g, S, E, F.pacc2);
    } SEAM(1); PB1(1);
    PB0(2); if (IN(2)) { prep_phase(F); } SEAM(2); PB1(2);
    PB0(3); if (IN(3)) { blockprep_phase(F); } SEAM(3); PB1(3);
    PB0(4); if (IN(4)) { scan_phase(F); } SEAM(4); PB1(4);
    PB0(5); if (IN(5)) { combine_phase(F); } SEAM(5); PB1(5);
    PB0(6); if (IN(6)) {
        { pg8::Gemm g{(const bf16*)(F.ws + WS_OATT), (const bf16*)(F.ws + WS_WPA), SEQ, DM, ATTW}; pg8::StaticOrder S; S.init(SEQ, DM, F.G, (int)blockIdx.x);
          pg8::EpiProjA E{(bf16*)(F.ws + WS_P1), (const bf16*)(F.ws + WS_G)};
          pg8::gemm_phase<pg8::EpiProjA, pg8::StaticOrder, true, true>(F.lds, g, S, E, F.pacc2); }
        __syncthreads();
        { pg8::Gemm g{(const bf16*)(F.ws + WS_ORWKV), (const bf16*)(F.ws + WS_WPR), SEQ, DM, RC}; pg8::StaticOrder S; S.init(SEQ, DM, F.G, (int)blockIdx.x);
          pg8::EpiProjB E{(const bf16*)(F.ws + WS_P1), (const bf16*)(F.ws + WS_G), (bf16*)(F.ws + WS_MX)};
          pg8::gemm_phase<pg8::EpiProjB, pg8::StaticOrder, true, true>(F.lds, g, S, E, F.pacc2); }
    } SEAM(6); PB1(6);
    PB0(7); if (IN(7)) {
        pg8::Gemm g{(const bf16*)(F.ws + WS_MX), (const bf16*)(F.ws + WS_WOUT), SEQ, DM, DM}; pg8::StaticOrder S; S.init(SEQ, DM, F.G, (int)blockIdx.x);
        pg8::EpiResid<false> E{F.in[0], nullptr, nullptr, (bf16*)(F.ws + WS_A2), SS2};
        pg8::gemm_phase<pg8::EpiResid<false>, pg8::StaticOrder, true, true>(F.lds, g, S, E, F.pacc2);
    } SEAM(7); PB1(7);
    PB0(8); if (IN(8)) {
        pg8::Gemm g{(const bf16*)(F.ws + WS_A2), (const bf16*)(F.ws + WS_WGU), SEQ, 2 * DFF, DM}; pg8::StaticOrder S; S.init(SEQ, 2 * DFF, F.G, (int)blockIdx.x);
        pg8::EpiSwiGLU E{(bf16*)(F.ws + WS_HID), SS2};
        pg8::gemm_phase<pg8::EpiSwiGLU, pg8::StaticOrder, true, true>(F.lds, g, S, E, F.pacc2);
    } SEAM(8); PB1(8);
    PB0(9); if (IN(9)) {
        pg8::Gemm g{(const bf16*)(F.ws + WS_HID), (const bf16*)(F.ws + WS_WD), SEQ, DM, DFF}; pg8::StaticOrder S; S.init(SEQ, DM, F.G, (int)blockIdx.x);
        pg8::EpiResid<true> E{nullptr, (const bf16*)(F.ws + WS_A2), F.out, nullptr, SS3};
        pg8::gemm_phase<pg8::EpiResid<true>, pg8::StaticOrder, true, true>(F.lds, g, S, E, F.pacc2);
    } SEAM(9); PB1(9);
    PB0(10); if (IN(10)) { final_phase(F); } PB1(10);
    if (PROBE_PHASE != 0 && blockIdx.x == 0 && F.tid == 0) { const unsigned long long te = __builtin_amdgcn_s_memrealtime(), want = (unsigned long long)PROBE_MULT * (((PROBE_PHASE >> 20) & 1) ? F.pacc2 : (pt1 + F.pacc));
        while (__builtin_amdgcn_s_memrealtime() - te < want && want < 2000000ull) __builtin_amdgcn_s_sleep(32); }
#undef PB0
#undef PB1
#undef IN
#undef SEAM
}

extern "C" void kernel_launch(void* const* d_in, const int* in_sizes, int n_in, void* d_out, int out_size, void* d_ws, size_t ws_size, hipStream_t stream) {
    static int grid = 0;
    if (grid == 0) {
        if (n_in != 26 || out_size != SEQ * DM || ws_size < WS_END) { fprintf(stderr, "kernel_launch: unexpected shapes (n_in %d, out %d, ws %zu, need %zu); nothing launched\n", n_in, out_size, ws_size, (size_t)WS_END); grid = -1; return; }
        int dev = 0, cus = 0, per_cu = 0;
        if (hipGetDevice(&dev) != hipSuccess || hipDeviceGetAttribute(&cus, hipDeviceAttributeMultiprocessorCount, dev) != hipSuccess) { grid = -1; return; }
        if (hipFuncSetAttribute((const void*)fwd_kernel, hipFuncAttributeMaxDynamicSharedMemorySize, LDS_BYTES) != hipSuccess) { fprintf(stderr, "kernel_launch: hipFuncSetAttribute failed\n"); grid = -1; return; }
        if (hipOccupancyMaxActiveBlocksPerMultiprocessor(&per_cu, (const void*)fwd_kernel, 512, LDS_BYTES) != hipSuccess || per_cu < 1) fprintf(stderr, "kernel_launch: occupancy query says %d per CU\n", per_cu);
        (void)hipGetLastError();
        grid = cus;
    }
    if (grid < 0) return;
    if (hipMemsetAsync((char*)d_ws + WS_CTL, 0, ZERO_BYTES, stream) != hipSuccess) return;
    Args a{};
    for (int i = 0; i < 26; ++i) a.in[i] = (const float*)d_in[i];
    a.out = (float*)d_out; a.ws = (unsigned char*)d_ws;
#if MK_SPLIT
    for (int p = 0; p < N_PHASES; ++p) { a.ph_lo = p; a.ph_hi = p + 1; hipLaunchKernelGGL(fwd_kernel, dim3(grid), dim3(512), LDS_BYTES, stream, a); }
#else
    a.ph_lo = 0; a.ph_hi = N_PHASES;
    hipLaunchKernelGGL(fwd_kernel, dim3(grid), dim3(512), LDS_BYTES, stream, a);
#endif
}
```

```cpp
#include <hip/hip_runtime.h>
#include <cstdio>
#include <cstdint>

#ifndef MK_SPLIT
#define MK_SPLIT 0
#endif

#ifndef PROBE_PHASE
#define PROBE_PHASE 0
#endif
#ifndef PROBE_MULT
#define PROBE_MULT 2
#endif
constexpr int NMETA = 16, SEQ = 8192, LTOK = 8208, DM = 4096, MPAD = 8448;
constexpr int INW = 18048, INWP = 18176;
constexpr int ATTW = 2048, KVW = 512, UW = 6784, UPITCH = 6912;
constexpr int RC = 2048, RH = 32, RN = 64;
constexpr int DFF = 11008;
constexpr float RMS_EPS = 1e-6f, GN_EPS = 64e-5f;
constexpr int HT = MPAD / 256;
constexpr int CT_Q = 32, CT_K = 40, CT_V = 42, CT_U = 44, CT_N = 71;

namespace pg8 {
#define PG8_LAS __attribute__((address_space(3)))
typedef unsigned short bf16_t;
typedef short bf16x8 __attribute__((ext_vector_type(8)));
typedef float f32x4 __attribute__((ext_vector_type(4)));
typedef unsigned u32x4 __attribute__((ext_vector_type(4)));
constexpr int BM = 256, BK = 64, HALF = 128, HTB = HALF * BK * 2  , STAGE_BYTES = 8 * HTB, NXCD = 8, WGM = 8;

__host__ __device__ __forceinline__ int lds_byte(int r, int c) { const int st = (r >> 4) * 2 + (c >> 5), rr = r & 15, cc = c & 31, ob = rr * 64 + cc * 2; return st * 1024 + (ob ^ (((ob >> 9) & 1) << 5)); }
__host__ __device__ __forceinline__ void stage_rc(int b, int& R, int& C) { const int st = b / 1024, sb = b % 1024, swz = sb ^ (((sb >> 9) & 1) << 5); R = (st >> 1) * 16 + swz / 64; C = (st & 1) * 32 + (swz % 64) / 2; }
__host__ __device__ __forceinline__ int perm32(int rho) { const int n = rho >> 4, i = rho & 15; return 8 * (i >> 2) + 4 * n + (i & 3); }

struct Unit { int pm, pn; };
struct Gemm { const bf16_t* A; const bf16_t* Bt; int M, N, K; };

struct StaticOrder {
    int nM, nN, nwg, G, c;
    __host__ __device__ void init(int M, int N, int G_, int c_) { nM = M / BM; nN = N / BM; nwg = nM * nN; G = G_; c = c_; }
    __host__ __device__ bool next(int i, Unit& u) const {
        const long L = (long)i * G + c; if (L >= nwg) return false;
        int wgid = (int)L; { const int q = nwg / NXCD, r = nwg % NXCD, xcd = wgid % NXCD, off = wgid / NXCD; wgid = (xcd < r ? xcd * (q + 1) : r * (q + 1) + (xcd - r) * q) + off; }
        const int nig = WGM * nN, gid = wgid / nig, fm = gid * WGM, gsz = (nM - fm) < WGM ? (nM - fm) : WGM;
        u.pm = fm + ((wgid % nig) % gsz); u.pn = (wgid % nig) / gsz; return true;
    }
    __device__ __forceinline__ void a_ready(const Unit&) const {}
    __device__ __forceinline__ void done(const Unit&) const {}
};

typedef float f32x2c __attribute__((ext_vector_type(2)));
typedef __bf16 bf16x2c __attribute__((ext_vector_type(2)));
__device__ __forceinline__ unsigned cvt_pk_bf16(float lo, float hi) { const f32x2c v = {lo, hi}; const bf16x2c r = __builtin_convertvector(v, bf16x2c); return __builtin_bit_cast(unsigned, r); }

typedef unsigned u32x2 __attribute__((ext_vector_type(2)));
__device__ __forceinline__ float bflo(unsigned w) { return __uint_as_float(w << 16); }
__device__ __forceinline__ float bfhi(unsigned w) { return __uint_as_float(w & 0xffff0000u); }
__device__ __forceinline__ float sigmoidf_(float x) { return __builtin_amdgcn_rcpf(1.0f + __expf(-x)); }

struct InOrder {
    StaticOrder base; int G, c;
    __device__ void init(int G_, int c_) { base.init(SEQ, INWP, G_, c_); G = G_; c = c_; }
    __device__ bool next(int i, Unit& u) const {
        const long L = (long)i * G + c;
        if (L < base.nwg) {
            base.next(i, u);
            if (u.pn >= CT_V && u.pn < CT_U) { const int e = (u.pn - CT_V) * 32 + u.pm; u.pm = HT + CT_V + e / HT; u.pn = e % HT; }
            else u.pn += HT;
            return true;
        }
        const int x = (int)(L - base.nwg);
        if (x >= 31) return false;
        if (x < 2) { const int e = 64 + x; u.pm = HT + CT_V + e / HT; u.pn = e % HT; }
        else { const int y = x - 2; u.pm = 32; u.pn = HT + (y < 2 ? CT_K + y : CT_U + (y - 2)); }
        return true;
    }
    __device__ __forceinline__ void a_ready(const Unit&) const {}
    __device__ __forceinline__ void done(const Unit&) const {}
};

struct EpiIn {
    static constexpr bool PERM = true, AFTER_DRAIN = false;
    bf16_t *G, *Q, *K, *Vt, *U; const float* bgate; const float* rope;
    __device__ __forceinline__ static void st8(bf16_t* p, const f32x4& v0, const f32x4& v1) {
        u32x4 w; w.x = cvt_pk_bf16(v0[0], v0[1]); w.y = cvt_pk_bf16(v0[2], v0[3]); w.z = cvt_pk_bf16(v1[0], v1[1]); w.w = cvt_pk_bf16(v1[2], v1[3]); *(u32x4*)p = w; }
    __device__ __forceinline__ void plain(const f32x4 (&acc)[2][2][4][2], bf16_t* base, int ldc, int row0, int col0) const {
#pragma unroll
        for (int ai = 0; ai < 2; ++ai)
#pragma unroll
            for (int m = 0; m < 4; ++m) { bf16_t* rowp = base + (size_t)(row0 + ai * HALF + m * 16) * ldc + col0;
#pragma unroll
                for (int bj = 0; bj < 2; ++bj) st8(rowp + bj * HALF, acc[ai][bj][m][0], acc[ai][bj][m][1]); }
    }
    __device__ __forceinline__ void roped(const f32x4 (&acc)[2][2][4][2], bf16_t* base, int ldc, int row0, int col0, int wc, int fq) const {
        if (wc != 0) { plain(acc, base, ldc, row0, col0); return; }
        const float sgn = (fq < 2) ? -1.0f : 1.0f;
#pragma unroll
        for (int ai = 0; ai < 2; ++ai)
#pragma unroll
            for (int m = 0; m < 4; ++m) { const int row = row0 + ai * HALF + m * 16; const int pos = row < SEQ ? row + NMETA : row - SEQ;
                const f32x4* cs = (const f32x4*)(rope + (size_t)pos * 32 + 16 * (fq & 1));
                const f32x4 c0 = cs[0], c1 = cs[1], c2 = cs[2], c3 = cs[3];
                const float cw[8] = {c0[0], c0[2], c1[0], c1[2], c2[0], c2[2], c3[0], c3[2]}, sw[8] = {c0[1], c0[3], c1[1], c1[3], c2[1], c2[3], c3[1], c3[3]};
                bf16_t* rowp = base + (size_t)row * ldc + col0;
#pragma unroll
                for (int bj = 0; bj < 2; ++bj) { f32x4 v0 = acc[ai][bj][m][0], v1 = acc[ai][bj][m][1], o0, o1;
#pragma unroll
                    for (int e = 0; e < 4; ++e) { const float p0 = __shfl_xor(v0[e], 32), p1 = __shfl_xor(v1[e], 32);
                        o0[e] = v0[e] * cw[e] + sgn * p0 * sw[e]; o1[e] = v1[e] * cw[4 + e] + sgn * p1 * sw[4 + e]; }
                    st8(rowp + bj * HALF, o0, o1); } }
    }
    __device__ __forceinline__ void operator()(const f32x4 (&acc)[2][2][4][2], const Unit& u, int wr, int wc, int fr, int fq) const {
        if (u.pm >= HT) {
            plain(acc, Vt, MPAD, (u.pm - HT - CT_V) * BM + wr * 64 + fr, u.pn * BM + wc * 32 + 8 * fq); return; }
        const int ct = u.pn - HT, row0 = u.pm * BM + wr * 64 + fr, cl = wc * 32 + 8 * fq;
        if (ct < CT_Q) {
            const int col0 = ct * BM + cl;
#pragma unroll
            for (int bj = 0; bj < 2; ++bj) { const f32x4 b0 = *(const f32x4*)(bgate + col0 + bj * HALF), b1 = *(const f32x4*)(bgate + col0 + bj * HALF + 4);
#pragma unroll
                for (int ai = 0; ai < 2; ++ai)
#pragma unroll
                    for (int m = 0; m < 4; ++m) { f32x4 v0 = acc[ai][bj][m][0] + b0, v1 = acc[ai][bj][m][1] + b1;
#pragma unroll
                        for (int e = 0; e < 4; ++e) { v0[e] = sigmoidf_(v0[e]); v1[e] = sigmoidf_(v1[e]); }
                        st8(G + (size_t)(row0 + ai * HALF + m * 16) * (2 * DM) + col0 + bj * HALF, v0, v1); } }
        } else if (ct < CT_K) { roped(acc, Q, ATTW, row0, (ct - CT_Q) * BM + cl, wc, fq);
        } else if (ct < CT_V) { roped(acc, K, KVW, row0, (ct - CT_K) * BM + cl, wc, fq);
        } else { plain(acc, U, UPITCH, row0, (ct - CT_U) * BM + cl); }
    }
};

struct EpiProjA {
    static constexpr bool PERM = true, AFTER_DRAIN = false;
    bf16_t* P1; const bf16_t* G;
    __device__ __forceinline__ void operator()(const f32x4 (&acc)[2][2][4][2], const Unit& u, int wr, int wc, int fr, int fq) const {
        const int row0 = u.pm * BM + wr * 64 + fr, col0 = u.pn * BM + wc * 32 + 8 * fq;
#pragma unroll
        for (int ai = 0; ai < 2; ++ai)
#pragma unroll
            for (int m = 0; m < 4; ++m) { const size_t r = (size_t)(row0 + ai * HALF + m * 16);
#pragma unroll
                for (int bj = 0; bj < 2; ++bj) { const int c = col0 + bj * HALF; const u32x4 g = *(const u32x4*)(G + r * (2 * DM) + c);
                    f32x4 o0 = acc[ai][bj][m][0], o1 = acc[ai][bj][m][1];
                    o0[0] *= bflo(g.x); o0[1] *= bfhi(g.x); o0[2] *= bflo(g.y); o0[3] *= bfhi(g.y); o1[0] *= bflo(g.z); o1[1] *= bfhi(g.z); o1[2] *= bflo(g.w); o1[3] *= bfhi(g.w);
                    EpiIn::st8(P1 + r * DM + c, o0, o1); } }
    }
};
struct EpiProjB {
    static constexpr bool PERM = true, AFTER_DRAIN = false;
    const bf16_t* P1; const bf16_t* G; bf16_t* MX;
    __device__ __forceinline__ void operator()(const f32x4 (&acc)[2][2][4][2], const Unit& u, int wr, int wc, int fr, int fq) const {
        const int row0 = u.pm * BM + wr * 64 + fr, col0 = u.pn * BM + wc * 32 + 8 * fq;
#pragma unroll
        for (int ai = 0; ai < 2; ++ai)
#pragma unroll
            for (int m = 0; m < 4; ++m) { const size_t r = (size_t)(row0 + ai * HALF + m * 16);
#pragma unroll
                for (int bj = 0; bj < 2; ++bj) { const int c = col0 + bj * HALF; const u32x4 g = *(const u32x4*)(G + r * (2 * DM) + DM + c); const u32x4 q = *(const u32x4*)(P1 + r * DM + c);
                    f32x4 o0 = {bflo(q.x), bfhi(q.x), bflo(q.y), bfhi(q.y)}, o1 = {bflo(q.z), bfhi(q.z), bflo(q.w), bfhi(q.w)}; const f32x4 a0 = acc[ai][bj][m][0], a1 = acc[ai][bj][m][1];
                    o0[0] += a0[0] * bflo(g.x); o0[1] += a0[1] * bfhi(g.x); o0[2] += a0[2] * bflo(g.y); o0[3] += a0[3] * bfhi(g.y);
                    o1[0] += a1[0] * bflo(g.z); o1[1] += a1[1] * bfhi(g.z); o1[2] += a1[2] * bflo(g.w); o1[3] += a1[3] * bfhi(g.w);
                    EpiIn::st8(MX + r * DM + c, o0, o1); }
                asm volatile("" ::: "memory"); }
    }
};
template <bool BASE_BF16> struct EpiResid {
    static constexpr bool PERM = true, AFTER_DRAIN = false;
    const float* BASEF; const bf16_t* BASEB; float* OUTF; bf16_t* OUTB; float* SS;
    __device__ __forceinline__ void operator()(const f32x4 (&acc)[2][2][4][2], const Unit& u, int wr, int wc, int fr, int fq) const {
        const int row0 = u.pm * BM + wr * 64 + fr, col0 = u.pn * BM + wc * 32 + 8 * fq;
#pragma unroll
        for (int ai = 0; ai < 2; ++ai)
#pragma unroll
            for (int m = 0; m < 4; ++m) { const size_t r = (size_t)(row0 + ai * HALF + m * 16); float ss = 0.f;
#pragma unroll
                for (int bj = 0; bj < 2; ++bj) { const int c = col0 + bj * HALF; f32x4 o0, o1;
                    if (BASE_BF16) { const u32x4 g = *(const u32x4*)(BASEB + r * DM + c); o0 = (f32x4){bflo(g.x), bfhi(g.x), bflo(g.y), bfhi(g.y)}; o1 = (f32x4){bflo(g.z), bfhi(g.z), bflo(g.w), bfhi(g.w)}; }
                    else { const float* bp = BASEF + r * DM + c; o0 = *(const f32x4*)bp; o1 = *(const f32x4*)(bp + 4); }
                    o0 += acc[ai][bj][m][0]; o1 += acc[ai][bj][m][1];
                    if (BASE_BF16) { float* op = OUTF + r * DM + c; *(f32x4*)op = o0; *(f32x4*)(op + 4) = o1; }
                    else { u32x4 w; w.x = cvt_pk_bf16(o0[0], o0[1]); w.y = cvt_pk_bf16(o0[2], o0[3]); w.z = cvt_pk_bf16(o1[0], o1[1]); w.w = cvt_pk_bf16(o1[2], o1[3]); *(u32x4*)(OUTB + r * DM + c) = w;
                        o0 = (f32x4){bflo(w.x), bfhi(w.x), bflo(w.y), bfhi(w.y)}; o1 = (f32x4){bflo(w.z), bfhi(w.z), bflo(w.w), bfhi(w.w)}; }
                    ss += (o0[0] * o0[0] + o0[1] * o0[1]) + (o0[2] * o0[2] + o0[3] * o0[3]) + (o1[0] * o1[0] + o1[1] * o1[1]) + (o1[2] * o1[2] + o1[3] * o1[3]); }
                ss += __shfl_xor(ss, 16); ss += __shfl_xor(ss, 32);
                if (fq == 0) atomicAdd(SS + r, ss);
                asm volatile("" ::: "memory"); }
    }
};
struct EpiSwiGLU {
    static constexpr bool PERM = true, AFTER_DRAIN = false;
    bf16_t* HID; const float* SS;
    __device__ __forceinline__ void operator()(const f32x4 (&acc)[2][2][4][2], const Unit& u, int wr, int wc, int fr, int fq) const {
        const int row0 = u.pm * BM + wr * 64 + fr, col0 = u.pn * HALF + wc * 32 + 8 * fq;
#pragma unroll
        for (int ai = 0; ai < 2; ++ai)
#pragma unroll
            for (int m = 0; m < 4; ++m) { const size_t r = (size_t)(row0 + ai * HALF + m * 16);
                const float rstd = __builtin_amdgcn_rsqf(SS[r] * (1.0f / DM) + RMS_EPS);
                f32x4 o0, o1;
#pragma unroll
                for (int e = 0; e < 4; ++e) { const float g0 = acc[ai][0][m][0][e] * rstd, u0 = acc[ai][1][m][0][e] * rstd, g1 = acc[ai][0][m][1][e] * rstd, u1 = acc[ai][1][m][1][e] * rstd;
                    o0[e] = g0 * sigmoidf_(g0) * u0; o1[e] = g1 * sigmoidf_(g1) * u1; }
                EpiIn::st8(HID + r * DFF + col0, o0, o1); }
    }
};

#define PG8_EPI_T0 unsigned long long epi_t0_ = 0; do { if ((PROBE_PHASE >> 20) & 1) epi_t0_ = __builtin_amdgcn_s_memrealtime(); } while (0)
#define PG8_EPI_T1 do { if ((PROBE_PHASE >> 20) & 1) epi_acc += __builtin_amdgcn_s_memrealtime() - epi_t0_; } while (0)
template <class Epi, class Sched, bool ALIGN_EPI = false, bool SP2 = false>
__device__ __forceinline__ void gemm_phase(PG8_LAS unsigned char* lds, const Gemm g, const Sched& S, const Epi& E, unsigned long long& epi_acc) {
    const int tid = threadIdx.x, wid = __builtin_amdgcn_readfirstlane(tid >> 6), lane = tid & 63, wr = wid >> 2, wc = wid & 3, fr = lane & 15, fq = lane >> 4;
    const int K = g.K, nt = K / BK;
    unsigned voffA[2], voffB[2];
#pragma unroll
    for (int i = 0; i < 2; ++i) { int R, C; stage_rc(tid * 16 + i * 8192, R, C); const int Rb = Epi::PERM ? ((R & ~31) + perm32(R & 31)) : R;
        voffA[i] = (unsigned)(R * K + C) * 2u; voffB[i] = (unsigned)(Rb * K + C) * 2u; }
    const size_t kstep = (size_t)(BK * 2);
    const size_t hstep = (size_t)HALF * K * 2;
    const size_t tstep = 2 * hstep;
    const unsigned ldsw = (unsigned)wid * 1024u;
    const int aoff = lds_byte(wr * 64 + fr, fq * 8), boff = lds_byte(wc * 32 + fr, fq * 8);
#define PG8_SA(b, h) (((b) * 2 + (h)) * HTB)
#define PG8_SB(b, h) ((4 + (b) * 2 + (h)) * HTB)
#define PG8_STAGE(bufoff, gbase, voff) do { _Pragma("unroll") for (int _i = 0; _i < 2; ++_i) \
        __builtin_amdgcn_global_load_lds((const unsigned*)((const char*)(gbase) + (voff)[_i]), (PG8_LAS unsigned*)(lds + (bufoff) + ldsw + _i * 8192), 16, 0, 0); } while (0)
#define PG8_LDA(dst, b, h) do { _Pragma("unroll") for (int m = 0; m < 4; ++m) _Pragma("unroll") for (int k = 0; k < 2; ++k) dst[m][k] = *(const PG8_LAS bf16x8*)(lds + PG8_SA(b, h) + aoff + m * 2048 + k * 1024); } while (0)
#define PG8_LDB(dst, b, h) do { _Pragma("unroll") for (int n = 0; n < 2; ++n) _Pragma("unroll") for (int k = 0; k < 2; ++k) dst[n][k] = *(const PG8_LAS bf16x8*)(lds + PG8_SB(b, h) + boff + n * 2048 + k * 1024); } while (0)
#define PG8_MMA(ai, bj, At, Bt) do { __builtin_amdgcn_s_setprio(1); _Pragma("unroll") for (int m = 0; m < 4; ++m) _Pragma("unroll") for (int n = 0; n < 2; ++n) _Pragma("unroll") for (int k = 0; k < 2; ++k) \
        acc[ai][bj][m][n] = __builtin_amdgcn_mfma_f32_16x16x32_bf16(Bt[n][k], At[m][k], acc[ai][bj][m][n], 0, 0, 0); __builtin_amdgcn_s_setprio(0); } while (0)
#define PG8_WAIT_V(n) asm volatile("s_waitcnt vmcnt(" #n ")" ::: "memory")
#define PG8_WAIT_L(n) asm volatile("s_waitcnt lgkmcnt(" #n ")" ::: "memory")
#define PG8_BAR __builtin_amdgcn_s_barrier()
#define PG8_SCHED __builtin_amdgcn_sched_barrier(0)
    Unit cur, nxt; int ui = 0;
    if (!S.next(0, cur)) return;
    f32x4 acc[2][2][4][2];
#pragma unroll
    for (int a = 0; a < 2; ++a)
#pragma unroll
        for (int b = 0; b < 2; ++b)
#pragma unroll
            for (int m = 0; m < 4; ++m)
#pragma unroll
                for (int n = 0; n < 2; ++n) acc[a][b][m][n] = (f32x4){0.f, 0.f, 0.f, 0.f};
    bf16x8 At[4][2], B0[2][2], B1[2][2];
    const char* cA = (const char*)g.A + (size_t)cur.pm * tstep; const char* cB = (const char*)g.Bt + (size_t)cur.pn * tstep;
    S.a_ready(cur);
    if constexpr (SP2) {
        PG8_STAGE(PG8_SB(0, 0), cB, voffB); PG8_STAGE(PG8_SB(0, 1), cB + hstep, voffB); PG8_STAGE(PG8_SA(0, 0), cA, voffA); PG8_STAGE(PG8_SA(0, 1), cA + hstep, voffA);
        if (wr == 1) PG8_BAR;
        PG8_WAIT_V(2); PG8_BAR;
        PG8_STAGE(PG8_SB(1, 0), cB + kstep, voffB); PG8_STAGE(PG8_SA(1, 0), cA + kstep, voffA); PG8_STAGE(PG8_SB(1, 1), cB + hstep + kstep, voffB);
        PG8_WAIT_V(6); PG8_BAR;
    } else {
        PG8_STAGE(PG8_SB(0, 0), cB, voffB); PG8_STAGE(PG8_SA(0, 0), cA, voffA); PG8_STAGE(PG8_SB(0, 1), cB + hstep, voffB); PG8_STAGE(PG8_SA(0, 1), cA + hstep, voffA);
        if (wr == 1) PG8_BAR;
        PG8_WAIT_V(4); PG8_BAR;
        PG8_STAGE(PG8_SB(1, 0), cB + kstep, voffB); PG8_STAGE(PG8_SA(1, 0), cA + kstep, voffA); PG8_STAGE(PG8_SB(1, 1), cB + hstep + kstep, voffB);
        PG8_WAIT_V(6); PG8_BAR;
    }
    for (;;) {
        const bool has_next = S.next(ui + 1, nxt);
        const char* nA = has_next ? (const char*)g.A + (size_t)nxt.pm * tstep : cA; const char* nB = has_next ? (const char*)g.Bt + (size_t)nxt.pn * tstep : cB;
        for (int t = 0; t < nt; t += 2) {
            const bool last = (t == nt - 2);
            const char* a1 = cA + (size_t)(t + 1) * kstep;
            const char* a2 = last ? nA : cA + (size_t)(t + 2) * kstep; const char* b2 = last ? nB : cB + (size_t)(t + 2) * kstep;
            const char* a3 = a2 + kstep; const char* b3 = b2 + kstep;
            if (last && has_next) S.a_ready(nxt);
            if constexpr (SP2) {
            PG8_LDB(B0, 0, 0); PG8_LDB(B1, 0, 1); PG8_SCHED; PG8_LDA(At, 0, 0); PG8_STAGE(PG8_SA(1, 1), a1 + hstep, voffA);
            PG8_WAIT_V(8); PG8_WAIT_L(0); PG8_BAR; PG8_MMA(0, 0, At, B0); PG8_MMA(0, 1, At, B1); PG8_BAR; PG8_SCHED;
            PG8_LDA(At, 0, 1); PG8_STAGE(PG8_SB(0, 0), b2, voffB); PG8_STAGE(PG8_SB(0, 1), b2 + hstep, voffB); PG8_STAGE(PG8_SA(0, 0), a2, voffA);
            PG8_WAIT_V(8); PG8_WAIT_L(0); PG8_BAR; PG8_MMA(1, 0, At, B0); PG8_MMA(1, 1, At, B1); PG8_BAR; PG8_SCHED;
            PG8_LDB(B0, 1, 0); PG8_LDB(B1, 1, 1); PG8_SCHED; PG8_LDA(At, 1, 0); PG8_STAGE(PG8_SA(0, 1), a2 + hstep, voffA);
            PG8_WAIT_V(8); PG8_WAIT_L(0); PG8_BAR; PG8_MMA(0, 0, At, B0); PG8_MMA(0, 1, At, B1); PG8_BAR; PG8_SCHED;
            PG8_LDA(At, 1, 1); PG8_STAGE(PG8_SB(1, 0), b3, voffB); PG8_STAGE(PG8_SB(1, 1), b3 + hstep, voffB); PG8_STAGE(PG8_SA(1, 0), a3, voffA);
            PG8_WAIT_V(8); PG8_WAIT_L(0); PG8_BAR; PG8_MMA(1, 0, At, B0); PG8_MMA(1, 1, At, B1); PG8_BAR; PG8_SCHED;
            } else {
            PG8_LDB(B0, 0, 0); PG8_SCHED; PG8_LDA(At, 0, 0); PG8_STAGE(PG8_SA(1, 1), a1 + hstep, voffA);
            PG8_WAIT_L(8); PG8_BAR; PG8_WAIT_L(0); PG8_MMA(0, 0, At, B0); PG8_BAR; PG8_SCHED;
            PG8_LDB(B1, 0, 1); PG8_STAGE(PG8_SB(0, 0), b2, voffB);
            PG8_BAR; PG8_WAIT_L(0); PG8_MMA(0, 1, At, B1); PG8_BAR;
            PG8_LDA(At, 0, 1); PG8_STAGE(PG8_SA(0, 0), a2, voffA);
            PG8_BAR; PG8_WAIT_L(0); PG8_MMA(1, 0, At, B0); PG8_BAR; PG8_SCHED;
            PG8_STAGE(PG8_SB(0, 1), b2 + hstep, voffB);
            PG8_WAIT_V(6); PG8_BAR; PG8_MMA(1, 1, At, B1); PG8_BAR;
            PG8_LDB(B0, 1, 0); PG8_SCHED; PG8_LDA(At, 1, 0); PG8_STAGE(PG8_SA(0, 1), a2 + hstep, voffA);
            PG8_WAIT_L(8); PG8_BAR; PG8_WAIT_L(0); PG8_MMA(0, 0, At, B0); PG8_BAR; PG8_SCHED;
            PG8_LDB(B1, 1, 1); PG8_STAGE(PG8_SB(1, 0), b3, voffB);
            PG8_BAR; PG8_WAIT_L(0); PG8_MMA(0, 1, At, B1); PG8_BAR;
            PG8_LDA(At, 1, 1); PG8_STAGE(PG8_SA(1, 0), a3, voffA);
            PG8_BAR; PG8_WAIT_L(0); PG8_MMA(1, 0, At, B0); PG8_BAR; PG8_SCHED;
            PG8_STAGE(PG8_SB(1, 1), b3 + hstep, voffB);
            PG8_WAIT_V(6); PG8_BAR; PG8_MMA(1, 1, At, B1); PG8_BAR;
            }
        }
        if constexpr (ALIGN_EPI) { if (wr == 0) PG8_BAR; }
        if constexpr (!Epi::AFTER_DRAIN) { PG8_EPI_T0; E(acc, cur, wr, wc, fr, fq); S.done(cur); PG8_EPI_T1; }
        if (!has_next) break;
#pragma unroll
        for (int a = 0; a < 2; ++a)
#pragma unroll
            for (int b = 0; b < 2; ++b)
#pragma unroll
                for (int m = 0; m < 4; ++m)
#pragma unroll
                    for (int n = 0; n < 2; ++n) acc[a][b][m][n] = (f32x4){0.f, 0.f, 0.f, 0.f};
        cur = nxt; cA = nA; cB = nB; ++ui;
        if constexpr (ALIGN_EPI) { if (wr == 1) PG8_BAR; }
    }
    PG8_WAIT_V(0);
    if constexpr (!ALIGN_EPI) { if (wr == 0) PG8_BAR; }
    PG8_BAR;
    if constexpr (Epi::AFTER_DRAIN) { E.fused(acc, cur, wr, wc, fr, fq, lds, wid, lane); S.done(cur); }
#undef PG8_SA
#undef PG8_SB
#undef PG8_STAGE
#undef PG8_LDA
#undef PG8_LDB
#undef PG8_MMA
#undef PG8_WAIT_V
#undef PG8_WAIT_L
#undef PG8_BAR
#undef PG8_SCHED
}

}

constexpr size_t MiB = 1u << 20;
constexpr size_t WS_CTL = 0;
constexpr size_t WS_ROPE = 1 * MiB;
constexpr size_t WS_LW2 = 3 * MiB, WS_LA2 = 4 * MiB, WS_LG2 = 5 * MiB;
constexpr size_t WS_BONUS = 6 * MiB;
constexpr size_t ZERO_BYTES = 8 * MiB;
constexpr size_t SCF = (size_t)LTOK * RC * 4, SCB = (size_t)LTOK * RC * 2;
constexpr size_t WS_H = 8 * MiB, WS_WIN = WS_H + (size_t)MPAD * DM * 2;
constexpr size_t WS_KD0 = 8 * MiB, WS_KD1 = WS_KD0 + SCB, WS_B0 = WS_KD1 + SCB, WS_B1 = WS_B0 + SCB, WS_KK = WS_B1 + SCB, WS_RR = WS_KK + SCB;
constexpr size_t WS_WGU = 8 * MiB;
constexpr size_t WS_G = 216 * MiB, WS_A2 = 216 * MiB;
constexpr size_t WS_Q = 344 * MiB, WS_K = 376 * MiB, WS_VT = 385 * MiB, WS_U = 394 * MiB;
constexpr size_t WS_P1 = 344 * MiB;
constexpr size_t WS_Y = 394 * MiB;
constexpr size_t WS_W0 = 506 * MiB, WS_W1 = WS_W0 + SCF;
constexpr size_t WS_WPA = 506 * MiB, WS_WPR = 522 * MiB, WS_WOUT = 538 * MiB, WS_OATT = 570 * MiB;
constexpr size_t WS_VV = 635 * MiB, WS_GG = 668 * MiB;
constexpr size_t WS_BO = 701 * MiB;
constexpr size_t WS_HID = 701 * MiB, WS_MX = 873 * MiB;
constexpr int NB0 = 513, NB1 = 512, NBT = NB0 + NB1;
constexpr int BO_FA = 0, BO_FH = 4096, BO_FB = 5120, BO_FG = 9216, BO_ITEM = 9472;
constexpr size_t WS_WD = 998 * MiB, WS_ORWKV = 1084 * MiB, WS_END = 1116 * MiB;
static_assert(WS_WIN + (size_t)INWP * DM * 2 <= WS_G && WS_RR + SCB <= WS_G && WS_WGU + (size_t)2 * DFF * DM * 2 <= WS_G, "map: A0");
static_assert(WS_U + (size_t)MPAD * UPITCH * 2 <= WS_W0 && WS_VT + (size_t)KVW * MPAD * 2 <= WS_U && WS_K + (size_t)MPAD * KVW * 2 <= WS_VT && WS_Q + (size_t)SEQ * ATTW * 2 <= WS_K && WS_Y + 2 * SCB <= WS_W0, "map: P1 outputs");
static_assert(WS_W1 + SCF <= WS_VV && WS_OATT + (size_t)SEQ * ATTW * 2 <= WS_VV && WS_VV + SCB <= WS_GG && WS_GG + SCB <= WS_BO && WS_P1 + (size_t)SEQ * DM * 2 <= WS_W0, "map: mid");
static_assert(WS_BO + (size_t)RH * NBT * BO_ITEM <= WS_WD && WS_HID + (size_t)SEQ * DFF * 2 <= WS_MX && WS_MX + (size_t)SEQ * DM * 2 <= WS_WD && WS_WD + (size_t)DM * DFF * 2 <= WS_ORWKV && WS_ORWKV + (size_t)SEQ * RC * 2 <= WS_END, "map: tail");
constexpr int CW_BAR = 4096;
constexpr int CW_SS2 = 65536, CW_SS3 = 65536 + 8192;
static_assert((CW_SS3 + 8192) * 4 <= (int)(1 * MiB), "CTL");

constexpr int RING_BYTES = 131072;
constexpr int LDSCTL_OFF = RING_BYTES, MISC_OFF = LDSCTL_OFF + 320;
constexpr int LDS_BYTES = 147456;

#define GAS __attribute__((address_space(1)))
#define LAS __attribute__((address_space(3)))
typedef unsigned short bf16;
typedef unsigned v4u __attribute__((ext_vector_type(4)));
typedef unsigned v2u __attribute__((ext_vector_type(2)));
typedef float f32x4 __attribute__((ext_vector_type(4)));
typedef float f32x2 __attribute__((ext_vector_type(2)));
typedef float f32x16 __attribute__((ext_vector_type(16)));
typedef short bf16x8 __attribute__((ext_vector_type(8)));
typedef GAS unsigned gu32;
#define RLX_AGENT __ATOMIC_RELAXED, __HIP_MEMORY_SCOPE_AGENT
#define LDS_WAIT() asm volatile("s_waitcnt lgkmcnt(0)" ::: "memory")
__device__ __forceinline__ unsigned pk2(float lo, float hi) { return pg8::cvt_pk_bf16(lo, hi); }
__device__ __forceinline__ unsigned f2bf(float f) { return pg8::cvt_pk_bf16(f, 0.f) & 0xffffu; }
__device__ __forceinline__ float bf2f(bf16 b) { return __uint_as_float(((unsigned)b) << 16); }
using pg8::bflo; using pg8::bfhi; using pg8::sigmoidf_;

#define XB_TMO      128
#define XB_XCNT(j)  (256  + 64 * (j))
#define XB_XSUB(j)  (1280 + 64 * (j))
#define XB_XGEN(j)  (2304 + 64 * (j))
#define XB_TOP      3328
#define XB_TOPGEN   3392
#define XCD_BAR_WORDS 3456
#define XB_SPIN_CAP (1u << 18)

__device__ __forceinline__ unsigned xb_ld(unsigned* p)              { return __hip_atomic_load(p, __ATOMIC_RELAXED, __HIP_MEMORY_SCOPE_AGENT); }
__device__ __forceinline__ unsigned xb_add(unsigned* p, unsigned v) { return __hip_atomic_fetch_add(p, v, __ATOMIC_RELAXED, __HIP_MEMORY_SCOPE_AGENT); }
__device__ __forceinline__ unsigned xb_xcc_id() { return (unsigned)__builtin_amdgcn_s_getreg((3 << 11) | 20) & 0xFu; }
#define XB_SPIN(cond, bar) do { unsigned _sp = 0; while (cond) { __builtin_amdgcn_s_sleep(1); \
    if ((++_sp & 255u) == 0u) { if (xb_ld(&(bar)[XB_TMO])) break; if (_sp > XB_SPIN_CAP) { atomicAdd(&(bar)[XB_TMO], 1u); break; } } } } while (0)

struct XcdBarrier {
    unsigned* bar; unsigned x;
    volatile LAS unsigned* st;
};

__device__ __forceinline__ XcdBarrier xcd_barrier_post(unsigned* bar, volatile LAS unsigned* st) {
    XcdBarrier b; b.bar = bar; b.x = xb_xcc_id(); b.st = st;
    if (threadIdx.x == 0) (void)xb_add(&bar[XB_XCNT(b.x)], 1u);
    return b;
}
__device__ __forceinline__ void xcd_barrier_complete(unsigned* bar, unsigned x, unsigned& nloc, unsigned& nx) {
    const unsigned G = gridDim.x * gridDim.y * gridDim.z;
    unsigned sum, cnt, mine, sp = 0u;
    for (;;) {
        sum = 0u; cnt = 0u; mine = 0u;
#pragma unroll
        for (unsigned j = 0; j < 16; ++j) { const unsigned c = xb_ld(&bar[XB_XCNT(j)]); sum += c; cnt += (c > 0u) ? 1u : 0u; mine = (j == x) ? c : mine; }
        if (sum == G) break;
        __builtin_amdgcn_s_sleep(1);
        if ((++sp & 255u) == 0u) { if (xb_ld(&bar[XB_TMO])) break; if (sp > XB_SPIN_CAP) { atomicAdd(&bar[XB_TMO], 1u); break; } }
    }
    nloc = mine > 0u ? mine : 1u; nx = cnt > 0u ? cnt : 1u;
}

__device__ __forceinline__ void xcd_barrier(const XcdBarrier& b) {
    asm volatile("s_waitcnt vmcnt(0)" ::: "memory");
    __syncthreads();
    if (threadIdx.x == 0) {
        unsigned* bar = b.bar;
        __builtin_amdgcn_s_waitcnt(0);
        unsigned nloc = b.st[0], nx = b.st[1];
        if (nloc == 0u) { xcd_barrier_complete(bar, b.x, nloc, nx); b.st[0] = nloc; b.st[1] = nx; }
        const unsigned old = xb_add(&bar[XB_XSUB(b.x)], 1u);
        const unsigned gen = old / nloc;
        if (old + 1u == (gen + 1u) * nloc) {
            __builtin_amdgcn_fence(__ATOMIC_RELEASE, "agent");
            asm volatile("s_waitcnt vmcnt(0)" ::: "memory");
            const unsigned og = xb_add(&bar[XB_TOP], 1u);
            const unsigned tg = og / nx;
            if (og + 1u == (tg + 1u) * nx) xb_add(&bar[XB_TOPGEN], 1u);
            else XB_SPIN(xb_ld(&bar[XB_TOPGEN]) == tg, bar);
            __builtin_amdgcn_fence(__ATOMIC_ACQUIRE, "agent");
            xb_add(&bar[XB_XGEN(b.x)], 1u);
            asm volatile("s_waitcnt vmcnt(0)" ::: "memory");
        } else {
            XB_SPIN(xb_ld(&bar[XB_XGEN(b.x)]) == gen, bar);
            __builtin_amdgcn_fence(__ATOMIC_ACQUIRE, "agent");
            asm volatile("s_waitcnt vmcnt(0)" ::: "memory");
        }
    }
    __syncthreads();
}


struct Frame {
    LAS unsigned char* lds;
    volatile LAS unsigned* MISC;
    gu32* ctl;
    int tid, lane, wave, G;
    unsigned char* ws;
    const float* in[26];
    float* out;
    unsigned long long pb0, pacc, pacc2;
};
#define FPB0(k) do { if ((PROBE_PHASE >> (k)) & 1) F.pb0 = __builtin_amdgcn_s_memrealtime(); } while (0)
#define FPB1(k) do { if ((PROBE_PHASE >> (k)) & 1) F.pacc += __builtin_amdgcn_s_memrealtime() - F.pb0; } while (0)
__device__ __forceinline__ float wave_sum(float v) {
#pragma unroll
    for (int o = 1; o < 64; o <<= 1) v += __shfl_xor(v, o);
    return v;
}

struct TrDesc { const float* W; bf16* WT; const float* kscale; int K, N, mode, item; };
__device__ __forceinline__ void tr_issue(const TrDesc& d, int lane, float (&wv)[32]) {
    const int nblk = d.N / 32, kb = d.item / nblk, nb = d.item % nblk, k0 = 64 * kb, n0 = 32 * nb;
#pragma unroll
    for (int i = 0; i < 32; ++i) wv[i] = d.W[(size_t)(k0 + 2 * i + (lane >> 5)) * d.N + n0 + (lane & 31)];
}
__device__ __forceinline__ void tr_finish(const TrDesc& d, LAS float* scr, int lane, const float (&wv)[32]) {
    const int nblk = d.N / 32, kb = d.item / nblk, nb = d.item % nblk, k0 = 64 * kb, n0 = 32 * nb;
#pragma unroll
    for (int i = 0; i < 32; ++i) { const int kk = 2 * i + (lane >> 5); float v = wv[i]; if (d.kscale) v *= d.kscale[k0 + kk]; scr[kk * 33 + (lane & 31)] = v; }
    LDS_WAIT(); asm volatile("" ::: "memory");
    const int c = lane & 7;
#pragma unroll
    for (int j = 0; j < 4; ++j) { const int n = (lane >> 3) + 8 * j; const LAS float* s = scr + (8 * c) * 33 + n;
        v4u o; o.x = pk2(s[0 * 33], s[1 * 33]); o.y = pk2(s[2 * 33], s[3 * 33]); o.z = pk2(s[4 * 33], s[5 * 33]); o.w = pk2(s[6 * 33], s[7 * 33]);
        const int nn = n0 + n; const int dr = (d.mode == 0) ? nn : (256 * (nn >> 7) + (nn & 127) + (d.mode == 2 ? 128 : 0));
        *(GAS v4u*)(d.WT + (size_t)dr * d.K + k0 + 8 * c) = o; }
    LDS_WAIT(); asm volatile("" ::: "memory");
}
__device__ __forceinline__ TrDesc conv_desc(Frame& F, int list, int it) {
    TrDesc d; d.kscale = nullptr; d.mode = 0;
    if (list == 0) { d.W = F.in[3]; d.WT = (bf16*)(F.ws + WS_WIN); d.K = DM; d.N = INW; d.item = it; return d; }
    constexpr int I_GU = (DM / 64) * (DFF / 32), I_P = (ATTW / 64) * (DM / 32), I_O = (DM / 64) * (DM / 32);
    int r = it;
    if (r < I_GU) { d.W = F.in[22]; d.WT = (bf16*)(F.ws + WS_WGU); d.K = DM; d.N = DFF; d.kscale = F.in[21]; d.mode = 1; d.item = r; return d; } r -= I_GU;
    if (r < I_GU) { d.W = F.in[23]; d.WT = (bf16*)(F.ws + WS_WGU); d.K = DM; d.N = DFF; d.kscale = F.in[21]; d.mode = 2; d.item = r; return d; } r -= I_GU;
    if (r < I_P) { d.W = F.in[18]; d.WT = (bf16*)(F.ws + WS_WPA); d.K = ATTW; d.N = DM; d.item = r; return d; } r -= I_P;
    if (r < I_P) { d.W = F.in[19]; d.WT = (bf16*)(F.ws + WS_WPR); d.K = RC; d.N = DM; d.item = r; return d; } r -= I_P;
    if (r < I_O) { d.W = F.in[20]; d.WT = (bf16*)(F.ws + WS_WOUT); d.K = DM; d.N = DM; d.item = r; return d; } r -= I_O;
    d.W = F.in[24]; d.WT = (bf16*)(F.ws + WS_WD); d.K = DFF; d.N = DM; d.item = r; return d;
}
__device__ __forceinline__ void convert_loop(Frame& F, LAS float* scr, int list, int first, int stride, int nitems) {
    int it = first; if (it >= nitems) return;
    TrDesc d0 = conv_desc(F, list, it); float wv[32]; tr_issue(d0, F.lane, wv);
    for (;;) { const int itn = it + stride; const bool more = itn < nitems;
        TrDesc d1 = d0; float nv[32];
        if (more) { d1 = conv_desc(F, list, itn); tr_issue(d1, F.lane, nv); }
        tr_finish(d0, scr, F.lane, wv);
        if (!more) break;
        d0 = d1; it = itn;
#pragma unroll
        for (int i = 0; i < 32; ++i) wv[i] = nv[i]; }
}
__device__ __forceinline__ void rms_row_to_bf16(int lane, const float* xrow, const float* w, bf16* orow) {
    const GAS f32x4* xr = (const GAS f32x4*)xrow + lane;
    f32x4 v[16]; float s = 0.f;
#pragma unroll
    for (int j = 0; j < 16; ++j) { v[j] = xr[64 * j]; s += (v[j].x * v[j].x + v[j].y * v[j].y) + (v[j].z * v[j].z + v[j].w * v[j].w); }
    const float rstd = 1.f / sqrtf(wave_sum(s) * (1.f / DM) + RMS_EPS);
    const GAS f32x4* wr = (const GAS f32x4*)w + lane;
    GAS v2u* o8 = (GAS v2u*)orow + lane;
#pragma unroll
    for (int j = 0; j < 16; ++j) { const f32x4 ww = wr[64 * j]; v2u o; o.x = pk2(v[j].x * rstd * ww.x, v[j].y * rstd * ww.y); o.y = pk2(v[j].z * rstd * ww.z, v[j].w * rstd * ww.w); o8[64 * j] = o; }
}
__device__ const double ROPE_INV[16] = {
    1.0000000000000000000000000e+0,
    4.4036660267178047359198331e-1,
    1.9392274474868577334259386e-1,
    8.5397100285765611280149662e-2,
    3.7606030930863935681246092e-2,
    1.6560440080994445548947445e-2,
    7.2926647372171090477661219e-3,
    3.2114459947525910185434889e-3,
    1.4142135623730950488016887e-3,
    6.2277242191459597955502746e-4,
    2.7424817567620731825332265e-4,
    1.2076973741146503832424826e-4,
    5.3182958969449886162502429e-5,
    2.3419998961409341542188076e-5,
    1.0313385377212458859810127e-5,
    4.5416704806078696531998012e-6
};

__device__ __forceinline__ void p0_prologue(Frame& F) {
    LAS float* scr = (LAS float*)(F.lds + F.wave * 16384);
    const int gw = blockIdx.x * 8 + F.wave, NGW = F.G * 8;
    bf16* Wint = (bf16*)(F.ws + WS_WIN); bf16* H = (bf16*)(F.ws + WS_H);
    convert_loop(F, scr, 0, gw, NGW, (DM / 64) * (INW / 32));
    for (int m = gw; m < MPAD + (INWP - INW); m += NGW) {
        if (m < SEQ) rms_row_to_bf16(F.lane, F.in[0] + (size_t)m * DM, F.in[2], H + (size_t)m * DM);
        else if (m < LTOK) rms_row_to_bf16(F.lane, F.in[1] + (size_t)(m - SEQ) * DM, F.in[2], H + (size_t)m * DM);
        else { bf16* row = (m < MPAD) ? H + (size_t)m * DM : Wint + (size_t)(INW + (m - MPAD)) * DM; GAS v4u* o = (GAS v4u*)row + F.lane;
#pragma unroll
            for (int j = 0; j < 8; ++j) o[64 * j] = (v4u){0u, 0u, 0u, 0u}; }
    }
    const int gt = blockIdx.x * 512 + F.tid, NGT = F.G * 512;
    float* rope = (float*)(F.ws + WS_ROPE);
    for (int i = gt; i < LTOK * 16; i += NGT) { const int pos = i >> 4, k = i & 15;
        const double ang = (double)pos * ROPE_INV[k]; const double kq = __builtin_rint(ang * 0.15915494309189535);
        const double red = (ang - kq * 6.28318530717958623) - kq * 2.4492935982947064e-16; const float rf = (float)red;
        rope[2 * i] = cosf(rf); rope[2 * i + 1] = sinf(rf); }
    bf16* w2t = (bf16*)(F.ws + WS_LW2); bf16* a2t = (bf16*)(F.ws + WS_LA2); bf16* g2t = (bf16*)(F.ws + WS_LG2);
    for (int i = gt; i < 2 * 96 * RC; i += NGT) { const int c = i % RC, j = (i / RC) % 96, d = i / (RC * 96);
        w2t[((size_t)d * RC + c) * 96 + j] = (bf16)f2bf(F.in[8][i]); a2t[((size_t)d * RC + c) * 96 + j] = (bf16)f2bf(F.in[10][i]); }
    for (int i = gt; i < 256 * RC; i += NGT) { const int c = i % RC, j = i / RC; g2t[(size_t)c * 256 + j] = (bf16)f2bf(F.in[11][i]); }
}

__device__ __forceinline__ int crow(int r, int hi) { return (r & 3) + 8 * (r >> 2) + 4 * hi; }
__device__ __forceinline__ void attn_phase(Frame& F, const int gw, const int NGW) {
    const bf16* Q = (const bf16*)(F.ws + WS_Q); const bf16* K = (const bf16*)(F.ws + WS_K); const bf16* Vt = (const bf16*)(F.ws + WS_VT); bf16* OA = (bf16*)(F.ws + WS_OATT);
    const float* sink = F.in[17];
    const int hh = F.lane >> 5, r = F.lane & 31;
    constexpr float SC = 0.08838834764831845f * 1.4426950408889634f, L2E = 1.4426950408889634f;
    for (int item = gw; item < 4096; item += NGW) {
        const int sub = item & 3, hq = (item >> 2) & 15, qb = item >> 6, q0 = qb * 128 + sub * 32, hk = hq >> 2;
        bf16x8 bq[8];
        { const bf16* qp = Q + (size_t)(q0 + r) * ATTW + hq * 128 + 8 * hh;
#pragma unroll
          for (int s = 0; s < 8; ++s) bq[s] = *(const bf16x8*)(qp + 16 * s); }
        f32x16 O[4];
#pragma unroll
        for (int dt = 0; dt < 4; ++dt)
#pragma unroll
            for (int i = 0; i < 16; ++i) O[dt][i] = 0.f;
        float m = sink[hq] * L2E, l = (hh == 0) ? 1.f : 0.f;
        const int tlo = (q0 >= 128) ? 0 : 4 - q0 / 32, thi = (q0 + 128 + 32 <= SEQ) ? 8 : 4 + (SEQ - 32 - q0) / 32;
        int ti = tlo;
        bf16x8 ak[8];
        { const int key0 = q0 + 32 * (ti - 4); const bf16* kp = K + (size_t)(key0 + r) * KVW + hk * 128 + 8 * hh;
#pragma unroll
          for (int s = 0; s < 8; ++s) ak[s] = *(const bf16x8*)(kp + 16 * s); }
        for (;;) {
            const bool meta = (ti == 9);
            const int key0 = meta ? SEQ : q0 + 32 * (ti - 4);
            const int tn = (ti < thi) ? ti + 1 : 9; const int keyn = (tn == 9) ? SEQ : q0 + 32 * (tn - 4);
            v2u av[4][2][2]; bf16x8 akn[8];
#pragma unroll
            for (int dt = 0; dt < 4; ++dt) { const bf16* vp = Vt + (size_t)(hk * 128 + 32 * dt + r) * MPAD + key0 + 4 * hh;
#pragma unroll
                for (int s2 = 0; s2 < 2; ++s2) { av[dt][s2][0] = *(const v2u*)(vp + 16 * s2); av[dt][s2][1] = *(const v2u*)(vp + 16 * s2 + 8); } }
            { const bf16* kp = K + (size_t)(keyn + r) * KVW + hk * 128 + 8 * hh;
#pragma unroll
              for (int s = 0; s < 8; ++s) akn[s] = *(const bf16x8*)(kp + 16 * s); }
            f32x16 st;
#pragma unroll
            for (int i = 0; i < 16; ++i) st[i] = 0.f;
#pragma unroll
            for (int s = 0; s < 8; ++s) st = __builtin_amdgcn_mfma_f32_32x32x16_bf16(ak[s], bq[s], st, 0, 0, 0);
            float tmax = -__builtin_inff();
#pragma unroll
            for (int i = 0; i < 16; ++i) { const int kr = crow(i, hh); bool ok;
                if (meta) ok = kr < NMETA; else { const int dlt = (key0 + kr) - (q0 + r); ok = (dlt >= -128) && (dlt <= 128); }
                const float t = ok ? st[i] * SC : -__builtin_inff(); st[i] = t; tmax = fmaxf(tmax, t); }
            tmax = fmaxf(tmax, __shfl_xor(tmax, 32));
            const float mn = fmaxf(m, tmax), alpha = __builtin_amdgcn_exp2f(m - mn); m = mn;
            float ps = 0.f;
#pragma unroll
            for (int i = 0; i < 16; ++i) { const float p = __builtin_amdgcn_exp2f(st[i] - mn); st[i] = p; ps += p; }
            l = l * alpha + ps;
#pragma unroll
            for (int dt = 0; dt < 4; ++dt)
#pragma unroll
                for (int i = 0; i < 16; ++i) O[dt][i] *= alpha;
            bf16x8 pb[2];
#pragma unroll
            for (int s2 = 0; s2 < 2; ++s2) { v4u w; w.x = pg8::cvt_pk_bf16(st[8 * s2 + 0], st[8 * s2 + 1]); w.y = pg8::cvt_pk_bf16(st[8 * s2 + 2], st[8 * s2 + 3]);
                w.z = pg8::cvt_pk_bf16(st[8 * s2 + 4], st[8 * s2 + 5]); w.w = pg8::cvt_pk_bf16(st[8 * s2 + 6], st[8 * s2 + 7]); pb[s2] = __builtin_bit_cast(bf16x8, w); }
#pragma unroll
            for (int dt = 0; dt < 4; ++dt)
#pragma unroll
                for (int s2 = 0; s2 < 2; ++s2) { const v4u w = {av[dt][s2][0].x, av[dt][s2][0].y, av[dt][s2][1].x, av[dt][s2][1].y};
                    O[dt] = __builtin_amdgcn_mfma_f32_32x32x16_bf16(__builtin_bit_cast(bf16x8, w), pb[s2], O[dt], 0, 0, 0); }
            if (meta) break;
            ti = tn;
#pragma unroll
            for (int s = 0; s < 8; ++s) ak[s] = akn[s];
        }
        l += __shfl_xor(l, 32);
        const float inv = 1.0f / l;
        bf16* op = OA + (size_t)(q0 + r) * ATTW + hq * 128 + 4 * hh;
#pragma unroll
        for (int dt = 0; dt < 4; ++dt)
#pragma unroll
            for (int g4 = 0; g4 < 4; ++g4) { v2u w; w.x = pg8::cvt_pk_bf16(O[dt][4 * g4 + 0] * inv, O[dt][4 * g4 + 1] * inv); w.y = pg8::cvt_pk_bf16(O[dt][4 * g4 + 2] * inv, O[dt][4 * g4 + 3] * inv);
                *(v2u*)(op + 32 * dt + 8 * g4) = w; }
    }
}

__device__ __forceinline__ int tok2row(int t) { return t < NMETA ? SEQ + t : t - NMETA; }
struct Sh8 { v4u uc, up, un; };
__device__ __forceinline__ Sh8 shift8_ld(const bf16* U, int t, int col) {
    const int tc = t < LTOK ? t : LTOK - 1, tp = (t >= 1 && t - 1 < LTOK) ? t - 1 : 0, tn = t + 1 < LTOK ? t + 1 : LTOK - 1;
    Sh8 s; s.uc = *(const v4u*)(U + (size_t)tok2row(tc) * UPITCH + col); s.up = *(const v4u*)(U + (size_t)tok2row(tp) * UPITCH + col); s.un = *(const v4u*)(U + (size_t)tok2row(tn) * UPITCH + col); return s; }
__device__ __forceinline__ void shift8_fin(const Sh8& s, int t, int col, const float* mu_p, const float* mu_n, float (&x)[8]) {
    const v4u zz = {0u, 0u, 0u, 0u};
    const v4u uc = t < LTOK ? s.uc : zz, up = (t >= 1 && t - 1 < LTOK) ? s.up : zz, un = t + 1 < LTOK ? s.un : zz;
    const f32x4 mp0 = *(const f32x4*)(mu_p + col), mp1 = *(const f32x4*)(mu_p + col + 4), mn0 = *(const f32x4*)(mu_n + col), mn1 = *(const f32x4*)(mu_n + col + 4);
    const unsigned ucw[4] = {uc.x, uc.y, uc.z, uc.w}, upw[4] = {up.x, up.y, up.z, up.w}, unw[4] = {un.x, un.y, un.z, un.w};
    const float mpw[8] = {mp0[0], mp0[1], mp0[2], mp0[3], mp1[0], mp1[1], mp1[2], mp1[3]}, mnw[8] = {mn0[0], mn0[1], mn0[2], mn0[3], mn1[0], mn1[1], mn1[2], mn1[3]};
#pragma unroll
    for (int e = 0; e < 8; ++e) { const float c0 = (e & 1) ? bfhi(ucw[e >> 1]) : bflo(ucw[e >> 1]), p0 = (e & 1) ? bfhi(upw[e >> 1]) : bflo(upw[e >> 1]), n0 = (e & 1) ? bfhi(unw[e >> 1]) : bflo(unw[e >> 1]);
        x[e] = c0 + mpw[e] * (p0 - c0) + mnw[e] * (n0 - c0); }
}
__device__ __forceinline__ void flush_bf16(const LAS bf16* tile, bf16* ARR, int t0, int cbase, int lane) {
#pragma unroll
    for (int h = 0; h < 2; ++h) { const int row = (lane >> 2) + 16 * h, ch = lane & 3; const v4u v = *(const LAS v4u*)(tile + row * 32 + 8 * ch);
        if (t0 + row < LTOK) *(v4u*)(ARR + (size_t)(t0 + row) * RC + cbase + 8 * ch) = v; }
}
__device__ __forceinline__ void flush_f32(const LAS float* tile, float* ARR, int t0, int cbase, int lane) {
#pragma unroll
    for (int h = 0; h < 4; ++h) { const int row = (lane >> 3) + 8 * h, ch = lane & 7; const f32x4 v = *(const LAS f32x4*)(tile + row * 32 + 4 * ch);
        if (t0 + row < LTOK) *(f32x4*)(ARR + (size_t)(t0 + row) * RC + cbase + 4 * ch) = v; }
}
__device__ __forceinline__ void prep_phase(Frame& F) {
    constexpr int XS = 648;
    LAS bf16* Xs = (LAS bf16*)F.lds;
    LAS bf16* Kt = (LAS bf16*)(F.lds + 41472 + F.wave * 8192);
    LAS bf16* Ot = Kt + 2048;
    const bf16* U = (const bf16*)(F.ws + WS_U);
    const float* mu_p = F.in[5]; const float* mu_n = F.in[6];
    const bf16* w2t = (const bf16*)(F.ws + WS_LW2); const bf16* a2t = (const bf16*)(F.ws + WS_LA2); const bf16* g2t = (const bf16*)(F.ws + WS_LG2);
    float* W0 = (float*)(F.ws + WS_W0); float* W1 = (float*)(F.ws + WS_W1);
    bf16* KD0 = (bf16*)(F.ws + WS_KD0); bf16* KD1 = (bf16*)(F.ws + WS_KD1); bf16* B0 = (bf16*)(F.ws + WS_B0); bf16* B1 = (bf16*)(F.ws + WS_B1);
    bf16* KK = (bf16*)(F.ws + WS_KK); bf16* RR = (bf16*)(F.ws + WS_RR); bf16* VV = (bf16*)(F.ws + WS_VV); bf16* GG = (bf16*)(F.ws + WS_GG);
    const int hh = F.lane >> 5, r = F.lane & 31;
    for (int unit = blockIdx.x; unit < 257 * 4; unit += F.G) {
        const int tt = unit >> 2, t0 = tt * 32, hd = (unit & 3) * 8 + F.wave;
        __syncthreads();
        FPB0(15);
        { Sh8 sx[5];
#pragma unroll
          for (int it = 0; it < 5; ++it) { const int ci = F.tid + 512 * it; sx[it] = shift8_ld(U, t0 + ci / 80, 3 * RC + 8 * (ci % 80)); }
#pragma unroll
          for (int it = 0; it < 5; ++it) { const int ci = F.tid + 512 * it, tl = ci / 80, ch = ci % 80;
            float x[8]; shift8_fin(sx[it], t0 + tl, 3 * RC + 8 * ch, mu_p, mu_n, x);
#pragma unroll
            for (int e = 0; e < 8; ++e) { float v = x[e];
                if (ch < 24) { const float ex = __expf(2.0f * v); v = 1.0f - 2.0f / (ex + 1.0f); }
                else if (ch >= 48) v = sigmoidf_(v);
                x[e] = v; }
            v4u o; o.x = pk2(x[0], x[1]); o.y = pk2(x[2], x[3]); o.z = pk2(x[4], x[5]); o.w = pk2(x[6], x[7]);
            *(LAS v4u*)(Xs + tl * XS + 8 * ch) = o; } }
        { const int c8 = hd * 64 + 8 * (F.lane & 7);
#pragma unroll
          for (int st = 0; st < 3; ++st) { const int col = (st == 0 ? RC : st == 1 ? 0 : 2 * RC) + c8; Sh8 sq[4];
#pragma unroll
            for (int q = 0; q < 4; ++q) sq[q] = shift8_ld(U, t0 + (F.lane >> 3) + 8 * q, col);
#pragma unroll
            for (int q = 0; q < 4; ++q) { const int tl = (F.lane >> 3) + 8 * q, tq = t0 + tl; float x[8]; shift8_fin(sq[q], tq, col, mu_p, mu_n, x);
                v4u o; o.x = pk2(x[0], x[1]); o.y = pk2(x[2], x[3]); o.z = pk2(x[4], x[5]); o.w = pk2(x[6], x[7]);
                if (st == 0) *(LAS v4u*)(Kt + tl * 64 + 8 * (F.lane & 7)) = o;
                else if (tq < LTOK) *(v4u*)((st == 1 ? RR : VV) + (size_t)tq * RC + c8) = o; } } }
        __syncthreads();
        FPB1(15); FPB0(16);
        float kp[2][16], ss[16];
#pragma unroll
        for (int i = 0; i < 16; ++i) ss[i] = 0.f;
#pragma unroll
        for (int ct = 0; ct < 2; ++ct) { const int c = hd * 64 + 32 * ct + r; const float kkw = F.in[12][c];
#pragma unroll
            for (int i = 0; i < 16; ++i) { kp[ct][i] = bf2f(Kt[crow(i, hh) * 64 + 32 * ct + r]); const float kr = kp[ct][i] * kkw; ss[i] += kr * kr; } }
#pragma unroll
        for (int i = 0; i < 16; ++i) {
#pragma unroll
            for (int o = 1; o < 32; o <<= 1) ss[i] += __shfl_xor(ss[i], o);
            ss[i] = 1.0f / fmaxf(sqrtf(ss[i]), 1e-12f); }
#define LDF(dst, ptr, n) do { _Pragma("unroll") for (int s_ = 0; s_ < (n); ++s_) dst[s_] = *(const bf16x8*)((ptr) + 16 * s_); } while (0)
#define MMF(frag, xoff, n) do { _Pragma("unroll") for (int i_ = 0; i_ < 16; ++i_) acc[i_] = 0.f; const LAS bf16* ap_ = Xs + r * XS + (xoff) + 8 * hh; \
            _Pragma("unroll") for (int s_ = 0; s_ < (n); ++s_) acc = __builtin_amdgcn_mfma_f32_32x32x16_bf16(*(const LAS bf16x8*)(ap_ + 16 * s_), frag[s_], acc, 0, 0, 0); } while (0)
#pragma unroll
        for (int ct = 0; ct < 2; ++ct) {
            const int c = hd * 64 + 32 * ct + r, cb = hd * 64 + 32 * ct;
            const float kkw = F.in[12][c], kaw = F.in[13][c];
            const bf16* pa0 = a2t + (size_t)c * 96 + 8 * hh; const bf16* pa1 = a2t + ((size_t)RC + c) * 96 + 8 * hh;
            const bf16* pw0 = w2t + (size_t)c * 96 + 8 * hh; const bf16* pw1 = w2t + ((size_t)RC + c) * 96 + 8 * hh; const bf16* pg = g2t + (size_t)c * 256 + 8 * hh;
            bf16x8 fa[6], fg[16]; f32x16 acc; float kk[16];
            LDF(fa, pa0, 6);
#pragma unroll
            for (int i = 0; i < 16; ++i) { kk[i] = kp[ct][i] * kkw * ss[i]; Ot[crow(i, hh) * 32 + r] = (bf16)f2bf(kk[i]); }
            flush_bf16(Ot, KK, t0, cb, F.lane);
#pragma unroll
            for (int d = 0; d < 2; ++d) {
                if (d == 0) { MMF(fa, 192, 6); LDF(fa, pa1, 6); } else { MMF(fa, 288, 6); LDF(fa, pw0, 6); }
                const float a0 = F.in[9][d * RC + c];
#pragma unroll
                for (int i = 0; i < 16; ++i) { acc[i] = sigmoidf_(a0 + acc[i]); Ot[crow(i, hh) * 32 + r] = (bf16)f2bf(kp[ct][i] * (1.0f + (acc[i] - 1.0f) * kaw)); }
                flush_bf16(Ot, d ? KD1 : KD0, t0, cb, F.lane);
#pragma unroll
                for (int i = 0; i < 16; ++i) Ot[crow(i, hh) * 32 + r] = (bf16)f2bf(kk[i] * acc[i]);
                flush_bf16(Ot, d ? B1 : B0, t0, cb, F.lane);
            }
#pragma unroll
            for (int d = 0; d < 2; ++d) {
                if (d == 0) { MMF(fa, 0, 6); LDF(fa, pw1, 6); } else { MMF(fa, 96, 6); LDF(fg, pg, 16); }
                const float w0 = F.in[7][d * RC + c]; LAS float* Of = (LAS float*)Ot;
#pragma unroll
                for (int i = 0; i < 16; ++i) Of[crow(i, hh) * 32 + r] = __expf(-0.6065306597126334f * sigmoidf_(w0 + acc[i]));
                flush_f32(Of, d ? W1 : W0, t0, cb, F.lane);
            }
            MMF(fg, 384, 16);
#pragma unroll
            for (int i = 0; i < 16; ++i) Ot[crow(i, hh) * 32 + r] = (bf16)f2bf(acc[i]);
            flush_bf16(Ot, GG, t0, cb, F.lane);
        }
#undef LDF
#undef MMF
        FPB1(16);
    }
    __syncthreads();
}

__device__ __forceinline__ int blk_tok(int d, int blk, int u) { return d ? (LTOK - 1 - 16 * blk - u) : (16 * blk + u); }
__device__ __forceinline__ size_t bo_item(int hd, int d, int blk) { return (size_t)(hd * NBT + (d ? NB0 : 0) + blk) * BO_ITEM; }
__device__ __forceinline__ v4u pack8(const float (&x)[8]) { v4u o; o.x = pk2(x[0], x[1]); o.y = pk2(x[2], x[3]); o.z = pk2(x[4], x[5]); o.w = pk2(x[6], x[7]); return o; }
__device__ __forceinline__ void blockprep_phase(Frame& F) {
    LAS unsigned char* wl = F.lds + F.wave * 16384;
    constexpr int LP = 72;
    LAS bf16* LT = (LAS bf16*)wl;
    LAS float* GM = (LAS float*)(wl + 9216);
    LAS float* TM = (LAS float*)(wl + 13312);
    LAS float* TB = (LAS float*)(wl + 14336);
    LAS float* AH = (LAS float*)(wl + 15360);
    const float* W0 = (const float*)(F.ws + WS_W0); const float* W1 = (const float*)(F.ws + WS_W1);
    const bf16* KD0 = (const bf16*)(F.ws + WS_KD0); const bf16* KD1 = (const bf16*)(F.ws + WS_KD1); const bf16* B0 = (const bf16*)(F.ws + WS_B0); const bf16* B1 = (const bf16*)(F.ws + WS_B1);
    const bf16* KK = (const bf16*)(F.ws + WS_KK); const bf16* RR = (const bf16*)(F.ws + WS_RR);
    float* BON = (float*)(F.ws + WS_BONUS); unsigned char* BO = F.ws + WS_BO;
    const int gw = blockIdx.x * 8 + F.wave, NGW = F.G * 8, j = F.lane, hh = F.lane >> 5, r31 = F.lane & 31, c16 = F.lane & 15;
    for (int it = gw; it < RH * NBT; it += NGW) {
        const int hd = it / NBT, rem = it % NBT, d = rem >= NB0 ? 1 : 0, blk = d ? rem - NB0 : rem, c = hd * 64 + j;
        const float* Wd = d ? W1 : W0; const bf16* KDd = d ? KD1 : KD0; const bf16* Bd = d ? B1 : B0;
        float kt[16], rt[16], kdh[16], bh[16]; float G15;
        { float G[16];
          { float g = 1.f;
#pragma unroll
            for (int u = 0; u < 16; ++u) { g *= Wd[(size_t)blk_tok(d, blk, u) * RC + c]; G[u] = g; } }
          asm volatile("" ::: "memory");
          const float rkw = F.in[14][c];
#pragma unroll
          for (int u = 0; u < 16; ++u) { const size_t o = (size_t)blk_tok(d, blk, u) * RC + c; kdh[u] = bf2f(KDd[o]); rt[u] = bf2f(RR[o]); }
#pragma unroll
          for (int u = 0; u < 16; ++u) { const float s = wave_sum(rt[u] * kdh[u] * rkw); if (F.lane == 0) atomicAdd(BON + (size_t)blk_tok(d, blk, u) * RH + hd, s);
              kdh[u] = kdh[u] / G[u]; rt[u] = rt[u] * G[u]; LT[(0 * 16 + u) * LP + j] = (bf16)f2bf(kdh[u]); LT[(3 * 16 + u) * LP + j] = (bf16)f2bf(rt[u]); }
          asm volatile("" ::: "memory");
#pragma unroll
          for (int u = 0; u < 16; ++u) { const size_t o = (size_t)blk_tok(d, blk, u) * RC + c; kt[u] = bf2f(KK[o]); bh[u] = bf2f(Bd[o]); }
#pragma unroll
          for (int u = 0; u < 16; ++u) { kt[u] = kt[u] * (u ? G[u - 1] : 1.f); bh[u] = bh[u] / G[u]; LT[(2 * 16 + u) * LP + j] = (bf16)f2bf(kt[u]); LT[(1 * 16 + u) * LP + j] = (bf16)f2bf(bh[u]); }
          G15 = G[15]; }
        asm volatile("" ::: "memory");
        f32x16 gacc;
#pragma unroll
        for (int i = 0; i < 16; ++i) gacc[i] = 0.f;
        { const LAS bf16* ap = LT + ((r31 < 16 ? 0 : 1) * 16 + (r31 & 15)) * LP + 8 * hh; const LAS bf16* bp = LT + ((r31 < 16 ? 2 : 3) * 16 + (r31 & 15)) * LP + 8 * hh;
#pragma unroll
          for (int s = 0; s < 4; ++s) gacc = __builtin_amdgcn_mfma_f32_32x32x16_bf16(*(const LAS bf16x8*)(ap + 16 * s), *(const LAS bf16x8*)(bp + 16 * s), gacc, 0, 0, 0); }
        float ga[16];
#pragma unroll
        for (int i = 0; i < 16; ++i) ga[i] = gacc[i];
#define RL(x, ln) __builtin_bit_cast(float, __builtin_amdgcn_readlane(__builtin_bit_cast(int, (x)), (ln)))
#define GREG(m) (4 * ((m) >> 3) + ((m) & 3))
#define GLN(m) (32 * (((m) >> 2) & 1))
#define A_(m, u)  RL(ga[GREG(m)], (u) + GLN(m))
#define B_(m, u)  RL(ga[8 + GREG(m)], (u) + GLN(m))
        float Tr[16];
#pragma unroll
        for (int m = 15; m >= 0; --m) { float s = (c16 == m) ? 1.f : 0.f;
#pragma unroll
            for (int u = m + 1; u < 16; ++u) s -= B_(m, u) * Tr[u];
            Tr[m] = s; }
        float bpc[16], apc[16];
#pragma unroll
        for (int u = 0; u < 16; ++u) { const int src = 16 + c16 + GLN(u); const float vb = __shfl(ga[8 + GREG(u)], src), va = __shfl(ga[GREG(u)], src);
            bpc[u] = (u <= c16) ? vb : 0.f; apc[u] = (u <= c16) ? va : 0.f; }
#pragma unroll
        for (int m = 0; m < 16; ++m) { float s = 0.f;
#pragma unroll
            for (int u = m; u < 16; ++u) s += RL(Tr[m], u) * bpc[u];
            bpc[m] = s; }
#pragma unroll
        for (int m = 0; m < 16; ++m) { float s = apc[m];
#pragma unroll
            for (int u = m + 1; u < 16; ++u) s -= A_(m, u) * bpc[u];
            AH[m * 16 + c16] = s; }
        float M1[16], M2[16];
#pragma unroll
        for (int m = 0; m < 16; ++m) { float s = 0.f;
#pragma unroll
            for (int u = m; u < 16; ++u) s += RL(Tr[m], u) * bh[u];
            M1[m] = s * G15; }
#pragma unroll
        for (int m = 0; m < 16; ++m) { float s = kdh[m] * G15;
#pragma unroll
            for (int u = m + 1; u < 16; ++u) s -= A_(m, u) * M1[u];
            M2[m] = s; }
#pragma unroll
        for (int u = 0; u < 16; ++u) { float s = rt[u];
#pragma unroll
            for (int m = 0; m <= u; ++m) s -= RL(bpc[m], u) * kt[m];
            rt[u] = s; }
#undef RL
#undef GREG
#undef GLN
#undef A_
#undef B_
        asm volatile("" ::: "memory");
        unsigned char* base = BO + bo_item(hd, d, blk);
        { const int a = j >> 5, jp = j & 31;
#pragma unroll
          for (int h2 = 0; h2 < 2; ++h2) { float x0[8], x1[8];
#pragma unroll
              for (int e = 0; e < 8; ++e) { x0[e] = -M1[8 * (e >> 2) + 4 * h2 + (e & 3)]; x1[e] = M2[8 * h2 + e]; }
              *(v4u*)(base + BO_FB + ((a * 2 + 0) * 64 + jp + 32 * h2) * 16) = pack8(x0); *(v4u*)(base + BO_FB + ((a * 2 + 1) * 64 + jp + 32 * h2) * 16) = pack8(x1); } }
        *(float*)(base + BO_FG + 4 * j) = G15;
#pragma unroll
        for (int u = 0; u < 16; ++u) { LT[u * LP + j] = (bf16)f2bf(kt[u]); LT[(16 + u) * LP + j] = (bf16)f2bf(rt[u]); }
#pragma unroll
        for (int ks = 0; ks < 4; ++ks) { const int j0 = 32 * (ks >> 1) + 16 * (ks & 1) + 4 * hh; const v2u lo = *(const LAS v2u*)(LT + r31 * LP + j0), hi = *(const LAS v2u*)(LT + r31 * LP + j0 + 8);
            *(v4u*)(base + BO_FA + (ks * 64 + F.lane) * 16) = (v4u){lo.x, lo.y, hi.x, hi.y}; }
        { float x[8];
#pragma unroll
          for (int e = 0; e < 8; ++e) x[e] = (r31 >= 16) ? AH[(8 * hh + e) * 16 + (r31 - 16)] : 0.f;
          *(v4u*)(base + BO_FH + F.lane * 16) = pack8(x); }
        asm volatile("" ::: "memory");
    }
}

constexpr int N_SCAN_WAVES = 128;
constexpr int N_CONVERT_ITEMS = 2 * (DM / 64) * (DFF / 32) + 2 * (ATTW / 64) * (DM / 32) + (DM / 64) * (DM / 32) + (DFF / 64) * (DM / 32);
constexpr int SR_SLOTS = 9, SR_STRIDE = 11264, SR_FV = 10240, SR_FLAGS = SR_SLOTS * SR_STRIDE, SR_WSCR = SR_FLAGS + 512, SR_NL = 4;
struct LdSet { v4u p[10]; unsigned short v[8]; };
__device__ __forceinline__ void sr_issue(LdSet& s, const unsigned char* item, const bf16* VV, int hd, int d, int blk, int ih, int lane) {
#pragma unroll
    for (int k = 0; k < 10; ++k) { const int pc = k * 64 + lane; s.p[k] = *(const v4u*)(item + (pc < BO_ITEM / 16 ? pc : BO_ITEM / 16 - 1) * 16); }
    const int hh = lane >> 5, il = lane & 31;
#pragma unroll
    for (int e = 0; e < 8; ++e) s.v[e] = VV[(size_t)blk_tok(d, blk, 8 * hh + e) * RC + hd * 64 + 32 * ih + il];
}
__device__ __forceinline__ void sr_write(const LdSet& s, LAS unsigned char* slot, int lane) {
#pragma unroll
    for (int k = 0; k < 10; ++k) *(LAS v4u*)(slot + (k * 64 + lane) * 16) = s.p[k];
    const v4u vw = {(unsigned)s.v[0] | ((unsigned)s.v[1] << 16), (unsigned)s.v[2] | ((unsigned)s.v[3] << 16), (unsigned)s.v[4] | ((unsigned)s.v[5] << 16), (unsigned)s.v[6] | ((unsigned)s.v[7] << 16)};
    *(LAS v4u*)(slot + SR_FV + lane * 16) = vw;
}
__device__ __forceinline__ bf16x8 pack_half(const f32x16& x, int s) {
    const v4u w = {pk2(x[8 * s + 0], x[8 * s + 1]), pk2(x[8 * s + 2], x[8 * s + 3]), pk2(x[8 * s + 4], x[8 * s + 5]), pk2(x[8 * s + 6], x[8 * s + 7])}; return __builtin_bit_cast(bf16x8, w); }
__device__ __forceinline__ void scan_phase(Frame& F) {
    const bf16* VV = (const bf16*)(F.ws + WS_VV); bf16* Y = (bf16*)(F.ws + WS_Y); const unsigned char* BO = F.ws + WS_BO;
    const bool sblock = (int)blockIdx.x < N_SCAN_WAVES;
    volatile LAS unsigned* FL = (volatile LAS unsigned*)(F.lds + SR_FLAGS);
    constexpr unsigned SPIN_CAP = 1u << 22;
    __syncthreads();
    if (F.tid < 128) FL[F.tid] = 0u;
    __syncthreads();
    const int pair = (int)blockIdx.x >> 1, ih = (int)blockIdx.x & 1, hd = pair >> 1, d = pair & 1, nblk = d ? NB1 : NB0, hh = F.lane >> 5, il = F.lane & 31;
    if (sblock && F.wave == 0) {
        __builtin_amdgcn_s_setprio(3);
        f32x16 St[2];
#pragma unroll
        for (int a = 0; a < 2; ++a)
#pragma unroll
            for (int i = 0; i < 16; ++i) St[a][i] = 0.f;
        FPB0(17);
        for (int blk = 0; blk < nblk; ++blk) {
            const int sl = blk % SR_SLOTS; const LAS unsigned char* slot = F.lds + sl * SR_STRIDE;
            { unsigned sp = 0; while (FL[sl] != (unsigned)(blk + 1)) { __builtin_amdgcn_s_sleep(1); if (++sp > SPIN_CAP) break; } }
            asm volatile("" ::: "memory");
            bf16x8 fa[4], fb[2][2]; f32x4 gm[2][4];
#pragma unroll
            for (int ks = 0; ks < 4; ++ks) fa[ks] = *(const LAS bf16x8*)(slot + BO_FA + (ks * 64 + F.lane) * 16);
            const bf16x8 fh = *(const LAS bf16x8*)(slot + BO_FH + F.lane * 16), vf = *(const LAS bf16x8*)(slot + SR_FV + F.lane * 16);
#pragma unroll
            for (int a = 0; a < 2; ++a)
#pragma unroll
                for (int k = 0; k < 2; ++k) fb[a][k] = *(const LAS bf16x8*)(slot + BO_FB + ((a * 2 + k) * 64 + F.lane) * 16);
#pragma unroll
            for (int a = 0; a < 2; ++a)
#pragma unroll
                for (int q = 0; q < 4; ++q) gm[a][q] = *(const LAS f32x4*)(slot + BO_FG + (32 * a + 8 * q + 4 * hh) * 4);
            asm volatile("s_waitcnt lgkmcnt(0)" ::: "memory");
            if (F.lane == 0) FL[16] = (unsigned)(blk + 1);
            f32x16 acc;
#pragma unroll
            for (int i = 0; i < 16; ++i) acc[i] = 0.f;
            acc = __builtin_amdgcn_mfma_f32_32x32x16_bf16(fh, vf, acc, 0, 0, 0);
#pragma unroll
            for (int a = 0; a < 2; ++a)
#pragma unroll
                for (int s = 0; s < 2; ++s) acc = __builtin_amdgcn_mfma_f32_32x32x16_bf16(fa[2 * a + s], pack_half(St[a], s), acc, 0, 0, 0);
#pragma unroll
            for (int e = 0; e < 8; ++e) { const int u = 8 * (e >> 2) + 4 * hh + (e & 3);
                Y[((size_t)d * LTOK + blk_tok(d, blk, u)) * RC + hd * 64 + 32 * ih + il] = (bf16)f2bf(acc[8 + e]); }
            const bf16x8 zb = pack_half(acc, 0);
#pragma unroll
            for (int a = 0; a < 2; ++a) {
#pragma unroll
                for (int i = 0; i < 16; ++i) St[a][i] *= gm[a][i >> 2][i & 3];
                St[a] = __builtin_amdgcn_mfma_f32_32x32x16_bf16(fb[a][0], zb, St[a], 0, 0, 0);
                St[a] = __builtin_amdgcn_mfma_f32_32x32x16_bf16(fb[a][1], vf, St[a], 0, 0, 0);
            }
        }
        FPB1(17);
        __builtin_amdgcn_s_setprio(0);
    } else if (sblock && F.wave <= SR_NL) {
        __builtin_amdgcn_s_setprio(2);
        const int lw = F.wave - 1;
        LdSet sA, sB;
#define SR_PUT(set, b_) do { const int sl_ = (b_) % SR_SLOTS; if ((b_) >= SR_SLOTS) { unsigned sp_ = 0; while (FL[16] < (unsigned)((b_) - SR_SLOTS + 1)) { __builtin_amdgcn_s_sleep(1); if (++sp_ > SPIN_CAP) break; } } \
            asm volatile("" ::: "memory"); sr_write(set, F.lds + sl_ * SR_STRIDE, F.lane); asm volatile("s_waitcnt lgkmcnt(0)" ::: "memory"); if (F.lane == 0) FL[sl_] = (unsigned)((b_) + 1); } while (0)
        int bA = lw, bB = lw + SR_NL;
        if (bA < nblk) sr_issue(sA, BO + bo_item(hd, d, bA), VV, hd, d, bA, ih, F.lane);
        if (bB < nblk) sr_issue(sB, BO + bo_item(hd, d, bB), VV, hd, d, bB, ih, F.lane);
        while (bA < nblk) {
            SR_PUT(sA, bA); bA += 2 * SR_NL; if (bA < nblk) sr_issue(sA, BO + bo_item(hd, d, bA), VV, hd, d, bA, ih, F.lane);
            if (bB < nblk) { SR_PUT(sB, bB); bB += 2 * SR_NL; if (bB < nblk) sr_issue(sB, BO + bo_item(hd, d, bB), VV, hd, d, bB, ih, F.lane); }
        }
#undef SR_PUT
        __builtin_amdgcn_s_setprio(0);
    } else {
        const int b = (int)blockIdx.x, nsb = F.G < N_SCAN_WAVES ? F.G : N_SCAN_WAVES, wps = 7 - SR_NL;
        const int widx = b < N_SCAN_WAVES ? b * wps + (F.wave - 1 - SR_NL) : nsb * wps + (b - N_SCAN_WAVES) * 8 + F.wave;
        const int NWK = nsb * wps + (F.G - nsb) * 8;
        unsigned long long rp0 = 0, rp1 = 0, rp2 = 0;
        if (PROBE_PHASE & (3 << 18)) rp0 = __builtin_amdgcn_s_memrealtime();
        attn_phase(F, widx, NWK);
        if (PROBE_PHASE & (3 << 18)) rp1 = __builtin_amdgcn_s_memrealtime();
        LAS float* scr = (LAS float*)(F.lds + (sblock ? SR_WSCR + (F.wave - 1 - SR_NL) * 8448 : F.wave * 8448));
        convert_loop(F, scr, 1, widx, NWK, N_CONVERT_ITEMS);
        if (PROBE_PHASE & (3 << 18)) { rp2 = __builtin_amdgcn_s_memrealtime(); if ((int)blockIdx.x == F.G - 1 && F.tid == 0) { unsigned long long v = 0; if ((PROBE_PHASE >> 18) & 1) v += rp1 - rp0; if ((PROBE_PHASE >> 19) & 1) v += rp2 - rp1;
            __hip_atomic_store((unsigned*)(F.ctl + 2048), (unsigned)v, __ATOMIC_RELAXED, __HIP_MEMORY_SCOPE_AGENT); } }
    }
}

__device__ __forceinline__ void combine_phase(Frame& F) {
    const bf16* Y0 = (const bf16*)(F.ws + WS_Y); const bf16* Y1 = Y0 + (size_t)LTOK * RC; const float* BON = (const float*)(F.ws + WS_BONUS);
    const bf16* VV = (const bf16*)(F.ws + WS_VV); const bf16* GG = (const bf16*)(F.ws + WS_GG);
    bf16* OR = (bf16*)(F.ws + WS_ORWKV);
    const float* lnw = F.in[15]; const float* lnb = F.in[16];
    const int gw = blockIdx.x * 8 + F.wave, NGW = F.G * 8;
    for (int row = gw; row < SEQ; row += NGW) { const int t = row + NMETA;
#pragma unroll 4
        for (int hd = 0; hd < RH; ++hd) { const int c = hd * 64 + F.lane; const size_t o = (size_t)t * RC + c;
            const float y = bf2f(Y0[o]) + bf2f(Y1[o]);
            const float mean = wave_sum(y) * (1.0f / 64.0f); const float dlt = y - mean; const float var = wave_sum(dlt * dlt) * (1.0f / 64.0f);
            const float yn = dlt * __builtin_amdgcn_rsqf(var + GN_EPS) * lnw[c] + lnb[c];
            const float outv = (yn + BON[(size_t)t * RH + hd] * bf2f(VV[o])) * bf2f(GG[o]);
            OR[(size_t)row * RC + c] = (bf16)f2bf(outv); } }
}
__device__ __forceinline__ void final_phase(Frame& F) {
    const float* SS3 = (const float*)(F.ctl + CW_SS3); const float* w = F.in[25];
    const int gw = blockIdx.x * 8 + F.wave, NGW = F.G * 8;
    for (int row = gw; row < SEQ; row += NGW) { const float rstd = 1.0f / sqrtf(SS3[row] * (1.0f / DM) + RMS_EPS);
        GAS f32x4* p = (GAS f32x4*)(F.out + (size_t)row * DM) + F.lane; const GAS f32x4* wp = (const GAS f32x4*)w + F.lane;
#pragma unroll
        for (int j = 0; j < 16; ++j) { const f32x4 v = p[64 * j], ww = wp[64 * j]; p[64 * j] = v * rstd * ww; } }
}
constexpr int N_PHASES = 11;
struct Args { const float* in[26]; float* out; unsigned char* ws; int ph_lo, ph_hi; };
__global__ void __launch_bounds__(512, 2) fwd_kernel(Args args) {
    extern __shared__ __attribute__((aligned(16))) unsigned char lds[];
    Frame F;
    F.lds = (LAS unsigned char*)lds;
    F.MISC = (volatile LAS unsigned*)(F.lds + MISC_OFF);
    F.tid = threadIdx.x; F.lane = F.tid & 63; F.wave = __builtin_amdgcn_readfirstlane(F.tid >> 6); F.G = gridDim.x;
    F.ws = args.ws; F.ctl = (gu32*)(args.ws + WS_CTL); F.out = args.out; F.pb0 = 0; F.pacc = 0; F.pacc2 = 0;
#pragma unroll
    for (int i = 0; i < 26; ++i) F.in[i] = args.in[i];
    for (int u = F.tid; u < (LDS_BYTES - LDSCTL_OFF) / 4; u += 512) ((LAS unsigned*)(F.lds + LDSCTL_OFF))[u] = 0u;
    __syncthreads();
    XcdBarrier bar; bar.bar = (unsigned*)(F.ctl + CW_BAR); bar.x = 0; bar.st = nullptr;
    if (!MK_SPLIT) bar = xcd_barrier_post((unsigned*)(F.ctl + CW_BAR), F.MISC + 8);
    const int lo = args.ph_lo, hi = args.ph_hi;
#define IN(k) (lo <= (k) && (k) < hi)
#define SEAM(k) do { if (IN(k) && IN((k) + 1)) xcd_barrier(bar); } while (0)
    bf16* Rm = (bf16*)(F.ws + WS_H);
    float* SS2 = (float*)(F.ctl + CW_SS2); float* SS3 = (float*)(F.ctl + CW_SS3);

    unsigned long long pt0 = 0, pt1 = 0;
#define PB0(k) do { if ((PROBE_PHASE >> (k)) & 1) pt0 = __builtin_amdgcn_s_memrealtime(); } while (0)
#define PB1(k) do { if ((PROBE_PHASE >> (k)) & 1) pt1 += __builtin_amdgcn_s_memrealtime() - pt0; } while (0)
    PB0(0); if (IN(0)) { p0_prologue(F); } SEAM(0); PB1(0);
    PB0(1); if (IN(1)) {
        pg8::Gemm g{Rm, Rm, MPAD + INWP, MPAD + INWP, DM}; pg8::InOrder S; S.init(F.G, (int)blockIdx.x);
        pg8::EpiIn E{(bf16*)(F.ws + WS_G), (bf16*)(F.ws + WS_Q), (bf16*)(F.ws + WS_K), (bf16*)(F.ws + WS_VT), (bf16*)(F.ws + WS_U), F.in[4], (const float*)(F.ws + WS_ROPE)};
        pg8::gemm_phase<pg8::EpiIn, pg8::InOrder, true, true>(F.lds, g, S, E, F.pacc2);
    } SEAM(1); PB1(1);
    PB0(2); if (IN(2)) { prep_phase(F); } SEAM(2); PB1(2);
    PB0(3); if (IN(3)) { blockprep_phase(F); } SEAM(3); PB1(3);
    PB0(4); if (IN(4)) { scan_phase(F); } SEAM(4); PB1(4);
    PB0(5); if (IN(5)) { combine_phase(F); } SEAM(5); PB1(5);
    PB0(6); if (IN(6)) {
        { pg8::Gemm g{(const bf16*)(F.ws + WS_OATT), (const bf16*)(F.ws + WS_WPA), SEQ, DM, ATTW}; pg8::StaticOrder S; S.init(SEQ, DM, F.G, (int)blockIdx.x);
          pg8::EpiProjA E{(bf16*)(F.ws + WS_P1), (const bf16*)(F.ws + WS_G)};
          pg8::gemm_phase<pg8::EpiProjA, pg8::StaticOrder, true, true>(F.lds, g, S, E, F.pacc2); }
        __syncthreads();
        { pg8::Gemm g{(const bf16*)(F.ws + WS_ORWKV), (const bf16*)(F.ws + WS_WPR), SEQ, DM, RC}; pg8::StaticOrder S; S.init(SEQ, DM, F.G, (int)blockIdx.x);
          pg8::EpiProjB E{(const bf16*)(F.ws + WS_P1), (const bf16*)(F.ws + WS_G), (bf16*)(F.ws + WS_MX)};
          pg8::gemm_phase<pg8::EpiProjB, pg8::StaticOrder, true, true>(F.lds, g, S, E, F.pacc2); }
    } SEAM(6); PB1(6);
    PB0(7); if (IN(7)) {
        pg8::Gemm g{(const bf16*)(F.ws + WS_MX), (const bf16*)(F.ws + WS_WOUT), SEQ, DM, DM}; pg8::StaticOrder S; S.init(SEQ, DM, F.G, (int)blockIdx.x);
        pg8::EpiResid<false> E{F.in[0], nullptr, nullptr, (bf16*)(F.ws + WS_A2), SS2};
        pg8::gemm_phase<pg8::EpiResid<false>, pg8::StaticOrder, true, true>(F.lds, g, S, E, F.pacc2);
    } SEAM(7); PB1(7);
    PB0(8); if (IN(8)) {
        pg8::Gemm g{(const bf16*)(F.ws + WS_A2), (const bf16*)(F.ws + WS_WGU), SEQ, 2 * DFF, DM}; pg8::StaticOrder S; S.init(SEQ, 2 * DFF, F.G, (int)blockIdx.x);
        pg8::EpiSwiGLU E{(bf16*)(F.ws + WS_HID), SS2};
        pg8::gemm_phase<pg8::EpiSwiGLU, pg8::StaticOrder, true, true>(F.lds, g, S, E, F.pacc2);
    } SEAM(8); PB1(8);
    PB0(9); if (IN(9)) {
        pg8::Gemm g{(const bf16*)(F.ws + WS_HID), (const bf16*)(F.ws + WS_WD), SEQ, DM, DFF}; pg8::StaticOrder S; S.init(SEQ, DM, F.G, (int)blockIdx.x);
        pg8::EpiResid<true> E{nullptr, (const bf16*)(F.ws + WS_A2), F.out, nullptr, SS3};
        pg8::gemm_phase<pg8::EpiResid<true>, pg8::StaticOrder, true, true>(F.lds, g, S, E, F.pacc2);
    } SEAM(9); PB1(9);
    PB0(10); if (IN(10)) { final_phase(F); } PB1(10);
    if (PROBE_PHASE != 0 && blockIdx.x == 0 && F.tid == 0) { const unsigned long long te = __builtin_amdgcn_s_memrealtime(), want = (unsigned long long)PROBE_MULT * (((PROBE_PHASE >> 20) & 1) ? F.pacc2 : (PROBE_PHASE & (3 << 18)) ? (unsigned long long)__hip_atomic_load((unsigned*)(F.ctl + 2048), __ATOMIC_RELAXED, __HIP_MEMORY_SCOPE_AGENT) : (pt1 + F.pacc));
        while (__builtin_amdgcn_s_memrealtime() - te < want && want < 2000000ull) __builtin_amdgcn_s_sleep(32); }
#undef PB0
#undef PB1
#undef IN
#undef SEAM
}

extern "C" void kernel_launch(void* const* d_in, const int* in_sizes, int n_in, void* d_out, int out_size, void* d_ws, size_t ws_size, hipStream_t stream) {
    static int grid = 0;
    if (grid == 0) {
        if (n_in != 26 || out_size != SEQ * DM || ws_size < WS_END) { fprintf(stderr, "kernel_launch: unexpected shapes (n_in %d, out %d, ws %zu, need %zu); nothing launched\n", n_in, out_size, ws_size, (size_t)WS_END); grid = -1; return; }
        int dev = 0, cus = 0, per_cu = 0;
        if (hipGetDevice(&dev) != hipSuccess || hipDeviceGetAttribute(&cus, hipDeviceAttributeMultiprocessorCount, dev) != hipSuccess) { grid = -1; return; }
        if (hipFuncSetAttribute((const void*)fwd_kernel, hipFuncAttributeMaxDynamicSharedMemorySize, LDS_BYTES) != hipSuccess) { fprintf(stderr, "kernel_launch: hipFuncSetAttribute failed\n"); grid = -1; return; }
        if (hipOccupancyMaxActiveBlocksPerMultiprocessor(&per_cu, (const void*)fwd_kernel, 512, LDS_BYTES) != hipSuccess || per_cu < 1) fprintf(stderr, "kernel_launch: occupancy query says %d per CU\n", per_cu);
        (void)hipGetLastError();
        grid = cus;
    }
    if (grid < 0) return;
    if (hipMemsetAsync((char*)d_ws + WS_CTL, 0, ZERO_BYTES, stream) != hipSuccess) return;
    Args a{};
    for (int i = 0; i < 26; ++i) a.in[i] = (const float*)d_in[i];
    a.out = (float*)d_out; a.ws = (unsigned char*)d_ws;
#if MK_SPLIT
    for (int p = 0; p < N_PHASES; ++p) { a.ph_lo = p; a.ph_hi = p + 1; hipLaunchKernelGGL(fwd_kernel, dim3(grid), dim3(512), LDS_BYTES, stream, a); }
#else
    a.ph_lo = 0; a.ph_hi = N_PHASES;
    hipLaunchKernelGGL(fwd_kernel, dim3(grid), dim3(512), LDS_BYTES, stream, a);
#endif
}
```

```cpp
#include <hip/hip_runtime.h>
#include <cstdio>
#include <cstdint>

#ifndef MK_SPLIT
#define MK_SPLIT 0
#endif

#ifndef PROBE_PHASE
#define PROBE_PHASE 0
#endif
#ifndef PROBE_MULT
#define PROBE_MULT 2
#endif
constexpr int NMETA = 16, SEQ = 8192, LTOK = 8208, DM = 4096, MPAD = 8448;
constexpr int INW = 18048, INWP = 18176;
constexpr int ATTW = 2048, KVW = 512, UW = 6784, UPITCH = 6912;
constexpr int RC = 2048, RH = 32, RN = 64;
constexpr int DFF = 11008;
constexpr float RMS_EPS = 1e-6f, GN_EPS = 64e-5f;
constexpr int HT = MPAD / 256;
constexpr int CT_Q = 32, CT_K = 40, CT_V = 42, CT_U = 44, CT_N = 71;

namespace pg8 {
#define PG8_LAS __attribute__((address_space(3)))
typedef unsigned short bf16_t;
typedef short bf16x8 __attribute__((ext_vector_type(8)));
typedef float f32x4 __attribute__((ext_vector_type(4)));
typedef unsigned u32x4 __attribute__((ext_vector_type(4)));
constexpr int BM = 256, BK = 64, HALF = 128, HTB = HALF * BK * 2  , STAGE_BYTES = 8 * HTB, NXCD = 8, WGM = 8;

__host__ __device__ __forceinline__ int lds_byte(int r, int c) { const int st = (r >> 4) * 2 + (c >> 5), rr = r & 15, cc = c & 31, ob = rr * 64 + cc * 2; return st * 1024 + (ob ^ (((ob >> 9) & 1) << 5)); }
__host__ __device__ __forceinline__ void stage_rc(int b, int& R, int& C) { const int st = b / 1024, sb = b % 1024, swz = sb ^ (((sb >> 9) & 1) << 5); R = (st >> 1) * 16 + swz / 64; C = (st & 1) * 32 + (swz % 64) / 2; }
__host__ __device__ __forceinline__ int perm32(int rho) { const int n = rho >> 4, i = rho & 15; return 8 * (i >> 2) + 4 * n + (i & 3); }

struct Unit { int pm, pn; };
struct Gemm { const bf16_t* A; const bf16_t* Bt; int M, N, K; };

struct StaticOrder {
    int nM, nN, nwg, G, c;
    __host__ __device__ void init(int M, int N, int G_, int c_) { nM = M / BM; nN = N / BM; nwg = nM * nN; G = G_; c = c_; }
    __host__ __device__ bool next(int i, Unit& u) const {
        const long L = (long)i * G + c; if (L >= nwg) return false;
        int wgid = (int)L; { const int q = nwg / NXCD, r = nwg % NXCD, xcd = wgid % NXCD, off = wgid / NXCD; wgid = (xcd < r ? xcd * (q + 1) : r * (q + 1) + (xcd - r) * q) + off; }
        const int nig = WGM * nN, gid = wgid / nig, fm = gid * WGM, gsz = (nM - fm) < WGM ? (nM - fm) : WGM;
        u.pm = fm + ((wgid % nig) % gsz); u.pn = (wgid % nig) / gsz; return true;
    }
    __device__ __forceinline__ void a_ready(const Unit&) const {}
    __device__ __forceinline__ void done(const Unit&) const {}
};

typedef float f32x2c __attribute__((ext_vector_type(2)));
typedef __bf16 bf16x2c __attribute__((ext_vector_type(2)));
__device__ __forceinline__ unsigned cvt_pk_bf16(float lo, float hi) { const f32x2c v = {lo, hi}; const bf16x2c r = __builtin_convertvector(v, bf16x2c); return __builtin_bit_cast(unsigned, r); }

typedef unsigned u32x2 __attribute__((ext_vector_type(2)));
__device__ __forceinline__ float bflo(unsigned w) { return __uint_as_float(w << 16); }
__device__ __forceinline__ float bfhi(unsigned w) { return __uint_as_float(w & 0xffff0000u); }
__device__ __forceinline__ float sigmoidf_(float x) { return __builtin_amdgcn_rcpf(1.0f + __expf(-x)); }

struct InOrder {
    StaticOrder base; int G, c;
    __device__ void init(int G_, int c_) { base.init(SEQ, INWP, G_, c_); G = G_; c = c_; }
    __device__ bool next(int i, Unit& u) const {
        const long L = (long)i * G + c;
        if (L < base.nwg) {
            base.next(i, u);
            if (u.pn >= CT_V && u.pn < CT_U) { const int e = (u.pn - CT_V) * 32 + u.pm; u.pm = HT + CT_V + e / HT; u.pn = e % HT; }
            else u.pn += HT;
            return true;
        }
        const int x = (int)(L - base.nwg);
        if (x >= 31) return false;
        if (x < 2) { const int e = 64 + x; u.pm = HT + CT_V + e / HT; u.pn = e % HT; }
        else { const int y = x - 2; u.pm = 32; u.pn = HT + (y < 2 ? CT_K + y : CT_U + (y - 2)); }
        return true;
    }
    __device__ __forceinline__ void a_ready(const Unit&) const {}
    __device__ __forceinline__ void done(const Unit&) const {}
};

struct EpiIn {
    static constexpr bool PERM = true, AFTER_DRAIN = false;
    bf16_t *G, *Q, *K, *Vt, *U; const float* bgate; const float* rope;
    __device__ __forceinline__ static void st8(bf16_t* p, const f32x4& v0, const f32x4& v1) {
        u32x4 w; w.x = cvt_pk_bf16(v0[0], v0[1]); w.y = cvt_pk_bf16(v0[2], v0[3]); w.z = cvt_pk_bf16(v1[0], v1[1]); w.w = cvt_pk_bf16(v1[2], v1[3]); *(u32x4*)p = w; }
    __device__ __forceinline__ void plain(const f32x4 (&acc)[2][2][4][2], bf16_t* base, int ldc, int row0, int col0) const {
#pragma unroll
        for (int ai = 0; ai < 2; ++ai)
#pragma unroll
            for (int m = 0; m < 4; ++m) { bf16_t* rowp = base + (size_t)(row0 + ai * HALF + m * 16) * ldc + col0;
#pragma unroll
                for (int bj = 0; bj < 2; ++bj) st8(rowp + bj * HALF, acc[ai][bj][m][0], acc[ai][bj][m][1]); }
    }
    __device__ __forceinline__ void roped(const f32x4 (&acc)[2][2][4][2], bf16_t* base, int ldc, int row0, int col0, int wc, int fq) const {
        if (wc != 0) { plain(acc, base, ldc, row0, col0); return; }
        const float sgn = (fq < 2) ? -1.0f : 1.0f;
#pragma unroll
        for (int ai = 0; ai < 2; ++ai)
#pragma unroll
            for (int m = 0; m < 4; ++m) { const int row = row0 + ai * HALF + m * 16; const int pos = row < SEQ ? row + NMETA : row - SEQ;
                const f32x4* cs = (const f32x4*)(rope + (size_t)pos * 32 + 16 * (fq & 1));
                const f32x4 c0 = cs[0], c1 = cs[1], c2 = cs[2], c3 = cs[3];
                const float cw[8] = {c0[0], c0[2], c1[0], c1[2], c2[0], c2[2], c3[0], c3[2]}, sw[8] = {c0[1], c0[3], c1[1], c1[3], c2[1], c2[3], c3[1], c3[3]};
                bf16_t* rowp = base + (size_t)row * ldc + col0;
#pragma unroll
                for (int bj = 0; bj < 2; ++bj) { f32x4 v0 = acc[ai][bj][m][0], v1 = acc[ai][bj][m][1], o0, o1;
#pragma unroll
                    for (int e = 0; e < 4; ++e) { const float p0 = __shfl_xor(v0[e], 32), p1 = __shfl_xor(v1[e], 32);
                        o0[e] = v0[e] * cw[e] + sgn * p0 * sw[e]; o1[e] = v1[e] * cw[4 + e] + sgn * p1 * sw[4 + e]; }
                    st8(rowp + bj * HALF, o0, o1); } }
    }
    __device__ __forceinline__ void operator()(const f32x4 (&acc)[2][2][4][2], const Unit& u, int wr, int wc, int fr, int fq) const {
        if (u.pm >= HT) {
            plain(acc, Vt, MPAD, (u.pm - HT - CT_V) * BM + wr * 64 + fr, u.pn * BM + wc * 32 + 8 * fq); return; }
        const int ct = u.pn - HT, row0 = u.pm * BM + wr * 64 + fr, cl = wc * 32 + 8 * fq;
        if (ct < CT_Q) {
            const int col0 = ct * BM + cl;
#pragma unroll
            for (int bj = 0; bj < 2; ++bj) { const f32x4 b0 = *(const f32x4*)(bgate + col0 + bj * HALF), b1 = *(const f32x4*)(bgate + col0 + bj * HALF + 4);
#pragma unroll
                for (int ai = 0; ai < 2; ++ai)
#pragma unroll
                    for (int m = 0; m < 4; ++m) { f32x4 v0 = acc[ai][bj][m][0] + b0, v1 = acc[ai][bj][m][1] + b1;
#pragma unroll
                        for (int e = 0; e < 4; ++e) { v0[e] = sigmoidf_(v0[e]); v1[e] = sigmoidf_(v1[e]); }
                        st8(G + (size_t)(row0 + ai * HALF + m * 16) * (2 * DM) + col0 + bj * HALF, v0, v1); } }
        } else if (ct < CT_K) { roped(acc, Q, ATTW, row0, (ct - CT_Q) * BM + cl, wc, fq);
        } else if (ct < CT_V) { roped(acc, K, KVW, row0, (ct - CT_K) * BM + cl, wc, fq);
        } else { plain(acc, U, UPITCH, row0, (ct - CT_U) * BM + cl); }
    }
};

struct EpiProjA {
    static constexpr bool PERM = true, AFTER_DRAIN = false;
    bf16_t* P1; const bf16_t* G;
    __device__ __forceinline__ void operator()(const f32x4 (&acc)[2][2][4][2], const Unit& u, int wr, int wc, int fr, int fq) const {
        const int row0 = u.pm * BM + wr * 64 + fr, col0 = u.pn * BM + wc * 32 + 8 * fq;
#pragma unroll
        for (int ai = 0; ai < 2; ++ai)
#pragma unroll
            for (int m = 0; m < 4; ++m) { const size_t r = (size_t)(row0 + ai * HALF + m * 16);
#pragma unroll
                for (int bj = 0; bj < 2; ++bj) { const int c = col0 + bj * HALF; const u32x4 g = *(const u32x4*)(G + r * (2 * DM) + c);
                    f32x4 o0 = acc[ai][bj][m][0], o1 = acc[ai][bj][m][1];
                    o0[0] *= bflo(g.x); o0[1] *= bfhi(g.x); o0[2] *= bflo(g.y); o0[3] *= bfhi(g.y); o1[0] *= bflo(g.z); o1[1] *= bfhi(g.z); o1[2] *= bflo(g.w); o1[3] *= bfhi(g.w);
                    EpiIn::st8(P1 + r * DM + c, o0, o1); } }
    }
};
struct EpiProjB {
    static constexpr bool PERM = true, AFTER_DRAIN = false;
    const bf16_t* P1; const bf16_t* G; bf16_t* MX;
    __device__ __forceinline__ void operator()(const f32x4 (&acc)[2][2][4][2], const Unit& u, int wr, int wc, int fr, int fq) const {
        const int row0 = u.pm * BM + wr * 64 + fr, col0 = u.pn * BM + wc * 32 + 8 * fq;
#pragma unroll
        for (int ai = 0; ai < 2; ++ai)
#pragma unroll
            for (int m = 0; m < 4; ++m) { const size_t r = (size_t)(row0 + ai * HALF + m * 16);
#pragma unroll
                for (int bj = 0; bj < 2; ++bj) { const int c = col0 + bj * HALF; const u32x4 g = *(const u32x4*)(G + r * (2 * DM) + DM + c); const u32x4 q = *(const u32x4*)(P1 + r * DM + c);
                    f32x4 o0 = {bflo(q.x), bfhi(q.x), bflo(q.y), bfhi(q.y)}, o1 = {bflo(q.z), bfhi(q.z), bflo(q.w), bfhi(q.w)}; const f32x4 a0 = acc[ai][bj][m][0], a1 = acc[ai][bj][m][1];
                    o0[0] += a0[0] * bflo(g.x); o0[1] += a0[1] * bfhi(g.x); o0[2] += a0[2] * bflo(g.y); o0[3] += a0[3] * bfhi(g.y);
                    o1[0] += a1[0] * bflo(g.z); o1[1] += a1[1] * bfhi(g.z); o1[2] += a1[2] * bflo(g.w); o1[3] += a1[3] * bfhi(g.w);
                    EpiIn::st8(MX + r * DM + c, o0, o1); }
                asm volatile("" ::: "memory"); }
    }
};
template <bool BASE_BF16> struct EpiResid {
    static constexpr bool PERM = true, AFTER_DRAIN = false;
    const float* BASEF; const bf16_t* BASEB; float* OUTF; bf16_t* OUTB; float* SS;
    __device__ __forceinline__ void operator()(const f32x4 (&acc)[2][2][4][2], const Unit& u, int wr, int wc, int fr, int fq) const {
        const int row0 = u.pm * BM + wr * 64 + fr, col0 = u.pn * BM + wc * 32 + 8 * fq;
#pragma unroll
        for (int ai = 0; ai < 2; ++ai)
#pragma unroll
            for (int m = 0; m < 4; ++m) { const size_t r = (size_t)(row0 + ai * HALF + m * 16); float ss = 0.f;
#pragma unroll
                for (int bj = 0; bj < 2; ++bj) { const int c = col0 + bj * HALF; f32x4 o0, o1;
                    if (BASE_BF16) { const u32x4 g = *(const u32x4*)(BASEB + r * DM + c); o0 = (f32x4){bflo(g.x), bfhi(g.x), bflo(g.y), bfhi(g.y)}; o1 = (f32x4){bflo(g.z), bfhi(g.z), bflo(g.w), bfhi(g.w)}; }
                    else { const float* bp = BASEF + r * DM + c; o0 = *(const f32x4*)bp; o1 = *(const f32x4*)(bp + 4); }
                    o0 += acc[ai][bj][m][0]; o1 += acc[ai][bj][m][1];
                    if (BASE_BF16) { float* op = OUTF + r * DM + c; *(f32x4*)op = o0; *(f32x4*)(op + 4) = o1; }
                    else { u32x4 w; w.x = cvt_pk_bf16(o0[0], o0[1]); w.y = cvt_pk_bf16(o0[2], o0[3]); w.z = cvt_pk_bf16(o1[0], o1[1]); w.w = cvt_pk_bf16(o1[2], o1[3]); *(u32x4*)(OUTB + r * DM + c) = w;
                        o0 = (f32x4){bflo(w.x), bfhi(w.x), bflo(w.y), bfhi(w.y)}; o1 = (f32x4){bflo(w.z), bfhi(w.z), bflo(w.w), bfhi(w.w)}; }
                    ss += (o0[0] * o0[0] + o0[1] * o0[1]) + (o0[2] * o0[2] + o0[3] * o0[3]) + (o1[0] * o1[0] + o1[1] * o1[1]) + (o1[2] * o1[2] + o1[3] * o1[3]); }
                ss += __shfl_xor(ss, 16); ss += __shfl_xor(ss, 32);
                if (fq == 0) atomicAdd(SS + r, ss);
                asm volatile("" ::: "memory"); }
    }
};
struct EpiSwiGLU {
    static constexpr bool PERM = true, AFTER_DRAIN = false;
    bf16_t* HID; const float* SS;
    __device__ __forceinline__ void operator()(const f32x4 (&acc)[2][2][4][2], const Unit& u, int wr, int wc, int fr, int fq) const {
        const int row0 = u.pm * BM + wr * 64 + fr, col0 = u.pn * HALF + wc * 32 + 8 * fq;
#pragma unroll
        for (int ai = 0; ai < 2; ++ai)
#pragma unroll
            for (int m = 0; m < 4; ++m) { const size_t r = (size_t)(row0 + ai * HALF + m * 16);
                const float rstd = __builtin_amdgcn_rsqf(SS[r] * (1.0f / DM) + RMS_EPS);
                f32x4 o0, o1;
#pragma unroll
                for (int e = 0; e < 4; ++e) { const float g0 = acc[ai][0][m][0][e] * rstd, u0 = acc[ai][1][m][0][e] * rstd, g1 = acc[ai][0][m][1][e] * rstd, u1 = acc[ai][1][m][1][e] * rstd;
                    o0[e] = g0 * sigmoidf_(g0) * u0; o1[e] = g1 * sigmoidf_(g1) * u1; }
                EpiIn::st8(HID + r * DFF + col0, o0, o1); }
    }
};

#define PG8_EPI_T0 unsigned long long epi_t0_ = 0; do { if ((PROBE_PHASE >> 20) & 1) epi_t0_ = __builtin_amdgcn_s_memrealtime(); } while (0)
#define PG8_EPI_T1 do { if ((PROBE_PHASE >> 20) & 1) epi_acc += __builtin_amdgcn_s_memrealtime() - epi_t0_; } while (0)
template <class Epi, class Sched, bool ALIGN_EPI = false, bool SP2 = false>
__device__ __forceinline__ void gemm_phase(PG8_LAS unsigned char* lds, const Gemm g, const Sched& S, const Epi& E, unsigned long long& epi_acc) {
    const int tid = threadIdx.x, wid = __builtin_amdgcn_readfirstlane(tid >> 6), lane = tid & 63, wr = wid >> 2, wc = wid & 3, fr = lane & 15, fq = lane >> 4;
    const int K = g.K, nt = K / BK;
    unsigned voffA[2], voffB[2];
#pragma unroll
    for (int i = 0; i < 2; ++i) { int R, C; stage_rc(tid * 16 + i * 8192, R, C); const int Rb = Epi::PERM ? ((R & ~31) + perm32(R & 31)) : R;
        voffA[i] = (unsigned)(R * K + C) * 2u; voffB[i] = (unsigned)(Rb * K + C) * 2u; }
    const size_t kstep = (size_t)(BK * 2);
    const size_t hstep = (size_t)HALF * K * 2;
    const size_t tstep = 2 * hstep;
    const unsigned ldsw = (unsigned)wid * 1024u;
    const int aoff = lds_byte(wr * 64 + fr, fq * 8), boff = lds_byte(wc * 32 + fr, fq * 8);
#define PG8_SA(b, h) (((b) * 2 + (h)) * HTB)
#define PG8_SB(b, h) ((4 + (b) * 2 + (h)) * HTB)
#define PG8_STAGE(bufoff, gbase, voff) do { _Pragma("unroll") for (int _i = 0; _i < 2; ++_i) \
        __builtin_amdgcn_global_load_lds((const unsigned*)((const char*)(gbase) + (voff)[_i]), (PG8_LAS unsigned*)(lds + (bufoff) + ldsw + _i * 8192), 16, 0, 0); } while (0)
#define PG8_LDA(dst, b, h) do { _Pragma("unroll") for (int m = 0; m < 4; ++m) _Pragma("unroll") for (int k = 0; k < 2; ++k) dst[m][k] = *(const PG8_LAS bf16x8*)(lds + PG8_SA(b, h) + aoff + m * 2048 + k * 1024); } while (0)
#define PG8_LDB(dst, b, h) do { _Pragma("unroll") for (int n = 0; n < 2; ++n) _Pragma("unroll") for (int k = 0; k < 2; ++k) dst[n][k] = *(const PG8_LAS bf16x8*)(lds + PG8_SB(b, h) + boff + n * 2048 + k * 1024); } while (0)
#define PG8_MMA(ai, bj, At, Bt) do { __builtin_amdgcn_s_setprio(1); _Pragma("unroll") for (int m = 0; m < 4; ++m) _Pragma("unroll") for (int n = 0; n < 2; ++n) _Pragma("unroll") for (int k = 0; k < 2; ++k) \
        acc[ai][bj][m][n] = __builtin_amdgcn_mfma_f32_16x16x32_bf16(Bt[n][k], At[m][k], acc[ai][bj][m][n], 0, 0, 0); __builtin_amdgcn_s_setprio(0); } while (0)
#define PG8_WAIT_V(n) asm volatile("s_waitcnt vmcnt(" #n ")" ::: "memory")
#define PG8_WAIT_L(n) asm volatile("s_waitcnt lgkmcnt(" #n ")" ::: "memory")
#define PG8_BAR __builtin_amdgcn_s_barrier()
#define PG8_SCHED __builtin_amdgcn_sched_barrier(0)
    Unit cur, nxt; int ui = 0;
    if (!S.next(0, cur)) return;
    f32x4 acc[2][2][4][2];
#pragma unroll
    for (int a = 0; a < 2; ++a)
#pragma unroll
        for (int b = 0; b < 2; ++b)
#pragma unroll
            for (int m = 0; m < 4; ++m)
#pragma unroll
                for (int n = 0; n < 2; ++n) acc[a][b][m][n] = (f32x4){0.f, 0.f, 0.f, 0.f};
    bf16x8 At[4][2], B0[2][2], B1[2][2];
    const char* cA = (const char*)g.A + (size_t)cur.pm * tstep; const char* cB = (const char*)g.Bt + (size_t)cur.pn * tstep;
    S.a_ready(cur);
    if constexpr (SP2) {
        PG8_STAGE(PG8_SB(0, 0), cB, voffB); PG8_STAGE(PG8_SB(0, 1), cB + hstep, voffB); PG8_STAGE(PG8_SA(0, 0), cA, voffA); PG8_STAGE(PG8_SA(0, 1), cA + hstep, voffA);
        if (wr == 1) PG8_BAR;
        PG8_WAIT_V(2); PG8_BAR;
        PG8_STAGE(PG8_SB(1, 0), cB + kstep, voffB); PG8_STAGE(PG8_SA(1, 0), cA + kstep, voffA); PG8_STAGE(PG8_SB(1, 1), cB + hstep + kstep, voffB);
        PG8_WAIT_V(6); PG8_BAR;
    } else {
        PG8_STAGE(PG8_SB(0, 0), cB, voffB); PG8_STAGE(PG8_SA(0, 0), cA, voffA); PG8_STAGE(PG8_SB(0, 1), cB + hstep, voffB); PG8_STAGE(PG8_SA(0, 1), cA + hstep, voffA);
        if (wr == 1) PG8_BAR;
        PG8_WAIT_V(4); PG8_BAR;
        PG8_STAGE(PG8_SB(1, 0), cB + kstep, voffB); PG8_STAGE(PG8_SA(1, 0), cA + kstep, voffA); PG8_STAGE(PG8_SB(1, 1), cB + hstep + kstep, voffB);
        PG8_WAIT_V(6); PG8_BAR;
    }
    for (;;) {
        const bool has_next = S.next(ui + 1, nxt);
        const char* nA = has_next ? (const char*)g.A + (size_t)nxt.pm * tstep : cA; const char* nB = has_next ? (const char*)g.Bt + (size_t)nxt.pn * tstep : cB;
        for (int t = 0; t < nt; t += 2) {
            const bool last = (t == nt - 2);
            const char* a1 = cA + (size_t)(t + 1) * kstep;
            const char* a2 = last ? nA : cA + (size_t)(t + 2) * kstep; const char* b2 = last ? nB : cB + (size_t)(t + 2) * kstep;
            const char* a3 = a2 + kstep; const char* b3 = b2 + kstep;
            if (last && has_next) S.a_ready(nxt);
            if constexpr (SP2) {
            PG8_LDB(B0, 0, 0); PG8_LDB(B1, 0, 1); PG8_SCHED; PG8_LDA(At, 0, 0); PG8_STAGE(PG8_SA(1, 1), a1 + hstep, voffA);
            PG8_WAIT_V(8); PG8_WAIT_L(0); PG8_BAR; PG8_MMA(0, 0, At, B0); PG8_MMA(0, 1, At, B1); PG8_BAR; PG8_SCHED;
            PG8_LDA(At, 0, 1); PG8_STAGE(PG8_SB(0, 0), b2, voffB); PG8_STAGE(PG8_SB(0, 1), b2 + hstep, voffB); PG8_STAGE(PG8_SA(0, 0), a2, voffA);
            PG8_WAIT_V(8); PG8_WAIT_L(0); PG8_BAR; PG8_MMA(1, 0, At, B0); PG8_MMA(1, 1, At, B1); PG8_BAR; PG8_SCHED;
            PG8_LDB(B0, 1, 0); PG8_LDB(B1, 1, 1); PG8_SCHED; PG8_LDA(At, 1, 0); PG8_STAGE(PG8_SA(0, 1), a2 + hstep, voffA);
            PG8_WAIT_V(8); PG8_WAIT_L(0); PG8_BAR; PG8_MMA(0, 0, At, B0); PG8_MMA(0, 1, At, B1); PG8_BAR; PG8_SCHED;
            PG8_LDA(At, 1, 1); PG8_STAGE(PG8_SB(1, 0), b3, voffB); PG8_STAGE(PG8_SB(1, 1), b3 + hstep, voffB); PG8_STAGE(PG8_SA(1, 0), a3, voffA);
            PG8_WAIT_V(8); PG8_WAIT_L(0); PG8_BAR; PG8_MMA(1, 0, At, B0); PG8_MMA(1, 1, At, B1); PG8_BAR; PG8_SCHED;
            } else {
            PG8_LDB(B0, 0, 0); PG8_SCHED; PG8_LDA(At, 0, 0); PG8_STAGE(PG8_SA(1, 1), a1 + hstep, voffA);
            PG8_WAIT_L(8); PG8_BAR; PG8_WAIT_L(0); PG8_MMA(0, 0, At, B0); PG8_BAR; PG8_SCHED;
            PG8_LDB(B1, 0, 1); PG8_STAGE(PG8_SB(0, 0), b2, voffB);
            PG8_BAR; PG8_WAIT_L(0); PG8_MMA(0, 1, At, B1); PG8_BAR;
            PG8_LDA(At, 0, 1); PG8_STAGE(PG8_SA(0, 0), a2, voffA);
            PG8_BAR; PG8_WAIT_L(0); PG8_MMA(1, 0, At, B0); PG8_BAR; PG8_SCHED;
            PG8_STAGE(PG8_SB(0, 1), b2 + hstep, voffB);
            PG8_WAIT_V(6); PG8_BAR; PG8_MMA(1, 1, At, B1); PG8_BAR;
            PG8_LDB(B0, 1, 0); PG8_SCHED; PG8_LDA(At, 1, 0); PG8_STAGE(PG8_SA(0, 1), a2 + hstep, voffA);
            PG8_WAIT_L(8); PG8_BAR; PG8_WAIT_L(0); PG8_MMA(0, 0, At, B0); PG8_BAR; PG8_SCHED;
            PG8_LDB(B1, 1, 1); PG8_STAGE(PG8_SB(1, 0), b3, voffB);
            PG8_BAR; PG8_WAIT_L(0); PG8_MMA(0, 1, At, B1); PG8_BAR;
            PG8_LDA(At, 1, 1); PG8_STAGE(PG8_SA(1, 0), a3, voffA);
            PG8_BAR; PG8_WAIT_L(0); PG8_MMA(1, 0, At, B0); PG8_BAR; PG8_SCHED;
            PG8_STAGE(PG8_SB(1, 1), b3 + hstep, voffB);
            PG8_WAIT_V(6); PG8_BAR; PG8_MMA(1, 1, At, B1); PG8_BAR;
            }
        }
        if constexpr (ALIGN_EPI) { if (wr == 0) PG8_BAR; }
        if constexpr (!Epi::AFTER_DRAIN) { PG8_EPI_T0; E(acc, cur, wr, wc, fr, fq); S.done(cur); PG8_EPI_T1; }
        if (!has_next) break;
#pragma unroll
        for (int a = 0; a < 2; ++a)
#pragma unroll
            for (int b = 0; b < 2; ++b)
#pragma unroll
                for (int m = 0; m < 4; ++m)
#pragma unroll
                    for (int n = 0; n < 2; ++n) acc[a][b][m][n] = (f32x4){0.f, 0.f, 0.f, 0.f};
        cur = nxt; cA = nA; cB = nB; ++ui;
        if constexpr (ALIGN_EPI) { if (wr == 1) PG8_BAR; }
    }
    PG8_WAIT_V(0);
    if constexpr (!ALIGN_EPI) { if (wr == 0) PG8_BAR; }
    PG8_BAR;
    if constexpr (Epi::AFTER_DRAIN) { E.fused(acc, cur, wr, wc, fr, fq, lds, wid, lane); S.done(cur); }
#undef PG8_SA
#undef PG8_SB
#undef PG8_STAGE
#undef PG8_LDA
#undef PG8_LDB
#undef PG8_MMA
#undef PG8_WAIT_V
#undef PG8_WAIT_L
#undef PG8_BAR
#undef PG8_SCHED
}

}

constexpr size_t MiB = 1u << 20;
constexpr size_t WS_CTL = 0;
constexpr size_t WS_ROPE = 1 * MiB;
constexpr size_t WS_LW2 = 3 * MiB, WS_LA2 = 4 * MiB, WS_LG2 = 5 * MiB;
constexpr size_t WS_BONUS = 6 * MiB;
constexpr size_t ZERO_BYTES = 8 * MiB;
constexpr size_t SCF = (size_t)LTOK * RC * 4, SCB = (size_t)LTOK * RC * 2;
constexpr size_t WS_H = 8 * MiB, WS_WIN = WS_H + (size_t)MPAD * DM * 2;
constexpr size_t WS_KD0 = 8 * MiB, WS_KD1 = WS_KD0 + SCB, WS_B0 = WS_KD1 + SCB, WS_B1 = WS_B0 + SCB, WS_KK = WS_B1 + SCB, WS_RR = WS_KK + SCB;
constexpr size_t WS_WGU = 8 * MiB;
constexpr size_t WS_G = 216 * MiB, WS_A2 = 216 * MiB;
constexpr size_t WS_Q = 344 * MiB, WS_K = 376 * MiB, WS_VT = 385 * MiB, WS_U = 394 * MiB;
constexpr size_t WS_P1 = 344 * MiB;
constexpr size_t WS_Y = 394 * MiB;
constexpr size_t WS_W0 = 506 * MiB, WS_W1 = WS_W0 + SCF;
constexpr size_t WS_WPA = 506 * MiB, WS_WPR = 522 * MiB, WS_WOUT = 538 * MiB, WS_OATT = 570 * MiB;
constexpr size_t WS_VV = 635 * MiB, WS_GG = 668 * MiB;
constexpr size_t WS_BO = 701 * MiB;
constexpr size_t WS_HID = 701 * MiB, WS_MX = 873 * MiB;
constexpr int NB0 = 513, NB1 = 512, NBT = NB0 + NB1;
constexpr int BO_FA = 0, BO_FH = 4096, BO_FB = 5120, BO_FG = 9216, BO_ITEM = 9472;
constexpr size_t WS_WD = 998 * MiB, WS_ORWKV = 1084 * MiB, WS_END = 1116 * MiB;
static_assert(WS_WIN + (size_t)INWP * DM * 2 <= WS_G && WS_RR + SCB <= WS_G && WS_WGU + (size_t)2 * DFF * DM * 2 <= WS_G, "map: A0");
static_assert(WS_U + (size_t)MPAD * UPITCH * 2 <= WS_W0 && WS_VT + (size_t)KVW * MPAD * 2 <= WS_U && WS_K + (size_t)MPAD * KVW * 2 <= WS_VT && WS_Q + (size_t)SEQ * ATTW * 2 <= WS_K && WS_Y + 2 * SCB <= WS_W0, "map: P1 outputs");
static_assert(WS_W1 + SCF <= WS_VV && WS_OATT + (size_t)SEQ * ATTW * 2 <= WS_VV && WS_VV + SCB <= WS_GG && WS_GG + SCB <= WS_BO && WS_P1 + (size_t)SEQ * DM * 2 <= WS_W0, "map: mid");
static_assert(WS_BO + (size_t)RH * NBT * BO_ITEM <= WS_WD && WS_HID + (size_t)SEQ * DFF * 2 <= WS_MX && WS_MX + (size_t)SEQ * DM * 2 <= WS_WD && WS_WD + (size_t)DM * DFF * 2 <= WS_ORWKV && WS_ORWKV + (size_t)SEQ * RC * 2 <= WS_END, "map: tail");
constexpr int CW_BAR = 4096;
constexpr int CW_SS2 = 65536, CW_SS3 = 65536 + 8192;
static_assert((CW_SS3 + 8192) * 4 <= (int)(1 * MiB), "CTL");

constexpr int RING_BYTES = 131072;
constexpr int LDSCTL_OFF = RING_BYTES, MISC_OFF = LDSCTL_OFF + 320;
constexpr int LDS_BYTES = 147456;

#define GAS __attribute__((address_space(1)))
#define LAS __attribute__((address_space(3)))
typedef unsigned short bf16;
typedef unsigned v4u __attribute__((ext_vector_type(4)));
typedef unsigned v2u __attribute__((ext_vector_type(2)));
typedef float f32x4 __attribute__((ext_vector_type(4)));
typedef float f32x2 __attribute__((ext_vector_type(2)));
typedef float f32x16 __attribute__((ext_vector_type(16)));
typedef short bf16x8 __attribute__((ext_vector_type(8)));
typedef GAS unsigned gu32;
#define RLX_AGENT __ATOMIC_RELAXED, __HIP_MEMORY_SCOPE_AGENT
#define LDS_WAIT() asm volatile("s_waitcnt lgkmcnt(0)" ::: "memory")
__device__ __forceinline__ unsigned pk2(float lo, float hi) { return pg8::cvt_pk_bf16(lo, hi); }
__device__ __forceinline__ unsigned f2bf(float f) { return pg8::cvt_pk_bf16(f, 0.f) & 0xffffu; }
__device__ __forceinline__ float bf2f(bf16 b) { return __uint_as_float(((unsigned)b) << 16); }
using pg8::bflo; using pg8::bfhi; using pg8::sigmoidf_;

#define XB_TMO      128
#define XB_XCNT(j)  (256  + 64 * (j))
#define XB_XSUB(j)  (1280 + 64 * (j))
#define XB_XGEN(j)  (2304 + 64 * (j))
#define XB_TOP      3328
#define XB_TOPGEN   3392
#define XCD_BAR_WORDS 3456
#define XB_SPIN_CAP (1u << 18)

__device__ __forceinline__ unsigned xb_ld(unsigned* p)              { return __hip_atomic_load(p, __ATOMIC_RELAXED, __HIP_MEMORY_SCOPE_AGENT); }
__device__ __forceinline__ unsigned xb_add(unsigned* p, unsigned v) { return __hip_atomic_fetch_add(p, v, __ATOMIC_RELAXED, __HIP_MEMORY_SCOPE_AGENT); }
__device__ __forceinline__ unsigned xb_xcc_id() { return (unsigned)__builtin_amdgcn_s_getreg((3 << 11) | 20) & 0xFu; }
#define XB_SPIN(cond, bar) do { unsigned _sp = 0; while (cond) { __builtin_amdgcn_s_sleep(1); \
    if ((++_sp & 255u) == 0u) { if (xb_ld(&(bar)[XB_TMO])) break; if (_sp > XB_SPIN_CAP) { atomicAdd(&(bar)[XB_TMO], 1u); break; } } } } while (0)

struct XcdBarrier {
    unsigned* bar; unsigned x;
    volatile LAS unsigned* st;
};

__device__ __forceinline__ XcdBarrier xcd_barrier_post(unsigned* bar, volatile LAS unsigned* st) {
    XcdBarrier b; b.bar = bar; b.x = xb_xcc_id(); b.st = st;
    if (threadIdx.x == 0) (void)xb_add(&bar[XB_XCNT(b.x)], 1u);
    return b;
}
__device__ __forceinline__ void xcd_barrier_complete(unsigned* bar, unsigned x, unsigned& nloc, unsigned& nx) {
    const unsigned G = gridDim.x * gridDim.y * gridDim.z;
    unsigned sum, cnt, mine, sp = 0u;
    for (;;) {
        sum = 0u; cnt = 0u; mine = 0u;
#pragma unroll
        for (unsigned j = 0; j < 16; ++j) { const unsigned c = xb_ld(&bar[XB_XCNT(j)]); sum += c; cnt += (c > 0u) ? 1u : 0u; mine = (j == x) ? c : mine; }
        if (sum == G) break;
        __builtin_amdgcn_s_sleep(1);
        if ((++sp & 255u) == 0u) { if (xb_ld(&bar[XB_TMO])) break; if (sp > XB_SPIN_CAP) { atomicAdd(&bar[XB_TMO], 1u); break; } }
    }
    nloc = mine > 0u ? mine : 1u; nx = cnt > 0u ? cnt : 1u;
}

__device__ __forceinline__ void xcd_barrier(const XcdBarrier& b) {
    asm volatile("s_waitcnt vmcnt(0)" ::: "memory");
    __syncthreads();
    if (threadIdx.x == 0) {
        unsigned* bar = b.bar;
        __builtin_amdgcn_s_waitcnt(0);
        unsigned nloc = b.st[0], nx = b.st[1];
        if (nloc == 0u) { xcd_barrier_complete(bar, b.x, nloc, nx); b.st[0] = nloc; b.st[1] = nx; }
        const unsigned old = xb_add(&bar[XB_XSUB(b.x)], 1u);
        const unsigned gen = old / nloc;
        if (old + 1u == (gen + 1u) * nloc) {
            __builtin_amdgcn_fence(__ATOMIC_RELEASE, "agent");
            asm volatile("s_waitcnt vmcnt(0)" ::: "memory");
            const unsigned og = xb_add(&bar[XB_TOP], 1u);
            const unsigned tg = og / nx;
            if (og + 1u == (tg + 1u) * nx) xb_add(&bar[XB_TOPGEN], 1u);
            else XB_SPIN(xb_ld(&bar[XB_TOPGEN]) == tg, bar);
            __builtin_amdgcn_fence(__ATOMIC_ACQUIRE, "agent");
            xb_add(&bar[XB_XGEN(b.x)], 1u);
            asm volatile("s_waitcnt vmcnt(0)" ::: "memory");
        } else {
            XB_SPIN(xb_ld(&bar[XB_XGEN(b.x)]) == gen, bar);
            __builtin_amdgcn_fence(__ATOMIC_ACQUIRE, "agent");
            asm volatile("s_waitcnt vmcnt(0)" ::: "memory");
        }
    }
    __syncthreads();
}


struct Frame {
    LAS unsigned char* lds;
    volatile LAS unsigned* MISC;
    gu32* ctl;
    int tid, lane, wave, G;
    unsigned char* ws;
    const float* in[26];
    float* out;
    unsigned long long pb0, pacc, pacc2;
};
#define FPB0(k) do { if ((PROBE_PHASE >> (k)) & 1) F.pb0 = __builtin_amdgcn_s_memrealtime(); } while (0)
#define FPB1(k) do { if ((PROBE_PHASE >> (k)) & 1) F.pacc += __builtin_amdgcn_s_memrealtime() - F.pb0; } while (0)
__device__ __forceinline__ float wave_sum(float v) {
#pragma unroll
    for (int o = 1; o < 64; o <<= 1) v += __shfl_xor(v, o);
    return v;
}

template <int KR> __device__ __forceinline__ void tr_issue(const float* W, int N, int item, int lane, float (&wv)[KR / 2]) {
    const int nblk = N / 32, kb = item / nblk, nb = item % nblk, k0 = KR * kb, n0 = 32 * nb;
#pragma unroll
    for (int i = 0; i < KR / 2; ++i) wv[i] = W[(size_t)(k0 + 2 * i + (lane >> 5)) * N + n0 + (lane & 31)];
}
template <int KR> __device__ __forceinline__ void tr_finish(bf16* WT, int K, int N, const float* kscale, int mode, int item, LAS float* scr, int lane, const float (&wv)[KR / 2]) {
    const int nblk = N / 32, kb = item / nblk, nb = item % nblk, k0 = KR * kb, n0 = 32 * nb;
#pragma unroll
    for (int i = 0; i < KR / 2; ++i) { const int kk = 2 * i + (lane >> 5); float v = wv[i]; if (kscale) v *= kscale[k0 + kk]; scr[kk * 33 + (lane & 31)] = v; }
    LDS_WAIT(); asm volatile("" ::: "memory");
    constexpr int CH = KR / 8;
    const int c = lane & (CH - 1);
#pragma unroll
    for (int jj = 0; jj < CH / 2; ++jj) { const int n = (lane / CH) + (64 / CH) * jj; const LAS float* s = scr + (8 * c) * 33 + n;
        v4u o; o.x = pk2(s[0 * 33], s[1 * 33]); o.y = pk2(s[2 * 33], s[3 * 33]); o.z = pk2(s[4 * 33], s[5 * 33]); o.w = pk2(s[6 * 33], s[7 * 33]);
        const int nn = n0 + n; const int dr = (mode == 0) ? nn : (256 * (nn >> 7) + (nn & 127) + (mode == 2 ? 128 : 0));
        *(GAS v4u*)(WT + (size_t)dr * K + k0 + 8 * c) = o; }
    LDS_WAIT(); asm volatile("" ::: "memory");
}
#define CONV_P4(it, CALL) do { constexpr int I_GU_ = (DM / 64) * (DFF / 32), I_P_ = (ATTW / 64) * (DM / 32); int r_ = (it); \
        if (r_ < I_GU_) { CALL(F.in[22], (bf16*)(F.ws + WS_WGU), DM, DFF, F.in[21], 1, r_); } \
        else if ((r_ -= I_GU_) < I_GU_) { CALL(F.in[23], (bf16*)(F.ws + WS_WGU), DM, DFF, F.in[21], 2, r_); } \
        else if ((r_ -= I_GU_) < I_P_) { CALL(F.in[18], (bf16*)(F.ws + WS_WPA), ATTW, DM, (const float*)nullptr, 0, r_); } \
        else if ((r_ -= I_P_) < I_P_) { CALL(F.in[19], (bf16*)(F.ws + WS_WPR), RC, DM, (const float*)nullptr, 0, r_); } \
        else if ((r_ -= I_P_) < (DM / 64) * (DM / 32)) { CALL(F.in[20], (bf16*)(F.ws + WS_WOUT), DM, DM, (const float*)nullptr, 0, r_); } \
        else { r_ -= (DM / 64) * (DM / 32); CALL(F.in[24], (bf16*)(F.ws + WS_WD), DFF, DM, (const float*)nullptr, 0, r_); } } while (0)
constexpr int N_P4_ITEMS = 2 * (DM / 64) * (DFF / 32) + 2 * (ATTW / 64) * (DM / 32) + (DM / 64) * (DM / 32) + (DFF / 64) * (DM / 32);
constexpr int N_WD_HALF_ITEMS = (DFF / 32) * (DM / 32);
__device__ __forceinline__ void convert_p4(Frame& F, LAS float* scr, int first, int stride) {
    int it = first; if (it >= N_P4_ITEMS) return;
    float wv[32];
#define CVI(W_, WT_, K_, N_, ks_, md_, item_) tr_issue<64>(W_, N_, item_, F.lane, wv)
#define CVN(W_, WT_, K_, N_, ks_, md_, item_) tr_issue<64>(W_, N_, item_, F.lane, nv)
#define CVF(W_, WT_, K_, N_, ks_, md_, item_) tr_finish<64>(WT_, K_, N_, ks_, md_, item_, scr, F.lane, wv)
    CONV_P4(it, CVI);
    for (;;) { const int itn = it + stride; const bool more = itn < N_P4_ITEMS; float nv[32];
        if (more) CONV_P4(itn, CVN);
        CONV_P4(it, CVF);
        if (!more) break;
        it = itn;
#pragma unroll
        for (int i = 0; i < 32; ++i) wv[i] = nv[i]; }
#undef CVI
#undef CVN
#undef CVF
}
__device__ __forceinline__ void convert_win(Frame& F, LAS float* scr, int first, int stride) {
    constexpr int NI = (DM / 64) * (INW / 32); bf16* WT = (bf16*)(F.ws + WS_WIN);
    int it = first; if (it >= NI) return;
    float wv[32]; tr_issue<64>(F.in[3], INW, it, F.lane, wv);
    for (;;) { const int itn = it + stride; const bool more = itn < NI; float nv[32];
        if (more) tr_issue<64>(F.in[3], INW, itn, F.lane, nv);
        tr_finish<64>(WT, DM, INW, nullptr, 0, it, scr, F.lane, wv);
        if (!more) break;
        it = itn;
#pragma unroll
        for (int i = 0; i < 32; ++i) wv[i] = nv[i]; }
}
__device__ __forceinline__ void rms_row_to_bf16(int lane, const float* xrow, const float* w, bf16* orow) {
    const GAS f32x4* xr = (const GAS f32x4*)xrow + lane;
    f32x4 v[16]; float s = 0.f;
#pragma unroll
    for (int j = 0; j < 16; ++j) { v[j] = xr[64 * j]; s += (v[j].x * v[j].x + v[j].y * v[j].y) + (v[j].z * v[j].z + v[j].w * v[j].w); }
    const float rstd = 1.f / sqrtf(wave_sum(s) * (1.f / DM) + RMS_EPS);
    const GAS f32x4* wr = (const GAS f32x4*)w + lane;
    GAS v2u* o8 = (GAS v2u*)orow + lane;
#pragma unroll
    for (int j = 0; j < 16; ++j) { const f32x4 ww = wr[64 * j]; v2u o; o.x = pk2(v[j].x * rstd * ww.x, v[j].y * rstd * ww.y); o.y = pk2(v[j].z * rstd * ww.z, v[j].w * rstd * ww.w); o8[64 * j] = o; }
}
__device__ const double ROPE_INV[16] = {
    1.0000000000000000000000000e+0,
    4.4036660267178047359198331e-1,
    1.9392274474868577334259386e-1,
    8.5397100285765611280149662e-2,
    3.7606030930863935681246092e-2,
    1.6560440080994445548947445e-2,
    7.2926647372171090477661219e-3,
    3.2114459947525910185434889e-3,
    1.4142135623730950488016887e-3,
    6.2277242191459597955502746e-4,
    2.7424817567620731825332265e-4,
    1.2076973741146503832424826e-4,
    5.3182958969449886162502429e-5,
    2.3419998961409341542188076e-5,
    1.0313385377212458859810127e-5,
    4.5416704806078696531998012e-6
};

__device__ __forceinline__ void p0_prologue(Frame& F) {
    LAS float* scr = (LAS float*)(F.lds + F.wave * 16384);
    const int gw = blockIdx.x * 8 + F.wave, NGW = F.G * 8;
    bf16* Wint = (bf16*)(F.ws + WS_WIN); bf16* H = (bf16*)(F.ws + WS_H);
    convert_win(F, scr, gw, NGW);
    for (int m = gw; m < MPAD + (INWP - INW); m += NGW) {
        if (m < SEQ) rms_row_to_bf16(F.lane, F.in[0] + (size_t)m * DM, F.in[2], H + (size_t)m * DM);
        else if (m < LTOK) rms_row_to_bf16(F.lane, F.in[1] + (size_t)(m - SEQ) * DM, F.in[2], H + (size_t)m * DM);
        else { bf16* row = (m < MPAD) ? H + (size_t)m * DM : Wint + (size_t)(INW + (m - MPAD)) * DM; GAS v4u* o = (GAS v4u*)row + F.lane;
#pragma unroll
            for (int j = 0; j < 8; ++j) o[64 * j] = (v4u){0u, 0u, 0u, 0u}; }
    }
    const int gt = blockIdx.x * 512 + F.tid, NGT = F.G * 512;
    float* rope = (float*)(F.ws + WS_ROPE);
    for (int i = gt; i < LTOK * 16; i += NGT) { const int pos = i >> 4, k = i & 15;
        const double ang = (double)pos * ROPE_INV[k]; const double kq = __builtin_rint(ang * 0.15915494309189535);
        const double red = (ang - kq * 6.28318530717958623) - kq * 2.4492935982947064e-16; const float rf = (float)red;
        rope[2 * i] = cosf(rf); rope[2 * i + 1] = sinf(rf); }
    bf16* w2t = (bf16*)(F.ws + WS_LW2); bf16* a2t = (bf16*)(F.ws + WS_LA2); bf16* g2t = (bf16*)(F.ws + WS_LG2);
    for (int i = gt; i < 2 * 96 * RC; i += NGT) { const int c = i % RC, j = (i / RC) % 96, d = i / (RC * 96);
        w2t[((size_t)d * RC + c) * 96 + j] = (bf16)f2bf(F.in[8][i]); a2t[((size_t)d * RC + c) * 96 + j] = (bf16)f2bf(F.in[10][i]); }
    for (int i = gt; i < 256 * RC; i += NGT) { const int c = i % RC, j = i / RC; g2t[(size_t)c * 256 + j] = (bf16)f2bf(F.in[11][i]); }
}

__device__ __forceinline__ int crow(int r, int hi) { return (r & 3) + 8 * (r >> 2) + 4 * hi; }
__device__ __forceinline__ void attn_phase(Frame& F, const int gw, const int NGW) {
    const bf16* Q = (const bf16*)(F.ws + WS_Q); const bf16* K = (const bf16*)(F.ws + WS_K); const bf16* Vt = (const bf16*)(F.ws + WS_VT); bf16* OA = (bf16*)(F.ws + WS_OATT);
    const float* sink = F.in[17];
    const int hh = F.lane >> 5, r = F.lane & 31;
    constexpr float SC = 0.08838834764831845f * 1.4426950408889634f, L2E = 1.4426950408889634f;
    for (int item = gw; item < 4096; item += NGW) {
        const int sub = item & 3, hq = (item >> 2) & 15, qb = item >> 6, q0 = qb * 128 + sub * 32, hk = hq >> 2;
        bf16x8 bq[8];
        { const bf16* qp = Q + (size_t)(q0 + r) * ATTW + hq * 128 + 8 * hh;
#pragma unroll
          for (int s = 0; s < 8; ++s) bq[s] = *(const bf16x8*)(qp + 16 * s); }
        f32x16 O[4];
#pragma unroll
        for (int dt = 0; dt < 4; ++dt)
#pragma unroll
            for (int i = 0; i < 16; ++i) O[dt][i] = 0.f;
        float m = sink[hq] * L2E, l = (hh == 0) ? 1.f : 0.f;
        const int tlo = (q0 >= 128) ? 0 : 4 - q0 / 32, thi = (q0 + 128 + 32 <= SEQ) ? 8 : 4 + (SEQ - 32 - q0) / 32;
        int ti = tlo;
        bf16x8 ak[8];
        { const int key0 = q0 + 32 * (ti - 4); const bf16* kp = K + (size_t)(key0 + r) * KVW + hk * 128 + 8 * hh;
#pragma unroll
          for (int s = 0; s < 8; ++s) ak[s] = *(const bf16x8*)(kp + 16 * s); }
        for (;;) {
            const bool meta = (ti == 9);
            const int key0 = meta ? SEQ : q0 + 32 * (ti - 4);
            const int tn = (ti < thi) ? ti + 1 : 9; const int keyn = (tn == 9) ? SEQ : q0 + 32 * (tn - 4);
            v2u av[4][2][2]; bf16x8 akn[8];
#pragma unroll
            for (int dt = 0; dt < 4; ++dt) { const bf16* vp = Vt + (size_t)(hk * 128 + 32 * dt + r) * MPAD + key0 + 4 * hh;
#pragma unroll
                for (int s2 = 0; s2 < 2; ++s2) { av[dt][s2][0] = *(const v2u*)(vp + 16 * s2); av[dt][s2][1] = *(const v2u*)(vp + 16 * s2 + 8); } }
            { const bf16* kp = K + (size_t)(keyn + r) * KVW + hk * 128 + 8 * hh;
#pragma unroll
              for (int s = 0; s < 8; ++s) akn[s] = *(const bf16x8*)(kp + 16 * s); }
            f32x16 st;
#pragma unroll
            for (int i = 0; i < 16; ++i) st[i] = 0.f;
#pragma unroll
            for (int s = 0; s < 8; ++s) st = __builtin_amdgcn_mfma_f32_32x32x16_bf16(ak[s], bq[s], st, 0, 0, 0);
            float tmax = -__builtin_inff();
#pragma unroll
            for (int i = 0; i < 16; ++i) { const int kr = crow(i, hh); bool ok;
                if (meta) ok = kr < NMETA; else { const int dlt = (key0 + kr) - (q0 + r); ok = (dlt >= -128) && (dlt <= 128); }
                const float t = ok ? st[i] * SC : -__builtin_inff(); st[i] = t; tmax = fmaxf(tmax, t); }
            tmax = fmaxf(tmax, __shfl_xor(tmax, 32));
            const float mn = fmaxf(m, tmax), alpha = __builtin_amdgcn_exp2f(m - mn); m = mn;
            float ps = 0.f;
#pragma unroll
            for (int i = 0; i < 16; ++i) { const float p = __builtin_amdgcn_exp2f(st[i] - mn); st[i] = p; ps += p; }
            l = l * alpha + ps;
#pragma unroll
            for (int dt = 0; dt < 4; ++dt)
#pragma unroll
                for (int i = 0; i < 16; ++i) O[dt][i] *= alpha;
            bf16x8 pb[2];
#pragma unroll
            for (int s2 = 0; s2 < 2; ++s2) { v4u w; w.x = pg8::cvt_pk_bf16(st[8 * s2 + 0], st[8 * s2 + 1]); w.y = pg8::cvt_pk_bf16(st[8 * s2 + 2], st[8 * s2 + 3]);
                w.z = pg8::cvt_pk_bf16(st[8 * s2 + 4], st[8 * s2 + 5]); w.w = pg8::cvt_pk_bf16(st[8 * s2 + 6], st[8 * s2 + 7]); pb[s2] = __builtin_bit_cast(bf16x8, w); }
#pragma unroll
            for (int dt = 0; dt < 4; ++dt)
#pragma unroll
                for (int s2 = 0; s2 < 2; ++s2) { const v4u w = {av[dt][s2][0].x, av[dt][s2][0].y, av[dt][s2][1].x, av[dt][s2][1].y};
                    O[dt] = __builtin_amdgcn_mfma_f32_32x32x16_bf16(__builtin_bit_cast(bf16x8, w), pb[s2], O[dt], 0, 0, 0); }
            if (meta) break;
            ti = tn;
#pragma unroll
            for (int s = 0; s < 8; ++s) ak[s] = akn[s];
        }
        l += __shfl_xor(l, 32);
        const float inv = 1.0f / l;
        bf16* op = OA + (size_t)(q0 + r) * ATTW + hq * 128 + 4 * hh;
#pragma unroll
        for (int dt = 0; dt < 4; ++dt)
#pragma unroll
            for (int g4 = 0; g4 < 4; ++g4) { v2u w; w.x = pg8::cvt_pk_bf16(O[dt][4 * g4 + 0] * inv, O[dt][4 * g4 + 1] * inv); w.y = pg8::cvt_pk_bf16(O[dt][4 * g4 + 2] * inv, O[dt][4 * g4 + 3] * inv);
                *(v2u*)(op + 32 * dt + 8 * g4) = w; }
    }
}

__device__ __forceinline__ int tok2row(int t) { return t < NMETA ? SEQ + t : t - NMETA; }
struct Sh8 { v4u uc, up, un; };
__device__ __forceinline__ Sh8 shift8_ld(const bf16* U, int t, int col) {
    const int tc = t < LTOK ? t : LTOK - 1, tp = (t >= 1 && t - 1 < LTOK) ? t - 1 : 0, tn = t + 1 < LTOK ? t + 1 : LTOK - 1;
    Sh8 s; s.uc = *(const v4u*)(U + (size_t)tok2row(tc) * UPITCH + col); s.up = *(const v4u*)(U + (size_t)tok2row(tp) * UPITCH + col); s.un = *(const v4u*)(U + (size_t)tok2row(tn) * UPITCH + col); return s; }
__device__ __forceinline__ void shift8_fin(const Sh8& s, int t, int col, const float* mu_p, const float* mu_n, float (&x)[8]) {
    const v4u zz = {0u, 0u, 0u, 0u};
    const v4u uc = t < LTOK ? s.uc : zz, up = (t >= 1 && t - 1 < LTOK) ? s.up : zz, un = t + 1 < LTOK ? s.un : zz;
    const f32x4 mp0 = *(const f32x4*)(mu_p + col), mp1 = *(const f32x4*)(mu_p + col + 4), mn0 = *(const f32x4*)(mu_n + col), mn1 = *(const f32x4*)(mu_n + col + 4);
    const unsigned ucw[4] = {uc.x, uc.y, uc.z, uc.w}, upw[4] = {up.x, up.y, up.z, up.w}, unw[4] = {un.x, un.y, un.z, un.w};
    const float mpw[8] = {mp0[0], mp0[1], mp0[2], mp0[3], mp1[0], mp1[1], mp1[2], mp1[3]}, mnw[8] = {mn0[0], mn0[1], mn0[2], mn0[3], mn1[0], mn1[1], mn1[2], mn1[3]};
#pragma unroll
    for (int e = 0; e < 8; ++e) { const float c0 = (e & 1) ? bfhi(ucw[e >> 1]) : bflo(ucw[e >> 1]), p0 = (e & 1) ? bfhi(upw[e >> 1]) : bflo(upw[e >> 1]), n0 = (e & 1) ? bfhi(unw[e >> 1]) : bflo(unw[e >> 1]);
        x[e] = c0 + mpw[e] * (p0 - c0) + mnw[e] * (n0 - c0); }
}
__device__ __forceinline__ void flush_bf16(const LAS bf16* tile, bf16* ARR, int t0, int cbase, int lane) {
#pragma unroll
    for (int h = 0; h < 2; ++h) { const int row = (lane >> 2) + 16 * h, ch = lane & 3; const v4u v = *(const LAS v4u*)(tile + row * 32 + 8 * ch);
        if (t0 + row < LTOK) *(v4u*)(ARR + (size_t)(t0 + row) * RC + cbase + 8 * ch) = v; }
}
__device__ __forceinline__ void flush_f32(const LAS float* tile, float* ARR, int t0, int cbase, int lane) {
#pragma unroll
    for (int h = 0; h < 4; ++h) { const int row = (lane >> 3) + 8 * h, ch = lane & 7; const f32x4 v = *(const LAS f32x4*)(tile + row * 32 + 4 * ch);
        if (t0 + row < LTOK) *(f32x4*)(ARR + (size_t)(t0 + row) * RC + cbase + 4 * ch) = v; }
}
__device__ __forceinline__ void prep_phase(Frame& F) {
    constexpr int XS = 648;
    LAS bf16* Xs = (LAS bf16*)F.lds;
    LAS bf16* Kt = (LAS bf16*)(F.lds + 41472 + F.wave * 8192);
    LAS bf16* Ot = Kt + 2048;
    const bf16* U = (const bf16*)(F.ws + WS_U);
    const float* mu_p = F.in[5]; const float* mu_n = F.in[6];
    const bf16* w2t = (const bf16*)(F.ws + WS_LW2); const bf16* a2t = (const bf16*)(F.ws + WS_LA2); const bf16* g2t = (const bf16*)(F.ws + WS_LG2);
    float* W0 = (float*)(F.ws + WS_W0); float* W1 = (float*)(F.ws + WS_W1);
    bf16* KD0 = (bf16*)(F.ws + WS_KD0); bf16* KD1 = (bf16*)(F.ws + WS_KD1); bf16* B0 = (bf16*)(F.ws + WS_B0); bf16* B1 = (bf16*)(F.ws + WS_B1);
    bf16* KK = (bf16*)(F.ws + WS_KK); bf16* RR = (bf16*)(F.ws + WS_RR); bf16* VV = (bf16*)(F.ws + WS_VV); bf16* GG = (bf16*)(F.ws + WS_GG);
    const int hh = F.lane >> 5, r = F.lane & 31;
    for (int unit = blockIdx.x; unit < 257 * 4; unit += F.G) {
        const int tt = unit >> 2, t0 = tt * 32, hd = (unit & 3) * 8 + F.wave;
        __syncthreads();
        FPB0(15);
        { Sh8 sx[5];
#pragma unroll
          for (int it = 0; it < 5; ++it) { const int ci = F.tid + 512 * it; sx[it] = shift8_ld(U, t0 + ci / 80, 3 * RC + 8 * (ci % 80)); }
#pragma unroll
          for (int it = 0; it < 5; ++it) { const int ci = F.tid + 512 * it, tl = ci / 80, ch = ci % 80;
            float x[8]; shift8_fin(sx[it], t0 + tl, 3 * RC + 8 * ch, mu_p, mu_n, x);
#pragma unroll
            for (int e = 0; e < 8; ++e) { float v = x[e];
                if (ch < 24) { const float ex = __expf(2.0f * v); v = 1.0f - 2.0f / (ex + 1.0f); }
                else if (ch >= 48) v = sigmoidf_(v);
                x[e] = v; }
            v4u o; o.x = pk2(x[0], x[1]); o.y = pk2(x[2], x[3]); o.z = pk2(x[4], x[5]); o.w = pk2(x[6], x[7]);
            *(LAS v4u*)(Xs + tl * XS + 8 * ch) = o; } }
        { const int c8 = hd * 64 + 8 * (F.lane & 7);
#pragma unroll
          for (int st = 0; st < 3; ++st) { const int col = (st == 0 ? RC : st == 1 ? 0 : 2 * RC) + c8; Sh8 sq[4];
#pragma unroll
            for (int q = 0; q < 4; ++q) sq[q] = shift8_ld(U, t0 + (F.lane >> 3) + 8 * q, col);
#pragma unroll
            for (int q = 0; q < 4; ++q) { const int tl = (F.lane >> 3) + 8 * q, tq = t0 + tl; float x[8]; shift8_fin(sq[q], tq, col, mu_p, mu_n, x);
                v4u o; o.x = pk2(x[0], x[1]); o.y = pk2(x[2], x[3]); o.z = pk2(x[4], x[5]); o.w = pk2(x[6], x[7]);
                if (st == 0) *(LAS v4u*)(Kt + tl * 64 + 8 * (F.lane & 7)) = o;
                else if (tq < LTOK) *(v4u*)((st == 1 ? RR : VV) + (size_t)tq * RC + c8) = o; } } }
        __syncthreads();
        FPB1(15); FPB0(16);
        float kp[2][16], ss[16];
#pragma unroll
        for (int i = 0; i < 16; ++i) ss[i] = 0.f;
#pragma unroll
        for (int ct = 0; ct < 2; ++ct) { const int c = hd * 64 + 32 * ct + r; const float kkw = F.in[12][c];
#pragma unroll
            for (int i = 0; i < 16; ++i) { kp[ct][i] = bf2f(Kt[crow(i, hh) * 64 + 32 * ct + r]); const float kr = kp[ct][i] * kkw; ss[i] += kr * kr; } }
#pragma unroll
        for (int i = 0; i < 16; ++i) {
#pragma unroll
            for (int o = 1; o < 32; o <<= 1) ss[i] += __shfl_xor(ss[i], o);
            ss[i] = 1.0f / fmaxf(sqrtf(ss[i]), 1e-12f); }
#define LDF(dst, ptr, n) do { _Pragma("unroll") for (int s_ = 0; s_ < (n); ++s_) dst[s_] = *(const bf16x8*)((ptr) + 16 * s_); } while (0)
#define MMF(frag, xoff, n) do { _Pragma("unroll") for (int i_ = 0; i_ < 16; ++i_) acc[i_] = 0.f; const LAS bf16* ap_ = Xs + r * XS + (xoff) + 8 * hh; \
            _Pragma("unroll") for (int s_ = 0; s_ < (n); ++s_) acc = __builtin_amdgcn_mfma_f32_32x32x16_bf16(*(const LAS bf16x8*)(ap_ + 16 * s_), frag[s_], acc, 0, 0, 0); } while (0)
#pragma unroll
        for (int ct = 0; ct < 2; ++ct) {
            const int c = hd * 64 + 32 * ct + r, cb = hd * 64 + 32 * ct;
            const float kkw = F.in[12][c], kaw = F.in[13][c];
            const bf16* pa0 = a2t + (size_t)c * 96 + 8 * hh; const bf16* pa1 = a2t + ((size_t)RC + c) * 96 + 8 * hh;
            const bf16* pw0 = w2t + (size_t)c * 96 + 8 * hh; const bf16* pw1 = w2t + ((size_t)RC + c) * 96 + 8 * hh; const bf16* pg = g2t + (size_t)c * 256 + 8 * hh;
            bf16x8 fa[6], fg[16]; f32x16 acc; float kk[16];
            LDF(fa, pa0, 6);
#pragma unroll
            for (int i = 0; i < 16; ++i) { kk[i] = kp[ct][i] * kkw * ss[i]; Ot[crow(i, hh) * 32 + r] = (bf16)f2bf(kk[i]); }
            flush_bf16(Ot, KK, t0, cb, F.lane);
#pragma unroll
            for (int d = 0; d < 2; ++d) {
                if (d == 0) { MMF(fa, 192, 6); LDF(fa, pa1, 6); } else { MMF(fa, 288, 6); LDF(fa, pw0, 6); }
                const float a0 = F.in[9][d * RC + c];
#pragma unroll
                for (int i = 0; i < 16; ++i) { acc[i] = sigmoidf_(a0 + acc[i]); Ot[crow(i, hh) * 32 + r] = (bf16)f2bf(kp[ct][i] * (1.0f + (acc[i] - 1.0f) * kaw)); }
                flush_bf16(Ot, d ? KD1 : KD0, t0, cb, F.lane);
#pragma unroll
                for (int i = 0; i < 16; ++i) Ot[crow(i, hh) * 32 + r] = (bf16)f2bf(kk[i] * acc[i]);
                flush_bf16(Ot, d ? B1 : B0, t0, cb, F.lane);
            }
#pragma unroll
            for (int d = 0; d < 2; ++d) {
                if (d == 0) { MMF(fa, 0, 6); LDF(fa, pw1, 6); } else { MMF(fa, 96, 6); LDF(fg, pg, 16); }
                const float w0 = F.in[7][d * RC + c]; LAS float* Of = (LAS float*)Ot;
#pragma unroll
                for (int i = 0; i < 16; ++i) Of[crow(i, hh) * 32 + r] = __expf(-0.6065306597126334f * sigmoidf_(w0 + acc[i]));
                flush_f32(Of, d ? W1 : W0, t0, cb, F.lane);
            }
            MMF(fg, 384, 16);
#pragma unroll
            for (int i = 0; i < 16; ++i) Ot[crow(i, hh) * 32 + r] = (bf16)f2bf(acc[i]);
            flush_bf16(Ot, GG, t0, cb, F.lane);
        }
#undef LDF
#undef MMF
        FPB1(16);
    }
    __syncthreads();
}

__device__ __forceinline__ int blk_tok(int d, int blk, int u) { return d ? (LTOK - 1 - 16 * blk - u) : (16 * blk + u); }
__device__ __forceinline__ size_t bo_item(int hd, int d, int blk) { return (size_t)(hd * NBT + (d ? NB0 : 0) + blk) * BO_ITEM; }
__device__ __forceinline__ v4u pack8(const float (&x)[8]) { v4u o; o.x = pk2(x[0], x[1]); o.y = pk2(x[2], x[3]); o.z = pk2(x[4], x[5]); o.w = pk2(x[6], x[7]); return o; }
__device__ __forceinline__ void blockprep_phase(Frame& F) {
    LAS unsigned char* wl = F.lds + F.wave * 16384;
    constexpr int LP = 72;
    LAS bf16* LT = (LAS bf16*)wl;
    LAS float* GM = (LAS float*)(wl + 9216);
    LAS float* TM = (LAS float*)(wl + 13312);
    LAS float* TB = (LAS float*)(wl + 14336);
    LAS float* AH = (LAS float*)(wl + 15360);
    const float* W0 = (const float*)(F.ws + WS_W0); const float* W1 = (const float*)(F.ws + WS_W1);
    const bf16* KD0 = (const bf16*)(F.ws + WS_KD0); const bf16* KD1 = (const bf16*)(F.ws + WS_KD1); const bf16* B0 = (const bf16*)(F.ws + WS_B0); const bf16* B1 = (const bf16*)(F.ws + WS_B1);
    const bf16* KK = (const bf16*)(F.ws + WS_KK); const bf16* RR = (const bf16*)(F.ws + WS_RR);
    float* BON = (float*)(F.ws + WS_BONUS); unsigned char* BO = F.ws + WS_BO;
    int lz; asm volatile("v_mov_b32 %0, 0" : "=v"(lz));
    const int gw = blockIdx.x * 8 + F.wave, NGW = F.G * 8, j = F.lane + lz, hh = j >> 5, r31 = j & 31, c16 = j & 15;
    for (int it = gw; it < RH * NBT; it += NGW) {
        const int hd = it / NBT, rem = it % NBT, d = rem >= NB0 ? 1 : 0, blk = d ? rem - NB0 : rem, c = hd * 64 + j;
        const float* Wd = d ? W1 : W0; const bf16* KDd = d ? KD1 : KD0; const bf16* Bd = d ? B1 : B0;
        float kt[16], rt[16], kdh[16], bh[16]; float G15;
        { float G[16];
          { float g = 1.f;
#pragma unroll
            for (int u = 0; u < 16; ++u) { g *= Wd[(size_t)blk_tok(d, blk, u) * RC + c]; G[u] = g; } }
          asm volatile("" ::: "memory");
          const float rkw = F.in[14][c];
#pragma unroll
          for (int u = 0; u < 16; ++u) { const size_t o = (size_t)blk_tok(d, blk, u) * RC + c; kdh[u] = bf2f(KDd[o]); rt[u] = bf2f(RR[o]); }
#pragma unroll
          for (int u = 0; u < 16; ++u) { const float s = wave_sum(rt[u] * kdh[u] * rkw); if (F.lane == 0) atomicAdd(BON + (size_t)blk_tok(d, blk, u) * RH + hd, s);
              kdh[u] = kdh[u] / G[u]; rt[u] = rt[u] * G[u]; LT[(0 * 16 + u) * LP + j] = (bf16)f2bf(kdh[u]); LT[(3 * 16 + u) * LP + j] = (bf16)f2bf(rt[u]); }
          asm volatile("" ::: "memory");
#pragma unroll
          for (int u = 0; u < 16; ++u) { const size_t o = (size_t)blk_tok(d, blk, u) * RC + c; kt[u] = bf2f(KK[o]); bh[u] = bf2f(Bd[o]); }
#pragma unroll
          for (int u = 0; u < 16; ++u) { kt[u] = kt[u] * (u ? G[u - 1] : 1.f); bh[u] = bh[u] / G[u]; LT[(2 * 16 + u) * LP + j] = (bf16)f2bf(kt[u]); LT[(1 * 16 + u) * LP + j] = (bf16)f2bf(bh[u]); }
          G15 = G[15]; }
        asm volatile("" ::: "memory");
        f32x16 gacc;
#pragma unroll
        for (int i = 0; i < 16; ++i) gacc[i] = 0.f;
        { const LAS bf16* ap = LT + ((r31 < 16 ? 0 : 1) * 16 + (r31 & 15)) * LP + 8 * hh; const LAS bf16* bp = LT + ((r31 < 16 ? 2 : 3) * 16 + (r31 & 15)) * LP + 8 * hh;
#pragma unroll
          for (int s = 0; s < 4; ++s) gacc = __builtin_amdgcn_mfma_f32_32x32x16_bf16(*(const LAS bf16x8*)(ap + 16 * s), *(const LAS bf16x8*)(bp + 16 * s), gacc, 0, 0, 0); }
        float ga[16];
#pragma unroll
        for (int i = 0; i < 16; ++i) ga[i] = gacc[i];
#define RL(x, ln) __builtin_bit_cast(float, __builtin_amdgcn_readlane(__builtin_bit_cast(int, (x)), (ln)))
#define GREG(m) (4 * ((m) >> 3) + ((m) & 3))
#define GLN(m) (32 * (((m) >> 2) & 1))
#define A_(m, u)  RL(ga[GREG(m)], (u) + GLN(m))
#define B_(m, u)  RL(ga[8 + GREG(m)], (u) + GLN(m))
        float Tr[16];
#pragma unroll
        for (int m = 15; m >= 0; --m) { float s = (c16 == m) ? 1.f : 0.f;
#pragma unroll
            for (int u = m + 1; u < 16; ++u) s -= B_(m, u) * Tr[u];
            Tr[m] = s; }
        float bpc[16], apc[16];
#pragma unroll
        for (int u = 0; u < 16; ++u) { const int src = 16 + c16 + GLN(u); const float vb = __shfl(ga[8 + GREG(u)], src), va = __shfl(ga[GREG(u)], src);
            bpc[u] = (u <= c16) ? vb : 0.f; apc[u] = (u <= c16) ? va : 0.f; }
#pragma unroll
        for (int m = 0; m < 16; ++m) { float s = 0.f;
#pragma unroll
            for (int u = m; u < 16; ++u) s += RL(Tr[m], u) * bpc[u];
            bpc[m] = s; }
#pragma unroll
        for (int m = 0; m < 16; ++m) { float s = apc[m];
#pragma unroll
            for (int u = m + 1; u < 16; ++u) s -= A_(m, u) * bpc[u];
            AH[m * 16 + c16] = s; }
        float M1[16], M2[16];
#pragma unroll
        for (int m = 0; m < 16; ++m) { float s = 0.f;
#pragma unroll
            for (int u = m; u < 16; ++u) s += RL(Tr[m], u) * bh[u];
            M1[m] = s * G15; }
#pragma unroll
        for (int m = 0; m < 16; ++m) { float s = kdh[m] * G15;
#pragma unroll
            for (int u = m + 1; u < 16; ++u) s -= A_(m, u) * M1[u];
            M2[m] = s; }
        unsigned char* base = BO + bo_item(hd, d, blk);
        { const int a = j >> 5, jp = j & 31;
#pragma unroll
          for (int h2 = 0; h2 < 2; ++h2) { float x0[8], x1[8];
#pragma unroll
              for (int e = 0; e < 8; ++e) { x0[e] = -M1[8 * (e >> 2) + 4 * h2 + (e & 3)]; x1[e] = M2[8 * h2 + e]; }
              *(v4u*)(base + BO_FB + ((a * 2 + 0) * 64 + jp + 32 * h2) * 16) = pack8(x0); *(v4u*)(base + BO_FB + ((a * 2 + 1) * 64 + jp + 32 * h2) * 16) = pack8(x1); } }
        *(float*)(base + BO_FG + 4 * j) = G15;
#pragma unroll
        for (int u = 0; u < 16; ++u) { float s = rt[u];
#pragma unroll
            for (int m = 0; m <= u; ++m) s -= RL(bpc[m], u) * kt[m];
            rt[u] = s; }
#undef RL
#undef GREG
#undef GLN
#undef A_
#undef B_
        asm volatile("" ::: "memory");
#pragma unroll
        for (int u = 0; u < 16; ++u) { LT[u * LP + j] = (bf16)f2bf(kt[u]); LT[(16 + u) * LP + j] = (bf16)f2bf(rt[u]); }
#pragma unroll
        for (int ks = 0; ks < 4; ++ks) { const int j0 = 32 * (ks >> 1) + 16 * (ks & 1) + 4 * hh; const v2u lo = *(const LAS v2u*)(LT + r31 * LP + j0), hi = *(const LAS v2u*)(LT + r31 * LP + j0 + 8);
            *(v4u*)(base + BO_FA + (ks * 64 + F.lane) * 16) = (v4u){lo.x, lo.y, hi.x, hi.y}; }
        { float x[8];
#pragma unroll
          for (int e = 0; e < 8; ++e) x[e] = (r31 >= 16) ? AH[(8 * hh + e) * 16 + (r31 - 16)] : 0.f;
          *(v4u*)(base + BO_FH + F.lane * 16) = pack8(x); }
        asm volatile("" ::: "memory");
    }
}

constexpr int N_SCAN_WAVES = 128;
constexpr int SR_SLOTS = 9, SR_STRIDE = 11264, SR_FV = 10240, SR_FLAGS = SR_SLOTS * SR_STRIDE, SR_WSCR = SR_FLAGS + 512, SR_NL = 4;
static_assert(SR_WSCR + (7 - SR_NL) * 8448 <= RING_BYTES, "scan phase LDS map");
struct LdSet { v4u p[10]; unsigned short v[8]; };
__device__ __forceinline__ void sr_issue(LdSet& s, const unsigned char* item, const bf16* VV, int hd, int d, int blk, int ih, int lane) {
#pragma unroll
    for (int k = 0; k < 10; ++k) { const int pc = k * 64 + lane; s.p[k] = *(const v4u*)(item + (pc < BO_ITEM / 16 ? pc : BO_ITEM / 16 - 1) * 16); }
    const int hh = lane >> 5, il = lane & 31;
#pragma unroll
    for (int e = 0; e < 8; ++e) s.v[e] = VV[(size_t)blk_tok(d, blk, 8 * hh + e) * RC + hd * 64 + 32 * ih + il];
}
__device__ __forceinline__ void sr_write(const LdSet& s, LAS unsigned char* slot, int lane) {
#pragma unroll
    for (int k = 0; k < 10; ++k) *(LAS v4u*)(slot + (k * 64 + lane) * 16) = s.p[k];
    const v4u vw = {(unsigned)s.v[0] | ((unsigned)s.v[1] << 16), (unsigned)s.v[2] | ((unsigned)s.v[3] << 16), (unsigned)s.v[4] | ((unsigned)s.v[5] << 16), (unsigned)s.v[6] | ((unsigned)s.v[7] << 16)};
    *(LAS v4u*)(slot + SR_FV + lane * 16) = vw;
}
__device__ __forceinline__ bf16x8 pack_half(const f32x16& x, int s) {
    const v4u w = {pk2(x[8 * s + 0], x[8 * s + 1]), pk2(x[8 * s + 2], x[8 * s + 3]), pk2(x[8 * s + 4], x[8 * s + 5]), pk2(x[8 * s + 6], x[8 * s + 7])}; return __builtin_bit_cast(bf16x8, w); }
__device__ __forceinline__ void scan_phase(Frame& F) {
    const bf16* VV = (const bf16*)(F.ws + WS_VV); bf16* Y = (bf16*)(F.ws + WS_Y); const unsigned char* BO = F.ws + WS_BO;
    const bool sblock = (int)blockIdx.x < N_SCAN_WAVES;
    volatile LAS unsigned* FL = (volatile LAS unsigned*)(F.lds + SR_FLAGS);
    constexpr unsigned SPIN_CAP = 1u << 22;
    __syncthreads();
    if (F.tid < 128) FL[F.tid] = 0u;
    __syncthreads();
    const int pair = (int)blockIdx.x >> 1, ih = (int)blockIdx.x & 1, hd = pair >> 1, d = pair & 1, nblk = d ? NB1 : NB0, hh = F.lane >> 5, il = F.lane & 31;
    if (sblock && F.wave == 0) {
        __builtin_amdgcn_s_setprio(3);
        f32x16 St[2];
#pragma unroll
        for (int a = 0; a < 2; ++a)
#pragma unroll
            for (int i = 0; i < 16; ++i) St[a][i] = 0.f;
        FPB0(17);
        for (int blk = 0; blk < nblk; ++blk) {
            const int sl = blk % SR_SLOTS; const LAS unsigned char* slot = F.lds + sl * SR_STRIDE;
            { unsigned sp = 0; while (FL[sl] != (unsigned)(blk + 1)) { __builtin_amdgcn_s_sleep(1); if (++sp > SPIN_CAP) break; } }
            asm volatile("" ::: "memory");
            bf16x8 fa[4], fb[2][2]; f32x4 gm[2][4];
#pragma unroll
            for (int ks = 0; ks < 4; ++ks) fa[ks] = *(const LAS bf16x8*)(slot + BO_FA + (ks * 64 + F.lane) * 16);
            const bf16x8 fh = *(const LAS bf16x8*)(slot + BO_FH + F.lane * 16), vf = *(const LAS bf16x8*)(slot + SR_FV + F.lane * 16);
#pragma unroll
            for (int a = 0; a < 2; ++a)
#pragma unroll
                for (int k = 0; k < 2; ++k) fb[a][k] = *(const LAS bf16x8*)(slot + BO_FB + ((a * 2 + k) * 64 + F.lane) * 16);
#pragma unroll
            for (int a = 0; a < 2; ++a)
#pragma unroll
                for (int q = 0; q < 4; ++q) gm[a][q] = *(const LAS f32x4*)(slot + BO_FG + (32 * a + 8 * q + 4 * hh) * 4);
            asm volatile("s_waitcnt lgkmcnt(0)" ::: "memory");
            if (F.lane == 0) FL[16] = (unsigned)(blk + 1);
            f32x16 acc;
#pragma unroll
            for (int i = 0; i < 16; ++i) acc[i] = 0.f;
            acc = __builtin_amdgcn_mfma_f32_32x32x16_bf16(fh, vf, acc, 0, 0, 0);
#pragma unroll
            for (int a = 0; a < 2; ++a)
#pragma unroll
                for (int s = 0; s < 2; ++s) acc = __builtin_amdgcn_mfma_f32_32x32x16_bf16(fa[2 * a + s], pack_half(St[a], s), acc, 0, 0, 0);
#pragma unroll
            for (int e = 0; e < 8; ++e) { const int u = 8 * (e >> 2) + 4 * hh + (e & 3);
                Y[((size_t)d * LTOK + blk_tok(d, blk, u)) * RC + hd * 64 + 32 * ih + il] = (bf16)f2bf(acc[8 + e]); }
            const bf16x8 zb = pack_half(acc, 0);
#pragma unroll
            for (int a = 0; a < 2; ++a) {
#pragma unroll
                for (int i = 0; i < 16; ++i) St[a][i] *= gm[a][i >> 2][i & 3];
                St[a] = __builtin_amdgcn_mfma_f32_32x32x16_bf16(fb[a][0], zb, St[a], 0, 0, 0);
                St[a] = __builtin_amdgcn_mfma_f32_32x32x16_bf16(fb[a][1], vf, St[a], 0, 0, 0);
            }
        }
        FPB1(17);
        __builtin_amdgcn_s_setprio(0);
    } else if (sblock && F.wave <= SR_NL) {
        __builtin_amdgcn_s_setprio(2);
        const int lw = F.wave - 1;
        LdSet st[2];
#define SR_PUT(set, b_) do { const int sl_ = (b_) % SR_SLOTS; if ((b_) >= SR_SLOTS) { unsigned sp_ = 0; while (FL[16] < (unsigned)((b_) - SR_SLOTS + 1)) { __builtin_amdgcn_s_sleep(1); if (++sp_ > SPIN_CAP) break; } } \
            asm volatile("" ::: "memory"); sr_write(set, F.lds + sl_ * SR_STRIDE, F.lane); asm volatile("s_waitcnt lgkmcnt(0)" ::: "memory"); if (F.lane == 0) FL[sl_] = (unsigned)((b_) + 1); } while (0)
#pragma unroll
        for (int k = 0; k < 2; ++k) { const int bb = lw + SR_NL * k; if (bb < nblk) sr_issue(st[k], BO + bo_item(hd, d, bb), VV, hd, d, bb, ih, F.lane); }
        for (int b0 = lw; b0 < nblk; b0 += 2 * SR_NL) {
#pragma unroll
            for (int k = 0; k < 2; ++k) { const int bb = b0 + SR_NL * k; if (bb < nblk) { SR_PUT(st[k], bb); const int nb = bb + 2 * SR_NL; if (nb < nblk) sr_issue(st[k], BO + bo_item(hd, d, nb), VV, hd, d, nb, ih, F.lane); } }
        }
#undef SR_PUT
        __builtin_amdgcn_s_setprio(0);
    } else {
        const int b = (int)blockIdx.x, nsb = F.G < N_SCAN_WAVES ? F.G : N_SCAN_WAVES, wps = 7 - SR_NL;
        const int widx = b < N_SCAN_WAVES ? b * wps + (F.wave - 1 - SR_NL) : nsb * wps + (b - N_SCAN_WAVES) * 8 + F.wave;
        const int NWK = nsb * wps + (F.G - nsb) * 8;
        unsigned long long rp0 = 0, rp1 = 0, rp2 = 0;
        if (PROBE_PHASE & (3 << 18)) rp0 = __builtin_amdgcn_s_memrealtime();
        LAS float* scr = (LAS float*)(F.lds + (sblock ? SR_WSCR + (F.wave - 1 - SR_NL) * 8448 : F.wave * 8448));
        attn_phase(F, widx, NWK);
        if (PROBE_PHASE & (3 << 18)) rp1 = __builtin_amdgcn_s_memrealtime();
        convert_p4(F, scr, widx, NWK);
        if (PROBE_PHASE & (3 << 18)) { rp2 = __builtin_amdgcn_s_memrealtime(); if ((int)blockIdx.x == F.G - 1 && F.tid == 0) { unsigned long long v = 0; if ((PROBE_PHASE >> 18) & 1) v += rp1 - rp0; if ((PROBE_PHASE >> 19) & 1) v += rp2 - rp1;
            __hip_atomic_store((unsigned*)(F.ctl + 2048), (unsigned)v, __ATOMIC_RELAXED, __HIP_MEMORY_SCOPE_AGENT); } }
    }
}

__device__ __forceinline__ float row16_sum(float x) {
    x += __builtin_bit_cast(float, __builtin_amdgcn_update_dpp(0, __builtin_bit_cast(int, x), 0xB1, 0xf, 0xf, true));
    x += __builtin_bit_cast(float, __builtin_amdgcn_update_dpp(0, __builtin_bit_cast(int, x), 0x4E, 0xf, 0xf, true));
    x += __builtin_bit_cast(float, __builtin_amdgcn_update_dpp(0, __builtin_bit_cast(int, x), 0x141, 0xf, 0xf, true));
    x += __builtin_bit_cast(float, __builtin_amdgcn_update_dpp(0, __builtin_bit_cast(int, x), 0x140, 0xf, 0xf, true));
    return x;
}
__device__ __forceinline__ void combine_phase(Frame& F) {
    const bf16* Y0 = (const bf16*)(F.ws + WS_Y); const bf16* Y1 = Y0 + (size_t)LTOK * RC; const float* BON = (const float*)(F.ws + WS_BONUS);
    const bf16* VV = (const bf16*)(F.ws + WS_VV); const bf16* GG = (const bf16*)(F.ws + WS_GG);
    bf16* OR = (bf16*)(F.ws + WS_ORWKV);
    const float* lnw = F.in[15]; const float* lnb = F.in[16];
    const int gw = blockIdx.x * 8 + F.wave, NGW = F.G * 8;
    for (int row = gw; row < SEQ; row += NGW) { const int t = row + NMETA;
#pragma unroll
        for (int st = 0; st < 8; ++st) { const int c = st * 256 + 4 * F.lane, hd = c >> 6; const size_t o = (size_t)t * RC + c;
            const v2u a0 = *(const v2u*)(Y0 + o), a1 = *(const v2u*)(Y1 + o), vv = *(const v2u*)(VV + o), gg = *(const v2u*)(GG + o);
            const f32x4 w = *(const f32x4*)(lnw + c), bb = *(const f32x4*)(lnb + c); const float bon = BON[(size_t)t * RH + hd];
            float y[4] = {bflo(a0.x) + bflo(a1.x), bfhi(a0.x) + bfhi(a1.x), bflo(a0.y) + bflo(a1.y), bfhi(a0.y) + bfhi(a1.y)};
            const float mean = row16_sum((y[0] + y[1]) + (y[2] + y[3])) * (1.0f / 64.0f);
#pragma unroll
            for (int e = 0; e < 4; ++e) y[e] -= mean;
            const float var = row16_sum((y[0] * y[0] + y[1] * y[1]) + (y[2] * y[2] + y[3] * y[3])) * (1.0f / 64.0f);
            const float rs = __builtin_amdgcn_rsqf(var + GN_EPS);
            const float v4[4] = {bflo(vv.x), bfhi(vv.x), bflo(vv.y), bfhi(vv.y)}, g4[4] = {bflo(gg.x), bfhi(gg.x), bflo(gg.y), bfhi(gg.y)};
            float ov[4];
#pragma unroll
            for (int e = 0; e < 4; ++e) ov[e] = (y[e] * rs * w[e] + bb[e] + bon * v4[e]) * g4[e];
            v2u ow; ow.x = pk2(ov[0], ov[1]); ow.y = pk2(ov[2], ov[3]);
            *(v2u*)(OR + (size_t)row * RC + c) = ow; } }
}
__device__ __forceinline__ void final_phase(Frame& F) {
    const float* SS3 = (const float*)(F.ctl + CW_SS3); const float* w = F.in[25];
    const int gw = blockIdx.x * 8 + F.wave, NGW = F.G * 8;
    for (int row = gw; row < SEQ; row += NGW) { const float rstd = 1.0f / sqrtf(SS3[row] * (1.0f / DM) + RMS_EPS);
        GAS f32x4* p = (GAS f32x4*)(F.out + (size_t)row * DM) + F.lane; const GAS f32x4* wp = (const GAS f32x4*)w + F.lane;
#pragma unroll
        for (int j = 0; j < 16; ++j) { const f32x4 v = p[64 * j], ww = wp[64 * j]; p[64 * j] = v * rstd * ww; } }
}
constexpr int N_PHASES = 11;
struct Args { const float* in[26]; float* out; unsigned char* ws; int ph_lo, ph_hi; };
__global__ void __launch_bounds__(512, 2) fwd_kernel(Args args) {
    extern __shared__ __attribute__((aligned(16))) unsigned char lds[];
    Frame F;
    F.lds = (LAS unsigned char*)lds;
    F.MISC = (volatile LAS unsigned*)(F.lds + MISC_OFF);
    F.tid = threadIdx.x; F.lane = F.tid & 63; F.wave = __builtin_amdgcn_readfirstlane(F.tid >> 6); F.G = gridDim.x;
    F.ws = args.ws; F.ctl = (gu32*)(args.ws + WS_CTL); F.out = args.out; F.pb0 = 0; F.pacc = 0; F.pacc2 = 0;
#pragma unroll
    for (int i = 0; i < 26; ++i) F.in[i] = args.in[i];
    for (int u = F.tid; u < (LDS_BYTES - LDSCTL_OFF) / 4; u += 512) ((LAS unsigned*)(F.lds + LDSCTL_OFF))[u] = 0u;
    __syncthreads();
    XcdBarrier bar; bar.bar = (unsigned*)(F.ctl + CW_BAR); bar.x = 0; bar.st = nullptr;
    if (!MK_SPLIT) bar = xcd_barrier_post((unsigned*)(F.ctl + CW_BAR), F.MISC + 8);
    const int lo = args.ph_lo, hi = args.ph_hi;
#define IN(k) (lo <= (k) && (k) < hi)
#define SEAM(k) do { if (IN(k) && IN((k) + 1)) xcd_barrier(bar); } while (0)
    bf16* Rm = (bf16*)(F.ws + WS_H);
    float* SS2 = (float*)(F.ctl + CW_SS2); float* SS3 = (float*)(F.ctl + CW_SS3);

    unsigned long long pt0 = 0, pt1 = 0;
#define PB0(k) do { if ((PROBE_PHASE >> (k)) & 1) pt0 = __builtin_amdgcn_s_memrealtime(); } while (0)
#define PB1(k) do { if ((PROBE_PHASE >> (k)) & 1) pt1 += __builtin_amdgcn_s_memrealtime() - pt0; } while (0)
    PB0(0); if (IN(0)) { p0_prologue(F); } SEAM(0); PB1(0);
    PB0(1); if (IN(1)) {
        pg8::Gemm g{Rm, Rm, MPAD + INWP, MPAD + INWP, DM}; pg8::InOrder S; S.init(F.G, (int)blockIdx.x);
        pg8::EpiIn E{(bf16*)(F.ws + WS_G), (bf16*)(F.ws + WS_Q), (bf16*)(F.ws + WS_K), (bf16*)(F.ws + WS_VT), (bf16*)(F.ws + WS_U), F.in[4], (const float*)(F.ws + WS_ROPE)};
        pg8::gemm_phase<pg8::EpiIn, pg8::InOrder, true, true>(F.lds, g, S, E, F.pacc2);
    } SEAM(1); PB1(1);
    PB0(2); if (IN(2)) { prep_phase(F); } SEAM(2); PB1(2);
    PB0(3); if (IN(3)) { blockprep_phase(F); } SEAM(3); PB1(3);
    PB0(4); if (IN(4)) { scan_phase(F); } SEAM(4); PB1(4);
    PB0(5); if (IN(5)) { combine_phase(F); } SEAM(5); PB1(5);
    PB0(6); if (IN(6)) {
        { pg8::Gemm g{(const bf16*)(F.ws + WS_OATT), (const bf16*)(F.ws + WS_WPA), SEQ, DM, ATTW}; pg8::StaticOrder S; S.init(SEQ, DM, F.G, (int)blockIdx.x);
          pg8::EpiProjA E{(bf16*)(F.ws + WS_P1), (const bf16*)(F.ws + WS_G)};
          pg8::gemm_phase<pg8::EpiProjA, pg8::StaticOrder, true, true>(F.lds, g, S, E, F.pacc2); }
        __syncthreads();
        { pg8::Gemm g{(const bf16*)(F.ws + WS_ORWKV), (const bf16*)(F.ws + WS_WPR), SEQ, DM, RC}; pg8::StaticOrder S; S.init(SEQ, DM, F.G, (int)blockIdx.x);
          pg8::EpiProjB E{(const bf16*)(F.ws + WS_P1), (const bf16*)(F.ws + WS_G), (bf16*)(F.ws + WS_MX)};
          pg8::gemm_phase<pg8::EpiProjB, pg8::StaticOrder, true, true>(F.lds, g, S, E, F.pacc2); }
    } SEAM(6); PB1(6);
    PB0(7); if (IN(7)) {
        pg8::Gemm g{(const bf16*)(F.ws + WS_MX), (const bf16*)(F.ws + WS_WOUT), SEQ, DM, DM}; pg8::StaticOrder S; S.init(SEQ, DM, F.G, (int)blockIdx.x);
        pg8::EpiResid<false> E{F.in[0], nullptr, nullptr, (bf16*)(F.ws + WS_A2), SS2};
        pg8::gemm_phase<pg8::EpiResid<false>, pg8::StaticOrder, true, true>(F.lds, g, S, E, F.pacc2);
    } SEAM(7); PB1(7);
    PB0(8); if (IN(8)) {
        pg8::Gemm g{(const bf16*)(F.ws + WS_A2), (const bf16*)(F.ws + WS_WGU), SEQ, 2 * DFF, DM}; pg8::StaticOrder S; S.init(SEQ, 2 * DFF, F.G, (int)blockIdx.x);
        pg8::EpiSwiGLU E{(bf16*)(F.ws + WS_HID), SS2};
        pg8::gemm_phase<pg8::EpiSwiGLU, pg8::StaticOrder, true, true>(F.lds, g, S, E, F.pacc2);
    } SEAM(8); PB1(8);
    PB0(9); if (IN(9)) {
        pg8::Gemm g{(const bf16*)(F.ws + WS_HID), (const bf16*)(F.ws + WS_WD), SEQ, DM, DFF}; pg8::StaticOrder S; S.init(SEQ, DM, F.G, (int)blockIdx.x);
        pg8::EpiResid<true> E{nullptr, (const bf16*)(F.ws + WS_A2), F.out, nullptr, SS3};
        pg8::gemm_phase<pg8::EpiResid<true>, pg8::StaticOrder, true, true>(F.lds, g, S, E, F.pacc2);
    } SEAM(9); PB1(9);
    PB0(10); if (IN(10)) { final_phase(F); } PB1(10);
    if (PROBE_PHASE != 0 && blockIdx.x == 0 && F.tid == 0) { const unsigned long long te = __builtin_amdgcn_s_memrealtime(), want = (unsigned long long)PROBE_MULT * (((PROBE_PHASE >> 20) & 1) ? F.pacc2 : (PROBE_PHASE & (3 << 18)) ? (unsigned long long)__hip_atomic_load((unsigned*)(F.ctl + 2048), __ATOMIC_RELAXED, __HIP_MEMORY_SCOPE_AGENT) : (pt1 + F.pacc));
        while (__builtin_amdgcn_s_memrealtime() - te < want && want < 2000000ull) __builtin_amdgcn_s_sleep(32); }
#undef PB0
#undef PB1
#undef IN
#undef SEAM
}

extern "C" void kernel_launch(void* const* d_in, const int* in_sizes, int n_in, void* d_out, int out_size, void* d_ws, size_t ws_size, hipStream_t stream) {
    static int grid = 0;
    if (grid == 0) {
        if (n_in != 26 || out_size != SEQ * DM || ws_size < WS_END) { fprintf(stderr, "kernel_launch: unexpected shapes (n_in %d, out %d, ws %zu, need %zu); nothing launched\n", n_in, out_size, ws_size, (size_t)WS_END); grid = -1; return; }
        int dev = 0, cus = 0, per_cu = 0;
        if (hipGetDevice(&dev) != hipSuccess || hipDeviceGetAttribute(&cus, hipDeviceAttributeMultiprocessorCount, dev) != hipSuccess) { grid = -1; return; }
        if (hipFuncSetAttribute((const void*)fwd_kernel, hipFuncAttributeMaxDynamicSharedMemorySize, LDS_BYTES) != hipSuccess) { fprintf(stderr, "kernel_launch: hipFuncSetAttribute failed\n"); grid = -1; return; }
        if (hipOccupancyMaxActiveBlocksPerMultiprocessor(&per_cu, (const void*)fwd_kernel, 512, LDS_BYTES) != hipSuccess || per_cu < 1) fprintf(stderr, "kernel_launch: occupancy query says %d per CU\n", per_cu);
        (void)hipGetLastError();
        grid = cus;
    }
    if (grid < 0) return;
    if (hipMemsetAsync((char*)d_ws + WS_CTL, 0, ZERO_BYTES, stream) != hipSuccess) return;
    Args a{};
    for (int i = 0; i < 26; ++i) a.in[i] = (const float*)d_in[i];
    a.out = (float*)d_out; a.ws = (unsigned char*)d_ws;
#if MK_SPLIT
    for (int p = 0; p < N_PHASES; ++p) { a.ph_lo = p; a.ph_hi = p + 1; hipLaunchKernelGGL(fwd_kernel, dim3(grid), dim3(512), LDS_BYTES, stream, a); }
#else
    a.ph_lo = 0; a.ph_hi = N_PHASES;
    hipLaunchKernelGGL(fwd_kernel, dim3(grid), dim3(512), LDS_BYTES, stream, a);
#endif
}
```

```cpp
#include <hip/hip_runtime.h>
#include <cstdio>
#include <cstdint>

#ifndef MK_SPLIT
#define MK_SPLIT 0
#endif

#ifndef PROBE_PHASE
#define PROBE_PHASE 0
#endif
#ifndef PROBE_MULT
#define PROBE_MULT 2
#endif
constexpr int NMETA = 16, SEQ = 8192, LTOK = 8208, DM = 4096, MPAD = 8448;
constexpr int INW = 18048, INWP = 18176;
constexpr int ATTW = 2048, KVW = 512, UW = 6784, UPITCH = 6912;
constexpr int RC = 2048, RH = 32, RN = 64;
constexpr int DFF = 11008;
constexpr float RMS_EPS = 1e-6f, GN_EPS = 64e-5f;
constexpr int HT = MPAD / 256;
constexpr int CT_Q = 32, CT_K = 40, CT_V = 42, CT_U = 44, CT_N = 71;

namespace pg8 {
#define PG8_LAS __attribute__((address_space(3)))
typedef unsigned short bf16_t;
typedef short bf16x8 __attribute__((ext_vector_type(8)));
typedef float f32x4 __attribute__((ext_vector_type(4)));
typedef unsigned u32x4 __attribute__((ext_vector_type(4)));
constexpr int BM = 256, BK = 64, HALF = 128, HTB = HALF * BK * 2  , STAGE_BYTES = 8 * HTB, NXCD = 8, WGM = 8;

__host__ __device__ __forceinline__ int lds_byte(int r, int c) { const int st = (r >> 4) * 2 + (c >> 5), rr = r & 15, cc = c & 31, ob = rr * 64 + cc * 2; return st * 1024 + (ob ^ (((ob >> 9) & 1) << 5)); }
__host__ __device__ __forceinline__ void stage_rc(int b, int& R, int& C) { const int st = b / 1024, sb = b % 1024, swz = sb ^ (((sb >> 9) & 1) << 5); R = (st >> 1) * 16 + swz / 64; C = (st & 1) * 32 + (swz % 64) / 2; }
__host__ __device__ __forceinline__ int perm32(int rho) { const int n = rho >> 4, i = rho & 15; return 8 * (i >> 2) + 4 * n + (i & 3); }

struct Unit { int pm, pn; };
struct Gemm { const bf16_t* A; const bf16_t* Bt; int M, N, K; };

struct StaticOrder {
    int nM, nN, nwg, G, c;
    __host__ __device__ void init(int M, int N, int G_, int c_) { nM = M / BM; nN = N / BM; nwg = nM * nN; G = G_; c = c_; }
    __host__ __device__ bool next(int i, Unit& u) const {
        const long L = (long)i * G + c; if (L >= nwg) return false;
        int wgid = (int)L; { const int q = nwg / NXCD, r = nwg % NXCD, xcd = wgid % NXCD, off = wgid / NXCD; wgid = (xcd < r ? xcd * (q + 1) : r * (q + 1) + (xcd - r) * q) + off; }
        const int nig = WGM * nN, gid = wgid / nig, fm = gid * WGM, gsz = (nM - fm) < WGM ? (nM - fm) : WGM;
        u.pm = fm + ((wgid % nig) % gsz); u.pn = (wgid % nig) / gsz; return true;
    }
    __device__ __forceinline__ void a_ready(const Unit&) const {}
    __device__ __forceinline__ void done(const Unit&) const {}
};

typedef float f32x2c __attribute__((ext_vector_type(2)));
typedef __bf16 bf16x2c __attribute__((ext_vector_type(2)));
__device__ __forceinline__ unsigned cvt_pk_bf16(float lo, float hi) { const f32x2c v = {lo, hi}; const bf16x2c r = __builtin_convertvector(v, bf16x2c); return __builtin_bit_cast(unsigned, r); }

typedef unsigned u32x2 __attribute__((ext_vector_type(2)));
__device__ __forceinline__ float bflo(unsigned w) { return __uint_as_float(w << 16); }
__device__ __forceinline__ float bfhi(unsigned w) { return __uint_as_float(w & 0xffff0000u); }
__device__ __forceinline__ float sigmoidf_(float x) { return __builtin_amdgcn_rcpf(1.0f + __expf(-x)); }

struct InOrder {
    StaticOrder base; int G, c;
    __device__ void init(int G_, int c_) { base.init(SEQ, INWP, G_, c_); G = G_; c = c_; }
    __device__ bool next(int i, Unit& u) const {
        const long L = (long)i * G + c;
        if (L < base.nwg) {
            base.next(i, u);
            if (u.pn >= CT_V && u.pn < CT_U) { const int e = (u.pn - CT_V) * 32 + u.pm; u.pm = HT + CT_V + e / HT; u.pn = e % HT; }
            else u.pn += HT;
            return true;
        }
        const int x = (int)(L - base.nwg);
        if (x >= 31) return false;
        if (x < 2) { const int e = 64 + x; u.pm = HT + CT_V + e / HT; u.pn = e % HT; }
        else { const int y = x - 2; u.pm = 32; u.pn = HT + (y < 2 ? CT_K + y : CT_U + (y - 2)); }
        return true;
    }
    __device__ __forceinline__ void a_ready(const Unit&) const {}
    __device__ __forceinline__ void done(const Unit&) const {}
};

struct EpiIn {
    static constexpr bool PERM = true, AFTER_DRAIN = false;
    bf16_t *G, *Q, *K, *Vt, *U; const float* bgate; const float* rope;
    __device__ __forceinline__ static void st8(bf16_t* p, const f32x4& v0, const f32x4& v1) {
        u32x4 w; w.x = cvt_pk_bf16(v0[0], v0[1]); w.y = cvt_pk_bf16(v0[2], v0[3]); w.z = cvt_pk_bf16(v1[0], v1[1]); w.w = cvt_pk_bf16(v1[2], v1[3]); *(u32x4*)p = w; }
    __device__ __forceinline__ void plain(const f32x4 (&acc)[2][2][4][2], bf16_t* base, int ldc, int row0, int col0) const {
#pragma unroll
        for (int ai = 0; ai < 2; ++ai)
#pragma unroll
            for (int m = 0; m < 4; ++m) { bf16_t* rowp = base + (size_t)(row0 + ai * HALF + m * 16) * ldc + col0;
#pragma unroll
                for (int bj = 0; bj < 2; ++bj) st8(rowp + bj * HALF, acc[ai][bj][m][0], acc[ai][bj][m][1]); }
    }
    __device__ __forceinline__ void roped(const f32x4 (&acc)[2][2][4][2], bf16_t* base, int ldc, int row0, int col0, int wc, int fq) const {
        if (wc != 0) { plain(acc, base, ldc, row0, col0); return; }
        const float sgn = (fq < 2) ? -1.0f : 1.0f;
#pragma unroll
        for (int ai = 0; ai < 2; ++ai)
#pragma unroll
            for (int m = 0; m < 4; ++m) { const int row = row0 + ai * HALF + m * 16; const int pos = row < SEQ ? row + NMETA : row - SEQ;
                const f32x4* cs = (const f32x4*)(rope + (size_t)pos * 32 + 16 * (fq & 1));
                const f32x4 c0 = cs[0], c1 = cs[1], c2 = cs[2], c3 = cs[3];
                const float cw[8] = {c0[0], c0[2], c1[0], c1[2], c2[0], c2[2], c3[0], c3[2]}, sw[8] = {c0[1], c0[3], c1[1], c1[3], c2[1], c2[3], c3[1], c3[3]};
                bf16_t* rowp = base + (size_t)row * ldc + col0;
#pragma unroll
                for (int bj = 0; bj < 2; ++bj) { f32x4 v0 = acc[ai][bj][m][0], v1 = acc[ai][bj][m][1], o0, o1;
#pragma unroll
                    for (int e = 0; e < 4; ++e) { const float p0 = __shfl_xor(v0[e], 32), p1 = __shfl_xor(v1[e], 32);
                        o0[e] = v0[e] * cw[e] + sgn * p0 * sw[e]; o1[e] = v1[e] * cw[4 + e] + sgn * p1 * sw[4 + e]; }
                    st8(rowp + bj * HALF, o0, o1); } }
    }
    __device__ __forceinline__ void operator()(const f32x4 (&acc)[2][2][4][2], const Unit& u, int wr, int wc, int fr, int fq) const {
        if (u.pm >= HT) {
            plain(acc, Vt, MPAD, (u.pm - HT - CT_V) * BM + wr * 64 + fr, u.pn * BM + wc * 32 + 8 * fq); return; }
        const int ct = u.pn - HT, row0 = u.pm * BM + wr * 64 + fr, cl = wc * 32 + 8 * fq;
        if (ct < CT_Q) {
            const int col0 = ct * BM + cl;
#pragma unroll
            for (int bj = 0; bj < 2; ++bj) { const f32x4 b0 = *(const f32x4*)(bgate + col0 + bj * HALF), b1 = *(const f32x4*)(bgate + col0 + bj * HALF + 4);
#pragma unroll
                for (int ai = 0; ai < 2; ++ai)
#pragma unroll
                    for (int m = 0; m < 4; ++m) { f32x4 v0 = acc[ai][bj][m][0] + b0, v1 = acc[ai][bj][m][1] + b1;
#pragma unroll
                        for (int e = 0; e < 4; ++e) { v0[e] = sigmoidf_(v0[e]); v1[e] = sigmoidf_(v1[e]); }
                        st8(G + (size_t)(row0 + ai * HALF + m * 16) * (2 * DM) + col0 + bj * HALF, v0, v1); } }
        } else if (ct < CT_K) { roped(acc, Q, ATTW, row0, (ct - CT_Q) * BM + cl, wc, fq);
        } else if (ct < CT_V) { roped(acc, K, KVW, row0, (ct - CT_K) * BM + cl, wc, fq);
        } else { plain(acc, U, UPITCH, row0, (ct - CT_U) * BM + cl); }
    }
};

struct EpiProjA {
    static constexpr bool PERM = true, AFTER_DRAIN = false;
    bf16_t* P1; const bf16_t* G;
    __device__ __forceinline__ void operator()(const f32x4 (&acc)[2][2][4][2], const Unit& u, int wr, int wc, int fr, int fq) const {
        const int row0 = u.pm * BM + wr * 64 + fr, col0 = u.pn * BM + wc * 32 + 8 * fq;
#pragma unroll
        for (int ai = 0; ai < 2; ++ai)
#pragma unroll
            for (int m = 0; m < 4; ++m) { const size_t r = (size_t)(row0 + ai * HALF + m * 16);
#pragma unroll
                for (int bj = 0; bj < 2; ++bj) { const int c = col0 + bj * HALF; const u32x4 g = *(const u32x4*)(G + r * (2 * DM) + c);
                    f32x4 o0 = acc[ai][bj][m][0], o1 = acc[ai][bj][m][1];
                    o0[0] *= bflo(g.x); o0[1] *= bfhi(g.x); o0[2] *= bflo(g.y); o0[3] *= bfhi(g.y); o1[0] *= bflo(g.z); o1[1] *= bfhi(g.z); o1[2] *= bflo(g.w); o1[3] *= bfhi(g.w);
                    EpiIn::st8(P1 + r * DM + c, o0, o1); } }
    }
};
struct EpiProjB {
    static constexpr bool PERM = true, AFTER_DRAIN = false;
    const bf16_t* P1; const bf16_t* G; bf16_t* MX;
    __device__ __forceinline__ void operator()(const f32x4 (&acc)[2][2][4][2], const Unit& u, int wr, int wc, int fr, int fq) const {
        const int row0 = u.pm * BM + wr * 64 + fr, col0 = u.pn * BM + wc * 32 + 8 * fq;
#pragma unroll
        for (int ai = 0; ai < 2; ++ai)
#pragma unroll
            for (int m = 0; m < 4; ++m) { const size_t r = (size_t)(row0 + ai * HALF + m * 16);
#pragma unroll
                for (int bj = 0; bj < 2; ++bj) { const int c = col0 + bj * HALF; const u32x4 g = *(const u32x4*)(G + r * (2 * DM) + DM + c); const u32x4 q = *(const u32x4*)(P1 + r * DM + c);
                    f32x4 o0 = {bflo(q.x), bfhi(q.x), bflo(q.y), bfhi(q.y)}, o1 = {bflo(q.z), bfhi(q.z), bflo(q.w), bfhi(q.w)}; const f32x4 a0 = acc[ai][bj][m][0], a1 = acc[ai][bj][m][1];
                    o0[0] += a0[0] * bflo(g.x); o0[1] += a0[1] * bfhi(g.x); o0[2] += a0[2] * bflo(g.y); o0[3] += a0[3] * bfhi(g.y);
                    o1[0] += a1[0] * bflo(g.z); o1[1] += a1[1] * bfhi(g.z); o1[2] += a1[2] * bflo(g.w); o1[3] += a1[3] * bfhi(g.w);
                    EpiIn::st8(MX + r * DM + c, o0, o1); }
                asm volatile("" ::: "memory"); }
    }
};
template <bool BASE_BF16> struct EpiResid {
    static constexpr bool PERM = true, AFTER_DRAIN = false;
    const float* BASEF; const bf16_t* BASEB; float* OUTF; bf16_t* OUTB; float* SS;
    __device__ __forceinline__ void operator()(const f32x4 (&acc)[2][2][4][2], const Unit& u, int wr, int wc, int fr, int fq) const {
        const int row0 = u.pm * BM + wr * 64 + fr, col0 = u.pn * BM + wc * 32 + 8 * fq;
#pragma unroll
        for (int ai = 0; ai < 2; ++ai)
#pragma unroll
            for (int m = 0; m < 4; ++m) { const size_t r = (size_t)(row0 + ai * HALF + m * 16); float ss = 0.f;
#pragma unroll
                for (int bj = 0; bj < 2; ++bj) { const int c = col0 + bj * HALF; f32x4 o0, o1;
                    if (BASE_BF16) { const u32x4 g = *(const u32x4*)(BASEB + r * DM + c); o0 = (f32x4){bflo(g.x), bfhi(g.x), bflo(g.y), bfhi(g.y)}; o1 = (f32x4){bflo(g.z), bfhi(g.z), bflo(g.w), bfhi(g.w)}; }
                    else { const float* bp = BASEF + r * DM + c; o0 = *(const f32x4*)bp; o1 = *(const f32x4*)(bp + 4); }
                    o0 += acc[ai][bj][m][0]; o1 += acc[ai][bj][m][1];
                    if (BASE_BF16) { float* op = OUTF + r * DM + c; *(f32x4*)op = o0; *(f32x4*)(op + 4) = o1; }
                    else { u32x4 w; w.x = cvt_pk_bf16(o0[0], o0[1]); w.y = cvt_pk_bf16(o0[2], o0[3]); w.z = cvt_pk_bf16(o1[0], o1[1]); w.w = cvt_pk_bf16(o1[2], o1[3]); *(u32x4*)(OUTB + r * DM + c) = w;
                        o0 = (f32x4){bflo(w.x), bfhi(w.x), bflo(w.y), bfhi(w.y)}; o1 = (f32x4){bflo(w.z), bfhi(w.z), bflo(w.w), bfhi(w.w)}; }
                    ss += (o0[0] * o0[0] + o0[1] * o0[1]) + (o0[2] * o0[2] + o0[3] * o0[3]) + (o1[0] * o1[0] + o1[1] * o1[1]) + (o1[2] * o1[2] + o1[3] * o1[3]); }
                ss += __shfl_xor(ss, 16); ss += __shfl_xor(ss, 32);
                if (fq == 0) atomicAdd(SS + r, ss);
                asm volatile("" ::: "memory"); }
    }
};
struct EpiSwiGLU {
    static constexpr bool PERM = true, AFTER_DRAIN = false;
    bf16_t* HID; const float* SS;
    __device__ __forceinline__ void operator()(const f32x4 (&acc)[2][2][4][2], const Unit& u, int wr, int wc, int fr, int fq) const {
        const int row0 = u.pm * BM + wr * 64 + fr, col0 = u.pn * HALF + wc * 32 + 8 * fq;
#pragma unroll
        for (int ai = 0; ai < 2; ++ai)
#pragma unroll
            for (int m = 0; m < 4; ++m) { const size_t r = (size_t)(row0 + ai * HALF + m * 16);
                const float rstd = __builtin_amdgcn_rsqf(SS[r] * (1.0f / DM) + RMS_EPS);
                f32x4 o0, o1;
#pragma unroll
                for (int e = 0; e < 4; ++e) { const float g0 = acc[ai][0][m][0][e] * rstd, u0 = acc[ai][1][m][0][e] * rstd, g1 = acc[ai][0][m][1][e] * rstd, u1 = acc[ai][1][m][1][e] * rstd;
                    o0[e] = g0 * sigmoidf_(g0) * u0; o1[e] = g1 * sigmoidf_(g1) * u1; }
                EpiIn::st8(HID + r * DFF + col0, o0, o1); }
    }
};

#define PG8_EPI_T0 unsigned long long epi_t0_ = 0; do { if ((PROBE_PHASE >> 20) & 1) epi_t0_ = __builtin_amdgcn_s_memrealtime(); } while (0)
#define PG8_EPI_T1 do { if ((PROBE_PHASE >> 20) & 1) epi_acc += __builtin_amdgcn_s_memrealtime() - epi_t0_; } while (0)
template <class Epi, class Sched, bool ALIGN_EPI = false, bool SP2 = false>
__device__ __forceinline__ void gemm_phase(PG8_LAS unsigned char* lds, const Gemm g, const Sched& S, const Epi& E, unsigned long long& epi_acc) {
    const int tid = threadIdx.x, wid = __builtin_amdgcn_readfirstlane(tid >> 6), lane = tid & 63, wr = wid >> 2, wc = wid & 3, fr = lane & 15, fq = lane >> 4;
    const int K = g.K, nt = K / BK;
    unsigned voffA[2], voffB[2];
#pragma unroll
    for (int i = 0; i < 2; ++i) { int R, C; stage_rc(tid * 16 + i * 8192, R, C); const int Rb = Epi::PERM ? ((R & ~31) + perm32(R & 31)) : R;
        voffA[i] = (unsigned)(R * K + C) * 2u; voffB[i] = (unsigned)(Rb * K + C) * 2u; }
    const size_t kstep = (size_t)(BK * 2);
    const size_t hstep = (size_t)HALF * K * 2;
    const size_t tstep = 2 * hstep;
    const unsigned ldsw = (unsigned)wid * 1024u;
    const int aoff = lds_byte(wr * 64 + fr, fq * 8), boff = lds_byte(wc * 32 + fr, fq * 8);
#define PG8_SA(b, h) (((b) * 2 + (h)) * HTB)
#define PG8_SB(b, h) ((4 + (b) * 2 + (h)) * HTB)
#define PG8_STAGE(bufoff, gbase, voff) do { _Pragma("unroll") for (int _i = 0; _i < 2; ++_i) \
        __builtin_amdgcn_global_load_lds((const unsigned*)((const char*)(gbase) + (voff)[_i]), (PG8_LAS unsigned*)(lds + (bufoff) + ldsw + _i * 8192), 16, 0, 0); } while (0)
#define PG8_LDA(dst, b, h) do { _Pragma("unroll") for (int m = 0; m < 4; ++m) _Pragma("unroll") for (int k = 0; k < 2; ++k) dst[m][k] = *(const PG8_LAS bf16x8*)(lds + PG8_SA(b, h) + aoff + m * 2048 + k * 1024); } while (0)
#define PG8_LDB(dst, b, h) do { _Pragma("unroll") for (int n = 0; n < 2; ++n) _Pragma("unroll") for (int k = 0; k < 2; ++k) dst[n][k] = *(const PG8_LAS bf16x8*)(lds + PG8_SB(b, h) + boff + n * 2048 + k * 1024); } while (0)
#define PG8_MMA(ai, bj, At, Bt) do { __builtin_amdgcn_s_setprio(1); _Pragma("unroll") for (int m = 0; m < 4; ++m) _Pragma("unroll") for (int n = 0; n < 2; ++n) _Pragma("unroll") for (int k = 0; k < 2; ++k) \
        acc[ai][bj][m][n] = __builtin_amdgcn_mfma_f32_16x16x32_bf16(Bt[n][k], At[m][k], acc[ai][bj][m][n], 0, 0, 0); __builtin_amdgcn_s_setprio(0); } while (0)
#define PG8_WAIT_V(n) asm volatile("s_waitcnt vmcnt(" #n ")" ::: "memory")
#define PG8_WAIT_L(n) asm volatile("s_waitcnt lgkmcnt(" #n ")" ::: "memory")
#define PG8_BAR __builtin_amdgcn_s_barrier()
#define PG8_SCHED __builtin_amdgcn_sched_barrier(0)
    Unit cur, nxt; int ui = 0;
    if (!S.next(0, cur)) return;
    f32x4 acc[2][2][4][2];
#pragma unroll
    for (int a = 0; a < 2; ++a)
#pragma unroll
        for (int b = 0; b < 2; ++b)
#pragma unroll
            for (int m = 0; m < 4; ++m)
#pragma unroll
                for (int n = 0; n < 2; ++n) acc[a][b][m][n] = (f32x4){0.f, 0.f, 0.f, 0.f};
    bf16x8 At[4][2], B0[2][2], B1[2][2];
    const char* cA = (const char*)g.A + (size_t)cur.pm * tstep; const char* cB = (const char*)g.Bt + (size_t)cur.pn * tstep;
    S.a_ready(cur);
    if constexpr (SP2) {
        PG8_STAGE(PG8_SB(0, 0), cB, voffB); PG8_STAGE(PG8_SB(0, 1), cB + hstep, voffB); PG8_STAGE(PG8_SA(0, 0), cA, voffA); PG8_STAGE(PG8_SA(0, 1), cA + hstep, voffA);
        if (wr == 1) PG8_BAR;
        PG8_WAIT_V(2); PG8_BAR;
        PG8_STAGE(PG8_SB(1, 0), cB + kstep, voffB); PG8_STAGE(PG8_SA(1, 0), cA + kstep, voffA); PG8_STAGE(PG8_SB(1, 1), cB + hstep + kstep, voffB);
        PG8_WAIT_V(6); PG8_BAR;
    } else {
        PG8_STAGE(PG8_SB(0, 0), cB, voffB); PG8_STAGE(PG8_SA(0, 0), cA, voffA); PG8_STAGE(PG8_SB(0, 1), cB + hstep, voffB); PG8_STAGE(PG8_SA(0, 1), cA + hstep, voffA);
        if (wr == 1) PG8_BAR;
        PG8_WAIT_V(4); PG8_BAR;
        PG8_STAGE(PG8_SB(1, 0), cB + kstep, voffB); PG8_STAGE(PG8_SA(1, 0), cA + kstep, voffA); PG8_STAGE(PG8_SB(1, 1), cB + hstep + kstep, voffB);
        PG8_WAIT_V(6); PG8_BAR;
    }
    for (;;) {
        const bool has_next = S.next(ui + 1, nxt);
        const char* nA = has_next ? (const char*)g.A + (size_t)nxt.pm * tstep : cA; const char* nB = has_next ? (const char*)g.Bt + (size_t)nxt.pn * tstep : cB;
        for (int t = 0; t < nt; t += 2) {
            const bool last = (t == nt - 2);
            const char* a1 = cA + (size_t)(t + 1) * kstep;
            const char* a2 = last ? nA : cA + (size_t)(t + 2) * kstep; const char* b2 = last ? nB : cB + (size_t)(t + 2) * kstep;
            const char* a3 = a2 + kstep; const char* b3 = b2 + kstep;
            if (last && has_next) S.a_ready(nxt);
            if constexpr (SP2) {
            PG8_LDB(B0, 0, 0); PG8_LDB(B1, 0, 1); PG8_SCHED; PG8_LDA(At, 0, 0); PG8_STAGE(PG8_SA(1, 1), a1 + hstep, voffA);
            PG8_WAIT_V(8); PG8_WAIT_L(0); PG8_BAR; PG8_MMA(0, 0, At, B0); PG8_MMA(0, 1, At, B1); PG8_BAR; PG8_SCHED;
            PG8_LDA(At, 0, 1); PG8_STAGE(PG8_SB(0, 0), b2, voffB); PG8_STAGE(PG8_SB(0, 1), b2 + hstep, voffB); PG8_STAGE(PG8_SA(0, 0), a2, voffA);
            PG8_WAIT_V(8); PG8_WAIT_L(0); PG8_BAR; PG8_MMA(1, 0, At, B0); PG8_MMA(1, 1, At, B1); PG8_BAR; PG8_SCHED;
            PG8_LDB(B0, 1, 0); PG8_LDB(B1, 1, 1); PG8_SCHED; PG8_LDA(At, 1, 0); PG8_STAGE(PG8_SA(0, 1), a2 + hstep, voffA);
            PG8_WAIT_V(8); PG8_WAIT_L(0); PG8_BAR; PG8_MMA(0, 0, At, B0); PG8_MMA(0, 1, At, B1); PG8_BAR; PG8_SCHED;
            PG8_LDA(At, 1, 1); PG8_STAGE(PG8_SB(1, 0), b3, voffB); PG8_STAGE(PG8_SB(1, 1), b3 + hstep, voffB); PG8_STAGE(PG8_SA(1, 0), a3, voffA);
            PG8_WAIT_V(8); PG8_WAIT_L(0); PG8_BAR; PG8_MMA(1, 0, At, B0); PG8_MMA(1, 1, At, B1); PG8_BAR; PG8_SCHED;
            } else {
            PG8_LDB(B0, 0, 0); PG8_SCHED; PG8_LDA(At, 0, 0); PG8_STAGE(PG8_SA(1, 1), a1 + hstep, voffA);
            PG8_WAIT_L(8); PG8_BAR; PG8_WAIT_L(0); PG8_MMA(0, 0, At, B0); PG8_BAR; PG8_SCHED;
            PG8_LDB(B1, 0, 1); PG8_STAGE(PG8_SB(0, 0), b2, voffB);
            PG8_BAR; PG8_WAIT_L(0); PG8_MMA(0, 1, At, B1); PG8_BAR;
            PG8_LDA(At, 0, 1); PG8_STAGE(PG8_SA(0, 0), a2, voffA);
            PG8_BAR; PG8_WAIT_L(0); PG8_MMA(1, 0, At, B0); PG8_BAR; PG8_SCHED;
            PG8_STAGE(PG8_SB(0, 1), b2 + hstep, voffB);
            PG8_WAIT_V(6); PG8_BAR; PG8_MMA(1, 1, At, B1); PG8_BAR;
            PG8_LDB(B0, 1, 0); PG8_SCHED; PG8_LDA(At, 1, 0); PG8_STAGE(PG8_SA(0, 1), a2 + hstep, voffA);
            PG8_WAIT_L(8); PG8_BAR; PG8_WAIT_L(0); PG8_MMA(0, 0, At, B0); PG8_BAR; PG8_SCHED;
            PG8_LDB(B1, 1, 1); PG8_STAGE(PG8_SB(1, 0), b3, voffB);
            PG8_BAR; PG8_WAIT_L(0); PG8_MMA(0, 1, At, B1); PG8_BAR;
            PG8_LDA(At, 1, 1); PG8_STAGE(PG8_SA(1, 0), a3, voffA);
            PG8_BAR; PG8_WAIT_L(0); PG8_MMA(1, 0, At, B0); PG8_BAR; PG8_SCHED;
            PG8_STAGE(PG8_SB(1, 1), b3 + hstep, voffB);
            PG8_WAIT_V(6); PG8_BAR; PG8_MMA(1, 1, At, B1); PG8_BAR;
            }
        }
        if constexpr (ALIGN_EPI) { if (wr == 0) PG8_BAR; }
        if constexpr (!Epi::AFTER_DRAIN) { PG8_EPI_T0; E(acc, cur, wr, wc, fr, fq); S.done(cur); PG8_EPI_T1; }
        if (!has_next) break;
#pragma unroll
        for (int a = 0; a < 2; ++a)
#pragma unroll
            for (int b = 0; b < 2; ++b)
#pragma unroll
                for (int m = 0; m < 4; ++m)
#pragma unroll
                    for (int n = 0; n < 2; ++n) acc[a][b][m][n] = (f32x4){0.f, 0.f, 0.f, 0.f};
        cur = nxt; cA = nA; cB = nB; ++ui;
        if constexpr (ALIGN_EPI) { if (wr == 1) PG8_BAR; }
    }
    PG8_WAIT_V(0);
    if constexpr (!ALIGN_EPI) { if (wr == 0) PG8_BAR; }
    PG8_BAR;
    if constexpr (Epi::AFTER_DRAIN) { E.fused(acc, cur, wr, wc, fr, fq, lds, wid, lane); S.done(cur); }
#undef PG8_SA
#undef PG8_SB
#undef PG8_STAGE
#undef PG8_LDA
#undef PG8_LDB
#undef PG8_MMA
#undef PG8_WAIT_V
#undef PG8_WAIT_L
#undef PG8_BAR
#undef PG8_SCHED
}

}

constexpr size_t MiB = 1u << 20;
constexpr size_t WS_CTL = 0;
constexpr size_t WS_ROPE = 1 * MiB;
constexpr size_t WS_LW2 = 3 * MiB, WS_LA2 = 4 * MiB, WS_LG2 = 5 * MiB;
constexpr size_t WS_BONUS = 6 * MiB;
constexpr size_t ZERO_BYTES = 8 * MiB;
constexpr size_t SCF = (size_t)LTOK * RC * 4, SCB = (size_t)LTOK * RC * 2;
constexpr size_t WS_H = 8 * MiB, WS_WIN = WS_H + (size_t)MPAD * DM * 2;
constexpr size_t WS_KD0 = 8 * MiB, WS_KD1 = WS_KD0 + SCB, WS_B0 = WS_KD1 + SCB, WS_B1 = WS_B0 + SCB, WS_KK = WS_B1 + SCB, WS_RR = WS_KK + SCB;
constexpr size_t WS_WGU = 8 * MiB;
constexpr size_t WS_G = 216 * MiB, WS_A2 = 216 * MiB;
constexpr size_t WS_Q = 344 * MiB, WS_K = 376 * MiB, WS_VT = 385 * MiB, WS_U = 394 * MiB;
constexpr size_t WS_P1 = 344 * MiB;
constexpr size_t WS_Y = 394 * MiB;
constexpr size_t WS_W0 = 506 * MiB, WS_W1 = WS_W0 + SCF;
constexpr size_t WS_WPA = 506 * MiB, WS_WPR = 522 * MiB, WS_WOUT = 538 * MiB, WS_OATT = 570 * MiB;
constexpr size_t WS_VV = 635 * MiB, WS_GG = 668 * MiB;
constexpr size_t WS_BO = 701 * MiB;
constexpr size_t WS_HID = 701 * MiB, WS_MX = 873 * MiB;
constexpr int NB0 = 513, NB1 = 512, NBT = NB0 + NB1;
constexpr int BO_FA = 0, BO_FAA = 4096, BO_FT = 5120, BO_FBP = 5632, BO_FB = 6144, BO_FG = 10240, BO_ITEM = 10496;
constexpr size_t WS_WD = 1030 * MiB, WS_ORWKV = 182 * MiB, WS_END = 1116 * MiB;
static_assert(WS_WIN + (size_t)INWP * DM * 2 <= WS_G && WS_RR + SCB <= WS_G && WS_WGU + (size_t)2 * DFF * DM * 2 <= WS_G, "map: A0");
static_assert(WS_U + (size_t)MPAD * UPITCH * 2 <= WS_W0 && WS_VT + (size_t)KVW * MPAD * 2 <= WS_U && WS_K + (size_t)MPAD * KVW * 2 <= WS_VT && WS_Q + (size_t)SEQ * ATTW * 2 <= WS_K && WS_Y + 2 * SCB <= WS_W0, "map: P1 outputs");
static_assert(WS_W1 + SCF <= WS_VV && WS_OATT + (size_t)SEQ * ATTW * 2 <= WS_VV && WS_VV + SCB <= WS_GG && WS_GG + SCB <= WS_BO && WS_P1 + (size_t)SEQ * DM * 2 <= WS_W0, "map: mid");
static_assert(WS_BO + (size_t)RH * NBT * BO_ITEM <= WS_WD && WS_HID + (size_t)SEQ * DFF * 2 <= WS_MX && WS_MX + (size_t)SEQ * DM * 2 <= WS_WD && WS_WD + (size_t)DM * DFF * 2 <= WS_END && WS_WGU + (size_t)2 * DFF * DM * 2 <= WS_ORWKV && WS_ORWKV + (size_t)SEQ * RC * 2 <= WS_G, "map: tail");
constexpr int CW_BAR = 4096;
constexpr int CW_SS2 = 65536, CW_SS3 = 65536 + 8192;
static_assert((CW_SS3 + 8192) * 4 <= (int)(1 * MiB), "CTL");

constexpr int RING_BYTES = 131072;
constexpr int LDSCTL_OFF = RING_BYTES, MISC_OFF = LDSCTL_OFF + 320;
constexpr int LDS_BYTES = 147456;

#define GAS __attribute__((address_space(1)))
#define LAS __attribute__((address_space(3)))
typedef unsigned short bf16;
typedef unsigned v4u __attribute__((ext_vector_type(4)));
typedef unsigned v2u __attribute__((ext_vector_type(2)));
typedef float f32x4 __attribute__((ext_vector_type(4)));
typedef float f32x2 __attribute__((ext_vector_type(2)));
typedef float f32x16 __attribute__((ext_vector_type(16)));
typedef short bf16x8 __attribute__((ext_vector_type(8)));
typedef GAS unsigned gu32;
#define RLX_AGENT __ATOMIC_RELAXED, __HIP_MEMORY_SCOPE_AGENT
#define LDS_WAIT() asm volatile("s_waitcnt lgkmcnt(0)" ::: "memory")
__device__ __forceinline__ unsigned pk2(float lo, float hi) { return pg8::cvt_pk_bf16(lo, hi); }
__device__ __forceinline__ unsigned f2bf(float f) { return pg8::cvt_pk_bf16(f, 0.f) & 0xffffu; }
__device__ __forceinline__ float bf2f(bf16 b) { return __uint_as_float(((unsigned)b) << 16); }
using pg8::bflo; using pg8::bfhi; using pg8::sigmoidf_;

#define XB_TMO      128
#define XB_XCNT(j)  (256  + 64 * (j))
#define XB_XSUB(j)  (1280 + 64 * (j))
#define XB_XGEN(j)  (2304 + 64 * (j))
#define XB_TOP      3328
#define XB_TOPGEN   3392
#define XCD_BAR_WORDS 3456
#define XB_SPIN_CAP (1u << 18)

__device__ __forceinline__ unsigned xb_ld(unsigned* p)              { return __hip_atomic_load(p, __ATOMIC_RELAXED, __HIP_MEMORY_SCOPE_AGENT); }
__device__ __forceinline__ unsigned xb_add(unsigned* p, unsigned v) { return __hip_atomic_fetch_add(p, v, __ATOMIC_RELAXED, __HIP_MEMORY_SCOPE_AGENT); }
__device__ __forceinline__ unsigned xb_xcc_id() { return (unsigned)__builtin_amdgcn_s_getreg((3 << 11) | 20) & 0xFu; }
#define XB_SPIN(cond, bar) do { unsigned _sp = 0; while (cond) { __builtin_amdgcn_s_sleep(1); \
    if ((++_sp & 255u) == 0u) { if (xb_ld(&(bar)[XB_TMO])) break; if (_sp > XB_SPIN_CAP) { atomicAdd(&(bar)[XB_TMO], 1u); break; } } } } while (0)

struct XcdBarrier {
    unsigned* bar; unsigned x;
    volatile LAS unsigned* st;
};

__device__ __forceinline__ XcdBarrier xcd_barrier_post(unsigned* bar, volatile LAS unsigned* st) {
    XcdBarrier b; b.bar = bar; b.x = xb_xcc_id(); b.st = st;
    if (threadIdx.x == 0) (void)xb_add(&bar[XB_XCNT(b.x)], 1u);
    return b;
}
__device__ __forceinline__ void xcd_barrier_complete(unsigned* bar, unsigned x, unsigned& nloc, unsigned& nx) {
    const unsigned G = gridDim.x * gridDim.y * gridDim.z;
    unsigned sum, cnt, mine, sp = 0u;
    for (;;) {
        sum = 0u; cnt = 0u; mine = 0u;
#pragma unroll
        for (unsigned j = 0; j < 16; ++j) { const unsigned c = xb_ld(&bar[XB_XCNT(j)]); sum += c; cnt += (c > 0u) ? 1u : 0u; mine = (j == x) ? c : mine; }
        if (sum == G) break;
        __builtin_amdgcn_s_sleep(1);
        if ((++sp & 255u) == 0u) { if (xb_ld(&bar[XB_TMO])) break; if (sp > XB_SPIN_CAP) { atomicAdd(&bar[XB_TMO], 1u); break; } }
    }
    nloc = mine > 0u ? mine : 1u; nx = cnt > 0u ? cnt : 1u;
}

__device__ __forceinline__ void xcd_barrier(const XcdBarrier& b) {
    asm volatile("s_waitcnt vmcnt(0)" ::: "memory");
    __syncthreads();
    if (threadIdx.x == 0) {
        unsigned* bar = b.bar;
        __builtin_amdgcn_s_waitcnt(0);
        unsigned nloc = b.st[0], nx = b.st[1];
        if (nloc == 0u) { xcd_barrier_complete(bar, b.x, nloc, nx); b.st[0] = nloc; b.st[1] = nx; }
        const unsigned old = xb_add(&bar[XB_XSUB(b.x)], 1u);
        const unsigned gen = old / nloc;
        if (old + 1u == (gen + 1u) * nloc) {
            __builtin_amdgcn_fence(__ATOMIC_RELEASE, "agent");
            asm volatile("s_waitcnt vmcnt(0)" ::: "memory");
            const unsigned og = xb_add(&bar[XB_TOP], 1u);
            const unsigned tg = og / nx;
            if (og + 1u == (tg + 1u) * nx) xb_add(&bar[XB_TOPGEN], 1u);
            else XB_SPIN(xb_ld(&bar[XB_TOPGEN]) == tg, bar);
            __builtin_amdgcn_fence(__ATOMIC_ACQUIRE, "agent");
            xb_add(&bar[XB_XGEN(b.x)], 1u);
            asm volatile("s_waitcnt vmcnt(0)" ::: "memory");
        } else {
            XB_SPIN(xb_ld(&bar[XB_XGEN(b.x)]) == gen, bar);
            __builtin_amdgcn_fence(__ATOMIC_ACQUIRE, "agent");
            asm volatile("s_waitcnt vmcnt(0)" ::: "memory");
        }
    }
    __syncthreads();
}


struct Frame {
    LAS unsigned char* lds;
    volatile LAS unsigned* MISC;
    gu32* ctl;
    int tid, lane, wave, G;
    unsigned char* ws;
    const float* in[26];
    float* out;
    unsigned long long pb0, pacc, pacc2;
};
#define FPB0(k) do { if ((PROBE_PHASE >> (k)) & 1) F.pb0 = __builtin_amdgcn_s_memrealtime(); } while (0)
#define FPB1(k) do { if ((PROBE_PHASE >> (k)) & 1) F.pacc += __builtin_amdgcn_s_memrealtime() - F.pb0; } while (0)
__device__ __forceinline__ float wave_sum(float v) {
#pragma unroll
    for (int o = 1; o < 64; o <<= 1) v += __shfl_xor(v, o);
    return v;
}

template <int KR> __device__ __forceinline__ void tr_issue(const float* W, int N, int item, int lane, float (&wv)[KR / 2]) {
    const int nblk = N / 32, kb = item / nblk, nb = item % nblk, k0 = KR * kb, n0 = 32 * nb;
#pragma unroll
    for (int i = 0; i < KR / 2; ++i) wv[i] = W[(size_t)(k0 + 2 * i + (lane >> 5)) * N + n0 + (lane & 31)];
}
template <int KR> __device__ __forceinline__ void tr_finish(bf16* WT, int K, int N, const float* kscale, int mode, int item, LAS float* scr, int lane, const float (&wv)[KR / 2]) {
    const int nblk = N / 32, kb = item / nblk, nb = item % nblk, k0 = KR * kb, n0 = 32 * nb;
#pragma unroll
    for (int i = 0; i < KR / 2; ++i) { const int kk = 2 * i + (lane >> 5); float v = wv[i]; if (kscale) v *= kscale[k0 + kk]; scr[kk * 33 + (lane & 31)] = v; }
    LDS_WAIT(); asm volatile("" ::: "memory");
    constexpr int CH = KR / 8;
    const int c = lane & (CH - 1);
#pragma unroll
    for (int jj = 0; jj < CH / 2; ++jj) { const int n = (lane / CH) + (64 / CH) * jj; const LAS float* s = scr + (8 * c) * 33 + n;
        v4u o; o.x = pk2(s[0 * 33], s[1 * 33]); o.y = pk2(s[2 * 33], s[3 * 33]); o.z = pk2(s[4 * 33], s[5 * 33]); o.w = pk2(s[6 * 33], s[7 * 33]);
        const int nn = n0 + n; const int dr = (mode == 0) ? nn : (256 * (nn >> 7) + (nn & 127) + (mode == 2 ? 128 : 0));
        *(GAS v4u*)(WT + (size_t)dr * K + k0 + 8 * c) = o; }
    LDS_WAIT(); asm volatile("" ::: "memory");
}
#define CONV_P4(it, CALL) do { constexpr int I_GU_ = (DM / 64) * (DFF / 32), I_P_ = (ATTW / 64) * (DM / 32); int r_ = (it); \
        if (r_ < I_GU_) { CALL(F.in[22], (bf16*)(F.ws + WS_WGU), DM, DFF, F.in[21], 1, r_); } \
        else if ((r_ -= I_GU_) < I_GU_) { CALL(F.in[23], (bf16*)(F.ws + WS_WGU), DM, DFF, F.in[21], 2, r_); } \
        else if ((r_ -= I_GU_) < I_P_) { CALL(F.in[18], (bf16*)(F.ws + WS_WPA), ATTW, DM, (const float*)nullptr, 0, r_); } \
        else if ((r_ -= I_P_) < I_P_) { CALL(F.in[19], (bf16*)(F.ws + WS_WPR), RC, DM, (const float*)nullptr, 0, r_); } \
        else if ((r_ -= I_P_) < (DM / 64) * (DM / 32)) { CALL(F.in[20], (bf16*)(F.ws + WS_WOUT), DM, DM, (const float*)nullptr, 0, r_); } \
        else { r_ -= (DM / 64) * (DM / 32); CALL(F.in[24], (bf16*)(F.ws + WS_WD), DFF, DM, (const float*)nullptr, 0, r_); } } while (0)
constexpr int N_P4_ITEMS = 2 * (DM / 64) * (DFF / 32) + 2 * (ATTW / 64) * (DM / 32) + (DM / 64) * (DM / 32) + (DFF / 64) * (DM / 32);
constexpr int N_WD_HALF_ITEMS = (DFF / 32) * (DM / 32);
__device__ __forceinline__ void convert_seg(Frame& F, LAS float* scr, int first, int stride, int limit) {
    int it = first; if (it >= limit) return;
    float wv[32];
#define CVI(W_, WT_, K_, N_, ks_, md_, item_) tr_issue<64>(W_, N_, item_, F.lane, wv)
#define CVN(W_, WT_, K_, N_, ks_, md_, item_) tr_issue<64>(W_, N_, item_, F.lane, nv)
#define CVF(W_, WT_, K_, N_, ks_, md_, item_) tr_finish<64>(WT_, K_, N_, ks_, md_, item_, scr, F.lane, wv)
    CONV_P4(it, CVI);
    for (;;) { const int itn = it + stride; const bool more = itn < limit; float nv[32];
        if (more) CONV_P4(itn, CVN);
        CONV_P4(it, CVF);
        if (!more) break;
        it = itn;
#pragma unroll
        for (int i = 0; i < 32; ++i) wv[i] = nv[i]; }
#undef CVI
#undef CVN
#undef CVF
}
__device__ __forceinline__ void convert_p4(Frame& F, LAS float* scr, int widx, int NWK, int pidx, int NPL) {
    (void)pidx; (void)NPL;
    convert_seg(F, scr, widx, NWK, N_P4_ITEMS);
}
__device__ __forceinline__ void convert_win(Frame& F, LAS float* scr, int first, int stride) {
    constexpr int NI = (DM / 64) * (INW / 32); bf16* WT = (bf16*)(F.ws + WS_WIN);
    int it = first; if (it >= NI) return;
    float wv[32]; tr_issue<64>(F.in[3], INW, it, F.lane, wv);
    for (;;) { const int itn = it + stride; const bool more = itn < NI; float nv[32];
        if (more) tr_issue<64>(F.in[3], INW, itn, F.lane, nv);
        tr_finish<64>(WT, DM, INW, nullptr, 0, it, scr, F.lane, wv);
        if (!more) break;
        it = itn;
#pragma unroll
        for (int i = 0; i < 32; ++i) wv[i] = nv[i]; }
}
__device__ __forceinline__ void rms_row_to_bf16(int lane, const float* xrow, const float* w, bf16* orow) {
    const GAS f32x4* xr = (const GAS f32x4*)xrow + lane;
    f32x4 v[16]; float s = 0.f;
#pragma unroll
    for (int j = 0; j < 16; ++j) { v[j] = xr[64 * j]; s += (v[j].x * v[j].x + v[j].y * v[j].y) + (v[j].z * v[j].z + v[j].w * v[j].w); }
    const float rstd = 1.f / sqrtf(wave_sum(s) * (1.f / DM) + RMS_EPS);
    const GAS f32x4* wr = (const GAS f32x4*)w + lane;
    GAS v2u* o8 = (GAS v2u*)orow + lane;
#pragma unroll
    for (int j = 0; j < 16; ++j) { const f32x4 ww = wr[64 * j]; v2u o; o.x = pk2(v[j].x * rstd * ww.x, v[j].y * rstd * ww.y); o.y = pk2(v[j].z * rstd * ww.z, v[j].w * rstd * ww.w); o8[64 * j] = o; }
}
__device__ const double ROPE_INV[16] = {
    1.0000000000000000000000000e+0,
    4.4036660267178047359198331e-1,
    1.9392274474868577334259386e-1,
    8.5397100285765611280149662e-2,
    3.7606030930863935681246092e-2,
    1.6560440080994445548947445e-2,
    7.2926647372171090477661219e-3,
    3.2114459947525910185434889e-3,
    1.4142135623730950488016887e-3,
    6.2277242191459597955502746e-4,
    2.7424817567620731825332265e-4,
    1.2076973741146503832424826e-4,
    5.3182958969449886162502429e-5,
    2.3419998961409341542188076e-5,
    1.0313385377212458859810127e-5,
    4.5416704806078696531998012e-6
};

__device__ __forceinline__ void p0_prologue(Frame& F) {
    LAS float* scr = (LAS float*)(F.lds + F.wave * 16384);
    const int gw = blockIdx.x * 8 + F.wave, NGW = F.G * 8;
    bf16* Wint = (bf16*)(F.ws + WS_WIN); bf16* H = (bf16*)(F.ws + WS_H);
    convert_win(F, scr, gw, NGW);
    for (int m = gw; m < MPAD + (INWP - INW); m += NGW) {
        if (m < SEQ) rms_row_to_bf16(F.lane, F.in[0] + (size_t)m * DM, F.in[2], H + (size_t)m * DM);
        else if (m < LTOK) rms_row_to_bf16(F.lane, F.in[1] + (size_t)(m - SEQ) * DM, F.in[2], H + (size_t)m * DM);
        else { bf16* row = (m < MPAD) ? H + (size_t)m * DM : Wint + (size_t)(INW + (m - MPAD)) * DM; GAS v4u* o = (GAS v4u*)row + F.lane;
#pragma unroll
            for (int j = 0; j < 8; ++j) o[64 * j] = (v4u){0u, 0u, 0u, 0u}; }
    }
    const int gt = blockIdx.x * 512 + F.tid, NGT = F.G * 512;
    float* rope = (float*)(F.ws + WS_ROPE);
    for (int i = gt; i < LTOK * 16; i += NGT) { const int pos = i >> 4, k = i & 15;
        const double ang = (double)pos * ROPE_INV[k]; const double kq = __builtin_rint(ang * 0.15915494309189535);
        const double red = (ang - kq * 6.28318530717958623) - kq * 2.4492935982947064e-16; const float rf = (float)red;
        rope[2 * i] = cosf(rf); rope[2 * i + 1] = sinf(rf); }
    bf16* w2t = (bf16*)(F.ws + WS_LW2); bf16* a2t = (bf16*)(F.ws + WS_LA2); bf16* g2t = (bf16*)(F.ws + WS_LG2);
    for (int i = gt; i < 2 * 96 * RC; i += NGT) { const int c = i % RC, j = (i / RC) % 96, d = i / (RC * 96);
        w2t[((size_t)d * RC + c) * 96 + j] = (bf16)f2bf(F.in[8][i]); a2t[((size_t)d * RC + c) * 96 + j] = (bf16)f2bf(F.in[10][i]); }
    for (int i = gt; i < 256 * RC; i += NGT) { const int c = i % RC, j = i / RC; g2t[(size_t)c * 256 + j] = (bf16)f2bf(F.in[11][i]); }
}

__device__ __forceinline__ int crow(int r, int hi) { return (r & 3) + 8 * (r >> 2) + 4 * hi; }
__device__ __forceinline__ void attn_phase(Frame& F, const int gw, const int NGW) {
    const bf16* Q = (const bf16*)(F.ws + WS_Q); const bf16* K = (const bf16*)(F.ws + WS_K); const bf16* Vt = (const bf16*)(F.ws + WS_VT); bf16* OA = (bf16*)(F.ws + WS_OATT);
    const float* sink = F.in[17];
    const int hh = F.lane >> 5, r = F.lane & 31;
    constexpr float SC = 0.08838834764831845f * 1.4426950408889634f, L2E = 1.4426950408889634f;
    for (int item = gw; item < 4096; item += NGW) {
        const int sub = item & 3, hq = (item >> 2) & 15, qb = item >> 6, q0 = qb * 128 + sub * 32, hk = hq >> 2;
        bf16x8 bq[8];
        { const bf16* qp = Q + (size_t)(q0 + r) * ATTW + hq * 128 + 8 * hh;
#pragma unroll
          for (int s = 0; s < 8; ++s) bq[s] = *(const bf16x8*)(qp + 16 * s); }
        f32x16 O[4];
#pragma unroll
        for (int dt = 0; dt < 4; ++dt)
#pragma unroll
            for (int i = 0; i < 16; ++i) O[dt][i] = 0.f;
        float m = sink[hq] * L2E, l = (hh == 0) ? 1.f : 0.f;
        const int tlo = (q0 >= 128) ? 0 : 4 - q0 / 32, thi = (q0 + 128 + 32 <= SEQ) ? 8 : 4 + (SEQ - 32 - q0) / 32;
        int ti = tlo;
        bf16x8 ak[8];
        { const int key0 = q0 + 32 * (ti - 4); const bf16* kp = K + (size_t)(key0 + r) * KVW + hk * 128 + 8 * hh;
#pragma unroll
          for (int s = 0; s < 8; ++s) ak[s] = *(const bf16x8*)(kp + 16 * s); }
        for (;;) {
            const bool meta = (ti == 9);
            const int key0 = meta ? SEQ : q0 + 32 * (ti - 4);
            const int tn = (ti < thi) ? ti + 1 : 9; const int keyn = (tn == 9) ? SEQ : q0 + 32 * (tn - 4);
            v2u av[4][2][2]; bf16x8 akn[8];
#pragma unroll
            for (int dt = 0; dt < 4; ++dt) { const bf16* vp = Vt + (size_t)(hk * 128 + 32 * dt + r) * MPAD + key0 + 4 * hh;
#pragma unroll
                for (int s2 = 0; s2 < 2; ++s2) { av[dt][s2][0] = *(const v2u*)(vp + 16 * s2); av[dt][s2][1] = *(const v2u*)(vp + 16 * s2 + 8); } }
            { const bf16* kp = K + (size_t)(keyn + r) * KVW + hk * 128 + 8 * hh;
#pragma unroll
              for (int s = 0; s < 8; ++s) akn[s] = *(const bf16x8*)(kp + 16 * s); }
            f32x16 st;
#pragma unroll
            for (int i = 0; i < 16; ++i) st[i] = 0.f;
#pragma unroll
            for (int s = 0; s < 8; ++s) st = __builtin_amdgcn_mfma_f32_32x32x16_bf16(ak[s], bq[s], st, 0, 0, 0);
            float tmax = -__builtin_inff();
#pragma unroll
            for (int i = 0; i < 16; ++i) { const int kr = crow(i, hh); bool ok;
                if (meta) ok = kr < NMETA; else { const int dlt = (key0 + kr) - (q0 + r); ok = (dlt >= -128) && (dlt <= 128); }
                const float t = ok ? st[i] * SC : -__builtin_inff(); st[i] = t; tmax = fmaxf(tmax, t); }
            tmax = fmaxf(tmax, __shfl_xor(tmax, 32));
            const float mn = fmaxf(m, tmax), alpha = __builtin_amdgcn_exp2f(m - mn); m = mn;
            float ps = 0.f;
#pragma unroll
            for (int i = 0; i < 16; ++i) { const float p = __builtin_amdgcn_exp2f(st[i] - mn); st[i] = p; ps += p; }
            l = l * alpha + ps;
#pragma unroll
            for (int dt = 0; dt < 4; ++dt)
#pragma unroll
                for (int i = 0; i < 16; ++i) O[dt][i] *= alpha;
            bf16x8 pb[2];
#pragma unroll
            for (int s2 = 0; s2 < 2; ++s2) { v4u w; w.x = pg8::cvt_pk_bf16(st[8 * s2 + 0], st[8 * s2 + 1]); w.y = pg8::cvt_pk_bf16(st[8 * s2 + 2], st[8 * s2 + 3]);
                w.z = pg8::cvt_pk_bf16(st[8 * s2 + 4], st[8 * s2 + 5]); w.w = pg8::cvt_pk_bf16(st[8 * s2 + 6], st[8 * s2 + 7]); pb[s2] = __builtin_bit_cast(bf16x8, w); }
#pragma unroll
            for (int dt = 0; dt < 4; ++dt)
#pragma unroll
                for (int s2 = 0; s2 < 2; ++s2) { const v4u w = {av[dt][s2][0].x, av[dt][s2][0].y, av[dt][s2][1].x, av[dt][s2][1].y};
                    O[dt] = __builtin_amdgcn_mfma_f32_32x32x16_bf16(__builtin_bit_cast(bf16x8, w), pb[s2], O[dt], 0, 0, 0); }
            if (meta) break;
            ti = tn;
#pragma unroll
            for (int s = 0; s < 8; ++s) ak[s] = akn[s];
        }
        l += __shfl_xor(l, 32);
        const float inv = 1.0f / l;
        bf16* op = OA + (size_t)(q0 + r) * ATTW + hq * 128 + 4 * hh;
#pragma unroll
        for (int dt = 0; dt < 4; ++dt)
#pragma unroll
            for (int g4 = 0; g4 < 4; ++g4) { v2u w; w.x = pg8::cvt_pk_bf16(O[dt][4 * g4 + 0] * inv, O[dt][4 * g4 + 1] * inv); w.y = pg8::cvt_pk_bf16(O[dt][4 * g4 + 2] * inv, O[dt][4 * g4 + 3] * inv);
                *(v2u*)(op + 32 * dt + 8 * g4) = w; }
    }
}

__device__ __forceinline__ int tok2row(int t) { return t < NMETA ? SEQ + t : t - NMETA; }
struct Sh8 { v4u uc, up, un; };
__device__ __forceinline__ Sh8 shift8_ld(const bf16* U, int t, int col) {
    const int tc = t < LTOK ? t : LTOK - 1, tp = (t >= 1 && t - 1 < LTOK) ? t - 1 : 0, tn = t + 1 < LTOK ? t + 1 : LTOK - 1;
    Sh8 s; s.uc = *(const v4u*)(U + (size_t)tok2row(tc) * UPITCH + col); s.up = *(const v4u*)(U + (size_t)tok2row(tp) * UPITCH + col); s.un = *(const v4u*)(U + (size_t)tok2row(tn) * UPITCH + col); return s; }
__device__ __forceinline__ void shift8_fin(const Sh8& s, int t, int col, const float* mu_p, const float* mu_n, float (&x)[8]) {
    const v4u zz = {0u, 0u, 0u, 0u};
    const v4u uc = t < LTOK ? s.uc : zz, up = (t >= 1 && t - 1 < LTOK) ? s.up : zz, un = t + 1 < LTOK ? s.un : zz;
    const f32x4 mp0 = *(const f32x4*)(mu_p + col), mp1 = *(const f32x4*)(mu_p + col + 4), mn0 = *(const f32x4*)(mu_n + col), mn1 = *(const f32x4*)(mu_n + col + 4);
    const unsigned ucw[4] = {uc.x, uc.y, uc.z, uc.w}, upw[4] = {up.x, up.y, up.z, up.w}, unw[4] = {un.x, un.y, un.z, un.w};
    const float mpw[8] = {mp0[0], mp0[1], mp0[2], mp0[3], mp1[0], mp1[1], mp1[2], mp1[3]}, mnw[8] = {mn0[0], mn0[1], mn0[2], mn0[3], mn1[0], mn1[1], mn1[2], mn1[3]};
#pragma unroll
    for (int e = 0; e < 8; ++e) { const float c0 = (e & 1) ? bfhi(ucw[e >> 1]) : bflo(ucw[e >> 1]), p0 = (e & 1) ? bfhi(upw[e >> 1]) : bflo(upw[e >> 1]), n0 = (e & 1) ? bfhi(unw[e >> 1]) : bflo(unw[e >> 1]);
        x[e] = c0 + mpw[e] * (p0 - c0) + mnw[e] * (n0 - c0); }
}
__device__ __forceinline__ void flush_bf16(const LAS bf16* tile, bf16* ARR, int t0, int cbase, int lane) {
#pragma unroll
    for (int h = 0; h < 2; ++h) { const int row = (lane >> 2) + 16 * h, ch = lane & 3; const v4u v = *(const LAS v4u*)(tile + row * 32 + 8 * ch);
        if (t0 + row < LTOK) *(v4u*)(ARR + (size_t)(t0 + row) * RC + cbase + 8 * ch) = v; }
}
__device__ __forceinline__ void flush_f32(const LAS float* tile, float* ARR, int t0, int cbase, int lane) {
#pragma unroll
    for (int h = 0; h < 4; ++h) { const int row = (lane >> 3) + 8 * h, ch = lane & 7; const f32x4 v = *(const LAS f32x4*)(tile + row * 32 + 4 * ch);
        if (t0 + row < LTOK) *(f32x4*)(ARR + (size_t)(t0 + row) * RC + cbase + 4 * ch) = v; }
}
__device__ __forceinline__ void prep_phase(Frame& F) {
    constexpr int XS = 648;
    LAS bf16* Xs = (LAS bf16*)F.lds;
    LAS bf16* Kt = (LAS bf16*)(F.lds + 41472 + F.wave * 8192);
    LAS bf16* Ot = Kt + 2048;
    const bf16* U = (const bf16*)(F.ws + WS_U);
    const float* mu_p = F.in[5]; const float* mu_n = F.in[6];
    const bf16* w2t = (const bf16*)(F.ws + WS_LW2); const bf16* a2t = (const bf16*)(F.ws + WS_LA2); const bf16* g2t = (const bf16*)(F.ws + WS_LG2);
    float* W0 = (float*)(F.ws + WS_W0); float* W1 = (float*)(F.ws + WS_W1);
    bf16* KD0 = (bf16*)(F.ws + WS_KD0); bf16* KD1 = (bf16*)(F.ws + WS_KD1); bf16* B0 = (bf16*)(F.ws + WS_B0); bf16* B1 = (bf16*)(F.ws + WS_B1);
    bf16* KK = (bf16*)(F.ws + WS_KK); bf16* RR = (bf16*)(F.ws + WS_RR); bf16* VV = (bf16*)(F.ws + WS_VV); bf16* GG = (bf16*)(F.ws + WS_GG);
    const int hh = F.lane >> 5, r = F.lane & 31;
    for (int unit = blockIdx.x; unit < 257 * 4; unit += F.G) {
        const int tt = unit >> 2, t0 = tt * 32, hd = (unit & 3) * 8 + F.wave;
        __syncthreads();
        FPB0(15);
        { Sh8 sx[5];
#pragma unroll
          for (int it = 0; it < 5; ++it) { const int ci = F.tid + 512 * it; sx[it] = shift8_ld(U, t0 + ci / 80, 3 * RC + 8 * (ci % 80)); }
#pragma unroll
          for (int it = 0; it < 5; ++it) { const int ci = F.tid + 512 * it, tl = ci / 80, ch = ci % 80;
            float x[8]; shift8_fin(sx[it], t0 + tl, 3 * RC + 8 * ch, mu_p, mu_n, x);
#pragma unroll
            for (int e = 0; e < 8; ++e) { float v = x[e];
                if (ch < 24) { const float ex = __expf(2.0f * v); v = 1.0f - 2.0f / (ex + 1.0f); }
                else if (ch >= 48) v = sigmoidf_(v);
                x[e] = v; }
            v4u o; o.x = pk2(x[0], x[1]); o.y = pk2(x[2], x[3]); o.z = pk2(x[4], x[5]); o.w = pk2(x[6], x[7]);
            *(LAS v4u*)(Xs + tl * XS + 8 * ch) = o; } }
        { const int c8 = hd * 64 + 8 * (F.lane & 7);
#pragma unroll
          for (int st = 0; st < 3; ++st) { const int col = (st == 0 ? RC : st == 1 ? 0 : 2 * RC) + c8; Sh8 sq[4];
#pragma unroll
            for (int q = 0; q < 4; ++q) sq[q] = shift8_ld(U, t0 + (F.lane >> 3) + 8 * q, col);
#pragma unroll
            for (int q = 0; q < 4; ++q) { const int tl = (F.lane >> 3) + 8 * q, tq = t0 + tl; float x[8]; shift8_fin(sq[q], tq, col, mu_p, mu_n, x);
                v4u o; o.x = pk2(x[0], x[1]); o.y = pk2(x[2], x[3]); o.z = pk2(x[4], x[5]); o.w = pk2(x[6], x[7]);
                if (st == 0) *(LAS v4u*)(Kt + tl * 64 + 8 * (F.lane & 7)) = o;
                else if (tq < LTOK) *(v4u*)((st == 1 ? RR : VV) + (size_t)tq * RC + c8) = o; } } }
        __syncthreads();
        FPB1(15); FPB0(16);
        float kp[2][16], ss[16];
#pragma unroll
        for (int i = 0; i < 16; ++i) ss[i] = 0.f;
#pragma unroll
        for (int ct = 0; ct < 2; ++ct) { const int c = hd * 64 + 32 * ct + r; const float kkw = F.in[12][c];
#pragma unroll
            for (int i = 0; i < 16; ++i) { kp[ct][i] = bf2f(Kt[crow(i, hh) * 64 + 32 * ct + r]); const float kr = kp[ct][i] * kkw; ss[i] += kr * kr; } }
#pragma unroll
        for (int i = 0; i < 16; ++i) {
#pragma unroll
            for (int o = 1; o < 32; o <<= 1) ss[i] += __shfl_xor(ss[i], o);
            ss[i] = 1.0f / fmaxf(sqrtf(ss[i]), 1e-12f); }
#define LDF(dst, ptr, n) do { _Pragma("unroll") for (int s_ = 0; s_ < (n); ++s_) dst[s_] = *(const bf16x8*)((ptr) + 16 * s_); } while (0)
#define MMF(frag, xoff, n) do { _Pragma("unroll") for (int i_ = 0; i_ < 16; ++i_) acc[i_] = 0.f; const LAS bf16* ap_ = Xs + r * XS + (xoff) + 8 * hh; \
            _Pragma("unroll") for (int s_ = 0; s_ < (n); ++s_) acc = __builtin_amdgcn_mfma_f32_32x32x16_bf16(*(const LAS bf16x8*)(ap_ + 16 * s_), frag[s_], acc, 0, 0, 0); } while (0)
#pragma unroll
        for (int ct = 0; ct < 2; ++ct) {
            const int c = hd * 64 + 32 * ct + r, cb = hd * 64 + 32 * ct;
            const float kkw = F.in[12][c], kaw = F.in[13][c];
            const bf16* pa0 = a2t + (size_t)c * 96 + 8 * hh; const bf16* pa1 = a2t + ((size_t)RC + c) * 96 + 8 * hh;
            const bf16* pw0 = w2t + (size_t)c * 96 + 8 * hh; const bf16* pw1 = w2t + ((size_t)RC + c) * 96 + 8 * hh; const bf16* pg = g2t + (size_t)c * 256 + 8 * hh;
            bf16x8 fa[6], fg[16]; f32x16 acc; float kk[16];
            LDF(fa, pa0, 6);
#pragma unroll
            for (int i = 0; i < 16; ++i) { kk[i] = kp[ct][i] * kkw * ss[i]; Ot[crow(i, hh) * 32 + r] = (bf16)f2bf(kk[i]); }
            flush_bf16(Ot, KK, t0, cb, F.lane);
#pragma unroll
            for (int d = 0; d < 2; ++d) {
                if (d == 0) { MMF(fa, 192, 6); LDF(fa, pa1, 6); } else { MMF(fa, 288, 6); LDF(fa, pw0, 6); }
                const float a0 = F.in[9][d * RC + c];
#pragma unroll
                for (int i = 0; i < 16; ++i) { acc[i] = sigmoidf_(a0 + acc[i]); Ot[crow(i, hh) * 32 + r] = (bf16)f2bf(kp[ct][i] * (1.0f + (acc[i] - 1.0f) * kaw)); }
                flush_bf16(Ot, d ? KD1 : KD0, t0, cb, F.lane);
#pragma unroll
                for (int i = 0; i < 16; ++i) Ot[crow(i, hh) * 32 + r] = (bf16)f2bf(kk[i] * acc[i]);
                flush_bf16(Ot, d ? B1 : B0, t0, cb, F.lane);
            }
#pragma unroll
            for (int d = 0; d < 2; ++d) {
                if (d == 0) { MMF(fa, 0, 6); LDF(fa, pw1, 6); } else { MMF(fa, 96, 6); LDF(fg, pg, 16); }
                const float w0 = F.in[7][d * RC + c]; LAS float* Of = (LAS float*)Ot;
#pragma unroll
                for (int i = 0; i < 16; ++i) Of[crow(i, hh) * 32 + r] = __expf(-0.6065306597126334f * sigmoidf_(w0 + acc[i]));
                flush_f32(Of, d ? W1 : W0, t0, cb, F.lane);
            }
            MMF(fg, 384, 16);
#pragma unroll
            for (int i = 0; i < 16; ++i) Ot[crow(i, hh) * 32 + r] = (bf16)f2bf(acc[i]);
            flush_bf16(Ot, GG, t0, cb, F.lane);
        }
#undef LDF
#undef MMF
        FPB1(16);
    }
    __syncthreads();
}

__device__ __forceinline__ int blk_tok(int d, int blk, int u) { return d ? (LTOK - 1 - 16 * blk - u) : (16 * blk + u); }
__device__ __forceinline__ size_t bo_item(int hd, int d, int blk) { return (size_t)(hd * NBT + (d ? NB0 : 0) + blk) * BO_ITEM; }
__device__ __forceinline__ v4u pack8(const float (&x)[8]) { v4u o; o.x = pk2(x[0], x[1]); o.y = pk2(x[2], x[3]); o.z = pk2(x[4], x[5]); o.w = pk2(x[6], x[7]); return o; }
__device__ __forceinline__ void blockprep_phase(Frame& F) {
    LAS unsigned char* wl = F.lds + F.wave * 16384;
    constexpr int LP = 72;
    LAS bf16* LT = (LAS bf16*)wl;
    LAS float* GM = (LAS float*)(wl + 9216);
    const float* W0 = (const float*)(F.ws + WS_W0); const float* W1 = (const float*)(F.ws + WS_W1);
    const bf16* KD0 = (const bf16*)(F.ws + WS_KD0); const bf16* KD1 = (const bf16*)(F.ws + WS_KD1); const bf16* B0 = (const bf16*)(F.ws + WS_B0); const bf16* B1 = (const bf16*)(F.ws + WS_B1);
    const bf16* KK = (const bf16*)(F.ws + WS_KK); const bf16* RR = (const bf16*)(F.ws + WS_RR);
    float* BON = (float*)(F.ws + WS_BONUS); unsigned char* BO = F.ws + WS_BO;
    int lz; asm volatile("v_mov_b32 %0, 0" : "=v"(lz));
    const int gw = blockIdx.x * 8 + F.wave, NGW = F.G * 8, j = F.lane + lz, hh = j >> 5, r31 = j & 31, c16 = j & 15;
    struct Raw { float w[16]; unsigned short kd[16], b[16], kk[16], r[16]; };
#define BP_DECODE(it_, hd_, d_, blk_) const int hd_ = (it_) / NBT, rem_##hd_ = (it_) % NBT, d_ = rem_##hd_ >= NB0 ? 1 : 0, blk_ = d_ ? rem_##hd_ - NB0 : rem_##hd_
#define BP_LOAD(R_, it_) do { BP_DECODE(it_, hdL, dL, blkL); const float* Wd_ = dL ? W1 : W0; const bf16* KDd_ = dL ? KD1 : KD0; const bf16* Bd_ = dL ? B1 : B0; \
        _Pragma("unroll") for (int u_ = 0; u_ < 16; ++u_) { const size_t o_ = (size_t)blk_tok(dL, blkL, u_) * RC + hdL * 64 + j; \
            R_.w[u_] = Wd_[o_]; R_.kd[u_] = KDd_[o_]; R_.b[u_] = Bd_[o_]; R_.kk[u_] = KK[o_]; R_.r[u_] = RR[o_]; } } while (0)
    Raw cur;
    if (gw < RH * NBT) BP_LOAD(cur, gw);
    for (int it = gw; it < RH * NBT; it += NGW) {
        BP_DECODE(it, hd, d, blk); const int c = hd * 64 + j;
        Raw nxt = cur;
        if (it + NGW < RH * NBT) BP_LOAD(nxt, it + NGW);
        float kt[16], rt[16], kdh[16], bh[16]; float G15;
        { float G[16];
          { float g = 1.f;
#pragma unroll
            for (int u = 0; u < 16; ++u) { g *= cur.w[u]; G[u] = g; } }
          const float rkw = F.in[14][c];
          float bsum = 0.f;
#pragma unroll
          for (int u = 0; u < 16; ++u) { kdh[u] = bf2f(cur.kd[u]); rt[u] = bf2f(cur.r[u]); const float s = wave_sum(rt[u] * kdh[u] * rkw); bsum = (F.lane == u) ? s : bsum;
              kdh[u] = kdh[u] / G[u]; rt[u] = rt[u] * G[u]; LT[(0 * 16 + u) * LP + j] = (bf16)f2bf(kdh[u]); LT[(3 * 16 + u) * LP + j] = (bf16)f2bf(rt[u]); }
          if (F.lane < 16) atomicAdd(BON + (size_t)blk_tok(d, blk, F.lane) * RH + hd, bsum);
#pragma unroll
          for (int u = 0; u < 16; ++u) { kt[u] = bf2f(cur.kk[u]) * (u ? G[u - 1] : 1.f); bh[u] = bf2f(cur.b[u]) / G[u]; LT[(2 * 16 + u) * LP + j] = (bf16)f2bf(kt[u]); LT[(1 * 16 + u) * LP + j] = (bf16)f2bf(bh[u]); }
          G15 = G[15]; }
        asm volatile("" ::: "memory");
        f32x16 gacc;
#pragma unroll
        for (int i = 0; i < 16; ++i) gacc[i] = 0.f;
        { const LAS bf16* ap = LT + ((r31 < 16 ? 0 : 1) * 16 + (r31 & 15)) * LP + 8 * hh; const LAS bf16* bp = LT + ((r31 < 16 ? 2 : 3) * 16 + (r31 & 15)) * LP + 8 * hh;
#pragma unroll
          for (int s = 0; s < 4; ++s) gacc = __builtin_amdgcn_mfma_f32_32x32x16_bf16(*(const LAS bf16x8*)(ap + 16 * s), *(const LAS bf16x8*)(bp + 16 * s), gacc, 0, 0, 0); }
        float ga[16];
#pragma unroll
        for (int i = 0; i < 16; ++i) ga[i] = gacc[i];
#pragma unroll
        for (int i = 0; i < 16; ++i) { const int row = crow(i, hh), m = row & 15, u = r31 & 15; const bool strict = (r31 < 16);
            GM[row * 32 + r31] = (strict ? (m < u) : (m <= u)) ? ga[i] : 0.f; }
#define RL(x, ln) __builtin_bit_cast(float, __builtin_amdgcn_readlane(__builtin_bit_cast(int, (x)), (ln)))
#define GREG(m) (4 * ((m) >> 3) + ((m) & 3))
#define GLN(m) (32 * (((m) >> 2) & 1))
#define B_(m, u)  RL(ga[8 + GREG(m)], (u) + GLN(m))
        float Tr[16];
#pragma unroll
        for (int m = 15; m >= 0; --m) { float s = (c16 == m) ? 1.f : 0.f;
#pragma unroll
            for (int u = m + 1; u < 16; ++u) s -= B_(m, u) * Tr[u];
            Tr[m] = s; }
#undef RL
#undef GREG
#undef GLN
#undef B_
        unsigned char* base = BO + bo_item(hd, d, blk);
        { const int a = j >> 5, jp = j & 31;
#pragma unroll
          for (int h2 = 0; h2 < 2; ++h2) { float x0[8], x1[8];
#pragma unroll
              for (int e = 0; e < 8; ++e) { x0[e] = -bh[8 * (e >> 2) + 4 * h2 + (e & 3)] * G15; x1[e] = kdh[8 * h2 + e] * G15; }
              *(v4u*)(base + BO_FB + ((a * 2 + 0) * 64 + jp + 32 * h2) * 16) = pack8(x0); *(v4u*)(base + BO_FB + ((a * 2 + 1) * 64 + jp + 32 * h2) * 16) = pack8(x1); } }
        *(float*)(base + BO_FG + 4 * j) = G15;
        { float x[8];
#pragma unroll
          for (int e = 0; e < 8; ++e) x[e] = GM[(8 * hh + e) * 32 + r31];
          *(v4u*)(base + BO_FAA + j * 16) = pack8(x); }
        if (r31 < 16) { float x[8];
#pragma unroll
            for (int e = 0; e < 8; ++e) { const float t0 = Tr[8 * (e >> 2) + (e & 3)], t1 = Tr[8 * (e >> 2) + 4 + (e & 3)]; x[e] = hh ? t1 : t0; }
            *(v4u*)(base + BO_FT + (hh * 16 + r31) * 16) = pack8(x); }
        else { float x[8];
#pragma unroll
            for (int e = 0; e < 8; ++e) x[e] = -GM[(16 + 8 * (e >> 2) + 4 * hh + (e & 3)) * 32 + r31];
            *(v4u*)(base + BO_FBP + (hh * 16 + (r31 - 16)) * 16) = pack8(x); }
#pragma unroll
        for (int u = 0; u < 16; ++u) { LT[u * LP + j] = (bf16)f2bf(kt[u]); LT[(16 + u) * LP + j] = (bf16)f2bf(rt[u]); }
#pragma unroll
        for (int ks = 0; ks < 4; ++ks) { const int j0 = 32 * (ks >> 1) + 16 * (ks & 1) + 4 * hh; const v2u lo = *(const LAS v2u*)(LT + r31 * LP + j0), hi = *(const LAS v2u*)(LT + r31 * LP + j0 + 8);
            *(v4u*)(base + BO_FA + (ks * 64 + j) * 16) = (v4u){lo.x, lo.y, hi.x, hi.y}; }
        cur = nxt;
        asm volatile("" ::: "memory");
    }
#undef BP_DECODE
#undef BP_LOAD
}

constexpr int N_SCAN_WAVES = 128;
constexpr int SR_SLOTS = 8, SR_STRIDE = 12288, SR_FV = 11264, SR_FLAGS = SR_SLOTS * SR_STRIDE, SR_WSCR = SR_FLAGS + 512, SR_NL = 4;
static_assert(SR_WSCR + (7 - SR_NL) * 8448 <= RING_BYTES, "scan phase LDS map");
struct LdSet { v4u p[11]; unsigned short v[8]; };
__device__ __forceinline__ void sr_issue(LdSet& s, const unsigned char* item, const bf16* VV, int hd, int d, int blk, int ih, int lane) {
#pragma unroll
    for (int k = 0; k < 11; ++k) { const int pc = k * 64 + lane; s.p[k] = *(const v4u*)(item + (pc < BO_ITEM / 16 ? pc : BO_ITEM / 16 - 1) * 16); }
    const int hh = lane >> 5, il = lane & 31;
#pragma unroll
    for (int e = 0; e < 8; ++e) s.v[e] = VV[(size_t)blk_tok(d, blk, 8 * hh + e) * RC + hd * 64 + 32 * ih + il];
}
__device__ __forceinline__ void sr_write(const LdSet& s, LAS unsigned char* slot, int lane) {
#pragma unroll
    for (int k = 0; k < 11; ++k) *(LAS v4u*)(slot + (k * 64 + lane) * 16) = s.p[k];
    const v4u vw = {(unsigned)s.v[0] | ((unsigned)s.v[1] << 16), (unsigned)s.v[2] | ((unsigned)s.v[3] << 16), (unsigned)s.v[4] | ((unsigned)s.v[5] << 16), (unsigned)s.v[6] | ((unsigned)s.v[7] << 16)};
    *(LAS v4u*)(slot + SR_FV + lane * 16) = vw;
}
__device__ __forceinline__ bf16x8 pack_half(const f32x16& x, int s) {
    const v4u w = {pk2(x[8 * s + 0], x[8 * s + 1]), pk2(x[8 * s + 2], x[8 * s + 3]), pk2(x[8 * s + 4], x[8 * s + 5]), pk2(x[8 * s + 6], x[8 * s + 7])}; return __builtin_bit_cast(bf16x8, w); }
__device__ __forceinline__ void scan_phase(Frame& F) {
    const bf16* VV = (const bf16*)(F.ws + WS_VV); bf16* Y = (bf16*)(F.ws + WS_Y); const unsigned char* BO = F.ws + WS_BO;
    const bool sblock = (int)blockIdx.x < N_SCAN_WAVES;
    volatile LAS unsigned* FL = (volatile LAS unsigned*)(F.lds + SR_FLAGS);
    constexpr unsigned SPIN_CAP = 1u << 22;
    __syncthreads();
    if (F.tid < 128) FL[F.tid] = 0u;
    __syncthreads();
    const int pair = (int)blockIdx.x >> 1, ih = (int)blockIdx.x & 1, hd = pair >> 1, d = pair & 1, nblk = d ? NB1 : NB0, hh = F.lane >> 5, il = F.lane & 31;
    if (sblock && F.wave == 0) {
        __builtin_amdgcn_s_setprio(3);
        f32x16 St[2];
#pragma unroll
        for (int a = 0; a < 2; ++a)
#pragma unroll
            for (int i = 0; i < 16; ++i) St[a][i] = 0.f;
        FPB0(17);
        const unsigned long long scan_t0 = ((PROBE_PHASE >> 21) & 1) ? __builtin_amdgcn_s_memrealtime() : 0ull;
        for (int blk = 0; blk < nblk; ++blk) {
            const int sl = blk % SR_SLOTS; const LAS unsigned char* slot = F.lds + sl * SR_STRIDE;
            { unsigned sp = 0; while (FL[sl] != (unsigned)(blk + 1)) { __builtin_amdgcn_s_sleep(1); if (++sp > SPIN_CAP) break; } }
            asm volatile("" ::: "memory");
            bf16x8 fa[4], fb[2][2]; f32x4 gm[2][4];
#pragma unroll
            for (int ks = 0; ks < 4; ++ks) fa[ks] = *(const LAS bf16x8*)(slot + BO_FA + (ks * 64 + F.lane) * 16);
            const bf16x8 faa = *(const LAS bf16x8*)(slot + BO_FAA + F.lane * 16), vf = *(const LAS bf16x8*)(slot + SR_FV + F.lane * 16);
            bf16x8 ft = *(const LAS bf16x8*)(slot + BO_FT + (hh * 16 + (il & 15)) * 16), fbp = *(const LAS bf16x8*)(slot + BO_FBP + (hh * 16 + (il & 15)) * 16);
            { const bf16x8 zz = {0, 0, 0, 0, 0, 0, 0, 0}; ft = (il < 16) ? ft : zz; fbp = (il >= 16) ? fbp : zz; }
#pragma unroll
            for (int a = 0; a < 2; ++a)
#pragma unroll
                for (int k = 0; k < 2; ++k) fb[a][k] = *(const LAS bf16x8*)(slot + BO_FB + ((a * 2 + k) * 64 + F.lane) * 16);
#pragma unroll
            for (int a = 0; a < 2; ++a)
#pragma unroll
                for (int q = 0; q < 4; ++q) gm[a][q] = *(const LAS f32x4*)(slot + BO_FG + (32 * a + 8 * q + 4 * hh) * 4);
            asm volatile("s_waitcnt lgkmcnt(0)" ::: "memory");
            if (F.lane == 0) FL[16] = (unsigned)(blk + 1);
            f32x16 acc, accp;
#pragma unroll
            for (int i = 0; i < 16; ++i) { acc[i] = 0.f; accp[i] = 0.f; }
            acc = __builtin_amdgcn_mfma_f32_32x32x16_bf16(faa, vf, acc, 0, 0, 0);
#pragma unroll
            for (int a = 0; a < 2; ++a)
#pragma unroll
                for (int s = 0; s < 2; ++s) acc = __builtin_amdgcn_mfma_f32_32x32x16_bf16(fa[2 * a + s], pack_half(St[a], s), acc, 0, 0, 0);
            accp = __builtin_amdgcn_mfma_f32_32x32x16_bf16(ft, pack_half(acc, 0), accp, 0, 0, 0);
            const bf16x8 pb = pack_half(accp, 0);
            acc = __builtin_amdgcn_mfma_f32_32x32x16_bf16(fbp, pb, acc, 0, 0, 0);
#pragma unroll
            for (int e = 0; e < 8; ++e) { const int u = 8 * (e >> 2) + 4 * hh + (e & 3);
                Y[((size_t)d * LTOK + blk_tok(d, blk, u)) * RC + hd * 64 + 32 * ih + il] = (bf16)f2bf(acc[8 + e]); }
#pragma unroll
            for (int a = 0; a < 2; ++a) {
#pragma unroll
                for (int i = 0; i < 16; ++i) St[a][i] *= gm[a][i >> 2][i & 3];
                St[a] = __builtin_amdgcn_mfma_f32_32x32x16_bf16(fb[a][0], pb, St[a], 0, 0, 0);
                St[a] = __builtin_amdgcn_mfma_f32_32x32x16_bf16(fb[a][1], vf, St[a], 0, 0, 0);
            }
        }
        FPB1(17);
        if ((PROBE_PHASE >> 21) & 1) { if (F.lane == 0) atomicMax((unsigned*)(F.ctl + 2048), (unsigned)(__builtin_amdgcn_s_memrealtime() - scan_t0)); }
        __builtin_amdgcn_s_setprio(0);
    } else if (sblock && F.wave <= SR_NL) {
        __builtin_amdgcn_s_setprio(2);
        const int lw = F.wave - 1;
        LdSet st[2];
#define SR_PUT(set, b_) do { const int sl_ = (b_) % SR_SLOTS; if ((b_) >= SR_SLOTS) { unsigned sp_ = 0; while (FL[16] < (unsigned)((b_) - SR_SLOTS + 1)) { __builtin_amdgcn_s_sleep(1); if (++sp_ > SPIN_CAP) break; } } \
            asm volatile("" ::: "memory"); sr_write(set, F.lds + sl_ * SR_STRIDE, F.lane); asm volatile("s_waitcnt lgkmcnt(0)" ::: "memory"); if (F.lane == 0) FL[sl_] = (unsigned)((b_) + 1); } while (0)
#pragma unroll
        for (int k = 0; k < 2; ++k) { const int bb = lw + SR_NL * k; if (bb < nblk) sr_issue(st[k], BO + bo_item(hd, d, bb), VV, hd, d, bb, ih, F.lane); }
        for (int b0 = lw; b0 < nblk; b0 += 2 * SR_NL) {
#pragma unroll
            for (int k = 0; k < 2; ++k) { const int bb = b0 + SR_NL * k; if (bb < nblk) { SR_PUT(st[k], bb); const int nb = bb + 2 * SR_NL; if (nb < nblk) sr_issue(st[k], BO + bo_item(hd, d, nb), VV, hd, d, nb, ih, F.lane); } }
        }
#undef SR_PUT
        __builtin_amdgcn_s_setprio(0);
    } else {
        const int b = (int)blockIdx.x, nsb = F.G < N_SCAN_WAVES ? F.G : N_SCAN_WAVES, wps = 7 - SR_NL;
        const int widx = b < N_SCAN_WAVES ? b * wps + (F.wave - 1 - SR_NL) : nsb * wps + (b - N_SCAN_WAVES) * 8 + F.wave;
        const int NWK = nsb * wps + (F.G - nsb) * 8;
        unsigned long long rp0 = 0, rp1 = 0, rp2 = 0;
        if (PROBE_PHASE & ((3 << 18) | (1 << 22))) rp0 = __builtin_amdgcn_s_memrealtime();
        LAS float* scr = (LAS float*)(F.lds + (sblock ? SR_WSCR + (F.wave - 1 - SR_NL) * 8448 : F.wave * 8448));
        attn_phase(F, widx, NWK);
        if (PROBE_PHASE & (3 << 18)) rp1 = __builtin_amdgcn_s_memrealtime();
        convert_p4(F, scr, widx, NWK, sblock ? -1 : (b - N_SCAN_WAVES) * 8 + F.wave, (F.G - nsb) * 8);
        if (PROBE_PHASE & (3 << 18)) { rp2 = __builtin_amdgcn_s_memrealtime(); if ((int)blockIdx.x == F.G - 1 && F.tid == 0) { unsigned long long v = 0; if ((PROBE_PHASE >> 18) & 1) v += rp1 - rp0; if ((PROBE_PHASE >> 19) & 1) v += rp2 - rp1;
            __hip_atomic_store((unsigned*)(F.ctl + 2048), (unsigned)v, __ATOMIC_RELAXED, __HIP_MEMORY_SCOPE_AGENT); } }
        if ((PROBE_PHASE >> 22) & 1) { if (blockIdx.x == 0 && F.wave == 5 && F.lane == 0) __hip_atomic_store((unsigned*)(F.ctl + 2048), (unsigned)(__builtin_amdgcn_s_memrealtime() - rp0), __ATOMIC_RELAXED, __HIP_MEMORY_SCOPE_AGENT); }
    }
}

__device__ __forceinline__ float row16_sum(float x) {
    x += __builtin_bit_cast(float, __builtin_amdgcn_update_dpp(0, __builtin_bit_cast(int, x), 0xB1, 0xf, 0xf, true));
    x += __builtin_bit_cast(float, __builtin_amdgcn_update_dpp(0, __builtin_bit_cast(int, x), 0x4E, 0xf, 0xf, true));
    x += __builtin_bit_cast(float, __builtin_amdgcn_update_dpp(0, __builtin_bit_cast(int, x), 0x141, 0xf, 0xf, true));
    x += __builtin_bit_cast(float, __builtin_amdgcn_update_dpp(0, __builtin_bit_cast(int, x), 0x140, 0xf, 0xf, true));
    return x;
}
__device__ __forceinline__ void combine_phase(Frame& F) {
    const bf16* Y0 = (const bf16*)(F.ws + WS_Y); const bf16* Y1 = Y0 + (size_t)LTOK * RC; const float* BON = (const float*)(F.ws + WS_BONUS);
    const bf16* VV = (const bf16*)(F.ws + WS_VV); const bf16* GG = (const bf16*)(F.ws + WS_GG);
    bf16* OR = (bf16*)(F.ws + WS_ORWKV);
    const float* lnw = F.in[15]; const float* lnb = F.in[16];
    const int gw = blockIdx.x * 8 + F.wave, NGW = F.G * 8;
    for (int row = gw; row < SEQ; row += NGW) { const int t = row + NMETA;
#pragma unroll
        for (int st = 0; st < 8; ++st) { const int c = st * 256 + 4 * F.lane, hd = c >> 6; const size_t o = (size_t)t * RC + c;
            const v2u a0 = *(const v2u*)(Y0 + o), a1 = *(const v2u*)(Y1 + o), vv = *(const v2u*)(VV + o), gg = *(const v2u*)(GG + o);
            const f32x4 w = *(const f32x4*)(lnw + c), bb = *(const f32x4*)(lnb + c); const float bon = BON[(size_t)t * RH + hd];
            float y[4] = {bflo(a0.x) + bflo(a1.x), bfhi(a0.x) + bfhi(a1.x), bflo(a0.y) + bflo(a1.y), bfhi(a0.y) + bfhi(a1.y)};
            const float mean = row16_sum((y[0] + y[1]) + (y[2] + y[3])) * (1.0f / 64.0f);
#pragma unroll
            for (int e = 0; e < 4; ++e) y[e] -= mean;
            const float var = row16_sum((y[0] * y[0] + y[1] * y[1]) + (y[2] * y[2] + y[3] * y[3])) * (1.0f / 64.0f);
            const float rs = __builtin_amdgcn_rsqf(var + GN_EPS);
            const float v4[4] = {bflo(vv.x), bfhi(vv.x), bflo(vv.y), bfhi(vv.y)}, g4[4] = {bflo(gg.x), bfhi(gg.x), bflo(gg.y), bfhi(gg.y)};
            float ov[4];
#pragma unroll
            for (int e = 0; e < 4; ++e) ov[e] = (y[e] * rs * w[e] + bb[e] + bon * v4[e]) * g4[e];
            v2u ow; ow.x = pk2(ov[0], ov[1]); ow.y = pk2(ov[2], ov[3]);
            *(v2u*)(OR + (size_t)row * RC + c) = ow; } }
}
__device__ __forceinline__ void final_phase(Frame& F) {
    const float* SS3 = (const float*)(F.ctl + CW_SS3); const float* w = F.in[25];
    const int gw = blockIdx.x * 8 + F.wave, NGW = F.G * 8;
    for (int row = gw; row < SEQ; row += NGW) { const float rstd = 1.0f / sqrtf(SS3[row] * (1.0f / DM) + RMS_EPS);
        GAS f32x4* p = (GAS f32x4*)(F.out + (size_t)row * DM) + F.lane; const GAS f32x4* wp = (const GAS f32x4*)w + F.lane;
#pragma unroll
        for (int j = 0; j < 16; ++j) { const f32x4 v = p[64 * j], ww = wp[64 * j]; p[64 * j] = v * rstd * ww; } }
}
constexpr int N_PHASES = 11;
struct Args { const float* in[26]; float* out; unsigned char* ws; int ph_lo, ph_hi; };
__global__ void __launch_bounds__(512, 2) fwd_kernel(Args args) {
    extern __shared__ __attribute__((aligned(16))) unsigned char lds[];
    Frame F;
    F.lds = (LAS unsigned char*)lds;
    F.MISC = (volatile LAS unsigned*)(F.lds + MISC_OFF);
    F.tid = threadIdx.x; F.lane = F.tid & 63; F.wave = __builtin_amdgcn_readfirstlane(F.tid >> 6); F.G = gridDim.x;
    F.ws = args.ws; F.ctl = (gu32*)(args.ws + WS_CTL); F.out = args.out; F.pb0 = 0; F.pacc = 0; F.pacc2 = 0;
#pragma unroll
    for (int i = 0; i < 26; ++i) F.in[i] = args.in[i];
    for (int u = F.tid; u < (LDS_BYTES - LDSCTL_OFF) / 4; u += 512) ((LAS unsigned*)(F.lds + LDSCTL_OFF))[u] = 0u;
    __syncthreads();
    XcdBarrier bar; bar.bar = (unsigned*)(F.ctl + CW_BAR); bar.x = 0; bar.st = nullptr;
    if (!MK_SPLIT) bar = xcd_barrier_post((unsigned*)(F.ctl + CW_BAR), F.MISC + 8);
    const int lo = args.ph_lo, hi = args.ph_hi;
#define IN(k) (lo <= (k) && (k) < hi)
#define SEAM(k) do { if (IN(k) && IN((k) + 1)) xcd_barrier(bar); } while (0)
    bf16* Rm = (bf16*)(F.ws + WS_H);
    float* SS2 = (float*)(F.ctl + CW_SS2); float* SS3 = (float*)(F.ctl + CW_SS3);

    unsigned long long pt0 = 0, pt1 = 0;
#define PB0(k) do { if ((PROBE_PHASE >> (k)) & 1) pt0 = __builtin_amdgcn_s_memrealtime(); } while (0)
#define PB1(k) do { if ((PROBE_PHASE >> (k)) & 1) pt1 += __builtin_amdgcn_s_memrealtime() - pt0; } while (0)
    PB0(0); if (IN(0)) { p0_prologue(F); } SEAM(0); PB1(0);
    PB0(1); if (IN(1)) {
        pg8::Gemm g{Rm, Rm, MPAD + INWP, MPAD + INWP, DM}; pg8::InOrder S; S.init(F.G, (int)blockIdx.x);
        pg8::EpiIn E{(bf16*)(F.ws + WS_G), (bf16*)(F.ws + WS_Q), (bf16*)(F.ws + WS_K), (bf16*)(F.ws + WS_VT), (bf16*)(F.ws + WS_U), F.in[4], (const float*)(F.ws + WS_ROPE)};
        pg8::gemm_phase<pg8::EpiIn, pg8::InOrder, true, true>(F.lds, g, S, E, F.pacc2);
    } SEAM(1); PB1(1);
    PB0(2); if (IN(2)) { prep_phase(F); } SEAM(2); PB1(2);
    PB0(3); if (IN(3)) { blockprep_phase(F); } SEAM(3); PB1(3);
    PB0(4); if (IN(4)) { scan_phase(F); } SEAM(4); PB1(4);
    PB0(5); if (IN(5)) { combine_phase(F); } SEAM(5); PB1(5);
    PB0(6); if (IN(6)) {
        { pg8::Gemm g{(const bf16*)(F.ws + WS_OATT), (const bf16*)(F.ws + WS_WPA), SEQ, DM, ATTW}; pg8::StaticOrder S; S.init(SEQ, DM, F.G, (int)blockIdx.x);
          pg8::EpiProjA E{(bf16*)(F.ws + WS_P1), (const bf16*)(F.ws + WS_G)};
          pg8::gemm_phase<pg8::EpiProjA, pg8::StaticOrder, true, true>(F.lds, g, S, E, F.pacc2); }
        __syncthreads();
        { pg8::Gemm g{(const bf16*)(F.ws + WS_ORWKV), (const bf16*)(F.ws + WS_WPR), SEQ, DM, RC}; pg8::StaticOrder S; S.init(SEQ, DM, F.G, (int)blockIdx.x);
          pg8::EpiProjB E{(const bf16*)(F.ws + WS_P1), (const bf16*)(F.ws + WS_G), (bf16*)(F.ws + WS_MX)};
          pg8::gemm_phase<pg8::EpiProjB, pg8::StaticOrder, true, true>(F.lds, g, S, E, F.pacc2); }
    } SEAM(6); PB1(6);
    PB0(7); if (IN(7)) {
        pg8::Gemm g{(const bf16*)(F.ws + WS_MX), (const bf16*)(F.ws + WS_WOUT), SEQ, DM, DM}; pg8::StaticOrder S; S.init(SEQ, DM, F.G, (int)blockIdx.x);
        pg8::EpiResid<false> E{F.in[0], nullptr, nullptr, (bf16*)(F.ws + WS_A2), SS2};
        pg8::gemm_phase<pg8::EpiResid<false>, pg8::StaticOrder, true, true>(F.lds, g, S, E, F.pacc2);
    } SEAM(7); PB1(7);
    PB0(8); if (IN(8)) {
        pg8::Gemm g{(const bf16*)(F.ws + WS_A2), (const bf16*)(F.ws + WS_WGU), SEQ, 2 * DFF, DM}; pg8::StaticOrder S; S.init(SEQ, 2 * DFF, F.G, (int)blockIdx.x);
        pg8::EpiSwiGLU E{(bf16*)(F.ws + WS_HID), SS2};
        pg8::gemm_phase<pg8::EpiSwiGLU, pg8::StaticOrder, true, true>(F.lds, g, S, E, F.pacc2);
    } SEAM(8); PB1(8);
    PB0(9); if (IN(9)) {
        pg8::Gemm g{(const bf16*)(F.ws + WS_HID), (const bf16*)(F.ws + WS_WD), SEQ, DM, DFF}; pg8::StaticOrder S; S.init(SEQ, DM, F.G, (int)blockIdx.x);
        pg8::EpiResid<true> E{nullptr, (const bf16*)(F.ws + WS_A2), F.out, nullptr, SS3};
        pg8::gemm_phase<pg8::EpiResid<true>, pg8::StaticOrder, true, true>(F.lds, g, S, E, F.pacc2);
    } SEAM(9); PB1(9);
    PB0(10); if (IN(10)) { final_phase(F); } PB1(10);
    if (PROBE_PHASE != 0 && blockIdx.x == 0 && F.tid == 0) { const unsigned long long te = __builtin_amdgcn_s_memrealtime(), want = (unsigned long long)PROBE_MULT * (((PROBE_PHASE >> 20) & 1) ? F.pacc2 : (PROBE_PHASE & ((3 << 18) | (3 << 21))) ? (unsigned long long)__hip_atomic_load((unsigned*)(F.ctl + 2048), __ATOMIC_RELAXED, __HIP_MEMORY_SCOPE_AGENT) : (pt1 + F.pacc));
        while (__builtin_amdgcn_s_memrealtime() - te < want && want < 2000000ull) __builtin_amdgcn_s_sleep(32); }
#undef PB0
#undef PB1
#undef IN
#undef SEAM
}

extern "C" void kernel_launch(void* const* d_in, const int* in_sizes, int n_in, void* d_out, int out_size, void* d_ws, size_t ws_size, hipStream_t stream) {
    static int grid = 0;
    if (grid == 0) {
        if (n_in != 26 || out_size != SEQ * DM || ws_size < WS_END) { fprintf(stderr, "kernel_launch: unexpected shapes (n_in %d, out %d, ws %zu, need %zu); nothing launched\n", n_in, out_size, ws_size, (size_t)WS_END); grid = -1; return; }
        int dev = 0, cus = 0, per_cu = 0;
        if (hipGetDevice(&dev) != hipSuccess || hipDeviceGetAttribute(&cus, hipDeviceAttributeMultiprocessorCount, dev) != hipSuccess) { grid = -1; return; }
        if (hipFuncSetAttribute((const void*)fwd_kernel, hipFuncAttributeMaxDynamicSharedMemorySize, LDS_BYTES) != hipSuccess) { fprintf(stderr, "kernel_launch: hipFuncSetAttribute failed\n"); grid = -1; return; }
        if (hipOccupancyMaxActiveBlocksPerMultiprocessor(&per_cu, (const void*)fwd_kernel, 512, LDS_BYTES) != hipSuccess || per_cu < 1) fprintf(stderr, "kernel_launch: occupancy query says %d per CU\n", per_cu);
        (void)hipGetLastError();
        grid = cus;
    }
    if (grid < 0) return;
    if (hipMemsetAsync((char*)d_ws + WS_CTL, 0, ZERO_BYTES, stream) != hipSuccess) return;
    Args a{};
    for (int i = 0; i < 26; ++i) a.in[i] = (const float*)d_in[i];
    a.out = (float*)d_out; a.ws = (unsigned char*)d_ws;
#if MK_SPLIT
    for (int p = 0; p < N_PHASES; ++p) { a.ph_lo = p; a.ph_hi = p + 1; hipLaunchKernelGGL(fwd_kernel, dim3(grid), dim3(512), LDS_BYTES, stream, a); }
#else
    a.ph_lo = 0; a.ph_hi = N_PHASES;
    hipLaunchKernelGGL(fwd_kernel, dim3(grid), dim3(512), LDS_BYTES, stream, a);
#endif
}
```

```cpp
#include <hip/hip_runtime.h>
#include <cstdio>
#include <cstdint>

#ifndef MK_SPLIT
#define MK_SPLIT 0
#endif

#ifndef PROBE_PHASE
#define PROBE_PHASE 0
#endif
#ifndef PROBE_MULT
#define PROBE_MULT 2
#endif
constexpr int NMETA = 16, SEQ = 8192, LTOK = 8208, DM = 4096, MPAD = 8448;
constexpr int INW = 18048, INWP = 18176;
constexpr int ATTW = 2048, KVW = 512, UW = 6784, UPITCH = 6912;
constexpr int RC = 2048, RH = 32, RN = 64;
constexpr int DFF = 11008;
constexpr float RMS_EPS = 1e-6f, GN_EPS = 64e-5f;
constexpr int HT = MPAD / 256;
constexpr int CT_Q = 32, CT_K = 40, CT_V = 42, CT_U = 44, CT_N = 71;

namespace pg8 {
#define PG8_LAS __attribute__((address_space(3)))
typedef unsigned short bf16_t;
typedef short bf16x8 __attribute__((ext_vector_type(8)));
typedef float f32x4 __attribute__((ext_vector_type(4)));
typedef unsigned u32x4 __attribute__((ext_vector_type(4)));
constexpr int BM = 256, BK = 64, HALF = 128, HTB = HALF * BK * 2  , STAGE_BYTES = 8 * HTB, NXCD = 8, WGM = 8;

__host__ __device__ __forceinline__ int lds_byte(int r, int c) { const int st = (r >> 4) * 2 + (c >> 5), rr = r & 15, cc = c & 31, ob = rr * 64 + cc * 2; return st * 1024 + (ob ^ (((ob >> 9) & 1) << 5)); }
__host__ __device__ __forceinline__ void stage_rc(int b, int& R, int& C) { const int st = b / 1024, sb = b % 1024, swz = sb ^ (((sb >> 9) & 1) << 5); R = (st >> 1) * 16 + swz / 64; C = (st & 1) * 32 + (swz % 64) / 2; }
__host__ __device__ __forceinline__ int perm32(int rho) { const int n = rho >> 4, i = rho & 15; return 8 * (i >> 2) + 4 * n + (i & 3); }

struct Unit { int pm, pn; };
struct Gemm { const bf16_t* A; const bf16_t* Bt; int M, N, K; };

struct StaticOrder {
    int nM, nN, nwg, G, c;
    __host__ __device__ void init(int M, int N, int G_, int c_) { nM = M / BM; nN = N / BM; nwg = nM * nN; G = G_; c = c_; }
    __host__ __device__ bool next(int i, Unit& u) const {
        const long L = (long)i * G + c; if (L >= nwg) return false;
        int wgid = (int)L; { const int q = nwg / NXCD, r = nwg % NXCD, xcd = wgid % NXCD, off = wgid / NXCD; wgid = (xcd < r ? xcd * (q + 1) : r * (q + 1) + (xcd - r) * q) + off; }
        const int nig = WGM * nN, gid = wgid / nig, fm = gid * WGM, gsz = (nM - fm) < WGM ? (nM - fm) : WGM;
        u.pm = fm + ((wgid % nig) % gsz); u.pn = (wgid % nig) / gsz; return true;
    }
    __device__ __forceinline__ void a_ready(const Unit&) const {}
    __device__ __forceinline__ void done(const Unit&) const {}
};

typedef float f32x2c __attribute__((ext_vector_type(2)));
typedef __bf16 bf16x2c __attribute__((ext_vector_type(2)));
__device__ __forceinline__ unsigned cvt_pk_bf16(float lo, float hi) { const f32x2c v = {lo, hi}; const bf16x2c r = __builtin_convertvector(v, bf16x2c); return __builtin_bit_cast(unsigned, r); }

typedef unsigned u32x2 __attribute__((ext_vector_type(2)));
__device__ __forceinline__ float bflo(unsigned w) { return __uint_as_float(w << 16); }
__device__ __forceinline__ float bfhi(unsigned w) { return __uint_as_float(w & 0xffff0000u); }
__device__ __forceinline__ float sigmoidf_(float x) { return __builtin_amdgcn_rcpf(1.0f + __expf(-x)); }

struct InOrder {
    StaticOrder base; int G, c;
    __device__ void init(int G_, int c_) { base.init(SEQ, INWP, G_, c_); G = G_; c = c_; }
    __device__ bool next(int i, Unit& u) const {
        const long L = (long)i * G + c;
        if (L < base.nwg) {
            base.next(i, u);
            if (u.pn >= CT_V && u.pn < CT_U) { const int e = (u.pn - CT_V) * 32 + u.pm; u.pm = HT + CT_V + e / HT; u.pn = e % HT; }
            else u.pn += HT;
            return true;
        }
        const int x = (int)(L - base.nwg);
        if (x >= 31) return false;
        if (x < 2) { const int e = 64 + x; u.pm = HT + CT_V + e / HT; u.pn = e % HT; }
        else { const int y = x - 2; u.pm = 32; u.pn = HT + (y < 2 ? CT_K + y : CT_U + (y - 2)); }
        return true;
    }
    __device__ __forceinline__ void a_ready(const Unit&) const {}
    __device__ __forceinline__ void done(const Unit&) const {}
};

struct EpiIn {
    static constexpr bool PERM = true, AFTER_DRAIN = false;
    bf16_t *G, *Q, *K, *Vt, *U; const float* bgate; const float* rope;
    __device__ __forceinline__ static void st8(bf16_t* p, const f32x4& v0, const f32x4& v1) {
        u32x4 w; w.x = cvt_pk_bf16(v0[0], v0[1]); w.y = cvt_pk_bf16(v0[2], v0[3]); w.z = cvt_pk_bf16(v1[0], v1[1]); w.w = cvt_pk_bf16(v1[2], v1[3]); *(u32x4*)p = w; }
    __device__ __forceinline__ void plain(const f32x4 (&acc)[2][2][4][2], bf16_t* base, int ldc, int row0, int col0) const {
#pragma unroll
        for (int ai = 0; ai < 2; ++ai)
#pragma unroll
            for (int m = 0; m < 4; ++m) { bf16_t* rowp = base + (size_t)(row0 + ai * HALF + m * 16) * ldc + col0;
#pragma unroll
                for (int bj = 0; bj < 2; ++bj) st8(rowp + bj * HALF, acc[ai][bj][m][0], acc[ai][bj][m][1]); }
    }
    __device__ __forceinline__ void roped(const f32x4 (&acc)[2][2][4][2], bf16_t* base, int ldc, int row0, int col0, int wc, int fq) const {
        if (wc != 0) { plain(acc, base, ldc, row0, col0); return; }
        const float sgn = (fq < 2) ? -1.0f : 1.0f;
#pragma unroll
        for (int ai = 0; ai < 2; ++ai)
#pragma unroll
            for (int m = 0; m < 4; ++m) { const int row = row0 + ai * HALF + m * 16; const int pos = row < SEQ ? row + NMETA : row - SEQ;
                const f32x4* cs = (const f32x4*)(rope + (size_t)pos * 32 + 16 * (fq & 1));
                const f32x4 c0 = cs[0], c1 = cs[1], c2 = cs[2], c3 = cs[3];
                const float cw[8] = {c0[0], c0[2], c1[0], c1[2], c2[0], c2[2], c3[0], c3[2]}, sw[8] = {c0[1], c0[3], c1[1], c1[3], c2[1], c2[3], c3[1], c3[3]};
                bf16_t* rowp = base + (size_t)row * ldc + col0;
#pragma unroll
                for (int bj = 0; bj < 2; ++bj) { f32x4 v0 = acc[ai][bj][m][0], v1 = acc[ai][bj][m][1], o0, o1;
#pragma unroll
                    for (int e = 0; e < 4; ++e) { const float p0 = __shfl_xor(v0[e], 32), p1 = __shfl_xor(v1[e], 32);
                        o0[e] = v0[e] * cw[e] + sgn * p0 * sw[e]; o1[e] = v1[e] * cw[4 + e] + sgn * p1 * sw[4 + e]; }
                    st8(rowp + bj * HALF, o0, o1); } }
    }
    __device__ __forceinline__ void operator()(const f32x4 (&acc)[2][2][4][2], const Unit& u, int wr, int wc, int fr, int fq) const {
        if (u.pm >= HT) {
            plain(acc, Vt, MPAD, (u.pm - HT - CT_V) * BM + wr * 64 + fr, u.pn * BM + wc * 32 + 8 * fq); return; }
        const int ct = u.pn - HT, row0 = u.pm * BM + wr * 64 + fr, cl = wc * 32 + 8 * fq;
        if (ct < CT_Q) {
            const int col0 = ct * BM + cl;
#pragma unroll
            for (int bj = 0; bj < 2; ++bj) { const f32x4 b0 = *(const f32x4*)(bgate + col0 + bj * HALF), b1 = *(const f32x4*)(bgate + col0 + bj * HALF + 4);
#pragma unroll
                for (int ai = 0; ai < 2; ++ai)
#pragma unroll
                    for (int m = 0; m < 4; ++m) { f32x4 v0 = acc[ai][bj][m][0] + b0, v1 = acc[ai][bj][m][1] + b1;
#pragma unroll
                        for (int e = 0; e < 4; ++e) { v0[e] = sigmoidf_(v0[e]); v1[e] = sigmoidf_(v1[e]); }
                        st8(G + (size_t)(row0 + ai * HALF + m * 16) * (2 * DM) + col0 + bj * HALF, v0, v1); } }
        } else if (ct < CT_K) { roped(acc, Q, ATTW, row0, (ct - CT_Q) * BM + cl, wc, fq);
        } else if (ct < CT_V) { roped(acc, K, KVW, row0, (ct - CT_K) * BM + cl, wc, fq);
        } else { plain(acc, U, UPITCH, row0, (ct - CT_U) * BM + cl); }
    }
};

struct EpiProjA {
    static constexpr bool PERM = true, AFTER_DRAIN = false;
    bf16_t* P1; const bf16_t* G;
    __device__ __forceinline__ void operator()(const f32x4 (&acc)[2][2][4][2], const Unit& u, int wr, int wc, int fr, int fq) const {
        const int row0 = u.pm * BM + wr * 64 + fr, col0 = u.pn * BM + wc * 32 + 8 * fq;
#pragma unroll
        for (int ai = 0; ai < 2; ++ai)
#pragma unroll
            for (int m = 0; m < 4; ++m) { const size_t r = (size_t)(row0 + ai * HALF + m * 16);
#pragma unroll
                for (int bj = 0; bj < 2; ++bj) { const int c = col0 + bj * HALF; const u32x4 g = *(const u32x4*)(G + r * (2 * DM) + c);
                    f32x4 o0 = acc[ai][bj][m][0], o1 = acc[ai][bj][m][1];
                    o0[0] *= bflo(g.x); o0[1] *= bfhi(g.x); o0[2] *= bflo(g.y); o0[3] *= bfhi(g.y); o1[0] *= bflo(g.z); o1[1] *= bfhi(g.z); o1[2] *= bflo(g.w); o1[3] *= bfhi(g.w);
                    EpiIn::st8(P1 + r * DM + c, o0, o1); } }
    }
};
struct EpiProjB {
    static constexpr bool PERM = true, AFTER_DRAIN = false;
    const bf16_t* P1; const bf16_t* G; bf16_t* MX;
    __device__ __forceinline__ void operator()(const f32x4 (&acc)[2][2][4][2], const Unit& u, int wr, int wc, int fr, int fq) const {
        const int row0 = u.pm * BM + wr * 64 + fr, col0 = u.pn * BM + wc * 32 + 8 * fq;
#pragma unroll
        for (int ai = 0; ai < 2; ++ai)
#pragma unroll
            for (int m = 0; m < 4; ++m) { const size_t r = (size_t)(row0 + ai * HALF + m * 16);
#pragma unroll
                for (int bj = 0; bj < 2; ++bj) { const int c = col0 + bj * HALF; const u32x4 g = *(const u32x4*)(G + r * (2 * DM) + DM + c); const u32x4 q = *(const u32x4*)(P1 + r * DM + c);
                    f32x4 o0 = {bflo(q.x), bfhi(q.x), bflo(q.y), bfhi(q.y)}, o1 = {bflo(q.z), bfhi(q.z), bflo(q.w), bfhi(q.w)}; const f32x4 a0 = acc[ai][bj][m][0], a1 = acc[ai][bj][m][1];
                    o0[0] += a0[0] * bflo(g.x); o0[1] += a0[1] * bfhi(g.x); o0[2] += a0[2] * bflo(g.y); o0[3] += a0[3] * bfhi(g.y);
                    o1[0] += a1[0] * bflo(g.z); o1[1] += a1[1] * bfhi(g.z); o1[2] += a1[2] * bflo(g.w); o1[3] += a1[3] * bfhi(g.w);
                    EpiIn::st8(MX + r * DM + c, o0, o1); }
                asm volatile("" ::: "memory"); }
    }
};
template <bool BASE_BF16> struct EpiResid {
    static constexpr bool PERM = true, AFTER_DRAIN = false;
    const float* BASEF; const bf16_t* BASEB; float* OUTF; bf16_t* OUTB; float* SS;
    __device__ __forceinline__ void operator()(const f32x4 (&acc)[2][2][4][2], const Unit& u, int wr, int wc, int fr, int fq) const {
        const int row0 = u.pm * BM + wr * 64 + fr, col0 = u.pn * BM + wc * 32 + 8 * fq;
#pragma unroll
        for (int ai = 0; ai < 2; ++ai)
#pragma unroll
            for (int m = 0; m < 4; ++m) { const size_t r = (size_t)(row0 + ai * HALF + m * 16); float ss = 0.f;
#pragma unroll
                for (int bj = 0; bj < 2; ++bj) { const int c = col0 + bj * HALF; f32x4 o0, o1;
                    if (BASE_BF16) { const u32x4 g = *(const u32x4*)(BASEB + r * DM + c); o0 = (f32x4){bflo(g.x), bfhi(g.x), bflo(g.y), bfhi(g.y)}; o1 = (f32x4){bflo(g.z), bfhi(g.z), bflo(g.w), bfhi(g.w)}; }
                    else { const float* bp = BASEF + r * DM + c; o0 = *(const f32x4*)bp; o1 = *(const f32x4*)(bp + 4); }
                    o0 += acc[ai][bj][m][0]; o1 += acc[ai][bj][m][1];
                    if (BASE_BF16) { float* op = OUTF + r * DM + c; *(f32x4*)op = o0; *(f32x4*)(op + 4) = o1; }
                    else { u32x4 w; w.x = cvt_pk_bf16(o0[0], o0[1]); w.y = cvt_pk_bf16(o0[2], o0[3]); w.z = cvt_pk_bf16(o1[0], o1[1]); w.w = cvt_pk_bf16(o1[2], o1[3]); *(u32x4*)(OUTB + r * DM + c) = w;
                        o0 = (f32x4){bflo(w.x), bfhi(w.x), bflo(w.y), bfhi(w.y)}; o1 = (f32x4){bflo(w.z), bfhi(w.z), bflo(w.w), bfhi(w.w)}; }
                    ss += (o0[0] * o0[0] + o0[1] * o0[1]) + (o0[2] * o0[2] + o0[3] * o0[3]) + (o1[0] * o1[0] + o1[1] * o1[1]) + (o1[2] * o1[2] + o1[3] * o1[3]); }
                ss += __shfl_xor(ss, 16); ss += __shfl_xor(ss, 32);
                if (fq == 0) atomicAdd(SS + r, ss);
                asm volatile("" ::: "memory"); }
    }
};
struct EpiSwiGLU {
    static constexpr bool PERM = true, AFTER_DRAIN = false;
    bf16_t* HID; const float* SS;
    __device__ __forceinline__ void operator()(const f32x4 (&acc)[2][2][4][2], const Unit& u, int wr, int wc, int fr, int fq) const {
        const int row0 = u.pm * BM + wr * 64 + fr, col0 = u.pn * HALF + wc * 32 + 8 * fq;
#pragma unroll
        for (int ai = 0; ai < 2; ++ai)
#pragma unroll
            for (int m = 0; m < 4; ++m) { const size_t r = (size_t)(row0 + ai * HALF + m * 16);
                const float rstd = __builtin_amdgcn_rsqf(SS[r] * (1.0f / DM) + RMS_EPS);
                f32x4 o0, o1;
#pragma unroll
                for (int e = 0; e < 4; ++e) { const float g0 = acc[ai][0][m][0][e] * rstd, u0 = acc[ai][1][m][0][e] * rstd, g1 = acc[ai][0][m][1][e] * rstd, u1 = acc[ai][1][m][1][e] * rstd;
                    o0[e] = g0 * sigmoidf_(g0) * u0; o1[e] = g1 * sigmoidf_(g1) * u1; }
                EpiIn::st8(HID + r * DFF + col0, o0, o1); }
    }
};

#define PG8_EPI_T0 unsigned long long epi_t0_ = 0; do { if ((PROBE_PHASE >> 20) & 1) epi_t0_ = __builtin_amdgcn_s_memrealtime(); } while (0)
#define PG8_EPI_T1 do { if ((PROBE_PHASE >> 20) & 1) epi_acc += __builtin_amdgcn_s_memrealtime() - epi_t0_; } while (0)
template <class Epi, class Sched, bool ALIGN_EPI = false, bool SP2 = false>
__device__ __forceinline__ void gemm_phase(PG8_LAS unsigned char* lds, const Gemm g, const Sched& S, const Epi& E, unsigned long long& epi_acc) {
    const int tid = threadIdx.x, wid = __builtin_amdgcn_readfirstlane(tid >> 6), lane = tid & 63, wr = wid >> 2, wc = wid & 3, fr = lane & 15, fq = lane >> 4;
    const int K = g.K, nt = K / BK;
    unsigned voffA[2], voffB[2];
#pragma unroll
    for (int i = 0; i < 2; ++i) { int R, C; stage_rc(tid * 16 + i * 8192, R, C); const int Rb = Epi::PERM ? ((R & ~31) + perm32(R & 31)) : R;
        voffA[i] = (unsigned)(R * K + C) * 2u; voffB[i] = (unsigned)(Rb * K + C) * 2u; }
    const size_t kstep = (size_t)(BK * 2);
    const size_t hstep = (size_t)HALF * K * 2;
    const size_t tstep = 2 * hstep;
    const unsigned ldsw = (unsigned)wid * 1024u;
    const int aoff = lds_byte(wr * 64 + fr, fq * 8), boff = lds_byte(wc * 32 + fr, fq * 8);
#define PG8_SA(b, h) (((b) * 2 + (h)) * HTB)
#define PG8_SB(b, h) ((4 + (b) * 2 + (h)) * HTB)
#define PG8_STAGE(bufoff, gbase, voff) do { _Pragma("unroll") for (int _i = 0; _i < 2; ++_i) \
        __builtin_amdgcn_global_load_lds((const unsigned*)((const char*)(gbase) + (voff)[_i]), (PG8_LAS unsigned*)(lds + (bufoff) + ldsw + _i * 8192), 16, 0, 0); } while (0)
#define PG8_LDA(dst, b, h) do { _Pragma("unroll") for (int m = 0; m < 4; ++m) _Pragma("unroll") for (int k = 0; k < 2; ++k) dst[m][k] = *(const PG8_LAS bf16x8*)(lds + PG8_SA(b, h) + aoff + m * 2048 + k * 1024); } while (0)
#define PG8_LDB(dst, b, h) do { _Pragma("unroll") for (int n = 0; n < 2; ++n) _Pragma("unroll") for (int k = 0; k < 2; ++k) dst[n][k] = *(const PG8_LAS bf16x8*)(lds + PG8_SB(b, h) + boff + n * 2048 + k * 1024); } while (0)
#define PG8_MMA(ai, bj, At, Bt) do { __builtin_amdgcn_s_setprio(1); _Pragma("unroll") for (int m = 0; m < 4; ++m) _Pragma("unroll") for (int n = 0; n < 2; ++n) _Pragma("unroll") for (int k = 0; k < 2; ++k) \
        acc[ai][bj][m][n] = __builtin_amdgcn_mfma_f32_16x16x32_bf16(Bt[n][k], At[m][k], acc[ai][bj][m][n], 0, 0, 0); __builtin_amdgcn_s_setprio(0); } while (0)
#define PG8_WAIT_V(n) asm volatile("s_waitcnt vmcnt(" #n ")" ::: "memory")
#define PG8_WAIT_L(n) asm volatile("s_waitcnt lgkmcnt(" #n ")" ::: "memory")
#define PG8_BAR __builtin_amdgcn_s_barrier()
#define PG8_SCHED __builtin_amdgcn_sched_barrier(0)
    Unit cur, nxt; int ui = 0;
    if (!S.next(0, cur)) return;
    f32x4 acc[2][2][4][2];
#pragma unroll
    for (int a = 0; a < 2; ++a)
#pragma unroll
        for (int b = 0; b < 2; ++b)
#pragma unroll
            for (int m = 0; m < 4; ++m)
#pragma unroll
                for (int n = 0; n < 2; ++n) acc[a][b][m][n] = (f32x4){0.f, 0.f, 0.f, 0.f};
    bf16x8 At[4][2], B0[2][2], B1[2][2];
    const char* cA = (const char*)g.A + (size_t)cur.pm * tstep; const char* cB = (const char*)g.Bt + (size_t)cur.pn * tstep;
    S.a_ready(cur);
    if constexpr (SP2) {
        PG8_STAGE(PG8_SB(0, 0), cB, voffB); PG8_STAGE(PG8_SB(0, 1), cB + hstep, voffB); PG8_STAGE(PG8_SA(0, 0), cA, voffA); PG8_STAGE(PG8_SA(0, 1), cA + hstep, voffA);
        if (wr == 1) PG8_BAR;
        PG8_WAIT_V(2); PG8_BAR;
        PG8_STAGE(PG8_SB(1, 0), cB + kstep, voffB); PG8_STAGE(PG8_SA(1, 0), cA + kstep, voffA); PG8_STAGE(PG8_SB(1, 1), cB + hstep + kstep, voffB);
        PG8_WAIT_V(6); PG8_BAR;
    } else {
        PG8_STAGE(PG8_SB(0, 0), cB, voffB); PG8_STAGE(PG8_SA(0, 0), cA, voffA); PG8_STAGE(PG8_SB(0, 1), cB + hstep, voffB); PG8_STAGE(PG8_SA(0, 1), cA + hstep, voffA);
        if (wr == 1) PG8_BAR;
        PG8_WAIT_V(4); PG8_BAR;
        PG8_STAGE(PG8_SB(1, 0), cB + kstep, voffB); PG8_STAGE(PG8_SA(1, 0), cA + kstep, voffA); PG8_STAGE(PG8_SB(1, 1), cB + hstep + kstep, voffB);
        PG8_WAIT_V(6); PG8_BAR;
    }
    for (;;) {
        const bool has_next = S.next(ui + 1, nxt);
        const char* nA = has_next ? (const char*)g.A + (size_t)nxt.pm * tstep : cA; const char* nB = has_next ? (const char*)g.Bt + (size_t)nxt.pn * tstep : cB;
        for (int t = 0; t < nt; t += 2) {
            const bool last = (t == nt - 2);
            const char* a1 = cA + (size_t)(t + 1) * kstep;
            const char* a2 = last ? nA : cA + (size_t)(t + 2) * kstep; const char* b2 = last ? nB : cB + (size_t)(t + 2) * kstep;
            const char* a3 = a2 + kstep; const char* b3 = b2 + kstep;
            if (last && has_next) S.a_ready(nxt);
            if constexpr (SP2) {
            PG8_LDB(B0, 0, 0); PG8_LDB(B1, 0, 1); PG8_SCHED; PG8_LDA(At, 0, 0); PG8_STAGE(PG8_SA(1, 1), a1 + hstep, voffA);
            PG8_WAIT_V(8); PG8_WAIT_L(0); PG8_BAR; PG8_MMA(0, 0, At, B0); PG8_MMA(0, 1, At, B1); PG8_BAR; PG8_SCHED;
            PG8_LDA(At, 0, 1); PG8_STAGE(PG8_SB(0, 0), b2, voffB); PG8_STAGE(PG8_SB(0, 1), b2 + hstep, voffB); PG8_STAGE(PG8_SA(0, 0), a2, voffA);
            PG8_WAIT_V(8); PG8_WAIT_L(0); PG8_BAR; PG8_MMA(1, 0, At, B0); PG8_MMA(1, 1, At, B1); PG8_BAR; PG8_SCHED;
            PG8_LDB(B0, 1, 0); PG8_LDB(B1, 1, 1); PG8_SCHED; PG8_LDA(At, 1, 0); PG8_STAGE(PG8_SA(0, 1), a2 + hstep, voffA);
            PG8_WAIT_V(8); PG8_WAIT_L(0); PG8_BAR; PG8_MMA(0, 0, At, B0); PG8_MMA(0, 1, At, B1); PG8_BAR; PG8_SCHED;
            PG8_LDA(At, 1, 1); PG8_STAGE(PG8_SB(1, 0), b3, voffB); PG8_STAGE(PG8_SB(1, 1), b3 + hstep, voffB); PG8_STAGE(PG8_SA(1, 0), a3, voffA);
            PG8_WAIT_V(8); PG8_WAIT_L(0); PG8_BAR; PG8_MMA(1, 0, At, B0); PG8_MMA(1, 1, At, B1); PG8_BAR; PG8_SCHED;
            } else {
            PG8_LDB(B0, 0, 0); PG8_SCHED; PG8_LDA(At, 0, 0); PG8_STAGE(PG8_SA(1, 1), a1 + hstep, voffA);
            PG8_WAIT_L(8); PG8_BAR; PG8_WAIT_L(0); PG8_MMA(0, 0, At, B0); PG8_BAR; PG8_SCHED;
            PG8_LDB(B1, 0, 1); PG8_STAGE(PG8_SB(0, 0), b2, voffB);
            PG8_BAR; PG8_WAIT_L(0); PG8_MMA(0, 1, At, B1); PG8_BAR;
            PG8_LDA(At, 0, 1); PG8_STAGE(PG8_SA(0, 0), a2, voffA);
            PG8_BAR; PG8_WAIT_L(0); PG8_MMA(1, 0, At, B0); PG8_BAR; PG8_SCHED;
            PG8_STAGE(PG8_SB(0, 1), b2 + hstep, voffB);
            PG8_WAIT_V(6); PG8_BAR; PG8_MMA(1, 1, At, B1); PG8_BAR;
            PG8_LDB(B0, 1, 0); PG8_SCHED; PG8_LDA(At, 1, 0); PG8_STAGE(PG8_SA(0, 1), a2 + hstep, voffA);
            PG8_WAIT_L(8); PG8_BAR; PG8_WAIT_L(0); PG8_MMA(0, 0, At, B0); PG8_BAR; PG8_SCHED;
            PG8_LDB(B1, 1, 1); PG8_STAGE(PG8_SB(1, 0), b3, voffB);
            PG8_BAR; PG8_WAIT_L(0); PG8_MMA(0, 1, At, B1); PG8_BAR;
            PG8_LDA(At, 1, 1); PG8_STAGE(PG8_SA(1, 0), a3, voffA);
            PG8_BAR; PG8_WAIT_L(0); PG8_MMA(1, 0, At, B0); PG8_BAR; PG8_SCHED;
            PG8_STAGE(PG8_SB(1, 1), b3 + hstep, voffB);
            PG8_WAIT_V(6); PG8_BAR; PG8_MMA(1, 1, At, B1); PG8_BAR;
            }
        }
        if constexpr (ALIGN_EPI) { if (wr == 0) PG8_BAR; }
        if constexpr (!Epi::AFTER_DRAIN) { PG8_EPI_T0; E(acc, cur, wr, wc, fr, fq); S.done(cur); PG8_EPI_T1; }
        if (!has_next) break;
#pragma unroll
        for (int a = 0; a < 2; ++a)
#pragma unroll
            for (int b = 0; b < 2; ++b)
#pragma unroll
                for (int m = 0; m < 4; ++m)
#pragma unroll
                    for (int n = 0; n < 2; ++n) acc[a][b][m][n] = (f32x4){0.f, 0.f, 0.f, 0.f};
        cur = nxt; cA = nA; cB = nB; ++ui;
        if constexpr (ALIGN_EPI) { if (wr == 1) PG8_BAR; }
    }
    PG8_WAIT_V(0);
    if constexpr (!ALIGN_EPI) { if (wr == 0) PG8_BAR; }
    PG8_BAR;
    if constexpr (Epi::AFTER_DRAIN) { E.fused(acc, cur, wr, wc, fr, fq, lds, wid, lane); S.done(cur); }
#undef PG8_SA
#undef PG8_SB
#undef PG8_STAGE
#undef PG8_LDA
#undef PG8_LDB
#undef PG8_MMA
#undef PG8_WAIT_V
#undef PG8_WAIT_L
#undef PG8_BAR
#undef PG8_SCHED
}

}

constexpr size_t MiB = 1u << 20;
constexpr size_t WS_CTL = 0;
constexpr size_t WS_ROPE = 1 * MiB;
constexpr size_t WS_LW2 = 3 * MiB, WS_LA2 = 4 * MiB, WS_LG2 = 5 * MiB;
constexpr size_t WS_BONUS = 6 * MiB;
constexpr size_t ZERO_BYTES = 8 * MiB;
constexpr size_t SCF = (size_t)LTOK * RC * 4, SCB = (size_t)LTOK * RC * 2;
constexpr size_t WS_H = 8 * MiB, WS_WIN = WS_H + (size_t)MPAD * DM * 2;
constexpr size_t WS_KD0 = 8 * MiB, WS_KD1 = WS_KD0 + SCB, WS_B0 = WS_KD1 + SCB, WS_B1 = WS_B0 + SCB, WS_KK = WS_B1 + SCB, WS_RR = WS_KK + SCB;
constexpr size_t WS_WGU = 8 * MiB;
constexpr size_t WS_G = 216 * MiB, WS_A2 = 216 * MiB;
constexpr size_t WS_Q = 344 * MiB, WS_K = 376 * MiB, WS_VT = 385 * MiB, WS_U = 394 * MiB;
constexpr size_t WS_P1 = 344 * MiB;
constexpr size_t WS_Y = 394 * MiB;
constexpr size_t WS_W0 = 506 * MiB, WS_W1 = WS_W0 + SCF;
constexpr size_t WS_WPA = 506 * MiB, WS_WPR = 522 * MiB, WS_WOUT = 538 * MiB, WS_OATT = 570 * MiB;
constexpr size_t WS_VV = 635 * MiB, WS_GG = 668 * MiB;
constexpr size_t WS_BO = 701 * MiB;
constexpr size_t WS_HID = 701 * MiB, WS_MX = 873 * MiB;
constexpr int NB0 = 513, NB1 = 512, NBT = NB0 + NB1;
constexpr int BO_FA = 0, BO_FAA = 4096, BO_FT = 5120, BO_FBP = 5632, BO_FB = 6144, BO_FG = 10240, BO_ITEM = 10496;
constexpr size_t WS_WD = 1030 * MiB, WS_ORWKV = 182 * MiB, WS_END = 1116 * MiB;
static_assert(WS_WIN + (size_t)INWP * DM * 2 <= WS_G && WS_RR + SCB <= WS_G && WS_WGU + (size_t)2 * DFF * DM * 2 <= WS_G, "map: A0");
static_assert(WS_U + (size_t)MPAD * UPITCH * 2 <= WS_W0 && WS_VT + (size_t)KVW * MPAD * 2 <= WS_U && WS_K + (size_t)MPAD * KVW * 2 <= WS_VT && WS_Q + (size_t)SEQ * ATTW * 2 <= WS_K && WS_Y + 2 * SCB <= WS_W0, "map: P1 outputs");
static_assert(WS_W1 + SCF <= WS_VV && WS_OATT + (size_t)SEQ * ATTW * 2 <= WS_VV && WS_VV + SCB <= WS_GG && WS_GG + SCB <= WS_BO && WS_P1 + (size_t)SEQ * DM * 2 <= WS_W0, "map: mid");
static_assert(WS_BO + (size_t)RH * NBT * BO_ITEM <= WS_WD && WS_HID + (size_t)SEQ * DFF * 2 <= WS_MX && WS_MX + (size_t)SEQ * DM * 2 <= WS_WD && WS_WD + (size_t)DM * DFF * 2 <= WS_END && WS_WGU + (size_t)2 * DFF * DM * 2 <= WS_ORWKV && WS_ORWKV + (size_t)SEQ * RC * 2 <= WS_G, "map: tail");
constexpr int CW_BAR = 4096;
constexpr int CW_SS2 = 65536, CW_SS3 = 65536 + 8192;
static_assert((CW_SS3 + 8192) * 4 <= (int)(1 * MiB), "CTL");

constexpr int RING_BYTES = 131072;
constexpr int LDSCTL_OFF = RING_BYTES, MISC_OFF = LDSCTL_OFF + 320;
constexpr int LDS_BYTES = 147456;

#define GAS __attribute__((address_space(1)))
#define LAS __attribute__((address_space(3)))
typedef unsigned short bf16;
typedef unsigned v4u __attribute__((ext_vector_type(4)));
typedef unsigned v2u __attribute__((ext_vector_type(2)));
typedef float f32x4 __attribute__((ext_vector_type(4)));
typedef float f32x2 __attribute__((ext_vector_type(2)));
typedef float f32x16 __attribute__((ext_vector_type(16)));
typedef short bf16x8 __attribute__((ext_vector_type(8)));
typedef GAS unsigned gu32;
#define RLX_AGENT __ATOMIC_RELAXED, __HIP_MEMORY_SCOPE_AGENT
#define LDS_WAIT() asm volatile("s_waitcnt lgkmcnt(0)" ::: "memory")
__device__ __forceinline__ unsigned pk2(float lo, float hi) { return pg8::cvt_pk_bf16(lo, hi); }
__device__ __forceinline__ unsigned f2bf(float f) { return pg8::cvt_pk_bf16(f, 0.f) & 0xffffu; }
__device__ __forceinline__ float bf2f(bf16 b) { return __uint_as_float(((unsigned)b) << 16); }
using pg8::bflo; using pg8::bfhi; using pg8::sigmoidf_;

#define XB_TMO      128
#define XB_XCNT(j)  (256  + 64 * (j))
#define XB_XSUB(j)  (1280 + 64 * (j))
#define XB_XGEN(j)  (2304 + 64 * (j))
#define XB_TOP      3328
#define XB_TOPGEN   3392
#define XCD_BAR_WORDS 3456
#define XB_SPIN_CAP (1u << 18)

__device__ __forceinline__ unsigned xb_ld(unsigned* p)              { return __hip_atomic_load(p, __ATOMIC_RELAXED, __HIP_MEMORY_SCOPE_AGENT); }
__device__ __forceinline__ unsigned xb_add(unsigned* p, unsigned v) { return __hip_atomic_fetch_add(p, v, __ATOMIC_RELAXED, __HIP_MEMORY_SCOPE_AGENT); }
__device__ __forceinline__ unsigned xb_xcc_id() { return (unsigned)__builtin_amdgcn_s_getreg((3 << 11) | 20) & 0xFu; }
#define XB_SPIN(cond, bar) do { unsigned _sp = 0; while (cond) { __builtin_amdgcn_s_sleep(1); \
    if ((++_sp & 255u) == 0u) { if (xb_ld(&(bar)[XB_TMO])) break; if (_sp > XB_SPIN_CAP) { atomicAdd(&(bar)[XB_TMO], 1u); break; } } } } while (0)

struct XcdBarrier {
    unsigned* bar; unsigned x;
    volatile LAS unsigned* st;
};

__device__ __forceinline__ XcdBarrier xcd_barrier_post(unsigned* bar, volatile LAS unsigned* st) {
    XcdBarrier b; b.bar = bar; b.x = xb_xcc_id(); b.st = st;
    if (threadIdx.x == 0) (void)xb_add(&bar[XB_XCNT(b.x)], 1u);
    return b;
}
__device__ __forceinline__ void xcd_barrier_complete(unsigned* bar, unsigned x, unsigned& nloc, unsigned& nx) {
    const unsigned G = gridDim.x * gridDim.y * gridDim.z;
    unsigned sum, cnt, mine, sp = 0u;
    for (;;) {
        sum = 0u; cnt = 0u; mine = 0u;
#pragma unroll
        for (unsigned j = 0; j < 16; ++j) { const unsigned c = xb_ld(&bar[XB_XCNT(j)]); sum += c; cnt += (c > 0u) ? 1u : 0u; mine = (j == x) ? c : mine; }
        if (sum == G) break;
        __builtin_amdgcn_s_sleep(1);
        if ((++sp & 255u) == 0u) { if (xb_ld(&bar[XB_TMO])) break; if (sp > XB_SPIN_CAP) { atomicAdd(&bar[XB_TMO], 1u); break; } }
    }
    nloc = mine > 0u ? mine : 1u; nx = cnt > 0u ? cnt : 1u;
}

__device__ __forceinline__ void xcd_barrier(const XcdBarrier& b) {
    asm volatile("s_waitcnt vmcnt(0)" ::: "memory");
    __syncthreads();
    if (threadIdx.x == 0) {
        unsigned* bar = b.bar;
        __builtin_amdgcn_s_waitcnt(0);
        unsigned nloc = b.st[0], nx = b.st[1];
        if (nloc == 0u) { xcd_barrier_complete(bar, b.x, nloc, nx); b.st[0] = nloc; b.st[1] = nx; }
        const unsigned old = xb_add(&bar[XB_XSUB(b.x)], 1u);
        const unsigned gen = old / nloc;
        if (old + 1u == (gen + 1u) * nloc) {
            __builtin_amdgcn_fence(__ATOMIC_RELEASE, "agent");
            asm volatile("s_waitcnt vmcnt(0)" ::: "memory");
            const unsigned og = xb_add(&bar[XB_TOP], 1u);
            const unsigned tg = og / nx;
            if (og + 1u == (tg + 1u) * nx) xb_add(&bar[XB_TOPGEN], 1u);
            else XB_SPIN(xb_ld(&bar[XB_TOPGEN]) == tg, bar);
            __builtin_amdgcn_fence(__ATOMIC_ACQUIRE, "agent");
            xb_add(&bar[XB_XGEN(b.x)], 1u);
            asm volatile("s_waitcnt vmcnt(0)" ::: "memory");
        } else {
            XB_SPIN(xb_ld(&bar[XB_XGEN(b.x)]) == gen, bar);
            __builtin_amdgcn_fence(__ATOMIC_ACQUIRE, "agent");
            asm volatile("s_waitcnt vmcnt(0)" ::: "memory");
        }
    }
    __syncthreads();
}


struct Frame {
    LAS unsigned char* lds;
    volatile LAS unsigned* MISC;
    gu32* ctl;
    int tid, lane, wave, G;
    unsigned char* ws;
    const float* in[26];
    float* out;
    unsigned long long pb0, pacc, pacc2;
};
#define FPB0(k) do { if ((PROBE_PHASE >> (k)) & 1) F.pb0 = __builtin_amdgcn_s_memrealtime(); } while (0)
#define FPB1(k) do { if ((PROBE_PHASE >> (k)) & 1) F.pacc += __builtin_amdgcn_s_memrealtime() - F.pb0; } while (0)
__device__ __forceinline__ float wave_sum(float v) {
#pragma unroll
    for (int o = 1; o < 64; o <<= 1) v += __shfl_xor(v, o);
    return v;
}

template <int KR> __device__ __forceinline__ void tr_issue(const float* W, int N, int item, int lane, float (&wv)[KR / 2]) {
    const int nblk = N / 32, kb = item / nblk, nb = item % nblk, k0 = KR * kb, n0 = 32 * nb;
#pragma unroll
    for (int i = 0; i < KR / 2; ++i) wv[i] = W[(size_t)(k0 + 2 * i + (lane >> 5)) * N + n0 + (lane & 31)];
}
template <int KR> __device__ __forceinline__ void tr_finish(bf16* WT, int K, int N, const float* kscale, int mode, int item, LAS float* scr, int lane, const float (&wv)[KR / 2]) {
    const int nblk = N / 32, kb = item / nblk, nb = item % nblk, k0 = KR * kb, n0 = 32 * nb;
#pragma unroll
    for (int i = 0; i < KR / 2; ++i) { const int kk = 2 * i + (lane >> 5); float v = wv[i]; if (kscale) v *= kscale[k0 + kk]; scr[kk * 33 + (lane & 31)] = v; }
    LDS_WAIT(); asm volatile("" ::: "memory");
    constexpr int CH = KR / 8;
    const int c = lane & (CH - 1);
#pragma unroll
    for (int jj = 0; jj < CH / 2; ++jj) { const int n = (lane / CH) + (64 / CH) * jj; const LAS float* s = scr + (8 * c) * 33 + n;
        v4u o; o.x = pk2(s[0 * 33], s[1 * 33]); o.y = pk2(s[2 * 33], s[3 * 33]); o.z = pk2(s[4 * 33], s[5 * 33]); o.w = pk2(s[6 * 33], s[7 * 33]);
        const int nn = n0 + n; const int dr = (mode == 0) ? nn : (256 * (nn >> 7) + (nn & 127) + (mode == 2 ? 128 : 0));
        *(GAS v4u*)(WT + (size_t)dr * K + k0 + 8 * c) = o; }
    LDS_WAIT(); asm volatile("" ::: "memory");
}
#define CONV_P4(it, CALL) do { constexpr int I_GU_ = (DM / 64) * (DFF / 32), I_P_ = (ATTW / 64) * (DM / 32); int r_ = (it); \
        if (r_ < I_GU_) { CALL(F.in[22], (bf16*)(F.ws + WS_WGU), DM, DFF, F.in[21], 1, r_); } \
        else if ((r_ -= I_GU_) < I_GU_) { CALL(F.in[23], (bf16*)(F.ws + WS_WGU), DM, DFF, F.in[21], 2, r_); } \
        else if ((r_ -= I_GU_) < I_P_) { CALL(F.in[18], (bf16*)(F.ws + WS_WPA), ATTW, DM, (const float*)nullptr, 0, r_); } \
        else if ((r_ -= I_P_) < I_P_) { CALL(F.in[19], (bf16*)(F.ws + WS_WPR), RC, DM, (const float*)nullptr, 0, r_); } \
        else { r_ -= I_P_; CALL(F.in[20], (bf16*)(F.ws + WS_WOUT), DM, DM, (const float*)nullptr, 0, r_); } } while (0)
constexpr int N_P4_ITEMS = 2 * (DM / 64) * (DFF / 32) + 2 * (ATTW / 64) * (DM / 32) + (DM / 64) * (DM / 32);
constexpr int N_WD_ITEMS = (DFF / 64) * (DM / 32);
constexpr int N_WD_HALF_ITEMS = (DFF / 32) * (DM / 32);
__device__ __forceinline__ void convert_seg(Frame& F, LAS float* scr, int first, int stride, int limit) {
    int it = first; if (it >= limit) return;
    float wv[32];
#define CVI(W_, WT_, K_, N_, ks_, md_, item_) tr_issue<64>(W_, N_, item_, F.lane, wv)
#define CVN(W_, WT_, K_, N_, ks_, md_, item_) tr_issue<64>(W_, N_, item_, F.lane, nv)
#define CVF(W_, WT_, K_, N_, ks_, md_, item_) tr_finish<64>(WT_, K_, N_, ks_, md_, item_, scr, F.lane, wv)
    CONV_P4(it, CVI);
    for (;;) { const int itn = it + stride; const bool more = itn < limit; float nv[32];
        if (more) CONV_P4(itn, CVN);
        CONV_P4(it, CVF);
        if (!more) break;
        it = itn;
#pragma unroll
        for (int i = 0; i < 32; ++i) wv[i] = nv[i]; }
#undef CVI
#undef CVN
#undef CVF
}
__device__ __forceinline__ void convert_p4(Frame& F, LAS float* scr, int widx, int NWK, int pidx, int NPL) {
    (void)pidx; (void)NPL;
    convert_seg(F, scr, widx, NWK, N_P4_ITEMS);
}
__device__ __forceinline__ void convert_win(Frame& F, LAS float* scr, int first, int stride) {
    constexpr int NI = (DM / 64) * (INW / 32); bf16* WT = (bf16*)(F.ws + WS_WIN);
    int it = first; if (it >= NI) return;
    float wv[32]; tr_issue<64>(F.in[3], INW, it, F.lane, wv);
    for (;;) { const int itn = it + stride; const bool more = itn < NI; float nv[32];
        if (more) tr_issue<64>(F.in[3], INW, itn, F.lane, nv);
        tr_finish<64>(WT, DM, INW, nullptr, 0, it, scr, F.lane, wv);
        if (!more) break;
        it = itn;
#pragma unroll
        for (int i = 0; i < 32; ++i) wv[i] = nv[i]; }
}
__device__ __forceinline__ void convert_wd(Frame& F, LAS float* scr, int first, int stride) {
    bf16* WT = (bf16*)(F.ws + WS_WD);
    int it = first; if (it >= N_WD_ITEMS) return;
    float wv[32]; tr_issue<64>(F.in[24], DM, it, F.lane, wv);
    for (;;) { const int itn = it + stride; const bool more = itn < N_WD_ITEMS; float nv[32];
        if (more) tr_issue<64>(F.in[24], DM, itn, F.lane, nv);
        tr_finish<64>(WT, DFF, DM, nullptr, 0, it, scr, F.lane, wv);
        if (!more) break;
        it = itn;
#pragma unroll
        for (int i = 0; i < 32; ++i) wv[i] = nv[i]; }
}
__device__ __forceinline__ void rms_row_to_bf16(int lane, const float* xrow, const float* w, bf16* orow) {
    const GAS f32x4* xr = (const GAS f32x4*)xrow + lane;
    f32x4 v[16]; float s = 0.f;
#pragma unroll
    for (int j = 0; j < 16; ++j) { v[j] = xr[64 * j]; s += (v[j].x * v[j].x + v[j].y * v[j].y) + (v[j].z * v[j].z + v[j].w * v[j].w); }
    const float rstd = 1.f / sqrtf(wave_sum(s) * (1.f / DM) + RMS_EPS);
    const GAS f32x4* wr = (const GAS f32x4*)w + lane;
    GAS v2u* o8 = (GAS v2u*)orow + lane;
#pragma unroll
    for (int j = 0; j < 16; ++j) { const f32x4 ww = wr[64 * j]; v2u o; o.x = pk2(v[j].x * rstd * ww.x, v[j].y * rstd * ww.y); o.y = pk2(v[j].z * rstd * ww.z, v[j].w * rstd * ww.w); o8[64 * j] = o; }
}
__device__ const double ROPE_INV[16] = {
    1.0000000000000000000000000e+0,
    4.4036660267178047359198331e-1,
    1.9392274474868577334259386e-1,
    8.5397100285765611280149662e-2,
    3.7606030930863935681246092e-2,
    1.6560440080994445548947445e-2,
    7.2926647372171090477661219e-3,
    3.2114459947525910185434889e-3,
    1.4142135623730950488016887e-3,
    6.2277242191459597955502746e-4,
    2.7424817567620731825332265e-4,
    1.2076973741146503832424826e-4,
    5.3182958969449886162502429e-5,
    2.3419998961409341542188076e-5,
    1.0313385377212458859810127e-5,
    4.5416704806078696531998012e-6
};

__device__ __forceinline__ void p0_prologue(Frame& F) {
    LAS float* scr = (LAS float*)(F.lds + F.wave * 16384);
    const int gw = blockIdx.x * 8 + F.wave, NGW = F.G * 8;
    bf16* Wint = (bf16*)(F.ws + WS_WIN); bf16* H = (bf16*)(F.ws + WS_H);
    convert_win(F, scr, gw, NGW);
    for (int m = gw; m < MPAD + (INWP - INW); m += NGW) {
        if (m < SEQ) rms_row_to_bf16(F.lane, F.in[0] + (size_t)m * DM, F.in[2], H + (size_t)m * DM);
        else if (m < LTOK) rms_row_to_bf16(F.lane, F.in[1] + (size_t)(m - SEQ) * DM, F.in[2], H + (size_t)m * DM);
        else { bf16* row = (m < MPAD) ? H + (size_t)m * DM : Wint + (size_t)(INW + (m - MPAD)) * DM; GAS v4u* o = (GAS v4u*)row + F.lane;
#pragma unroll
            for (int j = 0; j < 8; ++j) o[64 * j] = (v4u){0u, 0u, 0u, 0u}; }
    }
    const int gt = blockIdx.x * 512 + F.tid, NGT = F.G * 512;
    float* rope = (float*)(F.ws + WS_ROPE);
    for (int i = gt; i < LTOK * 16; i += NGT) { const int pos = i >> 4, k = i & 15;
        const double ang = (double)pos * ROPE_INV[k]; const double kq = __builtin_rint(ang * 0.15915494309189535);
        const double red = (ang - kq * 6.28318530717958623) - kq * 2.4492935982947064e-16; const float rf = (float)red;
        rope[2 * i] = cosf(rf); rope[2 * i + 1] = sinf(rf); }
    bf16* w2t = (bf16*)(F.ws + WS_LW2); bf16* a2t = (bf16*)(F.ws + WS_LA2); bf16* g2t = (bf16*)(F.ws + WS_LG2);
    for (int i = gt; i < 2 * 96 * RC; i += NGT) { const int c = i % RC, j = (i / RC) % 96, d = i / (RC * 96);
        w2t[((size_t)d * RC + c) * 96 + j] = (bf16)f2bf(F.in[8][i]); a2t[((size_t)d * RC + c) * 96 + j] = (bf16)f2bf(F.in[10][i]); }
    for (int i = gt; i < 256 * RC; i += NGT) { const int c = i % RC, j = i / RC; g2t[(size_t)c * 256 + j] = (bf16)f2bf(F.in[11][i]); }
}

__device__ __forceinline__ int crow(int r, int hi) { return (r & 3) + 8 * (r >> 2) + 4 * hi; }
__device__ __forceinline__ void attn_phase(Frame& F, const int gw, const int NGW) {
    const bf16* Q = (const bf16*)(F.ws + WS_Q); const bf16* K = (const bf16*)(F.ws + WS_K); const bf16* Vt = (const bf16*)(F.ws + WS_VT); bf16* OA = (bf16*)(F.ws + WS_OATT);
    const float* sink = F.in[17];
    const int hh = F.lane >> 5, r = F.lane & 31;
    constexpr float SC = 0.08838834764831845f * 1.4426950408889634f, L2E = 1.4426950408889634f;
    for (int item = gw; item < 4096; item += NGW) {
        const int sub = item & 3, hq = (item >> 2) & 15, qb = item >> 6, q0 = qb * 128 + sub * 32, hk = hq >> 2;
        bf16x8 bq[8];
        { const bf16* qp = Q + (size_t)(q0 + r) * ATTW + hq * 128 + 8 * hh;
#pragma unroll
          for (int s = 0; s < 8; ++s) bq[s] = *(const bf16x8*)(qp + 16 * s); }
        f32x16 O[4];
#pragma unroll
        for (int dt = 0; dt < 4; ++dt)
#pragma unroll
            for (int i = 0; i < 16; ++i) O[dt][i] = 0.f;
        float m = sink[hq] * L2E, l = (hh == 0) ? 1.f : 0.f;
        const int tlo = (q0 >= 128) ? 0 : 4 - q0 / 32, thi = (q0 + 128 + 32 <= SEQ) ? 8 : 4 + (SEQ - 32 - q0) / 32;
        int ti = tlo;
        bf16x8 ak[8];
        { const int key0 = q0 + 32 * (ti - 4); const bf16* kp = K + (size_t)(key0 + r) * KVW + hk * 128 + 8 * hh;
#pragma unroll
          for (int s = 0; s < 8; ++s) ak[s] = *(const bf16x8*)(kp + 16 * s); }
        for (;;) {
            const bool meta = (ti == 9);
            const int key0 = meta ? SEQ : q0 + 32 * (ti - 4);
            const int tn = (ti < thi) ? ti + 1 : 9; const int keyn = (tn == 9) ? SEQ : q0 + 32 * (tn - 4);
            v2u av[4][2][2]; bf16x8 akn[8];
#pragma unroll
            for (int dt = 0; dt < 4; ++dt) { const bf16* vp = Vt + (size_t)(hk * 128 + 32 * dt + r) * MPAD + key0 + 4 * hh;
#pragma unroll
                for (int s2 = 0; s2 < 2; ++s2) { av[dt][s2][0] = *(const v2u*)(vp + 16 * s2); av[dt][s2][1] = *(const v2u*)(vp + 16 * s2 + 8); } }
            { const bf16* kp = K + (size_t)(keyn + r) * KVW + hk * 128 + 8 * hh;
#pragma unroll
              for (int s = 0; s < 8; ++s) akn[s] = *(const bf16x8*)(kp + 16 * s); }
            f32x16 st;
#pragma unroll
            for (int i = 0; i < 16; ++i) st[i] = 0.f;
#pragma unroll
            for (int s = 0; s < 8; ++s) st = __builtin_amdgcn_mfma_f32_32x32x16_bf16(ak[s], bq[s], st, 0, 0, 0);
            float tmax = -__builtin_inff();
#pragma unroll
            for (int i = 0; i < 16; ++i) { const int kr = crow(i, hh); bool ok;
                if (meta) ok = kr < NMETA; else { const int dlt = (key0 + kr) - (q0 + r); ok = (dlt >= -128) && (dlt <= 128); }
                const float t = ok ? st[i] * SC : -__builtin_inff(); st[i] = t; tmax = fmaxf(tmax, t); }
            tmax = fmaxf(tmax, __shfl_xor(tmax, 32));
            const float mn = fmaxf(m, tmax), alpha = __builtin_amdgcn_exp2f(m - mn); m = mn;
            float ps = 0.f;
#pragma unroll
            for (int i = 0; i < 16; ++i) { const float p = __builtin_amdgcn_exp2f(st[i] - mn); st[i] = p; ps += p; }
            l = l * alpha + ps;
#pragma unroll
            for (int dt = 0; dt < 4; ++dt)
#pragma unroll
                for (int i = 0; i < 16; ++i) O[dt][i] *= alpha;
            bf16x8 pb[2];
#pragma unroll
            for (int s2 = 0; s2 < 2; ++s2) { v4u w; w.x = pg8::cvt_pk_bf16(st[8 * s2 + 0], st[8 * s2 + 1]); w.y = pg8::cvt_pk_bf16(st[8 * s2 + 2], st[8 * s2 + 3]);
                w.z = pg8::cvt_pk_bf16(st[8 * s2 + 4], st[8 * s2 + 5]); w.w = pg8::cvt_pk_bf16(st[8 * s2 + 6], st[8 * s2 + 7]); pb[s2] = __builtin_bit_cast(bf16x8, w); }
#pragma unroll
            for (int dt = 0; dt < 4; ++dt)
#pragma unroll
                for (int s2 = 0; s2 < 2; ++s2) { const v4u w = {av[dt][s2][0].x, av[dt][s2][0].y, av[dt][s2][1].x, av[dt][s2][1].y};
                    O[dt] = __builtin_amdgcn_mfma_f32_32x32x16_bf16(__builtin_bit_cast(bf16x8, w), pb[s2], O[dt], 0, 0, 0); }
            if (meta) break;
            ti = tn;
#pragma unroll
            for (int s = 0; s < 8; ++s) ak[s] = akn[s];
        }
        l += __shfl_xor(l, 32);
        const float inv = 1.0f / l;
        bf16* op = OA + (size_t)(q0 + r) * ATTW + hq * 128 + 4 * hh;
#pragma unroll
        for (int dt = 0; dt < 4; ++dt)
#pragma unroll
            for (int g4 = 0; g4 < 4; ++g4) { v2u w; w.x = pg8::cvt_pk_bf16(O[dt][4 * g4 + 0] * inv, O[dt][4 * g4 + 1] * inv); w.y = pg8::cvt_pk_bf16(O[dt][4 * g4 + 2] * inv, O[dt][4 * g4 + 3] * inv);
                *(v2u*)(op + 32 * dt + 8 * g4) = w; }
    }
}

__device__ __forceinline__ int tok2row(int t) { return t < NMETA ? SEQ + t : t - NMETA; }
struct Sh8 { v4u uc, up, un; };
__device__ __forceinline__ Sh8 shift8_ld(const bf16* U, int t, int col) {
    const int tc = t < LTOK ? t : LTOK - 1, tp = (t >= 1 && t - 1 < LTOK) ? t - 1 : 0, tn = t + 1 < LTOK ? t + 1 : LTOK - 1;
    Sh8 s; s.uc = *(const v4u*)(U + (size_t)tok2row(tc) * UPITCH + col); s.up = *(const v4u*)(U + (size_t)tok2row(tp) * UPITCH + col); s.un = *(const v4u*)(U + (size_t)tok2row(tn) * UPITCH + col); return s; }
__device__ __forceinline__ void shift8_fin(const Sh8& s, int t, int col, const float* mu_p, const float* mu_n, float (&x)[8]) {
    const v4u zz = {0u, 0u, 0u, 0u};
    const v4u uc = t < LTOK ? s.uc : zz, up = (t >= 1 && t - 1 < LTOK) ? s.up : zz, un = t + 1 < LTOK ? s.un : zz;
    const f32x4 mp0 = *(const f32x4*)(mu_p + col), mp1 = *(const f32x4*)(mu_p + col + 4), mn0 = *(const f32x4*)(mu_n + col), mn1 = *(const f32x4*)(mu_n + col + 4);
    const unsigned ucw[4] = {uc.x, uc.y, uc.z, uc.w}, upw[4] = {up.x, up.y, up.z, up.w}, unw[4] = {un.x, un.y, un.z, un.w};
    const float mpw[8] = {mp0[0], mp0[1], mp0[2], mp0[3], mp1[0], mp1[1], mp1[2], mp1[3]}, mnw[8] = {mn0[0], mn0[1], mn0[2], mn0[3], mn1[0], mn1[1], mn1[2], mn1[3]};
#pragma unroll
    for (int e = 0; e < 8; ++e) { const float c0 = (e & 1) ? bfhi(ucw[e >> 1]) : bflo(ucw[e >> 1]), p0 = (e & 1) ? bfhi(upw[e >> 1]) : bflo(upw[e >> 1]), n0 = (e & 1) ? bfhi(unw[e >> 1]) : bflo(unw[e >> 1]);
        x[e] = c0 + mpw[e] * (p0 - c0) + mnw[e] * (n0 - c0); }
}
__device__ __forceinline__ void flush_bf16(const LAS bf16* tile, bf16* ARR, int t0, int cbase, int lane) {
#pragma unroll
    for (int h = 0; h < 2; ++h) { const int row = (lane >> 2) + 16 * h, ch = lane & 3; const v4u v = *(const LAS v4u*)(tile + row * 32 + 8 * ch);
        if (t0 + row < LTOK) *(v4u*)(ARR + (size_t)(t0 + row) * RC + cbase + 8 * ch) = v; }
}
__device__ __forceinline__ void flush_f32(const LAS float* tile, float* ARR, int t0, int cbase, int lane) {
#pragma unroll
    for (int h = 0; h < 4; ++h) { const int row = (lane >> 3) + 8 * h, ch = lane & 7; const f32x4 v = *(const LAS f32x4*)(tile + row * 32 + 4 * ch);
        if (t0 + row < LTOK) *(f32x4*)(ARR + (size_t)(t0 + row) * RC + cbase + 4 * ch) = v; }
}
__device__ __forceinline__ void prep_phase(Frame& F) {
    constexpr int XS = 648;
    LAS bf16* Xs = (LAS bf16*)F.lds;
    LAS bf16* Kt = (LAS bf16*)(F.lds + 41472 + F.wave * 8192);
    LAS bf16* Ot = Kt + 2048;
    const bf16* U = (const bf16*)(F.ws + WS_U);
    const float* mu_p = F.in[5]; const float* mu_n = F.in[6];
    const bf16* w2t = (const bf16*)(F.ws + WS_LW2); const bf16* a2t = (const bf16*)(F.ws + WS_LA2); const bf16* g2t = (const bf16*)(F.ws + WS_LG2);
    float* W0 = (float*)(F.ws + WS_W0); float* W1 = (float*)(F.ws + WS_W1);
    bf16* KD0 = (bf16*)(F.ws + WS_KD0); bf16* KD1 = (bf16*)(F.ws + WS_KD1); bf16* B0 = (bf16*)(F.ws + WS_B0); bf16* B1 = (bf16*)(F.ws + WS_B1);
    bf16* KK = (bf16*)(F.ws + WS_KK); bf16* RR = (bf16*)(F.ws + WS_RR); bf16* VV = (bf16*)(F.ws + WS_VV); bf16* GG = (bf16*)(F.ws + WS_GG);
    const int hh = F.lane >> 5, r = F.lane & 31;
    for (int unit = blockIdx.x; unit < 257 * 4; unit += F.G) {
        const int tt = unit >> 2, t0 = tt * 32, hd = (unit & 3) * 8 + F.wave;
        __syncthreads();
        FPB0(15);
        { Sh8 sx[5];
#pragma unroll
          for (int it = 0; it < 5; ++it) { const int ci = F.tid + 512 * it; sx[it] = shift8_ld(U, t0 + ci / 80, 3 * RC + 8 * (ci % 80)); }
#pragma unroll
          for (int it = 0; it < 5; ++it) { const int ci = F.tid + 512 * it, tl = ci / 80, ch = ci % 80;
            float x[8]; shift8_fin(sx[it], t0 + tl, 3 * RC + 8 * ch, mu_p, mu_n, x);
#pragma unroll
            for (int e = 0; e < 8; ++e) { float v = x[e];
                if (ch < 24) { const float ex = __expf(2.0f * v); v = 1.0f - 2.0f / (ex + 1.0f); }
                else if (ch >= 48) v = sigmoidf_(v);
                x[e] = v; }
            v4u o; o.x = pk2(x[0], x[1]); o.y = pk2(x[2], x[3]); o.z = pk2(x[4], x[5]); o.w = pk2(x[6], x[7]);
            *(LAS v4u*)(Xs + tl * XS + 8 * ch) = o; } }
        { const int c8 = hd * 64 + 8 * (F.lane & 7);
#pragma unroll
          for (int st = 0; st < 3; ++st) { const int col = (st == 0 ? RC : st == 1 ? 0 : 2 * RC) + c8; Sh8 sq[4];
#pragma unroll
            for (int q = 0; q < 4; ++q) sq[q] = shift8_ld(U, t0 + (F.lane >> 3) + 8 * q, col);
#pragma unroll
            for (int q = 0; q < 4; ++q) { const int tl = (F.lane >> 3) + 8 * q, tq = t0 + tl; float x[8]; shift8_fin(sq[q], tq, col, mu_p, mu_n, x);
                v4u o; o.x = pk2(x[0], x[1]); o.y = pk2(x[2], x[3]); o.z = pk2(x[4], x[5]); o.w = pk2(x[6], x[7]);
                if (st == 0) *(LAS v4u*)(Kt + tl * 64 + 8 * (F.lane & 7)) = o;
                else if (tq < LTOK) *(v4u*)((st == 1 ? RR : VV) + (size_t)tq * RC + c8) = o; } } }
        __syncthreads();
        FPB1(15); FPB0(16);
        float kp[2][16], ss[16];
#pragma unroll
        for (int i = 0; i < 16; ++i) ss[i] = 0.f;
#pragma unroll
        for (int ct = 0; ct < 2; ++ct) { const int c = hd * 64 + 32 * ct + r; const float kkw = F.in[12][c];
#pragma unroll
            for (int i = 0; i < 16; ++i) { kp[ct][i] = bf2f(Kt[crow(i, hh) * 64 + 32 * ct + r]); const float kr = kp[ct][i] * kkw; ss[i] += kr * kr; } }
#pragma unroll
        for (int i = 0; i < 16; ++i) {
#pragma unroll
            for (int o = 1; o < 32; o <<= 1) ss[i] += __shfl_xor(ss[i], o);
            ss[i] = 1.0f / fmaxf(sqrtf(ss[i]), 1e-12f); }
#define LDF(dst, ptr, n) do { _Pragma("unroll") for (int s_ = 0; s_ < (n); ++s_) dst[s_] = *(const bf16x8*)((ptr) + 16 * s_); } while (0)
#define MMF(frag, xoff, n) do { _Pragma("unroll") for (int i_ = 0; i_ < 16; ++i_) acc[i_] = 0.f; const LAS bf16* ap_ = Xs + r * XS + (xoff) + 8 * hh; \
            _Pragma("unroll") for (int s_ = 0; s_ < (n); ++s_) acc = __builtin_amdgcn_mfma_f32_32x32x16_bf16(*(const LAS bf16x8*)(ap_ + 16 * s_), frag[s_], acc, 0, 0, 0); } while (0)
#pragma unroll
        for (int ct = 0; ct < 2; ++ct) {
            const int c = hd * 64 + 32 * ct + r, cb = hd * 64 + 32 * ct;
            const float kkw = F.in[12][c], kaw = F.in[13][c];
            const bf16* pa0 = a2t + (size_t)c * 96 + 8 * hh; const bf16* pa1 = a2t + ((size_t)RC + c) * 96 + 8 * hh;
            const bf16* pw0 = w2t + (size_t)c * 96 + 8 * hh; const bf16* pw1 = w2t + ((size_t)RC + c) * 96 + 8 * hh; const bf16* pg = g2t + (size_t)c * 256 + 8 * hh;
            bf16x8 fa[6], fg[16]; f32x16 acc; float kk[16];
            LDF(fa, pa0, 6);
#pragma unroll
            for (int i = 0; i < 16; ++i) { kk[i] = kp[ct][i] * kkw * ss[i]; Ot[crow(i, hh) * 32 + r] = (bf16)f2bf(kk[i]); }
            flush_bf16(Ot, KK, t0, cb, F.lane);
#pragma unroll
            for (int d = 0; d < 2; ++d) {
                if (d == 0) { MMF(fa, 192, 6); LDF(fa, pa1, 6); } else { MMF(fa, 288, 6); LDF(fa, pw0, 6); }
                const float a0 = F.in[9][d * RC + c];
#pragma unroll
                for (int i = 0; i < 16; ++i) { acc[i] = sigmoidf_(a0 + acc[i]); Ot[crow(i, hh) * 32 + r] = (bf16)f2bf(kp[ct][i] * (1.0f + (acc[i] - 1.0f) * kaw)); }
                flush_bf16(Ot, d ? KD1 : KD0, t0, cb, F.lane);
#pragma unroll
                for (int i = 0; i < 16; ++i) Ot[crow(i, hh) * 32 + r] = (bf16)f2bf(kk[i] * acc[i]);
                flush_bf16(Ot, d ? B1 : B0, t0, cb, F.lane);
            }
#pragma unroll
            for (int d = 0; d < 2; ++d) {
                if (d == 0) { MMF(fa, 0, 6); LDF(fa, pw1, 6); } else { MMF(fa, 96, 6); LDF(fg, pg, 16); }
                const float w0 = F.in[7][d * RC + c]; LAS float* Of = (LAS float*)Ot;
#pragma unroll
                for (int i = 0; i < 16; ++i) Of[crow(i, hh) * 32 + r] = __expf(-0.6065306597126334f * sigmoidf_(w0 + acc[i]));
                flush_f32(Of, d ? W1 : W0, t0, cb, F.lane);
            }
            MMF(fg, 384, 16);
#pragma unroll
            for (int i = 0; i < 16; ++i) Ot[crow(i, hh) * 32 + r] = (bf16)f2bf(acc[i]);
            flush_bf16(Ot, GG, t0, cb, F.lane);
        }
#undef LDF
#undef MMF
        FPB1(16);
    }
    __syncthreads();
}

__device__ __forceinline__ int blk_tok(int d, int blk, int u) { return d ? (LTOK - 1 - 16 * blk - u) : (16 * blk + u); }
__device__ __forceinline__ size_t bo_item(int hd, int d, int blk) { return (size_t)(hd * NBT + (d ? NB0 : 0) + blk) * BO_ITEM; }
__device__ __forceinline__ v4u pack8(const float (&x)[8]) { v4u o; o.x = pk2(x[0], x[1]); o.y = pk2(x[2], x[3]); o.z = pk2(x[4], x[5]); o.w = pk2(x[6], x[7]); return o; }
__device__ __forceinline__ void blockprep_phase(Frame& F) {
    LAS unsigned char* wl = F.lds + F.wave * 16384;
    constexpr int LP = 72;
    LAS bf16* LT = (LAS bf16*)wl;
    LAS float* GM = (LAS float*)(wl + 9216);
    const float* W0 = (const float*)(F.ws + WS_W0); const float* W1 = (const float*)(F.ws + WS_W1);
    const bf16* KD0 = (const bf16*)(F.ws + WS_KD0); const bf16* KD1 = (const bf16*)(F.ws + WS_KD1); const bf16* B0 = (const bf16*)(F.ws + WS_B0); const bf16* B1 = (const bf16*)(F.ws + WS_B1);
    const bf16* KK = (const bf16*)(F.ws + WS_KK); const bf16* RR = (const bf16*)(F.ws + WS_RR);
    float* BON = (float*)(F.ws + WS_BONUS); unsigned char* BO = F.ws + WS_BO;
    int lz; asm volatile("v_mov_b32 %0, 0" : "=v"(lz));
    const int gw = blockIdx.x * 8 + F.wave, NGW = F.G * 8, j = F.lane + lz, hh = j >> 5, r31 = j & 31, c16 = j & 15;
    struct Raw { float w[16]; unsigned short kd[16], b[16], kk[16], r[16]; };
#define BP_DECODE(it_, hd_, d_, blk_) const int hd_ = (it_) / NBT, rem_##hd_ = (it_) % NBT, d_ = rem_##hd_ >= NB0 ? 1 : 0, blk_ = d_ ? rem_##hd_ - NB0 : rem_##hd_
#define BP_LOAD(R_, it_) do { BP_DECODE(it_, hdL, dL, blkL); const float* Wd_ = dL ? W1 : W0; const bf16* KDd_ = dL ? KD1 : KD0; const bf16* Bd_ = dL ? B1 : B0; \
        _Pragma("unroll") for (int u_ = 0; u_ < 16; ++u_) { const size_t o_ = (size_t)blk_tok(dL, blkL, u_) * RC + hdL * 64 + j; \
            R_.w[u_] = Wd_[o_]; R_.kd[u_] = KDd_[o_]; R_.b[u_] = Bd_[o_]; R_.kk[u_] = KK[o_]; R_.r[u_] = RR[o_]; } } while (0)
    Raw cur;
    if (gw < RH * NBT) BP_LOAD(cur, gw);
    for (int it = gw; it < RH * NBT; it += NGW) {
        BP_DECODE(it, hd, d, blk); const int c = hd * 64 + j;
        Raw nxt = cur;
        if (it + NGW < RH * NBT) BP_LOAD(nxt, it + NGW);
        float kt[16], rt[16], kdh[16], bh[16]; float G15;
        { float G[16];
          { float g = 1.f;
#pragma unroll
            for (int u = 0; u < 16; ++u) { g *= cur.w[u]; G[u] = g; } }
          const float rkw = F.in[14][c];
          float bsum = 0.f;
#pragma unroll
          for (int u = 0; u < 16; ++u) { kdh[u] = bf2f(cur.kd[u]); rt[u] = bf2f(cur.r[u]); const float s = wave_sum(rt[u] * kdh[u] * rkw); bsum = (F.lane == u) ? s : bsum;
              kdh[u] = kdh[u] / G[u]; rt[u] = rt[u] * G[u]; LT[(0 * 16 + u) * LP + j] = (bf16)f2bf(kdh[u]); LT[(3 * 16 + u) * LP + j] = (bf16)f2bf(rt[u]); }
          if (F.lane < 16) atomicAdd(BON + (size_t)blk_tok(d, blk, F.lane) * RH + hd, bsum);
#pragma unroll
          for (int u = 0; u < 16; ++u) { kt[u] = bf2f(cur.kk[u]) * (u ? G[u - 1] : 1.f); bh[u] = bf2f(cur.b[u]) / G[u]; LT[(2 * 16 + u) * LP + j] = (bf16)f2bf(kt[u]); LT[(1 * 16 + u) * LP + j] = (bf16)f2bf(bh[u]); }
          G15 = G[15]; }
        asm volatile("" ::: "memory");
        f32x16 gacc;
#pragma unroll
        for (int i = 0; i < 16; ++i) gacc[i] = 0.f;
        { const LAS bf16* ap = LT + ((r31 < 16 ? 0 : 1) * 16 + (r31 & 15)) * LP + 8 * hh; const LAS bf16* bp = LT + ((r31 < 16 ? 2 : 3) * 16 + (r31 & 15)) * LP + 8 * hh;
#pragma unroll
          for (int s = 0; s < 4; ++s) gacc = __builtin_amdgcn_mfma_f32_32x32x16_bf16(*(const LAS bf16x8*)(ap + 16 * s), *(const LAS bf16x8*)(bp + 16 * s), gacc, 0, 0, 0); }
        float ga[16];
#pragma unroll
        for (int i = 0; i < 16; ++i) ga[i] = gacc[i];
#pragma unroll
        for (int i = 0; i < 16; ++i) { const int row = crow(i, hh), m = row & 15, u = r31 & 15; const bool strict = (r31 < 16);
            GM[row * 32 + r31] = (strict ? (m < u) : (m <= u)) ? ga[i] : 0.f; }
#define RL(x, ln) __builtin_bit_cast(float, __builtin_amdgcn_readlane(__builtin_bit_cast(int, (x)), (ln)))
#define GREG(m) (4 * ((m) >> 3) + ((m) & 3))
#define GLN(m) (32 * (((m) >> 2) & 1))
#define B_(m, u)  RL(ga[8 + GREG(m)], (u) + GLN(m))
        float Tr[16];
#pragma unroll
        for (int m = 15; m >= 0; --m) { float s = (c16 == m) ? 1.f : 0.f;
#pragma unroll
            for (int u = m + 1; u < 16; ++u) s -= B_(m, u) * Tr[u];
            Tr[m] = s; }
#undef RL
#undef GREG
#undef GLN
#undef B_
        unsigned char* base = BO + bo_item(hd, d, blk);
        { const int a = j >> 5, jp = j & 31;
#pragma unroll
          for (int h2 = 0; h2 < 2; ++h2) { float x0[8], x1[8];
#pragma unroll
              for (int e = 0; e < 8; ++e) { x0[e] = -bh[8 * (e >> 2) + 4 * h2 + (e & 3)] * G15; x1[e] = kdh[8 * h2 + e] * G15; }
              *(v4u*)(base + BO_FB + ((a * 2 + 0) * 64 + jp + 32 * h2) * 16) = pack8(x0); *(v4u*)(base + BO_FB + ((a * 2 + 1) * 64 + jp + 32 * h2) * 16) = pack8(x1); } }
        *(float*)(base + BO_FG + 4 * j) = G15;
        { float x[8];
#pragma unroll
          for (int e = 0; e < 8; ++e) x[e] = GM[(8 * hh + e) * 32 + r31];
          *(v4u*)(base + BO_FAA + j * 16) = pack8(x); }
        if (r31 < 16) { float x[8];
#pragma unroll
            for (int e = 0; e < 8; ++e) { const float t0 = Tr[8 * (e >> 2) + (e & 3)], t1 = Tr[8 * (e >> 2) + 4 + (e & 3)]; x[e] = hh ? t1 : t0; }
            *(v4u*)(base + BO_FT + (hh * 16 + r31) * 16) = pack8(x); }
        else { float x[8];
#pragma unroll
            for (int e = 0; e < 8; ++e) x[e] = -GM[(16 + 8 * (e >> 2) + 4 * hh + (e & 3)) * 32 + r31];
            *(v4u*)(base + BO_FBP + (hh * 16 + (r31 - 16)) * 16) = pack8(x); }
#pragma unroll
        for (int u = 0; u < 16; ++u) { LT[u * LP + j] = (bf16)f2bf(kt[u]); LT[(16 + u) * LP + j] = (bf16)f2bf(rt[u]); }
#pragma unroll
        for (int ks = 0; ks < 4; ++ks) { const int j0 = 32 * (ks >> 1) + 16 * (ks & 1) + 4 * hh; const v2u lo = *(const LAS v2u*)(LT + r31 * LP + j0), hi = *(const LAS v2u*)(LT + r31 * LP + j0 + 8);
            *(v4u*)(base + BO_FA + (ks * 64 + j) * 16) = (v4u){lo.x, lo.y, hi.x, hi.y}; }
        cur = nxt;
        asm volatile("" ::: "memory");
    }
#undef BP_DECODE
#undef BP_LOAD
}

constexpr int N_SCAN_WAVES = 128;
constexpr int SR_SLOTS = 8, SR_STRIDE = 12288, SR_FV = 11264, SR_FLAGS = SR_SLOTS * SR_STRIDE, SR_WSCR = SR_FLAGS + 512, SR_NL = 4;
static_assert(SR_WSCR + (7 - SR_NL) * 8448 <= RING_BYTES, "scan phase LDS map");
struct LdSet { v4u p[11]; unsigned short v[8]; };
__device__ __forceinline__ void sr_issue(LdSet& s, const unsigned char* item, const bf16* VV, int hd, int d, int blk, int ih, int lane) {
#pragma unroll
    for (int k = 0; k < 11; ++k) { const int pc = k * 64 + lane; s.p[k] = *(const v4u*)(item + (pc < BO_ITEM / 16 ? pc : BO_ITEM / 16 - 1) * 16); }
    const int hh = lane >> 5, il = lane & 31;
#pragma unroll
    for (int e = 0; e < 8; ++e) s.v[e] = VV[(size_t)blk_tok(d, blk, 8 * hh + e) * RC + hd * 64 + 32 * ih + il];
}
__device__ __forceinline__ void sr_write(const LdSet& s, LAS unsigned char* slot, int lane) {
#pragma unroll
    for (int k = 0; k < 11; ++k) *(LAS v4u*)(slot + (k * 64 + lane) * 16) = s.p[k];
    const v4u vw = {(unsigned)s.v[0] | ((unsigned)s.v[1] << 16), (unsigned)s.v[2] | ((unsigned)s.v[3] << 16), (unsigned)s.v[4] | ((unsigned)s.v[5] << 16), (unsigned)s.v[6] | ((unsigned)s.v[7] << 16)};
    *(LAS v4u*)(slot + SR_FV + lane * 16) = vw;
}
__device__ __forceinline__ bf16x8 pack_half(const f32x16& x, int s) {
    const v4u w = {pk2(x[8 * s + 0], x[8 * s + 1]), pk2(x[8 * s + 2], x[8 * s + 3]), pk2(x[8 * s + 4], x[8 * s + 5]), pk2(x[8 * s + 6], x[8 * s + 7])}; return __builtin_bit_cast(bf16x8, w); }
__device__ __forceinline__ void scan_phase(Frame& F) {
    const bf16* VV = (const bf16*)(F.ws + WS_VV); bf16* Y = (bf16*)(F.ws + WS_Y); const unsigned char* BO = F.ws + WS_BO;
    const bool sblock = (int)blockIdx.x < N_SCAN_WAVES;
    volatile LAS unsigned* FL = (volatile LAS unsigned*)(F.lds + SR_FLAGS);
    constexpr unsigned SPIN_CAP = 1u << 22;
    __syncthreads();
    if (F.tid < 128) FL[F.tid] = 0u;
    __syncthreads();
    const int pair = (int)blockIdx.x >> 1, ih = (int)blockIdx.x & 1, hd = pair >> 1, d = pair & 1, nblk = d ? NB1 : NB0, hh = F.lane >> 5, il = F.lane & 31;
    if (sblock && F.wave == 0) {
        __builtin_amdgcn_s_setprio(3);
        f32x16 St[2];
#pragma unroll
        for (int a = 0; a < 2; ++a)
#pragma unroll
            for (int i = 0; i < 16; ++i) St[a][i] = 0.f;
        FPB0(17);
        const unsigned long long scan_t0 = ((PROBE_PHASE >> 21) & 1) ? __builtin_amdgcn_s_memrealtime() : 0ull;
        for (int blk = 0; blk < nblk; ++blk) {
            const int sl = blk % SR_SLOTS; const LAS unsigned char* slot = F.lds + sl * SR_STRIDE;
            { unsigned sp = 0; while (FL[sl] != (unsigned)(blk + 1)) { __builtin_amdgcn_s_sleep(1); if (++sp > SPIN_CAP) break; } }
            asm volatile("" ::: "memory");
            bf16x8 fa[4], fb[2][2]; f32x4 gm[2][4];
#pragma unroll
            for (int ks = 0; ks < 4; ++ks) fa[ks] = *(const LAS bf16x8*)(slot + BO_FA + (ks * 64 + F.lane) * 16);
            const bf16x8 faa = *(const LAS bf16x8*)(slot + BO_FAA + F.lane * 16), vf = *(const LAS bf16x8*)(slot + SR_FV + F.lane * 16);
            bf16x8 ft = *(const LAS bf16x8*)(slot + BO_FT + (hh * 16 + (il & 15)) * 16), fbp = *(const LAS bf16x8*)(slot + BO_FBP + (hh * 16 + (il & 15)) * 16);
            { const bf16x8 zz = {0, 0, 0, 0, 0, 0, 0, 0}; ft = (il < 16) ? ft : zz; fbp = (il >= 16) ? fbp : zz; }
#pragma unroll
            for (int a = 0; a < 2; ++a)
#pragma unroll
                for (int k = 0; k < 2; ++k) fb[a][k] = *(const LAS bf16x8*)(slot + BO_FB + ((a * 2 + k) * 64 + F.lane) * 16);
#pragma unroll
            for (int a = 0; a < 2; ++a)
#pragma unroll
                for (int q = 0; q < 4; ++q) gm[a][q] = *(const LAS f32x4*)(slot + BO_FG + (32 * a + 8 * q + 4 * hh) * 4);
            asm volatile("s_waitcnt lgkmcnt(0)" ::: "memory");
            if (F.lane == 0) FL[16] = (unsigned)(blk + 1);
            f32x16 acc, accp;
#pragma unroll
            for (int i = 0; i < 16; ++i) { acc[i] = 0.f; accp[i] = 0.f; }
            acc = __builtin_amdgcn_mfma_f32_32x32x16_bf16(faa, vf, acc, 0, 0, 0);
#pragma unroll
            for (int a = 0; a < 2; ++a)
#pragma unroll
                for (int s = 0; s < 2; ++s) acc = __builtin_amdgcn_mfma_f32_32x32x16_bf16(fa[2 * a + s], pack_half(St[a], s), acc, 0, 0, 0);
            accp = __builtin_amdgcn_mfma_f32_32x32x16_bf16(ft, pack_half(acc, 0), accp, 0, 0, 0);
            const bf16x8 pb = pack_half(accp, 0);
            acc = __builtin_amdgcn_mfma_f32_32x32x16_bf16(fbp, pb, acc, 0, 0, 0);
#pragma unroll
            for (int e = 0; e < 8; ++e) { const int u = 8 * (e >> 2) + 4 * hh + (e & 3);
                Y[((size_t)d * LTOK + blk_tok(d, blk, u)) * RC + hd * 64 + 32 * ih + il] = (bf16)f2bf(acc[8 + e]); }
#pragma unroll
            for (int a = 0; a < 2; ++a) {
#pragma unroll
                for (int i = 0; i < 16; ++i) St[a][i] *= gm[a][i >> 2][i & 3];
                St[a] = __builtin_amdgcn_mfma_f32_32x32x16_bf16(fb[a][0], pb, St[a], 0, 0, 0);
                St[a] = __builtin_amdgcn_mfma_f32_32x32x16_bf16(fb[a][1], vf, St[a], 0, 0, 0);
            }
        }
        FPB1(17);
        if ((PROBE_PHASE >> 21) & 1) { if (F.lane == 0) atomicMax((unsigned*)(F.ctl + 2048), (unsigned)(__builtin_amdgcn_s_memrealtime() - scan_t0)); }
        __builtin_amdgcn_s_setprio(0);
    } else if (sblock && F.wave <= SR_NL) {
        __builtin_amdgcn_s_setprio(2);
        const int lw = F.wave - 1;
        LdSet st[2];
#define SR_PUT(set, b_) do { const int sl_ = (b_) % SR_SLOTS; if ((b_) >= SR_SLOTS) { unsigned sp_ = 0; while (FL[16] < (unsigned)((b_) - SR_SLOTS + 1)) { __builtin_amdgcn_s_sleep(1); if (++sp_ > SPIN_CAP) break; } } \
            asm volatile("" ::: "memory"); sr_write(set, F.lds + sl_ * SR_STRIDE, F.lane); asm volatile("s_waitcnt lgkmcnt(0)" ::: "memory"); if (F.lane == 0) FL[sl_] = (unsigned)((b_) + 1); } while (0)
#pragma unroll
        for (int k = 0; k < 2; ++k) { const int bb = lw + SR_NL * k; if (bb < nblk) sr_issue(st[k], BO + bo_item(hd, d, bb), VV, hd, d, bb, ih, F.lane); }
        for (int b0 = lw; b0 < nblk; b0 += 2 * SR_NL) {
#pragma unroll
            for (int k = 0; k < 2; ++k) { const int bb = b0 + SR_NL * k; if (bb < nblk) { SR_PUT(st[k], bb); const int nb = bb + 2 * SR_NL; if (nb < nblk) sr_issue(st[k], BO + bo_item(hd, d, nb), VV, hd, d, nb, ih, F.lane); } }
        }
#undef SR_PUT
        __builtin_amdgcn_s_setprio(0);
    } else {
        const int b = (int)blockIdx.x, nsb = F.G < N_SCAN_WAVES ? F.G : N_SCAN_WAVES, wps = 7 - SR_NL;
        const int widx = b < N_SCAN_WAVES ? b * wps + (F.wave - 1 - SR_NL) : nsb * wps + (b - N_SCAN_WAVES) * 8 + F.wave;
        const int NWK = nsb * wps + (F.G - nsb) * 8;
        unsigned long long rp0 = 0, rp1 = 0, rp2 = 0;
        if (PROBE_PHASE & ((3 << 18) | (1 << 22))) rp0 = __builtin_amdgcn_s_memrealtime();
        LAS float* scr = (LAS float*)(F.lds + (sblock ? SR_WSCR + (F.wave - 1 - SR_NL) * 8448 : F.wave * 8448));
        attn_phase(F, widx, NWK);
        if (PROBE_PHASE & (3 << 18)) rp1 = __builtin_amdgcn_s_memrealtime();
        convert_p4(F, scr, widx, NWK, sblock ? -1 : (b - N_SCAN_WAVES) * 8 + F.wave, (F.G - nsb) * 8);
        if (PROBE_PHASE & (3 << 18)) { rp2 = __builtin_amdgcn_s_memrealtime(); if ((int)blockIdx.x == F.G - 1 && F.tid == 0) { unsigned long long v = 0; if ((PROBE_PHASE >> 18) & 1) v += rp1 - rp0; if ((PROBE_PHASE >> 19) & 1) v += rp2 - rp1;
            __hip_atomic_store((unsigned*)(F.ctl + 2048), (unsigned)v, __ATOMIC_RELAXED, __HIP_MEMORY_SCOPE_AGENT); } }
        if ((PROBE_PHASE >> 22) & 1) { if (blockIdx.x == 0 && F.wave == 5 && F.lane == 0) __hip_atomic_store((unsigned*)(F.ctl + 2048), (unsigned)(__builtin_amdgcn_s_memrealtime() - rp0), __ATOMIC_RELAXED, __HIP_MEMORY_SCOPE_AGENT); }
    }
}

__device__ __forceinline__ float row16_sum(float x) {
    x += __builtin_bit_cast(float, __builtin_amdgcn_update_dpp(0, __builtin_bit_cast(int, x), 0xB1, 0xf, 0xf, true));
    x += __builtin_bit_cast(float, __builtin_amdgcn_update_dpp(0, __builtin_bit_cast(int, x), 0x4E, 0xf, 0xf, true));
    x += __builtin_bit_cast(float, __builtin_amdgcn_update_dpp(0, __builtin_bit_cast(int, x), 0x141, 0xf, 0xf, true));
    x += __builtin_bit_cast(float, __builtin_amdgcn_update_dpp(0, __builtin_bit_cast(int, x), 0x140, 0xf, 0xf, true));
    return x;
}
__device__ __forceinline__ void combine_phase(Frame& F) {
    const bf16* Y0 = (const bf16*)(F.ws + WS_Y); const bf16* Y1 = Y0 + (size_t)LTOK * RC; const float* BON = (const float*)(F.ws + WS_BONUS);
    const bf16* VV = (const bf16*)(F.ws + WS_VV); const bf16* GG = (const bf16*)(F.ws + WS_GG);
    bf16* OR = (bf16*)(F.ws + WS_ORWKV);
    const float* lnw = F.in[15]; const float* lnb = F.in[16];
    const int gw = blockIdx.x * 8 + F.wave, NGW = F.G * 8;
    for (int row = gw; row < SEQ; row += NGW) { const int t = row + NMETA;
#pragma unroll
        for (int st = 0; st < 8; ++st) { const int c = st * 256 + 4 * F.lane, hd = c >> 6; const size_t o = (size_t)t * RC + c;
            const v2u a0 = *(const v2u*)(Y0 + o), a1 = *(const v2u*)(Y1 + o), vv = *(const v2u*)(VV + o), gg = *(const v2u*)(GG + o);
            const f32x4 w = *(const f32x4*)(lnw + c), bb = *(const f32x4*)(lnb + c); const float bon = BON[(size_t)t * RH + hd];
            float y[4] = {bflo(a0.x) + bflo(a1.x), bfhi(a0.x) + bfhi(a1.x), bflo(a0.y) + bflo(a1.y), bfhi(a0.y) + bfhi(a1.y)};
            const float mean = row16_sum((y[0] + y[1]) + (y[2] + y[3])) * (1.0f / 64.0f);
#pragma unroll
            for (int e = 0; e < 4; ++e) y[e] -= mean;
            const float var = row16_sum((y[0] * y[0] + y[1] * y[1]) + (y[2] * y[2] + y[3] * y[3])) * (1.0f / 64.0f);
            const float rs = __builtin_amdgcn_rsqf(var + GN_EPS);
            const float v4[4] = {bflo(vv.x), bfhi(vv.x), bflo(vv.y), bfhi(vv.y)}, g4[4] = {bflo(gg.x), bfhi(gg.x), bflo(gg.y), bfhi(gg.y)};
            float ov[4];
#pragma unroll
            for (int e = 0; e < 4; ++e) ov[e] = (y[e] * rs * w[e] + bb[e] + bon * v4[e]) * g4[e];
            v2u ow; ow.x = pk2(ov[0], ov[1]); ow.y = pk2(ov[2], ov[3]);
            *(v2u*)(OR + (size_t)row * RC + c) = ow; } }
}
__device__ __forceinline__ void final_phase(Frame& F) {
    const float* SS3 = (const float*)(F.ctl + CW_SS3); const float* w = F.in[25];
    const int gw = blockIdx.x * 8 + F.wave, NGW = F.G * 8;
    for (int row = gw; row < SEQ; row += NGW) { const float rstd = 1.0f / sqrtf(SS3[row] * (1.0f / DM) + RMS_EPS);
        GAS f32x4* p = (GAS f32x4*)(F.out + (size_t)row * DM) + F.lane; const GAS f32x4* wp = (const GAS f32x4*)w + F.lane;
#pragma unroll
        for (int j = 0; j < 16; ++j) { const f32x4 v = p[64 * j], ww = wp[64 * j]; p[64 * j] = v * rstd * ww; } }
}
constexpr int N_PHASES = 11;
struct Args { const float* in[26]; float* out; unsigned char* ws; int ph_lo, ph_hi; };
__global__ void __launch_bounds__(512, 2) fwd_kernel(Args args) {
    extern __shared__ __attribute__((aligned(16))) unsigned char lds[];
    Frame F;
    F.lds = (LAS unsigned char*)lds;
    F.MISC = (volatile LAS unsigned*)(F.lds + MISC_OFF);
    F.tid = threadIdx.x; F.lane = F.tid & 63; F.wave = __builtin_amdgcn_readfirstlane(F.tid >> 6); F.G = gridDim.x;
    F.ws = args.ws; F.ctl = (gu32*)(args.ws + WS_CTL); F.out = args.out; F.pb0 = 0; F.pacc = 0; F.pacc2 = 0;
#pragma unroll
    for (int i = 0; i < 26; ++i) F.in[i] = args.in[i];
    for (int u = F.tid; u < (LDS_BYTES - LDSCTL_OFF) / 4; u += 512) ((LAS unsigned*)(F.lds + LDSCTL_OFF))[u] = 0u;
    __syncthreads();
    XcdBarrier bar; bar.bar = (unsigned*)(F.ctl + CW_BAR); bar.x = 0; bar.st = nullptr;
    if (!MK_SPLIT) bar = xcd_barrier_post((unsigned*)(F.ctl + CW_BAR), F.MISC + 8);
    const int lo = args.ph_lo, hi = args.ph_hi;
#define IN(k) (lo <= (k) && (k) < hi)
#define SEAM(k) do { if (IN(k) && IN((k) + 1)) xcd_barrier(bar); } while (0)
    bf16* Rm = (bf16*)(F.ws + WS_H);
    float* SS2 = (float*)(F.ctl + CW_SS2); float* SS3 = (float*)(F.ctl + CW_SS3);

    unsigned long long pt0 = 0, pt1 = 0;
#define PB0(k) do { if ((PROBE_PHASE >> (k)) & 1) pt0 = __builtin_amdgcn_s_memrealtime(); } while (0)
#define PB1(k) do { if ((PROBE_PHASE >> (k)) & 1) pt1 += __builtin_amdgcn_s_memrealtime() - pt0; } while (0)
    PB0(0); if (IN(0)) { p0_prologue(F); } SEAM(0); PB1(0);
    PB0(1); if (IN(1)) {
        pg8::Gemm g{Rm, Rm, MPAD + INWP, MPAD + INWP, DM}; pg8::InOrder S; S.init(F.G, (int)blockIdx.x);
        pg8::EpiIn E{(bf16*)(F.ws + WS_G), (bf16*)(F.ws + WS_Q), (bf16*)(F.ws + WS_K), (bf16*)(F.ws + WS_VT), (bf16*)(F.ws + WS_U), F.in[4], (const float*)(F.ws + WS_ROPE)};
        pg8::gemm_phase<pg8::EpiIn, pg8::InOrder, true, true>(F.lds, g, S, E, F.pacc2);
    } SEAM(1); PB1(1);
    PB0(2); if (IN(2)) { prep_phase(F); } SEAM(2); PB1(2);
    PB0(3); if (IN(3)) { blockprep_phase(F); } SEAM(3); PB1(3);
    PB0(4); if (IN(4)) { scan_phase(F); } SEAM(4); PB1(4);
    PB0(5); if (IN(5)) { combine_phase(F); } SEAM(5); PB1(5);
    PB0(6); if (IN(6)) {
        { pg8::Gemm g{(const bf16*)(F.ws + WS_OATT), (const bf16*)(F.ws + WS_WPA), SEQ, DM, ATTW}; pg8::StaticOrder S; S.init(SEQ, DM, F.G, (int)blockIdx.x);
          pg8::EpiProjA E{(bf16*)(F.ws + WS_P1), (const bf16*)(F.ws + WS_G)};
          pg8::gemm_phase<pg8::EpiProjA, pg8::StaticOrder, true, true>(F.lds, g, S, E, F.pacc2); }
        __syncthreads();
        { pg8::Gemm g{(const bf16*)(F.ws + WS_ORWKV), (const bf16*)(F.ws + WS_WPR), SEQ, DM, RC}; pg8::StaticOrder S; S.init(SEQ, DM, F.G, (int)blockIdx.x);
          pg8::EpiProjB E{(const bf16*)(F.ws + WS_P1), (const bf16*)(F.ws + WS_G), (bf16*)(F.ws + WS_MX)};
          pg8::gemm_phase<pg8::EpiProjB, pg8::StaticOrder, true, true>(F.lds, g, S, E, F.pacc2); }
    } SEAM(6); PB1(6);
    PB0(7); if (IN(7)) {
        pg8::Gemm g{(const bf16*)(F.ws + WS_MX), (const bf16*)(F.ws + WS_WOUT), SEQ, DM, DM}; pg8::StaticOrder S; S.init(SEQ, DM, F.G, (int)blockIdx.x);
        pg8::EpiResid<false> E{F.in[0], nullptr, nullptr, (bf16*)(F.ws + WS_A2), SS2};
        pg8::gemm_phase<pg8::EpiResid<false>, pg8::StaticOrder, true, true>(F.lds, g, S, E, F.pacc2);
    } SEAM(7); PB1(7);
    PB0(8); if (IN(8)) {
        pg8::Gemm g{(const bf16*)(F.ws + WS_A2), (const bf16*)(F.ws + WS_WGU), SEQ, 2 * DFF, DM}; pg8::StaticOrder S; S.init(SEQ, 2 * DFF, F.G, (int)blockIdx.x);
        pg8::EpiSwiGLU E{(bf16*)(F.ws + WS_HID), SS2};
        pg8::gemm_phase<pg8::EpiSwiGLU, pg8::StaticOrder, true, true>(F.lds, g, S, E, F.pacc2);
        {
          const int nun = (SEQ / 256) * (2 * DFF / 256), rounds = (nun + F.G - 1) / F.G, first_idle = nun - (rounds - 1) * F.G;
          const int nidle = F.G - first_idle;
          if (nidle > 0) { if ((int)blockIdx.x >= first_idle) convert_wd(F, (LAS float*)(F.lds + F.wave * 8448), ((int)blockIdx.x - first_idle) * 8 + F.wave, nidle * 8); }
          else convert_wd(F, (LAS float*)(F.lds + F.wave * 8448), (int)blockIdx.x * 8 + F.wave, F.G * 8); }
    } SEAM(8); PB1(8);
    const unsigned long long epi_before9 = F.pacc2;
    PB0(9); if (IN(9)) {
        pg8::Gemm g{(const bf16*)(F.ws + WS_HID), (const bf16*)(F.ws + WS_WD), SEQ, DM, DFF}; pg8::StaticOrder S; S.init(SEQ, DM, F.G, (int)blockIdx.x);
        pg8::EpiResid<true> E{nullptr, (const bf16*)(F.ws + WS_A2), F.out, nullptr, SS3};
        pg8::gemm_phase<pg8::EpiResid<true>, pg8::StaticOrder, true, true>(F.lds, g, S, E, F.pacc2);
    } SEAM(9); PB1(9);
    const unsigned long long epi9 = F.pacc2 - epi_before9;
    PB0(10); if (IN(10)) { final_phase(F); } PB1(10);
    if (PROBE_PHASE != 0 && blockIdx.x == 0 && F.tid == 0) { const unsigned long long te = __builtin_amdgcn_s_memrealtime(), want = (unsigned long long)PROBE_MULT * (((PROBE_PHASE >> 23) & 1) ? epi9 : ((PROBE_PHASE >> 20) & 1) ? F.pacc2 : (PROBE_PHASE & ((3 << 18) | (3 << 21))) ? (unsigned long long)__hip_atomic_load((unsigned*)(F.ctl + 2048), __ATOMIC_RELAXED, __HIP_MEMORY_SCOPE_AGENT) : (pt1 + F.pacc));
        while (__builtin_amdgcn_s_memrealtime() - te < want && want < 2000000ull) __builtin_amdgcn_s_sleep(32); }
#undef PB0
#undef PB1
#undef IN
#undef SEAM
}

extern "C" void kernel_launch(void* const* d_in, const int* in_sizes, int n_in, void* d_out, int out_size, void* d_ws, size_t ws_size, hipStream_t stream) {
    static int grid = 0;
    if (grid == 0) {
        if (n_in != 26 || out_size != SEQ * DM || ws_size < WS_END) { fprintf(stderr, "kernel_launch: unexpected shapes (n_in %d, out %d, ws %zu, need %zu); nothing launched\n", n_in, out_size, ws_size, (size_t)WS_END); grid = -1; return; }
        int dev = 0, cus = 0, per_cu = 0;
        if (hipGetDevice(&dev) != hipSuccess || hipDeviceGetAttribute(&cus, hipDeviceAttributeMultiprocessorCount, dev) != hipSuccess) { grid = -1; return; }
        if (hipFuncSetAttribute((const void*)fwd_kernel, hipFuncAttributeMaxDynamicSharedMemorySize, LDS_BYTES) != hipSuccess) { fprintf(stderr, "kernel_launch: hipFuncSetAttribute failed\n"); grid = -1; return; }
        if (hipOccupancyMaxActiveBlocksPerMultiprocessor(&per_cu, (const void*)fwd_kernel, 512, LDS_BYTES) != hipSuccess || per_cu < 1) fprintf(stderr, "kernel_launch: occupancy query says %d per CU\n", per_cu);
        (void)hipGetLastError();
        grid = cus;
    }
    if (grid < 0) return;
    if (hipMemsetAsync((char*)d_ws + WS_CTL, 0, ZERO_BYTES, stream) != hipSuccess) return;
    Args a{};
    for (int i = 0; i < 26; ++i) a.in[i] = (const float*)d_in[i];
    a.out = (float*)d_out; a.ws = (unsigned char*)d_ws;
#if MK_SPLIT
    for (int p = 0; p < N_PHASES; ++p) { a.ph_lo = p; a.ph_hi = p + 1; hipLaunchKernelGGL(fwd_kernel, dim3(grid), dim3(512), LDS_BYTES, stream, a); }
#else
    a.ph_lo = 0; a.ph_hi = N_PHASES;
    hipLaunchKernelGGL(fwd_kernel, dim3(grid), dim3(512), LDS_BYTES, stream, a);
#endif
}
```

```cpp
#include <hip/hip_runtime.h>
#include <cstdio>
#include <cstdint>

#ifndef MK_SPLIT
#define MK_SPLIT 0
#endif

#ifndef PROBE_PHASE
#define PROBE_PHASE 0
#endif
#ifndef PROBE_MULT
#define PROBE_MULT 2
#endif
constexpr int NMETA = 16, SEQ = 8192, LTOK = 8208, DM = 4096, MPAD = 8448;
constexpr int INW = 18048, INWP = 18176;
constexpr int ATTW = 2048, KVW = 512, UW = 6784, UPITCH = 6912;
constexpr int RC = 2048, RH = 32, RN = 64;
constexpr int DFF = 11008;
constexpr float RMS_EPS = 1e-6f, GN_EPS = 64e-5f;
constexpr int HT = MPAD / 256;
constexpr int CT_Q = 32, CT_K = 40, CT_V = 42, CT_U = 44, CT_N = 71;

namespace pg8 {
#define PG8_LAS __attribute__((address_space(3)))
typedef unsigned short bf16_t;
typedef short bf16x8 __attribute__((ext_vector_type(8)));
typedef float f32x4 __attribute__((ext_vector_type(4)));
typedef unsigned u32x4 __attribute__((ext_vector_type(4)));
constexpr int BM = 256, BK = 64, HALF = 128, HTB = HALF * BK * 2  , STAGE_BYTES = 8 * HTB, NXCD = 8, WGM = 8;

__host__ __device__ __forceinline__ int lds_byte(int r, int c) { const int st = (r >> 4) * 2 + (c >> 5), rr = r & 15, cc = c & 31, ob = rr * 64 + cc * 2; return st * 1024 + (ob ^ (((ob >> 9) & 1) << 5)); }
__host__ __device__ __forceinline__ void stage_rc(int b, int& R, int& C) { const int st = b / 1024, sb = b % 1024, swz = sb ^ (((sb >> 9) & 1) << 5); R = (st >> 1) * 16 + swz / 64; C = (st & 1) * 32 + (swz % 64) / 2; }
__host__ __device__ __forceinline__ int perm32(int rho) { const int n = rho >> 4, i = rho & 15; return 8 * (i >> 2) + 4 * n + (i & 3); }

struct Unit { int pm, pn; };
struct Gemm { const bf16_t* A; const bf16_t* Bt; int M, N, K; };

struct StaticOrder {
    int nM, nN, nwg, G, c;
    __host__ __device__ void init(int M, int N, int G_, int c_) { nM = M / BM; nN = N / BM; nwg = nM * nN; G = G_; c = c_; }
    __host__ __device__ bool next(int i, Unit& u) const {
        const long L = (long)i * G + c; if (L >= nwg) return false;
        int wgid = (int)L; { const int q = nwg / NXCD, r = nwg % NXCD, xcd = wgid % NXCD, off = wgid / NXCD; wgid = (xcd < r ? xcd * (q + 1) : r * (q + 1) + (xcd - r) * q) + off; }
        const int nig = WGM * nN, gid = wgid / nig, fm = gid * WGM, gsz = (nM - fm) < WGM ? (nM - fm) : WGM;
        u.pm = fm + ((wgid % nig) % gsz); u.pn = (wgid % nig) / gsz; return true;
    }
    __device__ __forceinline__ void a_ready(const Unit&) const {}
    __device__ __forceinline__ void done(const Unit&) const {}
};

typedef float f32x2c __attribute__((ext_vector_type(2)));
typedef __bf16 bf16x2c __attribute__((ext_vector_type(2)));
__device__ __forceinline__ unsigned cvt_pk_bf16(float lo, float hi) { const f32x2c v = {lo, hi}; const bf16x2c r = __builtin_convertvector(v, bf16x2c); return __builtin_bit_cast(unsigned, r); }

typedef unsigned u32x2 __attribute__((ext_vector_type(2)));
__device__ __forceinline__ float bflo(unsigned w) { return __uint_as_float(w << 16); }
__device__ __forceinline__ float bfhi(unsigned w) { return __uint_as_float(w & 0xffff0000u); }
__device__ __forceinline__ float sigmoidf_(float x) { return __builtin_amdgcn_rcpf(1.0f + __expf(-x)); }

struct InOrder {
    StaticOrder base; int G, c;
    __device__ void init(int G_, int c_) { base.init(SEQ, INWP, G_, c_); G = G_; c = c_; }
    __device__ bool next(int i, Unit& u) const {
        const long L = (long)i * G + c;
        if (L < base.nwg) {
            base.next(i, u);
            if (u.pn >= CT_V && u.pn < CT_U) { const int e = (u.pn - CT_V) * 32 + u.pm; u.pm = HT + CT_V + e / HT; u.pn = e % HT; }
            else u.pn += HT;
            return true;
        }
        const int x = (int)(L - base.nwg);
        if (x >= 31) return false;
        if (x < 2) { const int e = 64 + x; u.pm = HT + CT_V + e / HT; u.pn = e % HT; }
        else { const int y = x - 2; u.pm = 32; u.pn = HT + (y < 2 ? CT_K + y : CT_U + (y - 2)); }
        return true;
    }
    __device__ __forceinline__ void a_ready(const Unit&) const {}
    __device__ __forceinline__ void done(const Unit&) const {}
};

struct EpiIn {
    static constexpr bool PERM = true, AFTER_DRAIN = false;
    bf16_t *G, *Q, *K, *Vt, *U; const float* bgate; const float* rope;
    __device__ __forceinline__ static void st8(bf16_t* p, const f32x4& v0, const f32x4& v1) {
        u32x4 w; w.x = cvt_pk_bf16(v0[0], v0[1]); w.y = cvt_pk_bf16(v0[2], v0[3]); w.z = cvt_pk_bf16(v1[0], v1[1]); w.w = cvt_pk_bf16(v1[2], v1[3]); *(u32x4*)p = w; }
    __device__ __forceinline__ void plain(const f32x4 (&acc)[2][2][4][2], bf16_t* base, int ldc, int row0, int col0) const {
#pragma unroll
        for (int ai = 0; ai < 2; ++ai)
#pragma unroll
            for (int m = 0; m < 4; ++m) { bf16_t* rowp = base + (size_t)(row0 + ai * HALF + m * 16) * ldc + col0;
#pragma unroll
                for (int bj = 0; bj < 2; ++bj) st8(rowp + bj * HALF, acc[ai][bj][m][0], acc[ai][bj][m][1]); }
    }
    __device__ __forceinline__ void roped(const f32x4 (&acc)[2][2][4][2], bf16_t* base, int ldc, int row0, int col0, int wc, int fq) const {
        if (wc != 0) { plain(acc, base, ldc, row0, col0); return; }
        const float sgn = (fq < 2) ? -1.0f : 1.0f;
#pragma unroll
        for (int ai = 0; ai < 2; ++ai)
#pragma unroll
            for (int m = 0; m < 4; ++m) { const int row = row0 + ai * HALF + m * 16; const int pos = row < SEQ ? row + NMETA : row - SEQ;
                const f32x4* cs = (const f32x4*)(rope + (size_t)pos * 32 + 16 * (fq & 1));
                const f32x4 c0 = cs[0], c1 = cs[1], c2 = cs[2], c3 = cs[3];
                const float cw[8] = {c0[0], c0[2], c1[0], c1[2], c2[0], c2[2], c3[0], c3[2]}, sw[8] = {c0[1], c0[3], c1[1], c1[3], c2[1], c2[3], c3[1], c3[3]};
                bf16_t* rowp = base + (size_t)row * ldc + col0;
#pragma unroll
                for (int bj = 0; bj < 2; ++bj) { f32x4 v0 = acc[ai][bj][m][0], v1 = acc[ai][bj][m][1], o0, o1;
#pragma unroll
                    for (int e = 0; e < 4; ++e) { const float p0 = __shfl_xor(v0[e], 32), p1 = __shfl_xor(v1[e], 32);
                        o0[e] = v0[e] * cw[e] + sgn * p0 * sw[e]; o1[e] = v1[e] * cw[4 + e] + sgn * p1 * sw[4 + e]; }
                    st8(rowp + bj * HALF, o0, o1); } }
    }
    __device__ __forceinline__ void operator()(const f32x4 (&acc)[2][2][4][2], const Unit& u, int wr, int wc, int fr, int fq) const {
        if (u.pm >= HT) {
            plain(acc, Vt, MPAD, (u.pm - HT - CT_V) * BM + wr * 64 + fr, u.pn * BM + wc * 32 + 8 * fq); return; }
        const int ct = u.pn - HT, row0 = u.pm * BM + wr * 64 + fr, cl = wc * 32 + 8 * fq;
        if (ct < CT_Q) {
            const int col0 = ct * BM + cl;
#pragma unroll
            for (int bj = 0; bj < 2; ++bj) { const f32x4 b0 = *(const f32x4*)(bgate + col0 + bj * HALF), b1 = *(const f32x4*)(bgate + col0 + bj * HALF + 4);
#pragma unroll
                for (int ai = 0; ai < 2; ++ai)
#pragma unroll
                    for (int m = 0; m < 4; ++m) { f32x4 v0 = acc[ai][bj][m][0] + b0, v1 = acc[ai][bj][m][1] + b1;
#pragma unroll
                        for (int e = 0; e < 4; ++e) { v0[e] = sigmoidf_(v0[e]); v1[e] = sigmoidf_(v1[e]); }
                        st8(G + (size_t)(row0 + ai * HALF + m * 16) * (2 * DM) + col0 + bj * HALF, v0, v1); } }
        } else if (ct < CT_K) { roped(acc, Q, ATTW, row0, (ct - CT_Q) * BM + cl, wc, fq);
        } else if (ct < CT_V) { roped(acc, K, KVW, row0, (ct - CT_K) * BM + cl, wc, fq);
        } else { plain(acc, U, UPITCH, row0, (ct - CT_U) * BM + cl); }
    }
};

struct EpiProjA {
    static constexpr bool PERM = true, AFTER_DRAIN = false;
    bf16_t* P1; const bf16_t* G;
    __device__ __forceinline__ void operator()(const f32x4 (&acc)[2][2][4][2], const Unit& u, int wr, int wc, int fr, int fq) const {
        const int row0 = u.pm * BM + wr * 64 + fr, col0 = u.pn * BM + wc * 32 + 8 * fq;
#pragma unroll
        for (int ai = 0; ai < 2; ++ai)
#pragma unroll
            for (int m = 0; m < 4; ++m) { const size_t r = (size_t)(row0 + ai * HALF + m * 16);
#pragma unroll
                for (int bj = 0; bj < 2; ++bj) { const int c = col0 + bj * HALF; const u32x4 g = *(const u32x4*)(G + r * (2 * DM) + c);
                    f32x4 o0 = acc[ai][bj][m][0], o1 = acc[ai][bj][m][1];
                    o0[0] *= bflo(g.x); o0[1] *= bfhi(g.x); o0[2] *= bflo(g.y); o0[3] *= bfhi(g.y); o1[0] *= bflo(g.z); o1[1] *= bfhi(g.z); o1[2] *= bflo(g.w); o1[3] *= bfhi(g.w);
                    EpiIn::st8(P1 + r * DM + c, o0, o1); } }
    }
};
struct EpiProjB {
    static constexpr bool PERM = true, AFTER_DRAIN = false;
    const bf16_t* P1; const bf16_t* G; bf16_t* MX;
    __device__ __forceinline__ void operator()(const f32x4 (&acc)[2][2][4][2], const Unit& u, int wr, int wc, int fr, int fq) const {
        const int row0 = u.pm * BM + wr * 64 + fr, col0 = u.pn * BM + wc * 32 + 8 * fq;
#pragma unroll
        for (int ai = 0; ai < 2; ++ai)
#pragma unroll
            for (int m = 0; m < 4; ++m) { const size_t r = (size_t)(row0 + ai * HALF + m * 16);
#pragma unroll
                for (int bj = 0; bj < 2; ++bj) { const int c = col0 + bj * HALF; const u32x4 g = *(const u32x4*)(G + r * (2 * DM) + DM + c); const u32x4 q = *(const u32x4*)(P1 + r * DM + c);
                    f32x4 o0 = {bflo(q.x), bfhi(q.x), bflo(q.y), bfhi(q.y)}, o1 = {bflo(q.z), bfhi(q.z), bflo(q.w), bfhi(q.w)}; const f32x4 a0 = acc[ai][bj][m][0], a1 = acc[ai][bj][m][1];
                    o0[0] += a0[0] * bflo(g.x); o0[1] += a0[1] * bfhi(g.x); o0[2] += a0[2] * bflo(g.y); o0[3] += a0[3] * bfhi(g.y);
                    o1[0] += a1[0] * bflo(g.z); o1[1] += a1[1] * bfhi(g.z); o1[2] += a1[2] * bflo(g.w); o1[3] += a1[3] * bfhi(g.w);
                    EpiIn::st8(MX + r * DM + c, o0, o1); }
                asm volatile("" ::: "memory"); }
    }
};
template <bool BASE_BF16> struct EpiResid {
    static constexpr bool PERM = true, AFTER_DRAIN = false;
    const float* BASEF; const bf16_t* BASEB; float* OUTF; bf16_t* OUTB; float* SS;
    __device__ __forceinline__ void operator()(const f32x4 (&acc)[2][2][4][2], const Unit& u, int wr, int wc, int fr, int fq) const {
        const int row0 = u.pm * BM + wr * 64 + fr, col0 = u.pn * BM + wc * 32 + 8 * fq;
#pragma unroll
        for (int ai = 0; ai < 2; ++ai)
#pragma unroll
            for (int m = 0; m < 4; ++m) { const size_t r = (size_t)(row0 + ai * HALF + m * 16); float ss = 0.f;
#pragma unroll
                for (int bj = 0; bj < 2; ++bj) { const int c = col0 + bj * HALF; f32x4 o0, o1;
                    if (BASE_BF16) { const u32x4 g = *(const u32x4*)(BASEB + r * DM + c); o0 = (f32x4){bflo(g.x), bfhi(g.x), bflo(g.y), bfhi(g.y)}; o1 = (f32x4){bflo(g.z), bfhi(g.z), bflo(g.w), bfhi(g.w)}; }
                    else { const float* bp = BASEF + r * DM + c; o0 = *(const f32x4*)bp; o1 = *(const f32x4*)(bp + 4); }
                    o0 += acc[ai][bj][m][0]; o1 += acc[ai][bj][m][1];
                    if (BASE_BF16) { float* op = OUTF + r * DM + c; *(f32x4*)op = o0; *(f32x4*)(op + 4) = o1; }
                    else { u32x4 w; w.x = cvt_pk_bf16(o0[0], o0[1]); w.y = cvt_pk_bf16(o0[2], o0[3]); w.z = cvt_pk_bf16(o1[0], o1[1]); w.w = cvt_pk_bf16(o1[2], o1[3]); *(u32x4*)(OUTB + r * DM + c) = w;
                        o0 = (f32x4){bflo(w.x), bfhi(w.x), bflo(w.y), bfhi(w.y)}; o1 = (f32x4){bflo(w.z), bfhi(w.z), bflo(w.w), bfhi(w.w)}; }
                    ss += (o0[0] * o0[0] + o0[1] * o0[1]) + (o0[2] * o0[2] + o0[3] * o0[3]) + (o1[0] * o1[0] + o1[1] * o1[1]) + (o1[2] * o1[2] + o1[3] * o1[3]); }
                ss += __shfl_xor(ss, 16); ss += __shfl_xor(ss, 32);
                if (fq == 0) atomicAdd(SS + r, ss);
                asm volatile("" ::: "memory"); }
    }
};
struct EpiSwiGLU {
    static constexpr bool PERM = true, AFTER_DRAIN = false;
    bf16_t* HID; const float* SS;
    __device__ __forceinline__ void operator()(const f32x4 (&acc)[2][2][4][2], const Unit& u, int wr, int wc, int fr, int fq) const {
        const int row0 = u.pm * BM + wr * 64 + fr, col0 = u.pn * HALF + wc * 32 + 8 * fq;
#pragma unroll
        for (int ai = 0; ai < 2; ++ai)
#pragma unroll
            for (int m = 0; m < 4; ++m) { const size_t r = (size_t)(row0 + ai * HALF + m * 16);
                const float rstd = __builtin_amdgcn_rsqf(SS[r] * (1.0f / DM) + RMS_EPS);
                f32x4 o0, o1;
#pragma unroll
                for (int e = 0; e < 4; ++e) { const float g0 = acc[ai][0][m][0][e] * rstd, u0 = acc[ai][1][m][0][e] * rstd, g1 = acc[ai][0][m][1][e] * rstd, u1 = acc[ai][1][m][1][e] * rstd;
                    o0[e] = g0 * sigmoidf_(g0) * u0; o1[e] = g1 * sigmoidf_(g1) * u1; }
                EpiIn::st8(HID + r * DFF + col0, o0, o1); }
    }
};

#define PG8_EPI_T0 unsigned long long epi_t0_ = 0; do { if ((PROBE_PHASE >> 20) & 1) epi_t0_ = __builtin_amdgcn_s_memrealtime(); } while (0)
#define PG8_EPI_T1 do { if ((PROBE_PHASE >> 20) & 1) epi_acc += __builtin_amdgcn_s_memrealtime() - epi_t0_; } while (0)
template <class Epi, class Sched, bool ALIGN_EPI = false, bool SP2 = false>
__device__ __forceinline__ void gemm_phase(PG8_LAS unsigned char* lds, const Gemm g, const Sched& S, const Epi& E, unsigned long long& epi_acc) {
    const int tid = threadIdx.x, wid = __builtin_amdgcn_readfirstlane(tid >> 6), lane = tid & 63, wr = wid >> 2, wc = wid & 3, fr = lane & 15, fq = lane >> 4;
    const int K = g.K, nt = K / BK;
    unsigned voffA[2], voffB[2];
#pragma unroll
    for (int i = 0; i < 2; ++i) { int R, C; stage_rc(tid * 16 + i * 8192, R, C); const int Rb = Epi::PERM ? ((R & ~31) + perm32(R & 31)) : R;
        voffA[i] = (unsigned)(R * K + C) * 2u; voffB[i] = (unsigned)(Rb * K + C) * 2u; }
    const size_t kstep = (size_t)(BK * 2);
    const size_t hstep = (size_t)HALF * K * 2;
    const size_t tstep = 2 * hstep;
    const unsigned ldsw = (unsigned)wid * 1024u;
    const int aoff = lds_byte(wr * 64 + fr, fq * 8), boff = lds_byte(wc * 32 + fr, fq * 8);
#define PG8_SA(b, h) (((b) * 2 + (h)) * HTB)
#define PG8_SB(b, h) ((4 + (b) * 2 + (h)) * HTB)
#define PG8_STAGE(bufoff, gbase, voff) do { _Pragma("unroll") for (int _i = 0; _i < 2; ++_i) \
        __builtin_amdgcn_global_load_lds((const unsigned*)((const char*)(gbase) + (voff)[_i]), (PG8_LAS unsigned*)(lds + (bufoff) + ldsw + _i * 8192), 16, 0, 0); } while (0)
#define PG8_LDA(dst, b, h) do { _Pragma("unroll") for (int m = 0; m < 4; ++m) _Pragma("unroll") for (int k = 0; k < 2; ++k) dst[m][k] = *(const PG8_LAS bf16x8*)(lds + PG8_SA(b, h) + aoff + m * 2048 + k * 1024); } while (0)
#define PG8_LDB(dst, b, h) do { _Pragma("unroll") for (int n = 0; n < 2; ++n) _Pragma("unroll") for (int k = 0; k < 2; ++k) dst[n][k] = *(const PG8_LAS bf16x8*)(lds + PG8_SB(b, h) + boff + n * 2048 + k * 1024); } while (0)
#define PG8_MMA(ai, bj, At, Bt) do { __builtin_amdgcn_s_setprio(1); _Pragma("unroll") for (int m = 0; m < 4; ++m) _Pragma("unroll") for (int n = 0; n < 2; ++n) _Pragma("unroll") for (int k = 0; k < 2; ++k) \
        acc[ai][bj][m][n] = __builtin_amdgcn_mfma_f32_16x16x32_bf16(Bt[n][k], At[m][k], acc[ai][bj][m][n], 0, 0, 0); __builtin_amdgcn_s_setprio(0); } while (0)
#define PG8_WAIT_V(n) asm volatile("s_waitcnt vmcnt(" #n ")" ::: "memory")
#define PG8_WAIT_L(n) asm volatile("s_waitcnt lgkmcnt(" #n ")" ::: "memory")
#define PG8_BAR __builtin_amdgcn_s_barrier()
#define PG8_SCHED __builtin_amdgcn_sched_barrier(0)
    Unit cur, nxt; int ui = 0;
    if (!S.next(0, cur)) return;
    f32x4 acc[2][2][4][2];
#pragma unroll
    for (int a = 0; a < 2; ++a)
#pragma unroll
        for (int b = 0; b < 2; ++b)
#pragma unroll
            for (int m = 0; m < 4; ++m)
#pragma unroll
                for (int n = 0; n < 2; ++n) acc[a][b][m][n] = (f32x4){0.f, 0.f, 0.f, 0.f};
    bf16x8 At[4][2], B0[2][2], B1[2][2];
    const char* cA = (const char*)g.A + (size_t)cur.pm * tstep; const char* cB = (const char*)g.Bt + (size_t)cur.pn * tstep;
    S.a_ready(cur);
    if constexpr (SP2) {
        PG8_STAGE(PG8_SB(0, 0), cB, voffB); PG8_STAGE(PG8_SB(0, 1), cB + hstep, voffB); PG8_STAGE(PG8_SA(0, 0), cA, voffA); PG8_STAGE(PG8_SA(0, 1), cA + hstep, voffA);
        if (wr == 1) PG8_BAR;
        PG8_WAIT_V(2); PG8_BAR;
        PG8_STAGE(PG8_SB(1, 0), cB + kstep, voffB); PG8_STAGE(PG8_SA(1, 0), cA + kstep, voffA); PG8_STAGE(PG8_SB(1, 1), cB + hstep + kstep, voffB);
        PG8_WAIT_V(6); PG8_BAR;
    } else {
        PG8_STAGE(PG8_SB(0, 0), cB, voffB); PG8_STAGE(PG8_SA(0, 0), cA, voffA); PG8_STAGE(PG8_SB(0, 1), cB + hstep, voffB); PG8_STAGE(PG8_SA(0, 1), cA + hstep, voffA);
        if (wr == 1) PG8_BAR;
        PG8_WAIT_V(4); PG8_BAR;
        PG8_STAGE(PG8_SB(1, 0), cB + kstep, voffB); PG8_STAGE(PG8_SA(1, 0), cA + kstep, voffA); PG8_STAGE(PG8_SB(1, 1), cB + hstep + kstep, voffB);
        PG8_WAIT_V(6); PG8_BAR;
    }
    for (;;) {
        const bool has_next = S.next(ui + 1, nxt);
        const char* nA = has_next ? (const char*)g.A + (size_t)nxt.pm * tstep : cA; const char* nB = has_next ? (const char*)g.Bt + (size_t)nxt.pn * tstep : cB;
        for (int t = 0; t < nt; t += 2) {
            const bool last = (t == nt - 2);
            const char* a1 = cA + (size_t)(t + 1) * kstep;
            const char* a2 = last ? nA : cA + (size_t)(t + 2) * kstep; const char* b2 = last ? nB : cB + (size_t)(t + 2) * kstep;
            const char* a3 = a2 + kstep; const char* b3 = b2 + kstep;
            if (last && has_next) S.a_ready(nxt);
            if constexpr (SP2) {
            PG8_LDB(B0, 0, 0); PG8_LDB(B1, 0, 1); PG8_SCHED; PG8_LDA(At, 0, 0); PG8_STAGE(PG8_SA(1, 1), a1 + hstep, voffA);
            PG8_WAIT_V(8); PG8_WAIT_L(0); PG8_BAR; PG8_MMA(0, 0, At, B0); PG8_MMA(0, 1, At, B1); PG8_BAR; PG8_SCHED;
            PG8_LDA(At, 0, 1); PG8_STAGE(PG8_SB(0, 0), b2, voffB); PG8_STAGE(PG8_SB(0, 1), b2 + hstep, voffB); PG8_STAGE(PG8_SA(0, 0), a2, voffA);
            PG8_WAIT_V(8); PG8_WAIT_L(0); PG8_BAR; PG8_MMA(1, 0, At, B0); PG8_MMA(1, 1, At, B1); PG8_BAR; PG8_SCHED;
            PG8_LDB(B0, 1, 0); PG8_LDB(B1, 1, 1); PG8_SCHED; PG8_LDA(At, 1, 0); PG8_STAGE(PG8_SA(0, 1), a2 + hstep, voffA);
            PG8_WAIT_V(8); PG8_WAIT_L(0); PG8_BAR; PG8_MMA(0, 0, At, B0); PG8_MMA(0, 1, At, B1); PG8_BAR; PG8_SCHED;
            PG8_LDA(At, 1, 1); PG8_STAGE(PG8_SB(1, 0), b3, voffB); PG8_STAGE(PG8_SB(1, 1), b3 + hstep, voffB); PG8_STAGE(PG8_SA(1, 0), a3, voffA);
            PG8_WAIT_V(8); PG8_WAIT_L(0); PG8_BAR; PG8_MMA(1, 0, At, B0); PG8_MMA(1, 1, At, B1); PG8_BAR; PG8_SCHED;
            } else {
            PG8_LDB(B0, 0, 0); PG8_SCHED; PG8_LDA(At, 0, 0); PG8_STAGE(PG8_SA(1, 1), a1 + hstep, voffA);
            PG8_WAIT_L(8); PG8_BAR; PG8_WAIT_L(0); PG8_MMA(0, 0, At, B0); PG8_BAR; PG8_SCHED;
            PG8_LDB(B1, 0, 1); PG8_STAGE(PG8_SB(0, 0), b2, voffB);
            PG8_BAR; PG8_WAIT_L(0); PG8_MMA(0, 1, At, B1); PG8_BAR;
            PG8_LDA(At, 0, 1); PG8_STAGE(PG8_SA(0, 0), a2, voffA);
            PG8_BAR; PG8_WAIT_L(0); PG8_MMA(1, 0, At, B0); PG8_BAR; PG8_SCHED;
            PG8_STAGE(PG8_SB(0, 1), b2 + hstep, voffB);
            PG8_WAIT_V(6); PG8_BAR; PG8_MMA(1, 1, At, B1); PG8_BAR;
            PG8_LDB(B0, 1, 0); PG8_SCHED; PG8_LDA(At, 1, 0); PG8_STAGE(PG8_SA(0, 1), a2 + hstep, voffA);
            PG8_WAIT_L(8); PG8_BAR; PG8_WAIT_L(0); PG8_MMA(0, 0, At, B0); PG8_BAR; PG8_SCHED;
            PG8_LDB(B1, 1, 1); PG8_STAGE(PG8_SB(1, 0), b3, voffB);
            PG8_BAR; PG8_WAIT_L(0); PG8_MMA(0, 1, At, B1); PG8_BAR;
            PG8_LDA(At, 1, 1); PG8_STAGE(PG8_SA(1, 0), a3, voffA);
            PG8_BAR; PG8_WAIT_L(0); PG8_MMA(1, 0, At, B0); PG8_BAR; PG8_SCHED;
            PG8_STAGE(PG8_SB(1, 1), b3 + hstep, voffB);
            PG8_WAIT_V(6); PG8_BAR; PG8_MMA(1, 1, At, B1); PG8_BAR;
            }
        }
        if constexpr (ALIGN_EPI) { if (wr == 0) PG8_BAR; }
        if constexpr (!Epi::AFTER_DRAIN) { PG8_EPI_T0; E(acc, cur, wr, wc, fr, fq); S.done(cur); PG8_EPI_T1; }
        if (!has_next) break;
#pragma unroll
        for (int a = 0; a < 2; ++a)
#pragma unroll
            for (int b = 0; b < 2; ++b)
#pragma unroll
                for (int m = 0; m < 4; ++m)
#pragma unroll
                    for (int n = 0; n < 2; ++n) acc[a][b][m][n] = (f32x4){0.f, 0.f, 0.f, 0.f};
        cur = nxt; cA = nA; cB = nB; ++ui;
        if constexpr (ALIGN_EPI) { if (wr == 1) PG8_BAR; }
    }
    PG8_WAIT_V(0);
    if constexpr (!ALIGN_EPI) { if (wr == 0) PG8_BAR; }
    PG8_BAR;
    if constexpr (Epi::AFTER_DRAIN) { E.fused(acc, cur, wr, wc, fr, fq, lds, wid, lane); S.done(cur); }
#undef PG8_SA
#undef PG8_SB
#undef PG8_STAGE
#undef PG8_LDA
#undef PG8_LDB
#undef PG8_MMA
#undef PG8_WAIT_V
#undef PG8_WAIT_L
#undef PG8_BAR
#undef PG8_SCHED
}

}

constexpr size_t MiB = 1u << 20;
constexpr size_t WS_CTL = 0;
constexpr size_t WS_ROPE = 1 * MiB;
constexpr size_t WS_LW2 = 3 * MiB, WS_LA2 = 4 * MiB, WS_LG2 = 5 * MiB;
constexpr size_t WS_BONUS = 6 * MiB;
constexpr size_t ZERO_BYTES = 8 * MiB;
constexpr size_t SCF = (size_t)LTOK * RC * 4, SCB = (size_t)LTOK * RC * 2;
constexpr size_t WS_H = 8 * MiB, WS_WIN = WS_H + (size_t)MPAD * DM * 2;
constexpr size_t WS_KD0 = 8 * MiB, WS_KD1 = WS_KD0 + SCB, WS_B0 = WS_KD1 + SCB, WS_B1 = WS_B0 + SCB, WS_KK = WS_B1 + SCB, WS_RR = WS_KK + SCB;
constexpr size_t WS_WGU = 8 * MiB;
constexpr size_t WS_G = 216 * MiB, WS_A2 = 216 * MiB;
constexpr size_t WS_Q = 344 * MiB, WS_K = 376 * MiB, WS_VT = 385 * MiB, WS_U = 394 * MiB;
constexpr size_t WS_P1 = 344 * MiB;
constexpr size_t WS_Y = 394 * MiB;
constexpr size_t WS_W0 = 506 * MiB, WS_W1 = WS_W0 + SCF;
constexpr size_t WS_WPA = 506 * MiB, WS_WPR = 522 * MiB, WS_WOUT = 538 * MiB, WS_OATT = 570 * MiB;
constexpr size_t WS_VV = 635 * MiB, WS_GG = 668 * MiB;
constexpr size_t WS_BO = 701 * MiB;
constexpr size_t WS_HID = 701 * MiB, WS_MX = 873 * MiB;
constexpr int NB0 = 513, NB1 = 512, NBT = NB0 + NB1;
constexpr int BO_FA = 0, BO_FAA = 4096, BO_FT = 5120, BO_FBP = 5632, BO_FB = 6144, BO_FG = 10240, BO_ITEM = 10496;
constexpr size_t WS_WD = 1030 * MiB, WS_ORWKV = 182 * MiB, WS_END = 1116 * MiB;
static_assert(WS_WIN + (size_t)INWP * DM * 2 <= WS_G && WS_RR + SCB <= WS_G && WS_WGU + (size_t)2 * DFF * DM * 2 <= WS_G, "map: A0");
static_assert(WS_U + (size_t)MPAD * UPITCH * 2 <= WS_W0 && WS_VT + (size_t)KVW * MPAD * 2 <= WS_U && WS_K + (size_t)MPAD * KVW * 2 <= WS_VT && WS_Q + (size_t)SEQ * ATTW * 2 <= WS_K && WS_Y + 2 * SCB <= WS_W0, "map: P1 outputs");
static_assert(WS_W1 + SCF <= WS_VV && WS_OATT + (size_t)SEQ * ATTW * 2 <= WS_VV && WS_VV + SCB <= WS_GG && WS_GG + SCB <= WS_BO && WS_P1 + (size_t)SEQ * DM * 2 <= WS_W0, "map: mid");
static_assert(WS_BO + (size_t)RH * NBT * BO_ITEM <= WS_WD && WS_HID + (size_t)SEQ * DFF * 2 <= WS_MX && WS_MX + (size_t)SEQ * DM * 2 <= WS_WD && WS_WD + (size_t)DM * DFF * 2 <= WS_END && WS_WGU + (size_t)2 * DFF * DM * 2 <= WS_ORWKV && WS_ORWKV + (size_t)SEQ * RC * 2 <= WS_G, "map: tail");
constexpr int CW_BAR = 4096;
constexpr int CW_SS2 = 65536, CW_SS3 = 65536 + 8192;
static_assert((CW_SS3 + 8192) * 4 <= (int)(1 * MiB), "CTL");

constexpr int RING_BYTES = 131072;
constexpr int LDSCTL_OFF = RING_BYTES, MISC_OFF = LDSCTL_OFF + 320;
constexpr int LDS_BYTES = 147456;

#define GAS __attribute__((address_space(1)))
#define LAS __attribute__((address_space(3)))
typedef unsigned short bf16;
typedef unsigned v4u __attribute__((ext_vector_type(4)));
typedef unsigned v2u __attribute__((ext_vector_type(2)));
typedef float f32x4 __attribute__((ext_vector_type(4)));
typedef float f32x2 __attribute__((ext_vector_type(2)));
typedef float f32x16 __attribute__((ext_vector_type(16)));
typedef short bf16x8 __attribute__((ext_vector_type(8)));
typedef GAS unsigned gu32;
#define RLX_AGENT __ATOMIC_RELAXED, __HIP_MEMORY_SCOPE_AGENT
#define LDS_WAIT() asm volatile("s_waitcnt lgkmcnt(0)" ::: "memory")
__device__ __forceinline__ unsigned pk2(float lo, float hi) { return pg8::cvt_pk_bf16(lo, hi); }
__device__ __forceinline__ unsigned f2bf(float f) { return pg8::cvt_pk_bf16(f, 0.f) & 0xffffu; }
__device__ __forceinline__ float bf2f(bf16 b) { return __uint_as_float(((unsigned)b) << 16); }
using pg8::bflo; using pg8::bfhi; using pg8::sigmoidf_;

#define XB_TMO      128
#define XB_XCNT(j)  (256  + 64 * (j))
#define XB_XSUB(j)  (1280 + 64 * (j))
#define XB_XGEN(j)  (2304 + 64 * (j))
#define XB_TOP      3328
#define XB_TOPGEN   3392
#define XCD_BAR_WORDS 3456
#define XB_SPIN_CAP (1u << 18)

__device__ __forceinline__ unsigned xb_ld(unsigned* p)              { return __hip_atomic_load(p, __ATOMIC_RELAXED, __HIP_MEMORY_SCOPE_AGENT); }
__device__ __forceinline__ unsigned xb_add(unsigned* p, unsigned v) { return __hip_atomic_fetch_add(p, v, __ATOMIC_RELAXED, __HIP_MEMORY_SCOPE_AGENT); }
__device__ __forceinline__ unsigned xb_xcc_id() { return (unsigned)__builtin_amdgcn_s_getreg((3 << 11) | 20) & 0xFu; }
#define XB_SPIN(cond, bar) do { unsigned _sp = 0; while (cond) { __builtin_amdgcn_s_sleep(1); \
    if ((++_sp & 255u) == 0u) { if (xb_ld(&(bar)[XB_TMO])) break; if (_sp > XB_SPIN_CAP) { atomicAdd(&(bar)[XB_TMO], 1u); break; } } } } while (0)

struct XcdBarrier {
    unsigned* bar; unsigned x;
    volatile LAS unsigned* st;
};

__device__ __forceinline__ XcdBarrier xcd_barrier_post(unsigned* bar, volatile LAS unsigned* st) {
    XcdBarrier b; b.bar = bar; b.x = xb_xcc_id(); b.st = st;
    if (threadIdx.x == 0) (void)xb_add(&bar[XB_XCNT(b.x)], 1u);
    return b;
}
__device__ __forceinline__ void xcd_barrier_complete(unsigned* bar, unsigned x, unsigned& nloc, unsigned& nx) {
    const unsigned G = gridDim.x * gridDim.y * gridDim.z;
    unsigned sum, cnt, mine, sp = 0u;
    for (;;) {
        sum = 0u; cnt = 0u; mine = 0u;
#pragma unroll
        for (unsigned j = 0; j < 16; ++j) { const unsigned c = xb_ld(&bar[XB_XCNT(j)]); sum += c; cnt += (c > 0u) ? 1u : 0u; mine = (j == x) ? c : mine; }
        if (sum == G) break;
        __builtin_amdgcn_s_sleep(1);
        if ((++sp & 255u) == 0u) { if (xb_ld(&bar[XB_TMO])) break; if (sp > XB_SPIN_CAP) { atomicAdd(&bar[XB_TMO], 1u); break; } }
    }
    nloc = mine > 0u ? mine : 1u; nx = cnt > 0u ? cnt : 1u;
}

__device__ __forceinline__ void xcd_barrier(const XcdBarrier& b) {
    asm volatile("s_waitcnt vmcnt(0)" ::: "memory");
    __syncthreads();
    if (threadIdx.x == 0) {
        unsigned* bar = b.bar;
        __builtin_amdgcn_s_waitcnt(0);
        unsigned nloc = b.st[0], nx = b.st[1];
        if (nloc == 0u) { xcd_barrier_complete(bar, b.x, nloc, nx); b.st[0] = nloc; b.st[1] = nx; }
        const unsigned old = xb_add(&bar[XB_XSUB(b.x)], 1u);
        const unsigned gen = old / nloc;
        if (old + 1u == (gen + 1u) * nloc) {
            __builtin_amdgcn_fence(__ATOMIC_RELEASE, "agent");
            asm volatile("s_waitcnt vmcnt(0)" ::: "memory");
            const unsigned og = xb_add(&bar[XB_TOP], 1u);
            const unsigned tg = og / nx;
            if (og + 1u == (tg + 1u) * nx) xb_add(&bar[XB_TOPGEN], 1u);
            else XB_SPIN(xb_ld(&bar[XB_TOPGEN]) == tg, bar);
            __builtin_amdgcn_fence(__ATOMIC_ACQUIRE, "agent");
            xb_add(&bar[XB_XGEN(b.x)], 1u);
            asm volatile("s_waitcnt vmcnt(0)" ::: "memory");
        } else {
            XB_SPIN(xb_ld(&bar[XB_XGEN(b.x)]) == gen, bar);
            __builtin_amdgcn_fence(__ATOMIC_ACQUIRE, "agent");
            asm volatile("s_waitcnt vmcnt(0)" ::: "memory");
        }
    }
    __syncthreads();
}


struct Frame {
    LAS unsigned char* lds;
    volatile LAS unsigned* MISC;
    gu32* ctl;
    int tid, lane, wave, G;
    unsigned char* ws;
    const float* in[26];
    float* out;
    unsigned long long pb0, pacc, pacc2;
};
#define FPB0(k) do { if ((PROBE_PHASE >> (k)) & 1) F.pb0 = __builtin_amdgcn_s_memrealtime(); } while (0)
#define FPB1(k) do { if ((PROBE_PHASE >> (k)) & 1) F.pacc += __builtin_amdgcn_s_memrealtime() - F.pb0; } while (0)
__device__ __forceinline__ float wave_sum(float v) {
#pragma unroll
    for (int o = 1; o < 64; o <<= 1) v += __shfl_xor(v, o);
    return v;
}

template <int KR> __device__ __forceinline__ void tr_issue(const float* W, int N, int item, int lane, float (&wv)[KR / 2]) {
    const int nblk = N / 32, kb = item / nblk, nb = item % nblk, k0 = KR * kb, n0 = 32 * nb;
#pragma unroll
    for (int i = 0; i < KR / 2; ++i) wv[i] = W[(size_t)(k0 + 2 * i + (lane >> 5)) * N + n0 + (lane & 31)];
}
template <int KR> __device__ __forceinline__ void tr_finish(bf16* WT, int K, int N, const float* kscale, int mode, int item, LAS float* scr, int lane, const float (&wv)[KR / 2]) {
    const int nblk = N / 32, kb = item / nblk, nb = item % nblk, k0 = KR * kb, n0 = 32 * nb;
#pragma unroll
    for (int i = 0; i < KR / 2; ++i) { const int kk = 2 * i + (lane >> 5); float v = wv[i]; if (kscale) v *= kscale[k0 + kk]; scr[kk * 33 + (lane & 31)] = v; }
    LDS_WAIT(); asm volatile("" ::: "memory");
    constexpr int CH = KR / 8;
    const int c = lane & (CH - 1);
#pragma unroll
    for (int jj = 0; jj < CH / 2; ++jj) { const int n = (lane / CH) + (64 / CH) * jj; const LAS float* s = scr + (8 * c) * 33 + n;
        v4u o; o.x = pk2(s[0 * 33], s[1 * 33]); o.y = pk2(s[2 * 33], s[3 * 33]); o.z = pk2(s[4 * 33], s[5 * 33]); o.w = pk2(s[6 * 33], s[7 * 33]);
        const int nn = n0 + n; const int dr = (mode == 0) ? nn : (256 * (nn >> 7) + (nn & 127) + (mode == 2 ? 128 : 0));
        *(GAS v4u*)(WT + (size_t)dr * K + k0 + 8 * c) = o; }
    LDS_WAIT(); asm volatile("" ::: "memory");
}
#define CONV_P4(it, CALL) do { constexpr int I_GU_ = (DM / 64) * (DFF / 32), I_P_ = (ATTW / 64) * (DM / 32); int r_ = (it); \
        if (r_ < I_GU_) { CALL(F.in[22], (bf16*)(F.ws + WS_WGU), DM, DFF, F.in[21], 1, r_); } \
        else if ((r_ -= I_GU_) < I_GU_) { CALL(F.in[23], (bf16*)(F.ws + WS_WGU), DM, DFF, F.in[21], 2, r_); } \
        else if ((r_ -= I_GU_) < I_P_) { CALL(F.in[18], (bf16*)(F.ws + WS_WPA), ATTW, DM, (const float*)nullptr, 0, r_); } \
        else if ((r_ -= I_P_) < I_P_) { CALL(F.in[19], (bf16*)(F.ws + WS_WPR), RC, DM, (const float*)nullptr, 0, r_); } \
        else { r_ -= I_P_; CALL(F.in[20], (bf16*)(F.ws + WS_WOUT), DM, DM, (const float*)nullptr, 0, r_); } } while (0)
constexpr int N_P4_ITEMS = 2 * (DM / 64) * (DFF / 32) + 2 * (ATTW / 64) * (DM / 32) + (DM / 64) * (DM / 32);
constexpr int N_WD_ITEMS = (DFF / 64) * (DM / 32);
constexpr int N_WD_HALF_ITEMS = (DFF / 32) * (DM / 32);
__device__ __forceinline__ void convert_seg(Frame& F, LAS float* scr, int first, int stride, int limit) {
    int it = first; if (it >= limit) return;
    float w0[32], w1[32];
#define CVI0(W_, WT_, K_, N_, ks_, md_, item_) tr_issue<64>(W_, N_, item_, F.lane, w0)
#define CVI1(W_, WT_, K_, N_, ks_, md_, item_) tr_issue<64>(W_, N_, item_, F.lane, w1)
#define CVI2(W_, WT_, K_, N_, ks_, md_, item_) tr_issue<64>(W_, N_, item_, F.lane, w2)
#define CVF(W_, WT_, K_, N_, ks_, md_, item_) tr_finish<64>(WT_, K_, N_, ks_, md_, item_, scr, F.lane, w0)
    CONV_P4(it, CVI0);
    if (it + stride < limit) CONV_P4(it + stride, CVI1);
    for (;;) { const int it2 = it + 2 * stride; float w2[32];
        if (it2 < limit) CONV_P4(it2, CVI2);
        CONV_P4(it, CVF);
        it += stride; if (it >= limit) break;
#pragma unroll
        for (int i = 0; i < 32; ++i) { w0[i] = w1[i]; w1[i] = w2[i]; } }
#undef CVI0
#undef CVI1
#undef CVI2
#undef CVF
}
__device__ __forceinline__ void convert_p4(Frame& F, LAS float* scr, int widx, int NWK, int pidx, int NPL) {
    (void)widx; (void)NWK;
    if (pidx >= 0) convert_seg(F, scr, pidx, NPL, N_P4_ITEMS);
}
__device__ __forceinline__ void convert_one(Frame& F, LAS float* scr, const float* W, bf16* WT, int K, int N, int nitems, int first, int stride) {
    int it = first; if (it >= nitems) return;
    float w0[32], w1[32];
    tr_issue<64>(W, N, it, F.lane, w0);
    if (it + stride < nitems) tr_issue<64>(W, N, it + stride, F.lane, w1);
    for (;;) { const int it2 = it + 2 * stride; float w2[32];
        if (it2 < nitems) tr_issue<64>(W, N, it2, F.lane, w2);
        tr_finish<64>(WT, K, N, nullptr, 0, it, scr, F.lane, w0);
        it += stride; if (it >= nitems) break;
#pragma unroll
        for (int i = 0; i < 32; ++i) { w0[i] = w1[i]; w1[i] = w2[i]; } }
}
__device__ __forceinline__ void convert_wd(Frame& F, LAS float* scr, int first, int stride) { convert_one(F, scr, F.in[24], (bf16*)(F.ws + WS_WD), DFF, DM, N_WD_ITEMS, first, stride); }
__device__ __forceinline__ void rms_row_to_bf16(int lane, const float* xrow, const float* w, bf16* orow) {
    const GAS f32x4* xr = (const GAS f32x4*)xrow + lane;
    f32x4 v[16]; float s = 0.f;
#pragma unroll
    for (int j = 0; j < 16; ++j) { v[j] = xr[64 * j]; s += (v[j].x * v[j].x + v[j].y * v[j].y) + (v[j].z * v[j].z + v[j].w * v[j].w); }
    const float rstd = 1.f / sqrtf(wave_sum(s) * (1.f / DM) + RMS_EPS);
    const GAS f32x4* wr = (const GAS f32x4*)w + lane;
    GAS v2u* o8 = (GAS v2u*)orow + lane;
#pragma unroll
    for (int j = 0; j < 16; ++j) { const f32x4 ww = wr[64 * j]; v2u o; o.x = pk2(v[j].x * rstd * ww.x, v[j].y * rstd * ww.y); o.y = pk2(v[j].z * rstd * ww.z, v[j].w * rstd * ww.w); o8[64 * j] = o; }
}
__device__ const double ROPE_INV[16] = {
    1.0000000000000000000000000e+0,
    4.4036660267178047359198331e-1,
    1.9392274474868577334259386e-1,
    8.5397100285765611280149662e-2,
    3.7606030930863935681246092e-2,
    1.6560440080994445548947445e-2,
    7.2926647372171090477661219e-3,
    3.2114459947525910185434889e-3,
    1.4142135623730950488016887e-3,
    6.2277242191459597955502746e-4,
    2.7424817567620731825332265e-4,
    1.2076973741146503832424826e-4,
    5.3182958969449886162502429e-5,
    2.3419998961409341542188076e-5,
    1.0313385377212458859810127e-5,
    4.5416704806078696531998012e-6
};

__device__ __forceinline__ void p0_prologue(Frame& F) {
    LAS float* scr = (LAS float*)(F.lds + F.wave * 16384);
    const int gw = blockIdx.x * 8 + F.wave, NGW = F.G * 8;
    bf16* Wint = (bf16*)(F.ws + WS_WIN); bf16* H = (bf16*)(F.ws + WS_H);
    convert_one(F, scr, F.in[3], Wint, DM, INW, (DM / 64) * (INW / 32), gw, NGW);
    for (int m = gw; m < MPAD + (INWP - INW); m += NGW) {
        if (m < SEQ) rms_row_to_bf16(F.lane, F.in[0] + (size_t)m * DM, F.in[2], H + (size_t)m * DM);
        else if (m < LTOK) rms_row_to_bf16(F.lane, F.in[1] + (size_t)(m - SEQ) * DM, F.in[2], H + (size_t)m * DM);
        else { bf16* row = (m < MPAD) ? H + (size_t)m * DM : Wint + (size_t)(INW + (m - MPAD)) * DM; GAS v4u* o = (GAS v4u*)row + F.lane;
#pragma unroll
            for (int j = 0; j < 8; ++j) o[64 * j] = (v4u){0u, 0u, 0u, 0u}; }
    }
    const int gt = blockIdx.x * 512 + F.tid, NGT = F.G * 512;
    float* rope = (float*)(F.ws + WS_ROPE);
    for (int i = gt; i < LTOK * 16; i += NGT) { const int pos = i >> 4, k = i & 15;
        const double ang = (double)pos * ROPE_INV[k]; const double kq = __builtin_rint(ang * 0.15915494309189535);
        const double red = (ang - kq * 6.28318530717958623) - kq * 2.4492935982947064e-16; const float rf = (float)red;
        rope[2 * i] = cosf(rf); rope[2 * i + 1] = sinf(rf); }
    { bf16* w2t = (bf16*)(F.ws + WS_LW2); bf16* a2t = (bf16*)(F.ws + WS_LA2); bf16* g2t = (bf16*)(F.ws + WS_LG2);
      constexpr int I_L = 3 * (RC / 32), I_G = 8 * (RC / 32);
      for (int it = gw; it < 4 * I_L + I_G; it += NGW) { float wv[16];
          if (it < 4 * I_L) { const int mtx = it / I_L, r = it % I_L, dd = mtx & 1; const float* W = (mtx < 2 ? F.in[8] : F.in[10]) + (size_t)dd * 96 * RC; bf16* WT = (mtx < 2 ? w2t : a2t) + (size_t)dd * RC * 96;
              tr_issue<32>(W, RC, r, F.lane, wv); tr_finish<32>(WT, 96, RC, nullptr, 0, r, scr, F.lane, wv); }
          else { const int r = it - 4 * I_L; tr_issue<32>(F.in[11], RC, r, F.lane, wv); tr_finish<32>(g2t, 256, RC, nullptr, 0, r, scr, F.lane, wv); } } }
}

__device__ __forceinline__ int crow(int r, int hi) { return (r & 3) + 8 * (r >> 2) + 4 * hi; }
__device__ __forceinline__ void attn_phase(Frame& F, const int gw, const int NGW) {
    const bf16* Q = (const bf16*)(F.ws + WS_Q); const bf16* K = (const bf16*)(F.ws + WS_K); const bf16* Vt = (const bf16*)(F.ws + WS_VT); bf16* OA = (bf16*)(F.ws + WS_OATT);
    const float* sink = F.in[17];
    const int hh = F.lane >> 5, r = F.lane & 31;
    constexpr float SC = 0.08838834764831845f * 1.4426950408889634f, L2E = 1.4426950408889634f;
    for (int item = gw; item < 4096; item += NGW) {
        const int sub = item & 3, hq = (item >> 2) & 15, qb = item >> 6, q0 = qb * 128 + sub * 32, hk = hq >> 2;
        bf16x8 bq[8];
        { const bf16* qp = Q + (size_t)(q0 + r) * ATTW + hq * 128 + 8 * hh;
#pragma unroll
          for (int s = 0; s < 8; ++s) bq[s] = *(const bf16x8*)(qp + 16 * s); }
        f32x16 O[4];
#pragma unroll
        for (int dt = 0; dt < 4; ++dt)
#pragma unroll
            for (int i = 0; i < 16; ++i) O[dt][i] = 0.f;
        float m = sink[hq] * L2E, l = (hh == 0) ? 1.f : 0.f;
        const int tlo = (q0 >= 128) ? 0 : 4 - q0 / 32, thi = (q0 + 128 + 32 <= SEQ) ? 8 : 4 + (SEQ - 32 - q0) / 32;
        int ti = tlo;
        bf16x8 ak[8];
        { const int key0 = q0 + 32 * (ti - 4); const bf16* kp = K + (size_t)(key0 + r) * KVW + hk * 128 + 8 * hh;
#pragma unroll
          for (int s = 0; s < 8; ++s) ak[s] = *(const bf16x8*)(kp + 16 * s); }
        for (;;) {
            const bool meta = (ti == 9);
            const int key0 = meta ? SEQ : q0 + 32 * (ti - 4);
            const int tn = (ti < thi) ? ti + 1 : 9; const int keyn = (tn == 9) ? SEQ : q0 + 32 * (tn - 4);
            v2u av[4][2][2]; bf16x8 akn[8];
#pragma unroll
            for (int dt = 0; dt < 4; ++dt) { const bf16* vp = Vt + (size_t)(hk * 128 + 32 * dt + r) * MPAD + key0 + 4 * hh;
#pragma unroll
                for (int s2 = 0; s2 < 2; ++s2) { av[dt][s2][0] = *(const v2u*)(vp + 16 * s2); av[dt][s2][1] = *(const v2u*)(vp + 16 * s2 + 8); } }
            { const bf16* kp = K + (size_t)(keyn + r) * KVW + hk * 128 + 8 * hh;
#pragma unroll
              for (int s = 0; s < 8; ++s) akn[s] = *(const bf16x8*)(kp + 16 * s); }
            f32x16 st;
#pragma unroll
            for (int i = 0; i < 16; ++i) st[i] = 0.f;
#pragma unroll
            for (int s = 0; s < 8; ++s) st = __builtin_amdgcn_mfma_f32_32x32x16_bf16(ak[s], bq[s], st, 0, 0, 0);
            float tmax = -__builtin_inff();
#pragma unroll
            for (int i = 0; i < 16; ++i) { const int kr = crow(i, hh); bool ok;
                if (meta) ok = kr < NMETA; else { const int dlt = (key0 + kr) - (q0 + r); ok = (dlt >= -128) && (dlt <= 128); }
                const float t = ok ? st[i] * SC : -__builtin_inff(); st[i] = t; tmax = fmaxf(tmax, t); }
            tmax = fmaxf(tmax, __shfl_xor(tmax, 32));
            const float mn = fmaxf(m, tmax), alpha = __builtin_amdgcn_exp2f(m - mn); m = mn;
            float ps = 0.f;
#pragma unroll
            for (int i = 0; i < 16; ++i) { const float p = __builtin_amdgcn_exp2f(st[i] - mn); st[i] = p; ps += p; }
            l = l * alpha + ps;
#pragma unroll
            for (int dt = 0; dt < 4; ++dt)
#pragma unroll
                for (int i = 0; i < 16; ++i) O[dt][i] *= alpha;
            bf16x8 pb[2];
#pragma unroll
            for (int s2 = 0; s2 < 2; ++s2) { v4u w; w.x = pg8::cvt_pk_bf16(st[8 * s2 + 0], st[8 * s2 + 1]); w.y = pg8::cvt_pk_bf16(st[8 * s2 + 2], st[8 * s2 + 3]);
                w.z = pg8::cvt_pk_bf16(st[8 * s2 + 4], st[8 * s2 + 5]); w.w = pg8::cvt_pk_bf16(st[8 * s2 + 6], st[8 * s2 + 7]); pb[s2] = __builtin_bit_cast(bf16x8, w); }
#pragma unroll
            for (int dt = 0; dt < 4; ++dt)
#pragma unroll
                for (int s2 = 0; s2 < 2; ++s2) { const v4u w = {av[dt][s2][0].x, av[dt][s2][0].y, av[dt][s2][1].x, av[dt][s2][1].y};
                    O[dt] = __builtin_amdgcn_mfma_f32_32x32x16_bf16(__builtin_bit_cast(bf16x8, w), pb[s2], O[dt], 0, 0, 0); }
            if (meta) break;
            ti = tn;
#pragma unroll
            for (int s = 0; s < 8; ++s) ak[s] = akn[s];
        }
        l += __shfl_xor(l, 32);
        const float inv = 1.0f / l;
        bf16* op = OA + (size_t)(q0 + r) * ATTW + hq * 128 + 4 * hh;
#pragma unroll
        for (int dt = 0; dt < 4; ++dt)
#pragma unroll
            for (int g4 = 0; g4 < 4; ++g4) { v2u w; w.x = pg8::cvt_pk_bf16(O[dt][4 * g4 + 0] * inv, O[dt][4 * g4 + 1] * inv); w.y = pg8::cvt_pk_bf16(O[dt][4 * g4 + 2] * inv, O[dt][4 * g4 + 3] * inv);
                *(v2u*)(op + 32 * dt + 8 * g4) = w; }
    }
}

__device__ __forceinline__ int blk_tok(int d, int blk, int u) { return d ? (LTOK - 1 - 16 * blk - u) : (16 * blk + u); }
__device__ __forceinline__ size_t bo_item(int hd, int d, int blk) { return (size_t)(hd * NBT + (d ? NB0 : 0) + blk) * BO_ITEM; }
__device__ __forceinline__ v4u pack8(const float (&x)[8]) { v4u o; o.x = pk2(x[0], x[1]); o.y = pk2(x[2], x[3]); o.z = pk2(x[4], x[5]); o.w = pk2(x[6], x[7]); return o; }
__device__ __forceinline__ void blockprep_item(Frame& F, LAS unsigned char* wl, const int hd, const int d, const int blk, const int j) {
    constexpr int LP = 72;
    LAS bf16* LT = (LAS bf16*)wl; LAS float* GM = (LAS float*)wl;
    const float* Wd = (const float*)(F.ws + (d ? WS_W1 : WS_W0)); const bf16* KDd = (const bf16*)(F.ws + (d ? WS_KD1 : WS_KD0)); const bf16* Bd = (const bf16*)(F.ws + (d ? WS_B1 : WS_B0));
    const bf16* KK = (const bf16*)(F.ws + WS_KK); const bf16* RR = (const bf16*)(F.ws + WS_RR);
    float* BON = (float*)(F.ws + WS_BONUS); unsigned char* BO = F.ws + WS_BO;
    const int hh = j >> 5, r31 = j & 31, c16 = j & 15, c = hd * 64 + j;
    struct Raw { float w[16]; unsigned short kd[16], b[16], kk[16], r[16]; } cur;
#pragma unroll
    for (int u = 0; u < 16; ++u) { const size_t o = (size_t)blk_tok(d, blk, u) * RC + c; cur.w[u] = Wd[o]; cur.kd[u] = KDd[o]; cur.b[u] = Bd[o]; cur.kk[u] = KK[o]; cur.r[u] = RR[o]; }
    float kt[16], rt[16], kdh[16], bh[16]; float G15;
    { float G[16];
      { float g = 1.f;
#pragma unroll
        for (int u = 0; u < 16; ++u) { g *= cur.w[u]; G[u] = g; } }
      const float rkw = F.in[14][c];
      float bsum = 0.f;
#pragma unroll
      for (int u = 0; u < 16; ++u) { kdh[u] = bf2f(cur.kd[u]); rt[u] = bf2f(cur.r[u]); const float s = wave_sum(rt[u] * kdh[u] * rkw); bsum = (j == u) ? s : bsum;
          kdh[u] = kdh[u] / G[u]; rt[u] = rt[u] * G[u]; LT[(0 * 16 + u) * LP + j] = (bf16)f2bf(kdh[u]); LT[(3 * 16 + u) * LP + j] = (bf16)f2bf(rt[u]); }
      if (j < 16) atomicAdd(BON + (size_t)blk_tok(d, blk, j) * RH + hd, bsum);
#pragma unroll
      for (int u = 0; u < 16; ++u) { kt[u] = bf2f(cur.kk[u]) * (u ? G[u - 1] : 1.f); bh[u] = bf2f(cur.b[u]) / G[u]; LT[(2 * 16 + u) * LP + j] = (bf16)f2bf(kt[u]); LT[(1 * 16 + u) * LP + j] = (bf16)f2bf(bh[u]); }
      G15 = G[15]; }
    asm volatile("" ::: "memory");
    f32x16 gacc;
#pragma unroll
    for (int i = 0; i < 16; ++i) gacc[i] = 0.f;
    { const LAS bf16* ap = LT + ((r31 < 16 ? 0 : 1) * 16 + (r31 & 15)) * LP + 8 * hh; const LAS bf16* bp = LT + ((r31 < 16 ? 2 : 3) * 16 + (r31 & 15)) * LP + 8 * hh;
#pragma unroll
      for (int s = 0; s < 4; ++s) gacc = __builtin_amdgcn_mfma_f32_32x32x16_bf16(*(const LAS bf16x8*)(ap + 16 * s), *(const LAS bf16x8*)(bp + 16 * s), gacc, 0, 0, 0); }
    float ga[16];
#pragma unroll
    for (int i = 0; i < 16; ++i) ga[i] = gacc[i];
    asm volatile("s_waitcnt lgkmcnt(0)" ::: "memory");
#pragma unroll
    for (int i = 0; i < 16; ++i) { const int row = crow(i, hh), m = row & 15, u = r31 & 15; const bool strict = (r31 < 16);
        GM[row * 32 + r31] = (strict ? (m < u) : (m <= u)) ? ga[i] : 0.f; }
#define RL(x, ln) __builtin_bit_cast(float, __builtin_amdgcn_readlane(__builtin_bit_cast(int, (x)), (ln)))
#define GREG(m) (4 * ((m) >> 3) + ((m) & 3))
#define GLN(m) (32 * (((m) >> 2) & 1))
#define B_(m, u)  RL(ga[8 + GREG(m)], (u) + GLN(m))
    float Tr[16];
#pragma unroll
    for (int m = 15; m >= 0; --m) { float s = (c16 == m) ? 1.f : 0.f;
#pragma unroll
        for (int u = m + 1; u < 16; ++u) s -= B_(m, u) * Tr[u];
        Tr[m] = s; }
#undef RL
#undef GREG
#undef GLN
#undef B_
    unsigned char* base = BO + bo_item(hd, d, blk);
    { const int a = j >> 5, jp = j & 31;
#pragma unroll
      for (int h2 = 0; h2 < 2; ++h2) { float x0[8], x1[8];
#pragma unroll
          for (int e = 0; e < 8; ++e) { x0[e] = -bh[8 * (e >> 2) + 4 * h2 + (e & 3)] * G15; x1[e] = kdh[8 * h2 + e] * G15; }
          *(v4u*)(base + BO_FB + ((a * 2 + 0) * 64 + jp + 32 * h2) * 16) = pack8(x0); *(v4u*)(base + BO_FB + ((a * 2 + 1) * 64 + jp + 32 * h2) * 16) = pack8(x1); } }
    *(float*)(base + BO_FG + 4 * j) = G15;
    { float x[8];
#pragma unroll
      for (int e = 0; e < 8; ++e) x[e] = GM[(8 * hh + e) * 32 + r31];
      *(v4u*)(base + BO_FAA + j * 16) = pack8(x); }
    if (r31 < 16) { float x[8];
#pragma unroll
        for (int e = 0; e < 8; ++e) { const float t0 = Tr[8 * (e >> 2) + (e & 3)], t1 = Tr[8 * (e >> 2) + 4 + (e & 3)]; x[e] = hh ? t1 : t0; }
        *(v4u*)(base + BO_FT + (hh * 16 + r31) * 16) = pack8(x); }
    else { float x[8];
#pragma unroll
        for (int e = 0; e < 8; ++e) x[e] = -GM[(16 + 8 * (e >> 2) + 4 * hh + (e & 3)) * 32 + r31];
        *(v4u*)(base + BO_FBP + (hh * 16 + (r31 - 16)) * 16) = pack8(x); }
    asm volatile("s_waitcnt lgkmcnt(0)" ::: "memory");
#pragma unroll
    for (int u = 0; u < 16; ++u) { LT[u * LP + j] = (bf16)f2bf(kt[u]); LT[(16 + u) * LP + j] = (bf16)f2bf(rt[u]); }
#pragma unroll
    for (int ks = 0; ks < 4; ++ks) { const int j0 = 32 * (ks >> 1) + 16 * (ks & 1) + 4 * hh; const v2u lo = *(const LAS v2u*)(LT + r31 * LP + j0), hi = *(const LAS v2u*)(LT + r31 * LP + j0 + 8);
        *(v4u*)(base + BO_FA + (ks * 64 + j) * 16) = (v4u){lo.x, lo.y, hi.x, hi.y}; }
    asm volatile("" ::: "memory");
}

__device__ __forceinline__ int tok2row(int t) { return t < NMETA ? SEQ + t : t - NMETA; }
struct Sh8 { v4u uc, up, un; };
__device__ __forceinline__ Sh8 shift8_ld(const bf16* U, int t, int col) {
    const int tc = t < LTOK ? t : LTOK - 1, tp = (t >= 1 && t - 1 < LTOK) ? t - 1 : 0, tn = t + 1 < LTOK ? t + 1 : LTOK - 1;
    Sh8 s; s.uc = *(const v4u*)(U + (size_t)tok2row(tc) * UPITCH + col); s.up = *(const v4u*)(U + (size_t)tok2row(tp) * UPITCH + col); s.un = *(const v4u*)(U + (size_t)tok2row(tn) * UPITCH + col); return s; }
__device__ __forceinline__ void shift8_fin(const Sh8& s, int t, int col, const float* mu_p, const float* mu_n, float (&x)[8]) {
    const v4u zz = {0u, 0u, 0u, 0u};
    const v4u uc = t < LTOK ? s.uc : zz, up = (t >= 1 && t - 1 < LTOK) ? s.up : zz, un = t + 1 < LTOK ? s.un : zz;
    const f32x4 mp0 = *(const f32x4*)(mu_p + col), mp1 = *(const f32x4*)(mu_p + col + 4), mn0 = *(const f32x4*)(mu_n + col), mn1 = *(const f32x4*)(mu_n + col + 4);
    const unsigned ucw[4] = {uc.x, uc.y, uc.z, uc.w}, upw[4] = {up.x, up.y, up.z, up.w}, unw[4] = {un.x, un.y, un.z, un.w};
    const float mpw[8] = {mp0[0], mp0[1], mp0[2], mp0[3], mp1[0], mp1[1], mp1[2], mp1[3]}, mnw[8] = {mn0[0], mn0[1], mn0[2], mn0[3], mn1[0], mn1[1], mn1[2], mn1[3]};
#pragma unroll
    for (int e = 0; e < 8; ++e) { const float c0 = (e & 1) ? bfhi(ucw[e >> 1]) : bflo(ucw[e >> 1]), p0 = (e & 1) ? bfhi(upw[e >> 1]) : bflo(upw[e >> 1]), n0 = (e & 1) ? bfhi(unw[e >> 1]) : bflo(unw[e >> 1]);
        x[e] = c0 + mpw[e] * (p0 - c0) + mnw[e] * (n0 - c0); }
}
__device__ __forceinline__ void flush_bf16(const LAS bf16* tile, bf16* ARR, int t0, int cbase, int lane) {
#pragma unroll
    for (int h = 0; h < 2; ++h) { const int row = (lane >> 2) + 16 * h, ch = lane & 3; const v4u v = *(const LAS v4u*)(tile + row * 32 + 8 * ch);
        if (t0 + row < LTOK) *(v4u*)(ARR + (size_t)(t0 + row) * RC + cbase + 8 * ch) = v; }
}
__device__ __forceinline__ void flush_f32(const LAS float* tile, float* ARR, int t0, int cbase, int lane) {
#pragma unroll
    for (int h = 0; h < 4; ++h) { const int row = (lane >> 3) + 8 * h, ch = lane & 7; const f32x4 v = *(const LAS f32x4*)(tile + row * 32 + 4 * ch);
        if (t0 + row < LTOK) *(f32x4*)(ARR + (size_t)(t0 + row) * RC + cbase + 4 * ch) = v; }
}
__device__ __forceinline__ void prep_phase(Frame& F) {
    constexpr int XS = 648;
    LAS bf16* Xs = (LAS bf16*)F.lds;
    LAS unsigned char* wl = F.lds + 41472 + F.wave * 9216;
    LAS bf16* Kt = (LAS bf16*)wl;
    LAS bf16* Ot = Kt + 2048;
    const bf16* U = (const bf16*)(F.ws + WS_U);
    const float* mu_p = F.in[5]; const float* mu_n = F.in[6];
    const bf16* w2t = (const bf16*)(F.ws + WS_LW2); const bf16* a2t = (const bf16*)(F.ws + WS_LA2); const bf16* g2t = (const bf16*)(F.ws + WS_LG2);
    float* W0 = (float*)(F.ws + WS_W0); float* W1 = (float*)(F.ws + WS_W1);
    bf16* KD0 = (bf16*)(F.ws + WS_KD0); bf16* KD1 = (bf16*)(F.ws + WS_KD1); bf16* B0 = (bf16*)(F.ws + WS_B0); bf16* B1 = (bf16*)(F.ws + WS_B1);
    bf16* KK = (bf16*)(F.ws + WS_KK); bf16* RR = (bf16*)(F.ws + WS_RR); bf16* VV = (bf16*)(F.ws + WS_VV); bf16* GG = (bf16*)(F.ws + WS_GG);
    const int hh = F.lane >> 5, r = F.lane & 31;
    for (int unit = blockIdx.x; unit < 257 * 4; unit += F.G) {
        const int tt = unit >> 2, t0 = tt * 32, hd = (unit & 3) * 8 + F.wave;
        __syncthreads();
        FPB0(15);
        { Sh8 sx[5];
#pragma unroll
          for (int it = 0; it < 5; ++it) { const int ci = F.tid + 512 * it; sx[it] = shift8_ld(U, t0 + ci / 80, 3 * RC + 8 * (ci % 80)); }
#pragma unroll
          for (int it = 0; it < 5; ++it) { const int ci = F.tid + 512 * it, tl = ci / 80, ch = ci % 80;
            float x[8]; shift8_fin(sx[it], t0 + tl, 3 * RC + 8 * ch, mu_p, mu_n, x);
#pragma unroll
            for (int e = 0; e < 8; ++e) { float v = x[e];
                if (ch < 24) { const float ex = __expf(2.0f * v); v = 1.0f - 2.0f / (ex + 1.0f); }
                else if (ch >= 48) v = sigmoidf_(v);
                x[e] = v; }
            v4u o; o.x = pk2(x[0], x[1]); o.y = pk2(x[2], x[3]); o.z = pk2(x[4], x[5]); o.w = pk2(x[6], x[7]);
            *(LAS v4u*)(Xs + tl * XS + 8 * ch) = o; } }
        { const int c8 = hd * 64 + 8 * (F.lane & 7);
#pragma unroll
          for (int st = 0; st < 3; ++st) { const int col = (st == 0 ? RC : st == 1 ? 0 : 2 * RC) + c8; Sh8 sq[4];
#pragma unroll
            for (int q = 0; q < 4; ++q) sq[q] = shift8_ld(U, t0 + (F.lane >> 3) + 8 * q, col);
#pragma unroll
            for (int q = 0; q < 4; ++q) { const int tl = (F.lane >> 3) + 8 * q, tq = t0 + tl; float x[8]; shift8_fin(sq[q], tq, col, mu_p, mu_n, x);
                v4u o; o.x = pk2(x[0], x[1]); o.y = pk2(x[2], x[3]); o.z = pk2(x[4], x[5]); o.w = pk2(x[6], x[7]);
                if (st == 0) *(LAS v4u*)(Kt + tl * 64 + 8 * (F.lane & 7)) = o;
                else if (tq < LTOK) *(v4u*)((st == 1 ? RR : VV) + (size_t)tq * RC + c8) = o; } } }
        __syncthreads();
        FPB1(15); FPB0(16);
        float kp[2][16], ss[16];
#pragma unroll
        for (int i = 0; i < 16; ++i) ss[i] = 0.f;
#pragma unroll
        for (int ct = 0; ct < 2; ++ct) { const int c = hd * 64 + 32 * ct + r; const float kkw = F.in[12][c];
#pragma unroll
            for (int i = 0; i < 16; ++i) { kp[ct][i] = bf2f(Kt[crow(i, hh) * 64 + 32 * ct + r]); const float kr = kp[ct][i] * kkw; ss[i] += kr * kr; } }
#pragma unroll
        for (int i = 0; i < 16; ++i) {
#pragma unroll
            for (int o = 1; o < 32; o <<= 1) ss[i] += __shfl_xor(ss[i], o);
            ss[i] = 1.0f / fmaxf(sqrtf(ss[i]), 1e-12f); }
#define LDF(dst, ptr, n) do { _Pragma("unroll") for (int s_ = 0; s_ < (n); ++s_) dst[s_] = *(const bf16x8*)((ptr) + 16 * s_); } while (0)
#define MMF(frag, xoff, n) do { _Pragma("unroll") for (int i_ = 0; i_ < 16; ++i_) acc[i_] = 0.f; const LAS bf16* ap_ = Xs + r * XS + (xoff) + 8 * hh; \
            _Pragma("unroll") for (int s_ = 0; s_ < (n); ++s_) acc = __builtin_amdgcn_mfma_f32_32x32x16_bf16(*(const LAS bf16x8*)(ap_ + 16 * s_), frag[s_], acc, 0, 0, 0); } while (0)
#pragma unroll
        for (int ct = 0; ct < 2; ++ct) {
            const int c = hd * 64 + 32 * ct + r, cb = hd * 64 + 32 * ct;
            const float kkw = F.in[12][c], kaw = F.in[13][c];
            const bf16* pa0 = a2t + (size_t)c * 96 + 8 * hh; const bf16* pa1 = a2t + ((size_t)RC + c) * 96 + 8 * hh;
            const bf16* pw0 = w2t + (size_t)c * 96 + 8 * hh; const bf16* pw1 = w2t + ((size_t)RC + c) * 96 + 8 * hh; const bf16* pg = g2t + (size_t)c * 256 + 8 * hh;
            bf16x8 fa[6], fg[16]; f32x16 acc; float kk[16];
            LDF(fa, pa0, 6);
#pragma unroll
            for (int i = 0; i < 16; ++i) { kk[i] = kp[ct][i] * kkw * ss[i]; Ot[crow(i, hh) * 32 + r] = (bf16)f2bf(kk[i]); }
            flush_bf16(Ot, KK, t0, cb, F.lane);
#pragma unroll
            for (int d = 0; d < 2; ++d) {
                if (d == 0) { MMF(fa, 192, 6); LDF(fa, pa1, 6); } else { MMF(fa, 288, 6); LDF(fa, pw0, 6); }
                const float a0 = F.in[9][d * RC + c];
#pragma unroll
                for (int i = 0; i < 16; ++i) { acc[i] = sigmoidf_(a0 + acc[i]); Ot[crow(i, hh) * 32 + r] = (bf16)f2bf(kp[ct][i] * (1.0f + (acc[i] - 1.0f) * kaw)); }
                flush_bf16(Ot, d ? KD1 : KD0, t0, cb, F.lane);
#pragma unroll
                for (int i = 0; i < 16; ++i) Ot[crow(i, hh) * 32 + r] = (bf16)f2bf(kk[i] * acc[i]);
                flush_bf16(Ot, d ? B1 : B0, t0, cb, F.lane);
            }
#pragma unroll
            for (int d = 0; d < 2; ++d) {
                if (d == 0) { MMF(fa, 0, 6); LDF(fa, pw1, 6); } else { MMF(fa, 96, 6); LDF(fg, pg, 16); }
                const float w0 = F.in[7][d * RC + c]; LAS float* Of = (LAS float*)Ot;
#pragma unroll
                for (int i = 0; i < 16; ++i) Of[crow(i, hh) * 32 + r] = __expf(-0.6065306597126334f * sigmoidf_(w0 + acc[i]));
                flush_f32(Of, d ? W1 : W0, t0, cb, F.lane);
            }
            MMF(fg, 384, 16);
#pragma unroll
            for (int i = 0; i < 16; ++i) Ot[crow(i, hh) * 32 + r] = (bf16)f2bf(acc[i]);
            flush_bf16(Ot, GG, t0, cb, F.lane);
        }
#undef LDF
#undef MMF
        asm volatile("s_waitcnt vmcnt(0) lgkmcnt(0)" ::: "memory");
#pragma unroll 1
        for (int q = 0; q < 4; ++q) { const int d = q >> 1, half = q & 1; const int blk = d ? (NB1 - 2 * tt - half) : (2 * tt + half);
            int lzq; asm volatile("v_mov_b32 %0, 0" : "=v"(lzq));
            if (blk >= 0 && blk < (d ? NB1 : NB0)) blockprep_item(F, wl, hd, d, blk, F.lane + lzq); }
        FPB1(16);
    }
    __syncthreads();
}

constexpr int N_SCAN_WAVES = 128;
constexpr int SR_SLOTS = 8, SR_STRIDE = 12288, SR_FV = 11264, SR_FLAGS = SR_SLOTS * SR_STRIDE, SR_WSCR = SR_FLAGS + 512, SR_NL = 4;
static_assert(SR_WSCR + (7 - SR_NL) * 8448 <= RING_BYTES, "scan phase LDS map");
struct LdSet { v4u p[11]; unsigned short v[8]; };
__device__ __forceinline__ void sr_issue(LdSet& s, const unsigned char* item, const bf16* VV, int hd, int d, int blk, int ih, int lane) {
#pragma unroll
    for (int k = 0; k < 11; ++k) { const int pc = k * 64 + lane; s.p[k] = *(const v4u*)(item + (pc < BO_ITEM / 16 ? pc : BO_ITEM / 16 - 1) * 16); }
    const int hh = lane >> 5, il = lane & 31;
#pragma unroll
    for (int e = 0; e < 8; ++e) s.v[e] = VV[(size_t)blk_tok(d, blk, 8 * hh + e) * RC + hd * 64 + 32 * ih + il];
}
__device__ __forceinline__ void sr_write(const LdSet& s, LAS unsigned char* slot, int lane) {
#pragma unroll
    for (int k = 0; k < 11; ++k) *(LAS v4u*)(slot + (k * 64 + lane) * 16) = s.p[k];
    const v4u vw = {(unsigned)s.v[0] | ((unsigned)s.v[1] << 16), (unsigned)s.v[2] | ((unsigned)s.v[3] << 16), (unsigned)s.v[4] | ((unsigned)s.v[5] << 16), (unsigned)s.v[6] | ((unsigned)s.v[7] << 16)};
    *(LAS v4u*)(slot + SR_FV + lane * 16) = vw;
}
__device__ __forceinline__ bf16x8 pack_half(const f32x16& x, int s) {
    const v4u w = {pk2(x[8 * s + 0], x[8 * s + 1]), pk2(x[8 * s + 2], x[8 * s + 3]), pk2(x[8 * s + 4], x[8 * s + 5]), pk2(x[8 * s + 6], x[8 * s + 7])}; return __builtin_bit_cast(bf16x8, w); }
__device__ __forceinline__ void scan_phase(Frame& F) {
    const bf16* VV = (const bf16*)(F.ws + WS_VV); bf16* Y = (bf16*)(F.ws + WS_Y); const unsigned char* BO = F.ws + WS_BO;
    const bool sblock = (int)blockIdx.x < N_SCAN_WAVES;
    volatile LAS unsigned* FL = (volatile LAS unsigned*)(F.lds + SR_FLAGS);
    constexpr unsigned SPIN_CAP = 1u << 22;
    __syncthreads();
    if (F.tid < 128) FL[F.tid] = 0u;
    __syncthreads();
    const int pair = (int)blockIdx.x >> 1, ih = (int)blockIdx.x & 1, hd = pair >> 1, d = pair & 1, nblk = d ? NB1 : NB0, hh = F.lane >> 5, il = F.lane & 31;
    if (sblock && F.wave == 0) {
        __builtin_amdgcn_s_setprio(3);
        f32x16 St[2];
#pragma unroll
        for (int a = 0; a < 2; ++a)
#pragma unroll
            for (int i = 0; i < 16; ++i) St[a][i] = 0.f;
        FPB0(17);
        const unsigned long long scan_t0 = ((PROBE_PHASE >> 21) & 1) ? __builtin_amdgcn_s_memrealtime() : 0ull;
        for (int blk = 0; blk < nblk; ++blk) {
            const int sl = blk % SR_SLOTS; const LAS unsigned char* slot = F.lds + sl * SR_STRIDE;
            { unsigned sp = 0; while (FL[sl] != (unsigned)(blk + 1)) { __builtin_amdgcn_s_sleep(1); if (++sp > SPIN_CAP) break; } }
            asm volatile("" ::: "memory");
            bf16x8 fa[4], fb[2][2]; f32x4 gm[2][4];
#pragma unroll
            for (int ks = 0; ks < 4; ++ks) fa[ks] = *(const LAS bf16x8*)(slot + BO_FA + (ks * 64 + F.lane) * 16);
            const bf16x8 faa = *(const LAS bf16x8*)(slot + BO_FAA + F.lane * 16), vf = *(const LAS bf16x8*)(slot + SR_FV + F.lane * 16);
            bf16x8 ft = *(const LAS bf16x8*)(slot + BO_FT + (hh * 16 + (il & 15)) * 16), fbp = *(const LAS bf16x8*)(slot + BO_FBP + (hh * 16 + (il & 15)) * 16);
            { const bf16x8 zz = {0, 0, 0, 0, 0, 0, 0, 0}; ft = (il < 16) ? ft : zz; fbp = (il >= 16) ? fbp : zz; }
#pragma unroll
            for (int a = 0; a < 2; ++a)
#pragma unroll
                for (int k = 0; k < 2; ++k) fb[a][k] = *(const LAS bf16x8*)(slot + BO_FB + ((a * 2 + k) * 64 + F.lane) * 16);
#pragma unroll
            for (int a = 0; a < 2; ++a)
#pragma unroll
                for (int q = 0; q < 4; ++q) gm[a][q] = *(const LAS f32x4*)(slot + BO_FG + (32 * a + 8 * q + 4 * hh) * 4);
            asm volatile("s_waitcnt lgkmcnt(0)" ::: "memory");
            if (F.lane == 0) FL[16] = (unsigned)(blk + 1);
            f32x16 acc, accp;
#pragma unroll
            for (int i = 0; i < 16; ++i) { acc[i] = 0.f; accp[i] = 0.f; }
            acc = __builtin_amdgcn_mfma_f32_32x32x16_bf16(faa, vf, acc, 0, 0, 0);
#pragma unroll
            for (int a = 0; a < 2; ++a)
#pragma unroll
                for (int s = 0; s < 2; ++s) acc = __builtin_amdgcn_mfma_f32_32x32x16_bf16(fa[2 * a + s], pack_half(St[a], s), acc, 0, 0, 0);
            accp = __builtin_amdgcn_mfma_f32_32x32x16_bf16(ft, pack_half(acc, 0), accp, 0, 0, 0);
            const bf16x8 pb = pack_half(accp, 0);
            acc = __builtin_amdgcn_mfma_f32_32x32x16_bf16(fbp, pb, acc, 0, 0, 0);
#pragma unroll
            for (int e = 0; e < 8; ++e) { const int u = 8 * (e >> 2) + 4 * hh + (e & 3);
                Y[((size_t)d * LTOK + blk_tok(d, blk, u)) * RC + hd * 64 + 32 * ih + il] = (bf16)f2bf(acc[8 + e]); }
#pragma unroll
            for (int a = 0; a < 2; ++a) {
#pragma unroll
                for (int i = 0; i < 16; ++i) St[a][i] *= gm[a][i >> 2][i & 3];
                St[a] = __builtin_amdgcn_mfma_f32_32x32x16_bf16(fb[a][0], pb, St[a], 0, 0, 0);
                St[a] = __builtin_amdgcn_mfma_f32_32x32x16_bf16(fb[a][1], vf, St[a], 0, 0, 0);
            }
        }
        FPB1(17);
        if ((PROBE_PHASE >> 21) & 1) { if (F.lane == 0) atomicMax((unsigned*)(F.ctl + 2048), (unsigned)(__builtin_amdgcn_s_memrealtime() - scan_t0)); }
        __builtin_amdgcn_s_setprio(0);
    } else if (sblock && F.wave <= SR_NL) {
        const int lw = F.wave - 1;
        LdSet st[2];
#define SR_PUT(set, b_) do { const int sl_ = (b_) % SR_SLOTS; if ((b_) >= SR_SLOTS) { unsigned sp_ = 0; while (FL[16] < (unsigned)((b_) - SR_SLOTS + 1)) { __builtin_amdgcn_s_sleep(1); if (++sp_ > SPIN_CAP) break; } } \
            asm volatile("" ::: "memory"); sr_write(set, F.lds + sl_ * SR_STRIDE, F.lane); asm volatile("s_waitcnt lgkmcnt(0)" ::: "memory"); if (F.lane == 0) FL[sl_] = (unsigned)((b_) + 1); } while (0)
#pragma unroll
        for (int k = 0; k < 2; ++k) { const int bb = lw + SR_NL * k; if (bb < nblk) sr_issue(st[k], BO + bo_item(hd, d, bb), VV, hd, d, bb, ih, F.lane); }
        for (int b0 = lw; b0 < nblk; b0 += 2 * SR_NL) {
#pragma unroll
            for (int k = 0; k < 2; ++k) { const int bb = b0 + SR_NL * k; if (bb < nblk) { SR_PUT(st[k], bb); const int nb = bb + 2 * SR_NL; if (nb < nblk) sr_issue(st[k], BO + bo_item(hd, d, nb), VV, hd, d, nb, ih, F.lane); } }
        }
#undef SR_PUT
    } else {
        const int b = (int)blockIdx.x, nsb = F.G < N_SCAN_WAVES ? F.G : N_SCAN_WAVES, wps = 7 - SR_NL;
        const int widx = b < N_SCAN_WAVES ? b * wps + (F.wave - 1 - SR_NL) : nsb * wps + (b - N_SCAN_WAVES) * 8 + F.wave;
        const int NWK = nsb * wps + (F.G - nsb) * 8;
        unsigned long long rp0 = 0, rp1 = 0, rp2 = 0;
        if (PROBE_PHASE & ((3 << 18) | (1 << 22))) rp0 = __builtin_amdgcn_s_memrealtime();
        LAS float* scr = (LAS float*)(F.lds + (sblock ? SR_WSCR + (F.wave - 1 - SR_NL) * 8448 : F.wave * 8448));
        attn_phase(F, widx, NWK);
        if (PROBE_PHASE & (3 << 18)) rp1 = __builtin_amdgcn_s_memrealtime();
        convert_p4(F, scr, widx, NWK, sblock ? -1 : (b - N_SCAN_WAVES) * 8 + F.wave, (F.G - nsb) * 8);
        if (PROBE_PHASE & (3 << 18)) { rp2 = __builtin_amdgcn_s_memrealtime(); if ((int)blockIdx.x == F.G - 1 && F.tid == 0) { unsigned long long v = 0; if ((PROBE_PHASE >> 18) & 1) v += rp1 - rp0; if ((PROBE_PHASE >> 19) & 1) v += rp2 - rp1;
            __hip_atomic_store((unsigned*)(F.ctl + 2048), (unsigned)v, __ATOMIC_RELAXED, __HIP_MEMORY_SCOPE_AGENT); } }
        if ((PROBE_PHASE >> 22) & 1) { if (blockIdx.x == 0 && F.wave == 5 && F.lane == 0) __hip_atomic_store((unsigned*)(F.ctl + 2048), (unsigned)(__builtin_amdgcn_s_memrealtime() - rp0), __ATOMIC_RELAXED, __HIP_MEMORY_SCOPE_AGENT); }
    }
}

__device__ __forceinline__ float row16_sum(float x) {
    x += __builtin_bit_cast(float, __builtin_amdgcn_update_dpp(0, __builtin_bit_cast(int, x), 0xB1, 0xf, 0xf, true));
    x += __builtin_bit_cast(float, __builtin_amdgcn_update_dpp(0, __builtin_bit_cast(int, x), 0x4E, 0xf, 0xf, true));
    x += __builtin_bit_cast(float, __builtin_amdgcn_update_dpp(0, __builtin_bit_cast(int, x), 0x141, 0xf, 0xf, true));
    x += __builtin_bit_cast(float, __builtin_amdgcn_update_dpp(0, __builtin_bit_cast(int, x), 0x140, 0xf, 0xf, true));
    return x;
}
__device__ __forceinline__ void combine_phase(Frame& F) {
    const bf16* Y0 = (const bf16*)(F.ws + WS_Y); const bf16* Y1 = Y0 + (size_t)LTOK * RC; const float* BON = (const float*)(F.ws + WS_BONUS);
    const bf16* VV = (const bf16*)(F.ws + WS_VV); const bf16* GG = (const bf16*)(F.ws + WS_GG);
    bf16* OR = (bf16*)(F.ws + WS_ORWKV);
    const float* lnw = F.in[15]; const float* lnb = F.in[16];
    const int gw = blockIdx.x * 8 + F.wave, NGW = F.G * 8;
    for (int row = gw; row < SEQ; row += NGW) { const int t = row + NMETA;
#pragma unroll
        for (int st = 0; st < 8; ++st) { const int c = st * 256 + 4 * F.lane, hd = c >> 6; const size_t o = (size_t)t * RC + c;
            const v2u a0 = *(const v2u*)(Y0 + o), a1 = *(const v2u*)(Y1 + o), vv = *(const v2u*)(VV + o), gg = *(const v2u*)(GG + o);
            const f32x4 w = *(const f32x4*)(lnw + c), bb = *(const f32x4*)(lnb + c); const float bon = BON[(size_t)t * RH + hd];
            float y[4] = {bflo(a0.x) + bflo(a1.x), bfhi(a0.x) + bfhi(a1.x), bflo(a0.y) + bflo(a1.y), bfhi(a0.y) + bfhi(a1.y)};
            const float mean = row16_sum((y[0] + y[1]) + (y[2] + y[3])) * (1.0f / 64.0f);
#pragma unroll
            for (int e = 0; e < 4; ++e) y[e] -= mean;
            const float var = row16_sum((y[0] * y[0] + y[1] * y[1]) + (y[2] * y[2] + y[3] * y[3])) * (1.0f / 64.0f);
            const float rs = __builtin_amdgcn_rsqf(var + GN_EPS);
            const float v4[4] = {bflo(vv.x), bfhi(vv.x), bflo(vv.y), bfhi(vv.y)}, g4[4] = {bflo(gg.x), bfhi(gg.x), bflo(gg.y), bfhi(gg.y)};
            float ov[4];
#pragma unroll
            for (int e = 0; e < 4; ++e) ov[e] = (y[e] * rs * w[e] + bb[e] + bon * v4[e]) * g4[e];
            v2u ow; ow.x = pk2(ov[0], ov[1]); ow.y = pk2(ov[2], ov[3]);
            *(v2u*)(OR + (size_t)row * RC + c) = ow; } }
}
__device__ __forceinline__ void final_phase(Frame& F) {
    const float* SS3 = (const float*)(F.ctl + CW_SS3); const float* w = F.in[25];
    const int gw = blockIdx.x * 8 + F.wave, NGW = F.G * 8;
    for (int row = gw; row < SEQ; row += NGW) { const float rstd = 1.0f / sqrtf(SS3[row] * (1.0f / DM) + RMS_EPS);
        GAS f32x4* p = (GAS f32x4*)(F.out + (size_t)row * DM) + F.lane; const GAS f32x4* wp = (const GAS f32x4*)w + F.lane;
#pragma unroll
        for (int j = 0; j < 16; ++j) { const f32x4 v = p[64 * j], ww = wp[64 * j]; p[64 * j] = v * rstd * ww; } }
}
constexpr int N_PHASES = 10;
struct Args { const float* in[26]; float* out; unsigned char* ws; int ph_lo, ph_hi; };
__global__ void __launch_bounds__(512, 2) fwd_kernel(Args args) {
    extern __shared__ __attribute__((aligned(16))) unsigned char lds[];
    Frame F;
    F.lds = (LAS unsigned char*)lds;
    F.MISC = (volatile LAS unsigned*)(F.lds + MISC_OFF);
    F.tid = threadIdx.x; F.lane = F.tid & 63; F.wave = __builtin_amdgcn_readfirstlane(F.tid >> 6); F.G = gridDim.x;
    F.ws = args.ws; F.ctl = (gu32*)(args.ws + WS_CTL); F.out = args.out; F.pb0 = 0; F.pacc = 0; F.pacc2 = 0;
#pragma unroll
    for (int i = 0; i < 26; ++i) F.in[i] = args.in[i];
    for (int u = F.tid; u < (LDS_BYTES - LDSCTL_OFF) / 4; u += 512) ((LAS unsigned*)(F.lds + LDSCTL_OFF))[u] = 0u;
    __syncthreads();
    XcdBarrier bar; bar.bar = (unsigned*)(F.ctl + CW_BAR); bar.x = 0; bar.st = nullptr;
    if (!MK_SPLIT) bar = xcd_barrier_post((unsigned*)(F.ctl + CW_BAR), F.MISC + 8);
    const int lo = args.ph_lo, hi = args.ph_hi;
#define IN(k) (lo <= (k) && (k) < hi)
#define SEAM(k) do { if (IN(k) && IN((k) + 1)) xcd_barrier(bar); } while (0)
    bf16* Rm = (bf16*)(F.ws + WS_H);
    float* SS2 = (float*)(F.ctl + CW_SS2); float* SS3 = (float*)(F.ctl + CW_SS3);

    unsigned long long pt0 = 0, pt1 = 0;
#define PB0(k) do { if ((PROBE_PHASE >> (k)) & 1) pt0 = __builtin_amdgcn_s_memrealtime(); } while (0)
#define PB1(k) do { if ((PROBE_PHASE >> (k)) & 1) pt1 += __builtin_amdgcn_s_memrealtime() - pt0; } while (0)
    PB0(0); if (IN(0)) { p0_prologue(F); } SEAM(0); PB1(0);
    PB0(1); if (IN(1)) {
        pg8::Gemm g{Rm, Rm, MPAD + INWP, MPAD + INWP, DM}; pg8::InOrder S; S.init(F.G, (int)blockIdx.x);
        pg8::EpiIn E{(bf16*)(F.ws + WS_G), (bf16*)(F.ws + WS_Q), (bf16*)(F.ws + WS_K), (bf16*)(F.ws + WS_VT), (bf16*)(F.ws + WS_U), F.in[4], (const float*)(F.ws + WS_ROPE)};
        pg8::gemm_phase<pg8::EpiIn, pg8::InOrder, true, true>(F.lds, g, S, E, F.pacc2);
    } SEAM(1); PB1(1);
    PB0(2); if (IN(2)) { prep_phase(F); } SEAM(2); PB1(2);
    PB0(3); if (IN(3)) { scan_phase(F); } SEAM(3); PB1(3);
    PB0(4); if (IN(4)) { combine_phase(F); } SEAM(4); PB1(4);
    PB0(5); if (IN(5)) {
        { pg8::Gemm g{(const bf16*)(F.ws + WS_OATT), (const bf16*)(F.ws + WS_WPA), SEQ, DM, ATTW}; pg8::StaticOrder S; S.init(SEQ, DM, F.G, (int)blockIdx.x);
          pg8::EpiProjA E{(bf16*)(F.ws + WS_P1), (const bf16*)(F.ws + WS_G)};
          pg8::gemm_phase<pg8::EpiProjA, pg8::StaticOrder, true, true>(F.lds, g, S, E, F.pacc2); }
        __syncthreads();
        { pg8::Gemm g{(const bf16*)(F.ws + WS_ORWKV), (const bf16*)(F.ws + WS_WPR), SEQ, DM, RC}; pg8::StaticOrder S; S.init(SEQ, DM, F.G, (int)blockIdx.x);
          pg8::EpiProjB E{(const bf16*)(F.ws + WS_P1), (const bf16*)(F.ws + WS_G), (bf16*)(F.ws + WS_MX)};
          pg8::gemm_phase<pg8::EpiProjB, pg8::StaticOrder, true, true>(F.lds, g, S, E, F.pacc2); }
    } SEAM(5); PB1(5);
    PB0(6); if (IN(6)) {
        pg8::Gemm g{(const bf16*)(F.ws + WS_MX), (const bf16*)(F.ws + WS_WOUT), SEQ, DM, DM}; pg8::StaticOrder S; S.init(SEQ, DM, F.G, (int)blockIdx.x);
        pg8::EpiResid<false> E{F.in[0], nullptr, nullptr, (bf16*)(F.ws + WS_A2), SS2};
        pg8::gemm_phase<pg8::EpiResid<false>, pg8::StaticOrder, true, true>(F.lds, g, S, E, F.pacc2);
    } SEAM(6); PB1(6);
    const unsigned long long epi_before7 = F.pacc2;
    PB0(7); if (IN(7)) {
        pg8::Gemm g{(const bf16*)(F.ws + WS_A2), (const bf16*)(F.ws + WS_WGU), SEQ, 2 * DFF, DM}; pg8::StaticOrder S; S.init(SEQ, 2 * DFF, F.G, (int)blockIdx.x);
        pg8::EpiSwiGLU E{(bf16*)(F.ws + WS_HID), SS2};
        pg8::gemm_phase<pg8::EpiSwiGLU, pg8::StaticOrder, true, true>(F.lds, g, S, E, F.pacc2);
        {
          const int nun = (SEQ / 256) * (2 * DFF / 256), rounds = (nun + F.G - 1) / F.G, first_idle = nun - (rounds - 1) * F.G;
          const int nidle = F.G - first_idle;
          if (nidle > 0) { if ((int)blockIdx.x >= first_idle) convert_wd(F, (LAS float*)(F.lds + F.wave * 8448), ((int)blockIdx.x - first_idle) * 8 + F.wave, nidle * 8); }
          else convert_wd(F, (LAS float*)(F.lds + F.wave * 8448), (int)blockIdx.x * 8 + F.wave, F.G * 8); }
    } SEAM(7); PB1(7);
    const unsigned long long epi_before8 = F.pacc2;
    PB0(8); if (IN(8)) {
        pg8::Gemm g{(const bf16*)(F.ws + WS_HID), (const bf16*)(F.ws + WS_WD), SEQ, DM, DFF}; pg8::StaticOrder S; S.init(SEQ, DM, F.G, (int)blockIdx.x);
        pg8::EpiResid<true> E{nullptr, (const bf16*)(F.ws + WS_A2), F.out, nullptr, SS3};
        pg8::gemm_phase<pg8::EpiResid<true>, pg8::StaticOrder, true, true>(F.lds, g, S, E, F.pacc2);
    } SEAM(8); PB1(8);
    const unsigned long long epi9 = ((PROBE_PHASE >> 24) & 1) ? (epi_before8 - epi_before7) : (F.pacc2 - epi_before8);
    PB0(9); if (IN(9)) { final_phase(F); } PB1(9);
    if (PROBE_PHASE != 0 && blockIdx.x == 0 && F.tid == 0) { const unsigned long long te = __builtin_amdgcn_s_memrealtime(), want = (unsigned long long)PROBE_MULT * (((PROBE_PHASE >> 23) & 1) ? epi9 : ((PROBE_PHASE >> 20) & 1) ? F.pacc2 : (PROBE_PHASE & ((3 << 18) | (3 << 21))) ? (unsigned long long)__hip_atomic_load((unsigned*)(F.ctl + 2048), __ATOMIC_RELAXED, __HIP_MEMORY_SCOPE_AGENT) : (pt1 + F.pacc));
        while (__builtin_amdgcn_s_memrealtime() - te < want && want < 2000000ull) __builtin_amdgcn_s_sleep(32); }
#undef PB0
#undef PB1
#undef IN
#undef SEAM
}

extern "C" void kernel_launch(void* const* d_in, const int* in_sizes, int n_in, void* d_out, int out_size, void* d_ws, size_t ws_size, hipStream_t stream) {
    static int grid = 0;
    if (grid == 0) {
        if (n_in != 26 || out_size != SEQ * DM || ws_size < WS_END) { fprintf(stderr, "kernel_launch: unexpected shapes (n_in %d, out %d, ws %zu, need %zu); nothing launched\n", n_in, out_size, ws_size, (size_t)WS_END); grid = -1; return; }
        int dev = 0, cus = 0, per_cu = 0;
        if (hipGetDevice(&dev) != hipSuccess || hipDeviceGetAttribute(&cus, hipDeviceAttributeMultiprocessorCount, dev) != hipSuccess) { grid = -1; return; }
        if (hipFuncSetAttribute((const void*)fwd_kernel, hipFuncAttributeMaxDynamicSharedMemorySize, LDS_BYTES) != hipSuccess) { fprintf(stderr, "kernel_launch: hipFuncSetAttribute failed\n"); grid = -1; return; }
        if (hipOccupancyMaxActiveBlocksPerMultiprocessor(&per_cu, (const void*)fwd_kernel, 512, LDS_BYTES) != hipSuccess || per_cu < 1) fprintf(stderr, "kernel_launch: occupancy query says %d per CU\n", per_cu);
        (void)hipGetLastError();
        grid = cus;
    }
    if (grid < 0) return;
    if (hipMemsetAsync((char*)d_ws + WS_CTL, 0, ZERO_BYTES, stream) != hipSuccess) return;
    Args a{};
    for (int i = 0; i < 26; ++i) a.in[i] = (const float*)d_in[i];
    a.out = (float*)d_out; a.ws = (unsigned char*)d_ws;
#if MK_SPLIT
    for (int p = 0; p < N_PHASES; ++p) { a.ph_lo = p; a.ph_hi = p + 1; hipLaunchKernelGGL(fwd_kernel, dim3(grid), dim3(512), LDS_BYTES, stream, a); }
#else
    a.ph_lo = 0; a.ph_hi = N_PHASES;
    hipLaunchKernelGGL(fwd_kernel, dim3(grid), dim3(512), LDS_BYTES, stream, a);
#endif
}
```

```cpp
#include <hip/hip_runtime.h>
#include <cstdio>
#include <cstdint>

#ifndef MK_SPLIT
#define MK_SPLIT 0
#endif

#ifndef PROBE_PHASE
#define PROBE_PHASE 0
#endif
#ifndef PROBE_MULT
#define PROBE_MULT 2
#endif
constexpr int NMETA = 16, SEQ = 8192, LTOK = 8208, DM = 4096, MPAD = 8448;
constexpr int INW = 18048, INWP = 18176;
constexpr int ATTW = 2048, KVW = 512, UW = 6784, UPITCH = 6912;
constexpr int RC = 2048, RH = 32, RN = 64;
constexpr int DFF = 11008;
constexpr float RMS_EPS = 1e-6f, GN_EPS = 64e-5f;
constexpr int HT = MPAD / 256;
constexpr int CT_Q = 32, CT_K = 40, CT_V = 42, CT_U = 44, CT_N = 71;

namespace pg8 {
#define PG8_LAS __attribute__((address_space(3)))
typedef unsigned short bf16_t;
typedef short bf16x8 __attribute__((ext_vector_type(8)));
typedef float f32x4 __attribute__((ext_vector_type(4)));
typedef unsigned u32x4 __attribute__((ext_vector_type(4)));
constexpr int BM = 256, BK = 64, HALF = 128, HTB = HALF * BK * 2  , STAGE_BYTES = 8 * HTB, NXCD = 8, WGM = 8;

__host__ __device__ __forceinline__ int lds_byte(int r, int c) { const int st = (r >> 4) * 2 + (c >> 5), rr = r & 15, cc = c & 31, ob = rr * 64 + cc * 2; return st * 1024 + (ob ^ (((ob >> 9) & 1) << 5)); }
__host__ __device__ __forceinline__ void stage_rc(int b, int& R, int& C) { const int st = b / 1024, sb = b % 1024, swz = sb ^ (((sb >> 9) & 1) << 5); R = (st >> 1) * 16 + swz / 64; C = (st & 1) * 32 + (swz % 64) / 2; }
__host__ __device__ __forceinline__ int perm32(int rho) { const int n = rho >> 4, i = rho & 15; return 8 * (i >> 2) + 4 * n + (i & 3); }

struct Unit { int pm, pn; };
struct Gemm { const bf16_t* A; const bf16_t* Bt; int M, N, K; };

struct StaticOrder {
    int nM, nN, nwg, G, c;
    __host__ __device__ void init(int M, int N, int G_, int c_) { nM = M / BM; nN = N / BM; nwg = nM * nN; G = G_; c = c_; }
    __host__ __device__ bool next(int i, Unit& u) const {
        const long L = (long)i * G + c; if (L >= nwg) return false;
        int wgid = (int)L; { const int q = nwg / NXCD, r = nwg % NXCD, xcd = wgid % NXCD, off = wgid / NXCD; wgid = (xcd < r ? xcd * (q + 1) : r * (q + 1) + (xcd - r) * q) + off; }
        const int nig = WGM * nN, gid = wgid / nig, fm = gid * WGM, gsz = (nM - fm) < WGM ? (nM - fm) : WGM;
        u.pm = fm + ((wgid % nig) % gsz); u.pn = (wgid % nig) / gsz; return true;
    }
    __device__ __forceinline__ void a_ready(const Unit&) const {}
    __device__ __forceinline__ void done(const Unit&) const {}
};

typedef float f32x2c __attribute__((ext_vector_type(2)));
typedef __bf16 bf16x2c __attribute__((ext_vector_type(2)));
__device__ __forceinline__ unsigned cvt_pk_bf16(float lo, float hi) { const f32x2c v = {lo, hi}; const bf16x2c r = __builtin_convertvector(v, bf16x2c); return __builtin_bit_cast(unsigned, r); }

typedef unsigned u32x2 __attribute__((ext_vector_type(2)));
__device__ __forceinline__ float bflo(unsigned w) { return __uint_as_float(w << 16); }
__device__ __forceinline__ float bfhi(unsigned w) { return __uint_as_float(w & 0xffff0000u); }
__device__ __forceinline__ float sigmoidf_(float x) { return __builtin_amdgcn_rcpf(1.0f + __expf(-x)); }

struct InOrder {
    StaticOrder base; int G, c;
    __device__ void init(int G_, int c_) { base.init(SEQ, INWP, G_, c_); G = G_; c = c_; }
    __device__ bool next(int i, Unit& u) const {
        const long L = (long)i * G + c;
        if (L < base.nwg) {
            base.next(i, u);
            if (u.pn >= CT_V && u.pn < CT_U) { const int e = (u.pn - CT_V) * 32 + u.pm; u.pm = HT + CT_V + e / HT; u.pn = e % HT; }
            else u.pn += HT;
            return true;
        }
        const int x = (int)(L - base.nwg);
        if (x >= 31) return false;
        if (x < 2) { const int e = 64 + x; u.pm = HT + CT_V + e / HT; u.pn = e % HT; }
        else { const int y = x - 2; u.pm = 32; u.pn = HT + (y < 2 ? CT_K + y : CT_U + (y - 2)); }
        return true;
    }
    __device__ __forceinline__ void a_ready(const Unit&) const {}
    __device__ __forceinline__ void done(const Unit&) const {}
};

struct EpiIn {
    static constexpr bool PERM = true, AFTER_DRAIN = false;
    bf16_t *G, *Q, *K, *Vt, *U; const float* bgate; const float* rope;
    __device__ __forceinline__ static void st8(bf16_t* p, const f32x4& v0, const f32x4& v1) {
        u32x4 w; w.x = cvt_pk_bf16(v0[0], v0[1]); w.y = cvt_pk_bf16(v0[2], v0[3]); w.z = cvt_pk_bf16(v1[0], v1[1]); w.w = cvt_pk_bf16(v1[2], v1[3]); *(u32x4*)p = w; }
    __device__ __forceinline__ void plain(const f32x4 (&acc)[2][2][4][2], bf16_t* base, int ldc, int row0, int col0) const {
#pragma unroll
        for (int ai = 0; ai < 2; ++ai)
#pragma unroll
            for (int m = 0; m < 4; ++m) { bf16_t* rowp = base + (size_t)(row0 + ai * HALF + m * 16) * ldc + col0;
#pragma unroll
                for (int bj = 0; bj < 2; ++bj) st8(rowp + bj * HALF, acc[ai][bj][m][0], acc[ai][bj][m][1]); }
    }
    __device__ __forceinline__ void roped(const f32x4 (&acc)[2][2][4][2], bf16_t* base, int ldc, int row0, int col0, int wc, int fq) const {
        if (wc != 0) { plain(acc, base, ldc, row0, col0); return; }
        const float sgn = (fq < 2) ? -1.0f : 1.0f;
#pragma unroll
        for (int ai = 0; ai < 2; ++ai)
#pragma unroll
            for (int m = 0; m < 4; ++m) { const int row = row0 + ai * HALF + m * 16; const int pos = row < SEQ ? row + NMETA : row - SEQ;
                const f32x4* cs = (const f32x4*)(rope + (size_t)pos * 32 + 16 * (fq & 1));
                const f32x4 c0 = cs[0], c1 = cs[1], c2 = cs[2], c3 = cs[3];
                const float cw[8] = {c0[0], c0[2], c1[0], c1[2], c2[0], c2[2], c3[0], c3[2]}, sw[8] = {c0[1], c0[3], c1[1], c1[3], c2[1], c2[3], c3[1], c3[3]};
                bf16_t* rowp = base + (size_t)row * ldc + col0;
#pragma unroll
                for (int bj = 0; bj < 2; ++bj) { f32x4 v0 = acc[ai][bj][m][0], v1 = acc[ai][bj][m][1], o0, o1;
#pragma unroll
                    for (int e = 0; e < 4; ++e) { const float p0 = __shfl_xor(v0[e], 32), p1 = __shfl_xor(v1[e], 32);
                        o0[e] = v0[e] * cw[e] + sgn * p0 * sw[e]; o1[e] = v1[e] * cw[4 + e] + sgn * p1 * sw[4 + e]; }
                    st8(rowp + bj * HALF, o0, o1); } }
    }
    __device__ __forceinline__ void operator()(const f32x4 (&acc)[2][2][4][2], const Unit& u, int wr, int wc, int fr, int fq) const {
        if (u.pm >= HT) {
            plain(acc, Vt, MPAD, (u.pm - HT - CT_V) * BM + wr * 64 + fr, u.pn * BM + wc * 32 + 8 * fq); return; }
        const int ct = u.pn - HT, row0 = u.pm * BM + wr * 64 + fr, cl = wc * 32 + 8 * fq;
        if (ct < CT_Q) {
            const int col0 = ct * BM + cl;
#pragma unroll
            for (int bj = 0; bj < 2; ++bj) { const f32x4 b0 = *(const f32x4*)(bgate + col0 + bj * HALF), b1 = *(const f32x4*)(bgate + col0 + bj * HALF + 4);
#pragma unroll
                for (int ai = 0; ai < 2; ++ai)
#pragma unroll
                    for (int m = 0; m < 4; ++m) { f32x4 v0 = acc[ai][bj][m][0] + b0, v1 = acc[ai][bj][m][1] + b1;
#pragma unroll
                        for (int e = 0; e < 4; ++e) { v0[e] = sigmoidf_(v0[e]); v1[e] = sigmoidf_(v1[e]); }
                        st8(G + (size_t)(row0 + ai * HALF + m * 16) * (2 * DM) + col0 + bj * HALF, v0, v1); } }
        } else if (ct < CT_K) { roped(acc, Q, ATTW, row0, (ct - CT_Q) * BM + cl, wc, fq);
        } else if (ct < CT_V) { roped(acc, K, KVW, row0, (ct - CT_K) * BM + cl, wc, fq);
        } else { plain(acc, U, UPITCH, row0, (ct - CT_U) * BM + cl); }
    }
};

struct EpiProjA {
    static constexpr bool PERM = true, AFTER_DRAIN = false;
    bf16_t* P1; const bf16_t* G;
    __device__ __forceinline__ void operator()(const f32x4 (&acc)[2][2][4][2], const Unit& u, int wr, int wc, int fr, int fq) const {
        const int row0 = u.pm * BM + wr * 64 + fr, col0 = u.pn * BM + wc * 32 + 8 * fq;
#pragma unroll
        for (int ai = 0; ai < 2; ++ai)
#pragma unroll
            for (int m = 0; m < 4; ++m) { const size_t r = (size_t)(row0 + ai * HALF + m * 16);
#pragma unroll
                for (int bj = 0; bj < 2; ++bj) { const int c = col0 + bj * HALF; const u32x4 g = *(const u32x4*)(G + r * (2 * DM) + c);
                    f32x4 o0 = acc[ai][bj][m][0], o1 = acc[ai][bj][m][1];
                    o0[0] *= bflo(g.x); o0[1] *= bfhi(g.x); o0[2] *= bflo(g.y); o0[3] *= bfhi(g.y); o1[0] *= bflo(g.z); o1[1] *= bfhi(g.z); o1[2] *= bflo(g.w); o1[3] *= bfhi(g.w);
                    EpiIn::st8(P1 + r * DM + c, o0, o1); } }
    }
};
struct EpiProjB {
    static constexpr bool PERM = true, AFTER_DRAIN = false;
    const bf16_t* P1; const bf16_t* G; bf16_t* MX;
    __device__ __forceinline__ void operator()(const f32x4 (&acc)[2][2][4][2], const Unit& u, int wr, int wc, int fr, int fq) const {
        const int row0 = u.pm * BM + wr * 64 + fr, col0 = u.pn * BM + wc * 32 + 8 * fq;
#pragma unroll
        for (int ai = 0; ai < 2; ++ai)
#pragma unroll
            for (int m = 0; m < 4; ++m) { const size_t r = (size_t)(row0 + ai * HALF + m * 16);
#pragma unroll
                for (int bj = 0; bj < 2; ++bj) { const int c = col0 + bj * HALF; const u32x4 g = *(const u32x4*)(G + r * (2 * DM) + DM + c); const u32x4 q = *(const u32x4*)(P1 + r * DM + c);
                    f32x4 o0 = {bflo(q.x), bfhi(q.x), bflo(q.y), bfhi(q.y)}, o1 = {bflo(q.z), bfhi(q.z), bflo(q.w), bfhi(q.w)}; const f32x4 a0 = acc[ai][bj][m][0], a1 = acc[ai][bj][m][1];
                    o0[0] += a0[0] * bflo(g.x); o0[1] += a0[1] * bfhi(g.x); o0[2] += a0[2] * bflo(g.y); o0[3] += a0[3] * bfhi(g.y);
                    o1[0] += a1[0] * bflo(g.z); o1[1] += a1[1] * bfhi(g.z); o1[2] += a1[2] * bflo(g.w); o1[3] += a1[3] * bfhi(g.w);
                    EpiIn::st8(MX + r * DM + c, o0, o1); }
                asm volatile("" ::: "memory"); }
    }
};
template <bool BASE_BF16> struct EpiResid {
    static constexpr bool PERM = true, AFTER_DRAIN = false;
    const float* BASEF; const bf16_t* BASEB; float* OUTF; bf16_t* OUTB; float* SS;
    __device__ __forceinline__ void operator()(const f32x4 (&acc)[2][2][4][2], const Unit& u, int wr, int wc, int fr, int fq) const {
        const int row0 = u.pm * BM + wr * 64 + fr, col0 = u.pn * BM + wc * 32 + 8 * fq;
#pragma unroll
        for (int ai = 0; ai < 2; ++ai)
#pragma unroll
            for (int m = 0; m < 4; ++m) { const size_t r = (size_t)(row0 + ai * HALF + m * 16); float ss = 0.f;
#pragma unroll
                for (int bj = 0; bj < 2; ++bj) { const int c = col0 + bj * HALF; f32x4 o0, o1;
                    if (BASE_BF16) { const u32x4 g = *(const u32x4*)(BASEB + r * DM + c); o0 = (f32x4){bflo(g.x), bfhi(g.x), bflo(g.y), bfhi(g.y)}; o1 = (f32x4){bflo(g.z), bfhi(g.z), bflo(g.w), bfhi(g.w)}; }
                    else { const float* bp = BASEF + r * DM + c; o0 = *(const f32x4*)bp; o1 = *(const f32x4*)(bp + 4); }
                    o0 += acc[ai][bj][m][0]; o1 += acc[ai][bj][m][1];
                    if (BASE_BF16) { float* op = OUTF + r * DM + c; *(f32x4*)op = o0; *(f32x4*)(op + 4) = o1; }
                    else { u32x4 w; w.x = cvt_pk_bf16(o0[0], o0[1]); w.y = cvt_pk_bf16(o0[2], o0[3]); w.z = cvt_pk_bf16(o1[0], o1[1]); w.w = cvt_pk_bf16(o1[2], o1[3]); *(u32x4*)(OUTB + r * DM + c) = w;
                        o0 = (f32x4){bflo(w.x), bfhi(w.x), bflo(w.y), bfhi(w.y)}; o1 = (f32x4){bflo(w.z), bfhi(w.z), bflo(w.w), bfhi(w.w)}; }
                    ss += (o0[0] * o0[0] + o0[1] * o0[1]) + (o0[2] * o0[2] + o0[3] * o0[3]) + (o1[0] * o1[0] + o1[1] * o1[1]) + (o1[2] * o1[2] + o1[3] * o1[3]); }
                ss += __shfl_xor(ss, 16); ss += __shfl_xor(ss, 32);
                if (fq == 0) atomicAdd(SS + r, ss);
                asm volatile("" ::: "memory"); }
    }
};
struct EpiSwiGLU {
    static constexpr bool PERM = true, AFTER_DRAIN = false;
    bf16_t* HID; const float* SS;
    __device__ __forceinline__ void operator()(const f32x4 (&acc)[2][2][4][2], const Unit& u, int wr, int wc, int fr, int fq) const {
        const int row0 = u.pm * BM + wr * 64 + fr, col0 = u.pn * HALF + wc * 32 + 8 * fq;
#pragma unroll
        for (int ai = 0; ai < 2; ++ai)
#pragma unroll
            for (int m = 0; m < 4; ++m) { const size_t r = (size_t)(row0 + ai * HALF + m * 16);
                const float rstd = __builtin_amdgcn_rsqf(SS[r] * (1.0f / DM) + RMS_EPS);
                f32x4 o0, o1;
#pragma unroll
                for (int e = 0; e < 4; ++e) { const float g0 = acc[ai][0][m][0][e] * rstd, u0 = acc[ai][1][m][0][e] * rstd, g1 = acc[ai][0][m][1][e] * rstd, u1 = acc[ai][1][m][1][e] * rstd;
                    o0[e] = g0 * sigmoidf_(g0) * u0; o1[e] = g1 * sigmoidf_(g1) * u1; }
                EpiIn::st8(HID + r * DFF + col0, o0, o1); }
    }
};

#define PG8_EPI_T0 unsigned long long epi_t0_ = 0; do { if ((PROBE_PHASE >> 20) & 1) epi_t0_ = __builtin_amdgcn_s_memrealtime(); } while (0)
#define PG8_EPI_T1 do { if ((PROBE_PHASE >> 20) & 1) epi_acc += __builtin_amdgcn_s_memrealtime() - epi_t0_; } while (0)
template <class Epi, class Sched, bool ALIGN_EPI = false, bool SP2 = false>
__device__ __forceinline__ void gemm_phase(PG8_LAS unsigned char* lds, const Gemm g, const Sched& S, const Epi& E, unsigned long long& epi_acc) {
    const int tid = threadIdx.x, wid = __builtin_amdgcn_readfirstlane(tid >> 6), lane = tid & 63, wr = wid >> 2, wc = wid & 3, fr = lane & 15, fq = lane >> 4;
    const int K = g.K, nt = K / BK;
    unsigned voffA[2], voffB[2];
#pragma unroll
    for (int i = 0; i < 2; ++i) { int R, C; stage_rc(tid * 16 + i * 8192, R, C); const int Rb = Epi::PERM ? ((R & ~31) + perm32(R & 31)) : R;
        voffA[i] = (unsigned)(R * K + C) * 2u; voffB[i] = (unsigned)(Rb * K + C) * 2u; }
    const size_t kstep = (size_t)(BK * 2);
    const size_t hstep = (size_t)HALF * K * 2;
    const size_t tstep = 2 * hstep;
    const unsigned ldsw = (unsigned)wid * 1024u;
    const int aoff = lds_byte(wr * 64 + fr, fq * 8), boff = lds_byte(wc * 32 + fr, fq * 8);
#define PG8_SA(b, h) (((b) * 2 + (h)) * HTB)
#define PG8_SB(b, h) ((4 + (b) * 2 + (h)) * HTB)
#define PG8_STAGE(bufoff, gbase, voff) do { _Pragma("unroll") for (int _i = 0; _i < 2; ++_i) \
        __builtin_amdgcn_global_load_lds((const unsigned*)((const char*)(gbase) + (voff)[_i]), (PG8_LAS unsigned*)(lds + (bufoff) + ldsw + _i * 8192), 16, 0, 0); } while (0)
#define PG8_LDA(dst, b, h) do { _Pragma("unroll") for (int m = 0; m < 4; ++m) _Pragma("unroll") for (int k = 0; k < 2; ++k) dst[m][k] = *(const PG8_LAS bf16x8*)(lds + PG8_SA(b, h) + aoff + m * 2048 + k * 1024); } while (0)
#define PG8_LDB(dst, b, h) do { _Pragma("unroll") for (int n = 0; n < 2; ++n) _Pragma("unroll") for (int k = 0; k < 2; ++k) dst[n][k] = *(const PG8_LAS bf16x8*)(lds + PG8_SB(b, h) + boff + n * 2048 + k * 1024); } while (0)
#define PG8_MMA(ai, bj, At, Bt) do { __builtin_amdgcn_s_setprio(1); _Pragma("unroll") for (int m = 0; m < 4; ++m) _Pragma("unroll") for (int n = 0; n < 2; ++n) _Pragma("unroll") for (int k = 0; k < 2; ++k) \
        acc[ai][bj][m][n] = __builtin_amdgcn_mfma_f32_16x16x32_bf16(Bt[n][k], At[m][k], acc[ai][bj][m][n], 0, 0, 0); __builtin_amdgcn_s_setprio(0); } while (0)
#define PG8_WAIT_V(n) asm volatile("s_waitcnt vmcnt(" #n ")" ::: "memory")
#define PG8_WAIT_L(n) asm volatile("s_waitcnt lgkmcnt(" #n ")" ::: "memory")
#define PG8_BAR __builtin_amdgcn_s_barrier()
#define PG8_SCHED __builtin_amdgcn_sched_barrier(0)
    Unit cur, nxt; int ui = 0;
    if (!S.next(0, cur)) return;
    f32x4 acc[2][2][4][2];
#pragma unroll
    for (int a = 0; a < 2; ++a)
#pragma unroll
        for (int b = 0; b < 2; ++b)
#pragma unroll
            for (int m = 0; m < 4; ++m)
#pragma unroll
                for (int n = 0; n < 2; ++n) acc[a][b][m][n] = (f32x4){0.f, 0.f, 0.f, 0.f};
    bf16x8 At[4][2], B0[2][2], B1[2][2];
    const char* cA = (const char*)g.A + (size_t)cur.pm * tstep; const char* cB = (const char*)g.Bt + (size_t)cur.pn * tstep;
    S.a_ready(cur);
    if constexpr (SP2) {
        PG8_STAGE(PG8_SB(0, 0), cB, voffB); PG8_STAGE(PG8_SB(0, 1), cB + hstep, voffB); PG8_STAGE(PG8_SA(0, 0), cA, voffA); PG8_STAGE(PG8_SA(0, 1), cA + hstep, voffA);
        if (wr == 1) PG8_BAR;
        PG8_WAIT_V(2); PG8_BAR;
        PG8_STAGE(PG8_SB(1, 0), cB + kstep, voffB); PG8_STAGE(PG8_SA(1, 0), cA + kstep, voffA); PG8_STAGE(PG8_SB(1, 1), cB + hstep + kstep, voffB);
        PG8_WAIT_V(6); PG8_BAR;
    } else {
        PG8_STAGE(PG8_SB(0, 0), cB, voffB); PG8_STAGE(PG8_SA(0, 0), cA, voffA); PG8_STAGE(PG8_SB(0, 1), cB + hstep, voffB); PG8_STAGE(PG8_SA(0, 1), cA + hstep, voffA);
        if (wr == 1) PG8_BAR;
        PG8_WAIT_V(4); PG8_BAR;
        PG8_STAGE(PG8_SB(1, 0), cB + kstep, voffB); PG8_STAGE(PG8_SA(1, 0), cA + kstep, voffA); PG8_STAGE(PG8_SB(1, 1), cB + hstep + kstep, voffB);
        PG8_WAIT_V(6); PG8_BAR;
    }
    for (;;) {
        const bool has_next = S.next(ui + 1, nxt);
        const char* nA = has_next ? (const char*)g.A + (size_t)nxt.pm * tstep : cA; const char* nB = has_next ? (const char*)g.Bt + (size_t)nxt.pn * tstep : cB;
        for (int t = 0; t < nt; t += 2) {
            const bool last = (t == nt - 2);
            const char* a1 = cA + (size_t)(t + 1) * kstep;
            const char* a2 = last ? nA : cA + (size_t)(t + 2) * kstep; const char* b2 = last ? nB : cB + (size_t)(t + 2) * kstep;
            const char* a3 = a2 + kstep; const char* b3 = b2 + kstep;
            if (last && has_next) S.a_ready(nxt);
            if constexpr (SP2) {
            PG8_LDB(B0, 0, 0); PG8_LDB(B1, 0, 1); PG8_SCHED; PG8_LDA(At, 0, 0); PG8_STAGE(PG8_SA(1, 1), a1 + hstep, voffA);
            PG8_WAIT_V(8); PG8_WAIT_L(0); PG8_BAR; PG8_MMA(0, 0, At, B0); PG8_MMA(0, 1, At, B1); PG8_BAR; PG8_SCHED;
            PG8_LDA(At, 0, 1); PG8_STAGE(PG8_SB(0, 0), b2, voffB); PG8_STAGE(PG8_SB(0, 1), b2 + hstep, voffB); PG8_STAGE(PG8_SA(0, 0), a2, voffA);
            PG8_WAIT_V(8); PG8_WAIT_L(0); PG8_BAR; PG8_MMA(1, 0, At, B0); PG8_MMA(1, 1, At, B1); PG8_BAR; PG8_SCHED;
            PG8_LDB(B0, 1, 0); PG8_LDB(B1, 1, 1); PG8_SCHED; PG8_LDA(At, 1, 0); PG8_STAGE(PG8_SA(0, 1), a2 + hstep, voffA);
            PG8_WAIT_V(8); PG8_WAIT_L(0); PG8_BAR; PG8_MMA(0, 0, At, B0); PG8_MMA(0, 1, At, B1); PG8_BAR; PG8_SCHED;
            PG8_LDA(At, 1, 1); PG8_STAGE(PG8_SB(1, 0), b3, voffB); PG8_STAGE(PG8_SB(1, 1), b3 + hstep, voffB); PG8_STAGE(PG8_SA(1, 0), a3, voffA);
            PG8_WAIT_V(8); PG8_WAIT_L(0); PG8_BAR; PG8_MMA(1, 0, At, B0); PG8_MMA(1, 1, At, B1); PG8_BAR; PG8_SCHED;
            } else {
            PG8_LDB(B0, 0, 0); PG8_SCHED; PG8_LDA(At, 0, 0); PG8_STAGE(PG8_SA(1, 1), a1 + hstep, voffA);
            PG8_WAIT_L(8); PG8_BAR; PG8_WAIT_L(0); PG8_MMA(0, 0, At, B0); PG8_BAR; PG8_SCHED;
            PG8_LDB(B1, 0, 1); PG8_STAGE(PG8_SB(0, 0), b2, voffB);
            PG8_BAR; PG8_WAIT_L(0); PG8_MMA(0, 1, At, B1); PG8_BAR;
            PG8_LDA(At, 0, 1); PG8_STAGE(PG8_SA(0, 0), a2, voffA);
            PG8_BAR; PG8_WAIT_L(0); PG8_MMA(1, 0, At, B0); PG8_BAR; PG8_SCHED;
            PG8_STAGE(PG8_SB(0, 1), b2 + hstep, voffB);
            PG8_WAIT_V(6); PG8_BAR; PG8_MMA(1, 1, At, B1); PG8_BAR;
            PG8_LDB(B0, 1, 0); PG8_SCHED; PG8_LDA(At, 1, 0); PG8_STAGE(PG8_SA(0, 1), a2 + hstep, voffA);
            PG8_WAIT_L(8); PG8_BAR; PG8_WAIT_L(0); PG8_MMA(0, 0, At, B0); PG8_BAR; PG8_SCHED;
            PG8_LDB(B1, 1, 1); PG8_STAGE(PG8_SB(1, 0), b3, voffB);
            PG8_BAR; PG8_WAIT_L(0); PG8_MMA(0, 1, At, B1); PG8_BAR;
            PG8_LDA(At, 1, 1); PG8_STAGE(PG8_SA(1, 0), a3, voffA);
            PG8_BAR; PG8_WAIT_L(0); PG8_MMA(1, 0, At, B0); PG8_BAR; PG8_SCHED;
            PG8_STAGE(PG8_SB(1, 1), b3 + hstep, voffB);
            PG8_WAIT_V(6); PG8_BAR; PG8_MMA(1, 1, At, B1); PG8_BAR;
            }
        }
        if constexpr (ALIGN_EPI) { if (wr == 0) PG8_BAR; }
        if constexpr (!Epi::AFTER_DRAIN) { PG8_EPI_T0; E(acc, cur, wr, wc, fr, fq); S.done(cur); PG8_EPI_T1; }
        if (!has_next) break;
#pragma unroll
        for (int a = 0; a < 2; ++a)
#pragma unroll
            for (int b = 0; b < 2; ++b)
#pragma unroll
                for (int m = 0; m < 4; ++m)
#pragma unroll
                    for (int n = 0; n < 2; ++n) acc[a][b][m][n] = (f32x4){0.f, 0.f, 0.f, 0.f};
        cur = nxt; cA = nA; cB = nB; ++ui;
        if constexpr (ALIGN_EPI) { if (wr == 1) PG8_BAR; }
    }
    PG8_WAIT_V(0);
    if constexpr (!ALIGN_EPI) { if (wr == 0) PG8_BAR; }
    PG8_BAR;
    if constexpr (Epi::AFTER_DRAIN) { E.fused(acc, cur, wr, wc, fr, fq, lds, wid, lane); S.done(cur); }
#undef PG8_SA
#undef PG8_SB
#undef PG8_STAGE
#undef PG8_LDA
#undef PG8_LDB
#undef PG8_MMA
#undef PG8_WAIT_V
#undef PG8_WAIT_L
#undef PG8_BAR
#undef PG8_SCHED
}

}

constexpr size_t MiB = 1u << 20;
constexpr size_t WS_CTL = 0;
constexpr size_t WS_ROPE = 1 * MiB;
constexpr size_t WS_LW2 = 3 * MiB, WS_LA2 = 4 * MiB, WS_LG2 = 5 * MiB;
constexpr size_t WS_BONUS = 6 * MiB;
constexpr size_t ZERO_BYTES = 8 * MiB;
constexpr size_t SCF = (size_t)LTOK * RC * 4, SCB = (size_t)LTOK * RC * 2;
constexpr size_t WS_H = 8 * MiB, WS_WIN = WS_H + (size_t)MPAD * DM * 2;
constexpr size_t WS_KD0 = 8 * MiB, WS_KD1 = WS_KD0 + SCB, WS_B0 = WS_KD1 + SCB, WS_B1 = WS_B0 + SCB, WS_KK = WS_B1 + SCB, WS_RR = WS_KK + SCB;
constexpr size_t WS_WGU = 8 * MiB;
constexpr size_t WS_G = 216 * MiB, WS_A2 = 216 * MiB;
constexpr size_t WS_Q = 344 * MiB, WS_K = 376 * MiB, WS_VT = 385 * MiB, WS_U = 394 * MiB;
constexpr size_t WS_P1 = 344 * MiB;
constexpr size_t WS_Y = 394 * MiB;
constexpr size_t WS_W0 = 506 * MiB, WS_W1 = WS_W0 + SCF;
constexpr size_t WS_WPA = 506 * MiB, WS_WPR = 522 * MiB, WS_WOUT = 538 * MiB, WS_OATT = 570 * MiB;
constexpr size_t WS_VV = 635 * MiB, WS_GG = 668 * MiB;
constexpr size_t WS_BO = 701 * MiB;
constexpr size_t WS_HID = 701 * MiB, WS_MX = 873 * MiB;
constexpr int NB0 = 513, NB1 = 512, NBT = NB0 + NB1;
constexpr int BO_FA = 0, BO_FAA = 4096, BO_FT = 5120, BO_FBP = 5632, BO_FB = 6144, BO_FG = 10240, BO_ITEM = 10496;
constexpr size_t WS_WD = 1030 * MiB, WS_ORWKV = 182 * MiB, WS_END = 1116 * MiB;
static_assert(WS_WIN + (size_t)INWP * DM * 2 <= WS_G && WS_RR + SCB <= WS_G && WS_WGU + (size_t)2 * DFF * DM * 2 <= WS_G, "map: A0");
static_assert(WS_U + (size_t)MPAD * UPITCH * 2 <= WS_W0 && WS_VT + (size_t)KVW * MPAD * 2 <= WS_U && WS_K + (size_t)MPAD * KVW * 2 <= WS_VT && WS_Q + (size_t)SEQ * ATTW * 2 <= WS_K && WS_Y + 2 * SCB <= WS_W0, "map: P1 outputs");
static_assert(WS_W1 + SCF <= WS_VV && WS_OATT + (size_t)SEQ * ATTW * 2 <= WS_VV && WS_VV + SCB <= WS_GG && WS_GG + SCB <= WS_BO && WS_P1 + (size_t)SEQ * DM * 2 <= WS_W0, "map: mid");
static_assert(WS_BO + (size_t)RH * NBT * BO_ITEM <= WS_WD && WS_HID + (size_t)SEQ * DFF * 2 <= WS_MX && WS_MX + (size_t)SEQ * DM * 2 <= WS_WD && WS_WD + (size_t)DM * DFF * 2 <= WS_END && WS_WGU + (size_t)2 * DFF * DM * 2 <= WS_ORWKV && WS_ORWKV + (size_t)SEQ * RC * 2 <= WS_G, "map: tail");
constexpr int CW_BAR = 4096;
constexpr int CW_SS2 = 65536, CW_SS3 = 65536 + 8192;
static_assert((CW_SS3 + 8192) * 4 <= (int)(1 * MiB), "CTL");

constexpr int RING_BYTES = 131072;
constexpr int LDSCTL_OFF = RING_BYTES, MISC_OFF = LDSCTL_OFF + 320;
constexpr int LDS_BYTES = 147456;

#define GAS __attribute__((address_space(1)))
#define LAS __attribute__((address_space(3)))
typedef unsigned short bf16;
typedef unsigned v4u __attribute__((ext_vector_type(4)));
typedef unsigned v2u __attribute__((ext_vector_type(2)));
typedef float f32x4 __attribute__((ext_vector_type(4)));
typedef float f32x2 __attribute__((ext_vector_type(2)));
typedef float f32x16 __attribute__((ext_vector_type(16)));
typedef short bf16x8 __attribute__((ext_vector_type(8)));
typedef GAS unsigned gu32;
#define RLX_AGENT __ATOMIC_RELAXED, __HIP_MEMORY_SCOPE_AGENT
#define LDS_WAIT() asm volatile("s_waitcnt lgkmcnt(0)" ::: "memory")
__device__ __forceinline__ unsigned pk2(float lo, float hi) { return pg8::cvt_pk_bf16(lo, hi); }
__device__ __forceinline__ unsigned f2bf(float f) { return pg8::cvt_pk_bf16(f, 0.f) & 0xffffu; }
__device__ __forceinline__ float bf2f(bf16 b) { return __uint_as_float(((unsigned)b) << 16); }
using pg8::bflo; using pg8::bfhi; using pg8::sigmoidf_;

#define XB_TMO      128
#define XB_XCNT(j)  (256  + 64 * (j))
#define XB_XSUB(j)  (1280 + 64 * (j))
#define XB_XGEN(j)  (2304 + 64 * (j))
#define XB_TOP      3328
#define XB_TOPGEN   3392
#define XCD_BAR_WORDS 3456
#define XB_SPIN_CAP (1u << 18)

__device__ __forceinline__ unsigned xb_ld(unsigned* p)              { return __hip_atomic_load(p, __ATOMIC_RELAXED, __HIP_MEMORY_SCOPE_AGENT); }
__device__ __forceinline__ unsigned xb_add(unsigned* p, unsigned v) { return __hip_atomic_fetch_add(p, v, __ATOMIC_RELAXED, __HIP_MEMORY_SCOPE_AGENT); }
__device__ __forceinline__ unsigned xb_xcc_id() { return (unsigned)__builtin_amdgcn_s_getreg((3 << 11) | 20) & 0xFu; }
#define XB_SPIN(cond, bar) do { unsigned _sp = 0; while (cond) { __builtin_amdgcn_s_sleep(1); \
    if ((++_sp & 255u) == 0u) { if (xb_ld(&(bar)[XB_TMO])) break; if (_sp > XB_SPIN_CAP) { atomicAdd(&(bar)[XB_TMO], 1u); break; } } } } while (0)

struct XcdBarrier {
    unsigned* bar; unsigned x;
    volatile LAS unsigned* st;
};

__device__ __forceinline__ XcdBarrier xcd_barrier_post(unsigned* bar, volatile LAS unsigned* st) {
    XcdBarrier b; b.bar = bar; b.x = xb_xcc_id(); b.st = st;
    if (threadIdx.x == 0) (void)xb_add(&bar[XB_XCNT(b.x)], 1u);
    return b;
}
__device__ __forceinline__ void xcd_barrier_complete(unsigned* bar, unsigned x, unsigned& nloc, unsigned& nx) {
    const unsigned G = gridDim.x * gridDim.y * gridDim.z;
    unsigned sum, cnt, mine, sp = 0u;
    for (;;) {
        sum = 0u; cnt = 0u; mine = 0u;
#pragma unroll
        for (unsigned j = 0; j < 16; ++j) { const unsigned c = xb_ld(&bar[XB_XCNT(j)]); sum += c; cnt += (c > 0u) ? 1u : 0u; mine = (j == x) ? c : mine; }
        if (sum == G) break;
        __builtin_amdgcn_s_sleep(1);
        if ((++sp & 255u) == 0u) { if (xb_ld(&bar[XB_TMO])) break; if (sp > XB_SPIN_CAP) { atomicAdd(&bar[XB_TMO], 1u); break; } }
    }
    nloc = mine > 0u ? mine : 1u; nx = cnt > 0u ? cnt : 1u;
}

__device__ __forceinline__ void xcd_barrier(const XcdBarrier& b) {
    asm volatile("s_waitcnt vmcnt(0)" ::: "memory");
    __syncthreads();
    if (threadIdx.x == 0) {
        unsigned* bar = b.bar;
        __builtin_amdgcn_s_waitcnt(0);
        unsigned nloc = b.st[0], nx = b.st[1];
        if (nloc == 0u) { xcd_barrier_complete(bar, b.x, nloc, nx); b.st[0] = nloc; b.st[1] = nx; }
        const unsigned old = xb_add(&bar[XB_XSUB(b.x)], 1u);
        const unsigned gen = old / nloc;
        if (old + 1u == (gen + 1u) * nloc) {
            __builtin_amdgcn_fence(__ATOMIC_RELEASE, "agent");
            asm volatile("s_waitcnt vmcnt(0)" ::: "memory");
            const unsigned og = xb_add(&bar[XB_TOP], 1u);
            const unsigned tg = og / nx;
            if (og + 1u == (tg + 1u) * nx) xb_add(&bar[XB_TOPGEN], 1u);
            else XB_SPIN(xb_ld(&bar[XB_TOPGEN]) == tg, bar);
            __builtin_amdgcn_fence(__ATOMIC_ACQUIRE, "agent");
            xb_add(&bar[XB_XGEN(b.x)], 1u);
            asm volatile("s_waitcnt vmcnt(0)" ::: "memory");
        } else {
            XB_SPIN(xb_ld(&bar[XB_XGEN(b.x)]) == gen, bar);
            __builtin_amdgcn_fence(__ATOMIC_ACQUIRE, "agent");
            asm volatile("s_waitcnt vmcnt(0)" ::: "memory");
        }
    }
    __syncthreads();
}


struct Frame {
    LAS unsigned char* lds;
    volatile LAS unsigned* MISC;
    gu32* ctl;
    int tid, lane, wave, G;
    unsigned char* ws;
    const float* in[26];
    float* out;
    unsigned long long pb0, pacc, pacc2;
};
#define FPB0(k) do { if ((PROBE_PHASE >> (k)) & 1) F.pb0 = __builtin_amdgcn_s_memrealtime(); } while (0)
#define FPB1(k) do { if ((PROBE_PHASE >> (k)) & 1) F.pacc += __builtin_amdgcn_s_memrealtime() - F.pb0; } while (0)
__device__ __forceinline__ float wave_sum(float v) {
#pragma unroll
    for (int o = 1; o < 64; o <<= 1) v += __shfl_xor(v, o);
    return v;
}

template <int KR> __device__ __forceinline__ void tr_issue(const float* W, int N, int item, int lane, float (&wv)[KR / 2]) {
    const int nblk = N / 32, kb = item / nblk, nb = item % nblk, k0 = KR * kb, n0 = 32 * nb;
#pragma unroll
    for (int i = 0; i < KR / 2; ++i) wv[i] = W[(size_t)(k0 + 2 * i + (lane >> 5)) * N + n0 + (lane & 31)];
}
template <int KR> __device__ __forceinline__ void tr_finish(bf16* WT, int K, int N, const float* kscale, int mode, int item, LAS float* scr, int lane, const float (&wv)[KR / 2]) {
    const int nblk = N / 32, kb = item / nblk, nb = item % nblk, k0 = KR * kb, n0 = 32 * nb;
#pragma unroll
    for (int i = 0; i < KR / 2; ++i) { const int kk = 2 * i + (lane >> 5); float v = wv[i]; if (kscale) v *= kscale[k0 + kk]; scr[kk * 33 + (lane & 31)] = v; }
    LDS_WAIT(); asm volatile("" ::: "memory");
    constexpr int CH = KR / 8;
    const int c = lane & (CH - 1);
#pragma unroll
    for (int jj = 0; jj < CH / 2; ++jj) { const int n = (lane / CH) + (64 / CH) * jj; const LAS float* s = scr + (8 * c) * 33 + n;
        v4u o; o.x = pk2(s[0 * 33], s[1 * 33]); o.y = pk2(s[2 * 33], s[3 * 33]); o.z = pk2(s[4 * 33], s[5 * 33]); o.w = pk2(s[6 * 33], s[7 * 33]);
        const int nn = n0 + n; const int dr = (mode == 0) ? nn : (256 * (nn >> 7) + (nn & 127) + (mode == 2 ? 128 : 0));
        *(GAS v4u*)(WT + (size_t)dr * K + k0 + 8 * c) = o; }
    LDS_WAIT(); asm volatile("" ::: "memory");
}
#define CONV_P4(it, CALL) do { constexpr int I_GU_ = (DM / 64) * (DFF / 32), I_P_ = (ATTW / 64) * (DM / 32); int r_ = (it); \
        if (r_ < I_GU_) { CALL(F.in[22], (bf16*)(F.ws + WS_WGU), DM, DFF, F.in[21], 1, r_); } \
        else if ((r_ -= I_GU_) < I_GU_) { CALL(F.in[23], (bf16*)(F.ws + WS_WGU), DM, DFF, F.in[21], 2, r_); } \
        else if ((r_ -= I_GU_) < I_P_) { CALL(F.in[18], (bf16*)(F.ws + WS_WPA), ATTW, DM, (const float*)nullptr, 0, r_); } \
        else if ((r_ -= I_P_) < I_P_) { CALL(F.in[19], (bf16*)(F.ws + WS_WPR), RC, DM, (const float*)nullptr, 0, r_); } \
        else { r_ -= I_P_; CALL(F.in[20], (bf16*)(F.ws + WS_WOUT), DM, DM, (const float*)nullptr, 0, r_); } } while (0)
constexpr int N_P4_ITEMS = 2 * (DM / 64) * (DFF / 32) + 2 * (ATTW / 64) * (DM / 32) + (DM / 64) * (DM / 32);
constexpr int N_WD_ITEMS = (DFF / 64) * (DM / 32);
constexpr int N_WD_HALF_ITEMS = (DFF / 32) * (DM / 32);
__device__ __forceinline__ void convert_seg(Frame& F, LAS float* scr, int first, int stride, int limit) {
    int it = first; if (it >= limit) return;
    float w0[32], w1[32];
#define CVI0(W_, WT_, K_, N_, ks_, md_, item_) tr_issue<64>(W_, N_, item_, F.lane, w0)
#define CVI1(W_, WT_, K_, N_, ks_, md_, item_) tr_issue<64>(W_, N_, item_, F.lane, w1)
#define CVI2(W_, WT_, K_, N_, ks_, md_, item_) tr_issue<64>(W_, N_, item_, F.lane, w2)
#define CVF(W_, WT_, K_, N_, ks_, md_, item_) tr_finish<64>(WT_, K_, N_, ks_, md_, item_, scr, F.lane, w0)
    CONV_P4(it, CVI0);
    if (it + stride < limit) CONV_P4(it + stride, CVI1);
    for (;;) { const int it2 = it + 2 * stride; float w2[32];
        if (it2 < limit) CONV_P4(it2, CVI2);
        CONV_P4(it, CVF);
        it += stride; if (it >= limit) break;
#pragma unroll
        for (int i = 0; i < 32; ++i) { w0[i] = w1[i]; w1[i] = w2[i]; } }
#undef CVI0
#undef CVI1
#undef CVI2
#undef CVF
}
__device__ __forceinline__ void convert_p4(Frame& F, LAS float* scr, int widx, int NWK, int pidx, int NPL) {
    (void)pidx; (void)NPL;
    convert_seg(F, scr, widx, NWK, N_P4_ITEMS);
}
__device__ __forceinline__ void convert_one(Frame& F, LAS float* scr, const float* W, bf16* WT, int K, int N, int nitems, int first, int stride) {
    int it = first; if (it >= nitems) return;
    float w0[32], w1[32];
    tr_issue<64>(W, N, it, F.lane, w0);
    if (it + stride < nitems) tr_issue<64>(W, N, it + stride, F.lane, w1);
    for (;;) { const int it2 = it + 2 * stride; float w2[32];
        if (it2 < nitems) tr_issue<64>(W, N, it2, F.lane, w2);
        tr_finish<64>(WT, K, N, nullptr, 0, it, scr, F.lane, w0);
        it += stride; if (it >= nitems) break;
#pragma unroll
        for (int i = 0; i < 32; ++i) { w0[i] = w1[i]; w1[i] = w2[i]; } }
}
__device__ __forceinline__ void convert_wd(Frame& F, LAS float* scr, int first, int stride) { convert_one(F, scr, F.in[24], (bf16*)(F.ws + WS_WD), DFF, DM, N_WD_ITEMS, first, stride); }
__device__ __forceinline__ void rms_row_to_bf16(int lane, const float* xrow, const float* w, bf16* orow) {
    const GAS f32x4* xr = (const GAS f32x4*)xrow + lane;
    f32x4 v[16]; float s = 0.f;
#pragma unroll
    for (int j = 0; j < 16; ++j) { v[j] = xr[64 * j]; s += (v[j].x * v[j].x + v[j].y * v[j].y) + (v[j].z * v[j].z + v[j].w * v[j].w); }
    const float rstd = 1.f / sqrtf(wave_sum(s) * (1.f / DM) + RMS_EPS);
    const GAS f32x4* wr = (const GAS f32x4*)w + lane;
    GAS v2u* o8 = (GAS v2u*)orow + lane;
#pragma unroll
    for (int j = 0; j < 16; ++j) { const f32x4 ww = wr[64 * j]; v2u o; o.x = pk2(v[j].x * rstd * ww.x, v[j].y * rstd * ww.y); o.y = pk2(v[j].z * rstd * ww.z, v[j].w * rstd * ww.w); o8[64 * j] = o; }
}
__device__ const double ROPE_INV[16] = {
    1.0000000000000000000000000e+0,
    4.4036660267178047359198331e-1,
    1.9392274474868577334259386e-1,
    8.5397100285765611280149662e-2,
    3.7606030930863935681246092e-2,
    1.6560440080994445548947445e-2,
    7.2926647372171090477661219e-3,
    3.2114459947525910185434889e-3,
    1.4142135623730950488016887e-3,
    6.2277242191459597955502746e-4,
    2.7424817567620731825332265e-4,
    1.2076973741146503832424826e-4,
    5.3182958969449886162502429e-5,
    2.3419998961409341542188076e-5,
    1.0313385377212458859810127e-5,
    4.5416704806078696531998012e-6
};

__device__ __forceinline__ void p0_prologue(Frame& F) {
    LAS float* scr = (LAS float*)(F.lds + F.wave * 16384);
    const int gw = blockIdx.x * 8 + F.wave, NGW = F.G * 8;
    bf16* Wint = (bf16*)(F.ws + WS_WIN); bf16* H = (bf16*)(F.ws + WS_H);
    convert_one(F, scr, F.in[3], Wint, DM, INW, (DM / 64) * (INW / 32), gw, NGW);
    for (int m = gw; m < MPAD + (INWP - INW); m += NGW) {
        if (m < SEQ) rms_row_to_bf16(F.lane, F.in[0] + (size_t)m * DM, F.in[2], H + (size_t)m * DM);
        else if (m < LTOK) rms_row_to_bf16(F.lane, F.in[1] + (size_t)(m - SEQ) * DM, F.in[2], H + (size_t)m * DM);
        else { bf16* row = (m < MPAD) ? H + (size_t)m * DM : Wint + (size_t)(INW + (m - MPAD)) * DM; GAS v4u* o = (GAS v4u*)row + F.lane;
#pragma unroll
            for (int j = 0; j < 8; ++j) o[64 * j] = (v4u){0u, 0u, 0u, 0u}; }
    }
    const int gt = blockIdx.x * 512 + F.tid, NGT = F.G * 512;
    float* rope = (float*)(F.ws + WS_ROPE);
    for (int i = gt; i < LTOK * 16; i += NGT) { const int pos = i >> 4, k = i & 15;
        const double ang = (double)pos * ROPE_INV[k]; const double kq = __builtin_rint(ang * 0.15915494309189535);
        const double red = (ang - kq * 6.28318530717958623) - kq * 2.4492935982947064e-16; const float rf = (float)red;
        rope[2 * i] = cosf(rf); rope[2 * i + 1] = sinf(rf); }
    { bf16* w2t = (bf16*)(F.ws + WS_LW2); bf16* a2t = (bf16*)(F.ws + WS_LA2); bf16* g2t = (bf16*)(F.ws + WS_LG2);
      constexpr int I_L = 3 * (RC / 32), I_G = 8 * (RC / 32);
      for (int it = gw; it < 4 * I_L + I_G; it += NGW) { float wv[16];
          if (it < 4 * I_L) { const int mtx = it / I_L, r = it % I_L, dd = mtx & 1; const float* W = (mtx < 2 ? F.in[8] : F.in[10]) + (size_t)dd * 96 * RC; bf16* WT = (mtx < 2 ? w2t : a2t) + (size_t)dd * RC * 96;
              tr_issue<32>(W, RC, r, F.lane, wv); tr_finish<32>(WT, 96, RC, nullptr, 0, r, scr, F.lane, wv); }
          else { const int r = it - 4 * I_L; tr_issue<32>(F.in[11], RC, r, F.lane, wv); tr_finish<32>(g2t, 256, RC, nullptr, 0, r, scr, F.lane, wv); } } }
}

__device__ __forceinline__ int crow(int r, int hi) { return (r & 3) + 8 * (r >> 2) + 4 * hi; }
__device__ __forceinline__ void attn_phase(Frame& F, const int gw, const int NGW) {
    const bf16* Q = (const bf16*)(F.ws + WS_Q); const bf16* K = (const bf16*)(F.ws + WS_K); const bf16* Vt = (const bf16*)(F.ws + WS_VT); bf16* OA = (bf16*)(F.ws + WS_OATT);
    const float* sink = F.in[17];
    const int hh = F.lane >> 5, r = F.lane & 31;
    constexpr float SC = 0.08838834764831845f * 1.4426950408889634f, L2E = 1.4426950408889634f;
    for (int item = gw; item < 4096; item += NGW) {
        const int sub = item & 3, hq = (item >> 2) & 15, qb = item >> 6, q0 = qb * 128 + sub * 32, hk = hq >> 2;
        bf16x8 bq[8];
        { const bf16* qp = Q + (size_t)(q0 + r) * ATTW + hq * 128 + 8 * hh;
#pragma unroll
          for (int s = 0; s < 8; ++s) bq[s] = *(const bf16x8*)(qp + 16 * s); }
        f32x16 O[4];
#pragma unroll
        for (int dt = 0; dt < 4; ++dt)
#pragma unroll
            for (int i = 0; i < 16; ++i) O[dt][i] = 0.f;
        float m = sink[hq] * L2E, l = (hh == 0) ? 1.f : 0.f;
        const int tlo = (q0 >= 128) ? 0 : 4 - q0 / 32, thi = (q0 + 128 + 32 <= SEQ) ? 8 : 4 + (SEQ - 32 - q0) / 32;
        int ti = tlo;
        bf16x8 ak[8];
        { const int key0 = q0 + 32 * (ti - 4); const bf16* kp = K + (size_t)(key0 + r) * KVW + hk * 128 + 8 * hh;
#pragma unroll
          for (int s = 0; s < 8; ++s) ak[s] = *(const bf16x8*)(kp + 16 * s); }
        for (;;) {
            const bool meta = (ti == 9);
            const int key0 = meta ? SEQ : q0 + 32 * (ti - 4);
            const int tn = (ti < thi) ? ti + 1 : 9; const int keyn = (tn == 9) ? SEQ : q0 + 32 * (tn - 4);
            v2u av[4][2][2]; bf16x8 akn[8];
#pragma unroll
            for (int dt = 0; dt < 4; ++dt) { const bf16* vp = Vt + (size_t)(hk * 128 + 32 * dt + r) * MPAD + key0 + 4 * hh;
#pragma unroll
                for (int s2 = 0; s2 < 2; ++s2) { av[dt][s2][0] = *(const v2u*)(vp + 16 * s2); av[dt][s2][1] = *(const v2u*)(vp + 16 * s2 + 8); } }
            { const bf16* kp = K + (size_t)(keyn + r) * KVW + hk * 128 + 8 * hh;
#pragma unroll
              for (int s = 0; s < 8; ++s) akn[s] = *(const bf16x8*)(kp + 16 * s); }
            f32x16 st;
#pragma unroll
            for (int i = 0; i < 16; ++i) st[i] = 0.f;
#pragma unroll
            for (int s = 0; s < 8; ++s) st = __builtin_amdgcn_mfma_f32_32x32x16_bf16(ak[s], bq[s], st, 0, 0, 0);
            float tmax = -__builtin_inff();
#pragma unroll
            for (int i = 0; i < 16; ++i) { const int kr = crow(i, hh); bool ok;
                if (meta) ok = kr < NMETA; else { const int dlt = (key0 + kr) - (q0 + r); ok = (dlt >= -128) && (dlt <= 128); }
                const float t = ok ? st[i] * SC : -__builtin_inff(); st[i] = t; tmax = fmaxf(tmax, t); }
            tmax = fmaxf(tmax, __shfl_xor(tmax, 32));
            const float mn = fmaxf(m, tmax), alpha = __builtin_amdgcn_exp2f(m - mn); m = mn;
            float ps = 0.f;
#pragma unroll
            for (int i = 0; i < 16; ++i) { const float p = __builtin_amdgcn_exp2f(st[i] - mn); st[i] = p; ps += p; }
            l = l * alpha + ps;
#pragma unroll
            for (int dt = 0; dt < 4; ++dt)
#pragma unroll
                for (int i = 0; i < 16; ++i) O[dt][i] *= alpha;
            bf16x8 pb[2];
#pragma unroll
            for (int s2 = 0; s2 < 2; ++s2) { v4u w; w.x = pg8::cvt_pk_bf16(st[8 * s2 + 0], st[8 * s2 + 1]); w.y = pg8::cvt_pk_bf16(st[8 * s2 + 2], st[8 * s2 + 3]);
                w.z = pg8::cvt_pk_bf16(st[8 * s2 + 4], st[8 * s2 + 5]); w.w = pg8::cvt_pk_bf16(st[8 * s2 + 6], st[8 * s2 + 7]); pb[s2] = __builtin_bit_cast(bf16x8, w); }
#pragma unroll
            for (int dt = 0; dt < 4; ++dt)
#pragma unroll
                for (int s2 = 0; s2 < 2; ++s2) { const v4u w = {av[dt][s2][0].x, av[dt][s2][0].y, av[dt][s2][1].x, av[dt][s2][1].y};
                    O[dt] = __builtin_amdgcn_mfma_f32_32x32x16_bf16(__builtin_bit_cast(bf16x8, w), pb[s2], O[dt], 0, 0, 0); }
            if (meta) break;
            ti = tn;
#pragma unroll
            for (int s = 0; s < 8; ++s) ak[s] = akn[s];
        }
        l += __shfl_xor(l, 32);
        const float inv = 1.0f / l;
        bf16* op = OA + (size_t)(q0 + r) * ATTW + hq * 128 + 4 * hh;
#pragma unroll
        for (int dt = 0; dt < 4; ++dt)
#pragma unroll
            for (int g4 = 0; g4 < 4; ++g4) { v2u w; w.x = pg8::cvt_pk_bf16(O[dt][4 * g4 + 0] * inv, O[dt][4 * g4 + 1] * inv); w.y = pg8::cvt_pk_bf16(O[dt][4 * g4 + 2] * inv, O[dt][4 * g4 + 3] * inv);
                *(v2u*)(op + 32 * dt + 8 * g4) = w; }
    }
}

__device__ __forceinline__ int blk_tok(int d, int blk, int u) { return d ? (LTOK - 1 - 16 * blk - u) : (16 * blk + u); }
__device__ __forceinline__ size_t bo_item(int hd, int d, int blk) { return (size_t)(hd * NBT + (d ? NB0 : 0) + blk) * BO_ITEM; }
__device__ __forceinline__ v4u pack8(const float (&x)[8]) { v4u o; o.x = pk2(x[0], x[1]); o.y = pk2(x[2], x[3]); o.z = pk2(x[4], x[5]); o.w = pk2(x[6], x[7]); return o; }
__device__ __forceinline__ void blockprep_item(Frame& F, LAS unsigned char* wl, const int hd, const int d, const int blk, const int j) {
    constexpr int LP = 72;
    LAS bf16* LT = (LAS bf16*)wl; LAS float* GM = (LAS float*)wl;
    const float* Wd = (const float*)(F.ws + (d ? WS_W1 : WS_W0)); const bf16* KDd = (const bf16*)(F.ws + (d ? WS_KD1 : WS_KD0)); const bf16* Bd = (const bf16*)(F.ws + (d ? WS_B1 : WS_B0));
    const bf16* KK = (const bf16*)(F.ws + WS_KK); const bf16* RR = (const bf16*)(F.ws + WS_RR);
    float* BON = (float*)(F.ws + WS_BONUS); unsigned char* BO = F.ws + WS_BO;
    const int hh = j >> 5, r31 = j & 31, c16 = j & 15, c = hd * 64 + j;
    struct Raw { float w[16]; unsigned short kd[16], b[16], kk[16], r[16]; } cur;
#pragma unroll
    for (int u = 0; u < 16; ++u) { const size_t o = (size_t)blk_tok(d, blk, u) * RC + c; cur.w[u] = Wd[o]; cur.kd[u] = KDd[o]; cur.b[u] = Bd[o]; cur.kk[u] = KK[o]; cur.r[u] = RR[o]; }
    float kt[16], rt[16], kdh[16], bh[16]; float G15;
    { float G[16];
      { float g = 1.f;
#pragma unroll
        for (int u = 0; u < 16; ++u) { g *= cur.w[u]; G[u] = g; } }
      const float rkw = F.in[14][c];
      float bsum = 0.f;
#pragma unroll
      for (int u = 0; u < 16; ++u) { kdh[u] = bf2f(cur.kd[u]); rt[u] = bf2f(cur.r[u]); const float s = wave_sum(rt[u] * kdh[u] * rkw); bsum = (j == u) ? s : bsum;
          kdh[u] = kdh[u] / G[u]; rt[u] = rt[u] * G[u]; LT[(0 * 16 + u) * LP + j] = (bf16)f2bf(kdh[u]); LT[(3 * 16 + u) * LP + j] = (bf16)f2bf(rt[u]); }
      if (j < 16) atomicAdd(BON + (size_t)blk_tok(d, blk, j) * RH + hd, bsum);
#pragma unroll
      for (int u = 0; u < 16; ++u) { kt[u] = bf2f(cur.kk[u]) * (u ? G[u - 1] : 1.f); bh[u] = bf2f(cur.b[u]) / G[u]; LT[(2 * 16 + u) * LP + j] = (bf16)f2bf(kt[u]); LT[(1 * 16 + u) * LP + j] = (bf16)f2bf(bh[u]); }
      G15 = G[15]; }
    asm volatile("" ::: "memory");
    f32x16 gacc;
#pragma unroll
    for (int i = 0; i < 16; ++i) gacc[i] = 0.f;
    { const LAS bf16* ap = LT + ((r31 < 16 ? 0 : 1) * 16 + (r31 & 15)) * LP + 8 * hh; const LAS bf16* bp = LT + ((r31 < 16 ? 2 : 3) * 16 + (r31 & 15)) * LP + 8 * hh;
#pragma unroll
      for (int s = 0; s < 4; ++s) gacc = __builtin_amdgcn_mfma_f32_32x32x16_bf16(*(const LAS bf16x8*)(ap + 16 * s), *(const LAS bf16x8*)(bp + 16 * s), gacc, 0, 0, 0); }
    float ga[16];
#pragma unroll
    for (int i = 0; i < 16; ++i) ga[i] = gacc[i];
    asm volatile("s_waitcnt lgkmcnt(0)" ::: "memory");
#pragma unroll
    for (int i = 0; i < 16; ++i) { const int row = crow(i, hh), m = row & 15, u = r31 & 15; const bool strict = (r31 < 16);
        GM[row * 32 + r31] = (strict ? (m < u) : (m <= u)) ? ga[i] : 0.f; }
#define RL(x, ln) __builtin_bit_cast(float, __builtin_amdgcn_readlane(__builtin_bit_cast(int, (x)), (ln)))
#define GREG(m) (4 * ((m) >> 3) + ((m) & 3))
#define GLN(m) (32 * (((m) >> 2) & 1))
#define B_(m, u)  RL(ga[8 + GREG(m)], (u) + GLN(m))
    float Tr[16];
#pragma unroll
    for (int m = 15; m >= 0; --m) { float s = (c16 == m) ? 1.f : 0.f;
#pragma unroll
        for (int u = m + 1; u < 16; ++u) s -= B_(m, u) * Tr[u];
        Tr[m] = s; }
#undef RL
#undef GREG
#undef GLN
#undef B_
    unsigned char* base = BO + bo_item(hd, d, blk);
    { const int a = j >> 5, jp = j & 31;
#pragma unroll
      for (int h2 = 0; h2 < 2; ++h2) { float x0[8], x1[8];
#pragma unroll
          for (int e = 0; e < 8; ++e) { x0[e] = -bh[8 * (e >> 2) + 4 * h2 + (e & 3)] * G15; x1[e] = kdh[8 * h2 + e] * G15; }
          *(v4u*)(base + BO_FB + ((a * 2 + 0) * 64 + jp + 32 * h2) * 16) = pack8(x0); *(v4u*)(base + BO_FB + ((a * 2 + 1) * 64 + jp + 32 * h2) * 16) = pack8(x1); } }
    *(float*)(base + BO_FG + 4 * j) = G15;
    { float x[8];
#pragma unroll
      for (int e = 0; e < 8; ++e) x[e] = GM[(8 * hh + e) * 32 + r31];
      *(v4u*)(base + BO_FAA + j * 16) = pack8(x); }
    if (r31 < 16) { float x[8];
#pragma unroll
        for (int e = 0; e < 8; ++e) { const float t0 = Tr[8 * (e >> 2) + (e & 3)], t1 = Tr[8 * (e >> 2) + 4 + (e & 3)]; x[e] = hh ? t1 : t0; }
        *(v4u*)(base + BO_FT + (hh * 16 + r31) * 16) = pack8(x); }
    else { float x[8];
#pragma unroll
        for (int e = 0; e < 8; ++e) x[e] = -GM[(16 + 8 * (e >> 2) + 4 * hh + (e & 3)) * 32 + r31];
        *(v4u*)(base + BO_FBP + (hh * 16 + (r31 - 16)) * 16) = pack8(x); }
    asm volatile("s_waitcnt lgkmcnt(0)" ::: "memory");
#pragma unroll
    for (int u = 0; u < 16; ++u) { LT[u * LP + j] = (bf16)f2bf(kt[u]); LT[(16 + u) * LP + j] = (bf16)f2bf(rt[u]); }
#pragma unroll
    for (int ks = 0; ks < 4; ++ks) { const int j0 = 32 * (ks >> 1) + 16 * (ks & 1) + 4 * hh; const v2u lo = *(const LAS v2u*)(LT + r31 * LP + j0), hi = *(const LAS v2u*)(LT + r31 * LP + j0 + 8);
        *(v4u*)(base + BO_FA + (ks * 64 + j) * 16) = (v4u){lo.x, lo.y, hi.x, hi.y}; }
    asm volatile("" ::: "memory");
}

__device__ __forceinline__ int tok2row(int t) { return t < NMETA ? SEQ + t : t - NMETA; }
struct Sh8 { v4u uc, up, un; };
__device__ __forceinline__ Sh8 shift8_ld(const bf16* U, int t, int col) {
    const int tc = t < LTOK ? t : LTOK - 1, tp = (t >= 1 && t - 1 < LTOK) ? t - 1 : 0, tn = t + 1 < LTOK ? t + 1 : LTOK - 1;
    Sh8 s; s.uc = *(const v4u*)(U + (size_t)tok2row(tc) * UPITCH + col); s.up = *(const v4u*)(U + (size_t)tok2row(tp) * UPITCH + col); s.un = *(const v4u*)(U + (size_t)tok2row(tn) * UPITCH + col); return s; }
__device__ __forceinline__ void shift8_fin(const Sh8& s, int t, int col, const float* mu_p, const float* mu_n, float (&x)[8]) {
    const v4u zz = {0u, 0u, 0u, 0u};
    const v4u uc = t < LTOK ? s.uc : zz, up = (t >= 1 && t - 1 < LTOK) ? s.up : zz, un = t + 1 < LTOK ? s.un : zz;
    const f32x4 mp0 = *(const f32x4*)(mu_p + col), mp1 = *(const f32x4*)(mu_p + col + 4), mn0 = *(const f32x4*)(mu_n + col), mn1 = *(const f32x4*)(mu_n + col + 4);
    const unsigned ucw[4] = {uc.x, uc.y, uc.z, uc.w}, upw[4] = {up.x, up.y, up.z, up.w}, unw[4] = {un.x, un.y, un.z, un.w};
    const float mpw[8] = {mp0[0], mp0[1], mp0[2], mp0[3], mp1[0], mp1[1], mp1[2], mp1[3]}, mnw[8] = {mn0[0], mn0[1], mn0[2], mn0[3], mn1[0], mn1[1], mn1[2], mn1[3]};
#pragma unroll
    for (int e = 0; e < 8; ++e) { const float c0 = (e & 1) ? bfhi(ucw[e >> 1]) : bflo(ucw[e >> 1]), p0 = (e & 1) ? bfhi(upw[e >> 1]) : bflo(upw[e >> 1]), n0 = (e & 1) ? bfhi(unw[e >> 1]) : bflo(unw[e >> 1]);
        x[e] = c0 + mpw[e] * (p0 - c0) + mnw[e] * (n0 - c0); }
}
__device__ __forceinline__ void flush_bf16(const LAS bf16* tile, bf16* ARR, int t0, int cbase, int lane) {
#pragma unroll
    for (int h = 0; h < 2; ++h) { const int row = (lane >> 2) + 16 * h, ch = lane & 3; const v4u v = *(const LAS v4u*)(tile + row * 32 + 8 * ch);
        if (t0 + row < LTOK) *(v4u*)(ARR + (size_t)(t0 + row) * RC + cbase + 8 * ch) = v; }
}
__device__ __forceinline__ void flush_f32(const LAS float* tile, float* ARR, int t0, int cbase, int lane) {
#pragma unroll
    for (int h = 0; h < 4; ++h) { const int row = (lane >> 3) + 8 * h, ch = lane & 7; const f32x4 v = *(const LAS f32x4*)(tile + row * 32 + 4 * ch);
        if (t0 + row < LTOK) *(f32x4*)(ARR + (size_t)(t0 + row) * RC + cbase + 4 * ch) = v; }
}
__device__ __forceinline__ void prep_phase(Frame& F) {
    constexpr int XS = 648;
    LAS bf16* Xs = (LAS bf16*)F.lds;
    LAS unsigned char* wl = F.lds + 41472 + F.wave * 9216;
    LAS bf16* Kt = (LAS bf16*)wl;
    LAS bf16* Ot = Kt + 2048;
    const bf16* U = (const bf16*)(F.ws + WS_U);
    const float* mu_p = F.in[5]; const float* mu_n = F.in[6];
    const bf16* w2t = (const bf16*)(F.ws + WS_LW2); const bf16* a2t = (const bf16*)(F.ws + WS_LA2); const bf16* g2t = (const bf16*)(F.ws + WS_LG2);
    float* W0 = (float*)(F.ws + WS_W0); float* W1 = (float*)(F.ws + WS_W1);
    bf16* KD0 = (bf16*)(F.ws + WS_KD0); bf16* KD1 = (bf16*)(F.ws + WS_KD1); bf16* B0 = (bf16*)(F.ws + WS_B0); bf16* B1 = (bf16*)(F.ws + WS_B1);
    bf16* KK = (bf16*)(F.ws + WS_KK); bf16* RR = (bf16*)(F.ws + WS_RR); bf16* VV = (bf16*)(F.ws + WS_VV); bf16* GG = (bf16*)(F.ws + WS_GG);
    const int hh = F.lane >> 5, r = F.lane & 31;
    for (int unit = blockIdx.x; unit < 257 * 4; unit += F.G) {
        const int tt = unit >> 2, t0 = tt * 32, hd = (unit & 3) * 8 + F.wave;
        __syncthreads();
        FPB0(15);
        { Sh8 sx[5];
#pragma unroll
          for (int it = 0; it < 5; ++it) { const int ci = F.tid + 512 * it; sx[it] = shift8_ld(U, t0 + ci / 80, 3 * RC + 8 * (ci % 80)); }
#pragma unroll
          for (int it = 0; it < 5; ++it) { const int ci = F.tid + 512 * it, tl = ci / 80, ch = ci % 80;
            float x[8]; shift8_fin(sx[it], t0 + tl, 3 * RC + 8 * ch, mu_p, mu_n, x);
#pragma unroll
            for (int e = 0; e < 8; ++e) { float v = x[e];
                if (ch < 24) { const float ex = __expf(2.0f * v); v = 1.0f - 2.0f / (ex + 1.0f); }
                else if (ch >= 48) v = sigmoidf_(v);
                x[e] = v; }
            v4u o; o.x = pk2(x[0], x[1]); o.y = pk2(x[2], x[3]); o.z = pk2(x[4], x[5]); o.w = pk2(x[6], x[7]);
            *(LAS v4u*)(Xs + tl * XS + 8 * ch) = o; } }
        { const int c8 = hd * 64 + 8 * (F.lane & 7);
#pragma unroll
          for (int st = 0; st < 3; ++st) { const int col = (st == 0 ? RC : st == 1 ? 0 : 2 * RC) + c8; Sh8 sq[4];
#pragma unroll
            for (int q = 0; q < 4; ++q) sq[q] = shift8_ld(U, t0 + (F.lane >> 3) + 8 * q, col);
#pragma unroll
            for (int q = 0; q < 4; ++q) { const int tl = (F.lane >> 3) + 8 * q, tq = t0 + tl; float x[8]; shift8_fin(sq[q], tq, col, mu_p, mu_n, x);
                v4u o; o.x = pk2(x[0], x[1]); o.y = pk2(x[2], x[3]); o.z = pk2(x[4], x[5]); o.w = pk2(x[6], x[7]);
                if (st == 0) *(LAS v4u*)(Kt + tl * 64 + 8 * (F.lane & 7)) = o;
                else if (tq < LTOK) *(v4u*)((st == 1 ? RR : VV) + (size_t)tq * RC + c8) = o; } } }
        __syncthreads();
        FPB1(15); FPB0(16);
        float kp[2][16], ss[16];
#pragma unroll
        for (int i = 0; i < 16; ++i) ss[i] = 0.f;
#pragma unroll
        for (int ct = 0; ct < 2; ++ct) { const int c = hd * 64 + 32 * ct + r; const float kkw = F.in[12][c];
#pragma unroll
            for (int i = 0; i < 16; ++i) { kp[ct][i] = bf2f(Kt[crow(i, hh) * 64 + 32 * ct + r]); const float kr = kp[ct][i] * kkw; ss[i] += kr * kr; } }
#pragma unroll
        for (int i = 0; i < 16; ++i) {
#pragma unroll
            for (int o = 1; o < 32; o <<= 1) ss[i] += __shfl_xor(ss[i], o);
            ss[i] = 1.0f / fmaxf(sqrtf(ss[i]), 1e-12f); }
#define LDF(dst, ptr, n) do { _Pragma("unroll") for (int s_ = 0; s_ < (n); ++s_) dst[s_] = *(const bf16x8*)((ptr) + 16 * s_); } while (0)
#define MMF(frag, xoff, n) do { _Pragma("unroll") for (int i_ = 0; i_ < 16; ++i_) acc[i_] = 0.f; const LAS bf16* ap_ = Xs + r * XS + (xoff) + 8 * hh; \
            _Pragma("unroll") for (int s_ = 0; s_ < (n); ++s_) acc = __builtin_amdgcn_mfma_f32_32x32x16_bf16(*(const LAS bf16x8*)(ap_ + 16 * s_), frag[s_], acc, 0, 0, 0); } while (0)
#pragma unroll
        for (int ct = 0; ct < 2; ++ct) {
            const int c = hd * 64 + 32 * ct + r, cb = hd * 64 + 32 * ct;
            const float kkw = F.in[12][c], kaw = F.in[13][c];
            const bf16* pa0 = a2t + (size_t)c * 96 + 8 * hh; const bf16* pa1 = a2t + ((size_t)RC + c) * 96 + 8 * hh;
            const bf16* pw0 = w2t + (size_t)c * 96 + 8 * hh; const bf16* pw1 = w2t + ((size_t)RC + c) * 96 + 8 * hh; const bf16* pg = g2t + (size_t)c * 256 + 8 * hh;
            bf16x8 fa[6], fg[16]; f32x16 acc; float kk[16];
            LDF(fa, pa0, 6);
#pragma unroll
            for (int i = 0; i < 16; ++i) { kk[i] = kp[ct][i] * kkw * ss[i]; Ot[crow(i, hh) * 32 + r] = (bf16)f2bf(kk[i]); }
            flush_bf16(Ot, KK, t0, cb, F.lane);
#pragma unroll
            for (int d = 0; d < 2; ++d) {
                if (d == 0) { MMF(fa, 192, 6); LDF(fa, pa1, 6); } else { MMF(fa, 288, 6); LDF(fa, pw0, 6); }
                const float a0 = F.in[9][d * RC + c];
#pragma unroll
                for (int i = 0; i < 16; ++i) { acc[i] = sigmoidf_(a0 + acc[i]); Ot[crow(i, hh) * 32 + r] = (bf16)f2bf(kp[ct][i] * (1.0f + (acc[i] - 1.0f) * kaw)); }
                flush_bf16(Ot, d ? KD1 : KD0, t0, cb, F.lane);
#pragma unroll
                for (int i = 0; i < 16; ++i) Ot[crow(i, hh) * 32 + r] = (bf16)f2bf(kk[i] * acc[i]);
                flush_bf16(Ot, d ? B1 : B0, t0, cb, F.lane);
            }
#pragma unroll
            for (int d = 0; d < 2; ++d) {
                if (d == 0) { MMF(fa, 0, 6); LDF(fa, pw1, 6); } else { MMF(fa, 96, 6); LDF(fg, pg, 16); }
                const float w0 = F.in[7][d * RC + c]; LAS float* Of = (LAS float*)Ot;
#pragma unroll
                for (int i = 0; i < 16; ++i) Of[crow(i, hh) * 32 + r] = __expf(-0.6065306597126334f * sigmoidf_(w0 + acc[i]));
                flush_f32(Of, d ? W1 : W0, t0, cb, F.lane);
            }
            MMF(fg, 384, 16);
#pragma unroll
            for (int i = 0; i < 16; ++i) Ot[crow(i, hh) * 32 + r] = (bf16)f2bf(acc[i]);
            flush_bf16(Ot, GG, t0, cb, F.lane);
        }
#undef LDF
#undef MMF
        asm volatile("s_waitcnt vmcnt(0) lgkmcnt(0)" ::: "memory");
#pragma unroll 1
        for (int q = 0; q < 4; ++q) { const int d = q >> 1, half = q & 1; const int blk = d ? (NB1 - 2 * tt - half) : (2 * tt + half);
            int lzq; asm volatile("v_mov_b32 %0, 0" : "=v"(lzq));
            if (blk >= 0 && blk < (d ? NB1 : NB0)) blockprep_item(F, wl, hd, d, blk, F.lane + lzq); }
        FPB1(16);
    }
    __syncthreads();
}

constexpr int N_SCAN_WAVES = 128;
constexpr int SR_SLOTS = 8, SR_STRIDE = 12288, SR_FV = 11264, SR_FLAGS = SR_SLOTS * SR_STRIDE, SR_WSCR = SR_FLAGS + 512, SR_NL = 4;
static_assert(SR_WSCR + (7 - SR_NL) * 8448 <= RING_BYTES, "scan phase LDS map");
struct LdSet { v4u p[11]; unsigned short v[8]; };
__device__ __forceinline__ void sr_issue(LdSet& s, const unsigned char* item, const bf16* VV, int hd, int d, int blk, int ih, int lane) {
#pragma unroll
    for (int k = 0; k < 11; ++k) { const int pc = k * 64 + lane; s.p[k] = *(const v4u*)(item + (pc < BO_ITEM / 16 ? pc : BO_ITEM / 16 - 1) * 16); }
    const int hh = lane >> 5, il = lane & 31;
#pragma unroll
    for (int e = 0; e < 8; ++e) s.v[e] = VV[(size_t)blk_tok(d, blk, 8 * hh + e) * RC + hd * 64 + 32 * ih + il];
}
__device__ __forceinline__ void sr_write(const LdSet& s, LAS unsigned char* slot, int lane) {
#pragma unroll
    for (int k = 0; k < 11; ++k) *(LAS v4u*)(slot + (k * 64 + lane) * 16) = s.p[k];
    const v4u vw = {(unsigned)s.v[0] | ((unsigned)s.v[1] << 16), (unsigned)s.v[2] | ((unsigned)s.v[3] << 16), (unsigned)s.v[4] | ((unsigned)s.v[5] << 16), (unsigned)s.v[6] | ((unsigned)s.v[7] << 16)};
    *(LAS v4u*)(slot + SR_FV + lane * 16) = vw;
}
__device__ __forceinline__ bf16x8 pack_half(const f32x16& x, int s) {
    const v4u w = {pk2(x[8 * s + 0], x[8 * s + 1]), pk2(x[8 * s + 2], x[8 * s + 3]), pk2(x[8 * s + 4], x[8 * s + 5]), pk2(x[8 * s + 6], x[8 * s + 7])}; return __builtin_bit_cast(bf16x8, w); }
__device__ __forceinline__ void scan_phase(Frame& F) {
    const bf16* VV = (const bf16*)(F.ws + WS_VV); bf16* Y = (bf16*)(F.ws + WS_Y); const unsigned char* BO = F.ws + WS_BO;
    const bool sblock = (int)blockIdx.x < N_SCAN_WAVES;
    volatile LAS unsigned* FL = (volatile LAS unsigned*)(F.lds + SR_FLAGS);
    constexpr unsigned SPIN_CAP = 1u << 22;
    __syncthreads();
    if (F.tid < 128) FL[F.tid] = 0u;
    __syncthreads();
    const int pair = ((int)blockIdx.x & 7) | (((int)blockIdx.x >> 4) << 3), ih = ((int)blockIdx.x >> 3) & 1, hd = pair >> 1, d = pair & 1, nblk = d ? NB1 : NB0, hh = F.lane >> 5, il = F.lane & 31;
    if (sblock && F.wave == 0) {
        __builtin_amdgcn_s_setprio(3);
        f32x16 St[2];
#pragma unroll
        for (int a = 0; a < 2; ++a)
#pragma unroll
            for (int i = 0; i < 16; ++i) St[a][i] = 0.f;
        FPB0(17);
        const unsigned long long scan_t0 = ((PROBE_PHASE >> 21) & 1) ? __builtin_amdgcn_s_memrealtime() : 0ull;
        for (int blk = 0; blk < nblk; ++blk) {
            const int sl = blk % SR_SLOTS; const LAS unsigned char* slot = F.lds + sl * SR_STRIDE;
            { unsigned sp = 0; while (FL[sl] != (unsigned)(blk + 1)) { __builtin_amdgcn_s_sleep(1); if (++sp > SPIN_CAP) break; } }
            asm volatile("" ::: "memory");
            bf16x8 fa[4], fb[2][2]; f32x4 gm[2][4];
#pragma unroll
            for (int ks = 0; ks < 4; ++ks) fa[ks] = *(const LAS bf16x8*)(slot + BO_FA + (ks * 64 + F.lane) * 16);
            const bf16x8 faa = *(const LAS bf16x8*)(slot + BO_FAA + F.lane * 16), vf = *(const LAS bf16x8*)(slot + SR_FV + F.lane * 16);
            bf16x8 ft = *(const LAS bf16x8*)(slot + BO_FT + (hh * 16 + (il & 15)) * 16), fbp = *(const LAS bf16x8*)(slot + BO_FBP + (hh * 16 + (il & 15)) * 16);
            { const bf16x8 zz = {0, 0, 0, 0, 0, 0, 0, 0}; ft = (il < 16) ? ft : zz; fbp = (il >= 16) ? fbp : zz; }
#pragma unroll
            for (int a = 0; a < 2; ++a)
#pragma unroll
                for (int k = 0; k < 2; ++k) fb[a][k] = *(const LAS bf16x8*)(slot + BO_FB + ((a * 2 + k) * 64 + F.lane) * 16);
#pragma unroll
            for (int a = 0; a < 2; ++a)
#pragma unroll
                for (int q = 0; q < 4; ++q) gm[a][q] = *(const LAS f32x4*)(slot + BO_FG + (32 * a + 8 * q + 4 * hh) * 4);
            asm volatile("s_waitcnt lgkmcnt(0)" ::: "memory");
            if (F.lane == 0) FL[16] = (unsigned)(blk + 1);
            f32x16 acc, accp;
#pragma unroll
            for (int i = 0; i < 16; ++i) { acc[i] = 0.f; accp[i] = 0.f; }
            acc = __builtin_amdgcn_mfma_f32_32x32x16_bf16(faa, vf, acc, 0, 0, 0);
#pragma unroll
            for (int a = 0; a < 2; ++a)
#pragma unroll
                for (int s = 0; s < 2; ++s) acc = __builtin_amdgcn_mfma_f32_32x32x16_bf16(fa[2 * a + s], pack_half(St[a], s), acc, 0, 0, 0);
            accp = __builtin_amdgcn_mfma_f32_32x32x16_bf16(ft, pack_half(acc, 0), accp, 0, 0, 0);
            const bf16x8 pb = pack_half(accp, 0);
            acc = __builtin_amdgcn_mfma_f32_32x32x16_bf16(fbp, pb, acc, 0, 0, 0);
#pragma unroll
            for (int e = 0; e < 8; ++e) { const int u = 8 * (e >> 2) + 4 * hh + (e & 3);
                Y[((size_t)d * LTOK + blk_tok(d, blk, u)) * RC + hd * 64 + 32 * ih + il] = (bf16)f2bf(acc[8 + e]); }
#pragma unroll
            for (int a = 0; a < 2; ++a) {
#pragma unroll
                for (int i = 0; i < 16; ++i) St[a][i] *= gm[a][i >> 2][i & 3];
                St[a] = __builtin_amdgcn_mfma_f32_32x32x16_bf16(fb[a][0], pb, St[a], 0, 0, 0);
                St[a] = __builtin_amdgcn_mfma_f32_32x32x16_bf16(fb[a][1], vf, St[a], 0, 0, 0);
            }
        }
        FPB1(17);
        if ((PROBE_PHASE >> 21) & 1) { if (F.lane == 0) atomicMax((unsigned*)(F.ctl + 2048), (unsigned)(__builtin_amdgcn_s_memrealtime() - scan_t0)); }
        __builtin_amdgcn_s_setprio(0);
    } else if (sblock && F.wave <= SR_NL) {
        const int lw = F.wave - 1;
        LdSet st[2];
#define SR_PUT(set, b_) do { const int sl_ = (b_) % SR_SLOTS; if ((b_) >= SR_SLOTS) { unsigned sp_ = 0; while (FL[16] < (unsigned)((b_) - SR_SLOTS + 1)) { __builtin_amdgcn_s_sleep(1); if (++sp_ > SPIN_CAP) break; } } \
            asm volatile("" ::: "memory"); sr_write(set, F.lds + sl_ * SR_STRIDE, F.lane); asm volatile("s_waitcnt lgkmcnt(0)" ::: "memory"); if (F.lane == 0) FL[sl_] = (unsigned)((b_) + 1); } while (0)
#pragma unroll
        for (int k = 0; k < 2; ++k) { const int bb = lw + SR_NL * k; if (bb < nblk) sr_issue(st[k], BO + bo_item(hd, d, bb), VV, hd, d, bb, ih, F.lane); }
        for (int b0 = lw; b0 < nblk; b0 += 2 * SR_NL) {
#pragma unroll
            for (int k = 0; k < 2; ++k) { const int bb = b0 + SR_NL * k; if (bb < nblk) { SR_PUT(st[k], bb); const int nb = bb + 2 * SR_NL; if (nb < nblk) sr_issue(st[k], BO + bo_item(hd, d, nb), VV, hd, d, nb, ih, F.lane); } }
        }
#undef SR_PUT
    } else {
        const int b = (int)blockIdx.x, nsb = F.G < N_SCAN_WAVES ? F.G : N_SCAN_WAVES, wps = 7 - SR_NL;
        const int widx = b < N_SCAN_WAVES ? b * wps + (F.wave - 1 - SR_NL) : nsb * wps + (b - N_SCAN_WAVES) * 8 + F.wave;
        const int NWK = nsb * wps + (F.G - nsb) * 8;
        unsigned long long rp0 = 0, rp1 = 0, rp2 = 0;
        if (PROBE_PHASE & ((3 << 18) | (1 << 22))) rp0 = __builtin_amdgcn_s_memrealtime();
        LAS float* scr = (LAS float*)(F.lds + (sblock ? SR_WSCR + (F.wave - 1 - SR_NL) * 8448 : F.wave * 8448));
        attn_phase(F, widx, NWK);
        if (PROBE_PHASE & (3 << 18)) rp1 = __builtin_amdgcn_s_memrealtime();
        convert_p4(F, scr, widx, NWK, sblock ? -1 : (b - N_SCAN_WAVES) * 8 + F.wave, (F.G - nsb) * 8);
        if (PROBE_PHASE & (3 << 18)) { rp2 = __builtin_amdgcn_s_memrealtime(); if ((int)blockIdx.x == F.G - 1 && F.tid == 0) { unsigned long long v = 0; if ((PROBE_PHASE >> 18) & 1) v += rp1 - rp0; if ((PROBE_PHASE >> 19) & 1) v += rp2 - rp1;
            __hip_atomic_store((unsigned*)(F.ctl + 2048), (unsigned)v, __ATOMIC_RELAXED, __HIP_MEMORY_SCOPE_AGENT); } }
        if ((PROBE_PHASE >> 22) & 1) { if (blockIdx.x == 0 && F.wave == 5 && F.lane == 0) __hip_atomic_store((unsigned*)(F.ctl + 2048), (unsigned)(__builtin_amdgcn_s_memrealtime() - rp0), __ATOMIC_RELAXED, __HIP_MEMORY_SCOPE_AGENT); }
    }
}

__device__ __forceinline__ float row16_sum(float x) {
    x += __builtin_bit_cast(float, __builtin_amdgcn_update_dpp(0, __builtin_bit_cast(int, x), 0xB1, 0xf, 0xf, true));
    x += __builtin_bit_cast(float, __builtin_amdgcn_update_dpp(0, __builtin_bit_cast(int, x), 0x4E, 0xf, 0xf, true));
    x += __builtin_bit_cast(float, __builtin_amdgcn_update_dpp(0, __builtin_bit_cast(int, x), 0x141, 0xf, 0xf, true));
    x += __builtin_bit_cast(float, __builtin_amdgcn_update_dpp(0, __builtin_bit_cast(int, x), 0x140, 0xf, 0xf, true));
    return x;
}
__device__ __forceinline__ void combine_phase(Frame& F) {
    const bf16* Y0 = (const bf16*)(F.ws + WS_Y); const bf16* Y1 = Y0 + (size_t)LTOK * RC; const float* BON = (const float*)(F.ws + WS_BONUS);
    const bf16* VV = (const bf16*)(F.ws + WS_VV); const bf16* GG = (const bf16*)(F.ws + WS_GG);
    bf16* OR = (bf16*)(F.ws + WS_ORWKV);
    const float* lnw = F.in[15]; const float* lnb = F.in[16];
    const int gw = blockIdx.x * 8 + F.wave, NGW = F.G * 8;
    for (int row = gw; row < SEQ; row += NGW) { const int t = row + NMETA;
#pragma unroll
        for (int st = 0; st < 8; ++st) { const int c = st * 256 + 4 * F.lane, hd = c >> 6; const size_t o = (size_t)t * RC + c;
            const v2u a0 = *(const v2u*)(Y0 + o), a1 = *(const v2u*)(Y1 + o), vv = *(const v2u*)(VV + o), gg = *(const v2u*)(GG + o);
            const f32x4 w = *(const f32x4*)(lnw + c), bb = *(const f32x4*)(lnb + c); const float bon = BON[(size_t)t * RH + hd];
            float y[4] = {bflo(a0.x) + bflo(a1.x), bfhi(a0.x) + bfhi(a1.x), bflo(a0.y) + bflo(a1.y), bfhi(a0.y) + bfhi(a1.y)};
            const float mean = row16_sum((y[0] + y[1]) + (y[2] + y[3])) * (1.0f / 64.0f);
#pragma unroll
            for (int e = 0; e < 4; ++e) y[e] -= mean;
            const float var = row16_sum((y[0] * y[0] + y[1] * y[1]) + (y[2] * y[2] + y[3] * y[3])) * (1.0f / 64.0f);
            const float rs = __builtin_amdgcn_rsqf(var + GN_EPS);
            const float v4[4] = {bflo(vv.x), bfhi(vv.x), bflo(vv.y), bfhi(vv.y)}, g4[4] = {bflo(gg.x), bfhi(gg.x), bflo(gg.y), bfhi(gg.y)};
            float ov[4];
#pragma unroll
            for (int e = 0; e < 4; ++e) ov[e] = (y[e] * rs * w[e] + bb[e] + bon * v4[e]) * g4[e];
            v2u ow; ow.x = pk2(ov[0], ov[1]); ow.y = pk2(ov[2], ov[3]);
            *(v2u*)(OR + (size_t)row * RC + c) = ow; } }
}
__device__ __forceinline__ void final_phase(Frame& F) {
    const float* SS3 = (const float*)(F.ctl + CW_SS3); const float* w = F.in[25];
    const int gw = blockIdx.x * 8 + F.wave, NGW = F.G * 8;
    for (int row = gw; row < SEQ; row += NGW) { const float rstd = 1.0f / sqrtf(SS3[row] * (1.0f / DM) + RMS_EPS);
        GAS f32x4* p = (GAS f32x4*)(F.out + (size_t)row * DM) + F.lane; const GAS f32x4* wp = (const GAS f32x4*)w + F.lane;
#pragma unroll
        for (int j = 0; j < 16; ++j) { const f32x4 v = p[64 * j], ww = wp[64 * j]; p[64 * j] = v * rstd * ww; } }
}
constexpr int N_PHASES = 10;
struct Args { const float* in[26]; float* out; unsigned char* ws; int ph_lo, ph_hi; };
__global__ void __launch_bounds__(512, 2) fwd_kernel(Args args) {
    extern __shared__ __attribute__((aligned(16))) unsigned char lds[];
    Frame F;
    F.lds = (LAS unsigned char*)lds;
    F.MISC = (volatile LAS unsigned*)(F.lds + MISC_OFF);
    F.tid = threadIdx.x; F.lane = F.tid & 63; F.wave = __builtin_amdgcn_readfirstlane(F.tid >> 6); F.G = gridDim.x;
    F.ws = args.ws; F.ctl = (gu32*)(args.ws + WS_CTL); F.out = args.out; F.pb0 = 0; F.pacc = 0; F.pacc2 = 0;
#pragma unroll
    for (int i = 0; i < 26; ++i) F.in[i] = args.in[i];
    for (int u = F.tid; u < (LDS_BYTES - LDSCTL_OFF) / 4; u += 512) ((LAS unsigned*)(F.lds + LDSCTL_OFF))[u] = 0u;
    __syncthreads();
    XcdBarrier bar; bar.bar = (unsigned*)(F.ctl + CW_BAR); bar.x = 0; bar.st = nullptr;
    if (!MK_SPLIT) bar = xcd_barrier_post((unsigned*)(F.ctl + CW_BAR), F.MISC + 8);
    const int lo = args.ph_lo, hi = args.ph_hi;
#define IN(k) (lo <= (k) && (k) < hi)
#define SEAM(k) do { if (IN(k) && IN((k) + 1)) xcd_barrier(bar); } while (0)
    bf16* Rm = (bf16*)(F.ws + WS_H);
    float* SS2 = (float*)(F.ctl + CW_SS2); float* SS3 = (float*)(F.ctl + CW_SS3);

    unsigned long long pt0 = 0, pt1 = 0;
#define PB0(k) do { if ((PROBE_PHASE >> (k)) & 1) pt0 = __builtin_amdgcn_s_memrealtime(); } while (0)
#define PB1(k) do { if ((PROBE_PHASE >> (k)) & 1) pt1 += __builtin_amdgcn_s_memrealtime() - pt0; } while (0)
    PB0(0); if (IN(0)) { p0_prologue(F); } SEAM(0); PB1(0);
    PB0(1); if (IN(1)) {
        pg8::Gemm g{Rm, Rm, MPAD + INWP, MPAD + INWP, DM}; pg8::InOrder S; S.init(F.G, (int)blockIdx.x);
        pg8::EpiIn E{(bf16*)(F.ws + WS_G), (bf16*)(F.ws + WS_Q), (bf16*)(F.ws + WS_K), (bf16*)(F.ws + WS_VT), (bf16*)(F.ws + WS_U), F.in[4], (const float*)(F.ws + WS_ROPE)};
        pg8::gemm_phase<pg8::EpiIn, pg8::InOrder, true, true>(F.lds, g, S, E, F.pacc2);
    } SEAM(1); PB1(1);
    PB0(2); if (IN(2)) { prep_phase(F); } SEAM(2); PB1(2);
    PB0(3); if (IN(3)) { scan_phase(F); } SEAM(3); PB1(3);
    PB0(4); if (IN(4)) { combine_phase(F); } SEAM(4); PB1(4);
    PB0(5); if (IN(5)) {
        { pg8::Gemm g{(const bf16*)(F.ws + WS_OATT), (const bf16*)(F.ws + WS_WPA), SEQ, DM, ATTW}; pg8::StaticOrder S; S.init(SEQ, DM, F.G, (int)blockIdx.x);
          pg8::EpiProjA E{(bf16*)(F.ws + WS_P1), (const bf16*)(F.ws + WS_G)};
          pg8::gemm_phase<pg8::EpiProjA, pg8::StaticOrder, true, true>(F.lds, g, S, E, F.pacc2); }
        __syncthreads();
        { pg8::Gemm g{(const bf16*)(F.ws + WS_ORWKV), (const bf16*)(F.ws + WS_WPR), SEQ, DM, RC}; pg8::StaticOrder S; S.init(SEQ, DM, F.G, (int)blockIdx.x);
          pg8::EpiProjB E{(const bf16*)(F.ws + WS_P1), (const bf16*)(F.ws + WS_G), (bf16*)(F.ws + WS_MX)};
          pg8::gemm_phase<pg8::EpiProjB, pg8::StaticOrder, true, true>(F.lds, g, S, E, F.pacc2); }
    } SEAM(5); PB1(5);
    PB0(6); if (IN(6)) {
        pg8::Gemm g{(const bf16*)(F.ws + WS_MX), (const bf16*)(F.ws + WS_WOUT), SEQ, DM, DM}; pg8::StaticOrder S; S.init(SEQ, DM, F.G, (int)blockIdx.x);
        pg8::EpiResid<false> E{F.in[0], nullptr, nullptr, (bf16*)(F.ws + WS_A2), SS2};
        pg8::gemm_phase<pg8::EpiResid<false>, pg8::StaticOrder, true, true>(F.lds, g, S, E, F.pacc2);
    } SEAM(6); PB1(6);
    const unsigned long long epi_before7 = F.pacc2;
    PB0(7); if (IN(7)) {
        pg8::Gemm g{(const bf16*)(F.ws + WS_A2), (const bf16*)(F.ws + WS_WGU), SEQ, 2 * DFF, DM}; pg8::StaticOrder S; S.init(SEQ, 2 * DFF, F.G, (int)blockIdx.x);
        pg8::EpiSwiGLU E{(bf16*)(F.ws + WS_HID), SS2};
        pg8::gemm_phase<pg8::EpiSwiGLU, pg8::StaticOrder, true, true>(F.lds, g, S, E, F.pacc2);
        {
          const int nun = (SEQ / 256) * (2 * DFF / 256), rounds = (nun + F.G - 1) / F.G, first_idle = nun - (rounds - 1) * F.G;
          const int nidle = F.G - first_idle;
          if (nidle > 0) { if ((int)blockIdx.x >= first_idle) convert_wd(F, (LAS float*)(F.lds + F.wave * 8448), ((int)blockIdx.x - first_idle) * 8 + F.wave, nidle * 8); }
          else convert_wd(F, (LAS float*)(F.lds + F.wave * 8448), (int)blockIdx.x * 8 + F.wave, F.G * 8); }
    } SEAM(7); PB1(7);
    const unsigned long long epi_before8 = F.pacc2;
    PB0(8); if (IN(8)) {
        pg8::Gemm g{(const bf16*)(F.ws + WS_HID), (const bf16*)(F.ws + WS_WD), SEQ, DM, DFF}; pg8::StaticOrder S; S.init(SEQ, DM, F.G, (int)blockIdx.x);
        pg8::EpiResid<true> E{nullptr, (const bf16*)(F.ws + WS_A2), F.out, nullptr, SS3};
        pg8::gemm_phase<pg8::EpiResid<true>, pg8::StaticOrder, true, true>(F.lds, g, S, E, F.pacc2);
    } SEAM(8); PB1(8);
    const unsigned long long epi9 = ((PROBE_PHASE >> 24) & 1) ? (epi_before8 - epi_before7) : (F.pacc2 - epi_before8);
    PB0(9); if (IN(9)) { final_phase(F); } PB1(9);
    if (PROBE_PHASE != 0 && blockIdx.x == 0 && F.tid == 0) { const unsigned long long te = __builtin_amdgcn_s_memrealtime(), want = (unsigned long long)PROBE_MULT * (((PROBE_PHASE >> 23) & 1) ? epi9 : ((PROBE_PHASE >> 20) & 1) ? F.pacc2 : (PROBE_PHASE & ((3 << 18) | (3 << 21))) ? (unsigned long long)__hip_atomic_load((unsigned*)(F.ctl + 2048), __ATOMIC_RELAXED, __HIP_MEMORY_SCOPE_AGENT) : (pt1 + F.pacc));
        while (__builtin_amdgcn_s_memrealtime() - te < want && want < 2000000ull) __builtin_amdgcn_s_sleep(32); }
#undef PB0
#undef PB1
#undef IN
#undef SEAM
}

extern "C" void kernel_launch(void* const* d_in, const int* in_sizes, int n_in, void* d_out, int out_size, void* d_ws, size_t ws_size, hipStream_t stream) {
    static int grid = 0;
    if (grid == 0) {
        if (n_in != 26 || out_size != SEQ * DM || ws_size < WS_END) { fprintf(stderr, "kernel_launch: unexpected shapes (n_in %d, out %d, ws %zu, need %zu); nothing launched\n", n_in, out_size, ws_size, (size_t)WS_END); grid = -1; return; }
        int dev = 0, cus = 0, per_cu = 0;
        if (hipGetDevice(&dev) != hipSuccess || hipDeviceGetAttribute(&cus, hipDeviceAttributeMultiprocessorCount, dev) != hipSuccess) { grid = -1; return; }
        if (hipFuncSetAttribute((const void*)fwd_kernel, hipFuncAttributeMaxDynamicSharedMemorySize, LDS_BYTES) != hipSuccess) { fprintf(stderr, "kernel_launch: hipFuncSetAttribute failed\n"); grid = -1; return; }
        if (hipOccupancyMaxActiveBlocksPerMultiprocessor(&per_cu, (const void*)fwd_kernel, 512, LDS_BYTES) != hipSuccess || per_cu < 1) fprintf(stderr, "kernel_launch: occupancy query says %d per CU\n", per_cu);
        (void)hipGetLastError();
        grid = cus;
    }
    if (grid < 0) return;
    if (hipMemsetAsync((char*)d_ws + WS_CTL, 0, ZERO_BYTES, stream) != hipSuccess) return;
    Args a{};
    for (int i = 0; i < 26; ++i) a.in[i] = (const float*)d_in[i];
    a.out = (float*)d_out; a.ws = (unsigned char*)d_ws;
#if MK_SPLIT
    for (int p = 0; p < N_PHASES; ++p) { a.ph_lo = p; a.ph_hi = p + 1; hipLaunchKernelGGL(fwd_kernel, dim3(grid), dim3(512), LDS_BYTES, stream, a); }
#else
    a.ph_lo = 0; a.ph_hi = N_PHASES;
    hipLaunchKernelGGL(fwd_kernel, dim3(grid), dim3(512), LDS_BYTES, stream, a);
#endif
}
```

```cpp
#include <hip/hip_runtime.h>
#include <cstdio>
#include <cstdint>

#ifndef MK_SPLIT
#define MK_SPLIT 0
#endif

#ifndef PROBE_PHASE
#define PROBE_PHASE 0
#endif
#ifndef PROBE_MULT
#define PROBE_MULT 2
#endif
constexpr int NMETA = 16, SEQ = 8192, LTOK = 8208, DM = 4096, MPAD = 8448;
constexpr int INW = 18048, INWP = 18176;
constexpr int ATTW = 2048, KVW = 512, UW = 6784, UPITCH = 6912;
constexpr int RC = 2048, RH = 32, RN = 64;
constexpr int DFF = 11008;
constexpr float RMS_EPS = 1e-6f, GN_EPS = 64e-5f;
constexpr int HT = MPAD / 256;
constexpr int CT_Q = 32, CT_K = 40, CT_V = 42, CT_U = 44, CT_N = 71;

namespace pg8 {
#define PG8_LAS __attribute__((address_space(3)))
typedef unsigned short bf16_t;
typedef short bf16x8 __attribute__((ext_vector_type(8)));
typedef float f32x4 __attribute__((ext_vector_type(4)));
typedef unsigned u32x4 __attribute__((ext_vector_type(4)));
constexpr int BM = 256, BK = 64, HALF = 128, HTB = HALF * BK * 2  , STAGE_BYTES = 8 * HTB, NXCD = 8, WGM = 8;

__host__ __device__ __forceinline__ int lds_byte(int r, int c) { const int st = (r >> 4) * 2 + (c >> 5), rr = r & 15, cc = c & 31, ob = rr * 64 + cc * 2; return st * 1024 + (ob ^ (((ob >> 9) & 1) << 5)); }
__host__ __device__ __forceinline__ void stage_rc(int b, int& R, int& C) { const int st = b / 1024, sb = b % 1024, swz = sb ^ (((sb >> 9) & 1) << 5); R = (st >> 1) * 16 + swz / 64; C = (st & 1) * 32 + (swz % 64) / 2; }
__host__ __device__ __forceinline__ int perm32(int rho) { const int n = rho >> 4, i = rho & 15; return 8 * (i >> 2) + 4 * n + (i & 3); }

struct Unit { int pm, pn; };
struct Gemm { const bf16_t* A; const bf16_t* Bt; int M, N, K; };

struct StaticOrder {
    int nM, nN, nwg, G, c;
    __host__ __device__ void init(int M, int N, int G_, int c_) { nM = M / BM; nN = N / BM; nwg = nM * nN; G = G_; c = c_; }
    __host__ __device__ bool next(int i, Unit& u) const {
        const long L = (long)i * G + c; if (L >= nwg) return false;
        int wgid = (int)L; { const int q = nwg / NXCD, r = nwg % NXCD, xcd = wgid % NXCD, off = wgid / NXCD; wgid = (xcd < r ? xcd * (q + 1) : r * (q + 1) + (xcd - r) * q) + off; }
        const int nig = WGM * nN, gid = wgid / nig, fm = gid * WGM, gsz = (nM - fm) < WGM ? (nM - fm) : WGM;
        u.pm = fm + ((wgid % nig) % gsz); u.pn = (wgid % nig) / gsz; return true;
    }
    __device__ __forceinline__ void a_ready(const Unit&) const {}
    __device__ __forceinline__ void done(const Unit&) const {}
};

typedef float f32x2c __attribute__((ext_vector_type(2)));
typedef __bf16 bf16x2c __attribute__((ext_vector_type(2)));
__device__ __forceinline__ unsigned cvt_pk_bf16(float lo, float hi) { const f32x2c v = {lo, hi}; const bf16x2c r = __builtin_convertvector(v, bf16x2c); return __builtin_bit_cast(unsigned, r); }

typedef unsigned u32x2 __attribute__((ext_vector_type(2)));
__device__ __forceinline__ float bflo(unsigned w) { return __uint_as_float(w << 16); }
__device__ __forceinline__ float bfhi(unsigned w) { return __uint_as_float(w & 0xffff0000u); }
__device__ __forceinline__ float sigmoidf_(float x) { return __builtin_amdgcn_rcpf(1.0f + __expf(-x)); }

struct InOrder {
    StaticOrder base; int G, c;
    __device__ void init(int G_, int c_) { base.init(SEQ, INWP, G_, c_); G = G_; c = c_; }
    __device__ bool next(int i, Unit& u) const {
        const long L = (long)i * G + c;
        if (L < base.nwg) {
            base.next(i, u);
            if (u.pn >= CT_V && u.pn < CT_U) { const int e = (u.pn - CT_V) * 32 + u.pm; u.pm = HT + CT_V + e / HT; u.pn = e % HT; }
            else u.pn += HT;
            return true;
        }
        const int x = (int)(L - base.nwg);
        if (x >= 31) return false;
        if (x < 2) { const int e = 64 + x; u.pm = HT + CT_V + e / HT; u.pn = e % HT; }
        else { const int y = x - 2; u.pm = 32; u.pn = HT + (y < 2 ? CT_K + y : CT_U + (y - 2)); }
        return true;
    }
    __device__ __forceinline__ void a_ready(const Unit&) const {}
    __device__ __forceinline__ void done(const Unit&) const {}
};

struct EpiIn {
    static constexpr bool PERM = true, AFTER_DRAIN = false;
    bf16_t *G, *Q, *K, *Vt, *U; const float* bgate; const float* rope;
    __device__ __forceinline__ static void st8(bf16_t* p, const f32x4& v0, const f32x4& v1) {
        u32x4 w; w.x = cvt_pk_bf16(v0[0], v0[1]); w.y = cvt_pk_bf16(v0[2], v0[3]); w.z = cvt_pk_bf16(v1[0], v1[1]); w.w = cvt_pk_bf16(v1[2], v1[3]); *(u32x4*)p = w; }
    __device__ __forceinline__ void plain(const f32x4 (&acc)[2][2][4][2], bf16_t* base, int ldc, int row0, int col0) const {
#pragma unroll
        for (int ai = 0; ai < 2; ++ai)
#pragma unroll
            for (int m = 0; m < 4; ++m) { bf16_t* rowp = base + (size_t)(row0 + ai * HALF + m * 16) * ldc + col0;
#pragma unroll
                for (int bj = 0; bj < 2; ++bj) st8(rowp + bj * HALF, acc[ai][bj][m][0], acc[ai][bj][m][1]); }
    }
    __device__ __forceinline__ void roped(const f32x4 (&acc)[2][2][4][2], bf16_t* base, int ldc, int row0, int col0, int wc, int fq) const {
        if (wc != 0) { plain(acc, base, ldc, row0, col0); return; }
        const float sgn = (fq < 2) ? -1.0f : 1.0f;
#pragma unroll
        for (int ai = 0; ai < 2; ++ai)
#pragma unroll
            for (int m = 0; m < 4; ++m) { const int row = row0 + ai * HALF + m * 16; const int pos = row < SEQ ? row + NMETA : row - SEQ;
                const f32x4* cs = (const f32x4*)(rope + (size_t)pos * 32 + 16 * (fq & 1));
                const f32x4 c0 = cs[0], c1 = cs[1], c2 = cs[2], c3 = cs[3];
                const float cw[8] = {c0[0], c0[2], c1[0], c1[2], c2[0], c2[2], c3[0], c3[2]}, sw[8] = {c0[1], c0[3], c1[1], c1[3], c2[1], c2[3], c3[1], c3[3]};
                bf16_t* rowp = base + (size_t)row * ldc + col0;
#pragma unroll
                for (int bj = 0; bj < 2; ++bj) { f32x4 v0 = acc[ai][bj][m][0], v1 = acc[ai][bj][m][1], o0, o1;
#pragma unroll
                    for (int e = 0; e < 4; ++e) { const float p0 = __shfl_xor(v0[e], 32), p1 = __shfl_xor(v1[e], 32);
                        o0[e] = v0[e] * cw[e] + sgn * p0 * sw[e]; o1[e] = v1[e] * cw[4 + e] + sgn * p1 * sw[4 + e]; }
                    st8(rowp + bj * HALF, o0, o1); } }
    }
    __device__ __forceinline__ void operator()(const f32x4 (&acc)[2][2][4][2], const Unit& u, int wr, int wc, int fr, int fq) const {
        if (u.pm >= HT) {
            plain(acc, Vt, MPAD, (u.pm - HT - CT_V) * BM + wr * 64 + fr, u.pn * BM + wc * 32 + 8 * fq); return; }
        const int ct = u.pn - HT, row0 = u.pm * BM + wr * 64 + fr, cl = wc * 32 + 8 * fq;
        if (ct < CT_Q) {
            const int col0 = ct * BM + cl;
#pragma unroll
            for (int bj = 0; bj < 2; ++bj) { const f32x4 b0 = *(const f32x4*)(bgate + col0 + bj * HALF), b1 = *(const f32x4*)(bgate + col0 + bj * HALF + 4);
#pragma unroll
                for (int ai = 0; ai < 2; ++ai)
#pragma unroll
                    for (int m = 0; m < 4; ++m) { f32x4 v0 = acc[ai][bj][m][0] + b0, v1 = acc[ai][bj][m][1] + b1;
#pragma unroll
                        for (int e = 0; e < 4; ++e) { v0[e] = sigmoidf_(v0[e]); v1[e] = sigmoidf_(v1[e]); }
                        st8(G + (size_t)(row0 + ai * HALF + m * 16) * (2 * DM) + col0 + bj * HALF, v0, v1); } }
        } else if (ct < CT_K) { roped(acc, Q, ATTW, row0, (ct - CT_Q) * BM + cl, wc, fq);
        } else if (ct < CT_V) { roped(acc, K, KVW, row0, (ct - CT_K) * BM + cl, wc, fq);
        } else { plain(acc, U, UPITCH, row0, (ct - CT_U) * BM + cl); }
    }
};

struct EpiProjA {
    static constexpr bool PERM = true, AFTER_DRAIN = false;
    bf16_t* P1; const bf16_t* G;
    __device__ __forceinline__ void operator()(const f32x4 (&acc)[2][2][4][2], const Unit& u, int wr, int wc, int fr, int fq) const {
        const int row0 = u.pm * BM + wr * 64 + fr, col0 = u.pn * BM + wc * 32 + 8 * fq;
#pragma unroll
        for (int ai = 0; ai < 2; ++ai)
#pragma unroll
            for (int m = 0; m < 4; ++m) { const size_t r = (size_t)(row0 + ai * HALF + m * 16);
#pragma unroll
                for (int bj = 0; bj < 2; ++bj) { const int c = col0 + bj * HALF; const u32x4 g = *(const u32x4*)(G + r * (2 * DM) + c);
                    f32x4 o0 = acc[ai][bj][m][0], o1 = acc[ai][bj][m][1];
                    o0[0] *= bflo(g.x); o0[1] *= bfhi(g.x); o0[2] *= bflo(g.y); o0[3] *= bfhi(g.y); o1[0] *= bflo(g.z); o1[1] *= bfhi(g.z); o1[2] *= bflo(g.w); o1[3] *= bfhi(g.w);
                    EpiIn::st8(P1 + r * DM + c, o0, o1); } }
    }
};
struct EpiProjB {
    static constexpr bool PERM = true, AFTER_DRAIN = false;
    const bf16_t* P1; const bf16_t* G; bf16_t* MX;
    __device__ __forceinline__ void operator()(const f32x4 (&acc)[2][2][4][2], const Unit& u, int wr, int wc, int fr, int fq) const {
        const int row0 = u.pm * BM + wr * 64 + fr, col0 = u.pn * BM + wc * 32 + 8 * fq;
#pragma unroll
        for (int ai = 0; ai < 2; ++ai)
#pragma unroll
            for (int m = 0; m < 4; ++m) { const size_t r = (size_t)(row0 + ai * HALF + m * 16);
#pragma unroll
                for (int bj = 0; bj < 2; ++bj) { const int c = col0 + bj * HALF; const u32x4 g = *(const u32x4*)(G + r * (2 * DM) + DM + c); const u32x4 q = *(const u32x4*)(P1 + r * DM + c);
                    f32x4 o0 = {bflo(q.x), bfhi(q.x), bflo(q.y), bfhi(q.y)}, o1 = {bflo(q.z), bfhi(q.z), bflo(q.w), bfhi(q.w)}; const f32x4 a0 = acc[ai][bj][m][0], a1 = acc[ai][bj][m][1];
                    o0[0] += a0[0] * bflo(g.x); o0[1] += a0[1] * bfhi(g.x); o0[2] += a0[2] * bflo(g.y); o0[3] += a0[3] * bfhi(g.y);
                    o1[0] += a1[0] * bflo(g.z); o1[1] += a1[1] * bfhi(g.z); o1[2] += a1[2] * bflo(g.w); o1[3] += a1[3] * bfhi(g.w);
                    EpiIn::st8(MX + r * DM + c, o0, o1); }
                asm volatile("" ::: "memory"); }
    }
};
template <bool BASE_BF16> struct EpiResid {
    static constexpr bool PERM = true, AFTER_DRAIN = false;
    const float* BASEF; const bf16_t* BASEB; float* OUTF; bf16_t* OUTB; float* SS;
    __device__ __forceinline__ void operator()(const f32x4 (&acc)[2][2][4][2], const Unit& u, int wr, int wc, int fr, int fq) const {
        const int row0 = u.pm * BM + wr * 64 + fr, col0 = u.pn * BM + wc * 32 + 8 * fq;
#pragma unroll
        for (int ai = 0; ai < 2; ++ai)
#pragma unroll
            for (int m = 0; m < 4; ++m) { const size_t r = (size_t)(row0 + ai * HALF + m * 16); float ss = 0.f;
#pragma unroll
                for (int bj = 0; bj < 2; ++bj) { const int c = col0 + bj * HALF; f32x4 o0, o1;
                    if (BASE_BF16) { const u32x4 g = *(const u32x4*)(BASEB + r * DM + c); o0 = (f32x4){bflo(g.x), bfhi(g.x), bflo(g.y), bfhi(g.y)}; o1 = (f32x4){bflo(g.z), bfhi(g.z), bflo(g.w), bfhi(g.w)}; }
                    else { const float* bp = BASEF + r * DM + c; o0 = *(const f32x4*)bp; o1 = *(const f32x4*)(bp + 4); }
                    o0 += acc[ai][bj][m][0]; o1 += acc[ai][bj][m][1];
                    if (BASE_BF16) { float* op = OUTF + r * DM + c; *(f32x4*)op = o0; *(f32x4*)(op + 4) = o1; }
                    else { u32x4 w; w.x = cvt_pk_bf16(o0[0], o0[1]); w.y = cvt_pk_bf16(o0[2], o0[3]); w.z = cvt_pk_bf16(o1[0], o1[1]); w.w = cvt_pk_bf16(o1[2], o1[3]); *(u32x4*)(OUTB + r * DM + c) = w;
                        o0 = (f32x4){bflo(w.x), bfhi(w.x), bflo(w.y), bfhi(w.y)}; o1 = (f32x4){bflo(w.z), bfhi(w.z), bflo(w.w), bfhi(w.w)}; }
                    ss += (o0[0] * o0[0] + o0[1] * o0[1]) + (o0[2] * o0[2] + o0[3] * o0[3]) + (o1[0] * o1[0] + o1[1] * o1[1]) + (o1[2] * o1[2] + o1[3] * o1[3]); }
                ss += __shfl_xor(ss, 16); ss += __shfl_xor(ss, 32);
                if (fq == 0) atomicAdd(SS + r, ss);
                asm volatile("" ::: "memory"); }
    }
};
struct EpiSwiGLU {
    static constexpr bool PERM = true, AFTER_DRAIN = false;
    bf16_t* HID; const float* SS;
    __device__ __forceinline__ void operator()(const f32x4 (&acc)[2][2][4][2], const Unit& u, int wr, int wc, int fr, int fq) const {
        const int row0 = u.pm * BM + wr * 64 + fr, col0 = u.pn * HALF + wc * 32 + 8 * fq;
#pragma unroll
        for (int ai = 0; ai < 2; ++ai)
#pragma unroll
            for (int m = 0; m < 4; ++m) { const size_t r = (size_t)(row0 + ai * HALF + m * 16);
                const float rstd = __builtin_amdgcn_rsqf(SS[r] * (1.0f / DM) + RMS_EPS);
                f32x4 o0, o1;
#pragma unroll
                for (int e = 0; e < 4; ++e) { const float g0 = acc[ai][0][m][0][e] * rstd, u0 = acc[ai][1][m][0][e] * rstd, g1 = acc[ai][0][m][1][e] * rstd, u1 = acc[ai][1][m][1][e] * rstd;
                    o0[e] = g0 * sigmoidf_(g0) * u0; o1[e] = g1 * sigmoidf_(g1) * u1; }
                EpiIn::st8(HID + r * DFF + col0, o0, o1); }
    }
};

#define PG8_EPI_T0 unsigned long long epi_t0_ = 0; do { if ((PROBE_PHASE >> 20) & 1) epi_t0_ = __builtin_amdgcn_s_memrealtime(); } while (0)
#define PG8_EPI_T1 do { if ((PROBE_PHASE >> 20) & 1) epi_acc += __builtin_amdgcn_s_memrealtime() - epi_t0_; } while (0)
template <class Epi, class Sched, bool ALIGN_EPI = false, bool SP2 = false>
__device__ __forceinline__ void gemm_phase(PG8_LAS unsigned char* lds, const Gemm g, const Sched& S, const Epi& E, unsigned long long& epi_acc) {
    const int tid = threadIdx.x, wid = __builtin_amdgcn_readfirstlane(tid >> 6), lane = tid & 63, wr = wid >> 2, wc = wid & 3, fr = lane & 15, fq = lane >> 4;
    const int K = g.K, nt = K / BK;
    unsigned voffA[2], voffB[2];
#pragma unroll
    for (int i = 0; i < 2; ++i) { int R, C; stage_rc(tid * 16 + i * 8192, R, C); const int Rb = Epi::PERM ? ((R & ~31) + perm32(R & 31)) : R;
        voffA[i] = (unsigned)(R * K + C) * 2u; voffB[i] = (unsigned)(Rb * K + C) * 2u; }
    const size_t kstep = (size_t)(BK * 2);
    const size_t hstep = (size_t)HALF * K * 2;
    const size_t tstep = 2 * hstep;
    const unsigned ldsw = (unsigned)wid * 1024u;
    const int aoff = lds_byte(wr * 64 + fr, fq * 8), boff = lds_byte(wc * 32 + fr, fq * 8);
#define PG8_SA(b, h) (((b) * 2 + (h)) * HTB)
#define PG8_SB(b, h) ((4 + (b) * 2 + (h)) * HTB)
#define PG8_STAGE(bufoff, gbase, voff) do { _Pragma("unroll") for (int _i = 0; _i < 2; ++_i) \
        __builtin_amdgcn_global_load_lds((const unsigned*)((const char*)(gbase) + (voff)[_i]), (PG8_LAS unsigned*)(lds + (bufoff) + ldsw + _i * 8192), 16, 0, 0); } while (0)
#define PG8_LDA(dst, b, h) do { _Pragma("unroll") for (int m = 0; m < 4; ++m) _Pragma("unroll") for (int k = 0; k < 2; ++k) dst[m][k] = *(const PG8_LAS bf16x8*)(lds + PG8_SA(b, h) + aoff + m * 2048 + k * 1024); } while (0)
#define PG8_LDB(dst, b, h) do { _Pragma("unroll") for (int n = 0; n < 2; ++n) _Pragma("unroll") for (int k = 0; k < 2; ++k) dst[n][k] = *(const PG8_LAS bf16x8*)(lds + PG8_SB(b, h) + boff + n * 2048 + k * 1024); } while (0)
#define PG8_MMA(ai, bj, At, Bt) do { __builtin_amdgcn_s_setprio(1); _Pragma("unroll") for (int m = 0; m < 4; ++m) _Pragma("unroll") for (int n = 0; n < 2; ++n) _Pragma("unroll") for (int k = 0; k < 2; ++k) \
        acc[ai][bj][m][n] = __builtin_amdgcn_mfma_f32_16x16x32_bf16(Bt[n][k], At[m][k], acc[ai][bj][m][n], 0, 0, 0); __builtin_amdgcn_s_setprio(0); } while (0)
#define PG8_WAIT_V(n) asm volatile("s_waitcnt vmcnt(" #n ")" ::: "memory")
#define PG8_WAIT_L(n) asm volatile("s_waitcnt lgkmcnt(" #n ")" ::: "memory")
#define PG8_BAR __builtin_amdgcn_s_barrier()
#define PG8_SCHED __builtin_amdgcn_sched_barrier(0)
    Unit cur, nxt; int ui = 0;
    if (!S.next(0, cur)) return;
    f32x4 acc[2][2][4][2];
#pragma unroll
    for (int a = 0; a < 2; ++a)
#pragma unroll
        for (int b = 0; b < 2; ++b)
#pragma unroll
            for (int m = 0; m < 4; ++m)
#pragma unroll
                for (int n = 0; n < 2; ++n) acc[a][b][m][n] = (f32x4){0.f, 0.f, 0.f, 0.f};
    bf16x8 At[4][2], B0[2][2], B1[2][2];
    const char* cA = (const char*)g.A + (size_t)cur.pm * tstep; const char* cB = (const char*)g.Bt + (size_t)cur.pn * tstep;
    S.a_ready(cur);
    if constexpr (SP2) {
        PG8_STAGE(PG8_SB(0, 0), cB, voffB); PG8_STAGE(PG8_SB(0, 1), cB + hstep, voffB); PG8_STAGE(PG8_SA(0, 0), cA, voffA); PG8_STAGE(PG8_SA(0, 1), cA + hstep, voffA);
        if (wr == 1) PG8_BAR;
        PG8_WAIT_V(2); PG8_BAR;
        PG8_STAGE(PG8_SB(1, 0), cB + kstep, voffB); PG8_STAGE(PG8_SA(1, 0), cA + kstep, voffA); PG8_STAGE(PG8_SB(1, 1), cB + hstep + kstep, voffB);
        PG8_WAIT_V(6); PG8_BAR;
    } else {
        PG8_STAGE(PG8_SB(0, 0), cB, voffB); PG8_STAGE(PG8_SA(0, 0), cA, voffA); PG8_STAGE(PG8_SB(0, 1), cB + hstep, voffB); PG8_STAGE(PG8_SA(0, 1), cA + hstep, voffA);
        if (wr == 1) PG8_BAR;
        PG8_WAIT_V(4); PG8_BAR;
        PG8_STAGE(PG8_SB(1, 0), cB + kstep, voffB); PG8_STAGE(PG8_SA(1, 0), cA + kstep, voffA); PG8_STAGE(PG8_SB(1, 1), cB + hstep + kstep, voffB);
        PG8_WAIT_V(6); PG8_BAR;
    }
    for (;;) {
        const bool has_next = S.next(ui + 1, nxt);
        const char* nA = has_next ? (const char*)g.A + (size_t)nxt.pm * tstep : cA; const char* nB = has_next ? (const char*)g.Bt + (size_t)nxt.pn * tstep : cB;
        for (int t = 0; t < nt; t += 2) {
            const bool last = (t == nt - 2);
            const char* a1 = cA + (size_t)(t + 1) * kstep;
            const char* a2 = last ? nA : cA + (size_t)(t + 2) * kstep; const char* b2 = last ? nB : cB + (size_t)(t + 2) * kstep;
            const char* a3 = a2 + kstep; const char* b3 = b2 + kstep;
            if (last && has_next) S.a_ready(nxt);
            if constexpr (SP2) {
            PG8_LDB(B0, 0, 0); PG8_LDB(B1, 0, 1); PG8_SCHED; PG8_LDA(At, 0, 0); PG8_STAGE(PG8_SA(1, 1), a1 + hstep, voffA);
            PG8_WAIT_V(8); PG8_WAIT_L(0); PG8_BAR; PG8_MMA(0, 0, At, B0); PG8_MMA(0, 1, At, B1); PG8_BAR; PG8_SCHED;
            PG8_LDA(At, 0, 1); PG8_STAGE(PG8_SB(0, 0), b2, voffB); PG8_STAGE(PG8_SB(0, 1), b2 + hstep, voffB); PG8_STAGE(PG8_SA(0, 0), a2, voffA);
            PG8_WAIT_V(8); PG8_WAIT_L(0); PG8_BAR; PG8_MMA(1, 0, At, B0); PG8_MMA(1, 1, At, B1); PG8_BAR; PG8_SCHED;
            PG8_LDB(B0, 1, 0); PG8_LDB(B1, 1, 1); PG8_SCHED; PG8_LDA(At, 1, 0); PG8_STAGE(PG8_SA(0, 1), a2 + hstep, voffA);
            PG8_WAIT_V(8); PG8_WAIT_L(0); PG8_BAR; PG8_MMA(0, 0, At, B0); PG8_MMA(0, 1, At, B1); PG8_BAR; PG8_SCHED;
            PG8_LDA(At, 1, 1); PG8_STAGE(PG8_SB(1, 0), b3, voffB); PG8_STAGE(PG8_SB(1, 1), b3 + hstep, voffB); PG8_STAGE(PG8_SA(1, 0), a3, voffA);
            PG8_WAIT_V(8); PG8_WAIT_L(0); PG8_BAR; PG8_MMA(1, 0, At, B0); PG8_MMA(1, 1, At, B1); PG8_BAR; PG8_SCHED;
            } else {
            PG8_LDB(B0, 0, 0); PG8_SCHED; PG8_LDA(At, 0, 0); PG8_STAGE(PG8_SA(1, 1), a1 + hstep, voffA);
            PG8_WAIT_L(8); PG8_BAR; PG8_WAIT_L(0); PG8_MMA(0, 0, At, B0); PG8_BAR; PG8_SCHED;
            PG8_LDB(B1, 0, 1); PG8_STAGE(PG8_SB(0, 0), b2, voffB);
            PG8_BAR; PG8_WAIT_L(0); PG8_MMA(0, 1, At, B1); PG8_BAR;
            PG8_LDA(At, 0, 1); PG8_STAGE(PG8_SA(0, 0), a2, voffA);
            PG8_BAR; PG8_WAIT_L(0); PG8_MMA(1, 0, At, B0); PG8_BAR; PG8_SCHED;
            PG8_STAGE(PG8_SB(0, 1), b2 + hstep, voffB);
            PG8_WAIT_V(6); PG8_BAR; PG8_MMA(1, 1, At, B1); PG8_BAR;
            PG8_LDB(B0, 1, 0); PG8_SCHED; PG8_LDA(At, 1, 0); PG8_STAGE(PG8_SA(0, 1), a2 + hstep, voffA);
            PG8_WAIT_L(8); PG8_BAR; PG8_WAIT_L(0); PG8_MMA(0, 0, At, B0); PG8_BAR; PG8_SCHED;
            PG8_LDB(B1, 1, 1); PG8_STAGE(PG8_SB(1, 0), b3, voffB);
            PG8_BAR; PG8_WAIT_L(0); PG8_MMA(0, 1, At, B1); PG8_BAR;
            PG8_LDA(At, 1, 1); PG8_STAGE(PG8_SA(1, 0), a3, voffA);
            PG8_BAR; PG8_WAIT_L(0); PG8_MMA(1, 0, At, B0); PG8_BAR; PG8_SCHED;
            PG8_STAGE(PG8_SB(1, 1), b3 + hstep, voffB);
            PG8_WAIT_V(6); PG8_BAR; PG8_MMA(1, 1, At, B1); PG8_BAR;
            }
        }
        if constexpr (ALIGN_EPI) { if (wr == 0) PG8_BAR; }
        if constexpr (!Epi::AFTER_DRAIN) { PG8_EPI_T0; E(acc, cur, wr, wc, fr, fq); S.done(cur); PG8_EPI_T1; }
        if (!has_next) break;
#pragma unroll
        for (int a = 0; a < 2; ++a)
#pragma unroll
            for (int b = 0; b < 2; ++b)
#pragma unroll
                for (int m = 0; m < 4; ++m)
#pragma unroll
                    for (int n = 0; n < 2; ++n) acc[a][b][m][n] = (f32x4){0.f, 0.f, 0.f, 0.f};
        cur = nxt; cA = nA; cB = nB; ++ui;
        if constexpr (ALIGN_EPI) { if (wr == 1) PG8_BAR; }
    }
    PG8_WAIT_V(0);
    if constexpr (!ALIGN_EPI) { if (wr == 0) PG8_BAR; }
    PG8_BAR;
    if constexpr (Epi::AFTER_DRAIN) { E.fused(acc, cur, wr, wc, fr, fq, lds, wid, lane); S.done(cur); }
#undef PG8_SA
#undef PG8_SB
#undef PG8_STAGE
#undef PG8_LDA
#undef PG8_LDB
#undef PG8_MMA
#undef PG8_WAIT_V
#undef PG8_WAIT_L
#undef PG8_BAR
#undef PG8_SCHED
}

}

constexpr size_t MiB = 1u << 20;
constexpr size_t WS_CTL = 0;
constexpr size_t WS_ROPE = 1 * MiB;
constexpr size_t WS_LW2 = 3 * MiB, WS_LA2 = 4 * MiB, WS_LG2 = 5 * MiB;
constexpr size_t WS_BONUS = 6 * MiB;
constexpr size_t ZERO_BYTES = 8 * MiB;
constexpr size_t SCF = (size_t)LTOK * RC * 4, SCB = (size_t)LTOK * RC * 2;
constexpr size_t WS_H = 8 * MiB, WS_WIN = WS_H + (size_t)MPAD * DM * 2;
constexpr size_t WS_KD0 = 8 * MiB, WS_KD1 = WS_KD0 + SCB, WS_B0 = WS_KD1 + SCB, WS_B1 = WS_B0 + SCB, WS_KK = WS_B1 + SCB, WS_RR = WS_KK + SCB;
constexpr size_t WS_WGU = 8 * MiB;
constexpr size_t WS_G = 216 * MiB, WS_A2 = 216 * MiB;
constexpr size_t WS_Q = 344 * MiB, WS_K = 376 * MiB, WS_VT = 385 * MiB, WS_U = 394 * MiB;
constexpr size_t WS_P1 = 344 * MiB;
constexpr size_t WS_Y = 394 * MiB;
constexpr size_t WS_W0 = 506 * MiB, WS_W1 = WS_W0 + SCF;
constexpr size_t WS_WPA = 506 * MiB, WS_WPR = 522 * MiB, WS_WOUT = 538 * MiB, WS_OATT = 570 * MiB;
constexpr size_t WS_VV = 635 * MiB, WS_GG = 668 * MiB;
constexpr size_t WS_BO = 701 * MiB;
constexpr size_t WS_HID = 701 * MiB, WS_MX = 873 * MiB;
constexpr int NB0 = 513, NB1 = 512, NBT = NB0 + NB1;
constexpr int BO_FA = 0, BO_FAA = 4096, BO_FT = 5120, BO_FBP = 5632, BO_FB = 6144, BO_FG = 10240, BO_ITEM = 10496;
constexpr size_t WS_WD = 1030 * MiB, WS_ORWKV = 182 * MiB, WS_END = 1116 * MiB;
static_assert(WS_WIN + (size_t)INWP * DM * 2 <= WS_G && WS_RR + SCB <= WS_G && WS_WGU + (size_t)2 * DFF * DM * 2 <= WS_G, "map: A0");
static_assert(WS_U + (size_t)MPAD * UPITCH * 2 <= WS_W0 && WS_VT + (size_t)KVW * MPAD * 2 <= WS_U && WS_K + (size_t)MPAD * KVW * 2 <= WS_VT && WS_Q + (size_t)SEQ * ATTW * 2 <= WS_K && WS_Y + 2 * SCB <= WS_W0, "map: P1 outputs");
static_assert(WS_W1 + SCF <= WS_VV && WS_OATT + (size_t)SEQ * ATTW * 2 <= WS_VV && WS_VV + SCB <= WS_GG && WS_GG + SCB <= WS_BO && WS_P1 + (size_t)SEQ * DM * 2 <= WS_W0, "map: mid");
static_assert(WS_BO + (size_t)RH * NBT * BO_ITEM <= WS_WD && WS_HID + (size_t)SEQ * DFF * 2 <= WS_MX && WS_MX + (size_t)SEQ * DM * 2 <= WS_WD && WS_WD + (size_t)DM * DFF * 2 <= WS_END && WS_WGU + (size_t)2 * DFF * DM * 2 <= WS_ORWKV && WS_ORWKV + (size_t)SEQ * RC * 2 <= WS_G, "map: tail");
constexpr int CW_BAR = 4096;
constexpr int CW_SS2 = 65536, CW_SS3 = 65536 + 8192;
static_assert((CW_SS3 + 8192) * 4 <= (int)(1 * MiB), "CTL");

constexpr int RING_BYTES = 131072;
constexpr int LDSCTL_OFF = RING_BYTES, MISC_OFF = LDSCTL_OFF + 320;
constexpr int LDS_BYTES = 147456;

#define GAS __attribute__((address_space(1)))
#define LAS __attribute__((address_space(3)))
typedef unsigned short bf16;
typedef unsigned v4u __attribute__((ext_vector_type(4)));
typedef unsigned v2u __attribute__((ext_vector_type(2)));
typedef float f32x4 __attribute__((ext_vector_type(4)));
typedef float f32x2 __attribute__((ext_vector_type(2)));
typedef float f32x16 __attribute__((ext_vector_type(16)));
typedef short bf16x8 __attribute__((ext_vector_type(8)));
typedef GAS unsigned gu32;
#define RLX_AGENT __ATOMIC_RELAXED, __HIP_MEMORY_SCOPE_AGENT
#define LDS_WAIT() asm volatile("s_waitcnt lgkmcnt(0)" ::: "memory")
__device__ __forceinline__ unsigned pk2(float lo, float hi) { return pg8::cvt_pk_bf16(lo, hi); }
__device__ __forceinline__ unsigned f2bf(float f) { return pg8::cvt_pk_bf16(f, 0.f) & 0xffffu; }
__device__ __forceinline__ float bf2f(bf16 b) { return __uint_as_float(((unsigned)b) << 16); }
using pg8::bflo; using pg8::bfhi; using pg8::sigmoidf_;

#define XB_TMO      128
#define XB_XCNT(j)  (256  + 64 * (j))
#define XB_XSUB(j)  (1280 + 64 * (j))
#define XB_XGEN(j)  (2304 + 64 * (j))
#define XB_TOP      3328
#define XB_TOPGEN   3392
#define XCD_BAR_WORDS 3456
#define XB_SPIN_CAP (1u << 18)

__device__ __forceinline__ unsigned xb_ld(unsigned* p)              { return __hip_atomic_load(p, __ATOMIC_RELAXED, __HIP_MEMORY_SCOPE_AGENT); }
__device__ __forceinline__ unsigned xb_add(unsigned* p, unsigned v) { return __hip_atomic_fetch_add(p, v, __ATOMIC_RELAXED, __HIP_MEMORY_SCOPE_AGENT); }
__device__ __forceinline__ unsigned xb_xcc_id() { return (unsigned)__builtin_amdgcn_s_getreg((3 << 11) | 20) & 0xFu; }
#define XB_SPIN(cond, bar) do { unsigned _sp = 0; while (cond) { __builtin_amdgcn_s_sleep(1); \
    if ((++_sp & 255u) == 0u) { if (xb_ld(&(bar)[XB_TMO])) break; if (_sp > XB_SPIN_CAP) { atomicAdd(&(bar)[XB_TMO], 1u); break; } } } } while (0)

struct XcdBarrier {
    unsigned* bar; unsigned x;
    volatile LAS unsigned* st;
};

__device__ __forceinline__ XcdBarrier xcd_barrier_post(unsigned* bar, volatile LAS unsigned* st) {
    XcdBarrier b; b.bar = bar; b.x = xb_xcc_id(); b.st = st;
    if (threadIdx.x == 0) (void)xb_add(&bar[XB_XCNT(b.x)], 1u);
    return b;
}
__device__ __forceinline__ void xcd_barrier_complete(unsigned* bar, unsigned x, unsigned& nloc, unsigned& nx) {
    const unsigned G = gridDim.x * gridDim.y * gridDim.z;
    unsigned sum, cnt, mine, sp = 0u;
    for (;;) {
        sum = 0u; cnt = 0u; mine = 0u;
#pragma unroll
        for (unsigned j = 0; j < 16; ++j) { const unsigned c = xb_ld(&bar[XB_XCNT(j)]); sum += c; cnt += (c > 0u) ? 1u : 0u; mine = (j == x) ? c : mine; }
        if (sum == G) break;
        __builtin_amdgcn_s_sleep(1);
        if ((++sp & 255u) == 0u) { if (xb_ld(&bar[XB_TMO])) break; if (sp > XB_SPIN_CAP) { atomicAdd(&bar[XB_TMO], 1u); break; } }
    }
    nloc = mine > 0u ? mine : 1u; nx = cnt > 0u ? cnt : 1u;
}

__device__ __forceinline__ void xcd_barrier(const XcdBarrier& b) {
    asm volatile("s_waitcnt vmcnt(0)" ::: "memory");
    __syncthreads();
    if (threadIdx.x == 0) {
        unsigned* bar = b.bar;
        __builtin_amdgcn_s_waitcnt(0);
        unsigned nloc = b.st[0], nx = b.st[1];
        if (nloc == 0u) { xcd_barrier_complete(bar, b.x, nloc, nx); b.st[0] = nloc; b.st[1] = nx; }
        const unsigned old = xb_add(&bar[XB_XSUB(b.x)], 1u);
        const unsigned gen = old / nloc;
        if (old + 1u == (gen + 1u) * nloc) {
            __builtin_amdgcn_fence(__ATOMIC_RELEASE, "agent");
            asm volatile("s_waitcnt vmcnt(0)" ::: "memory");
            const unsigned og = xb_add(&bar[XB_TOP], 1u);
            const unsigned tg = og / nx;
            if (og + 1u == (tg + 1u) * nx) xb_add(&bar[XB_TOPGEN], 1u);
            else XB_SPIN(xb_ld(&bar[XB_TOPGEN]) == tg, bar);
            __builtin_amdgcn_fence(__ATOMIC_ACQUIRE, "agent");
            xb_add(&bar[XB_XGEN(b.x)], 1u);
            asm volatile("s_waitcnt vmcnt(0)" ::: "memory");
        } else {
            XB_SPIN(xb_ld(&bar[XB_XGEN(b.x)]) == gen, bar);
            __builtin_amdgcn_fence(__ATOMIC_ACQUIRE, "agent");
            asm volatile("s_waitcnt vmcnt(0)" ::: "memory");
        }
    }
    __syncthreads();
}


struct Frame {
    LAS unsigned char* lds;
    volatile LAS unsigned* MISC;
    gu32* ctl;
    int tid, lane, wave, G;
    unsigned char* ws;
    const float* in[26];
    float* out;
    unsigned long long pb0, pacc, pacc2;
};
#define FPB0(k) do { if ((PROBE_PHASE >> (k)) & 1) F.pb0 = __builtin_amdgcn_s_memrealtime(); } while (0)
#define FPB1(k) do { if ((PROBE_PHASE >> (k)) & 1) F.pacc += __builtin_amdgcn_s_memrealtime() - F.pb0; } while (0)
__device__ __forceinline__ float wave_sum(float v) {
#pragma unroll
    for (int o = 1; o < 64; o <<= 1) v += __shfl_xor(v, o);
    return v;
}

template <int KR> __device__ __forceinline__ void tr_issue(const float* W, int N, int item, int lane, float (&wv)[KR / 2]) {
    const int nblk = N / 32, kb = item / nblk, nb = item % nblk, k0 = KR * kb, n0 = 32 * nb;
#pragma unroll
    for (int i = 0; i < KR / 2; ++i) wv[i] = W[(size_t)(k0 + 2 * i + (lane >> 5)) * N + n0 + (lane & 31)];
}
template <int KR> __device__ __forceinline__ void tr_finish(bf16* WT, int K, int N, const float* kscale, int mode, int item, LAS float* scr, int lane, const float (&wv)[KR / 2]) {
    const int nblk = N / 32, kb = item / nblk, nb = item % nblk, k0 = KR * kb, n0 = 32 * nb;
#pragma unroll
    for (int i = 0; i < KR / 2; ++i) { const int kk = 2 * i + (lane >> 5); float v = wv[i]; if (kscale) v *= kscale[k0 + kk]; scr[kk * 33 + (lane & 31)] = v; }
    LDS_WAIT(); asm volatile("" ::: "memory");
    constexpr int CH = KR / 8;
    const int c = lane & (CH - 1);
#pragma unroll
    for (int jj = 0; jj < CH / 2; ++jj) { const int n = (lane / CH) + (64 / CH) * jj; const LAS float* s = scr + (8 * c) * 33 + n;
        v4u o; o.x = pk2(s[0 * 33], s[1 * 33]); o.y = pk2(s[2 * 33], s[3 * 33]); o.z = pk2(s[4 * 33], s[5 * 33]); o.w = pk2(s[6 * 33], s[7 * 33]);
        const int nn = n0 + n; const int dr = (mode == 0) ? nn : (256 * (nn >> 7) + (nn & 127) + (mode == 2 ? 128 : 0));
        *(GAS v4u*)(WT + (size_t)dr * K + k0 + 8 * c) = o; }
    LDS_WAIT(); asm volatile("" ::: "memory");
}
#define CONV_P4(it, CALL) do { constexpr int I_GU_ = (DM / 64) * (DFF / 32), I_P_ = (ATTW / 64) * (DM / 32); int r_ = (it); \
        if (r_ < I_GU_) { CALL(F.in[22], (bf16*)(F.ws + WS_WGU), DM, DFF, F.in[21], 1, r_); } \
        else if ((r_ -= I_GU_) < I_GU_) { CALL(F.in[23], (bf16*)(F.ws + WS_WGU), DM, DFF, F.in[21], 2, r_); } \
        else if ((r_ -= I_GU_) < I_P_) { CALL(F.in[18], (bf16*)(F.ws + WS_WPA), ATTW, DM, (const float*)nullptr, 0, r_); } \
        else if ((r_ -= I_P_) < I_P_) { CALL(F.in[19], (bf16*)(F.ws + WS_WPR), RC, DM, (const float*)nullptr, 0, r_); } \
        else { r_ -= I_P_; CALL(F.in[20], (bf16*)(F.ws + WS_WOUT), DM, DM, (const float*)nullptr, 0, r_); } } while (0)
constexpr int N_P4_ITEMS = 2 * (DM / 64) * (DFF / 32) + 2 * (ATTW / 64) * (DM / 32) + (DM / 64) * (DM / 32);
constexpr int N_WD_ITEMS = (DFF / 64) * (DM / 32);
constexpr int N_WD_HALF_ITEMS = (DFF / 32) * (DM / 32);
__device__ __forceinline__ void convert_seg(Frame& F, LAS float* scr, int first, int stride, int limit) {
    int it = first; if (it >= limit) return;
    float w0[32], w1[32];
#define CVI0(W_, WT_, K_, N_, ks_, md_, item_) tr_issue<64>(W_, N_, item_, F.lane, w0)
#define CVI1(W_, WT_, K_, N_, ks_, md_, item_) tr_issue<64>(W_, N_, item_, F.lane, w1)
#define CVI2(W_, WT_, K_, N_, ks_, md_, item_) tr_issue<64>(W_, N_, item_, F.lane, w2)
#define CVF(W_, WT_, K_, N_, ks_, md_, item_) tr_finish<64>(WT_, K_, N_, ks_, md_, item_, scr, F.lane, w0)
    CONV_P4(it, CVI0);
    if (it + stride < limit) CONV_P4(it + stride, CVI1);
    for (;;) { const int it2 = it + 2 * stride; float w2[32];
        if (it2 < limit) CONV_P4(it2, CVI2);
        CONV_P4(it, CVF);
        it += stride; if (it >= limit) break;
#pragma unroll
        for (int i = 0; i < 32; ++i) { w0[i] = w1[i]; w1[i] = w2[i]; } }
#undef CVI0
#undef CVI1
#undef CVI2
#undef CVF
}
__device__ __forceinline__ void convert_p4(Frame& F, LAS float* scr, int widx, int NWK, int pidx, int NPL) {
    (void)pidx; (void)NPL;
    convert_seg(F, scr, widx, NWK, N_P4_ITEMS);
}
__device__ __forceinline__ void convert_one(Frame& F, LAS float* scr, const float* W, bf16* WT, int K, int N, int nitems, int first, int stride) {
    int it = first; if (it >= nitems) return;
    float w0[32], w1[32];
    tr_issue<64>(W, N, it, F.lane, w0);
    if (it + stride < nitems) tr_issue<64>(W, N, it + stride, F.lane, w1);
    for (;;) { const int it2 = it + 2 * stride; float w2[32];
        if (it2 < nitems) tr_issue<64>(W, N, it2, F.lane, w2);
        tr_finish<64>(WT, K, N, nullptr, 0, it, scr, F.lane, w0);
        it += stride; if (it >= nitems) break;
#pragma unroll
        for (int i = 0; i < 32; ++i) { w0[i] = w1[i]; w1[i] = w2[i]; } }
}
__device__ __forceinline__ void convert_wd(Frame& F, LAS float* scr, int first, int stride) { convert_one(F, scr, F.in[24], (bf16*)(F.ws + WS_WD), DFF, DM, N_WD_ITEMS, first, stride); }
__device__ __forceinline__ void rms_row_to_bf16(int lane, const float* xrow, const float* w, bf16* orow) {
    const GAS f32x4* xr = (const GAS f32x4*)xrow + lane;
    f32x4 v[16]; float s = 0.f;
#pragma unroll
    for (int j = 0; j < 16; ++j) { v[j] = xr[64 * j]; s += (v[j].x * v[j].x + v[j].y * v[j].y) + (v[j].z * v[j].z + v[j].w * v[j].w); }
    const float rstd = 1.f / sqrtf(wave_sum(s) * (1.f / DM) + RMS_EPS);
    const GAS f32x4* wr = (const GAS f32x4*)w + lane;
    GAS v2u* o8 = (GAS v2u*)orow + lane;
#pragma unroll
    for (int j = 0; j < 16; ++j) { const f32x4 ww = wr[64 * j]; v2u o; o.x = pk2(v[j].x * rstd * ww.x, v[j].y * rstd * ww.y); o.y = pk2(v[j].z * rstd * ww.z, v[j].w * rstd * ww.w); o8[64 * j] = o; }
}
__device__ const double ROPE_INV[16] = {
    1.0000000000000000000000000e+0,
    4.4036660267178047359198331e-1,
    1.9392274474868577334259386e-1,
    8.5397100285765611280149662e-2,
    3.7606030930863935681246092e-2,
    1.6560440080994445548947445e-2,
    7.2926647372171090477661219e-3,
    3.2114459947525910185434889e-3,
    1.4142135623730950488016887e-3,
    6.2277242191459597955502746e-4,
    2.7424817567620731825332265e-4,
    1.2076973741146503832424826e-4,
    5.3182958969449886162502429e-5,
    2.3419998961409341542188076e-5,
    1.0313385377212458859810127e-5,
    4.5416704806078696531998012e-6
};

__device__ __forceinline__ void p0_prologue(Frame& F) {
    LAS float* scr = (LAS float*)(F.lds + F.wave * 16384);
    const int gw = blockIdx.x * 8 + F.wave, NGW = F.G * 8;
    bf16* Wint = (bf16*)(F.ws + WS_WIN); bf16* H = (bf16*)(F.ws + WS_H);
    convert_one(F, scr, F.in[3], Wint, DM, INW, (DM / 64) * (INW / 32), gw, NGW);
    for (int m = gw; m < MPAD + (INWP - INW); m += NGW) {
        if (m < SEQ) rms_row_to_bf16(F.lane, F.in[0] + (size_t)m * DM, F.in[2], H + (size_t)m * DM);
        else if (m < LTOK) rms_row_to_bf16(F.lane, F.in[1] + (size_t)(m - SEQ) * DM, F.in[2], H + (size_t)m * DM);
        else { bf16* row = (m < MPAD) ? H + (size_t)m * DM : Wint + (size_t)(INW + (m - MPAD)) * DM; GAS v4u* o = (GAS v4u*)row + F.lane;
#pragma unroll
            for (int j = 0; j < 8; ++j) o[64 * j] = (v4u){0u, 0u, 0u, 0u}; }
    }
    const int gt = blockIdx.x * 512 + F.tid, NGT = F.G * 512;
    float* rope = (float*)(F.ws + WS_ROPE);
    for (int i = gt; i < LTOK * 16; i += NGT) { const int pos = i >> 4, k = i & 15;
        const double ang = (double)pos * ROPE_INV[k]; const double kq = __builtin_rint(ang * 0.15915494309189535);
        const double red = (ang - kq * 6.28318530717958623) - kq * 2.4492935982947064e-16; const float rf = (float)red;
        rope[2 * i] = cosf(rf); rope[2 * i + 1] = sinf(rf); }
    { bf16* w2t = (bf16*)(F.ws + WS_LW2); bf16* a2t = (bf16*)(F.ws + WS_LA2); bf16* g2t = (bf16*)(F.ws + WS_LG2);
      constexpr int I_L = 3 * (RC / 32), I_G = 8 * (RC / 32);
      for (int it = gw; it < 4 * I_L + I_G; it += NGW) { float wv[16];
          if (it < 4 * I_L) { const int mtx = it / I_L, r = it % I_L, dd = mtx & 1; const float* W = (mtx < 2 ? F.in[8] : F.in[10]) + (size_t)dd * 96 * RC; bf16* WT = (mtx < 2 ? w2t : a2t) + (size_t)dd * RC * 96;
              tr_issue<32>(W, RC, r, F.lane, wv); tr_finish<32>(WT, 96, RC, nullptr, 0, r, scr, F.lane, wv); }
          else { const int r = it - 4 * I_L; tr_issue<32>(F.in[11], RC, r, F.lane, wv); tr_finish<32>(g2t, 256, RC, nullptr, 0, r, scr, F.lane, wv); } } }
}

__device__ __forceinline__ int crow(int r, int hi) { return (r & 3) + 8 * (r >> 2) + 4 * hi; }
__device__ __forceinline__ void attn_phase(Frame& F, const int gw, const int NGW) {
    const bf16* Q = (const bf16*)(F.ws + WS_Q); const bf16* K = (const bf16*)(F.ws + WS_K); const bf16* Vt = (const bf16*)(F.ws + WS_VT); bf16* OA = (bf16*)(F.ws + WS_OATT);
    const float* sink = F.in[17];
    const int hh = F.lane >> 5, r = F.lane & 31;
    constexpr float SC = 0.08838834764831845f * 1.4426950408889634f, L2E = 1.4426950408889634f;
    for (int item = gw; item < 4096; item += NGW) {
        const int sub = item & 3, hq = (item >> 2) & 15, qb = item >> 6, q0 = qb * 128 + sub * 32, hk = hq >> 2;
        bf16x8 bq[8];
        { const bf16* qp = Q + (size_t)(q0 + r) * ATTW + hq * 128 + 8 * hh;
#pragma unroll
          for (int s = 0; s < 8; ++s) bq[s] = *(const bf16x8*)(qp + 16 * s); }
        f32x16 O[4];
#pragma unroll
        for (int dt = 0; dt < 4; ++dt)
#pragma unroll
            for (int i = 0; i < 16; ++i) O[dt][i] = 0.f;
        float m = sink[hq] * L2E, l = (hh == 0) ? 1.f : 0.f;
        const int tlo = (q0 >= 128) ? 0 : 4 - q0 / 32, thi = (q0 + 128 + 32 <= SEQ) ? 8 : 4 + (SEQ - 32 - q0) / 32;
        int ti = tlo;
        bf16x8 ak[8];
        { const int key0 = q0 + 32 * (ti - 4); const bf16* kp = K + (size_t)(key0 + r) * KVW + hk * 128 + 8 * hh;
#pragma unroll
          for (int s = 0; s < 8; ++s) ak[s] = *(const bf16x8*)(kp + 16 * s); }
        for (;;) {
            const bool meta = (ti == 9);
            const int key0 = meta ? SEQ : q0 + 32 * (ti - 4);
            const int tn = (ti < thi) ? ti + 1 : 9; const int keyn = (tn == 9) ? SEQ : q0 + 32 * (tn - 4);
            v2u av[4][2][2]; bf16x8 akn[8];
#pragma unroll
            for (int dt = 0; dt < 4; ++dt) { const bf16* vp = Vt + (size_t)(hk * 128 + 32 * dt + r) * MPAD + key0 + 4 * hh;
#pragma unroll
                for (int s2 = 0; s2 < 2; ++s2) { av[dt][s2][0] = *(const v2u*)(vp + 16 * s2); av[dt][s2][1] = *(const v2u*)(vp + 16 * s2 + 8); } }
            { const bf16* kp = K + (size_t)(keyn + r) * KVW + hk * 128 + 8 * hh;
#pragma unroll
              for (int s = 0; s < 8; ++s) akn[s] = *(const bf16x8*)(kp + 16 * s); }
            f32x16 st;
#pragma unroll
            for (int i = 0; i < 16; ++i) st[i] = 0.f;
#pragma unroll
            for (int s = 0; s < 8; ++s) st = __builtin_amdgcn_mfma_f32_32x32x16_bf16(ak[s], bq[s], st, 0, 0, 0);
            float tmax = -__builtin_inff();
#pragma unroll
            for (int i = 0; i < 16; ++i) { const int kr = crow(i, hh); bool ok;
                if (meta) ok = kr < NMETA; else { const int dlt = (key0 + kr) - (q0 + r); ok = (dlt >= -128) && (dlt <= 128); }
                const float t = ok ? st[i] * SC : -__builtin_inff(); st[i] = t; tmax = fmaxf(tmax, t); }
            tmax = fmaxf(tmax, __shfl_xor(tmax, 32));
            const float mn = fmaxf(m, tmax), alpha = __builtin_amdgcn_exp2f(m - mn); m = mn;
            float ps = 0.f;
#pragma unroll
            for (int i = 0; i < 16; ++i) { const float p = __builtin_amdgcn_exp2f(st[i] - mn); st[i] = p; ps += p; }
            l = l * alpha + ps;
#pragma unroll
            for (int dt = 0; dt < 4; ++dt)
#pragma unroll
                for (int i = 0; i < 16; ++i) O[dt][i] *= alpha;
            bf16x8 pb[2];
#pragma unroll
            for (int s2 = 0; s2 < 2; ++s2) { v4u w; w.x = pg8::cvt_pk_bf16(st[8 * s2 + 0], st[8 * s2 + 1]); w.y = pg8::cvt_pk_bf16(st[8 * s2 + 2], st[8 * s2 + 3]);
                w.z = pg8::cvt_pk_bf16(st[8 * s2 + 4], st[8 * s2 + 5]); w.w = pg8::cvt_pk_bf16(st[8 * s2 + 6], st[8 * s2 + 7]); pb[s2] = __builtin_bit_cast(bf16x8, w); }
#pragma unroll
            for (int dt = 0; dt < 4; ++dt)
#pragma unroll
                for (int s2 = 0; s2 < 2; ++s2) { const v4u w = {av[dt][s2][0].x, av[dt][s2][0].y, av[dt][s2][1].x, av[dt][s2][1].y};
                    O[dt] = __builtin_amdgcn_mfma_f32_32x32x16_bf16(__builtin_bit_cast(bf16x8, w), pb[s2], O[dt], 0, 0, 0); }
            if (meta) break;
            ti = tn;
#pragma unroll
            for (int s = 0; s < 8; ++s) ak[s] = akn[s];
        }
        l += __shfl_xor(l, 32);
        const float inv = 1.0f / l;
        bf16* op = OA + (size_t)(q0 + r) * ATTW + hq * 128 + 4 * hh;
#pragma unroll
        for (int dt = 0; dt < 4; ++dt)
#pragma unroll
            for (int g4 = 0; g4 < 4; ++g4) { v2u w; w.x = pg8::cvt_pk_bf16(O[dt][4 * g4 + 0] * inv, O[dt][4 * g4 + 1] * inv); w.y = pg8::cvt_pk_bf16(O[dt][4 * g4 + 2] * inv, O[dt][4 * g4 + 3] * inv);
                *(v2u*)(op + 32 * dt + 8 * g4) = w; }
    }
}

__device__ __forceinline__ int blk_tok(int d, int blk, int u) { return d ? (LTOK - 1 - 16 * blk - u) : (16 * blk + u); }
__device__ __forceinline__ size_t bo_item(int hd, int d, int blk) { return (size_t)(hd * NBT + (d ? NB0 : 0) + blk) * BO_ITEM; }
__device__ __forceinline__ v4u pack8(const float (&x)[8]) { v4u o; o.x = pk2(x[0], x[1]); o.y = pk2(x[2], x[3]); o.z = pk2(x[4], x[5]); o.w = pk2(x[6], x[7]); return o; }
__device__ __forceinline__ void blockprep_item(Frame& F, LAS unsigned char* wl, const int hd, const int d, const int blk, const int j) {
    constexpr int LP = 72;
    LAS bf16* LT = (LAS bf16*)wl; LAS float* GM = (LAS float*)wl;
    const float* Wd = (const float*)(F.ws + (d ? WS_W1 : WS_W0)); const bf16* KDd = (const bf16*)(F.ws + (d ? WS_KD1 : WS_KD0)); const bf16* Bd = (const bf16*)(F.ws + (d ? WS_B1 : WS_B0));
    const bf16* KK = (const bf16*)(F.ws + WS_KK); const bf16* RR = (const bf16*)(F.ws + WS_RR);
    float* BON = (float*)(F.ws + WS_BONUS); unsigned char* BO = F.ws + WS_BO;
    const int hh = j >> 5, r31 = j & 31, c16 = j & 15, c = hd * 64 + j;
    struct Raw { float w[16]; unsigned short kd[16], b[16], kk[16], r[16]; } cur;
#pragma unroll
    for (int u = 0; u < 16; ++u) { const size_t o = (size_t)blk_tok(d, blk, u) * RC + c; cur.w[u] = Wd[o]; cur.kd[u] = KDd[o]; cur.b[u] = Bd[o]; cur.kk[u] = KK[o]; cur.r[u] = RR[o]; }
    float kt[16], rt[16], kdh[16], bh[16]; float G15;
    { float G[16];
      { float g = 1.f;
#pragma unroll
        for (int u = 0; u < 16; ++u) { g *= cur.w[u]; G[u] = g; } }
      const float rkw = F.in[14][c];
      float bsum = 0.f;
#pragma unroll
      for (int u = 0; u < 16; ++u) { kdh[u] = bf2f(cur.kd[u]); rt[u] = bf2f(cur.r[u]); const float s = wave_sum(rt[u] * kdh[u] * rkw); bsum = (j == u) ? s : bsum;
          kdh[u] = kdh[u] / G[u]; rt[u] = rt[u] * G[u]; LT[(0 * 16 + u) * LP + j] = (bf16)f2bf(kdh[u]); LT[(3 * 16 + u) * LP + j] = (bf16)f2bf(rt[u]); }
      if (j < 16) atomicAdd(BON + (size_t)blk_tok(d, blk, j) * RH + hd, bsum);
#pragma unroll
      for (int u = 0; u < 16; ++u) { kt[u] = bf2f(cur.kk[u]) * (u ? G[u - 1] : 1.f); bh[u] = bf2f(cur.b[u]) / G[u]; LT[(2 * 16 + u) * LP + j] = (bf16)f2bf(kt[u]); LT[(1 * 16 + u) * LP + j] = (bf16)f2bf(bh[u]); }
      G15 = G[15]; }
    asm volatile("" ::: "memory");
    f32x16 gacc;
#pragma unroll
    for (int i = 0; i < 16; ++i) gacc[i] = 0.f;
    { const LAS bf16* ap = LT + ((r31 < 16 ? 0 : 1) * 16 + (r31 & 15)) * LP + 8 * hh; const LAS bf16* bp = LT + ((r31 < 16 ? 2 : 3) * 16 + (r31 & 15)) * LP + 8 * hh;
#pragma unroll
      for (int s = 0; s < 4; ++s) gacc = __builtin_amdgcn_mfma_f32_32x32x16_bf16(*(const LAS bf16x8*)(ap + 16 * s), *(const LAS bf16x8*)(bp + 16 * s), gacc, 0, 0, 0); }
    float ga[16];
#pragma unroll
    for (int i = 0; i < 16; ++i) ga[i] = gacc[i];
    asm volatile("s_waitcnt lgkmcnt(0)" ::: "memory");
#pragma unroll
    for (int i = 0; i < 16; ++i) { const int row = crow(i, hh), m = row & 15, u = r31 & 15; const bool strict = (r31 < 16);
        GM[row * 32 + r31] = (strict ? (m < u) : (m <= u)) ? ga[i] : 0.f; }
#define RL(x, ln) __builtin_bit_cast(float, __builtin_amdgcn_readlane(__builtin_bit_cast(int, (x)), (ln)))
#define GREG(m) (4 * ((m) >> 3) + ((m) & 3))
#define GLN(m) (32 * (((m) >> 2) & 1))
#define B_(m, u)  RL(ga[8 + GREG(m)], (u) + GLN(m))
    float Tr[16];
#pragma unroll
    for (int m = 15; m >= 0; --m) { float s = (c16 == m) ? 1.f : 0.f;
#pragma unroll
        for (int u = m + 1; u < 16; ++u) s -= B_(m, u) * Tr[u];
        Tr[m] = s; }
#undef RL
#undef GREG
#undef GLN
#undef B_
    unsigned char* base = BO + bo_item(hd, d, blk);
    { const int a = j >> 5, jp = j & 31;
#pragma unroll
      for (int h2 = 0; h2 < 2; ++h2) { float x0[8], x1[8];
#pragma unroll
          for (int e = 0; e < 8; ++e) { x0[e] = -bh[8 * (e >> 2) + 4 * h2 + (e & 3)] * G15; x1[e] = kdh[8 * h2 + e] * G15; }
          *(v4u*)(base + BO_FB + ((a * 2 + 0) * 64 + jp + 32 * h2) * 16) = pack8(x0); *(v4u*)(base + BO_FB + ((a * 2 + 1) * 64 + jp + 32 * h2) * 16) = pack8(x1); } }
    *(float*)(base + BO_FG + 4 * j) = G15;
    { float x[8];
#pragma unroll
      for (int e = 0; e < 8; ++e) x[e] = GM[(8 * hh + e) * 32 + r31];
      *(v4u*)(base + BO_FAA + j * 16) = pack8(x); }
    if (r31 < 16) { float x[8];
#pragma unroll
        for (int e = 0; e < 8; ++e) { const float t0 = Tr[8 * (e >> 2) + (e & 3)], t1 = Tr[8 * (e >> 2) + 4 + (e & 3)]; x[e] = hh ? t1 : t0; }
        *(v4u*)(base + BO_FT + (hh * 16 + r31) * 16) = pack8(x); }
    else { float x[8];
#pragma unroll
        for (int e = 0; e < 8; ++e) x[e] = -GM[(16 + 8 * (e >> 2) + 4 * hh + (e & 3)) * 32 + r31];
        *(v4u*)(base + BO_FBP + (hh * 16 + (r31 - 16)) * 16) = pack8(x); }
    asm volatile("s_waitcnt lgkmcnt(0)" ::: "memory");
#pragma unroll
    for (int u = 0; u < 16; ++u) { LT[u * LP + j] = (bf16)f2bf(kt[u]); LT[(16 + u) * LP + j] = (bf16)f2bf(rt[u]); }
#pragma unroll
    for (int ks = 0; ks < 4; ++ks) { const int j0 = 32 * (ks >> 1) + 16 * (ks & 1) + 4 * hh; const v2u lo = *(const LAS v2u*)(LT + r31 * LP + j0), hi = *(const LAS v2u*)(LT + r31 * LP + j0 + 8);
        *(v4u*)(base + BO_FA + (ks * 64 + j) * 16) = (v4u){lo.x, lo.y, hi.x, hi.y}; }
    asm volatile("" ::: "memory");
}

__device__ __forceinline__ int tok2row(int t) { return t < NMETA ? SEQ + t : t - NMETA; }
struct Sh8 { v4u uc, up, un; };
__device__ __forceinline__ Sh8 shift8_ld(const bf16* U, int t, int col) {
    const int tc = t < LTOK ? t : LTOK - 1, tp = (t >= 1 && t - 1 < LTOK) ? t - 1 : 0, tn = t + 1 < LTOK ? t + 1 : LTOK - 1;
    Sh8 s; s.uc = *(const v4u*)(U + (size_t)tok2row(tc) * UPITCH + col); s.up = *(const v4u*)(U + (size_t)tok2row(tp) * UPITCH + col); s.un = *(const v4u*)(U + (size_t)tok2row(tn) * UPITCH + col); return s; }
__device__ __forceinline__ void shift8_fin(const Sh8& s, int t, int col, const float* mu_p, const float* mu_n, float (&x)[8]) {
    const v4u zz = {0u, 0u, 0u, 0u};
    const v4u uc = t < LTOK ? s.uc : zz, up = (t >= 1 && t - 1 < LTOK) ? s.up : zz, un = t + 1 < LTOK ? s.un : zz;
    const f32x4 mp0 = *(const f32x4*)(mu_p + col), mp1 = *(const f32x4*)(mu_p + col + 4), mn0 = *(const f32x4*)(mu_n + col), mn1 = *(const f32x4*)(mu_n + col + 4);
    const unsigned ucw[4] = {uc.x, uc.y, uc.z, uc.w}, upw[4] = {up.x, up.y, up.z, up.w}, unw[4] = {un.x, un.y, un.z, un.w};
    const float mpw[8] = {mp0[0], mp0[1], mp0[2], mp0[3], mp1[0], mp1[1], mp1[2], mp1[3]}, mnw[8] = {mn0[0], mn0[1], mn0[2], mn0[3], mn1[0], mn1[1], mn1[2], mn1[3]};
#pragma unroll
    for (int e = 0; e < 8; ++e) { const float c0 = (e & 1) ? bfhi(ucw[e >> 1]) : bflo(ucw[e >> 1]), p0 = (e & 1) ? bfhi(upw[e >> 1]) : bflo(upw[e >> 1]), n0 = (e & 1) ? bfhi(unw[e >> 1]) : bflo(unw[e >> 1]);
        x[e] = c0 + mpw[e] * (p0 - c0) + mnw[e] * (n0 - c0); }
}
__device__ __forceinline__ void flush_bf16(const LAS bf16* tile, bf16* ARR, int t0, int cbase, int lane) {
#pragma unroll
    for (int h = 0; h < 2; ++h) { const int row = (lane >> 2) + 16 * h, ch = lane & 3; const v4u v = *(const LAS v4u*)(tile + row * 32 + 8 * ch);
        if (t0 + row < LTOK) *(v4u*)(ARR + (size_t)(t0 + row) * RC + cbase + 8 * ch) = v; }
}
__device__ __forceinline__ void flush_f32(const LAS float* tile, float* ARR, int t0, int cbase, int lane) {
#pragma unroll
    for (int h = 0; h < 4; ++h) { const int row = (lane >> 3) + 8 * h, ch = lane & 7; const f32x4 v = *(const LAS f32x4*)(tile + row * 32 + 4 * ch);
        if (t0 + row < LTOK) *(f32x4*)(ARR + (size_t)(t0 + row) * RC + cbase + 4 * ch) = v; }
}
__device__ __forceinline__ void prep_phase(Frame& F) {
    constexpr int XS = 648;
    LAS bf16* Xs = (LAS bf16*)F.lds;
    LAS unsigned char* wl = F.lds + 41472 + F.wave * 9216;
    LAS bf16* Kt = (LAS bf16*)wl;
    LAS bf16* Ot = Kt + 2048;
    const bf16* U = (const bf16*)(F.ws + WS_U);
    const float* mu_p = F.in[5]; const float* mu_n = F.in[6];
    const bf16* w2t = (const bf16*)(F.ws + WS_LW2); const bf16* a2t = (const bf16*)(F.ws + WS_LA2); const bf16* g2t = (const bf16*)(F.ws + WS_LG2);
    float* W0 = (float*)(F.ws + WS_W0); float* W1 = (float*)(F.ws + WS_W1);
    bf16* KD0 = (bf16*)(F.ws + WS_KD0); bf16* KD1 = (bf16*)(F.ws + WS_KD1); bf16* B0 = (bf16*)(F.ws + WS_B0); bf16* B1 = (bf16*)(F.ws + WS_B1);
    bf16* KK = (bf16*)(F.ws + WS_KK); bf16* RR = (bf16*)(F.ws + WS_RR); bf16* VV = (bf16*)(F.ws + WS_VV); bf16* GG = (bf16*)(F.ws + WS_GG);
    const int hh = F.lane >> 5, r = F.lane & 31;
    for (int unit = blockIdx.x; unit < 257 * 4; unit += F.G) {
        const int tt = unit >> 2, t0 = tt * 32, hd = (unit & 3) * 8 + F.wave;
        __syncthreads();
        FPB0(15);
        { Sh8 sx[5];
#pragma unroll
          for (int it = 0; it < 5; ++it) { const int ci = F.tid + 512 * it; sx[it] = shift8_ld(U, t0 + ci / 80, 3 * RC + 8 * (ci % 80)); }
#pragma unroll
          for (int it = 0; it < 5; ++it) { const int ci = F.tid + 512 * it, tl = ci / 80, ch = ci % 80;
            float x[8]; shift8_fin(sx[it], t0 + tl, 3 * RC + 8 * ch, mu_p, mu_n, x);
#pragma unroll
            for (int e = 0; e < 8; ++e) { float v = x[e];
                if (ch < 24) { const float ex = __expf(2.0f * v); v = 1.0f - 2.0f / (ex + 1.0f); }
                else if (ch >= 48) v = sigmoidf_(v);
                x[e] = v; }
            v4u o; o.x = pk2(x[0], x[1]); o.y = pk2(x[2], x[3]); o.z = pk2(x[4], x[5]); o.w = pk2(x[6], x[7]);
            *(LAS v4u*)(Xs + tl * XS + 8 * ch) = o; } }
        { const int c8 = hd * 64 + 8 * (F.lane & 7);
#pragma unroll
          for (int st = 0; st < 3; ++st) { const int col = (st == 0 ? RC : st == 1 ? 0 : 2 * RC) + c8; Sh8 sq[4];
#pragma unroll
            for (int q = 0; q < 4; ++q) sq[q] = shift8_ld(U, t0 + (F.lane >> 3) + 8 * q, col);
#pragma unroll
            for (int q = 0; q < 4; ++q) { const int tl = (F.lane >> 3) + 8 * q, tq = t0 + tl; float x[8]; shift8_fin(sq[q], tq, col, mu_p, mu_n, x);
                v4u o; o.x = pk2(x[0], x[1]); o.y = pk2(x[2], x[3]); o.z = pk2(x[4], x[5]); o.w = pk2(x[6], x[7]);
                if (st == 0) *(LAS v4u*)(Kt + tl * 64 + 8 * (F.lane & 7)) = o;
                else if (tq < LTOK) *(v4u*)((st == 1 ? RR : VV) + (size_t)tq * RC + c8) = o; } } }
        __syncthreads();
        FPB1(15); FPB0(16);
        float kp[2][16], ss[16];
#pragma unroll
        for (int i = 0; i < 16; ++i) ss[i] = 0.f;
#pragma unroll
        for (int ct = 0; ct < 2; ++ct) { const int c = hd * 64 + 32 * ct + r; const float kkw = F.in[12][c];
#pragma unroll
            for (int i = 0; i < 16; ++i) { kp[ct][i] = bf2f(Kt[crow(i, hh) * 64 + 32 * ct + r]); const float kr = kp[ct][i] * kkw; ss[i] += kr * kr; } }
#pragma unroll
        for (int i = 0; i < 16; ++i) {
#pragma unroll
            for (int o = 1; o < 32; o <<= 1) ss[i] += __shfl_xor(ss[i], o);
            ss[i] = 1.0f / fmaxf(sqrtf(ss[i]), 1e-12f); }
#define LDF(dst, ptr, n) do { _Pragma("unroll") for (int s_ = 0; s_ < (n); ++s_) dst[s_] = *(const bf16x8*)((ptr) + 16 * s_); } while (0)
#define MMF(frag, xoff, n) do { _Pragma("unroll") for (int i_ = 0; i_ < 16; ++i_) acc[i_] = 0.f; const LAS bf16* ap_ = Xs + r * XS + (xoff) + 8 * hh; \
            _Pragma("unroll") for (int s_ = 0; s_ < (n); ++s_) acc = __builtin_amdgcn_mfma_f32_32x32x16_bf16(*(const LAS bf16x8*)(ap_ + 16 * s_), frag[s_], acc, 0, 0, 0); } while (0)
#pragma unroll
        for (int ct = 0; ct < 2; ++ct) {
            const int c = hd * 64 + 32 * ct + r, cb = hd * 64 + 32 * ct;
            const float kkw = F.in[12][c], kaw = F.in[13][c];
            const bf16* pa0 = a2t + (size_t)c * 96 + 8 * hh; const bf16* pa1 = a2t + ((size_t)RC + c) * 96 + 8 * hh;
            const bf16* pw0 = w2t + (size_t)c * 96 + 8 * hh; const bf16* pw1 = w2t + ((size_t)RC + c) * 96 + 8 * hh; const bf16* pg = g2t + (size_t)c * 256 + 8 * hh;
            bf16x8 fa[6], fg[16]; f32x16 acc; float kk[16];
            LDF(fa, pa0, 6);
#pragma unroll
            for (int i = 0; i < 16; ++i) { kk[i] = kp[ct][i] * kkw * ss[i]; Ot[crow(i, hh) * 32 + r] = (bf16)f2bf(kk[i]); }
            flush_bf16(Ot, KK, t0, cb, F.lane);
#pragma unroll
            for (int d = 0; d < 2; ++d) {
                if (d == 0) { MMF(fa, 192, 6); LDF(fa, pa1, 6); } else { MMF(fa, 288, 6); LDF(fa, pw0, 6); }
                const float a0 = F.in[9][d * RC + c];
#pragma unroll
                for (int i = 0; i < 16; ++i) { acc[i] = sigmoidf_(a0 + acc[i]); Ot[crow(i, hh) * 32 + r] = (bf16)f2bf(kp[ct][i] * (1.0f + (acc[i] - 1.0f) * kaw)); }
                flush_bf16(Ot, d ? KD1 : KD0, t0, cb, F.lane);
#pragma unroll
                for (int i = 0; i < 16; ++i) Ot[crow(i, hh) * 32 + r] = (bf16)f2bf(kk[i] * acc[i]);
                flush_bf16(Ot, d ? B1 : B0, t0, cb, F.lane);
            }
#pragma unroll
            for (int d = 0; d < 2; ++d) {
                if (d == 0) { MMF(fa, 0, 6); LDF(fa, pw1, 6); } else { MMF(fa, 96, 6); LDF(fg, pg, 16); }
                const float w0 = F.in[7][d * RC + c]; LAS float* Of = (LAS float*)Ot;
#pragma unroll
                for (int i = 0; i < 16; ++i) Of[crow(i, hh) * 32 + r] = __expf(-0.6065306597126334f * sigmoidf_(w0 + acc[i]));
                flush_f32(Of, d ? W1 : W0, t0, cb, F.lane);
            }
            MMF(fg, 384, 16);
#pragma unroll
            for (int i = 0; i < 16; ++i) Ot[crow(i, hh) * 32 + r] = (bf16)f2bf(acc[i]);
            flush_bf16(Ot, GG, t0, cb, F.lane);
        }
#undef LDF
#undef MMF
        asm volatile("s_waitcnt vmcnt(0) lgkmcnt(0)" ::: "memory");
#pragma unroll 1
        for (int q = 0; q < 4; ++q) { const int d = q >> 1, half = q & 1; const int blk = d ? (NB1 - 2 * tt - half) : (2 * tt + half);
            int lzq; asm volatile("v_mov_b32 %0, 0" : "=v"(lzq));
            if (blk >= 0 && blk < (d ? NB1 : NB0)) blockprep_item(F, wl, hd, d, blk, F.lane + lzq); }
        FPB1(16);
    }
    __syncthreads();
}

constexpr int N_SCAN_WAVES = 64;
constexpr int SR_SLOTS = 8, SR_STRIDE = 13312, SR_FV = 11264, SR_FLAGS = SR_SLOTS * SR_STRIDE, SR_WSCR = SR_FLAGS + 512, SR_NL = 4, SR_NS = 2;
static_assert(SR_WSCR + (8 - SR_NS - SR_NL) * 8448 <= RING_BYTES, "scan phase LDS map");
typedef unsigned short us2_t __attribute__((ext_vector_type(2)));
struct LdSet { v4u p[11]; us2_t v[2][4]; };
__device__ __forceinline__ void sr_issue(LdSet& s, const unsigned char* item, const bf16* VV, int hd, int d, int blk, int lane) {
#pragma unroll
    for (int k = 0; k < 11; ++k) { const int pc = k * 64 + lane; s.p[k] = *(const v4u*)(item + (pc < BO_ITEM / 16 ? pc : BO_ITEM / 16 - 1) * 16); }
    const int hh = lane >> 5, il = lane & 31;
#pragma unroll
    for (int e = 0; e < 8; ++e) { const unsigned short* vr = (const unsigned short*)VV + (size_t)blk_tok(d, blk, 8 * hh + e) * RC + hd * 64 + il; s.v[0][e >> 1][e & 1] = vr[0]; s.v[1][e >> 1][e & 1] = vr[32]; }
}
__device__ __forceinline__ void sr_write(const LdSet& s, LAS unsigned char* slot, int lane) {
#pragma unroll
    for (int k = 0; k < 11; ++k) *(LAS v4u*)(slot + (k * 64 + lane) * 16) = s.p[k];
#pragma unroll
    for (int h = 0; h < 2; ++h) { const v4u vw = {__builtin_bit_cast(unsigned, s.v[h][0]), __builtin_bit_cast(unsigned, s.v[h][1]), __builtin_bit_cast(unsigned, s.v[h][2]), __builtin_bit_cast(unsigned, s.v[h][3])};
        *(LAS v4u*)(slot + SR_FV + 1024 * h + lane * 16) = vw; }
}
__device__ __forceinline__ bf16x8 pack_half(const f32x16& x, int s) {
    const v4u w = {pk2(x[8 * s + 0], x[8 * s + 1]), pk2(x[8 * s + 2], x[8 * s + 3]), pk2(x[8 * s + 4], x[8 * s + 5]), pk2(x[8 * s + 6], x[8 * s + 7])}; return __builtin_bit_cast(bf16x8, w); }
__device__ __forceinline__ void scan_phase(Frame& F) {
    const bf16* VV = (const bf16*)(F.ws + WS_VV); bf16* Y = (bf16*)(F.ws + WS_Y); const unsigned char* BO = F.ws + WS_BO;
    const bool sblock = (int)blockIdx.x < N_SCAN_WAVES;
    volatile LAS unsigned* FL = (volatile LAS unsigned*)(F.lds + SR_FLAGS);
    constexpr unsigned SPIN_CAP = 1u << 22;
    __syncthreads();
    if (F.tid < 128) FL[F.tid] = 0u;
    __syncthreads();
    const int pair = (int)blockIdx.x, ih = F.wave & 1, hd = pair >> 1, d = pair & 1, nblk = d ? NB1 : NB0, hh = F.lane >> 5, il = F.lane & 31;
    if (sblock && F.wave < SR_NS) {
        __builtin_amdgcn_s_setprio(3);
        f32x16 St[2];
#pragma unroll
        for (int a = 0; a < 2; ++a)
#pragma unroll
            for (int i = 0; i < 16; ++i) St[a][i] = 0.f;
        FPB0(17);
        const unsigned long long scan_t0 = ((PROBE_PHASE >> 21) & 1) ? __builtin_amdgcn_s_memrealtime() : 0ull;
        for (int blk = 0; blk < nblk; ++blk) {
            const int sl = blk % SR_SLOTS; const LAS unsigned char* slot = F.lds + sl * SR_STRIDE;
            { unsigned sp = 0; while (FL[sl] != (unsigned)(blk + 1)) { __builtin_amdgcn_s_sleep(1); if (++sp > SPIN_CAP) break; } }
            asm volatile("" ::: "memory");
            bf16x8 fa[4], fb[2][2]; f32x4 gm[2][4];
#pragma unroll
            for (int ks = 0; ks < 4; ++ks) fa[ks] = *(const LAS bf16x8*)(slot + BO_FA + (ks * 64 + F.lane) * 16);
            const bf16x8 faa = *(const LAS bf16x8*)(slot + BO_FAA + F.lane * 16), vf = *(const LAS bf16x8*)(slot + SR_FV + 1024 * ih + F.lane * 16);
            bf16x8 ft = *(const LAS bf16x8*)(slot + BO_FT + (hh * 16 + (il & 15)) * 16), fbp = *(const LAS bf16x8*)(slot + BO_FBP + (hh * 16 + (il & 15)) * 16);
            { const bf16x8 zz = {0, 0, 0, 0, 0, 0, 0, 0}; ft = (il < 16) ? ft : zz; fbp = (il >= 16) ? fbp : zz; }
#pragma unroll
            for (int a = 0; a < 2; ++a)
#pragma unroll
                for (int k = 0; k < 2; ++k) fb[a][k] = *(const LAS bf16x8*)(slot + BO_FB + ((a * 2 + k) * 64 + F.lane) * 16);
#pragma unroll
            for (int a = 0; a < 2; ++a)
#pragma unroll
                for (int q = 0; q < 4; ++q) gm[a][q] = *(const LAS f32x4*)(slot + BO_FG + (32 * a + 8 * q + 4 * hh) * 4);
            asm volatile("s_waitcnt lgkmcnt(0)" ::: "memory");
            if (F.lane == 0) FL[16 + ih] = (unsigned)(blk + 1);
            f32x16 acc, accp;
#pragma unroll
            for (int i = 0; i < 16; ++i) { acc[i] = 0.f; accp[i] = 0.f; }
            acc = __builtin_amdgcn_mfma_f32_32x32x16_bf16(faa, vf, acc, 0, 0, 0);
#pragma unroll
            for (int a = 0; a < 2; ++a)
#pragma unroll
                for (int s = 0; s < 2; ++s) acc = __builtin_amdgcn_mfma_f32_32x32x16_bf16(fa[2 * a + s], pack_half(St[a], s), acc, 0, 0, 0);
            accp = __builtin_amdgcn_mfma_f32_32x32x16_bf16(ft, pack_half(acc, 0), accp, 0, 0, 0);
            const bf16x8 pb = pack_half(accp, 0);
            acc = __builtin_amdgcn_mfma_f32_32x32x16_bf16(fbp, pb, acc, 0, 0, 0);
#pragma unroll
            for (int e = 0; e < 8; ++e) { const int u = 8 * (e >> 2) + 4 * hh + (e & 3);
                Y[((size_t)d * LTOK + blk_tok(d, blk, u)) * RC + hd * 64 + 32 * ih + il] = (bf16)f2bf(acc[8 + e]); }
#pragma unroll
            for (int a = 0; a < 2; ++a) {
#pragma unroll
                for (int i = 0; i < 16; ++i) St[a][i] *= gm[a][i >> 2][i & 3];
                St[a] = __builtin_amdgcn_mfma_f32_32x32x16_bf16(fb[a][0], pb, St[a], 0, 0, 0);
                St[a] = __builtin_amdgcn_mfma_f32_32x32x16_bf16(fb[a][1], vf, St[a], 0, 0, 0);
            }
        }
        FPB1(17);
        if ((PROBE_PHASE >> 21) & 1) { if (F.lane == 0) atomicMax((unsigned*)(F.ctl + 2048), (unsigned)(__builtin_amdgcn_s_memrealtime() - scan_t0)); }
        __builtin_amdgcn_s_setprio(0);
    } else if (sblock && F.wave < SR_NS + SR_NL) {
        const int lw = F.wave - SR_NS;
        LdSet st[2];
#define SR_PUT(set, b_) do { const int sl_ = (b_) % SR_SLOTS; if ((b_) >= SR_SLOTS) { unsigned sp_ = 0; while (FL[16] < (unsigned)((b_) - SR_SLOTS + 1) || FL[17] < (unsigned)((b_) - SR_SLOTS + 1)) { __builtin_amdgcn_s_sleep(1); if (++sp_ > SPIN_CAP) break; } } \
            asm volatile("" ::: "memory"); sr_write(set, F.lds + sl_ * SR_STRIDE, F.lane); asm volatile("s_waitcnt lgkmcnt(0)" ::: "memory"); if (F.lane == 0) FL[sl_] = (unsigned)((b_) + 1); } while (0)
#pragma unroll
        for (int k = 0; k < 2; ++k) { const int bb = lw + SR_NL * k; if (bb < nblk) sr_issue(st[k], BO + bo_item(hd, d, bb), VV, hd, d, bb, F.lane); }
        for (int b0 = lw; b0 < nblk; b0 += 2 * SR_NL) {
#pragma unroll
            for (int k = 0; k < 2; ++k) { const int bb = b0 + SR_NL * k; if (bb < nblk) { SR_PUT(st[k], bb); const int nb = bb + 2 * SR_NL; if (nb < nblk) sr_issue(st[k], BO + bo_item(hd, d, nb), VV, hd, d, nb, F.lane); } }
        }
#undef SR_PUT
    } else {
        const int b = (int)blockIdx.x, nsb = F.G < N_SCAN_WAVES ? F.G : N_SCAN_WAVES, wps = 8 - SR_NS - SR_NL;
        const int widx = b < N_SCAN_WAVES ? b * wps + (F.wave - SR_NS - SR_NL) : nsb * wps + (b - N_SCAN_WAVES) * 8 + F.wave;
        const int NWK = nsb * wps + (F.G - nsb) * 8;
        unsigned long long rp0 = 0, rp1 = 0, rp2 = 0;
        if (PROBE_PHASE & ((3 << 18) | (1 << 22))) rp0 = __builtin_amdgcn_s_memrealtime();
        LAS float* scr = (LAS float*)(F.lds + (sblock ? SR_WSCR + (F.wave - SR_NS - SR_NL) * 8448 : F.wave * 8448));
        attn_phase(F, widx, NWK);
        if (PROBE_PHASE & (3 << 18)) rp1 = __builtin_amdgcn_s_memrealtime();
        convert_p4(F, scr, widx, NWK, sblock ? -1 : (b - N_SCAN_WAVES) * 8 + F.wave, (F.G - nsb) * 8);
        if (PROBE_PHASE & (3 << 18)) { rp2 = __builtin_amdgcn_s_memrealtime(); if ((int)blockIdx.x == F.G - 1 && F.tid == 0) { unsigned long long v = 0; if ((PROBE_PHASE >> 18) & 1) v += rp1 - rp0; if ((PROBE_PHASE >> 19) & 1) v += rp2 - rp1;
            __hip_atomic_store((unsigned*)(F.ctl + 2048), (unsigned)v, __ATOMIC_RELAXED, __HIP_MEMORY_SCOPE_AGENT); } }
        if ((PROBE_PHASE >> 22) & 1) { if (blockIdx.x == 0 && F.wave == 6 && F.lane == 0) __hip_atomic_store((unsigned*)(F.ctl + 2048), (unsigned)(__builtin_amdgcn_s_memrealtime() - rp0), __ATOMIC_RELAXED, __HIP_MEMORY_SCOPE_AGENT); }
    }
}

__device__ __forceinline__ float row16_sum(float x) {
    x += __builtin_bit_cast(float, __builtin_amdgcn_update_dpp(0, __builtin_bit_cast(int, x), 0xB1, 0xf, 0xf, true));
    x += __builtin_bit_cast(float, __builtin_amdgcn_update_dpp(0, __builtin_bit_cast(int, x), 0x4E, 0xf, 0xf, true));
    x += __builtin_bit_cast(float, __builtin_amdgcn_update_dpp(0, __builtin_bit_cast(int, x), 0x141, 0xf, 0xf, true));
    x += __builtin_bit_cast(float, __builtin_amdgcn_update_dpp(0, __builtin_bit_cast(int, x), 0x140, 0xf, 0xf, true));
    return x;
}
__device__ __forceinline__ void combine_phase(Frame& F) {
    const bf16* Y0 = (const bf16*)(F.ws + WS_Y); const bf16* Y1 = Y0 + (size_t)LTOK * RC; const float* BON = (const float*)(F.ws + WS_BONUS);
    const bf16* VV = (const bf16*)(F.ws + WS_VV); const bf16* GG = (const bf16*)(F.ws + WS_GG);
    bf16* OR = (bf16*)(F.ws + WS_ORWKV);
    const float* lnw = F.in[15]; const float* lnb = F.in[16];
    const int gw = blockIdx.x * 8 + F.wave, NGW = F.G * 8;
    for (int row = gw; row < SEQ; row += NGW) { const int t = row + NMETA;
#pragma unroll
        for (int st = 0; st < 8; ++st) { const int c = st * 256 + 4 * F.lane, hd = c >> 6; const size_t o = (size_t)t * RC + c;
            const v2u a0 = *(const v2u*)(Y0 + o), a1 = *(const v2u*)(Y1 + o), vv = *(const v2u*)(VV + o), gg = *(const v2u*)(GG + o);
            const f32x4 w = *(const f32x4*)(lnw + c), bb = *(const f32x4*)(lnb + c); const float bon = BON[(size_t)t * RH + hd];
            float y[4] = {bflo(a0.x) + bflo(a1.x), bfhi(a0.x) + bfhi(a1.x), bflo(a0.y) + bflo(a1.y), bfhi(a0.y) + bfhi(a1.y)};
            const float mean = row16_sum((y[0] + y[1]) + (y[2] + y[3])) * (1.0f / 64.0f);
#pragma unroll
            for (int e = 0; e < 4; ++e) y[e] -= mean;
            const float var = row16_sum((y[0] * y[0] + y[1] * y[1]) + (y[2] * y[2] + y[3] * y[3])) * (1.0f / 64.0f);
            const float rs = __builtin_amdgcn_rsqf(var + GN_EPS);
            const float v4[4] = {bflo(vv.x), bfhi(vv.x), bflo(vv.y), bfhi(vv.y)}, g4[4] = {bflo(gg.x), bfhi(gg.x), bflo(gg.y), bfhi(gg.y)};
            float ov[4];
#pragma unroll
            for (int e = 0; e < 4; ++e) ov[e] = (y[e] * rs * w[e] + bb[e] + bon * v4[e]) * g4[e];
            v2u ow; ow.x = pk2(ov[0], ov[1]); ow.y = pk2(ov[2], ov[3]);
            *(v2u*)(OR + (size_t)row * RC + c) = ow; } }
}
__device__ __forceinline__ void final_phase(Frame& F) {
    const float* SS3 = (const float*)(F.ctl + CW_SS3); const float* w = F.in[25];
    const int gw = blockIdx.x * 8 + F.wave, NGW = F.G * 8;
    for (int row = gw; row < SEQ; row += NGW) { const float rstd = 1.0f / sqrtf(SS3[row] * (1.0f / DM) + RMS_EPS);
        GAS f32x4* p = (GAS f32x4*)(F.out + (size_t)row * DM) + F.lane; const GAS f32x4* wp = (const GAS f32x4*)w + F.lane;
#pragma unroll
        for (int j = 0; j < 16; ++j) { const f32x4 v = p[64 * j], ww = wp[64 * j]; p[64 * j] = v * rstd * ww; } }
}
constexpr int N_PHASES = 10;
struct Args { const float* in[26]; float* out; unsigned char* ws; int ph_lo, ph_hi; };
__global__ void __launch_bounds__(512, 2) fwd_kernel(Args args) {
    extern __shared__ __attribute__((aligned(16))) unsigned char lds[];
    Frame F;
    F.lds = (LAS unsigned char*)lds;
    F.MISC = (volatile LAS unsigned*)(F.lds + MISC_OFF);
    F.tid = threadIdx.x; F.lane = F.tid & 63; F.wave = __builtin_amdgcn_readfirstlane(F.tid >> 6); F.G = gridDim.x;
    F.ws = args.ws; F.ctl = (gu32*)(args.ws + WS_CTL); F.out = args.out; F.pb0 = 0; F.pacc = 0; F.pacc2 = 0;
#pragma unroll
    for (int i = 0; i < 26; ++i) F.in[i] = args.in[i];
    for (int u = F.tid; u < (LDS_BYTES - LDSCTL_OFF) / 4; u += 512) ((LAS unsigned*)(F.lds + LDSCTL_OFF))[u] = 0u;
    __syncthreads();
    XcdBarrier bar; bar.bar = (unsigned*)(F.ctl + CW_BAR); bar.x = 0; bar.st = nullptr;
    if (!MK_SPLIT) bar = xcd_barrier_post((unsigned*)(F.ctl + CW_BAR), F.MISC + 8);
    const int lo = args.ph_lo, hi = args.ph_hi;
#define IN(k) (lo <= (k) && (k) < hi)
#define SEAM(k) do { if (IN(k) && IN((k) + 1)) xcd_barrier(bar); } while (0)
    bf16* Rm = (bf16*)(F.ws + WS_H);
    float* SS2 = (float*)(F.ctl + CW_SS2); float* SS3 = (float*)(F.ctl + CW_SS3);

    unsigned long long pt0 = 0, pt1 = 0;
#define PB0(k) do { if ((PROBE_PHASE >> (k)) & 1) pt0 = __builtin_amdgcn_s_memrealtime(); } while (0)
#define PB1(k) do { if ((PROBE_PHASE >> (k)) & 1) pt1 += __builtin_amdgcn_s_memrealtime() - pt0; } while (0)
    PB0(0); if (IN(0)) { p0_prologue(F); } SEAM(0); PB1(0);
    PB0(1); if (IN(1)) {
        pg8::Gemm g{Rm, Rm, MPAD + INWP, MPAD + INWP, DM}; pg8::InOrder S; S.init(F.G, (int)blockIdx.x);
        pg8::EpiIn E{(bf16*)(F.ws + WS_G), (bf16*)(F.ws + WS_Q), (bf16*)(F.ws + WS_K), (bf16*)(F.ws + WS_VT), (bf16*)(F.ws + WS_U), F.in[4], (const float*)(F.ws + WS_ROPE)};
        pg8::gemm_phase<pg8::EpiIn, pg8::InOrder, true, true>(F.lds, g, S, E, F.pacc2);
    } SEAM(1); PB1(1);
    PB0(2); if (IN(2)) { prep_phase(F); } SEAM(2); PB1(2);
    PB0(3); if (IN(3)) { scan_phase(F); } SEAM(3); PB1(3);
    PB0(4); if (IN(4)) { combine_phase(F); } SEAM(4); PB1(4);
    PB0(5); if (IN(5)) {
        { pg8::Gemm g{(const bf16*)(F.ws + WS_OATT), (const bf16*)(F.ws + WS_WPA), SEQ, DM, ATTW}; pg8::StaticOrder S; S.init(SEQ, DM, F.G, (int)blockIdx.x);
          pg8::EpiProjA E{(bf16*)(F.ws + WS_P1), (const bf16*)(F.ws + WS_G)};
          pg8::gemm_phase<pg8::EpiProjA, pg8::StaticOrder, true, true>(F.lds, g, S, E, F.pacc2); }
        __syncthreads();
        { pg8::Gemm g{(const bf16*)(F.ws + WS_ORWKV), (const bf16*)(F.ws + WS_WPR), SEQ, DM, RC}; pg8::StaticOrder S; S.init(SEQ, DM, F.G, (int)blockIdx.x);
          pg8::EpiProjB E{(const bf16*)(F.ws + WS_P1), (const bf16*)(F.ws + WS_G), (bf16*)(F.ws + WS_MX)};
          pg8::gemm_phase<pg8::EpiProjB, pg8::StaticOrder, true, true>(F.lds, g, S, E, F.pacc2); }
    } SEAM(5); PB1(5);
    PB0(6); if (IN(6)) {
        pg8::Gemm g{(const bf16*)(F.ws + WS_MX), (const bf16*)(F.ws + WS_WOUT), SEQ, DM, DM}; pg8::StaticOrder S; S.init(SEQ, DM, F.G, (int)blockIdx.x);
        pg8::EpiResid<false> E{F.in[0], nullptr, nullptr, (bf16*)(F.ws + WS_A2), SS2};
        pg8::gemm_phase<pg8::EpiResid<false>, pg8::StaticOrder, true, true>(F.lds, g, S, E, F.pacc2);
    } SEAM(6); PB1(6);
    const unsigned long long epi_before7 = F.pacc2;
    PB0(7); if (IN(7)) {
        pg8::Gemm g{(const bf16*)(F.ws + WS_A2), (const bf16*)(F.ws + WS_WGU), SEQ, 2 * DFF, DM}; pg8::StaticOrder S; S.init(SEQ, 2 * DFF, F.G, (int)blockIdx.x);
        pg8::EpiSwiGLU E{(bf16*)(F.ws + WS_HID), SS2};
        pg8::gemm_phase<pg8::EpiSwiGLU, pg8::StaticOrder, true, true>(F.lds, g, S, E, F.pacc2);
        {
          const int nun = (SEQ / 256) * (2 * DFF / 256), rounds = (nun + F.G - 1) / F.G, first_idle = nun - (rounds - 1) * F.G;
          const int nidle = F.G - first_idle;
          if (nidle > 0) { if ((int)blockIdx.x >= first_idle) convert_wd(F, (LAS float*)(F.lds + F.wave * 8448), ((int)blockIdx.x - first_idle) * 8 + F.wave, nidle * 8); }
          else convert_wd(F, (LAS float*)(F.lds + F.wave * 8448), (int)blockIdx.x * 8 + F.wave, F.G * 8); }
    } SEAM(7); PB1(7);
    const unsigned long long epi_before8 = F.pacc2;
    PB0(8); if (IN(8)) {
        pg8::Gemm g{(const bf16*)(F.ws + WS_HID), (const bf16*)(F.ws + WS_WD), SEQ, DM, DFF}; pg8::StaticOrder S; S.init(SEQ, DM, F.G, (int)blockIdx.x);
        pg8::EpiResid<true> E{nullptr, (const bf16*)(F.ws + WS_A2), F.out, nullptr, SS3};
        pg8::gemm_phase<pg8::EpiResid<true>, pg8::StaticOrder, true, true>(F.lds, g, S, E, F.pacc2);
    } SEAM(8); PB1(8);
    const unsigned long long epi9 = ((PROBE_PHASE >> 24) & 1) ? (epi_before8 - epi_before7) : (F.pacc2 - epi_before8);
    PB0(9); if (IN(9)) { final_phase(F); } PB1(9);
    if (PROBE_PHASE != 0 && blockIdx.x == 0 && F.tid == 0) { const unsigned long long te = __builtin_amdgcn_s_memrealtime(), want = (unsigned long long)PROBE_MULT * (((PROBE_PHASE >> 23) & 1) ? epi9 : ((PROBE_PHASE >> 20) & 1) ? F.pacc2 : (PROBE_PHASE & ((3 << 18) | (3 << 21))) ? (unsigned long long)__hip_atomic_load((unsigned*)(F.ctl + 2048), __ATOMIC_RELAXED, __HIP_MEMORY_SCOPE_AGENT) : (pt1 + F.pacc));
        while (__builtin_amdgcn_s_memrealtime() - te < want && want < 2000000ull) __builtin_amdgcn_s_sleep(32); }
#undef PB0
#undef PB1
#undef IN
#undef SEAM
}

extern "C" void kernel_launch(void* const* d_in, const int* in_sizes, int n_in, void* d_out, int out_size, void* d_ws, size_t ws_size, hipStream_t stream) {
    static int grid = 0;
    if (grid == 0) {
        if (n_in != 26 || out_size != SEQ * DM || ws_size < WS_END) { fprintf(stderr, "kernel_launch: unexpected shapes (n_in %d, out %d, ws %zu, need %zu); nothing launched\n", n_in, out_size, ws_size, (size_t)WS_END); grid = -1; return; }
        int dev = 0, cus = 0, per_cu = 0;
        if (hipGetDevice(&dev) != hipSuccess || hipDeviceGetAttribute(&cus, hipDeviceAttributeMultiprocessorCount, dev) != hipSuccess) { grid = -1; return; }
        if (hipFuncSetAttribute((const void*)fwd_kernel, hipFuncAttributeMaxDynamicSharedMemorySize, LDS_BYTES) != hipSuccess) { fprintf(stderr, "kernel_launch: hipFuncSetAttribute failed\n"); grid = -1; return; }
        if (hipOccupancyMaxActiveBlocksPerMultiprocessor(&per_cu, (const void*)fwd_kernel, 512, LDS_BYTES) != hipSuccess || per_cu < 1) fprintf(stderr, "kernel_launch: occupancy query says %d per CU\n", per_cu);
        (void)hipGetLastError();
        grid = cus;
    }
    if (grid < 0) return;
    if (hipMemsetAsync((char*)d_ws + WS_CTL, 0, ZERO_BYTES, stream) != hipSuccess) return;
    Args a{};
    for (int i = 0; i < 26; ++i) a.in[i] = (const float*)d_in[i];
    a.out = (float*)d_out; a.ws = (unsigned char*)d_ws;
#if MK_SPLIT
    for (int p = 0; p < N_PHASES; ++p) { a.ph_lo = p; a.ph_hi = p + 1; hipLaunchKernelGGL(fwd_kernel, dim3(grid), dim3(512), LDS_BYTES, stream, a); }
#else
    a.ph_lo = 0; a.ph_hi = N_PHASES;
    hipLaunchKernelGGL(fwd_kernel, dim3(grid), dim3(512), LDS_BYTES, stream, a);
#endif
}
```

```cpp
#include <hip/hip_runtime.h>
#include <cstdio>
#include <cstdint>

#ifndef MK_SPLIT
#define MK_SPLIT 0
#endif

#ifndef PROBE_PHASE
#define PROBE_PHASE 0
#endif
#ifndef PROBE_MULT
#define PROBE_MULT 2
#endif
constexpr int NMETA = 16, SEQ = 8192, LTOK = 8208, DM = 4096, MPAD = 8448;
constexpr int INW = 18048, INWP = 18176;
constexpr int ATTW = 2048, KVW = 512, UW = 6784, UPITCH = 6912;
constexpr int RC = 2048, RH = 32, RN = 64;
constexpr int DFF = 11008;
constexpr float RMS_EPS = 1e-6f, GN_EPS = 64e-5f;
constexpr int HT = MPAD / 256;
constexpr int CT_Q = 32, CT_K = 40, CT_V = 42, CT_U = 44, CT_N = 71;

namespace pg8 {
#define PG8_LAS __attribute__((address_space(3)))
typedef unsigned short bf16_t;
typedef short bf16x8 __attribute__((ext_vector_type(8)));
typedef float f32x4 __attribute__((ext_vector_type(4)));
typedef unsigned u32x4 __attribute__((ext_vector_type(4)));
constexpr int BM = 256, BK = 64, HALF = 128, HTB = HALF * BK * 2  , STAGE_BYTES = 8 * HTB, NXCD = 8, WGM = 8;

__host__ __device__ __forceinline__ int lds_byte(int r, int c) { const int st = (r >> 4) * 2 + (c >> 5), rr = r & 15, cc = c & 31, ob = rr * 64 + cc * 2; return st * 1024 + (ob ^ (((ob >> 9) & 1) << 5)); }
__host__ __device__ __forceinline__ void stage_rc(int b, int& R, int& C) { const int st = b / 1024, sb = b % 1024, swz = sb ^ (((sb >> 9) & 1) << 5); R = (st >> 1) * 16 + swz / 64; C = (st & 1) * 32 + (swz % 64) / 2; }
__host__ __device__ __forceinline__ int perm32(int rho) { const int n = rho >> 4, i = rho & 15; return 8 * (i >> 2) + 4 * n + (i & 3); }

struct Unit { int pm, pn; };
struct Gemm { const bf16_t* A; const bf16_t* Bt; int M, N, K; };

struct StaticOrder {
    int nM, nN, nwg, G, c;
    __host__ __device__ void init(int M, int N, int G_, int c_) { nM = M / BM; nN = N / BM; nwg = nM * nN; G = G_; c = c_; }
    __host__ __device__ bool next(int i, Unit& u) const {
        const long L = (long)i * G + c; if (L >= nwg) return false;
        int wgid = (int)L; { const int q = nwg / NXCD, r = nwg % NXCD, xcd = wgid % NXCD, off = wgid / NXCD; wgid = (xcd < r ? xcd * (q + 1) : r * (q + 1) + (xcd - r) * q) + off; }
        const int nig = WGM * nN, gid = wgid / nig, fm = gid * WGM, gsz = (nM - fm) < WGM ? (nM - fm) : WGM;
        u.pm = fm + ((wgid % nig) % gsz); u.pn = (wgid % nig) / gsz; return true;
    }
    __device__ __forceinline__ void a_ready(const Unit&) const {}
    __device__ __forceinline__ void done(const Unit&) const {}
};

typedef float f32x2c __attribute__((ext_vector_type(2)));
typedef __bf16 bf16x2c __attribute__((ext_vector_type(2)));
__device__ __forceinline__ unsigned cvt_pk_bf16(float lo, float hi) { const f32x2c v = {lo, hi}; const bf16x2c r = __builtin_convertvector(v, bf16x2c); return __builtin_bit_cast(unsigned, r); }

typedef unsigned u32x2 __attribute__((ext_vector_type(2)));
__device__ __forceinline__ float bflo(unsigned w) { return __uint_as_float(w << 16); }
__device__ __forceinline__ float bfhi(unsigned w) { return __uint_as_float(w & 0xffff0000u); }
__device__ __forceinline__ float sigmoidf_(float x) { return __builtin_amdgcn_rcpf(1.0f + __expf(-x)); }

struct InOrder {
    StaticOrder base; int G, c;
    __device__ void init(int G_, int c_) { base.init(SEQ, INWP, G_, c_); G = G_; c = c_; }
    __device__ bool next(int i, Unit& u) const {
        const long L = (long)i * G + c;
        if (L < base.nwg) {
            base.next(i, u);
            if (u.pn >= CT_V && u.pn < CT_U) { const int e = (u.pn - CT_V) * 32 + u.pm; u.pm = HT + CT_V + e / HT; u.pn = e % HT; }
            else u.pn += HT;
            return true;
        }
        const int x = (int)(L - base.nwg);
        if (x >= 31) return false;
        if (x < 2) { const int e = 64 + x; u.pm = HT + CT_V + e / HT; u.pn = e % HT; }
        else { const int y = x - 2; u.pm = 32; u.pn = HT + (y < 2 ? CT_K + y : CT_U + (y - 2)); }
        return true;
    }
    __device__ __forceinline__ void a_ready(const Unit&) const {}
    __device__ __forceinline__ void done(const Unit&) const {}
};

struct EpiIn {
    static constexpr bool PERM = true, AFTER_DRAIN = false;
    bf16_t *G, *Q, *K, *Vt, *U; const float* bgate; const float* rope;
    __device__ __forceinline__ static void st8(bf16_t* p, const f32x4& v0, const f32x4& v1) {
        u32x4 w; w.x = cvt_pk_bf16(v0[0], v0[1]); w.y = cvt_pk_bf16(v0[2], v0[3]); w.z = cvt_pk_bf16(v1[0], v1[1]); w.w = cvt_pk_bf16(v1[2], v1[3]); *(u32x4*)p = w; }
    __device__ __forceinline__ void plain(const f32x4 (&acc)[2][2][4][2], bf16_t* base, int ldc, int row0, int col0) const {
#pragma unroll
        for (int ai = 0; ai < 2; ++ai)
#pragma unroll
            for (int m = 0; m < 4; ++m) { bf16_t* rowp = base + (size_t)(row0 + ai * HALF + m * 16) * ldc + col0;
#pragma unroll
                for (int bj = 0; bj < 2; ++bj) st8(rowp + bj * HALF, acc[ai][bj][m][0], acc[ai][bj][m][1]); }
    }
    __device__ __forceinline__ void roped(const f32x4 (&acc)[2][2][4][2], bf16_t* base, int ldc, int row0, int col0, int wc, int fq) const {
        if (wc != 0) { plain(acc, base, ldc, row0, col0); return; }
        const float sgn = (fq < 2) ? -1.0f : 1.0f;
#pragma unroll
        for (int ai = 0; ai < 2; ++ai)
#pragma unroll
            for (int m = 0; m < 4; ++m) { const int row = row0 + ai * HALF + m * 16; const int pos = row < SEQ ? row + NMETA : row - SEQ;
                const f32x4* cs = (const f32x4*)(rope + (size_t)pos * 32 + 16 * (fq & 1));
                const f32x4 c0 = cs[0], c1 = cs[1], c2 = cs[2], c3 = cs[3];
                const float cw[8] = {c0[0], c0[2], c1[0], c1[2], c2[0], c2[2], c3[0], c3[2]}, sw[8] = {c0[1], c0[3], c1[1], c1[3], c2[1], c2[3], c3[1], c3[3]};
                bf16_t* rowp = base + (size_t)row * ldc + col0;
#pragma unroll
                for (int bj = 0; bj < 2; ++bj) { f32x4 v0 = acc[ai][bj][m][0], v1 = acc[ai][bj][m][1], o0, o1;
#pragma unroll
                    for (int e = 0; e < 4; ++e) { const float p0 = __shfl_xor(v0[e], 32), p1 = __shfl_xor(v1[e], 32);
                        o0[e] = v0[e] * cw[e] + sgn * p0 * sw[e]; o1[e] = v1[e] * cw[4 + e] + sgn * p1 * sw[4 + e]; }
                    st8(rowp + bj * HALF, o0, o1); } }
    }
    __device__ __forceinline__ void operator()(const f32x4 (&acc)[2][2][4][2], const Unit& u, int wr, int wc, int fr, int fq) const {
        if (u.pm >= HT) {
            plain(acc, Vt, MPAD, (u.pm - HT - CT_V) * BM + wr * 64 + fr, u.pn * BM + wc * 32 + 8 * fq); return; }
        const int ct = u.pn - HT, row0 = u.pm * BM + wr * 64 + fr, cl = wc * 32 + 8 * fq;
        if (ct < CT_Q) {
            const int col0 = ct * BM + cl;
#pragma unroll
            for (int bj = 0; bj < 2; ++bj) { const f32x4 b0 = *(const f32x4*)(bgate + col0 + bj * HALF), b1 = *(const f32x4*)(bgate + col0 + bj * HALF + 4);
#pragma unroll
                for (int ai = 0; ai < 2; ++ai)
#pragma unroll
                    for (int m = 0; m < 4; ++m) { f32x4 v0 = acc[ai][bj][m][0] + b0, v1 = acc[ai][bj][m][1] + b1;
#pragma unroll
                        for (int e = 0; e < 4; ++e) { v0[e] = sigmoidf_(v0[e]); v1[e] = sigmoidf_(v1[e]); }
                        st8(G + (size_t)(row0 + ai * HALF + m * 16) * (2 * DM) + col0 + bj * HALF, v0, v1); } }
        } else if (ct < CT_K) { roped(acc, Q, ATTW, row0, (ct - CT_Q) * BM + cl, wc, fq);
        } else if (ct < CT_V) { roped(acc, K, KVW, row0, (ct - CT_K) * BM + cl, wc, fq);
        } else { plain(acc, U, UPITCH, row0, (ct - CT_U) * BM + cl); }
    }
};

struct EpiProjA {
    static constexpr bool PERM = true, AFTER_DRAIN = false;
    bf16_t* P1; const bf16_t* G;
    __device__ __forceinline__ void operator()(const f32x4 (&acc)[2][2][4][2], const Unit& u, int wr, int wc, int fr, int fq) const {
        const int row0 = u.pm * BM + wr * 64 + fr, col0 = u.pn * BM + wc * 32 + 8 * fq;
#pragma unroll
        for (int ai = 0; ai < 2; ++ai)
#pragma unroll
            for (int m = 0; m < 4; ++m) { const size_t r = (size_t)(row0 + ai * HALF + m * 16);
#pragma unroll
                for (int bj = 0; bj < 2; ++bj) { const int c = col0 + bj * HALF; const u32x4 g = *(const u32x4*)(G + r * (2 * DM) + c);
                    f32x4 o0 = acc[ai][bj][m][0], o1 = acc[ai][bj][m][1];
                    o0[0] *= bflo(g.x); o0[1] *= bfhi(g.x); o0[2] *= bflo(g.y); o0[3] *= bfhi(g.y); o1[0] *= bflo(g.z); o1[1] *= bfhi(g.z); o1[2] *= bflo(g.w); o1[3] *= bfhi(g.w);
                    EpiIn::st8(P1 + r * DM + c, o0, o1); } }
    }
};
struct EpiProjB {
    static constexpr bool PERM = true, AFTER_DRAIN = false;
    const bf16_t* P1; const bf16_t* G; bf16_t* MX;
    __device__ __forceinline__ void operator()(const f32x4 (&acc)[2][2][4][2], const Unit& u, int wr, int wc, int fr, int fq) const {
        const int row0 = u.pm * BM + wr * 64 + fr, col0 = u.pn * BM + wc * 32 + 8 * fq;
#pragma unroll
        for (int ai = 0; ai < 2; ++ai)
#pragma unroll
            for (int m = 0; m < 4; ++m) { const size_t r = (size_t)(row0 + ai * HALF + m * 16);
#pragma unroll
                for (int bj = 0; bj < 2; ++bj) { const int c = col0 + bj * HALF; const u32x4 g = *(const u32x4*)(G + r * (2 * DM) + DM + c); const u32x4 q = *(const u32x4*)(P1 + r * DM + c);
                    f32x4 o0 = {bflo(q.x), bfhi(q.x), bflo(q.y), bfhi(q.y)}, o1 = {bflo(q.z), bfhi(q.z), bflo(q.w), bfhi(q.w)}; const f32x4 a0 = acc[ai][bj][m][0], a1 = acc[ai][bj][m][1];
                    o0[0] += a0[0] * bflo(g.x); o0[1] += a0[1] * bfhi(g.x); o0[2] += a0[2] * bflo(g.y); o0[3] += a0[3] * bfhi(g.y);
                    o1[0] += a1[0] * bflo(g.z); o1[1] += a1[1] * bfhi(g.z); o1[2] += a1[2] * bflo(g.w); o1[3] += a1[3] * bfhi(g.w);
                    EpiIn::st8(MX + r * DM + c, o0, o1); }
                asm volatile("" ::: "memory"); }
    }
};
template <bool BASE_BF16> struct EpiResid {
    static constexpr bool PERM = true, AFTER_DRAIN = false;
    const float* BASEF; const bf16_t* BASEB; float* OUTF; bf16_t* OUTB; float* SS;
    __device__ __forceinline__ void operator()(const f32x4 (&acc)[2][2][4][2], const Unit& u, int wr, int wc, int fr, int fq) const {
        const int row0 = u.pm * BM + wr * 64 + fr, col0 = u.pn * BM + wc * 32 + 8 * fq;
#pragma unroll
        for (int ai = 0; ai < 2; ++ai)
#pragma unroll
            for (int m = 0; m < 4; ++m) { const size_t r = (size_t)(row0 + ai * HALF + m * 16); float ss = 0.f;
#pragma unroll
                for (int bj = 0; bj < 2; ++bj) { const int c = col0 + bj * HALF; f32x4 o0, o1;
                    if (BASE_BF16) { const u32x4 g = *(const u32x4*)(BASEB + r * DM + c); o0 = (f32x4){bflo(g.x), bfhi(g.x), bflo(g.y), bfhi(g.y)}; o1 = (f32x4){bflo(g.z), bfhi(g.z), bflo(g.w), bfhi(g.w)}; }
                    else { const float* bp = BASEF + r * DM + c; o0 = *(const f32x4*)bp; o1 = *(const f32x4*)(bp + 4); }
                    o0 += acc[ai][bj][m][0]; o1 += acc[ai][bj][m][1];
                    if (BASE_BF16) { float* op = OUTF + r * DM + c; *(f32x4*)op = o0; *(f32x4*)(op + 4) = o1; }
                    else { u32x4 w; w.x = cvt_pk_bf16(o0[0], o0[1]); w.y = cvt_pk_bf16(o0[2], o0[3]); w.z = cvt_pk_bf16(o1[0], o1[1]); w.w = cvt_pk_bf16(o1[2], o1[3]); *(u32x4*)(OUTB + r * DM + c) = w;
                        o0 = (f32x4){bflo(w.x), bfhi(w.x), bflo(w.y), bfhi(w.y)}; o1 = (f32x4){bflo(w.z), bfhi(w.z), bflo(w.w), bfhi(w.w)}; }
                    ss += (o0[0] * o0[0] + o0[1] * o0[1]) + (o0[2] * o0[2] + o0[3] * o0[3]) + (o1[0] * o1[0] + o1[1] * o1[1]) + (o1[2] * o1[2] + o1[3] * o1[3]); }
                ss += __shfl_xor(ss, 16); ss += __shfl_xor(ss, 32);
                if (fq == 0) atomicAdd(SS + r, ss);
                asm volatile("" ::: "memory"); }
    }
};
struct EpiSwiGLU {
    static constexpr bool PERM = true, AFTER_DRAIN = false;
    bf16_t* HID; const float* SS;
    __device__ __forceinline__ void operator()(const f32x4 (&acc)[2][2][4][2], const Unit& u, int wr, int wc, int fr, int fq) const {
        const int row0 = u.pm * BM + wr * 64 + fr, col0 = u.pn * HALF + wc * 32 + 8 * fq;
#pragma unroll
        for (int ai = 0; ai < 2; ++ai)
#pragma unroll
            for (int m = 0; m < 4; ++m) { const size_t r = (size_t)(row0 + ai * HALF + m * 16);
                const float rstd = __builtin_amdgcn_rsqf(SS[r] * (1.0f / DM) + RMS_EPS);
                f32x4 o0, o1;
#pragma unroll
                for (int e = 0; e < 4; ++e) { const float g0 = acc[ai][0][m][0][e] * rstd, u0 = acc[ai][1][m][0][e] * rstd, g1 = acc[ai][0][m][1][e] * rstd, u1 = acc[ai][1][m][1][e] * rstd;
                    o0[e] = g0 * sigmoidf_(g0) * u0; o1[e] = g1 * sigmoidf_(g1) * u1; }
                EpiIn::st8(HID + r * DFF + col0, o0, o1); }
    }
};

#define PG8_EPI_T0 unsigned long long epi_t0_ = 0; do { if ((PROBE_PHASE >> 20) & 1) epi_t0_ = __builtin_amdgcn_s_memrealtime(); } while (0)
#define PG8_EPI_T1 do { if ((PROBE_PHASE >> 20) & 1) epi_acc += __builtin_amdgcn_s_memrealtime() - epi_t0_; } while (0)
template <class Epi, class Sched, bool ALIGN_EPI = false, bool SP2 = false>
__device__ __forceinline__ void gemm_phase(PG8_LAS unsigned char* lds, const Gemm g, const Sched& S, const Epi& E, unsigned long long& epi_acc) {
    const int tid = threadIdx.x, wid = __builtin_amdgcn_readfirstlane(tid >> 6), lane = tid & 63, wr = wid >> 2, wc = wid & 3, fr = lane & 15, fq = lane >> 4;
    const int K = g.K, nt = K / BK;
    unsigned voffA[2], voffB[2];
#pragma unroll
    for (int i = 0; i < 2; ++i) { int R, C; stage_rc(tid * 16 + i * 8192, R, C); const int Rb = Epi::PERM ? ((R & ~31) + perm32(R & 31)) : R;
        voffA[i] = (unsigned)(R * K + C) * 2u; voffB[i] = (unsigned)(Rb * K + C) * 2u; }
    const size_t kstep = (size_t)(BK * 2);
    const size_t hstep = (size_t)HALF * K * 2;
    const size_t tstep = 2 * hstep;
    const unsigned ldsw = (unsigned)wid * 1024u;
    const int aoff = lds_byte(wr * 64 + fr, fq * 8), boff = lds_byte(wc * 32 + fr, fq * 8);
#define PG8_SA(b, h) (((b) * 2 + (h)) * HTB)
#define PG8_SB(b, h) ((4 + (b) * 2 + (h)) * HTB)
#define PG8_STAGE(bufoff, gbase, voff) do { _Pragma("unroll") for (int _i = 0; _i < 2; ++_i) \
        __builtin_amdgcn_global_load_lds((const unsigned*)((const char*)(gbase) + (voff)[_i]), (PG8_LAS unsigned*)(lds + (bufoff) + ldsw + _i * 8192), 16, 0, 0); } while (0)
#define PG8_LDA(dst, b, h) do { _Pragma("unroll") for (int m = 0; m < 4; ++m) _Pragma("unroll") for (int k = 0; k < 2; ++k) dst[m][k] = *(const PG8_LAS bf16x8*)(lds + PG8_SA(b, h) + aoff + m * 2048 + k * 1024); } while (0)
#define PG8_LDB(dst, b, h) do { _Pragma("unroll") for (int n = 0; n < 2; ++n) _Pragma("unroll") for (int k = 0; k < 2; ++k) dst[n][k] = *(const PG8_LAS bf16x8*)(lds + PG8_SB(b, h) + boff + n * 2048 + k * 1024); } while (0)
#define PG8_MMA(ai, bj, At, Bt) do { __builtin_amdgcn_s_setprio(1); _Pragma("unroll") for (int m = 0; m < 4; ++m) _Pragma("unroll") for (int n = 0; n < 2; ++n) _Pragma("unroll") for (int k = 0; k < 2; ++k) \
        acc[ai][bj][m][n] = __builtin_amdgcn_mfma_f32_16x16x32_bf16(Bt[n][k], At[m][k], acc[ai][bj][m][n], 0, 0, 0); __builtin_amdgcn_s_setprio(0); } while (0)
#define PG8_WAIT_V(n) asm volatile("s_waitcnt vmcnt(" #n ")" ::: "memory")
#define PG8_WAIT_L(n) asm volatile("s_waitcnt lgkmcnt(" #n ")" ::: "memory")
#define PG8_BAR __builtin_amdgcn_s_barrier()
#define PG8_SCHED __builtin_amdgcn_sched_barrier(0)
    Unit cur, nxt; int ui = 0;
    if (!S.next(0, cur)) return;
    f32x4 acc[2][2][4][2];
#pragma unroll
    for (int a = 0; a < 2; ++a)
#pragma unroll
        for (int b = 0; b < 2; ++b)
#pragma unroll
            for (int m = 0; m < 4; ++m)
#pragma unroll
                for (int n = 0; n < 2; ++n) acc[a][b][m][n] = (f32x4){0.f, 0.f, 0.f, 0.f};
    bf16x8 At[4][2], B0[2][2], B1[2][2];
    const char* cA = (const char*)g.A + (size_t)cur.pm * tstep; const char* cB = (const char*)g.Bt + (size_t)cur.pn * tstep;
    S.a_ready(cur);
    if constexpr (SP2) {
        PG8_STAGE(PG8_SB(0, 0), cB, voffB); PG8_STAGE(PG8_SB(0, 1), cB + hstep, voffB); PG8_STAGE(PG8_SA(0, 0), cA, voffA); PG8_STAGE(PG8_SA(0, 1), cA + hstep, voffA);
        if (wr == 1) PG8_BAR;
        PG8_WAIT_V(2); PG8_BAR;
        PG8_STAGE(PG8_SB(1, 0), cB + kstep, voffB); PG8_STAGE(PG8_SA(1, 0), cA + kstep, voffA); PG8_STAGE(PG8_SB(1, 1), cB + hstep + kstep, voffB);
        PG8_WAIT_V(6); PG8_BAR;
    } else {
        PG8_STAGE(PG8_SB(0, 0), cB, voffB); PG8_STAGE(PG8_SA(0, 0), cA, voffA); PG8_STAGE(PG8_SB(0, 1), cB + hstep, voffB); PG8_STAGE(PG8_SA(0, 1), cA + hstep, voffA);
        if (wr == 1) PG8_BAR;
        PG8_WAIT_V(4); PG8_BAR;
        PG8_STAGE(PG8_SB(1, 0), cB + kstep, voffB); PG8_STAGE(PG8_SA(1, 0), cA + kstep, voffA); PG8_STAGE(PG8_SB(1, 1), cB + hstep + kstep, voffB);
        PG8_WAIT_V(6); PG8_BAR;
    }
    for (;;) {
        const bool has_next = S.next(ui + 1, nxt);
        const char* nA = has_next ? (const char*)g.A + (size_t)nxt.pm * tstep : cA; const char* nB = has_next ? (const char*)g.Bt + (size_t)nxt.pn * tstep : cB;
        for (int t = 0; t < nt; t += 2) {
            const bool last = (t == nt - 2);
            const char* a1 = cA + (size_t)(t + 1) * kstep;
            const char* a2 = last ? nA : cA + (size_t)(t + 2) * kstep; const char* b2 = last ? nB : cB + (size_t)(t + 2) * kstep;
            const char* a3 = a2 + kstep; const char* b3 = b2 + kstep;
            if (last && has_next) S.a_ready(nxt);
            if constexpr (SP2) {
            PG8_LDB(B0, 0, 0); PG8_LDB(B1, 0, 1); PG8_SCHED; PG8_LDA(At, 0, 0); PG8_STAGE(PG8_SA(1, 1), a1 + hstep, voffA);
            PG8_WAIT_V(8); PG8_WAIT_L(0); PG8_BAR; PG8_MMA(0, 0, At, B0); PG8_MMA(0, 1, At, B1); PG8_BAR; PG8_SCHED;
            PG8_LDA(At, 0, 1); PG8_STAGE(PG8_SB(0, 0), b2, voffB); PG8_STAGE(PG8_SB(0, 1), b2 + hstep, voffB); PG8_STAGE(PG8_SA(0, 0), a2, voffA);
            PG8_WAIT_V(8); PG8_WAIT_L(0); PG8_BAR; PG8_MMA(1, 0, At, B0); PG8_MMA(1, 1, At, B1); PG8_BAR; PG8_SCHED;
            PG8_LDB(B0, 1, 0); PG8_LDB(B1, 1, 1); PG8_SCHED; PG8_LDA(At, 1, 0); PG8_STAGE(PG8_SA(0, 1), a2 + hstep, voffA);
            PG8_WAIT_V(8); PG8_WAIT_L(0); PG8_BAR; PG8_MMA(0, 0, At, B0); PG8_MMA(0, 1, At, B1); PG8_BAR; PG8_SCHED;
            PG8_LDA(At, 1, 1); PG8_STAGE(PG8_SB(1, 0), b3, voffB); PG8_STAGE(PG8_SB(1, 1), b3 + hstep, voffB); PG8_STAGE(PG8_SA(1, 0), a3, voffA);
            PG8_WAIT_V(8); PG8_WAIT_L(0); PG8_BAR; PG8_MMA(1, 0, At, B0); PG8_MMA(1, 1, At, B1); PG8_BAR; PG8_SCHED;
            } else {
            PG8_LDB(B0, 0, 0); PG8_SCHED; PG8_LDA(At, 0, 0); PG8_STAGE(PG8_SA(1, 1), a1 + hstep, voffA);
            PG8_WAIT_L(8); PG8_BAR; PG8_WAIT_L(0); PG8_MMA(0, 0, At, B0); PG8_BAR; PG8_SCHED;
            PG8_LDB(B1, 0, 1); PG8_STAGE(PG8_SB(0, 0), b2, voffB);
            PG8_BAR; PG8_WAIT_L(0); PG8_MMA(0, 1, At, B1); PG8_BAR;
            PG8_LDA(At, 0, 1); PG8_STAGE(PG8_SA(0, 0), a2, voffA);
            PG8_BAR; PG8_WAIT_L(0); PG8_MMA(1, 0, At, B0); PG8_BAR; PG8_SCHED;
            PG8_STAGE(PG8_SB(0, 1), b2 + hstep, voffB);
            PG8_WAIT_V(6); PG8_BAR; PG8_MMA(1, 1, At, B1); PG8_BAR;
            PG8_LDB(B0, 1, 0); PG8_SCHED; PG8_LDA(At, 1, 0); PG8_STAGE(PG8_SA(0, 1), a2 + hstep, voffA);
            PG8_WAIT_L(8); PG8_BAR; PG8_WAIT_L(0); PG8_MMA(0, 0, At, B0); PG8_BAR; PG8_SCHED;
            PG8_LDB(B1, 1, 1); PG8_STAGE(PG8_SB(1, 0), b3, voffB);
            PG8_BAR; PG8_WAIT_L(0); PG8_MMA(0, 1, At, B1); PG8_BAR;
            PG8_LDA(At, 1, 1); PG8_STAGE(PG8_SA(1, 0), a3, voffA);
            PG8_BAR; PG8_WAIT_L(0); PG8_MMA(1, 0, At, B0); PG8_BAR; PG8_SCHED;
            PG8_STAGE(PG8_SB(1, 1), b3 + hstep, voffB);
            PG8_WAIT_V(6); PG8_BAR; PG8_MMA(1, 1, At, B1); PG8_BAR;
            }
        }
        if constexpr (ALIGN_EPI) { if (wr == 0) PG8_BAR; }
        if constexpr (!Epi::AFTER_DRAIN) { PG8_EPI_T0; E(acc, cur, wr, wc, fr, fq); S.done(cur); PG8_EPI_T1; }
        if (!has_next) break;
#pragma unroll
        for (int a = 0; a < 2; ++a)
#pragma unroll
            for (int b = 0; b < 2; ++b)
#pragma unroll
                for (int m = 0; m < 4; ++m)
#pragma unroll
                    for (int n = 0; n < 2; ++n) acc[a][b][m][n] = (f32x4){0.f, 0.f, 0.f, 0.f};
        cur = nxt; cA = nA; cB = nB; ++ui;
        if constexpr (ALIGN_EPI) { if (wr == 1) PG8_BAR; }
    }
    PG8_WAIT_V(0);
    if constexpr (!ALIGN_EPI) { if (wr == 0) PG8_BAR; }
    PG8_BAR;
    if constexpr (Epi::AFTER_DRAIN) { E.fused(acc, cur, wr, wc, fr, fq, lds, wid, lane); S.done(cur); }
#undef PG8_SA
#undef PG8_SB
#undef PG8_STAGE
#undef PG8_LDA
#undef PG8_LDB
#undef PG8_MMA
#undef PG8_WAIT_V
#undef PG8_WAIT_L
#undef PG8_BAR
#undef PG8_SCHED
}

}

constexpr size_t MiB = 1u << 20;
constexpr size_t WS_CTL = 0;
constexpr size_t WS_ROPE = 1 * MiB;
constexpr size_t WS_LW2 = 3 * MiB, WS_LA2 = 4 * MiB, WS_LG2 = 5 * MiB;
constexpr size_t WS_BONUS = 6 * MiB;
constexpr size_t ZERO_BYTES = 8 * MiB;
constexpr size_t SCF = (size_t)LTOK * RC * 4, SCB = (size_t)LTOK * RC * 2;
constexpr size_t WS_H = 8 * MiB, WS_WIN = WS_H + (size_t)MPAD * DM * 2;
constexpr size_t WS_KD0 = 8 * MiB, WS_KD1 = WS_KD0 + SCB, WS_B0 = WS_KD1 + SCB, WS_B1 = WS_B0 + SCB, WS_KK = WS_B1 + SCB, WS_RR = WS_KK + SCB;
constexpr size_t WS_WGU = 8 * MiB;
constexpr size_t WS_G = 216 * MiB, WS_A2 = 216 * MiB;
constexpr size_t WS_Q = 344 * MiB, WS_K = 376 * MiB, WS_VT = 385 * MiB, WS_U = 394 * MiB;
constexpr size_t WS_P1 = 344 * MiB;
constexpr size_t WS_Y = 394 * MiB;
constexpr size_t WS_W0 = 506 * MiB, WS_W1 = WS_W0 + SCF;
constexpr size_t WS_WPA = 506 * MiB, WS_WPR = 522 * MiB, WS_WOUT = 538 * MiB, WS_OATT = 570 * MiB;
constexpr size_t WS_VV = 635 * MiB, WS_GG = 668 * MiB;
constexpr size_t WS_BO = 701 * MiB;
constexpr size_t WS_HID = 701 * MiB, WS_MX = 873 * MiB;
constexpr int NB0 = 513, NB1 = 512, NBT = NB0 + NB1;
constexpr int BO_FA = 0, BO_FAA = 4096, BO_FT = 5120, BO_FBP = 5632, BO_FB = 6144, BO_FG = 10240, BO_ITEM = 10496;
constexpr size_t WS_WD = 1030 * MiB, WS_ORWKV = 182 * MiB, WS_END = 1116 * MiB;
static_assert(WS_WIN + (size_t)INWP * DM * 2 <= WS_G && WS_RR + SCB <= WS_G && WS_WGU + (size_t)2 * DFF * DM * 2 <= WS_G, "map: A0");
static_assert(WS_U + (size_t)MPAD * UPITCH * 2 <= WS_W0 && WS_VT + (size_t)KVW * MPAD * 2 <= WS_U && WS_K + (size_t)MPAD * KVW * 2 <= WS_VT && WS_Q + (size_t)SEQ * ATTW * 2 <= WS_K && WS_Y + 2 * SCB <= WS_W0, "map: P1 outputs");
static_assert(WS_W1 + SCF <= WS_VV && WS_OATT + (size_t)SEQ * ATTW * 2 <= WS_VV && WS_VV + SCB <= WS_GG && WS_GG + SCB <= WS_BO && WS_P1 + (size_t)SEQ * DM * 2 <= WS_W0, "map: mid");
static_assert(WS_BO + (size_t)RH * NBT * BO_ITEM <= WS_WD && WS_HID + (size_t)SEQ * DFF * 2 <= WS_MX && WS_MX + (size_t)SEQ * DM * 2 <= WS_WD && WS_WD + (size_t)DM * DFF * 2 <= WS_END && WS_WGU + (size_t)2 * DFF * DM * 2 <= WS_ORWKV && WS_ORWKV + (size_t)SEQ * RC * 2 <= WS_G, "map: tail");
constexpr int CW_BAR = 4096;
constexpr int CW_SS2 = 65536, CW_SS3 = 65536 + 8192;
static_assert((CW_SS3 + 8192) * 4 <= (int)(1 * MiB), "CTL");

constexpr int RING_BYTES = 131072;
constexpr int LDSCTL_OFF = RING_BYTES, MISC_OFF = LDSCTL_OFF + 320;
constexpr int LDS_BYTES = 147456;

#define GAS __attribute__((address_space(1)))
#define LAS __attribute__((address_space(3)))
typedef unsigned short bf16;
typedef unsigned v4u __attribute__((ext_vector_type(4)));
typedef unsigned v2u __attribute__((ext_vector_type(2)));
typedef float f32x4 __attribute__((ext_vector_type(4)));
typedef float f32x2 __attribute__((ext_vector_type(2)));
typedef float f32x16 __attribute__((ext_vector_type(16)));
typedef short bf16x8 __attribute__((ext_vector_type(8)));
typedef GAS unsigned gu32;
#define RLX_AGENT __ATOMIC_RELAXED, __HIP_MEMORY_SCOPE_AGENT
#define LDS_WAIT() asm volatile("s_waitcnt lgkmcnt(0)" ::: "memory")
__device__ __forceinline__ unsigned pk2(float lo, float hi) { return pg8::cvt_pk_bf16(lo, hi); }
__device__ __forceinline__ unsigned f2bf(float f) { return pg8::cvt_pk_bf16(f, 0.f) & 0xffffu; }
__device__ __forceinline__ float bf2f(bf16 b) { return __uint_as_float(((unsigned)b) << 16); }
using pg8::bflo; using pg8::bfhi; using pg8::sigmoidf_;

#define XB_TMO      128
#define XB_XCNT(j)  (256  + 64 * (j))
#define XB_XSUB(j)  (1280 + 64 * (j))
#define XB_XGEN(j)  (2304 + 64 * (j))
#define XB_TOP      3328
#define XB_TOPGEN   3392
#define XCD_BAR_WORDS 3456
#define XB_SPIN_CAP (1u << 18)

__device__ __forceinline__ unsigned xb_ld(unsigned* p)              { return __hip_atomic_load(p, __ATOMIC_RELAXED, __HIP_MEMORY_SCOPE_AGENT); }
__device__ __forceinline__ unsigned xb_add(unsigned* p, unsigned v) { return __hip_atomic_fetch_add(p, v, __ATOMIC_RELAXED, __HIP_MEMORY_SCOPE_AGENT); }
__device__ __forceinline__ unsigned xb_xcc_id() { return (unsigned)__builtin_amdgcn_s_getreg((3 << 11) | 20) & 0xFu; }
#define XB_SPIN(cond, bar) do { unsigned _sp = 0; while (cond) { __builtin_amdgcn_s_sleep(1); \
    if ((++_sp & 255u) == 0u) { if (xb_ld(&(bar)[XB_TMO])) break; if (_sp > XB_SPIN_CAP) { atomicAdd(&(bar)[XB_TMO], 1u); break; } } } } while (0)

struct XcdBarrier {
    unsigned* bar; unsigned x;
    volatile LAS unsigned* st;
};

__device__ __forceinline__ XcdBarrier xcd_barrier_post(unsigned* bar, volatile LAS unsigned* st) {
    XcdBarrier b; b.bar = bar; b.x = xb_xcc_id(); b.st = st;
    if (threadIdx.x == 0) (void)xb_add(&bar[XB_XCNT(b.x)], 1u);
    return b;
}
__device__ __forceinline__ void xcd_barrier_complete(unsigned* bar, unsigned x, unsigned& nloc, unsigned& nx) {
    const unsigned G = gridDim.x * gridDim.y * gridDim.z;
    unsigned sum, cnt, mine, sp = 0u;
    for (;;) {
        sum = 0u; cnt = 0u; mine = 0u;
#pragma unroll
        for (unsigned j = 0; j < 16; ++j) { const unsigned c = xb_ld(&bar[XB_XCNT(j)]); sum += c; cnt += (c > 0u) ? 1u : 0u; mine = (j == x) ? c : mine; }
        if (sum == G) break;
        __builtin_amdgcn_s_sleep(1);
        if ((++sp & 255u) == 0u) { if (xb_ld(&bar[XB_TMO])) break; if (sp > XB_SPIN_CAP) { atomicAdd(&bar[XB_TMO], 1u); break; } }
    }
    nloc = mine > 0u ? mine : 1u; nx = cnt > 0u ? cnt : 1u;
}

__device__ __forceinline__ void xcd_barrier(const XcdBarrier& b) {
    asm volatile("s_waitcnt vmcnt(0)" ::: "memory");
    __syncthreads();
    if (threadIdx.x == 0) {
        unsigned* bar = b.bar;
        __builtin_amdgcn_s_waitcnt(0);
        unsigned nloc = b.st[0], nx = b.st[1];
        if (nloc == 0u) { xcd_barrier_complete(bar, b.x, nloc, nx); b.st[0] = nloc; b.st[1] = nx; }
        const unsigned old = xb_add(&bar[XB_XSUB(b.x)], 1u);
        const unsigned gen = old / nloc;
        if (old + 1u == (gen + 1u) * nloc) {
            __builtin_amdgcn_fence(__ATOMIC_RELEASE, "agent");
            asm volatile("s_waitcnt vmcnt(0)" ::: "memory");
            const unsigned og = xb_add(&bar[XB_TOP], 1u);
            const unsigned tg = og / nx;
            if (og + 1u == (tg + 1u) * nx) xb_add(&bar[XB_TOPGEN], 1u);
            else XB_SPIN(xb_ld(&bar[XB_TOPGEN]) == tg, bar);
            __builtin_amdgcn_fence(__ATOMIC_ACQUIRE, "agent");
            xb_add(&bar[XB_XGEN(b.x)], 1u);
            asm volatile("s_waitcnt vmcnt(0)" ::: "memory");
        } else {
            XB_SPIN(xb_ld(&bar[XB_XGEN(b.x)]) == gen, bar);
            __builtin_amdgcn_fence(__ATOMIC_ACQUIRE, "agent");
            asm volatile("s_waitcnt vmcnt(0)" ::: "memory");
        }
    }
    __syncthreads();
}


struct Frame {
    LAS unsigned char* lds;
    volatile LAS unsigned* MISC;
    gu32* ctl;
    int tid, lane, wave, G;
    unsigned char* ws;
    const float* in[26];
    float* out;
    unsigned long long pb0, pacc, pacc2;
};
#define FPB0(k) do { if ((PROBE_PHASE >> (k)) & 1) F.pb0 = __builtin_amdgcn_s_memrealtime(); } while (0)
#define FPB1(k) do { if ((PROBE_PHASE >> (k)) & 1) F.pacc += __builtin_amdgcn_s_memrealtime() - F.pb0; } while (0)
__device__ __forceinline__ float wave_sum(float v) {
#pragma unroll
    for (int o = 1; o < 64; o <<= 1) v += __shfl_xor(v, o);
    return v;
}

template <int KR> __device__ __forceinline__ void tr_issue(const float* W, int N, int item, int lane, float (&wv)[KR / 2]) {
    const int nblk = N / 32, kb = item / nblk, nb = item % nblk, k0 = KR * kb, n0 = 32 * nb;
#pragma unroll
    for (int i = 0; i < KR / 2; ++i) wv[i] = W[(size_t)(k0 + 2 * i + (lane >> 5)) * N + n0 + (lane & 31)];
}
template <int KR> __device__ __forceinline__ void tr_finish(bf16* WT, int K, int N, const float* kscale, int mode, int item, LAS float* scr, int lane, const float (&wv)[KR / 2]) {
    const int nblk = N / 32, kb = item / nblk, nb = item % nblk, k0 = KR * kb, n0 = 32 * nb;
#pragma unroll
    for (int i = 0; i < KR / 2; ++i) { const int kk = 2 * i + (lane >> 5); float v = wv[i]; if (kscale) v *= kscale[k0 + kk]; scr[kk * 33 + (lane & 31)] = v; }
    LDS_WAIT(); asm volatile("" ::: "memory");
    constexpr int CH = KR / 8;
    const int c = lane & (CH - 1);
#pragma unroll
    for (int jj = 0; jj < CH / 2; ++jj) { const int n = (lane / CH) + (64 / CH) * jj; const LAS float* s = scr + (8 * c) * 33 + n;
        v4u o; o.x = pk2(s[0 * 33], s[1 * 33]); o.y = pk2(s[2 * 33], s[3 * 33]); o.z = pk2(s[4 * 33], s[5 * 33]); o.w = pk2(s[6 * 33], s[7 * 33]);
        const int nn = n0 + n; const int dr = (mode == 0) ? nn : (256 * (nn >> 7) + (nn & 127) + (mode == 2 ? 128 : 0));
        *(GAS v4u*)(WT + (size_t)dr * K + k0 + 8 * c) = o; }
    LDS_WAIT(); asm volatile("" ::: "memory");
}
#define CONV_P4(it, CALL) do { constexpr int I_GU_ = (DM / 64) * (DFF / 32), I_P_ = (ATTW / 64) * (DM / 32); int r_ = (it); \
        if (r_ < I_GU_) { CALL(F.in[22], (bf16*)(F.ws + WS_WGU), DM, DFF, F.in[21], 1, r_); } \
        else if ((r_ -= I_GU_) < I_GU_) { CALL(F.in[23], (bf16*)(F.ws + WS_WGU), DM, DFF, F.in[21], 2, r_); } \
        else if ((r_ -= I_GU_) < I_P_) { CALL(F.in[18], (bf16*)(F.ws + WS_WPA), ATTW, DM, (const float*)nullptr, 0, r_); } \
        else if ((r_ -= I_P_) < I_P_) { CALL(F.in[19], (bf16*)(F.ws + WS_WPR), RC, DM, (const float*)nullptr, 0, r_); } \
        else { r_ -= I_P_; CALL(F.in[20], (bf16*)(F.ws + WS_WOUT), DM, DM, (const float*)nullptr, 0, r_); } } while (0)
constexpr int N_P4_ITEMS = 2 * (DM / 64) * (DFF / 32) + 2 * (ATTW / 64) * (DM / 32) + (DM / 64) * (DM / 32);
constexpr int N_WD_ITEMS = (DFF / 64) * (DM / 32);
constexpr int N_WD_HALF_ITEMS = (DFF / 32) * (DM / 32);
__device__ __forceinline__ void convert_seg(Frame& F, LAS float* scr, int first, int stride, int limit) {
    int it = first; if (it >= limit) return;
    float w0[32], w1[32];
#define CVI0(W_, WT_, K_, N_, ks_, md_, item_) tr_issue<64>(W_, N_, item_, F.lane, w0)
#define CVI1(W_, WT_, K_, N_, ks_, md_, item_) tr_issue<64>(W_, N_, item_, F.lane, w1)
#define CVI2(W_, WT_, K_, N_, ks_, md_, item_) tr_issue<64>(W_, N_, item_, F.lane, w2)
#define CVF(W_, WT_, K_, N_, ks_, md_, item_) tr_finish<64>(WT_, K_, N_, ks_, md_, item_, scr, F.lane, w0)
    CONV_P4(it, CVI0);
    if (it + stride < limit) CONV_P4(it + stride, CVI1);
    for (;;) { const int it2 = it + 2 * stride; float w2[32];
        if (it2 < limit) CONV_P4(it2, CVI2);
        CONV_P4(it, CVF);
        it += stride; if (it >= limit) break;
#pragma unroll
        for (int i = 0; i < 32; ++i) { w0[i] = w1[i]; w1[i] = w2[i]; } }
#undef CVI0
#undef CVI1
#undef CVI2
#undef CVF
}
__device__ __forceinline__ void convert_p4(Frame& F, LAS float* scr, int widx, int NWK, int pidx, int NPL) {
    (void)widx; (void)NWK;
    if (pidx >= 0) convert_seg(F, scr, pidx, NPL, N_P4_ITEMS);
}
__device__ __forceinline__ void convert_one(Frame& F, LAS float* scr, const float* W, bf16* WT, int K, int N, int nitems, int first, int stride) {
    int it = first; if (it >= nitems) return;
    float w0[32], w1[32];
    tr_issue<64>(W, N, it, F.lane, w0);
    if (it + stride < nitems) tr_issue<64>(W, N, it + stride, F.lane, w1);
    for (;;) { const int it2 = it + 2 * stride; float w2[32];
        if (it2 < nitems) tr_issue<64>(W, N, it2, F.lane, w2);
        tr_finish<64>(WT, K, N, nullptr, 0, it, scr, F.lane, w0);
        it += stride; if (it >= nitems) break;
#pragma unroll
        for (int i = 0; i < 32; ++i) { w0[i] = w1[i]; w1[i] = w2[i]; } }
}
__device__ __forceinline__ void convert_wd(Frame& F, LAS float* scr, int first, int stride) { convert_one(F, scr, F.in[24], (bf16*)(F.ws + WS_WD), DFF, DM, N_WD_ITEMS, first, stride); }
__device__ __forceinline__ void rms_row_to_bf16(int lane, const float* xrow, const float* w, bf16* orow) {
    const GAS f32x4* xr = (const GAS f32x4*)xrow + lane;
    f32x4 v[16]; float s = 0.f;
#pragma unroll
    for (int j = 0; j < 16; ++j) { v[j] = xr[64 * j]; s += (v[j].x * v[j].x + v[j].y * v[j].y) + (v[j].z * v[j].z + v[j].w * v[j].w); }
    const float rstd = 1.f / sqrtf(wave_sum(s) * (1.f / DM) + RMS_EPS);
    const GAS f32x4* wr = (const GAS f32x4*)w + lane;
    GAS v2u* o8 = (GAS v2u*)orow + lane;
#pragma unroll
    for (int j = 0; j < 16; ++j) { const f32x4 ww = wr[64 * j]; v2u o; o.x = pk2(v[j].x * rstd * ww.x, v[j].y * rstd * ww.y); o.y = pk2(v[j].z * rstd * ww.z, v[j].w * rstd * ww.w); o8[64 * j] = o; }
}
__device__ const double ROPE_INV[16] = {
    1.0000000000000000000000000e+0,
    4.4036660267178047359198331e-1,
    1.9392274474868577334259386e-1,
    8.5397100285765611280149662e-2,
    3.7606030930863935681246092e-2,
    1.6560440080994445548947445e-2,
    7.2926647372171090477661219e-3,
    3.2114459947525910185434889e-3,
    1.4142135623730950488016887e-3,
    6.2277242191459597955502746e-4,
    2.7424817567620731825332265e-4,
    1.2076973741146503832424826e-4,
    5.3182958969449886162502429e-5,
    2.3419998961409341542188076e-5,
    1.0313385377212458859810127e-5,
    4.5416704806078696531998012e-6
};

__device__ __forceinline__ void p0_prologue(Frame& F) {
    LAS float* scr = (LAS float*)(F.lds + F.wave * 16384);
    const int gw = blockIdx.x * 8 + F.wave, NGW = F.G * 8;
    bf16* Wint = (bf16*)(F.ws + WS_WIN); bf16* H = (bf16*)(F.ws + WS_H);
    convert_one(F, scr, F.in[3], Wint, DM, INW, (DM / 64) * (INW / 32), gw, NGW);
    for (int m = gw; m < MPAD + (INWP - INW); m += NGW) {
        if (m < SEQ) rms_row_to_bf16(F.lane, F.in[0] + (size_t)m * DM, F.in[2], H + (size_t)m * DM);
        else if (m < LTOK) rms_row_to_bf16(F.lane, F.in[1] + (size_t)(m - SEQ) * DM, F.in[2], H + (size_t)m * DM);
        else { bf16* row = (m < MPAD) ? H + (size_t)m * DM : Wint + (size_t)(INW + (m - MPAD)) * DM; GAS v4u* o = (GAS v4u*)row + F.lane;
#pragma unroll
            for (int j = 0; j < 8; ++j) o[64 * j] = (v4u){0u, 0u, 0u, 0u}; }
    }
    const int gt = blockIdx.x * 512 + F.tid, NGT = F.G * 512;
    float* rope = (float*)(F.ws + WS_ROPE);
    for (int i = gt; i < LTOK * 16; i += NGT) { const int pos = i >> 4, k = i & 15;
        const double ang = (double)pos * ROPE_INV[k]; const double kq = __builtin_rint(ang * 0.15915494309189535);
        const double red = (ang - kq * 6.28318530717958623) - kq * 2.4492935982947064e-16; const float rf = (float)red;
        rope[2 * i] = cosf(rf); rope[2 * i + 1] = sinf(rf); }
    { bf16* w2t = (bf16*)(F.ws + WS_LW2); bf16* a2t = (bf16*)(F.ws + WS_LA2); bf16* g2t = (bf16*)(F.ws + WS_LG2);
      constexpr int I_L = 3 * (RC / 32), I_G = 8 * (RC / 32);
      for (int it = gw; it < 4 * I_L + I_G; it += NGW) { float wv[16];
          if (it < 4 * I_L) { const int mtx = it / I_L, r = it % I_L, dd = mtx & 1; const float* W = (mtx < 2 ? F.in[8] : F.in[10]) + (size_t)dd * 96 * RC; bf16* WT = (mtx < 2 ? w2t : a2t) + (size_t)dd * RC * 96;
              tr_issue<32>(W, RC, r, F.lane, wv); tr_finish<32>(WT, 96, RC, nullptr, 0, r, scr, F.lane, wv); }
          else { const int r = it - 4 * I_L; tr_issue<32>(F.in[11], RC, r, F.lane, wv); tr_finish<32>(g2t, 256, RC, nullptr, 0, r, scr, F.lane, wv); } } }
}

__device__ __forceinline__ int crow(int r, int hi) { return (r & 3) + 8 * (r >> 2) + 4 * hi; }
__device__ __forceinline__ void attn_phase(Frame& F, const int gw, const int NGW) {
    const bf16* Q = (const bf16*)(F.ws + WS_Q); const bf16* K = (const bf16*)(F.ws + WS_K); const bf16* Vt = (const bf16*)(F.ws + WS_VT); bf16* OA = (bf16*)(F.ws + WS_OATT);
    const float* sink = F.in[17];
    const int hh = F.lane >> 5, r = F.lane & 31;
    constexpr float SC = 0.08838834764831845f * 1.4426950408889634f, L2E = 1.4426950408889634f;
    for (int item = gw; item < 4096; item += NGW) {
        const int sub = item & 3, hq = (item >> 2) & 15, qb = item >> 6, q0 = qb * 128 + sub * 32, hk = hq >> 2;
        bf16x8 bq[8];
        { const bf16* qp = Q + (size_t)(q0 + r) * ATTW + hq * 128 + 8 * hh;
#pragma unroll
          for (int s = 0; s < 8; ++s) bq[s] = *(const bf16x8*)(qp + 16 * s); }
        f32x16 O[4];
#pragma unroll
        for (int dt = 0; dt < 4; ++dt)
#pragma unroll
            for (int i = 0; i < 16; ++i) O[dt][i] = 0.f;
        float m = sink[hq] * L2E, l = (hh == 0) ? 1.f : 0.f;
        const int tlo = (q0 >= 128) ? 0 : 4 - q0 / 32, thi = (q0 + 128 + 32 <= SEQ) ? 8 : 4 + (SEQ - 32 - q0) / 32;
        int ti = tlo;
        bf16x8 ak[8];
        { const int key0 = q0 + 32 * (ti - 4); const bf16* kp = K + (size_t)(key0 + r) * KVW + hk * 128 + 8 * hh;
#pragma unroll
          for (int s = 0; s < 8; ++s) ak[s] = *(const bf16x8*)(kp + 16 * s); }
        for (;;) {
            const bool meta = (ti == 9);
            const int key0 = meta ? SEQ : q0 + 32 * (ti - 4);
            const int tn = (ti < thi) ? ti + 1 : 9; const int keyn = (tn == 9) ? SEQ : q0 + 32 * (tn - 4);
            v2u av[4][2][2]; bf16x8 akn[8];
#pragma unroll
            for (int dt = 0; dt < 4; ++dt) { const bf16* vp = Vt + (size_t)(hk * 128 + 32 * dt + r) * MPAD + key0 + 4 * hh;
#pragma unroll
                for (int s2 = 0; s2 < 2; ++s2) { av[dt][s2][0] = *(const v2u*)(vp + 16 * s2); av[dt][s2][1] = *(const v2u*)(vp + 16 * s2 + 8); } }
            { const bf16* kp = K + (size_t)(keyn + r) * KVW + hk * 128 + 8 * hh;
#pragma unroll
              for (int s = 0; s < 8; ++s) akn[s] = *(const bf16x8*)(kp + 16 * s); }
            f32x16 st;
#pragma unroll
            for (int i = 0; i < 16; ++i) st[i] = 0.f;
#pragma unroll
            for (int s = 0; s < 8; ++s) st = __builtin_amdgcn_mfma_f32_32x32x16_bf16(ak[s], bq[s], st, 0, 0, 0);
            float tmax = -__builtin_inff();
#pragma unroll
            for (int i = 0; i < 16; ++i) { const int kr = crow(i, hh); bool ok;
                if (meta) ok = kr < NMETA; else { const int dlt = (key0 + kr) - (q0 + r); ok = (dlt >= -128) && (dlt <= 128); }
                const float t = ok ? st[i] * SC : -__builtin_inff(); st[i] = t; tmax = fmaxf(tmax, t); }
            tmax = fmaxf(tmax, __shfl_xor(tmax, 32));
            const float mn = fmaxf(m, tmax), alpha = __builtin_amdgcn_exp2f(m - mn); m = mn;
            float ps = 0.f;
#pragma unroll
            for (int i = 0; i < 16; ++i) { const float p = __builtin_amdgcn_exp2f(st[i] - mn); st[i] = p; ps += p; }
            l = l * alpha + ps;
#pragma unroll
            for (int dt = 0; dt < 4; ++dt)
#pragma unroll
                for (int i = 0; i < 16; ++i) O[dt][i] *= alpha;
            bf16x8 pb[2];
#pragma unroll
            for (int s2 = 0; s2 < 2; ++s2) { v4u w; w.x = pg8::cvt_pk_bf16(st[8 * s2 + 0], st[8 * s2 + 1]); w.y = pg8::cvt_pk_bf16(st[8 * s2 + 2], st[8 * s2 + 3]);
                w.z = pg8::cvt_pk_bf16(st[8 * s2 + 4], st[8 * s2 + 5]); w.w = pg8::cvt_pk_bf16(st[8 * s2 + 6], st[8 * s2 + 7]); pb[s2] = __builtin_bit_cast(bf16x8, w); }
#pragma unroll
            for (int dt = 0; dt < 4; ++dt)
#pragma unroll
                for (int s2 = 0; s2 < 2; ++s2) { const v4u w = {av[dt][s2][0].x, av[dt][s2][0].y, av[dt][s2][1].x, av[dt][s2][1].y};
                    O[dt] = __builtin_amdgcn_mfma_f32_32x32x16_bf16(__builtin_bit_cast(bf16x8, w), pb[s2], O[dt], 0, 0, 0); }
            if (meta) break;
            ti = tn;
#pragma unroll
            for (int s = 0; s < 8; ++s) ak[s] = akn[s];
        }
        l += __shfl_xor(l, 32);
        const float inv = 1.0f / l;
        bf16* op = OA + (size_t)(q0 + r) * ATTW + hq * 128 + 4 * hh;
#pragma unroll
        for (int dt = 0; dt < 4; ++dt)
#pragma unroll
            for (int g4 = 0; g4 < 4; ++g4) { v2u w; w.x = pg8::cvt_pk_bf16(O[dt][4 * g4 + 0] * inv, O[dt][4 * g4 + 1] * inv); w.y = pg8::cvt_pk_bf16(O[dt][4 * g4 + 2] * inv, O[dt][4 * g4 + 3] * inv);
                *(v2u*)(op + 32 * dt + 8 * g4) = w; }
    }
}

__device__ __forceinline__ int blk_tok(int d, int blk, int u) { return d ? (LTOK - 1 - 16 * blk - u) : (16 * blk + u); }
__device__ __forceinline__ size_t bo_item(int hd, int d, int blk) { return (size_t)(hd * NBT + (d ? NB0 : 0) + blk) * BO_ITEM; }
__device__ __forceinline__ v4u pack8(const float (&x)[8]) { v4u o; o.x = pk2(x[0], x[1]); o.y = pk2(x[2], x[3]); o.z = pk2(x[4], x[5]); o.w = pk2(x[6], x[7]); return o; }
__device__ __forceinline__ void blockprep_item(Frame& F, LAS unsigned char* wl, const int hd, const int d, const int blk, const int j) {
    constexpr int LP = 72;
    LAS bf16* LT = (LAS bf16*)wl; LAS float* GM = (LAS float*)wl;
    const float* Wd = (const float*)(F.ws + (d ? WS_W1 : WS_W0)); const bf16* KDd = (const bf16*)(F.ws + (d ? WS_KD1 : WS_KD0)); const bf16* Bd = (const bf16*)(F.ws + (d ? WS_B1 : WS_B0));
    const bf16* KK = (const bf16*)(F.ws + WS_KK); const bf16* RR = (const bf16*)(F.ws + WS_RR);
    float* BON = (float*)(F.ws + WS_BONUS); unsigned char* BO = F.ws + WS_BO;
    const int hh = j >> 5, r31 = j & 31, c16 = j & 15, c = hd * 64 + j;
    struct Raw { float w[16]; unsigned short kd[16], b[16], kk[16], r[16]; } cur;
#pragma unroll
    for (int u = 0; u < 16; ++u) { const size_t o = (size_t)blk_tok(d, blk, u) * RC + c; cur.w[u] = Wd[o]; cur.kd[u] = KDd[o]; cur.b[u] = Bd[o]; cur.kk[u] = KK[o]; cur.r[u] = RR[o]; }
    float kt[16], rt[16], kdh[16], bh[16]; float G15;
    { float G[16];
      { float g = 1.f;
#pragma unroll
        for (int u = 0; u < 16; ++u) { g *= cur.w[u]; G[u] = g; } }
      const float rkw = F.in[14][c];
      float bsum = 0.f;
#pragma unroll
      for (int u = 0; u < 16; ++u) { kdh[u] = bf2f(cur.kd[u]); rt[u] = bf2f(cur.r[u]); const float s = wave_sum(rt[u] * kdh[u] * rkw); bsum = (j == u) ? s : bsum;
          kdh[u] = kdh[u] / G[u]; rt[u] = rt[u] * G[u]; LT[(0 * 16 + u) * LP + j] = (bf16)f2bf(kdh[u]); LT[(3 * 16 + u) * LP + j] = (bf16)f2bf(rt[u]); }
      if (j < 16) atomicAdd(BON + (size_t)blk_tok(d, blk, j) * RH + hd, bsum);
#pragma unroll
      for (int u = 0; u < 16; ++u) { kt[u] = bf2f(cur.kk[u]) * (u ? G[u - 1] : 1.f); bh[u] = bf2f(cur.b[u]) / G[u]; LT[(2 * 16 + u) * LP + j] = (bf16)f2bf(kt[u]); LT[(1 * 16 + u) * LP + j] = (bf16)f2bf(bh[u]); }
      G15 = G[15]; }
    asm volatile("" ::: "memory");
    f32x16 gacc;
#pragma unroll
    for (int i = 0; i < 16; ++i) gacc[i] = 0.f;
    { const LAS bf16* ap = LT + ((r31 < 16 ? 0 : 1) * 16 + (r31 & 15)) * LP + 8 * hh; const LAS bf16* bp = LT + ((r31 < 16 ? 2 : 3) * 16 + (r31 & 15)) * LP + 8 * hh;
#pragma unroll
      for (int s = 0; s < 4; ++s) gacc = __builtin_amdgcn_mfma_f32_32x32x16_bf16(*(const LAS bf16x8*)(ap + 16 * s), *(const LAS bf16x8*)(bp + 16 * s), gacc, 0, 0, 0); }
    float ga[16];
#pragma unroll
    for (int i = 0; i < 16; ++i) ga[i] = gacc[i];
    asm volatile("s_waitcnt lgkmcnt(0)" ::: "memory");
#pragma unroll
    for (int i = 0; i < 16; ++i) { const int row = crow(i, hh), m = row & 15, u = r31 & 15; const bool strict = (r31 < 16);
        GM[row * 32 + r31] = (strict ? (m < u) : (m <= u)) ? ga[i] : 0.f; }
#define RL(x, ln) __builtin_bit_cast(float, __builtin_amdgcn_readlane(__builtin_bit_cast(int, (x)), (ln)))
#define GREG(m) (4 * ((m) >> 3) + ((m) & 3))
#define GLN(m) (32 * (((m) >> 2) & 1))
#define B_(m, u)  RL(ga[8 + GREG(m)], (u) + GLN(m))
    float Tr[16];
#pragma unroll
    for (int m = 15; m >= 0; --m) { float s = (c16 == m) ? 1.f : 0.f;
#pragma unroll
        for (int u = m + 1; u < 16; ++u) s -= B_(m, u) * Tr[u];
        Tr[m] = s; }
#undef RL
#undef GREG
#undef GLN
#undef B_
    unsigned char* base = BO + bo_item(hd, d, blk);
    { const int a = j >> 5, jp = j & 31;
#pragma unroll
      for (int h2 = 0; h2 < 2; ++h2) { float x0[8], x1[8];
#pragma unroll
          for (int e = 0; e < 8; ++e) { x0[e] = -bh[8 * (e >> 2) + 4 * h2 + (e & 3)] * G15; x1[e] = kdh[8 * h2 + e] * G15; }
          *(v4u*)(base + BO_FB + ((a * 2 + 0) * 64 + jp + 32 * h2) * 16) = pack8(x0); *(v4u*)(base + BO_FB + ((a * 2 + 1) * 64 + jp + 32 * h2) * 16) = pack8(x1); } }
    *(float*)(base + BO_FG + 4 * j) = G15;
    { float x[8];
#pragma unroll
      for (int e = 0; e < 8; ++e) x[e] = GM[(8 * hh + e) * 32 + r31];
      *(v4u*)(base + BO_FAA + j * 16) = pack8(x); }
    if (r31 < 16) { float x[8];
#pragma unroll
        for (int e = 0; e < 8; ++e) { const float t0 = Tr[8 * (e >> 2) + (e & 3)], t1 = Tr[8 * (e >> 2) + 4 + (e & 3)]; x[e] = hh ? t1 : t0; }
        *(v4u*)(base + BO_FT + (hh * 16 + r31) * 16) = pack8(x); }
    else { float x[8];
#pragma unroll
        for (int e = 0; e < 8; ++e) x[e] = -GM[(16 + 8 * (e >> 2) + 4 * hh + (e & 3)) * 32 + r31];
        *(v4u*)(base + BO_FBP + (hh * 16 + (r31 - 16)) * 16) = pack8(x); }
    asm volatile("s_waitcnt lgkmcnt(0)" ::: "memory");
#pragma unroll
    for (int u = 0; u < 16; ++u) { LT[u * LP + j] = (bf16)f2bf(kt[u]); LT[(16 + u) * LP + j] = (bf16)f2bf(rt[u]); }
#pragma unroll
    for (int ks = 0; ks < 4; ++ks) { const int j0 = 32 * (ks >> 1) + 16 * (ks & 1) + 4 * hh; const v2u lo = *(const LAS v2u*)(LT + r31 * LP + j0), hi = *(const LAS v2u*)(LT + r31 * LP + j0 + 8);
        *(v4u*)(base + BO_FA + (ks * 64 + j) * 16) = (v4u){lo.x, lo.y, hi.x, hi.y}; }
    asm volatile("" ::: "memory");
}

__device__ __forceinline__ int tok2row(int t) { return t < NMETA ? SEQ + t : t - NMETA; }
struct Sh8 { v4u uc, up, un; };
__device__ __forceinline__ Sh8 shift8_ld(const bf16* U, int t, int col) {
    const int tc = t < LTOK ? t : LTOK - 1, tp = (t >= 1 && t - 1 < LTOK) ? t - 1 : 0, tn = t + 1 < LTOK ? t + 1 : LTOK - 1;
    Sh8 s; s.uc = *(const v4u*)(U + (size_t)tok2row(tc) * UPITCH + col); s.up = *(const v4u*)(U + (size_t)tok2row(tp) * UPITCH + col); s.un = *(const v4u*)(U + (size_t)tok2row(tn) * UPITCH + col); return s; }
__device__ __forceinline__ void shift8_fin(const Sh8& s, int t, int col, const float* mu_p, const float* mu_n, float (&x)[8]) {
    const v4u zz = {0u, 0u, 0u, 0u};
    const v4u uc = t < LTOK ? s.uc : zz, up = (t >= 1 && t - 1 < LTOK) ? s.up : zz, un = t + 1 < LTOK ? s.un : zz;
    const f32x4 mp0 = *(const f32x4*)(mu_p + col), mp1 = *(const f32x4*)(mu_p + col + 4), mn0 = *(const f32x4*)(mu_n + col), mn1 = *(const f32x4*)(mu_n + col + 4);
    const unsigned ucw[4] = {uc.x, uc.y, uc.z, uc.w}, upw[4] = {up.x, up.y, up.z, up.w}, unw[4] = {un.x, un.y, un.z, un.w};
    const float mpw[8] = {mp0[0], mp0[1], mp0[2], mp0[3], mp1[0], mp1[1], mp1[2], mp1[3]}, mnw[8] = {mn0[0], mn0[1], mn0[2], mn0[3], mn1[0], mn1[1], mn1[2], mn1[3]};
#pragma unroll
    for (int e = 0; e < 8; ++e) { const float c0 = (e & 1) ? bfhi(ucw[e >> 1]) : bflo(ucw[e >> 1]), p0 = (e & 1) ? bfhi(upw[e >> 1]) : bflo(upw[e >> 1]), n0 = (e & 1) ? bfhi(unw[e >> 1]) : bflo(unw[e >> 1]);
        x[e] = c0 + mpw[e] * (p0 - c0) + mnw[e] * (n0 - c0); }
}
__device__ __forceinline__ void flush_bf16(const LAS bf16* tile, bf16* ARR, int t0, int cbase, int lane) {
#pragma unroll
    for (int h = 0; h < 2; ++h) { const int row = (lane >> 2) + 16 * h, ch = lane & 3; const v4u v = *(const LAS v4u*)(tile + row * 32 + 8 * ch);
        if (t0 + row < LTOK) *(v4u*)(ARR + (size_t)(t0 + row) * RC + cbase + 8 * ch) = v; }
}
__device__ __forceinline__ void flush_f32(const LAS float* tile, float* ARR, int t0, int cbase, int lane) {
#pragma unroll
    for (int h = 0; h < 4; ++h) { const int row = (lane >> 3) + 8 * h, ch = lane & 7; const f32x4 v = *(const LAS f32x4*)(tile + row * 32 + 4 * ch);
        if (t0 + row < LTOK) *(f32x4*)(ARR + (size_t)(t0 + row) * RC + cbase + 4 * ch) = v; }
}
__device__ __forceinline__ void prep_phase(Frame& F) {
    constexpr int XS = 648;
    LAS bf16* Xs = (LAS bf16*)F.lds;
    LAS unsigned char* wl = F.lds + 41472 + F.wave * 9216;
    LAS bf16* Kt = (LAS bf16*)wl;
    LAS bf16* Ot = Kt + 2048;
    const bf16* U = (const bf16*)(F.ws + WS_U);
    const float* mu_p = F.in[5]; const float* mu_n = F.in[6];
    const bf16* w2t = (const bf16*)(F.ws + WS_LW2); const bf16* a2t = (const bf16*)(F.ws + WS_LA2); const bf16* g2t = (const bf16*)(F.ws + WS_LG2);
    float* W0 = (float*)(F.ws + WS_W0); float* W1 = (float*)(F.ws + WS_W1);
    bf16* KD0 = (bf16*)(F.ws + WS_KD0); bf16* KD1 = (bf16*)(F.ws + WS_KD1); bf16* B0 = (bf16*)(F.ws + WS_B0); bf16* B1 = (bf16*)(F.ws + WS_B1);
    bf16* KK = (bf16*)(F.ws + WS_KK); bf16* RR = (bf16*)(F.ws + WS_RR); bf16* VV = (bf16*)(F.ws + WS_VV); bf16* GG = (bf16*)(F.ws + WS_GG);
    const int hh = F.lane >> 5, r = F.lane & 31;
    for (int unit = blockIdx.x; unit < 257 * 4; unit += F.G) {
        const int tt = unit >> 2, t0 = tt * 32, hd = (unit & 3) * 8 + F.wave;
        __syncthreads();
        FPB0(15);
        { Sh8 sx[5];
#pragma unroll
          for (int it = 0; it < 5; ++it) { const int ci = F.tid + 512 * it; sx[it] = shift8_ld(U, t0 + ci / 80, 3 * RC + 8 * (ci % 80)); }
#pragma unroll
          for (int it = 0; it < 5; ++it) { const int ci = F.tid + 512 * it, tl = ci / 80, ch = ci % 80;
            float x[8]; shift8_fin(sx[it], t0 + tl, 3 * RC + 8 * ch, mu_p, mu_n, x);
#pragma unroll
            for (int e = 0; e < 8; ++e) { float v = x[e];
                if (ch < 24) { const float ex = __expf(2.0f * v); v = 1.0f - 2.0f / (ex + 1.0f); }
                else if (ch >= 48) v = sigmoidf_(v);
                x[e] = v; }
            v4u o; o.x = pk2(x[0], x[1]); o.y = pk2(x[2], x[3]); o.z = pk2(x[4], x[5]); o.w = pk2(x[6], x[7]);
            *(LAS v4u*)(Xs + tl * XS + 8 * ch) = o; } }
        { const int c8 = hd * 64 + 8 * (F.lane & 7);
#pragma unroll
          for (int st = 0; st < 3; ++st) { const int col = (st == 0 ? RC : st == 1 ? 0 : 2 * RC) + c8; Sh8 sq[4];
#pragma unroll
            for (int q = 0; q < 4; ++q) sq[q] = shift8_ld(U, t0 + (F.lane >> 3) + 8 * q, col);
#pragma unroll
            for (int q = 0; q < 4; ++q) { const int tl = (F.lane >> 3) + 8 * q, tq = t0 + tl; float x[8]; shift8_fin(sq[q], tq, col, mu_p, mu_n, x);
                v4u o; o.x = pk2(x[0], x[1]); o.y = pk2(x[2], x[3]); o.z = pk2(x[4], x[5]); o.w = pk2(x[6], x[7]);
                if (st == 0) *(LAS v4u*)(Kt + tl * 64 + 8 * (F.lane & 7)) = o;
                else if (tq < LTOK) *(v4u*)((st == 1 ? RR : VV) + (size_t)tq * RC + c8) = o; } } }
        __syncthreads();
        FPB1(15); FPB0(16);
        float kp[2][16], ss[16];
#pragma unroll
        for (int i = 0; i < 16; ++i) ss[i] = 0.f;
#pragma unroll
        for (int ct = 0; ct < 2; ++ct) { const int c = hd * 64 + 32 * ct + r; const float kkw = F.in[12][c];
#pragma unroll
            for (int i = 0; i < 16; ++i) { kp[ct][i] = bf2f(Kt[crow(i, hh) * 64 + 32 * ct + r]); const float kr = kp[ct][i] * kkw; ss[i] += kr * kr; } }
#pragma unroll
        for (int i = 0; i < 16; ++i) {
#pragma unroll
            for (int o = 1; o < 32; o <<= 1) ss[i] += __shfl_xor(ss[i], o);
            ss[i] = 1.0f / fmaxf(sqrtf(ss[i]), 1e-12f); }
#define LDF(dst, ptr, n) do { _Pragma("unroll") for (int s_ = 0; s_ < (n); ++s_) dst[s_] = *(const bf16x8*)((ptr) + 16 * s_); } while (0)
#define MMF(frag, xoff, n) do { _Pragma("unroll") for (int i_ = 0; i_ < 16; ++i_) acc[i_] = 0.f; const LAS bf16* ap_ = Xs + r * XS + (xoff) + 8 * hh; \
            _Pragma("unroll") for (int s_ = 0; s_ < (n); ++s_) acc = __builtin_amdgcn_mfma_f32_32x32x16_bf16(*(const LAS bf16x8*)(ap_ + 16 * s_), frag[s_], acc, 0, 0, 0); } while (0)
#pragma unroll
        for (int ct = 0; ct < 2; ++ct) {
            const int c = hd * 64 + 32 * ct + r, cb = hd * 64 + 32 * ct;
            const float kkw = F.in[12][c], kaw = F.in[13][c];
            const bf16* pa0 = a2t + (size_t)c * 96 + 8 * hh; const bf16* pa1 = a2t + ((size_t)RC + c) * 96 + 8 * hh;
            const bf16* pw0 = w2t + (size_t)c * 96 + 8 * hh; const bf16* pw1 = w2t + ((size_t)RC + c) * 96 + 8 * hh; const bf16* pg = g2t + (size_t)c * 256 + 8 * hh;
            bf16x8 fa[6], fg[16]; f32x16 acc; float kk[16];
            LDF(fa, pa0, 6);
#pragma unroll
            for (int i = 0; i < 16; ++i) { kk[i] = kp[ct][i] * kkw * ss[i]; Ot[crow(i, hh) * 32 + r] = (bf16)f2bf(kk[i]); }
            flush_bf16(Ot, KK, t0, cb, F.lane);
#pragma unroll
            for (int d = 0; d < 2; ++d) {
                if (d == 0) { MMF(fa, 192, 6); LDF(fa, pa1, 6); } else { MMF(fa, 288, 6); LDF(fa, pw0, 6); }
                const float a0 = F.in[9][d * RC + c];
#pragma unroll
                for (int i = 0; i < 16; ++i) { acc[i] = sigmoidf_(a0 + acc[i]); Ot[crow(i, hh) * 32 + r] = (bf16)f2bf(kp[ct][i] * (1.0f + (acc[i] - 1.0f) * kaw)); }
                flush_bf16(Ot, d ? KD1 : KD0, t0, cb, F.lane);
#pragma unroll
                for (int i = 0; i < 16; ++i) Ot[crow(i, hh) * 32 + r] = (bf16)f2bf(kk[i] * acc[i]);
                flush_bf16(Ot, d ? B1 : B0, t0, cb, F.lane);
            }
#pragma unroll
            for (int d = 0; d < 2; ++d) {
                if (d == 0) { MMF(fa, 0, 6); LDF(fa, pw1, 6); } else { MMF(fa, 96, 6); LDF(fg, pg, 16); }
                const float w0 = F.in[7][d * RC + c]; LAS float* Of = (LAS float*)Ot;
#pragma unroll
                for (int i = 0; i < 16; ++i) Of[crow(i, hh) * 32 + r] = __expf(-0.6065306597126334f * sigmoidf_(w0 + acc[i]));
                flush_f32(Of, d ? W1 : W0, t0, cb, F.lane);
            }
            MMF(fg, 384, 16);
#pragma unroll
            for (int i = 0; i < 16; ++i) Ot[crow(i, hh) * 32 + r] = (bf16)f2bf(acc[i]);
            flush_bf16(Ot, GG, t0, cb, F.lane);
        }
#undef LDF
#undef MMF
        asm volatile("s_waitcnt vmcnt(0) lgkmcnt(0)" ::: "memory");
#pragma unroll 1
        for (int q = 0; q < 4; ++q) { const int d = q >> 1, half = q & 1; const int blk = d ? (NB1 - 2 * tt - half) : (2 * tt + half);
            int lzq; asm volatile("v_mov_b32 %0, 0" : "=v"(lzq));
            if (blk >= 0 && blk < (d ? NB1 : NB0)) blockprep_item(F, wl, hd, d, blk, F.lane + lzq); }
        FPB1(16);
    }
    __syncthreads();
}

constexpr int N_SCAN_WAVES = 64;
constexpr int SR_SLOTS = 8, SR_STRIDE = 13312, SR_FV = 11264, SR_FLAGS = SR_SLOTS * SR_STRIDE, SR_WSCR = SR_FLAGS + 512, SR_NL = 4, SR_NS = 2;
static_assert(SR_WSCR + (8 - SR_NS - SR_NL) * 8448 <= RING_BYTES, "scan phase LDS map");
typedef unsigned short us2_t __attribute__((ext_vector_type(2)));
struct LdSet { v4u p[11]; us2_t v[2][4]; };
__device__ __forceinline__ void sr_issue(LdSet& s, const unsigned char* item, const bf16* VV, int hd, int d, int blk, int lane) {
#pragma unroll
    for (int k = 0; k < 11; ++k) { const int pc = k * 64 + lane; s.p[k] = *(const v4u*)(item + (pc < BO_ITEM / 16 ? pc : BO_ITEM / 16 - 1) * 16); }
    const int hh = lane >> 5, il = lane & 31;
#pragma unroll
    for (int e = 0; e < 8; ++e) { const unsigned short* vr = (const unsigned short*)VV + (size_t)blk_tok(d, blk, 8 * hh + e) * RC + hd * 64 + il; s.v[0][e >> 1][e & 1] = vr[0]; s.v[1][e >> 1][e & 1] = vr[32]; }
}
__device__ __forceinline__ void sr_write(const LdSet& s, LAS unsigned char* slot, int lane) {
#pragma unroll
    for (int k = 0; k < 11; ++k) *(LAS v4u*)(slot + (k * 64 + lane) * 16) = s.p[k];
#pragma unroll
    for (int h = 0; h < 2; ++h) { const v4u vw = {__builtin_bit_cast(unsigned, s.v[h][0]), __builtin_bit_cast(unsigned, s.v[h][1]), __builtin_bit_cast(unsigned, s.v[h][2]), __builtin_bit_cast(unsigned, s.v[h][3])};
        *(LAS v4u*)(slot + SR_FV + 1024 * h + lane * 16) = vw; }
}
__device__ __forceinline__ bf16x8 pack_half(const f32x16& x, int s) {
    const v4u w = {pk2(x[8 * s + 0], x[8 * s + 1]), pk2(x[8 * s + 2], x[8 * s + 3]), pk2(x[8 * s + 4], x[8 * s + 5]), pk2(x[8 * s + 6], x[8 * s + 7])}; return __builtin_bit_cast(bf16x8, w); }
__device__ __forceinline__ void scan_phase(Frame& F) {
    const bf16* VV = (const bf16*)(F.ws + WS_VV); bf16* Y = (bf16*)(F.ws + WS_Y); const unsigned char* BO = F.ws + WS_BO;
    const bool sblock = (int)blockIdx.x < N_SCAN_WAVES;
    volatile LAS unsigned* FL = (volatile LAS unsigned*)(F.lds + SR_FLAGS);
    constexpr unsigned SPIN_CAP = 1u << 22;
    __syncthreads();
    if (F.tid < 128) FL[F.tid] = 0u;
    __syncthreads();
    const int pair = (int)blockIdx.x, ih = F.wave & 1, hd = pair >> 1, d = pair & 1, nblk = d ? NB1 : NB0, hh = F.lane >> 5, il = F.lane & 31;
    if (sblock && F.wave < SR_NS) {
        __builtin_amdgcn_s_setprio(3);
        f32x16 St[2];
#pragma unroll
        for (int a = 0; a < 2; ++a)
#pragma unroll
            for (int i = 0; i < 16; ++i) St[a][i] = 0.f;
        FPB0(17);
        const unsigned long long scan_t0 = ((PROBE_PHASE >> 21) & 1) ? __builtin_amdgcn_s_memrealtime() : 0ull;
        for (int blk = 0; blk < nblk; ++blk) {
            const int sl = blk % SR_SLOTS; const LAS unsigned char* slot = F.lds + sl * SR_STRIDE;
            { unsigned sp = 0; while (FL[sl] != (unsigned)(blk + 1)) { __builtin_amdgcn_s_sleep(1); if (++sp > SPIN_CAP) break; } }
            asm volatile("" ::: "memory");
            bf16x8 fa[4], fb[2][2]; f32x4 gm[2][4];
#pragma unroll
            for (int ks = 0; ks < 4; ++ks) fa[ks] = *(const LAS bf16x8*)(slot + BO_FA + (ks * 64 + F.lane) * 16);
            const bf16x8 faa = *(const LAS bf16x8*)(slot + BO_FAA + F.lane * 16), vf = *(const LAS bf16x8*)(slot + SR_FV + 1024 * ih + F.lane * 16);
            bf16x8 ft = *(const LAS bf16x8*)(slot + BO_FT + (hh * 16 + (il & 15)) * 16), fbp = *(const LAS bf16x8*)(slot + BO_FBP + (hh * 16 + (il & 15)) * 16);
            { const bf16x8 zz = {0, 0, 0, 0, 0, 0, 0, 0}; ft = (il < 16) ? ft : zz; fbp = (il >= 16) ? fbp : zz; }
#pragma unroll
            for (int a = 0; a < 2; ++a)
#pragma unroll
                for (int k = 0; k < 2; ++k) fb[a][k] = *(const LAS bf16x8*)(slot + BO_FB + ((a * 2 + k) * 64 + F.lane) * 16);
#pragma unroll
            for (int a = 0; a < 2; ++a)
#pragma unroll
                for (int q = 0; q < 4; ++q) gm[a][q] = *(const LAS f32x4*)(slot + BO_FG + (32 * a + 8 * q + 4 * hh) * 4);
            asm volatile("s_waitcnt lgkmcnt(0)" ::: "memory");
            if (F.lane == 0) FL[16 + ih] = (unsigned)(blk + 1);
            f32x16 acc, accp;
#pragma unroll
            for (int i = 0; i < 16; ++i) { acc[i] = 0.f; accp[i] = 0.f; }
            acc = __builtin_amdgcn_mfma_f32_32x32x16_bf16(faa, vf, acc, 0, 0, 0);
#pragma unroll
            for (int a = 0; a < 2; ++a)
#pragma unroll
                for (int s = 0; s < 2; ++s) acc = __builtin_amdgcn_mfma_f32_32x32x16_bf16(fa[2 * a + s], pack_half(St[a], s), acc, 0, 0, 0);
            accp = __builtin_amdgcn_mfma_f32_32x32x16_bf16(ft, pack_half(acc, 0), accp, 0, 0, 0);
            const bf16x8 pb = pack_half(accp, 0);
            acc = __builtin_amdgcn_mfma_f32_32x32x16_bf16(fbp, pb, acc, 0, 0, 0);
#pragma unroll
            for (int e = 0; e < 8; ++e) { const int u = 8 * (e >> 2) + 4 * hh + (e & 3);
                Y[((size_t)d * LTOK + blk_tok(d, blk, u)) * RC + hd * 64 + 32 * ih + il] = (bf16)f2bf(acc[8 + e]); }
#pragma unroll
            for (int a = 0; a < 2; ++a) {
#pragma unroll
                for (int i = 0; i < 16; ++i) St[a][i] *= gm[a][i >> 2][i & 3];
                St[a] = __builtin_amdgcn_mfma_f32_32x32x16_bf16(fb[a][0], pb, St[a], 0, 0, 0);
                St[a] = __builtin_amdgcn_mfma_f32_32x32x16_bf16(fb[a][1], vf, St[a], 0, 0, 0);
            }
        }
        FPB1(17);
        if ((PROBE_PHASE >> 21) & 1) { if (F.lane == 0) atomicMax((unsigned*)(F.ctl + 2048), (unsigned)(__builtin_amdgcn_s_memrealtime() - scan_t0)); }
        __builtin_amdgcn_s_setprio(0);
    } else if (sblock && F.wave < SR_NS + SR_NL) {
        const int lw = F.wave - SR_NS;
        LdSet st[2];
#define SR_PUT(set, b_) do { const int sl_ = (b_) % SR_SLOTS; if ((b_) >= SR_SLOTS) { unsigned sp_ = 0; while (FL[16] < (unsigned)((b_) - SR_SLOTS + 1) || FL[17] < (unsigned)((b_) - SR_SLOTS + 1)) { __builtin_amdgcn_s_sleep(1); if (++sp_ > SPIN_CAP) break; } } \
            asm volatile("" ::: "memory"); sr_write(set, F.lds + sl_ * SR_STRIDE, F.lane); asm volatile("s_waitcnt lgkmcnt(0)" ::: "memory"); if (F.lane == 0) FL[sl_] = (unsigned)((b_) + 1); } while (0)
#pragma unroll
        for (int k = 0; k < 2; ++k) { const int bb = lw + SR_NL * k; if (bb < nblk) sr_issue(st[k], BO + bo_item(hd, d, bb), VV, hd, d, bb, F.lane); }
        for (int b0 = lw; b0 < nblk; b0 += 2 * SR_NL) {
#pragma unroll
            for (int k = 0; k < 2; ++k) { const int bb = b0 + SR_NL * k; if (bb < nblk) { SR_PUT(st[k], bb); const int nb = bb + 2 * SR_NL; if (nb < nblk) sr_issue(st[k], BO + bo_item(hd, d, nb), VV, hd, d, nb, F.lane); } }
        }
#undef SR_PUT
    } else {
        const int b = (int)blockIdx.x, nsb = F.G < N_SCAN_WAVES ? F.G : N_SCAN_WAVES, wps = 8 - SR_NS - SR_NL;
        const int widx = b < N_SCAN_WAVES ? b * wps + (F.wave - SR_NS - SR_NL) : nsb * wps + (b - N_SCAN_WAVES) * 8 + F.wave;
        const int NWK = nsb * wps + (F.G - nsb) * 8;
        unsigned long long rp0 = 0, rp1 = 0, rp2 = 0;
        if (PROBE_PHASE & ((3 << 18) | (1 << 22))) rp0 = __builtin_amdgcn_s_memrealtime();
        LAS float* scr = (LAS float*)(F.lds + (sblock ? SR_WSCR + (F.wave - SR_NS - SR_NL) * 8448 : F.wave * 8448));
        attn_phase(F, widx, NWK);
        if (PROBE_PHASE & (3 << 18)) rp1 = __builtin_amdgcn_s_memrealtime();
        convert_p4(F, scr, widx, NWK, sblock ? -1 : (b - N_SCAN_WAVES) * 8 + F.wave, (F.G - nsb) * 8);
        if (PROBE_PHASE & (3 << 18)) { rp2 = __builtin_amdgcn_s_memrealtime(); if ((((PROBE_PHASE >> 25) & 1) ? (blockIdx.x == 0 && F.wave == 6 && F.lane == 0) : ((int)blockIdx.x == F.G - 1 && F.tid == 0))) { unsigned long long v = 0; if ((PROBE_PHASE >> 18) & 1) v += rp1 - rp0; if ((PROBE_PHASE >> 19) & 1) v += rp2 - rp1;
            __hip_atomic_store((unsigned*)(F.ctl + 2048), (unsigned)v, __ATOMIC_RELAXED, __HIP_MEMORY_SCOPE_AGENT); } }
        if ((PROBE_PHASE >> 22) & 1) { if (blockIdx.x == 0 && F.wave == 6 && F.lane == 0) __hip_atomic_store((unsigned*)(F.ctl + 2048), (unsigned)(__builtin_amdgcn_s_memrealtime() - rp0), __ATOMIC_RELAXED, __HIP_MEMORY_SCOPE_AGENT); }
    }
}

__device__ __forceinline__ float row16_sum(float x) {
    x += __builtin_bit_cast(float, __builtin_amdgcn_update_dpp(0, __builtin_bit_cast(int, x), 0xB1, 0xf, 0xf, true));
    x += __builtin_bit_cast(float, __builtin_amdgcn_update_dpp(0, __builtin_bit_cast(int, x), 0x4E, 0xf, 0xf, true));
    x += __builtin_bit_cast(float, __builtin_amdgcn_update_dpp(0, __builtin_bit_cast(int, x), 0x141, 0xf, 0xf, true));
    x += __builtin_bit_cast(float, __builtin_amdgcn_update_dpp(0, __builtin_bit_cast(int, x), 0x140, 0xf, 0xf, true));
    return x;
}
__device__ __forceinline__ void combine_phase(Frame& F) {
    const bf16* Y0 = (const bf16*)(F.ws + WS_Y); const bf16* Y1 = Y0 + (size_t)LTOK * RC; const float* BON = (const float*)(F.ws + WS_BONUS);
    const bf16* VV = (const bf16*)(F.ws + WS_VV); const bf16* GG = (const bf16*)(F.ws + WS_GG);
    bf16* OR = (bf16*)(F.ws + WS_ORWKV);
    const float* lnw = F.in[15]; const float* lnb = F.in[16];
    const int gw = blockIdx.x * 8 + F.wave, NGW = F.G * 8;
    for (int row = gw; row < SEQ; row += NGW) { const int t = row + NMETA;
#pragma unroll
        for (int st = 0; st < 8; ++st) { const int c = st * 256 + 4 * F.lane, hd = c >> 6; const size_t o = (size_t)t * RC + c;
            const v2u a0 = *(const v2u*)(Y0 + o), a1 = *(const v2u*)(Y1 + o), vv = *(const v2u*)(VV + o), gg = *(const v2u*)(GG + o);
            const f32x4 w = *(const f32x4*)(lnw + c), bb = *(const f32x4*)(lnb + c); const float bon = BON[(size_t)t * RH + hd];
            float y[4] = {bflo(a0.x) + bflo(a1.x), bfhi(a0.x) + bfhi(a1.x), bflo(a0.y) + bflo(a1.y), bfhi(a0.y) + bfhi(a1.y)};
            const float mean = row16_sum((y[0] + y[1]) + (y[2] + y[3])) * (1.0f / 64.0f);
#pragma unroll
            for (int e = 0; e < 4; ++e) y[e] -= mean;
            const float var = row16_sum((y[0] * y[0] + y[1] * y[1]) + (y[2] * y[2] + y[3] * y[3])) * (1.0f / 64.0f);
            const float rs = __builtin_amdgcn_rsqf(var + GN_EPS);
            const float v4[4] = {bflo(vv.x), bfhi(vv.x), bflo(vv.y), bfhi(vv.y)}, g4[4] = {bflo(gg.x), bfhi(gg.x), bflo(gg.y), bfhi(gg.y)};
            float ov[4];
#pragma unroll
            for (int e = 0; e < 4; ++e) ov[e] = (y[e] * rs * w[e] + bb[e] + bon * v4[e]) * g4[e];
            v2u ow; ow.x = pk2(ov[0], ov[1]); ow.y = pk2(ov[2], ov[3]);
            *(v2u*)(OR + (size_t)row * RC + c) = ow; } }
}
__device__ __forceinline__ void final_phase(Frame& F) {
    const float* SS3 = (const float*)(F.ctl + CW_SS3); const float* w = F.in[25];
    const int gw = blockIdx.x * 8 + F.wave, NGW = F.G * 8;
    for (int row = gw; row < SEQ; row += NGW) { const float rstd = 1.0f / sqrtf(SS3[row] * (1.0f / DM) + RMS_EPS);
        GAS f32x4* p = (GAS f32x4*)(F.out + (size_t)row * DM) + F.lane; const GAS f32x4* wp = (const GAS f32x4*)w + F.lane;
#pragma unroll
        for (int j = 0; j < 16; ++j) { const f32x4 v = p[64 * j], ww = wp[64 * j]; p[64 * j] = v * rstd * ww; } }
}
constexpr int N_PHASES = 10;
struct Args { const float* in[26]; float* out; unsigned char* ws; int ph_lo, ph_hi; };
__global__ void __launch_bounds__(512, 2) fwd_kernel(Args args) {
    extern __shared__ __attribute__((aligned(16))) unsigned char lds[];
    Frame F;
    F.lds = (LAS unsigned char*)lds;
    F.MISC = (volatile LAS unsigned*)(F.lds + MISC_OFF);
    F.tid = threadIdx.x; F.lane = F.tid & 63; F.wave = __builtin_amdgcn_readfirstlane(F.tid >> 6); F.G = gridDim.x;
    F.ws = args.ws; F.ctl = (gu32*)(args.ws + WS_CTL); F.out = args.out; F.pb0 = 0; F.pacc = 0; F.pacc2 = 0;
#pragma unroll
    for (int i = 0; i < 26; ++i) F.in[i] = args.in[i];
    for (int u = F.tid; u < (LDS_BYTES - LDSCTL_OFF) / 4; u += 512) ((LAS unsigned*)(F.lds + LDSCTL_OFF))[u] = 0u;
    __syncthreads();
    XcdBarrier bar; bar.bar = (unsigned*)(F.ctl + CW_BAR); bar.x = 0; bar.st = nullptr;
    if (!MK_SPLIT) bar = xcd_barrier_post((unsigned*)(F.ctl + CW_BAR), F.MISC + 8);
    const int lo = args.ph_lo, hi = args.ph_hi;
#define IN(k) (lo <= (k) && (k) < hi)
#define SEAM(k) do { if (IN(k) && IN((k) + 1)) xcd_barrier(bar); } while (0)
    bf16* Rm = (bf16*)(F.ws + WS_H);
    float* SS2 = (float*)(F.ctl + CW_SS2); float* SS3 = (float*)(F.ctl + CW_SS3);

    unsigned long long pt0 = 0, pt1 = 0;
#define PB0(k) do { if ((PROBE_PHASE >> (k)) & 1) pt0 = __builtin_amdgcn_s_memrealtime(); } while (0)
#define PB1(k) do { if ((PROBE_PHASE >> (k)) & 1) pt1 += __builtin_amdgcn_s_memrealtime() - pt0; } while (0)
    PB0(0); if (IN(0)) { p0_prologue(F); } SEAM(0); PB1(0);
    PB0(1); if (IN(1)) {
        pg8::Gemm g{Rm, Rm, MPAD + INWP, MPAD + INWP, DM}; pg8::InOrder S; S.init(F.G, (int)blockIdx.x);
        pg8::EpiIn E{(bf16*)(F.ws + WS_G), (bf16*)(F.ws + WS_Q), (bf16*)(F.ws + WS_K), (bf16*)(F.ws + WS_VT), (bf16*)(F.ws + WS_U), F.in[4], (const float*)(F.ws + WS_ROPE)};
        pg8::gemm_phase<pg8::EpiIn, pg8::InOrder, true, true>(F.lds, g, S, E, F.pacc2);
    } SEAM(1); PB1(1);
    PB0(2); if (IN(2)) { prep_phase(F); } SEAM(2); PB1(2);
    PB0(3); if (IN(3)) { scan_phase(F); } SEAM(3); PB1(3);
    PB0(4); if (IN(4)) { combine_phase(F); } SEAM(4); PB1(4);
    PB0(5); if (IN(5)) {
        { pg8::Gemm g{(const bf16*)(F.ws + WS_OATT), (const bf16*)(F.ws + WS_WPA), SEQ, DM, ATTW}; pg8::StaticOrder S; S.init(SEQ, DM, F.G, (int)blockIdx.x);
          pg8::EpiProjA E{(bf16*)(F.ws + WS_P1), (const bf16*)(F.ws + WS_G)};
          pg8::gemm_phase<pg8::EpiProjA, pg8::StaticOrder, true, true>(F.lds, g, S, E, F.pacc2); }
        __syncthreads();
        { pg8::Gemm g{(const bf16*)(F.ws + WS_ORWKV), (const bf16*)(F.ws + WS_WPR), SEQ, DM, RC}; pg8::StaticOrder S; S.init(SEQ, DM, F.G, (int)blockIdx.x);
          pg8::EpiProjB E{(const bf16*)(F.ws + WS_P1), (const bf16*)(F.ws + WS_G), (bf16*)(F.ws + WS_MX)};
          pg8::gemm_phase<pg8::EpiProjB, pg8::StaticOrder, true, true>(F.lds, g, S, E, F.pacc2); }
    } SEAM(5); PB1(5);
    PB0(6); if (IN(6)) {
        pg8::Gemm g{(const bf16*)(F.ws + WS_MX), (const bf16*)(F.ws + WS_WOUT), SEQ, DM, DM}; pg8::StaticOrder S; S.init(SEQ, DM, F.G, (int)blockIdx.x);
        pg8::EpiResid<false> E{F.in[0], nullptr, nullptr, (bf16*)(F.ws + WS_A2), SS2};
        pg8::gemm_phase<pg8::EpiResid<false>, pg8::StaticOrder, true, true>(F.lds, g, S, E, F.pacc2);
    } SEAM(6); PB1(6);
    const unsigned long long epi_before7 = F.pacc2;
    PB0(7); if (IN(7)) {
        pg8::Gemm g{(const bf16*)(F.ws + WS_A2), (const bf16*)(F.ws + WS_WGU), SEQ, 2 * DFF, DM}; pg8::StaticOrder S; S.init(SEQ, 2 * DFF, F.G, (int)blockIdx.x);
        pg8::EpiSwiGLU E{(bf16*)(F.ws + WS_HID), SS2};
        pg8::gemm_phase<pg8::EpiSwiGLU, pg8::StaticOrder, true, true>(F.lds, g, S, E, F.pacc2);
        {
          const int nun = (SEQ / 256) * (2 * DFF / 256), rounds = (nun + F.G - 1) / F.G, first_idle = nun - (rounds - 1) * F.G;
          const int nidle = F.G - first_idle;
          if (nidle > 0) { if ((int)blockIdx.x >= first_idle) convert_wd(F, (LAS float*)(F.lds + F.wave * 8448), ((int)blockIdx.x - first_idle) * 8 + F.wave, nidle * 8); }
          else convert_wd(F, (LAS float*)(F.lds + F.wave * 8448), (int)blockIdx.x * 8 + F.wave, F.G * 8); }
    } SEAM(7); PB1(7);
    const unsigned long long epi_before8 = F.pacc2;
    PB0(8); if (IN(8)) {
        pg8::Gemm g{(const bf16*)(F.ws + WS_HID), (const bf16*)(F.ws + WS_WD), SEQ, DM, DFF}; pg8::StaticOrder S; S.init(SEQ, DM, F.G, (int)blockIdx.x);
        pg8::EpiResid<true> E{nullptr, (const bf16*)(F.ws + WS_A2), F.out, nullptr, SS3};
        pg8::gemm_phase<pg8::EpiResid<true>, pg8::StaticOrder, true, true>(F.lds, g, S, E, F.pacc2);
    } SEAM(8); PB1(8);
    const unsigned long long epi9 = ((PROBE_PHASE >> 24) & 1) ? (epi_before8 - epi_before7) : (F.pacc2 - epi_before8);
    PB0(9); if (IN(9)) { final_phase(F); } PB1(9);
    if (PROBE_PHASE != 0 && blockIdx.x == 0 && F.tid == 0) { const unsigned long long te = __builtin_amdgcn_s_memrealtime(), want = (unsigned long long)PROBE_MULT * (((PROBE_PHASE >> 23) & 1) ? epi9 : ((PROBE_PHASE >> 20) & 1) ? F.pacc2 : (PROBE_PHASE & ((3 << 18) | (3 << 21))) ? (unsigned long long)__hip_atomic_load((unsigned*)(F.ctl + 2048), __ATOMIC_RELAXED, __HIP_MEMORY_SCOPE_AGENT) : (pt1 + F.pacc));
        while (__builtin_amdgcn_s_memrealtime() - te < want && want < 2000000ull) __builtin_amdgcn_s_sleep(32); }
#undef PB0
#undef PB1
#undef IN
#undef SEAM
}

extern "C" void kernel_launch(void* const* d_in, const int* in_sizes, int n_in, void* d_out, int out_size, void* d_ws, size_t ws_size, hipStream_t stream) {
    static int grid = 0;
    if (grid == 0) {
        if (n_in != 26 || out_size != SEQ * DM || ws_size < WS_END) { fprintf(stderr, "kernel_launch: unexpected shapes (n_in %d, out %d, ws %zu, need %zu); nothing launched\n", n_in, out_size, ws_size, (size_t)WS_END); grid = -1; return; }
        int dev = 0, cus = 0, per_cu = 0;
        if (hipGetDevice(&dev) != hipSuccess || hipDeviceGetAttribute(&cus, hipDeviceAttributeMultiprocessorCount, dev) != hipSuccess) { grid = -1; return; }
        if (hipFuncSetAttribute((const void*)fwd_kernel, hipFuncAttributeMaxDynamicSharedMemorySize, LDS_BYTES) != hipSuccess) { fprintf(stderr, "kernel_launch: hipFuncSetAttribute failed\n"); grid = -1; return; }
        if (hipOccupancyMaxActiveBlocksPerMultiprocessor(&per_cu, (const void*)fwd_kernel, 512, LDS_BYTES) != hipSuccess || per_cu < 1) fprintf(stderr, "kernel_launch: occupancy query says %d per CU\n", per_cu);
        (void)hipGetLastError();
        grid = cus;
    }
    if (grid < 0) return;
    if (hipMemsetAsync((char*)d_ws + WS_CTL, 0, ZERO_BYTES, stream) != hipSuccess) return;
    Args a{};
    for (int i = 0; i < 26; ++i) a.in[i] = (const float*)d_in[i];
    a.out = (float*)d_out; a.ws = (unsigned char*)d_ws;
#if MK_SPLIT
    for (int p = 0; p < N_PHASES; ++p) { a.ph_lo = p; a.ph_hi = p + 1; hipLaunchKernelGGL(fwd_kernel, dim3(grid), dim3(512), LDS_BYTES, stream, a); }
#else
    a.ph_lo = 0; a.ph_hi = N_PHASES;
    hipLaunchKernelGGL(fwd_kernel, dim3(grid), dim3(512), LDS_BYTES, stream, a);
#endif
}
```

```cpp
#include <hip/hip_runtime.h>
#include <cstdio>
#include <cstdint>

#ifndef MK_SPLIT
#define MK_SPLIT 0
#endif

#ifndef PROBE_PHASE
#define PROBE_PHASE 0
#endif
#ifndef PROBE_MULT
#define PROBE_MULT 2
#endif
constexpr int NMETA = 16, SEQ = 8192, LTOK = 8208, DM = 4096, MPAD = 8448;
constexpr int INW = 18048, INWP = 18176;
constexpr int ATTW = 2048, KVW = 512, UW = 6784, UPITCH = 6912;
constexpr int RC = 2048, RH = 32, RN = 64;
constexpr int DFF = 11008;
constexpr float RMS_EPS = 1e-6f, GN_EPS = 64e-5f;
constexpr int HT = MPAD / 256;
constexpr int CT_Q = 32, CT_K = 40, CT_V = 42, CT_U = 44, CT_N = 71;

namespace pg8 {
#define PG8_LAS __attribute__((address_space(3)))
typedef unsigned short bf16_t;
typedef short bf16x8 __attribute__((ext_vector_type(8)));
typedef float f32x4 __attribute__((ext_vector_type(4)));
typedef unsigned u32x4 __attribute__((ext_vector_type(4)));
constexpr int BM = 256, BK = 64, HALF = 128, HTB = HALF * BK * 2  , STAGE_BYTES = 8 * HTB, NXCD = 8, WGM = 8;

__host__ __device__ __forceinline__ int lds_byte(int r, int c) { const int st = (r >> 4) * 2 + (c >> 5), rr = r & 15, cc = c & 31, ob = rr * 64 + cc * 2; return st * 1024 + (ob ^ (((ob >> 9) & 1) << 5)); }
__host__ __device__ __forceinline__ void stage_rc(int b, int& R, int& C) { const int st = b / 1024, sb = b % 1024, swz = sb ^ (((sb >> 9) & 1) << 5); R = (st >> 1) * 16 + swz / 64; C = (st & 1) * 32 + (swz % 64) / 2; }
__host__ __device__ __forceinline__ int perm32(int rho) { const int n = rho >> 4, i = rho & 15; return 8 * (i >> 2) + 4 * n + (i & 3); }

struct Unit { int pm, pn; };
struct Gemm { const bf16_t* A; const bf16_t* Bt; int M, N, K; };

struct StaticOrder {
    int nM, nN, nwg, G, c;
    __host__ __device__ void init(int M, int N, int G_, int c_) { nM = M / BM; nN = N / BM; nwg = nM * nN; G = G_; c = c_; }
    __host__ __device__ bool next(int i, Unit& u) const {
        const long L = (long)i * G + c; if (L >= nwg) return false;
        int wgid = (int)L; { const int q = nwg / NXCD, r = nwg % NXCD, xcd = wgid % NXCD, off = wgid / NXCD; wgid = (xcd < r ? xcd * (q + 1) : r * (q + 1) + (xcd - r) * q) + off; }
        const int nig = WGM * nN, gid = wgid / nig, fm = gid * WGM, gsz = (nM - fm) < WGM ? (nM - fm) : WGM;
        u.pm = fm + ((wgid % nig) % gsz); u.pn = (wgid % nig) / gsz; return true;
    }
    __device__ __forceinline__ void a_ready(const Unit&) const {}
    __device__ __forceinline__ void done(const Unit&) const {}
};

typedef float f32x2c __attribute__((ext_vector_type(2)));
typedef __bf16 bf16x2c __attribute__((ext_vector_type(2)));
__device__ __forceinline__ unsigned cvt_pk_bf16(float lo, float hi) { const f32x2c v = {lo, hi}; const bf16x2c r = __builtin_convertvector(v, bf16x2c); return __builtin_bit_cast(unsigned, r); }

typedef unsigned u32x2 __attribute__((ext_vector_type(2)));
__device__ __forceinline__ float bflo(unsigned w) { return __uint_as_float(w << 16); }
__device__ __forceinline__ float bfhi(unsigned w) { return __uint_as_float(w & 0xffff0000u); }
__device__ __forceinline__ float sigmoidf_(float x) { return __builtin_amdgcn_rcpf(1.0f + __expf(-x)); }

struct InOrder {
    StaticOrder base; int G, c;
    __device__ void init(int G_, int c_) { base.init(SEQ, INWP, G_, c_); G = G_; c = c_; }
    __device__ bool next(int i, Unit& u) const {
        const long L = (long)i * G + c;
        if (L < base.nwg) {
            base.next(i, u);
            if (u.pn >= CT_V && u.pn < CT_U) { const int e = (u.pn - CT_V) * 32 + u.pm; u.pm = HT + CT_V + e / HT; u.pn = e % HT; }
            else u.pn += HT;
            return true;
        }
        const int x = (int)(L - base.nwg);
        if (x >= 31) return false;
        if (x < 2) { const int e = 64 + x; u.pm = HT + CT_V + e / HT; u.pn = e % HT; }
        else { const int y = x - 2; u.pm = 32; u.pn = HT + (y < 2 ? CT_K + y : CT_U + (y - 2)); }
        return true;
    }
    __device__ __forceinline__ void a_ready(const Unit&) const {}
    __device__ __forceinline__ void done(const Unit&) const {}
};

struct EpiIn {
    static constexpr bool PERM = true, AFTER_DRAIN = false;
    bf16_t *G, *Q, *K, *Vt, *U; const float* bgate; const float* rope;
    __device__ __forceinline__ static void st8(bf16_t* p, const f32x4& v0, const f32x4& v1) {
        u32x4 w; w.x = cvt_pk_bf16(v0[0], v0[1]); w.y = cvt_pk_bf16(v0[2], v0[3]); w.z = cvt_pk_bf16(v1[0], v1[1]); w.w = cvt_pk_bf16(v1[2], v1[3]); *(u32x4*)p = w; }
    __device__ __forceinline__ void plain(const f32x4 (&acc)[2][2][4][2], bf16_t* base, int ldc, int row0, int col0) const {
#pragma unroll
        for (int ai = 0; ai < 2; ++ai)
#pragma unroll
            for (int m = 0; m < 4; ++m) { bf16_t* rowp = base + (size_t)(row0 + ai * HALF + m * 16) * ldc + col0;
#pragma unroll
                for (int bj = 0; bj < 2; ++bj) st8(rowp + bj * HALF, acc[ai][bj][m][0], acc[ai][bj][m][1]); }
    }
    __device__ __forceinline__ void plain_vt(const f32x4 (&acc)[2][2][4][2], bf16_t* base, int ldc, int row0, int col0) const {
#pragma unroll
        for (int ai = 0; ai < 2; ++ai)
#pragma unroll
            for (int m = 0; m < 4; ++m) { bf16_t* rowp = base + (size_t)(row0 + ai * HALF + m * 16) * ldc;
#pragma unroll
                for (int bj = 0; bj < 2; ++bj) { const int col = col0 + bj * HALF, g = col & ~15, jj = (col >> 3) & 1; const f32x4 v0 = acc[ai][bj][m][0], v1 = acc[ai][bj][m][1];
                    u32x2 w0, w1; w0.x = cvt_pk_bf16(v0[0], v0[1]); w0.y = cvt_pk_bf16(v0[2], v0[3]); w1.x = cvt_pk_bf16(v1[0], v1[1]); w1.y = cvt_pk_bf16(v1[2], v1[3]);
                    *(u32x2*)(rowp + g + 4 * jj) = w0; *(u32x2*)(rowp + g + 8 + 4 * jj) = w1; } }
    }
    __device__ __forceinline__ void roped(const f32x4 (&acc)[2][2][4][2], bf16_t* base, int ldc, int row0, int col0, int wc, int fq) const {
        if (wc != 0) { plain(acc, base, ldc, row0, col0); return; }
        const float sgn = (fq < 2) ? -1.0f : 1.0f;
#pragma unroll
        for (int ai = 0; ai < 2; ++ai)
#pragma unroll
            for (int m = 0; m < 4; ++m) { const int row = row0 + ai * HALF + m * 16; const int pos = row < SEQ ? row + NMETA : row - SEQ;
                const f32x4* cs = (const f32x4*)(rope + (size_t)pos * 32 + 16 * (fq & 1));
                const f32x4 c0 = cs[0], c1 = cs[1], c2 = cs[2], c3 = cs[3];
                const float cw[8] = {c0[0], c0[2], c1[0], c1[2], c2[0], c2[2], c3[0], c3[2]}, sw[8] = {c0[1], c0[3], c1[1], c1[3], c2[1], c2[3], c3[1], c3[3]};
                bf16_t* rowp = base + (size_t)row * ldc + col0;
#pragma unroll
                for (int bj = 0; bj < 2; ++bj) { f32x4 v0 = acc[ai][bj][m][0], v1 = acc[ai][bj][m][1], o0, o1;
#pragma unroll
                    for (int e = 0; e < 4; ++e) { const float p0 = __shfl_xor(v0[e], 32), p1 = __shfl_xor(v1[e], 32);
                        o0[e] = v0[e] * cw[e] + sgn * p0 * sw[e]; o1[e] = v1[e] * cw[4 + e] + sgn * p1 * sw[4 + e]; }
                    st8(rowp + bj * HALF, o0, o1); } }
    }
    __device__ __forceinline__ void operator()(const f32x4 (&acc)[2][2][4][2], const Unit& u, int wr, int wc, int fr, int fq) const {
        if (u.pm >= HT) {
            plain_vt(acc, Vt, MPAD, (u.pm - HT - CT_V) * BM + wr * 64 + fr, u.pn * BM + wc * 32 + 8 * fq); return; }
        const int ct = u.pn - HT, row0 = u.pm * BM + wr * 64 + fr, cl = wc * 32 + 8 * fq;
        if (ct < CT_Q) {
            const int col0 = ct * BM + cl;
#pragma unroll
            for (int bj = 0; bj < 2; ++bj) { const f32x4 b0 = *(const f32x4*)(bgate + col0 + bj * HALF), b1 = *(const f32x4*)(bgate + col0 + bj * HALF + 4);
#pragma unroll
                for (int ai = 0; ai < 2; ++ai)
#pragma unroll
                    for (int m = 0; m < 4; ++m) { f32x4 v0 = acc[ai][bj][m][0] + b0, v1 = acc[ai][bj][m][1] + b1;
#pragma unroll
                        for (int e = 0; e < 4; ++e) { v0[e] = sigmoidf_(v0[e]); v1[e] = sigmoidf_(v1[e]); }
                        st8(G + (size_t)(row0 + ai * HALF + m * 16) * (2 * DM) + col0 + bj * HALF, v0, v1); } }
        } else if (ct < CT_K) { roped(acc, Q, ATTW, row0, (ct - CT_Q) * BM + cl, wc, fq);
        } else if (ct < CT_V) { roped(acc, K, KVW, row0, (ct - CT_K) * BM + cl, wc, fq);
        } else { plain(acc, U, UPITCH, row0, (ct - CT_U) * BM + cl); }
    }
};

struct EpiProjA {
    static constexpr bool PERM = true, AFTER_DRAIN = false;
    bf16_t* P1; const bf16_t* G;
    __device__ __forceinline__ void operator()(const f32x4 (&acc)[2][2][4][2], const Unit& u, int wr, int wc, int fr, int fq) const {
        const int row0 = u.pm * BM + wr * 64 + fr, col0 = u.pn * BM + wc * 32 + 8 * fq;
#pragma unroll
        for (int ai = 0; ai < 2; ++ai)
#pragma unroll
            for (int m = 0; m < 4; ++m) { const size_t r = (size_t)(row0 + ai * HALF + m * 16);
#pragma unroll
                for (int bj = 0; bj < 2; ++bj) { const int c = col0 + bj * HALF; const u32x4 g = *(const u32x4*)(G + r * (2 * DM) + c);
                    f32x4 o0 = acc[ai][bj][m][0], o1 = acc[ai][bj][m][1];
                    o0[0] *= bflo(g.x); o0[1] *= bfhi(g.x); o0[2] *= bflo(g.y); o0[3] *= bfhi(g.y); o1[0] *= bflo(g.z); o1[1] *= bfhi(g.z); o1[2] *= bflo(g.w); o1[3] *= bfhi(g.w);
                    EpiIn::st8(P1 + r * DM + c, o0, o1); } }
    }
};
struct EpiProjB {
    static constexpr bool PERM = true, AFTER_DRAIN = false;
    const bf16_t* P1; const bf16_t* G; bf16_t* MX;
    __device__ __forceinline__ void operator()(const f32x4 (&acc)[2][2][4][2], const Unit& u, int wr, int wc, int fr, int fq) const {
        const int row0 = u.pm * BM + wr * 64 + fr, col0 = u.pn * BM + wc * 32 + 8 * fq;
#pragma unroll
        for (int ai = 0; ai < 2; ++ai)
#pragma unroll
            for (int m = 0; m < 4; ++m) { const size_t r = (size_t)(row0 + ai * HALF + m * 16);
#pragma unroll
                for (int bj = 0; bj < 2; ++bj) { const int c = col0 + bj * HALF; const u32x4 g = *(const u32x4*)(G + r * (2 * DM) + DM + c); const u32x4 q = *(const u32x4*)(P1 + r * DM + c);
                    f32x4 o0 = {bflo(q.x), bfhi(q.x), bflo(q.y), bfhi(q.y)}, o1 = {bflo(q.z), bfhi(q.z), bflo(q.w), bfhi(q.w)}; const f32x4 a0 = acc[ai][bj][m][0], a1 = acc[ai][bj][m][1];
                    o0[0] += a0[0] * bflo(g.x); o0[1] += a0[1] * bfhi(g.x); o0[2] += a0[2] * bflo(g.y); o0[3] += a0[3] * bfhi(g.y);
                    o1[0] += a1[0] * bflo(g.z); o1[1] += a1[1] * bfhi(g.z); o1[2] += a1[2] * bflo(g.w); o1[3] += a1[3] * bfhi(g.w);
                    EpiIn::st8(MX + r * DM + c, o0, o1); }
                asm volatile("" ::: "memory"); }
    }
};
template <bool BASE_BF16> struct EpiResid {
    static constexpr bool PERM = true, AFTER_DRAIN = false;
    const float* BASEF; const bf16_t* BASEB; float* OUTF; bf16_t* OUTB; float* SS;
    __device__ __forceinline__ void operator()(const f32x4 (&acc)[2][2][4][2], const Unit& u, int wr, int wc, int fr, int fq) const {
        const int row0 = u.pm * BM + wr * 64 + fr, col0 = u.pn * BM + wc * 32 + 8 * fq;
#pragma unroll
        for (int ai = 0; ai < 2; ++ai)
#pragma unroll
            for (int m = 0; m < 4; ++m) { const size_t r = (size_t)(row0 + ai * HALF + m * 16); float ss = 0.f;
#pragma unroll
                for (int bj = 0; bj < 2; ++bj) { const int c = col0 + bj * HALF; f32x4 o0, o1;
                    if (BASE_BF16) { const u32x4 g = *(const u32x4*)(BASEB + r * DM + c); o0 = (f32x4){bflo(g.x), bfhi(g.x), bflo(g.y), bfhi(g.y)}; o1 = (f32x4){bflo(g.z), bfhi(g.z), bflo(g.w), bfhi(g.w)}; }
                    else { const float* bp = BASEF + r * DM + c; o0 = *(const f32x4*)bp; o1 = *(const f32x4*)(bp + 4); }
                    o0 += acc[ai][bj][m][0]; o1 += acc[ai][bj][m][1];
                    if (BASE_BF16) { float* op = OUTF + r * DM + c; *(f32x4*)op = o0; *(f32x4*)(op + 4) = o1; }
                    else { u32x4 w; w.x = cvt_pk_bf16(o0[0], o0[1]); w.y = cvt_pk_bf16(o0[2], o0[3]); w.z = cvt_pk_bf16(o1[0], o1[1]); w.w = cvt_pk_bf16(o1[2], o1[3]); *(u32x4*)(OUTB + r * DM + c) = w;
                        o0 = (f32x4){bflo(w.x), bfhi(w.x), bflo(w.y), bfhi(w.y)}; o1 = (f32x4){bflo(w.z), bfhi(w.z), bflo(w.w), bfhi(w.w)}; }
                    ss += (o0[0] * o0[0] + o0[1] * o0[1]) + (o0[2] * o0[2] + o0[3] * o0[3]) + (o1[0] * o1[0] + o1[1] * o1[1]) + (o1[2] * o1[2] + o1[3] * o1[3]); }
                ss += __shfl_xor(ss, 16); ss += __shfl_xor(ss, 32);
                if (fq == 0) atomicAdd(SS + r, ss);
                asm volatile("" ::: "memory"); }
    }
};
struct EpiSwiGLU {
    static constexpr bool PERM = true, AFTER_DRAIN = false;
    bf16_t* HID; const float* SS;
    __device__ __forceinline__ void operator()(const f32x4 (&acc)[2][2][4][2], const Unit& u, int wr, int wc, int fr, int fq) const {
        const int row0 = u.pm * BM + wr * 64 + fr, col0 = u.pn * HALF + wc * 32 + 8 * fq;
#pragma unroll
        for (int ai = 0; ai < 2; ++ai)
#pragma unroll
            for (int m = 0; m < 4; ++m) { const size_t r = (size_t)(row0 + ai * HALF + m * 16);
                const float rstd = __builtin_amdgcn_rsqf(SS[r] * (1.0f / DM) + RMS_EPS);
                f32x4 o0, o1;
#pragma unroll
                for (int e = 0; e < 4; ++e) { const float g0 = acc[ai][0][m][0][e] * rstd, u0 = acc[ai][1][m][0][e] * rstd, g1 = acc[ai][0][m][1][e] * rstd, u1 = acc[ai][1][m][1][e] * rstd;
                    o0[e] = g0 * sigmoidf_(g0) * u0; o1[e] = g1 * sigmoidf_(g1) * u1; }
                EpiIn::st8(HID + r * DFF + col0, o0, o1); }
    }
};

#define PG8_EPI_T0 unsigned long long epi_t0_ = 0; do { if ((PROBE_PHASE >> 20) & 1) epi_t0_ = __builtin_amdgcn_s_memrealtime(); } while (0)
#define PG8_EPI_T1 do { if ((PROBE_PHASE >> 20) & 1) epi_acc += __builtin_amdgcn_s_memrealtime() - epi_t0_; } while (0)
template <class Epi, class Sched, bool ALIGN_EPI = false, bool SP2 = false>
__device__ __forceinline__ void gemm_phase(PG8_LAS unsigned char* lds, const Gemm g, const Sched& S, const Epi& E, unsigned long long& epi_acc) {
    const int tid = threadIdx.x, wid = __builtin_amdgcn_readfirstlane(tid >> 6), lane = tid & 63, wr = wid >> 2, wc = wid & 3, fr = lane & 15, fq = lane >> 4;
    const int K = g.K, nt = K / BK;
    unsigned voffA[2], voffB[2];
#pragma unroll
    for (int i = 0; i < 2; ++i) { int R, C; stage_rc(tid * 16 + i * 8192, R, C); const int Rb = Epi::PERM ? ((R & ~31) + perm32(R & 31)) : R;
        voffA[i] = (unsigned)(R * K + C) * 2u; voffB[i] = (unsigned)(Rb * K + C) * 2u; }
    const size_t kstep = (size_t)(BK * 2);
    const size_t hstep = (size_t)HALF * K * 2;
    const size_t tstep = 2 * hstep;
    const unsigned ldsw = (unsigned)wid * 1024u;
    const int aoff = lds_byte(wr * 64 + fr, fq * 8), boff = lds_byte(wc * 32 + fr, fq * 8);
#define PG8_SA(b, h) (((b) * 2 + (h)) * HTB)
#define PG8_SB(b, h) ((4 + (b) * 2 + (h)) * HTB)
#define PG8_STAGE(bufoff, gbase, voff) do { _Pragma("unroll") for (int _i = 0; _i < 2; ++_i) \
        __builtin_amdgcn_global_load_lds((const unsigned*)((const char*)(gbase) + (voff)[_i]), (PG8_LAS unsigned*)(lds + (bufoff) + ldsw + _i * 8192), 16, 0, 0); } while (0)
#define PG8_LDA(dst, b, h) do { _Pragma("unroll") for (int m = 0; m < 4; ++m) _Pragma("unroll") for (int k = 0; k < 2; ++k) dst[m][k] = *(const PG8_LAS bf16x8*)(lds + PG8_SA(b, h) + aoff + m * 2048 + k * 1024); } while (0)
#define PG8_LDB(dst, b, h) do { _Pragma("unroll") for (int n = 0; n < 2; ++n) _Pragma("unroll") for (int k = 0; k < 2; ++k) dst[n][k] = *(const PG8_LAS bf16x8*)(lds + PG8_SB(b, h) + boff + n * 2048 + k * 1024); } while (0)
#define PG8_MMA(ai, bj, At, Bt) do { __builtin_amdgcn_s_setprio(1); _Pragma("unroll") for (int m = 0; m < 4; ++m) _Pragma("unroll") for (int n = 0; n < 2; ++n) _Pragma("unroll") for (int k = 0; k < 2; ++k) \
        acc[ai][bj][m][n] = __builtin_amdgcn_mfma_f32_16x16x32_bf16(Bt[n][k], At[m][k], acc[ai][bj][m][n], 0, 0, 0); __builtin_amdgcn_s_setprio(0); } while (0)
#define PG8_WAIT_V(n) asm volatile("s_waitcnt vmcnt(" #n ")" ::: "memory")
#define PG8_WAIT_L(n) asm volatile("s_waitcnt lgkmcnt(" #n ")" ::: "memory")
#define PG8_BAR __builtin_amdgcn_s_barrier()
#define PG8_SCHED __builtin_amdgcn_sched_barrier(0)
    Unit cur, nxt; int ui = 0;
    if (!S.next(0, cur)) return;
    f32x4 acc[2][2][4][2];
#pragma unroll
    for (int a = 0; a < 2; ++a)
#pragma unroll
        for (int b = 0; b < 2; ++b)
#pragma unroll
            for (int m = 0; m < 4; ++m)
#pragma unroll
                for (int n = 0; n < 2; ++n) acc[a][b][m][n] = (f32x4){0.f, 0.f, 0.f, 0.f};
    bf16x8 At[4][2], B0[2][2], B1[2][2];
    const char* cA = (const char*)g.A + (size_t)cur.pm * tstep; const char* cB = (const char*)g.Bt + (size_t)cur.pn * tstep;
    S.a_ready(cur);
    if constexpr (SP2) {
        PG8_STAGE(PG8_SB(0, 0), cB, voffB); PG8_STAGE(PG8_SB(0, 1), cB + hstep, voffB); PG8_STAGE(PG8_SA(0, 0), cA, voffA); PG8_STAGE(PG8_SA(0, 1), cA + hstep, voffA);
        if (wr == 1) PG8_BAR;
        PG8_WAIT_V(2); PG8_BAR;
        PG8_STAGE(PG8_SB(1, 0), cB + kstep, voffB); PG8_STAGE(PG8_SA(1, 0), cA + kstep, voffA); PG8_STAGE(PG8_SB(1, 1), cB + hstep + kstep, voffB);
        PG8_WAIT_V(6); PG8_BAR;
    } else {
        PG8_STAGE(PG8_SB(0, 0), cB, voffB); PG8_STAGE(PG8_SA(0, 0), cA, voffA); PG8_STAGE(PG8_SB(0, 1), cB + hstep, voffB); PG8_STAGE(PG8_SA(0, 1), cA + hstep, voffA);
        if (wr == 1) PG8_BAR;
        PG8_WAIT_V(4); PG8_BAR;
        PG8_STAGE(PG8_SB(1, 0), cB + kstep, voffB); PG8_STAGE(PG8_SA(1, 0), cA + kstep, voffA); PG8_STAGE(PG8_SB(1, 1), cB + hstep + kstep, voffB);
        PG8_WAIT_V(6); PG8_BAR;
    }
    for (;;) {
        const bool has_next = S.next(ui + 1, nxt);
        const char* nA = has_next ? (const char*)g.A + (size_t)nxt.pm * tstep : cA; const char* nB = has_next ? (const char*)g.Bt + (size_t)nxt.pn * tstep : cB;
        for (int t = 0; t < nt; t += 2) {
            const bool last = (t == nt - 2);
            const char* a1 = cA + (size_t)(t + 1) * kstep;
            const char* a2 = last ? nA : cA + (size_t)(t + 2) * kstep; const char* b2 = last ? nB : cB + (size_t)(t + 2) * kstep;
            const char* a3 = a2 + kstep; const char* b3 = b2 + kstep;
            if (last && has_next) S.a_ready(nxt);
            if constexpr (SP2) {
            PG8_LDB(B0, 0, 0); PG8_LDB(B1, 0, 1); PG8_SCHED; PG8_LDA(At, 0, 0); PG8_STAGE(PG8_SA(1, 1), a1 + hstep, voffA);
            PG8_WAIT_V(8); PG8_WAIT_L(0); PG8_BAR; PG8_MMA(0, 0, At, B0); PG8_MMA(0, 1, At, B1); PG8_BAR; PG8_SCHED;
            PG8_LDA(At, 0, 1); PG8_STAGE(PG8_SB(0, 0), b2, voffB); PG8_STAGE(PG8_SB(0, 1), b2 + hstep, voffB); PG8_STAGE(PG8_SA(0, 0), a2, voffA);
            PG8_WAIT_V(8); PG8_WAIT_L(0); PG8_BAR; PG8_MMA(1, 0, At, B0); PG8_MMA(1, 1, At, B1); PG8_BAR; PG8_SCHED;
            PG8_LDB(B0, 1, 0); PG8_LDB(B1, 1, 1); PG8_SCHED; PG8_LDA(At, 1, 0); PG8_STAGE(PG8_SA(0, 1), a2 + hstep, voffA);
            PG8_WAIT_V(8); PG8_WAIT_L(0); PG8_BAR; PG8_MMA(0, 0, At, B0); PG8_MMA(0, 1, At, B1); PG8_BAR; PG8_SCHED;
            PG8_LDA(At, 1, 1); PG8_STAGE(PG8_SB(1, 0), b3, voffB); PG8_STAGE(PG8_SB(1, 1), b3 + hstep, voffB); PG8_STAGE(PG8_SA(1, 0), a3, voffA);
            PG8_WAIT_V(8); PG8_WAIT_L(0); PG8_BAR; PG8_MMA(1, 0, At, B0); PG8_MMA(1, 1, At, B1); PG8_BAR; PG8_SCHED;
            } else {
            PG8_LDB(B0, 0, 0); PG8_SCHED; PG8_LDA(At, 0, 0); PG8_STAGE(PG8_SA(1, 1), a1 + hstep, voffA);
            PG8_WAIT_L(8); PG8_BAR; PG8_WAIT_L(0); PG8_MMA(0, 0, At, B0); PG8_BAR; PG8_SCHED;
            PG8_LDB(B1, 0, 1); PG8_STAGE(PG8_SB(0, 0), b2, voffB);
            PG8_BAR; PG8_WAIT_L(0); PG8_MMA(0, 1, At, B1); PG8_BAR;
            PG8_LDA(At, 0, 1); PG8_STAGE(PG8_SA(0, 0), a2, voffA);
            PG8_BAR; PG8_WAIT_L(0); PG8_MMA(1, 0, At, B0); PG8_BAR; PG8_SCHED;
            PG8_STAGE(PG8_SB(0, 1), b2 + hstep, voffB);
            PG8_WAIT_V(6); PG8_BAR; PG8_MMA(1, 1, At, B1); PG8_BAR;
            PG8_LDB(B0, 1, 0); PG8_SCHED; PG8_LDA(At, 1, 0); PG8_STAGE(PG8_SA(0, 1), a2 + hstep, voffA);
            PG8_WAIT_L(8); PG8_BAR; PG8_WAIT_L(0); PG8_MMA(0, 0, At, B0); PG8_BAR; PG8_SCHED;
            PG8_LDB(B1, 1, 1); PG8_STAGE(PG8_SB(1, 0), b3, voffB);
            PG8_BAR; PG8_WAIT_L(0); PG8_MMA(0, 1, At, B1); PG8_BAR;
            PG8_LDA(At, 1, 1); PG8_STAGE(PG8_SA(1, 0), a3, voffA);
            PG8_BAR; PG8_WAIT_L(0); PG8_MMA(1, 0, At, B0); PG8_BAR; PG8_SCHED;
            PG8_STAGE(PG8_SB(1, 1), b3 + hstep, voffB);
            PG8_WAIT_V(6); PG8_BAR; PG8_MMA(1, 1, At, B1); PG8_BAR;
            }
        }
        if constexpr (ALIGN_EPI) { if (wr == 0) PG8_BAR; }
        if constexpr (!Epi::AFTER_DRAIN) { PG8_EPI_T0; E(acc, cur, wr, wc, fr, fq); S.done(cur); PG8_EPI_T1; }
        if (!has_next) break;
#pragma unroll
        for (int a = 0; a < 2; ++a)
#pragma unroll
            for (int b = 0; b < 2; ++b)
#pragma unroll
                for (int m = 0; m < 4; ++m)
#pragma unroll
                    for (int n = 0; n < 2; ++n) acc[a][b][m][n] = (f32x4){0.f, 0.f, 0.f, 0.f};
        cur = nxt; cA = nA; cB = nB; ++ui;
        if constexpr (ALIGN_EPI) { if (wr == 1) PG8_BAR; }
    }
    PG8_WAIT_V(0);
    if constexpr (!ALIGN_EPI) { if (wr == 0) PG8_BAR; }
    PG8_BAR;
    if constexpr (Epi::AFTER_DRAIN) { E.fused(acc, cur, wr, wc, fr, fq, lds, wid, lane); S.done(cur); }
#undef PG8_SA
#undef PG8_SB
#undef PG8_STAGE
#undef PG8_LDA
#undef PG8_LDB
#undef PG8_MMA
#undef PG8_WAIT_V
#undef PG8_WAIT_L
#undef PG8_BAR
#undef PG8_SCHED
}

}

constexpr size_t MiB = 1u << 20;
constexpr size_t WS_CTL = 0;
constexpr size_t WS_ROPE = 1 * MiB;
constexpr size_t WS_LW2 = 3 * MiB, WS_LA2 = 4 * MiB, WS_LG2 = 5 * MiB;
constexpr size_t WS_BONUS = 6 * MiB;
constexpr size_t ZERO_BYTES = 8 * MiB;
constexpr size_t SCF = (size_t)LTOK * RC * 4, SCB = (size_t)LTOK * RC * 2;
constexpr size_t WS_H = 8 * MiB, WS_WIN = WS_H + (size_t)MPAD * DM * 2;
constexpr size_t WS_KD0 = 8 * MiB, WS_KD1 = WS_KD0 + SCB, WS_B0 = WS_KD1 + SCB, WS_B1 = WS_B0 + SCB, WS_KK = WS_B1 + SCB, WS_RR = WS_KK + SCB;
constexpr size_t WS_WGU = 8 * MiB;
constexpr size_t WS_G = 216 * MiB, WS_A2 = 216 * MiB;
constexpr size_t WS_Q = 344 * MiB, WS_K = 376 * MiB, WS_VT = 385 * MiB, WS_U = 394 * MiB;
constexpr size_t WS_P1 = 344 * MiB;
constexpr size_t WS_Y = 394 * MiB;
constexpr size_t WS_W0 = 506 * MiB, WS_W1 = WS_W0 + SCF;
constexpr size_t WS_WPA = 506 * MiB, WS_WPR = 522 * MiB, WS_WOUT = 538 * MiB, WS_OATT = 570 * MiB;
constexpr size_t WS_VV = 635 * MiB, WS_GG = 668 * MiB;
constexpr size_t WS_BO = 701 * MiB;
constexpr size_t WS_HID = 701 * MiB, WS_MX = 873 * MiB;
constexpr int NB0 = 513, NB1 = 512, NBT = NB0 + NB1;
constexpr int BO_FA = 0, BO_FAA = 4096, BO_FT = 5120, BO_FBP = 5632, BO_FB = 6144, BO_FG = 10240, BO_ITEM = 10496;
constexpr size_t WS_WD = 1030 * MiB, WS_ORWKV = 182 * MiB, WS_END = 1116 * MiB;
static_assert(WS_WIN + (size_t)INWP * DM * 2 <= WS_G && WS_RR + SCB <= WS_G && WS_WGU + (size_t)2 * DFF * DM * 2 <= WS_G, "map: A0");
static_assert(WS_U + (size_t)MPAD * UPITCH * 2 <= WS_W0 && WS_VT + (size_t)KVW * MPAD * 2 <= WS_U && WS_K + (size_t)MPAD * KVW * 2 <= WS_VT && WS_Q + (size_t)SEQ * ATTW * 2 <= WS_K && WS_Y + 2 * SCB <= WS_W0, "map: P1 outputs");
static_assert(WS_W1 + SCF <= WS_VV && WS_OATT + (size_t)SEQ * ATTW * 2 <= WS_VV && WS_VV + SCB <= WS_GG && WS_GG + SCB <= WS_BO && WS_P1 + (size_t)SEQ * DM * 2 <= WS_W0, "map: mid");
static_assert(WS_BO + (size_t)RH * NBT * BO_ITEM <= WS_WD && WS_HID + (size_t)SEQ * DFF * 2 <= WS_MX && WS_MX + (size_t)SEQ * DM * 2 <= WS_WD && WS_WD + (size_t)DM * DFF * 2 <= WS_END && WS_WGU + (size_t)2 * DFF * DM * 2 <= WS_ORWKV && WS_ORWKV + (size_t)SEQ * RC * 2 <= WS_G, "map: tail");
constexpr int CW_BAR = 4096;
constexpr int CW_SS2 = 65536, CW_SS3 = 65536 + 8192;
static_assert((CW_SS3 + 8192) * 4 <= (int)(1 * MiB), "CTL");

constexpr int RING_BYTES = 131072;
constexpr int LDSCTL_OFF = RING_BYTES, MISC_OFF = LDSCTL_OFF + 320;
constexpr int LDS_BYTES = 147456;

#define GAS __attribute__((address_space(1)))
#define LAS __attribute__((address_space(3)))
typedef unsigned short bf16;
typedef unsigned v4u __attribute__((ext_vector_type(4)));
typedef unsigned v2u __attribute__((ext_vector_type(2)));
typedef float f32x4 __attribute__((ext_vector_type(4)));
typedef float f32x2 __attribute__((ext_vector_type(2)));
typedef float f32x16 __attribute__((ext_vector_type(16)));
typedef short bf16x8 __attribute__((ext_vector_type(8)));
typedef GAS unsigned gu32;
#define RLX_AGENT __ATOMIC_RELAXED, __HIP_MEMORY_SCOPE_AGENT
#define LDS_WAIT() asm volatile("s_waitcnt lgkmcnt(0)" ::: "memory")
__device__ __forceinline__ unsigned pk2(float lo, float hi) { return pg8::cvt_pk_bf16(lo, hi); }
__device__ __forceinline__ unsigned f2bf(float f) { return pg8::cvt_pk_bf16(f, 0.f) & 0xffffu; }
__device__ __forceinline__ float bf2f(bf16 b) { return __uint_as_float(((unsigned)b) << 16); }
using pg8::bflo; using pg8::bfhi; using pg8::sigmoidf_;

#define XB_TMO      128
#define XB_XCNT(j)  (256  + 64 * (j))
#define XB_XSUB(j)  (1280 + 64 * (j))
#define XB_XGEN(j)  (2304 + 64 * (j))
#define XB_TOP      3328
#define XB_TOPGEN   3392
#define XCD_BAR_WORDS 3456
#define XB_SPIN_CAP (1u << 18)

__device__ __forceinline__ unsigned xb_ld(unsigned* p)              { return __hip_atomic_load(p, __ATOMIC_RELAXED, __HIP_MEMORY_SCOPE_AGENT); }
__device__ __forceinline__ unsigned xb_add(unsigned* p, unsigned v) { return __hip_atomic_fetch_add(p, v, __ATOMIC_RELAXED, __HIP_MEMORY_SCOPE_AGENT); }
__device__ __forceinline__ unsigned xb_xcc_id() { return (unsigned)__builtin_amdgcn_s_getreg((3 << 11) | 20) & 0xFu; }
#define XB_SPIN(cond, bar) do { unsigned _sp = 0; while (cond) { __builtin_amdgcn_s_sleep(1); \
    if ((++_sp & 255u) == 0u) { if (xb_ld(&(bar)[XB_TMO])) break; if (_sp > XB_SPIN_CAP) { atomicAdd(&(bar)[XB_TMO], 1u); break; } } } } while (0)

struct XcdBarrier {
    unsigned* bar; unsigned x;
    volatile LAS unsigned* st;
};

__device__ __forceinline__ XcdBarrier xcd_barrier_post(unsigned* bar, volatile LAS unsigned* st) {
    XcdBarrier b; b.bar = bar; b.x = xb_xcc_id(); b.st = st;
    if (threadIdx.x == 0) (void)xb_add(&bar[XB_XCNT(b.x)], 1u);
    return b;
}
__device__ __forceinline__ void xcd_barrier_complete(unsigned* bar, unsigned x, unsigned& nloc, unsigned& nx) {
    const unsigned G = gridDim.x * gridDim.y * gridDim.z;
    unsigned sum, cnt, mine, sp = 0u;
    for (;;) {
        sum = 0u; cnt = 0u; mine = 0u;
#pragma unroll
        for (unsigned j = 0; j < 16; ++j) { const unsigned c = xb_ld(&bar[XB_XCNT(j)]); sum += c; cnt += (c > 0u) ? 1u : 0u; mine = (j == x) ? c : mine; }
        if (sum == G) break;
        __builtin_amdgcn_s_sleep(1);
        if ((++sp & 255u) == 0u) { if (xb_ld(&bar[XB_TMO])) break; if (sp > XB_SPIN_CAP) { atomicAdd(&bar[XB_TMO], 1u); break; } }
    }
    nloc = mine > 0u ? mine : 1u; nx = cnt > 0u ? cnt : 1u;
}

__device__ __forceinline__ void xcd_barrier(const XcdBarrier& b) {
    asm volatile("s_waitcnt vmcnt(0)" ::: "memory");
    __syncthreads();
    if (threadIdx.x == 0) {
        unsigned* bar = b.bar;
        __builtin_amdgcn_s_waitcnt(0);
        unsigned nloc = b.st[0], nx = b.st[1];
        if (nloc == 0u) { xcd_barrier_complete(bar, b.x, nloc, nx); b.st[0] = nloc; b.st[1] = nx; }
        const unsigned old = xb_add(&bar[XB_XSUB(b.x)], 1u);
        const unsigned gen = old / nloc;
        if (old + 1u == (gen + 1u) * nloc) {
            __builtin_amdgcn_fence(__ATOMIC_RELEASE, "agent");
            asm volatile("s_waitcnt vmcnt(0)" ::: "memory");
            const unsigned og = xb_add(&bar[XB_TOP], 1u);
            const unsigned tg = og / nx;
            if (og + 1u == (tg + 1u) * nx) xb_add(&bar[XB_TOPGEN], 1u);
            else XB_SPIN(xb_ld(&bar[XB_TOPGEN]) == tg, bar);
            __builtin_amdgcn_fence(__ATOMIC_ACQUIRE, "agent");
            xb_add(&bar[XB_XGEN(b.x)], 1u);
            asm volatile("s_waitcnt vmcnt(0)" ::: "memory");
        } else {
            XB_SPIN(xb_ld(&bar[XB_XGEN(b.x)]) == gen, bar);
            __builtin_amdgcn_fence(__ATOMIC_ACQUIRE, "agent");
            asm volatile("s_waitcnt vmcnt(0)" ::: "memory");
        }
    }
    __syncthreads();
}


struct Frame {
    LAS unsigned char* lds;
    volatile LAS unsigned* MISC;
    gu32* ctl;
    int tid, lane, wave, G;
    unsigned char* ws;
    const float* in[26];
    float* out;
    unsigned long long pb0, pacc, pacc2;
};
#define FPB0(k) do { if ((PROBE_PHASE >> (k)) & 1) F.pb0 = __builtin_amdgcn_s_memrealtime(); } while (0)
#define FPB1(k) do { if ((PROBE_PHASE >> (k)) & 1) F.pacc += __builtin_amdgcn_s_memrealtime() - F.pb0; } while (0)
__device__ __forceinline__ float wave_sum(float v) {
#pragma unroll
    for (int o = 1; o < 64; o <<= 1) v += __shfl_xor(v, o);
    return v;
}

template <int KR> __device__ __forceinline__ void tr_issue(const float* W, int N, int item, int lane, float (&wv)[KR / 2]) {
    const int nblk = N / 32, kb = item / nblk, nb = item % nblk, k0 = KR * kb, n0 = 32 * nb;
#pragma unroll
    for (int i = 0; i < KR / 2; ++i) wv[i] = W[(size_t)(k0 + 2 * i + (lane >> 5)) * N + n0 + (lane & 31)];
}
template <int KR> __device__ __forceinline__ void tr_finish(bf16* WT, int K, int N, const float* kscale, int mode, int item, LAS float* scr, int lane, const float (&wv)[KR / 2]) {
    const int nblk = N / 32, kb = item / nblk, nb = item % nblk, k0 = KR * kb, n0 = 32 * nb;
#pragma unroll
    for (int i = 0; i < KR / 2; ++i) { const int kk = 2 * i + (lane >> 5); float v = wv[i]; if (kscale) v *= kscale[k0 + kk]; scr[kk * 33 + (lane & 31)] = v; }
    LDS_WAIT(); asm volatile("" ::: "memory");
    constexpr int CH = KR / 8;
    const int c = lane & (CH - 1);
#pragma unroll
    for (int jj = 0; jj < CH / 2; ++jj) { const int n = (lane / CH) + (64 / CH) * jj; const LAS float* s = scr + (8 * c) * 33 + n;
        v4u o; o.x = pk2(s[0 * 33], s[1 * 33]); o.y = pk2(s[2 * 33], s[3 * 33]); o.z = pk2(s[4 * 33], s[5 * 33]); o.w = pk2(s[6 * 33], s[7 * 33]);
        const int nn = n0 + n; const int dr = (mode == 0) ? nn : (256 * (nn >> 7) + (nn & 127) + (mode == 2 ? 128 : 0));
        *(GAS v4u*)(WT + (size_t)dr * K + k0 + 8 * c) = o; }
    LDS_WAIT(); asm volatile("" ::: "memory");
}
#define CONV_P4(it, CALL) do { constexpr int I_GU_ = (DM / 64) * (DFF / 32), I_P_ = (ATTW / 64) * (DM / 32); int r_ = (it); \
        if (r_ < I_GU_) { CALL(F.in[22], (bf16*)(F.ws + WS_WGU), DM, DFF, F.in[21], 1, r_); } \
        else if ((r_ -= I_GU_) < I_GU_) { CALL(F.in[23], (bf16*)(F.ws + WS_WGU), DM, DFF, F.in[21], 2, r_); } \
        else if ((r_ -= I_GU_) < I_P_) { CALL(F.in[18], (bf16*)(F.ws + WS_WPA), ATTW, DM, (const float*)nullptr, 0, r_); } \
        else if ((r_ -= I_P_) < I_P_) { CALL(F.in[19], (bf16*)(F.ws + WS_WPR), RC, DM, (const float*)nullptr, 0, r_); } \
        else { r_ -= I_P_; CALL(F.in[20], (bf16*)(F.ws + WS_WOUT), DM, DM, (const float*)nullptr, 0, r_); } } while (0)
constexpr int N_P4_ITEMS = 2 * (DM / 64) * (DFF / 32) + 2 * (ATTW / 64) * (DM / 32) + (DM / 64) * (DM / 32);
constexpr int N_WD_ITEMS = (DFF / 64) * (DM / 32);
constexpr int N_WD_HALF_ITEMS = (DFF / 32) * (DM / 32);
__device__ __forceinline__ void convert_seg(Frame& F, LAS float* scr, int first, int stride, int limit) {
    int it = first; if (it >= limit) return;
    float w0[32], w1[32];
#define CVI0(W_, WT_, K_, N_, ks_, md_, item_) tr_issue<64>(W_, N_, item_, F.lane, w0)
#define CVI1(W_, WT_, K_, N_, ks_, md_, item_) tr_issue<64>(W_, N_, item_, F.lane, w1)
#define CVI2(W_, WT_, K_, N_, ks_, md_, item_) tr_issue<64>(W_, N_, item_, F.lane, w2)
#define CVF(W_, WT_, K_, N_, ks_, md_, item_) tr_finish<64>(WT_, K_, N_, ks_, md_, item_, scr, F.lane, w0)
    CONV_P4(it, CVI0);
    if (it + stride < limit) CONV_P4(it + stride, CVI1);
    for (;;) { const int it2 = it + 2 * stride; float w2[32];
        if (it2 < limit) CONV_P4(it2, CVI2);
        CONV_P4(it, CVF);
        it += stride; if (it >= limit) break;
#pragma unroll
        for (int i = 0; i < 32; ++i) { w0[i] = w1[i]; w1[i] = w2[i]; } }
#undef CVI0
#undef CVI1
#undef CVI2
#undef CVF
}
__device__ __forceinline__ void convert_one(Frame& F, LAS float* scr, const float* W, bf16* WT, int K, int N, int nitems, int first, int stride) {
    int it = first; if (it >= nitems) return;
    float w0[32], w1[32];
    tr_issue<64>(W, N, it, F.lane, w0);
    if (it + stride < nitems) tr_issue<64>(W, N, it + stride, F.lane, w1);
    for (;;) { const int it2 = it + 2 * stride; float w2[32];
        if (it2 < nitems) tr_issue<64>(W, N, it2, F.lane, w2);
        tr_finish<64>(WT, K, N, nullptr, 0, it, scr, F.lane, w0);
        it += stride; if (it >= nitems) break;
#pragma unroll
        for (int i = 0; i < 32; ++i) { w0[i] = w1[i]; w1[i] = w2[i]; } }
}
__device__ __forceinline__ void convert_wd(Frame& F, LAS float* scr, int first, int stride) { convert_one(F, scr, F.in[24], (bf16*)(F.ws + WS_WD), DFF, DM, N_WD_ITEMS, first, stride); }
__device__ __forceinline__ void rms_row_to_bf16(int lane, const float* xrow, const float* w, bf16* orow) {
    const GAS f32x4* xr = (const GAS f32x4*)xrow + lane;
    f32x4 v[16]; float s = 0.f;
#pragma unroll
    for (int j = 0; j < 16; ++j) { v[j] = xr[64 * j]; s += (v[j].x * v[j].x + v[j].y * v[j].y) + (v[j].z * v[j].z + v[j].w * v[j].w); }
    const float rstd = 1.f / sqrtf(wave_sum(s) * (1.f / DM) + RMS_EPS);
    const GAS f32x4* wr = (const GAS f32x4*)w + lane;
    GAS v2u* o8 = (GAS v2u*)orow + lane;
#pragma unroll
    for (int j = 0; j < 16; ++j) { const f32x4 ww = wr[64 * j]; v2u o; o.x = pk2(v[j].x * rstd * ww.x, v[j].y * rstd * ww.y); o.y = pk2(v[j].z * rstd * ww.z, v[j].w * rstd * ww.w); o8[64 * j] = o; }
}
__device__ const double ROPE_INV[16] = {
    1.0000000000000000000000000e+0,
    4.4036660267178047359198331e-1,
    1.9392274474868577334259386e-1,
    8.5397100285765611280149662e-2,
    3.7606030930863935681246092e-2,
    1.6560440080994445548947445e-2,
    7.2926647372171090477661219e-3,
    3.2114459947525910185434889e-3,
    1.4142135623730950488016887e-3,
    6.2277242191459597955502746e-4,
    2.7424817567620731825332265e-4,
    1.2076973741146503832424826e-4,
    5.3182958969449886162502429e-5,
    2.3419998961409341542188076e-5,
    1.0313385377212458859810127e-5,
    4.5416704806078696531998012e-6
};

__device__ __forceinline__ void p0_prologue(Frame& F) {
    LAS float* scr = (LAS float*)(F.lds + F.wave * 16384);
    const int gw = blockIdx.x * 8 + F.wave, NGW = F.G * 8;
    bf16* Wint = (bf16*)(F.ws + WS_WIN); bf16* H = (bf16*)(F.ws + WS_H);
    convert_one(F, scr, F.in[3], Wint, DM, INW, (DM / 64) * (INW / 32), gw, NGW);
    for (int m = gw; m < MPAD + (INWP - INW); m += NGW) {
        if (m < SEQ) rms_row_to_bf16(F.lane, F.in[0] + (size_t)m * DM, F.in[2], H + (size_t)m * DM);
        else if (m < LTOK) rms_row_to_bf16(F.lane, F.in[1] + (size_t)(m - SEQ) * DM, F.in[2], H + (size_t)m * DM);
        else { bf16* row = (m < MPAD) ? H + (size_t)m * DM : Wint + (size_t)(INW + (m - MPAD)) * DM; GAS v4u* o = (GAS v4u*)row + F.lane;
#pragma unroll
            for (int j = 0; j < 8; ++j) o[64 * j] = (v4u){0u, 0u, 0u, 0u}; }
    }
    const int gt = blockIdx.x * 512 + F.tid, NGT = F.G * 512;
    float* rope = (float*)(F.ws + WS_ROPE);
    for (int i = gt; i < LTOK * 16; i += NGT) { const int pos = i >> 4, k = i & 15;
        const double ang = (double)pos * ROPE_INV[k]; const double kq = __builtin_rint(ang * 0.15915494309189535);
        const double red = (ang - kq * 6.28318530717958623) - kq * 2.4492935982947064e-16; const float rf = (float)red;
        rope[2 * i] = cosf(rf); rope[2 * i + 1] = sinf(rf); }
    { bf16* w2t = (bf16*)(F.ws + WS_LW2); bf16* a2t = (bf16*)(F.ws + WS_LA2); bf16* g2t = (bf16*)(F.ws + WS_LG2);
      constexpr int I_L = 3 * (RC / 32), I_G = 8 * (RC / 32);
      for (int it = gw; it < 4 * I_L + I_G; it += NGW) { float wv[16];
          if (it < 4 * I_L) { const int mtx = it / I_L, r = it % I_L, dd = mtx & 1; const float* W = (mtx < 2 ? F.in[8] : F.in[10]) + (size_t)dd * 96 * RC; bf16* WT = (mtx < 2 ? w2t : a2t) + (size_t)dd * RC * 96;
              tr_issue<32>(W, RC, r, F.lane, wv); tr_finish<32>(WT, 96, RC, nullptr, 0, r, scr, F.lane, wv); }
          else { const int r = it - 4 * I_L; tr_issue<32>(F.in[11], RC, r, F.lane, wv); tr_finish<32>(g2t, 256, RC, nullptr, 0, r, scr, F.lane, wv); } } }
}

__device__ __forceinline__ int crow(int r, int hi) { return (r & 3) + 8 * (r >> 2) + 4 * hi; }
__device__ __forceinline__ void attn_phase(Frame& F, const int gw, const int NGW, const int item_lo, const int item_hi) {
    const bf16* Q = (const bf16*)(F.ws + WS_Q); const bf16* K = (const bf16*)(F.ws + WS_K); const bf16* Vt = (const bf16*)(F.ws + WS_VT); bf16* OA = (bf16*)(F.ws + WS_OATT);
    const float* sink = F.in[17];
    const int hh = F.lane >> 5, r = F.lane & 31;
    constexpr float SC = 0.08838834764831845f * 1.4426950408889634f, L2E = 1.4426950408889634f;
    for (int item = item_lo + gw; item < item_hi; item += NGW) {
        const int sub = item & 3, hq = (item >> 2) & 15, qb = item >> 6, q0 = qb * 128 + sub * 32, hk = hq >> 2;
        bf16x8 bq[8];
        { const bf16* qp = Q + (size_t)(q0 + r) * ATTW + hq * 128 + 8 * hh;
#pragma unroll
          for (int s = 0; s < 8; ++s) bq[s] = *(const bf16x8*)(qp + 16 * s); }
        f32x16 O[4];
#pragma unroll
        for (int dt = 0; dt < 4; ++dt)
#pragma unroll
            for (int i = 0; i < 16; ++i) O[dt][i] = 0.f;
        float m = sink[hq] * L2E, l = (hh == 0) ? 1.f : 0.f;
        const int tlo = (q0 >= 128) ? 0 : 4 - q0 / 32, thi = (q0 + 128 + 32 <= SEQ) ? 8 : 4 + (SEQ - 32 - q0) / 32;
        int ti = tlo;
        bf16x8 ak[8];
        { const int key0 = q0 + 32 * (ti - 4); const bf16* kp = K + (size_t)(key0 + r) * KVW + hk * 128 + 8 * hh;
#pragma unroll
          for (int s = 0; s < 8; ++s) ak[s] = *(const bf16x8*)(kp + 16 * s); }
        for (;;) {
            const bool meta = (ti == 9);
            const int key0 = meta ? SEQ : q0 + 32 * (ti - 4);
            const int tn = (ti < thi) ? ti + 1 : 9; const int keyn = (tn == 9) ? SEQ : q0 + 32 * (tn - 4);
            v4u av[4][2]; bf16x8 akn[8];
#pragma unroll
            for (int dt = 0; dt < 4; ++dt) { const bf16* vp = Vt + (size_t)(hk * 128 + 32 * dt + r) * MPAD + key0 + 8 * hh;
#pragma unroll
                for (int s2 = 0; s2 < 2; ++s2) av[dt][s2] = *(const v4u*)(vp + 16 * s2); }
            { const bf16* kp = K + (size_t)(keyn + r) * KVW + hk * 128 + 8 * hh;
#pragma unroll
              for (int s = 0; s < 8; ++s) akn[s] = *(const bf16x8*)(kp + 16 * s); }
            f32x16 st;
#pragma unroll
            for (int i = 0; i < 16; ++i) st[i] = 0.f;
#pragma unroll
            for (int s = 0; s < 8; ++s) st = __builtin_amdgcn_mfma_f32_32x32x16_bf16(ak[s], bq[s], st, 0, 0, 0);
            float tmax = -__builtin_inff();
#pragma unroll
            for (int i = 0; i < 16; ++i) { const int kr = crow(i, hh); bool ok;
                if (meta) ok = kr < NMETA; else { const int dlt = (key0 + kr) - (q0 + r); ok = (dlt >= -128) && (dlt <= 128); }
                const float t = ok ? st[i] * SC : -__builtin_inff(); st[i] = t; tmax = fmaxf(tmax, t); }
            tmax = fmaxf(tmax, __shfl_xor(tmax, 32));
            const float mn = fmaxf(m, tmax), alpha = __builtin_amdgcn_exp2f(m - mn); m = mn;
            float ps = 0.f;
#pragma unroll
            for (int i = 0; i < 16; ++i) { const float p = __builtin_amdgcn_exp2f(st[i] - mn); st[i] = p; ps += p; }
            l = l * alpha + ps;
#pragma unroll
            for (int dt = 0; dt < 4; ++dt)
#pragma unroll
                for (int i = 0; i < 16; ++i) O[dt][i] *= alpha;
            bf16x8 pb[2];
#pragma unroll
            for (int s2 = 0; s2 < 2; ++s2) { v4u w; w.x = pg8::cvt_pk_bf16(st[8 * s2 + 0], st[8 * s2 + 1]); w.y = pg8::cvt_pk_bf16(st[8 * s2 + 2], st[8 * s2 + 3]);
                w.z = pg8::cvt_pk_bf16(st[8 * s2 + 4], st[8 * s2 + 5]); w.w = pg8::cvt_pk_bf16(st[8 * s2 + 6], st[8 * s2 + 7]); pb[s2] = __builtin_bit_cast(bf16x8, w); }
#pragma unroll
            for (int dt = 0; dt < 4; ++dt)
#pragma unroll
                for (int s2 = 0; s2 < 2; ++s2) O[dt] = __builtin_amdgcn_mfma_f32_32x32x16_bf16(__builtin_bit_cast(bf16x8, av[dt][s2]), pb[s2], O[dt], 0, 0, 0);
            if (meta) break;
            ti = tn;
#pragma unroll
            for (int s = 0; s < 8; ++s) ak[s] = akn[s];
        }
        l += __shfl_xor(l, 32);
        const float inv = 1.0f / l;
        bf16* op = OA + (size_t)(q0 + r) * ATTW + hq * 128 + 4 * hh;
#pragma unroll
        for (int dt = 0; dt < 4; ++dt)
#pragma unroll
            for (int g4 = 0; g4 < 4; ++g4) { v2u w; w.x = pg8::cvt_pk_bf16(O[dt][4 * g4 + 0] * inv, O[dt][4 * g4 + 1] * inv); w.y = pg8::cvt_pk_bf16(O[dt][4 * g4 + 2] * inv, O[dt][4 * g4 + 3] * inv);
                *(v2u*)(op + 32 * dt + 8 * g4) = w; }
    }
}

__device__ __forceinline__ int blk_tok(int d, int blk, int u) { return d ? (LTOK - 1 - 16 * blk - u) : (16 * blk + u); }
__device__ __forceinline__ size_t bo_item(int hd, int d, int blk) { return (size_t)(hd * NBT + (d ? NB0 : 0) + blk) * BO_ITEM; }
__device__ __forceinline__ v4u pack8(const float (&x)[8]) { v4u o; o.x = pk2(x[0], x[1]); o.y = pk2(x[2], x[3]); o.z = pk2(x[4], x[5]); o.w = pk2(x[6], x[7]); return o; }
__device__ __forceinline__ void blockprep_item(Frame& F, LAS unsigned char* wl, const int hd, const int d, const int blk, const int j) {
    constexpr int LP = 72;
    LAS bf16* LT = (LAS bf16*)wl; LAS float* GM = (LAS float*)wl;
    const float* Wd = (const float*)(F.ws + (d ? WS_W1 : WS_W0)); const bf16* KDd = (const bf16*)(F.ws + (d ? WS_KD1 : WS_KD0)); const bf16* Bd = (const bf16*)(F.ws + (d ? WS_B1 : WS_B0));
    const bf16* KK = (const bf16*)(F.ws + WS_KK); const bf16* RR = (const bf16*)(F.ws + WS_RR);
    float* BON = (float*)(F.ws + WS_BONUS); unsigned char* BO = F.ws + WS_BO;
    const int hh = j >> 5, r31 = j & 31, c16 = j & 15, c = hd * 64 + j;
    struct Raw { float w[16]; unsigned short kd[16], b[16], kk[16], r[16]; } cur;
#pragma unroll
    for (int u = 0; u < 16; ++u) { const size_t o = (size_t)blk_tok(d, blk, u) * RC + c; cur.w[u] = Wd[o]; cur.kd[u] = KDd[o]; cur.b[u] = Bd[o]; cur.kk[u] = KK[o]; cur.r[u] = RR[o]; }
    float kt[16], rt[16], kdh[16], bh[16]; float G15;
    { float G[16], Gi[16];
      { float g = 1.f;
#pragma unroll
        for (int u = 0; u < 16; ++u) { g *= cur.w[u]; G[u] = g; Gi[u] = __builtin_amdgcn_rcpf(g); } }
      const float rkw = F.in[14][c];
      float bsum = 0.f;
#pragma unroll
      for (int u = 0; u < 16; ++u) { kdh[u] = bf2f(cur.kd[u]); rt[u] = bf2f(cur.r[u]); const float s = wave_sum(rt[u] * kdh[u] * rkw); bsum = (j == u) ? s : bsum;
          kdh[u] = kdh[u] * Gi[u]; rt[u] = rt[u] * G[u]; LT[(0 * 16 + u) * LP + j] = (bf16)f2bf(kdh[u]); LT[(3 * 16 + u) * LP + j] = (bf16)f2bf(rt[u]); }
      if (j < 16) atomicAdd(BON + (size_t)blk_tok(d, blk, j) * RH + hd, bsum);
#pragma unroll
      for (int u = 0; u < 16; ++u) { kt[u] = bf2f(cur.kk[u]) * (u ? G[u - 1] : 1.f); bh[u] = bf2f(cur.b[u]) * Gi[u]; LT[(2 * 16 + u) * LP + j] = (bf16)f2bf(kt[u]); LT[(1 * 16 + u) * LP + j] = (bf16)f2bf(bh[u]); }
      G15 = G[15]; }
    asm volatile("" ::: "memory");
    f32x16 gacc;
#pragma unroll
    for (int i = 0; i < 16; ++i) gacc[i] = 0.f;
    { const LAS bf16* ap = LT + ((r31 < 16 ? 0 : 1) * 16 + (r31 & 15)) * LP + 8 * hh; const LAS bf16* bp = LT + ((r31 < 16 ? 2 : 3) * 16 + (r31 & 15)) * LP + 8 * hh;
#pragma unroll
      for (int s = 0; s < 4; ++s) gacc = __builtin_amdgcn_mfma_f32_32x32x16_bf16(*(const LAS bf16x8*)(ap + 16 * s), *(const LAS bf16x8*)(bp + 16 * s), gacc, 0, 0, 0); }
    float ga[16];
#pragma unroll
    for (int i = 0; i < 16; ++i) ga[i] = gacc[i];
    asm volatile("s_waitcnt lgkmcnt(0)" ::: "memory");
#pragma unroll
    for (int i = 0; i < 16; ++i) { const int row = crow(i, hh), m = row & 15, u = r31 & 15; const bool strict = (r31 < 16);
        GM[row * 32 + r31] = (strict ? (m < u) : (m <= u)) ? ga[i] : 0.f; }
#define RL(x, ln) __builtin_bit_cast(float, __builtin_amdgcn_readlane(__builtin_bit_cast(int, (x)), (ln)))
#define GREG(m) (4 * ((m) >> 3) + ((m) & 3))
#define GLN(m) (32 * (((m) >> 2) & 1))
#define B_(m, u)  RL(ga[8 + GREG(m)], (u) + GLN(m))
    float Tr[16];
#pragma unroll
    for (int m = 15; m >= 0; --m) { float s = (c16 == m) ? 1.f : 0.f;
#pragma unroll
        for (int u = m + 1; u < 16; ++u) s -= B_(m, u) * Tr[u];
        Tr[m] = s; }
#undef RL
#undef GREG
#undef GLN
#undef B_
    unsigned char* base = BO + bo_item(hd, d, blk);
    { const int a = j >> 5, jp = j & 31;
#pragma unroll
      for (int h2 = 0; h2 < 2; ++h2) { float x0[8], x1[8];
#pragma unroll
          for (int e = 0; e < 8; ++e) { x0[e] = -bh[8 * (e >> 2) + 4 * h2 + (e & 3)] * G15; x1[e] = kdh[8 * h2 + e] * G15; }
          *(v4u*)(base + BO_FB + ((a * 2 + 0) * 64 + jp + 32 * h2) * 16) = pack8(x0); *(v4u*)(base + BO_FB + ((a * 2 + 1) * 64 + jp + 32 * h2) * 16) = pack8(x1); } }
    *(float*)(base + BO_FG + 4 * j) = G15;
    { float x[8];
#pragma unroll
      for (int e = 0; e < 8; ++e) x[e] = GM[(8 * hh + e) * 32 + r31];
      *(v4u*)(base + BO_FAA + j * 16) = pack8(x); }
    if (r31 < 16) { float x[8];
#pragma unroll
        for (int e = 0; e < 8; ++e) { const float t0 = Tr[8 * (e >> 2) + (e & 3)], t1 = Tr[8 * (e >> 2) + 4 + (e & 3)]; x[e] = hh ? t1 : t0; }
        *(v4u*)(base + BO_FT + (hh * 16 + r31) * 16) = pack8(x); }
    else { float x[8];
#pragma unroll
        for (int e = 0; e < 8; ++e) x[e] = -GM[(16 + 8 * (e >> 2) + 4 * hh + (e & 3)) * 32 + r31];
        *(v4u*)(base + BO_FBP + (hh * 16 + (r31 - 16)) * 16) = pack8(x); }
    asm volatile("s_waitcnt lgkmcnt(0)" ::: "memory");
#pragma unroll
    for (int u = 0; u < 16; ++u) { LT[u * LP + j] = (bf16)f2bf(kt[u]); LT[(16 + u) * LP + j] = (bf16)f2bf(rt[u]); }
#pragma unroll
    for (int ks = 0; ks < 4; ++ks) { const int j0 = 32 * (ks >> 1) + 16 * (ks & 1) + 4 * hh; const v2u lo = *(const LAS v2u*)(LT + r31 * LP + j0), hi = *(const LAS v2u*)(LT + r31 * LP + j0 + 8);
        *(v4u*)(base + BO_FA + (ks * 64 + j) * 16) = (v4u){lo.x, lo.y, hi.x, hi.y}; }
    asm volatile("" ::: "memory");
}

__device__ __forceinline__ int tok2row(int t) { return t < NMETA ? SEQ + t : t - NMETA; }
struct Sh8 { v4u uc, up, un; };
__device__ __forceinline__ Sh8 shift8_ld(const bf16* U, int t, int col) {
    const int tc = t < LTOK ? t : LTOK - 1, tp = (t >= 1 && t - 1 < LTOK) ? t - 1 : 0, tn = t + 1 < LTOK ? t + 1 : LTOK - 1;
    Sh8 s; s.uc = *(const v4u*)(U + (size_t)tok2row(tc) * UPITCH + col); s.up = *(const v4u*)(U + (size_t)tok2row(tp) * UPITCH + col); s.un = *(const v4u*)(U + (size_t)tok2row(tn) * UPITCH + col); return s; }
__device__ __forceinline__ void shift8_fin(const Sh8& s, int t, int col, const float* mu_p, const float* mu_n, float (&x)[8]) {
    const v4u zz = {0u, 0u, 0u, 0u};
    const v4u uc = t < LTOK ? s.uc : zz, up = (t >= 1 && t - 1 < LTOK) ? s.up : zz, un = t + 1 < LTOK ? s.un : zz;
    const f32x4 mp0 = *(const f32x4*)(mu_p + col), mp1 = *(const f32x4*)(mu_p + col + 4), mn0 = *(const f32x4*)(mu_n + col), mn1 = *(const f32x4*)(mu_n + col + 4);
    const unsigned ucw[4] = {uc.x, uc.y, uc.z, uc.w}, upw[4] = {up.x, up.y, up.z, up.w}, unw[4] = {un.x, un.y, un.z, un.w};
    const float mpw[8] = {mp0[0], mp0[1], mp0[2], mp0[3], mp1[0], mp1[1], mp1[2], mp1[3]}, mnw[8] = {mn0[0], mn0[1], mn0[2], mn0[3], mn1[0], mn1[1], mn1[2], mn1[3]};
#pragma unroll
    for (int e = 0; e < 8; ++e) { const float c0 = (e & 1) ? bfhi(ucw[e >> 1]) : bflo(ucw[e >> 1]), p0 = (e & 1) ? bfhi(upw[e >> 1]) : bflo(upw[e >> 1]), n0 = (e & 1) ? bfhi(unw[e >> 1]) : bflo(unw[e >> 1]);
        x[e] = c0 + mpw[e] * (p0 - c0) + mnw[e] * (n0 - c0); }
}
__device__ __forceinline__ void flush_bf16(const LAS bf16* tile, bf16* ARR, int t0, int cbase, int lane) {
#pragma unroll
    for (int h = 0; h < 2; ++h) { const int row = (lane >> 2) + 16 * h, ch = lane & 3; const v4u v = *(const LAS v4u*)(tile + row * 32 + 8 * ch);
        if (t0 + row < LTOK) *(v4u*)(ARR + (size_t)(t0 + row) * RC + cbase + 8 * ch) = v; }
}
__device__ __forceinline__ void flush_f32(const LAS float* tile, float* ARR, int t0, int cbase, int lane) {
#pragma unroll
    for (int h = 0; h < 4; ++h) { const int row = (lane >> 3) + 8 * h, ch = lane & 7; const f32x4 v = *(const LAS f32x4*)(tile + row * 32 + 4 * ch);
        if (t0 + row < LTOK) *(f32x4*)(ARR + (size_t)(t0 + row) * RC + cbase + 4 * ch) = v; }
}
constexpr int CW_TAIL = 3072;
__device__ __forceinline__ void tail_wait(Frame& F, const bool leader) {
    const unsigned need = (unsigned)(F.G < RH ? F.G : RH);
    if (leader) { unsigned sp = 0; while (__hip_atomic_load((unsigned*)(F.ctl + CW_TAIL), __ATOMIC_RELAXED, __HIP_MEMORY_SCOPE_AGENT) < need) { __builtin_amdgcn_s_sleep(2); if (++sp > (1u << 22)) break; } }
    __builtin_amdgcn_fence(__ATOMIC_ACQUIRE, "agent");
}
__device__ __forceinline__ void prep_phase(Frame& F, const XcdBarrier& bar) {
    constexpr int XS = 648;
    LAS bf16* Xs = (LAS bf16*)F.lds;
    LAS unsigned char* wl = F.lds + 41472 + F.wave * 9216;
    LAS bf16* Kt = (LAS bf16*)wl;
    LAS bf16* Ot = Kt + 2048;
    const bf16* U = (const bf16*)(F.ws + WS_U);
    const float* mu_p = F.in[5]; const float* mu_n = F.in[6];
    const bf16* w2t = (const bf16*)(F.ws + WS_LW2); const bf16* a2t = (const bf16*)(F.ws + WS_LA2); const bf16* g2t = (const bf16*)(F.ws + WS_LG2);
    float* W0 = (float*)(F.ws + WS_W0); float* W1 = (float*)(F.ws + WS_W1);
    bf16* KD0 = (bf16*)(F.ws + WS_KD0); bf16* KD1 = (bf16*)(F.ws + WS_KD1); bf16* B0 = (bf16*)(F.ws + WS_B0); bf16* B1 = (bf16*)(F.ws + WS_B1);
    bf16* KK = (bf16*)(F.ws + WS_KK); bf16* RR = (bf16*)(F.ws + WS_RR); bf16* VV = (bf16*)(F.ws + WS_VV); bf16* GG = (bf16*)(F.ws + WS_GG);
    const int hh = F.lane >> 5, r = F.lane & 31;
    const int nreg = ((int)blockIdx.x < 1024) ? (1024 - (int)blockIdx.x + F.G - 1) / F.G : 0, ntail = ((int)blockIdx.x < RH) ? (RH - (int)blockIdx.x + F.G - 1) / F.G : 0;
    for (int ui = 0; ui < nreg + ntail; ++ui) {
        if (ui == nreg && !MK_SPLIT) xcd_barrier(bar);
        const bool tail = ui >= nreg; const int unit = (int)blockIdx.x + ui * F.G;
        const int tt = tail ? 256 : (unit >> 2), t0 = tt * 32, hd = tail ? (int)blockIdx.x + (ui - nreg) * F.G : (unit & 3) * 8 + F.wave;
        const bool act = !tail || F.wave < 4; const int tpart = tail ? (F.wave >> 1) : -1;
        __syncthreads();
        FPB0(15);
        { Sh8 sx[5];
#pragma unroll
          for (int it = 0; it < 5; ++it) { const int ci = F.tid + 512 * it; sx[it] = shift8_ld(U, t0 + ci / 80, 3 * RC + 8 * (ci % 80)); }
#pragma unroll
          for (int it = 0; it < 5; ++it) { const int ci = F.tid + 512 * it, tl = ci / 80, ch = ci % 80;
            float x[8]; shift8_fin(sx[it], t0 + tl, 3 * RC + 8 * ch, mu_p, mu_n, x);
#pragma unroll
            for (int e = 0; e < 8; ++e) { float v = x[e];
                if (ch < 24) { const float ex = __expf(2.0f * v); v = 1.0f - 2.0f / (ex + 1.0f); }
                else if (ch >= 48) v = sigmoidf_(v);
                x[e] = v; }
            v4u o; o.x = pk2(x[0], x[1]); o.y = pk2(x[2], x[3]); o.z = pk2(x[4], x[5]); o.w = pk2(x[6], x[7]);
            *(LAS v4u*)(Xs + tl * XS + 8 * ch) = o; } }
        if (act) { const int c8 = hd * 64 + 8 * (F.lane & 7);
#pragma unroll
          for (int st = 0; st < 3; ++st) { const int col = (st == 0 ? RC : st == 1 ? 0 : 2 * RC) + c8; Sh8 sq[4];
#pragma unroll
            for (int q = 0; q < 4; ++q) sq[q] = shift8_ld(U, t0 + (F.lane >> 3) + 8 * q, col);
#pragma unroll
            for (int q = 0; q < 4; ++q) { const int tl = (F.lane >> 3) + 8 * q, tq = t0 + tl; float x[8]; shift8_fin(sq[q], tq, col, mu_p, mu_n, x);
                v4u o; o.x = pk2(x[0], x[1]); o.y = pk2(x[2], x[3]); o.z = pk2(x[4], x[5]); o.w = pk2(x[6], x[7]);
                if (st == 0) *(LAS v4u*)(Kt + tl * 64 + 8 * (F.lane & 7)) = o;
                else if (tq < LTOK) *(v4u*)((st == 1 ? RR : VV) + (size_t)tq * RC + c8) = o; } } }
        __syncthreads();
        FPB1(15); FPB0(16);
        if (act) {
        float kp[2][16], ss[16];
#pragma unroll
        for (int i = 0; i < 16; ++i) ss[i] = 0.f;
#pragma unroll
        for (int ct = 0; ct < 2; ++ct) { const int c = hd * 64 + 32 * ct + r; const float kkw = F.in[12][c];
#pragma unroll
            for (int i = 0; i < 16; ++i) { kp[ct][i] = bf2f(Kt[crow(i, hh) * 64 + 32 * ct + r]); const float kr = kp[ct][i] * kkw; ss[i] += kr * kr; } }
#pragma unroll
        for (int i = 0; i < 16; ++i) {
#pragma unroll
            for (int o = 1; o < 32; o <<= 1) ss[i] += __shfl_xor(ss[i], o);
            ss[i] = 1.0f / fmaxf(sqrtf(ss[i]), 1e-12f); }
#define LDF(dst, ptr, n) do { _Pragma("unroll") for (int s_ = 0; s_ < (n); ++s_) dst[s_] = *(const bf16x8*)((ptr) + 16 * s_); } while (0)
#define MMF(frag, xoff, n) do { _Pragma("unroll") for (int i_ = 0; i_ < 16; ++i_) acc[i_] = 0.f; const LAS bf16* ap_ = Xs + r * XS + (xoff) + 8 * hh; \
            _Pragma("unroll") for (int s_ = 0; s_ < (n); ++s_) acc = __builtin_amdgcn_mfma_f32_32x32x16_bf16(*(const LAS bf16x8*)(ap_ + 16 * s_), frag[s_], acc, 0, 0, 0); } while (0)
#pragma unroll
        for (int ct = 0; ct < 2; ++ct) {
            if (tail && ct != (F.wave & 1)) continue;
            const int c = hd * 64 + 32 * ct + r, cb = hd * 64 + 32 * ct;
            const float kkw = F.in[12][c], kaw = F.in[13][c];
            const bf16* pa0 = a2t + (size_t)c * 96 + 8 * hh; const bf16* pa1 = a2t + ((size_t)RC + c) * 96 + 8 * hh;
            const bf16* pw0 = w2t + (size_t)c * 96 + 8 * hh; const bf16* pw1 = w2t + ((size_t)RC + c) * 96 + 8 * hh; const bf16* pg = g2t + (size_t)c * 256 + 8 * hh;
            bf16x8 fa[6], fg[16]; f32x16 acc; float kk[16];
            LDF(fa, (tpart == 1 ? pw0 : pa0), 6);
            if (tpart != 1) {
#pragma unroll
            for (int i = 0; i < 16; ++i) { kk[i] = kp[ct][i] * kkw * ss[i]; Ot[crow(i, hh) * 32 + r] = (bf16)f2bf(kk[i]); }
            flush_bf16(Ot, KK, t0, cb, F.lane);
#pragma unroll
            for (int d = 0; d < 2; ++d) {
                if (d == 0) { MMF(fa, 192, 6); LDF(fa, pa1, 6); } else { MMF(fa, 288, 6); LDF(fa, pw0, 6); }
                const float a0 = F.in[9][d * RC + c];
#pragma unroll
                for (int i = 0; i < 16; ++i) { acc[i] = sigmoidf_(a0 + acc[i]); Ot[crow(i, hh) * 32 + r] = (bf16)f2bf(kp[ct][i] * (1.0f + (acc[i] - 1.0f) * kaw)); }
                flush_bf16(Ot, d ? KD1 : KD0, t0, cb, F.lane);
#pragma unroll
                for (int i = 0; i < 16; ++i) Ot[crow(i, hh) * 32 + r] = (bf16)f2bf(kk[i] * acc[i]);
                flush_bf16(Ot, d ? B1 : B0, t0, cb, F.lane);
            }
            }
            if (tpart != 0) {
#pragma unroll
            for (int d = 0; d < 2; ++d) {
                if (d == 0) { MMF(fa, 0, 6); LDF(fa, pw1, 6); } else { MMF(fa, 96, 6); LDF(fg, pg, 16); }
                const float w0 = F.in[7][d * RC + c]; LAS float* Of = (LAS float*)Ot;
#pragma unroll
                for (int i = 0; i < 16; ++i) Of[crow(i, hh) * 32 + r] = __expf(-0.6065306597126334f * sigmoidf_(w0 + acc[i]));
                flush_f32(Of, d ? W1 : W0, t0, cb, F.lane);
            }
            MMF(fg, 384, 16);
#pragma unroll
            for (int i = 0; i < 16; ++i) Ot[crow(i, hh) * 32 + r] = (bf16)f2bf(acc[i]);
            flush_bf16(Ot, GG, t0, cb, F.lane);
            }
        }
#undef LDF
#undef MMF
        asm volatile("s_waitcnt vmcnt(0) lgkmcnt(0)" ::: "memory");
        }
        if (tail) __syncthreads();
        if (act) {
#pragma unroll 1
        for (int q = 0; q < 4; ++q) { const int d = q >> 1, half = q & 1; const int blk = d ? (NB1 - 2 * tt - half) : (2 * tt + half);
            if (tail && q != 2 * F.wave) continue;
            int lzq; asm volatile("v_mov_b32 %0, 0" : "=v"(lzq));
            if (blk >= 0 && blk < (d ? NB1 : NB0)) blockprep_item(F, wl, hd, d, blk, F.lane + lzq); }
        }
        FPB1(16);
    }
    if (ntail == 0) { if (!MK_SPLIT) xcd_barrier(bar); }
    else {
        asm volatile("s_waitcnt vmcnt(0)" ::: "memory");
        __syncthreads();
        if (F.tid == 0) { __builtin_amdgcn_fence(__ATOMIC_RELEASE, "agent"); asm volatile("s_waitcnt vmcnt(0)" ::: "memory");
            __hip_atomic_fetch_add((unsigned*)(F.ctl + CW_TAIL), 1u, __ATOMIC_RELAXED, __HIP_MEMORY_SCOPE_AGENT); }
    }
    __syncthreads();
}

constexpr int N_SCAN_WAVES = 64;
constexpr int SR_SLOTS = 8, SR_STRIDE = 13312, SR_FV = 11264, SR_FLAGS = SR_SLOTS * SR_STRIDE, SR_WSCR = SR_FLAGS + 512, SR_NL = 4, SR_NS = 2, SR_NSET = 3;
static_assert(SR_WSCR + (8 - SR_NS - SR_NL) * 8448 <= RING_BYTES, "scan phase LDS map");
typedef unsigned short us2_t __attribute__((ext_vector_type(2)));
struct LdSet { v4u p[11]; us2_t v[2][4]; };
__device__ __forceinline__ void sr_issue(LdSet& s, const unsigned char* item, const bf16* VV, int hd, int d, int blk, int lane) {
#pragma unroll
    for (int k = 0; k < 11; ++k) { const int pc = k * 64 + lane; s.p[k] = *(const v4u*)(item + (pc < BO_ITEM / 16 ? pc : BO_ITEM / 16 - 1) * 16); }
    const int hh = lane >> 5, il = lane & 31;
#pragma unroll
    for (int e = 0; e < 8; ++e) { const unsigned short* vr = (const unsigned short*)VV + (size_t)blk_tok(d, blk, 8 * hh + e) * RC + hd * 64 + il; s.v[0][e >> 1][e & 1] = vr[0]; s.v[1][e >> 1][e & 1] = vr[32]; }
}
__device__ __forceinline__ void sr_write(const LdSet& s, LAS unsigned char* slot, int lane) {
#pragma unroll
    for (int k = 0; k < 11; ++k) *(LAS v4u*)(slot + (k * 64 + lane) * 16) = s.p[k];
#pragma unroll
    for (int h = 0; h < 2; ++h) { const v4u vw = {__builtin_bit_cast(unsigned, s.v[h][0]), __builtin_bit_cast(unsigned, s.v[h][1]), __builtin_bit_cast(unsigned, s.v[h][2]), __builtin_bit_cast(unsigned, s.v[h][3])};
        *(LAS v4u*)(slot + SR_FV + 1024 * h + lane * 16) = vw; }
}
__device__ __forceinline__ bf16x8 pack_half(const f32x16& x, int s) {
    const v4u w = {pk2(x[8 * s + 0], x[8 * s + 1]), pk2(x[8 * s + 2], x[8 * s + 3]), pk2(x[8 * s + 4], x[8 * s + 5]), pk2(x[8 * s + 6], x[8 * s + 7])}; return __builtin_bit_cast(bf16x8, w); }
__device__ __forceinline__ void scan_phase(Frame& F) {
    const bf16* VV = (const bf16*)(F.ws + WS_VV); bf16* Y = (bf16*)(F.ws + WS_Y); const unsigned char* BO = F.ws + WS_BO;
    const bool sblock = (int)blockIdx.x < N_SCAN_WAVES;
    volatile LAS unsigned* FL = (volatile LAS unsigned*)(F.lds + SR_FLAGS);
    constexpr unsigned SPIN_CAP = 1u << 22;
    __syncthreads();
    if (F.tid < 128) FL[F.tid] = 0u;
    if (sblock) tail_wait(F, F.tid == 0);
    __syncthreads();
    const int pair = (int)blockIdx.x, ih = F.wave & 1, hd = pair >> 1, d = pair & 1, nblk = d ? NB1 : NB0, hh = F.lane >> 5, il = F.lane & 31;
    if (sblock && F.wave < SR_NS) {
        __builtin_amdgcn_s_setprio(3);
        f32x16 St[2];
#pragma unroll
        for (int a = 0; a < 2; ++a)
#pragma unroll
            for (int i = 0; i < 16; ++i) St[a][i] = 0.f;
        FPB0(17);
        const unsigned long long scan_t0 = ((PROBE_PHASE >> 21) & 1) ? __builtin_amdgcn_s_memrealtime() : 0ull;
        bf16x8 efa[4], efaa, evf, eft, efbp;
#define SC_EARLY(fa_, faa_, vf_, ft_, fbp_, slot_) do { _Pragma("unroll") for (int ks = 0; ks < 4; ++ks) fa_[ks] = *(const LAS bf16x8*)((slot_) + BO_FA + (ks * 64 + F.lane) * 16); \
            faa_ = *(const LAS bf16x8*)((slot_) + BO_FAA + F.lane * 16); vf_ = *(const LAS bf16x8*)((slot_) + SR_FV + 1024 * ih + F.lane * 16); \
            ft_ = *(const LAS bf16x8*)((slot_) + BO_FT + (hh * 16 + (il & 15)) * 16); fbp_ = *(const LAS bf16x8*)((slot_) + BO_FBP + (hh * 16 + (il & 15)) * 16); } while (0)
        { unsigned sp = 0; while (FL[0] != 1u) { __builtin_amdgcn_s_sleep(1); if (++sp > SPIN_CAP) break; } }
        asm volatile("" ::: "memory");
        SC_EARLY(efa, efaa, evf, eft, efbp, F.lds);
        asm volatile("" ::: "memory");
        unsigned fnext = FL[(1 < nblk ? 1 : 0) % SR_SLOTS];
        const unsigned ylane = (unsigned)((d ? (1 - hh) : hh) * 4 * RC + il);
        const int uih = __builtin_amdgcn_readfirstlane(ih);
        for (int blk = 0; blk < nblk; ++blk) {
            const int sl = blk % SR_SLOTS; const LAS unsigned char* slot = F.lds + sl * SR_STRIDE;
            const int nb = blk + 1 < nblk ? blk + 1 : blk, sln = nb % SR_SLOTS; const LAS unsigned char* slotn = F.lds + sln * SR_STRIDE;
            if (fnext != (unsigned)(nb + 1)) { unsigned sp = 0; while (FL[sln] != (unsigned)(nb + 1)) { __builtin_amdgcn_s_sleep(1); if (++sp > SPIN_CAP) break; } }
            asm volatile("" ::: "memory");
            bf16x8 fb[2][2]; f32x4 gm[2][4];
#pragma unroll
            for (int a = 0; a < 2; ++a)
#pragma unroll
                for (int k = 0; k < 2; ++k) fb[a][k] = *(const LAS bf16x8*)(slot + BO_FB + ((a * 2 + k) * 64 + F.lane) * 16);
#pragma unroll
            for (int a = 0; a < 2; ++a)
#pragma unroll
                for (int q = 0; q < 4; ++q) gm[a][q] = *(const LAS f32x4*)(slot + BO_FG + (32 * a + 8 * q + 4 * hh) * 4);
            bf16x8 nfa[4], nfaa, nvf, nft, nfbp;
            SC_EARLY(nfa, nfaa, nvf, nft, nfbp, slotn);
            asm volatile("" ::: "memory");
            { const int nb2 = blk + 2 < nblk ? blk + 2 : nblk - 1; fnext = FL[nb2 % SR_SLOTS]; }
            if (F.lane == 0) FL[16 + ih] = (unsigned)(blk + 1);
            asm volatile("" ::: "memory");
            bf16x8 ft = eft, fbp = efbp;
            { const bf16x8 zz = {0, 0, 0, 0, 0, 0, 0, 0}; ft = (il < 16) ? ft : zz; fbp = (il >= 16) ? fbp : zz; }
            f32x16 acc, accp;
#pragma unroll
            for (int i = 0; i < 16; ++i) { acc[i] = 0.f; accp[i] = 0.f; }
            acc = __builtin_amdgcn_mfma_f32_32x32x16_bf16(efaa, evf, acc, 0, 0, 0);
#pragma unroll
            for (int a = 0; a < 2; ++a)
#pragma unroll
                for (int s = 0; s < 2; ++s) acc = __builtin_amdgcn_mfma_f32_32x32x16_bf16(efa[2 * a + s], pack_half(St[a], s), acc, 0, 0, 0);
            accp = __builtin_amdgcn_mfma_f32_32x32x16_bf16(ft, pack_half(acc, 0), accp, 0, 0, 0);
            const bf16x8 pb = pack_half(accp, 0);
            acc = __builtin_amdgcn_mfma_f32_32x32x16_bf16(fbp, pb, acc, 0, 0, 0);
#pragma unroll
            for (int e = 0; e < 8; ++e) { const int ce = 8 * (e >> 2) + (e & 3);
                bf16* yb = Y + ((size_t)d * LTOK + (d ? (LTOK - 1 - 16 * blk - ce - 4) : (16 * blk + ce))) * RC + hd * 64 + 32 * uih;
                yb[ylane] = (bf16)f2bf(acc[8 + e]); }
#pragma unroll
            for (int a = 0; a < 2; ++a) {
#pragma unroll
                for (int i = 0; i < 16; ++i) St[a][i] *= gm[a][i >> 2][i & 3];
                St[a] = __builtin_amdgcn_mfma_f32_32x32x16_bf16(fb[a][0], pb, St[a], 0, 0, 0);
                St[a] = __builtin_amdgcn_mfma_f32_32x32x16_bf16(fb[a][1], evf, St[a], 0, 0, 0);
            }
#pragma unroll
            for (int ks = 0; ks < 4; ++ks) efa[ks] = nfa[ks];
            efaa = nfaa; evf = nvf; eft = nft; efbp = nfbp;
        }
#undef SC_EARLY
        FPB1(17);
        if ((PROBE_PHASE >> 21) & 1) { if (F.lane == 0) atomicMax((unsigned*)(F.ctl + 2048), (unsigned)(__builtin_amdgcn_s_memrealtime() - scan_t0)); }
        __builtin_amdgcn_s_setprio(0);
    } else if (sblock && F.wave < SR_NS + SR_NL) {
        const int lw = F.wave - SR_NS;
        LdSet st[SR_NSET];
#define SR_PUT(set, b_) do { const int sl_ = (b_) % SR_SLOTS; if ((b_) >= SR_SLOTS) { unsigned sp_ = 0; while (FL[16] < (unsigned)((b_) - SR_SLOTS + 1) || FL[17] < (unsigned)((b_) - SR_SLOTS + 1)) { __builtin_amdgcn_s_sleep(1); if (++sp_ > SPIN_CAP) break; } } \
            asm volatile("" ::: "memory"); sr_write(set, F.lds + sl_ * SR_STRIDE, F.lane); asm volatile("s_waitcnt lgkmcnt(0)" ::: "memory"); if (F.lane == 0) FL[sl_] = (unsigned)((b_) + 1); } while (0)
#pragma unroll
        for (int k = 0; k < SR_NSET; ++k) { const int bb = lw + SR_NL * k; if (bb < nblk) sr_issue(st[k], BO + bo_item(hd, d, bb), VV, hd, d, bb, F.lane); }
        for (int b0 = lw; b0 < nblk; b0 += SR_NSET * SR_NL) {
#pragma unroll
            for (int k = 0; k < SR_NSET; ++k) { const int bb = b0 + SR_NL * k; if (bb < nblk) { SR_PUT(st[k], bb); const int nb = bb + SR_NSET * SR_NL; if (nb < nblk) sr_issue(st[k], BO + bo_item(hd, d, nb), VV, hd, d, nb, F.lane); } }
        }
#undef SR_PUT
    } else {
        const int b = (int)blockIdx.x, nsb = F.G < N_SCAN_WAVES ? F.G : N_SCAN_WAVES, wps = 8 - SR_NS - SR_NL;
        const int widx = b < N_SCAN_WAVES ? b * wps + (F.wave - SR_NS - SR_NL) : nsb * wps + (b - N_SCAN_WAVES) * 8 + F.wave;
        const int NWK = nsb * wps + (F.G - nsb) * 8;
        unsigned long long rp0 = 0, rp1 = 0, rp2 = 0;
        if (PROBE_PHASE & ((3 << 18) | (1 << 22) | (1 << 26))) rp0 = __builtin_amdgcn_s_memrealtime();
        LAS float* scr = (LAS float*)(F.lds + (sblock ? SR_WSCR + (F.wave - SR_NS - SR_NL) * 8448 : F.wave * 8448));
        { const int NSBW = nsb * wps, NPLW = (F.G - nsb) * 8, pidx = (b - N_SCAN_WAVES) * 8 + F.wave;
          const int A_SB = NPLW > 0 ? 64 : 4096;
          if (sblock) attn_phase(F, widx, NSBW, 0, A_SB);
          else {
              attn_phase(F, pidx, NPLW, A_SB, 4096);
              const int R = (4096 - A_SB) % NPLW, NL = NPLW - R;
              const int xA = (N_P4_ITEMS - NL * 12) / NPLW, segA = (R > 0 && xA > 0) ? xA * NPLW : N_P4_ITEMS;
              tail_wait(F, F.lane == 0);
              convert_seg(F, scr, pidx, NPLW, segA);
              if (segA < N_P4_ITEMS && pidx >= R) convert_seg(F, scr, segA + pidx - R, NL, N_P4_ITEMS);
          } }
        if (PROBE_PHASE & (3 << 18)) rp1 = __builtin_amdgcn_s_memrealtime();
        if (PROBE_PHASE & (3 << 18)) { rp2 = __builtin_amdgcn_s_memrealtime(); if ((((PROBE_PHASE >> 25) & 1) ? (blockIdx.x == 0 && F.wave == 6 && F.lane == 0) : ((int)blockIdx.x == F.G - 1 && F.tid == 0))) { unsigned long long v = 0; if ((PROBE_PHASE >> 18) & 1) v += rp1 - rp0; if ((PROBE_PHASE >> 19) & 1) v += rp2 - rp1;
            __hip_atomic_store((unsigned*)(F.ctl + 2048), (unsigned)v, __ATOMIC_RELAXED, __HIP_MEMORY_SCOPE_AGENT); } }
        if ((PROBE_PHASE >> 26) & 1) { if (F.lane == 0 && ((PROBE_PHASE >> 27) & 1 ? sblock : (!sblock && (((PROBE_PHASE >> 28) & 1) ? widx >= 768 : true) && (((PROBE_PHASE >> 29) & 1) ? (b & 7) == 0 : true)))) atomicMax((unsigned*)(F.ctl + 2048), (unsigned)(__builtin_amdgcn_s_memrealtime() - rp0)); }
        if ((PROBE_PHASE >> 22) & 1) { if (blockIdx.x == 0 && F.wave == 6 && F.lane == 0) __hip_atomic_store((unsigned*)(F.ctl + 2048), (unsigned)(__builtin_amdgcn_s_memrealtime() - rp0), __ATOMIC_RELAXED, __HIP_MEMORY_SCOPE_AGENT); }
    }
}

__device__ __forceinline__ float row16_sum(float x) {
    x += __builtin_bit_cast(float, __builtin_amdgcn_update_dpp(0, __builtin_bit_cast(int, x), 0xB1, 0xf, 0xf, true));
    x += __builtin_bit_cast(float, __builtin_amdgcn_update_dpp(0, __builtin_bit_cast(int, x), 0x4E, 0xf, 0xf, true));
    x += __builtin_bit_cast(float, __builtin_amdgcn_update_dpp(0, __builtin_bit_cast(int, x), 0x141, 0xf, 0xf, true));
    x += __builtin_bit_cast(float, __builtin_amdgcn_update_dpp(0, __builtin_bit_cast(int, x), 0x140, 0xf, 0xf, true));
    return x;
}
__device__ __forceinline__ void combine_phase(Frame& F) {
    const bf16* Y0 = (const bf16*)(F.ws + WS_Y); const bf16* Y1 = Y0 + (size_t)LTOK * RC; const float* BON = (const float*)(F.ws + WS_BONUS);
    const bf16* VV = (const bf16*)(F.ws + WS_VV); const bf16* GG = (const bf16*)(F.ws + WS_GG);
    bf16* OR = (bf16*)(F.ws + WS_ORWKV);
    const float* lnw = F.in[15]; const float* lnb = F.in[16];
    const int gw = blockIdx.x * 8 + F.wave, NGW = F.G * 8;
#define COMB_ROW(a0, a1, vv, gg, bon, row_) do { \
            float y[4] = {bflo(a0.x) + bflo(a1.x), bfhi(a0.x) + bfhi(a1.x), bflo(a0.y) + bflo(a1.y), bfhi(a0.y) + bfhi(a1.y)}; \
            const float mean = row16_sum((y[0] + y[1]) + (y[2] + y[3])) * (1.0f / 64.0f); \
            _Pragma("unroll") for (int e = 0; e < 4; ++e) y[e] -= mean; \
            const float var = row16_sum((y[0] * y[0] + y[1] * y[1]) + (y[2] * y[2] + y[3] * y[3])) * (1.0f / 64.0f); \
            const float rs = __builtin_amdgcn_rsqf(var + GN_EPS); \
            const float v4[4] = {bflo(vv.x), bfhi(vv.x), bflo(vv.y), bfhi(vv.y)}, g4[4] = {bflo(gg.x), bfhi(gg.x), bflo(gg.y), bfhi(gg.y)}; \
            float ov[4]; \
            _Pragma("unroll") for (int e = 0; e < 4; ++e) ov[e] = (y[e] * rs * w[e] + bb[e] + bon * v4[e]) * g4[e]; \
            v2u ow; ow.x = pk2(ov[0], ov[1]); ow.y = pk2(ov[2], ov[3]); \
            *(v2u*)(OR + (size_t)(row_) * RC + c) = ow; } while (0)
    for (int row = gw; row < SEQ; row += 2 * NGW) { const int rowb = row + NGW; const bool vb = rowb < SEQ; const int ta = row + NMETA, tb = (vb ? rowb : row) + NMETA;
#pragma unroll
        for (int st = 0; st < 8; ++st) { const int c = st * 256 + 4 * F.lane, hd = c >> 6; const size_t oa = (size_t)ta * RC + c, ob = (size_t)tb * RC + c;
            const v2u a0 = *(const v2u*)(Y0 + oa), a1 = *(const v2u*)(Y1 + oa), vv = *(const v2u*)(VV + oa), gg = *(const v2u*)(GG + oa);
            const v2u b0 = *(const v2u*)(Y0 + ob), b1 = *(const v2u*)(Y1 + ob), vw = *(const v2u*)(VV + ob), gh = *(const v2u*)(GG + ob);
            const f32x4 w = *(const f32x4*)(lnw + c), bb = *(const f32x4*)(lnb + c); const float bona = BON[(size_t)ta * RH + hd], bonb = BON[(size_t)tb * RH + hd];
            COMB_ROW(a0, a1, vv, gg, bona, row);
            if (vb) COMB_ROW(b0, b1, vw, gh, bonb, rowb); } }
#undef COMB_ROW
}
__device__ __forceinline__ void final_phase(Frame& F) {
    const float* SS3 = (const float*)(F.ctl + CW_SS3); const float* w = F.in[25];
    const int gw = blockIdx.x * 8 + F.wave, NGW = F.G * 8;
    for (int row = gw; row < SEQ; row += 2 * NGW) { const int rowb = row + NGW; const bool vb = rowb < SEQ; const int rb = vb ? rowb : row;
        const float rstda = 1.0f / sqrtf(SS3[row] * (1.0f / DM) + RMS_EPS), rstdb = 1.0f / sqrtf(SS3[rb] * (1.0f / DM) + RMS_EPS);
        GAS f32x4* pa = (GAS f32x4*)(F.out + (size_t)row * DM) + F.lane; GAS f32x4* pb = (GAS f32x4*)(F.out + (size_t)rb * DM) + F.lane; const GAS f32x4* wp = (const GAS f32x4*)w + F.lane;
        f32x4 va[16], vbv[16];
#pragma unroll
        for (int j = 0; j < 16; ++j) va[j] = pa[64 * j];
#pragma unroll
        for (int j = 0; j < 16; ++j) vbv[j] = pb[64 * j];
#pragma unroll
        for (int j = 0; j < 16; ++j) { const f32x4 ww = wp[64 * j]; pa[64 * j] = va[j] * rstda * ww; if (vb) pb[64 * j] = vbv[j] * rstdb * ww; } }
}
constexpr int N_PHASES = 10;
struct Args { const float* in[26]; float* out; unsigned char* ws; int ph_lo, ph_hi; };
__global__ void __launch_bounds__(512, 2) fwd_kernel(Args args) {
    extern __shared__ __attribute__((aligned(16))) unsigned char lds[];
    Frame F;
    F.lds = (LAS unsigned char*)lds;
    F.MISC = (volatile LAS unsigned*)(F.lds + MISC_OFF);
    F.tid = threadIdx.x; F.lane = F.tid & 63; F.wave = __builtin_amdgcn_readfirstlane(F.tid >> 6); F.G = gridDim.x;
    F.ws = args.ws; F.ctl = (gu32*)(args.ws + WS_CTL); F.out = args.out; F.pb0 = 0; F.pacc = 0; F.pacc2 = 0;
#pragma unroll
    for (int i = 0; i < 26; ++i) F.in[i] = args.in[i];
    for (int u = F.tid; u < (LDS_BYTES - LDSCTL_OFF) / 4; u += 512) ((LAS unsigned*)(F.lds + LDSCTL_OFF))[u] = 0u;
    __syncthreads();
    XcdBarrier bar; bar.bar = (unsigned*)(F.ctl + CW_BAR); bar.x = 0; bar.st = nullptr;
    if (!MK_SPLIT) bar = xcd_barrier_post((unsigned*)(F.ctl + CW_BAR), F.MISC + 8);
    const int lo = args.ph_lo, hi = args.ph_hi;
#define IN(k) (lo <= (k) && (k) < hi)
#define SEAM(k) do { if (IN(k) && IN((k) + 1)) xcd_barrier(bar); } while (0)
    bf16* Rm = (bf16*)(F.ws + WS_H);
    float* SS2 = (float*)(F.ctl + CW_SS2); float* SS3 = (float*)(F.ctl + CW_SS3);

    unsigned long long pt0 = 0, pt1 = 0;
#define PB0(k) do { if ((PROBE_PHASE >> (k)) & 1) pt0 = __builtin_amdgcn_s_memrealtime(); } while (0)
#define PB1(k) do { if ((PROBE_PHASE >> (k)) & 1) pt1 += __builtin_amdgcn_s_memrealtime() - pt0; } while (0)
    PB0(0); if (IN(0)) { p0_prologue(F); } SEAM(0); PB1(0);
    PB0(1); if (IN(1)) {
        pg8::Gemm g{Rm, Rm, MPAD + INWP, MPAD + INWP, DM}; pg8::InOrder S; S.init(F.G, (int)blockIdx.x);
        pg8::EpiIn E{(bf16*)(F.ws + WS_G), (bf16*)(F.ws + WS_Q), (bf16*)(F.ws + WS_K), (bf16*)(F.ws + WS_VT), (bf16*)(F.ws + WS_U), F.in[4], (const float*)(F.ws + WS_ROPE)};
        pg8::gemm_phase<pg8::EpiIn, pg8::InOrder, true, true>(F.lds, g, S, E, F.pacc2);
    } SEAM(1); PB1(1);
    PB0(2); if (IN(2)) { prep_phase(F, bar); } PB1(2);
    PB0(3); if (IN(3)) { scan_phase(F); } SEAM(3); PB1(3);
    PB0(4); if (IN(4)) { combine_phase(F); } SEAM(4); PB1(4);
    PB0(5); if (IN(5)) {
        { pg8::Gemm g{(const bf16*)(F.ws + WS_OATT), (const bf16*)(F.ws + WS_WPA), SEQ, DM, ATTW}; pg8::StaticOrder S; S.init(SEQ, DM, F.G, (int)blockIdx.x);
          pg8::EpiProjA E{(bf16*)(F.ws + WS_P1), (const bf16*)(F.ws + WS_G)};
          pg8::gemm_phase<pg8::EpiProjA, pg8::StaticOrder, true, true>(F.lds, g, S, E, F.pacc2); }
        __syncthreads();
        { pg8::Gemm g{(const bf16*)(F.ws + WS_ORWKV), (const bf16*)(F.ws + WS_WPR), SEQ, DM, RC}; pg8::StaticOrder S; S.init(SEQ, DM, F.G, (int)blockIdx.x);
          pg8::EpiProjB E{(const bf16*)(F.ws + WS_P1), (const bf16*)(F.ws + WS_G), (bf16*)(F.ws + WS_MX)};
          pg8::gemm_phase<pg8::EpiProjB, pg8::StaticOrder, true, true>(F.lds, g, S, E, F.pacc2); }
    } SEAM(5); PB1(5);
    PB0(6); if (IN(6)) {
        pg8::Gemm g{(const bf16*)(F.ws + WS_MX), (const bf16*)(F.ws + WS_WOUT), SEQ, DM, DM}; pg8::StaticOrder S; S.init(SEQ, DM, F.G, (int)blockIdx.x);
        pg8::EpiResid<false> E{F.in[0], nullptr, nullptr, (bf16*)(F.ws + WS_A2), SS2};
        pg8::gemm_phase<pg8::EpiResid<false>, pg8::StaticOrder, true, true>(F.lds, g, S, E, F.pacc2);
    } SEAM(6); PB1(6);
    const unsigned long long epi_before7 = F.pacc2;
    PB0(7); if (IN(7)) {
        pg8::Gemm g{(const bf16*)(F.ws + WS_A2), (const bf16*)(F.ws + WS_WGU), SEQ, 2 * DFF, DM}; pg8::StaticOrder S; S.init(SEQ, 2 * DFF, F.G, (int)blockIdx.x);
        pg8::EpiSwiGLU E{(bf16*)(F.ws + WS_HID), SS2};
        pg8::gemm_phase<pg8::EpiSwiGLU, pg8::StaticOrder, true, true>(F.lds, g, S, E, F.pacc2);
        {
          const int nun = (SEQ / 256) * (2 * DFF / 256), rounds = (nun + F.G - 1) / F.G, first_idle = nun - (rounds - 1) * F.G;
          const int nidle = F.G - first_idle;
          if (nidle > 0) { if ((int)blockIdx.x >= first_idle) convert_wd(F, (LAS float*)(F.lds + F.wave * 8448), ((int)blockIdx.x - first_idle) * 8 + F.wave, nidle * 8); }
          else convert_wd(F, (LAS float*)(F.lds + F.wave * 8448), (int)blockIdx.x * 8 + F.wave, F.G * 8); }
    } SEAM(7); PB1(7);
    const unsigned long long epi_before8 = F.pacc2;
    PB0(8); if (IN(8)) {
        pg8::Gemm g{(const bf16*)(F.ws + WS_HID), (const bf16*)(F.ws + WS_WD), SEQ, DM, DFF}; pg8::StaticOrder S; S.init(SEQ, DM, F.G, (int)blockIdx.x);
        pg8::EpiResid<true> E{nullptr, (const bf16*)(F.ws + WS_A2), F.out, nullptr, SS3};
        pg8::gemm_phase<pg8::EpiResid<true>, pg8::StaticOrder, true, true>(F.lds, g, S, E, F.pacc2);
    } SEAM(8); PB1(8);
    const unsigned long long epi9 = ((PROBE_PHASE >> 24) & 1) ? (epi_before8 - epi_before7) : (F.pacc2 - epi_before8);
    PB0(9); if (IN(9)) { final_phase(F); } PB1(9);
    if (PROBE_PHASE != 0 && blockIdx.x == 0 && F.tid == 0) { const unsigned long long te = __builtin_amdgcn_s_memrealtime(), want = (unsigned long long)PROBE_MULT * (((PROBE_PHASE >> 23) & 1) ? epi9 : ((PROBE_PHASE >> 20) & 1) ? F.pacc2 : (PROBE_PHASE & ((3 << 18) | (3 << 21) | (1 << 26))) ? (unsigned long long)__hip_atomic_load((unsigned*)(F.ctl + 2048), __ATOMIC_RELAXED, __HIP_MEMORY_SCOPE_AGENT) : (pt1 + F.pacc));
        while (__builtin_amdgcn_s_memrealtime() - te < want && want < 2000000ull) __builtin_amdgcn_s_sleep(32); }
#undef PB0
#undef PB1
#undef IN
#undef SEAM
}

extern "C" void kernel_launch(void* const* d_in, const int* in_sizes, int n_in, void* d_out, int out_size, void* d_ws, size_t ws_size, hipStream_t stream) {
    static int grid = 0;
    if (grid == 0) {
        if (n_in != 26 || out_size != SEQ * DM || ws_size < WS_END) { fprintf(stderr, "kernel_launch: unexpected shapes (n_in %d, out %d, ws %zu, need %zu); nothing launched\n", n_in, out_size, ws_size, (size_t)WS_END); grid = -1; return; }
        int dev = 0, cus = 0, per_cu = 0;
        if (hipGetDevice(&dev) != hipSuccess || hipDeviceGetAttribute(&cus, hipDeviceAttributeMultiprocessorCount, dev) != hipSuccess) { grid = -1; return; }
        if (hipFuncSetAttribute((const void*)fwd_kernel, hipFuncAttributeMaxDynamicSharedMemorySize, LDS_BYTES) != hipSuccess) { fprintf(stderr, "kernel_launch: hipFuncSetAttribute failed\n"); grid = -1; return; }
        if (hipOccupancyMaxActiveBlocksPerMultiprocessor(&per_cu, (const void*)fwd_kernel, 512, LDS_BYTES) != hipSuccess || per_cu < 1) fprintf(stderr, "kernel_launch: occupancy query says %d per CU\n", per_cu);
        (void)hipGetLastError();
        grid = cus;
    }
    if (grid < 0) return;
    if (hipMemsetAsync((char*)d_ws + WS_CTL, 0, ZERO_BYTES, stream) != hipSuccess) return;
    Args a{};
    for (int i = 0; i < 26; ++i) a.in[i] = (const float*)d_in[i];
    a.out = (float*)d_out; a.ws = (unsigned char*)d_ws;
#if MK_SPLIT
    for (int p = 0; p < N_PHASES; ++p) { a.ph_lo = p; a.ph_hi = p + 1; hipLaunchKernelGGL(fwd_kernel, dim3(grid), dim3(512), LDS_BYTES, stream, a); }
#else
    a.ph_lo = 0; a.ph_hi = N_PHASES;
    hipLaunchKernelGGL(fwd_kernel, dim3(grid), dim3(512), LDS_BYTES, stream, a);
#endif
}
```
